# Optimizing an MI355X kernel written in HIP

```python
import math
import jax, jax.numpy as jnp
from jax import lax
import numpy as np

D_MODEL = 1024
BATCH = 2
SEQ = 8192
DEPTH = 1

MIX_WIDTH = D_MODEL
FOURIER_WIDTH = D_MODEL // 4
FOURIER_GROUPS = 4
FOURIER_GROUP_DIM = FOURIER_WIDTH // FOURIER_GROUPS
ATTN_WIDTH = MIX_WIDTH - FOURIER_WIDTH
HEAD_DIM = 64
ATTN_HEADS = ATTN_WIDTH // HEAD_DIM
IN_PROJ_WIDTH = FOURIER_WIDTH + 3 * ATTN_WIDTH
DILATED_BRANCHES = ((128, 1), (512, 4), (2048, 16))
Q_BLOCK = 128
ROPE_THETA = 10000.0
NEG_INF = -1e30
PEER_N_KEYS = 128
PEER_N_EXPERTS = PEER_N_KEYS * PEER_N_KEYS
PEER_HEADS = 8
PEER_KEY_DIM = 128
PEER_HALF = PEER_KEY_DIM // 2
PEER_TOPK = 16
TOKEN_CHUNK = 128
LN_EPS = 1e-5
DEEPNORM_ALPHA = (2.0 * DEPTH) ** 0.25
DEEPNORM_BETA = (8.0 * DEPTH) ** -0.25

kernel_name = "hymba_fnet_longnet_peer_encoder"


def _normal(key, shape, std):
    return jax.random.normal(key, shape, jnp.float32) * std


def _normalize(x):
    xf = x.astype(jnp.float32)
    mu = jnp.mean(xf, axis=-1, keepdims=True)
    var = jnp.mean(jnp.square(xf - mu), axis=-1, keepdims=True)
    return ((xf - mu) * lax.rsqrt(var + LN_EPS)).astype(x.dtype)


def _layer_norm(x, gain, bias):
    return _normalize(x) * gain + bias


def _rope(t, positions):
    half = HEAD_DIM // 2
    inv_freq = ROPE_THETA ** (-jnp.arange(half, dtype=jnp.float32) / half)
    ang = positions.astype(jnp.float32)[..., None] * inv_freq
    cos = jnp.cos(ang)[:, :, None, :]
    sin = jnp.sin(ang)[:, :, None, :]
    tf = t.astype(jnp.float32)
    t1, t2 = tf[..., :half], tf[..., half:]
    out = jnp.concatenate([t1 * cos - t2 * sin, t2 * cos + t1 * sin], axis=-1)
    return out.astype(t.dtype)


def _fourier_mixer(f, w_fourier):
    b, s, _ = f.shape
    fg = f.reshape(b, s, FOURIER_GROUPS, FOURIER_GROUP_DIM).astype(jnp.float32)
    spec = jnp.fft.fft2(fg, axes=(1, 3), norm="ortho").real
    out = jnp.einsum('bsgc,gcd->bsgd', spec, w_fourier.astype(jnp.float32))
    return out.reshape(b, s, FOURIER_WIDTH).astype(f.dtype)


def _dilated_attention(q, k, v):
    b, h, s, dh = q.shape
    n_blocks = s // Q_BLOCK
    scale = HEAD_DIM ** -0.5

    def block(i):
        start = i * Q_BLOCK
        qb = lax.dynamic_slice_in_dim(q, start, Q_BLOCK, axis=2).astype(jnp.float32)
        pos = start + jnp.arange(Q_BLOCK, dtype=jnp.int32)
        lses, outs = [], []
        for window, dil in DILATED_BRANCHES:
            n_side = window // (2 * dil)
            offs = dil * jnp.arange(-n_side, n_side + 1, dtype=jnp.int32)
            idx = pos[:, None] + offs[None, :]
            valid = (idx >= 0) & (idx < s)
            idx = jnp.clip(idx, 0, s - 1)
            kg = jnp.take(k, idx, axis=2, mode='clip').astype(jnp.float32)
            vg = jnp.take(v, idx, axis=2, mode='clip').astype(jnp.float32)
            sc = jnp.einsum('bhqd,bhqkd->bhqk', qb, kg) * scale
            sc = jnp.where(valid, sc, NEG_INF)
            lse = jax.nn.logsumexp(sc, axis=-1)
            p = jnp.exp(sc - lse[..., None])
            outs.append(jnp.einsum('bhqk,bhqkd->bhqd', p, vg))
            lses.append(lse)
        w = jax.nn.softmax(jnp.stack(lses, axis=0), axis=0)
        return jnp.einsum('rbhq,rbhqd->bhqd', w, jnp.stack(outs, axis=0))

    out = lax.map(block, jnp.arange(n_blocks, dtype=jnp.int32))
    out = out.transpose(1, 0, 3, 2, 4).reshape(b, s, h * dh)
    return out.astype(q.dtype)


def _peer(h, w_peer_q, peer_subkeys, peer_u, peer_v):
    b, s, d = h.shape
    t = h.reshape(b * s, d)
    n_tok = b * s
    q = (t @ w_peer_q).reshape(n_tok, PEER_HEADS, 2, PEER_HALF).astype(jnp.float32)
    sub = jnp.einsum('thpc,hpkc->thpk', q, peer_subkeys.astype(jnp.float32))
    sv, si = lax.top_k(sub, PEER_TOPK)
    cand = (sv[:, :, 0, :, None] + sv[:, :, 1, None, :]).reshape(n_tok, PEER_HEADS, PEER_TOPK * PEER_TOPK)
    cid = (si[:, :, 0, :, None] * PEER_N_KEYS + si[:, :, 1, None, :]).reshape(n_tok, PEER_HEADS, PEER_TOPK * PEER_TOPK)
    top_v, top_pos = lax.top_k(cand, PEER_TOPK)
    expert_ids = jnp.take_along_axis(cid, top_pos, axis=-1)
    gates = jax.nn.softmax(top_v, axis=-1)
    ids = expert_ids.reshape(n_tok, PEER_HEADS * PEER_TOPK)
    gates = gates.reshape(n_tok, PEER_HEADS * PEER_TOPK)
    n_chunks = n_tok // TOKEN_CHUNK

    def chunk(args):
        tc, ic, gc = args
        ug = jnp.take(peer_u, ic, axis=0, mode='clip').astype(jnp.float32)
        act = jax.nn.gelu(jnp.einsum('ced,cd->ce', ug, tc.astype(jnp.float32)), approximate=False)
        vg = jnp.take(peer_v, ic, axis=0, mode='clip').astype(jnp.float32)
        return jnp.einsum('ce,ced->cd', gc * act, vg)

    y = lax.map(chunk, (t.reshape(n_chunks, TOKEN_CHUNK, d),
                        ids.reshape(n_chunks, TOKEN_CHUNK, -1),
                        gates.reshape(n_chunks, TOKEN_CHUNK, -1)))
    return y.reshape(b, s, d).astype(h.dtype)


def setup_inputs(seed: int = 0) -> dict:
    key = jax.random.key(seed)
    ks = jax.random.split(key, 18)
    d = D_MODEL
    x = _normal(ks[0], (BATCH, SEQ, d), 1.0)
    c = _normal(ks[1], (BATCH, d), 1.0)
    positions = (jnp.arange(SEQ, dtype=jnp.int32)[None, :]
                 + jax.random.randint(ks[2], (BATCH, 1), 0, 1024, dtype=jnp.int32))
    w_ada = _normal(ks[3], (DEPTH, d, 6 * d), 0.2 * d ** -0.5)
    b_ada = _normal(ks[4], (DEPTH, 6 * d), 0.01)
    w_in = _normal(ks[5], (DEPTH, d, IN_PROJ_WIDTH), d ** -0.5)
    b_in = _normal(ks[6], (DEPTH, IN_PROJ_WIDTH), 0.01)
    w_fourier = _normal(ks[7], (DEPTH, FOURIER_GROUPS, FOURIER_GROUP_DIM, FOURIER_GROUP_DIM), FOURIER_GROUP_DIM ** -0.5)
    w_out = _normal(ks[8], (DEPTH, MIX_WIDTH, d), DEEPNORM_BETA * MIX_WIDTH ** -0.5)
    b_out = _normal(ks[9], (DEPTH, d), 0.01)
    ln1_gain = 1.0 + _normal(ks[10], (DEPTH, d), 0.02)
    ln1_bias = _normal(ks[11], (DEPTH, d), 0.02)
    w_peer_q = _normal(ks[12], (DEPTH, d, PEER_HEADS * PEER_KEY_DIM), d ** -0.5)
    peer_subkeys = _normal(ks[13], (DEPTH, PEER_HEADS, 2, PEER_N_KEYS, PEER_HALF), PEER_HALF ** -0.5)
    peer_u = _normal(ks[14], (DEPTH, PEER_N_EXPERTS, d), d ** -0.5)
    peer_v = _normal(ks[15], (DEPTH, PEER_N_EXPERTS, d), DEEPNORM_BETA)
    ln2_gain = 1.0 + _normal(ks[16], (DEPTH, d), 0.02)
    ln2_bias = _normal(ks[17], (DEPTH, d), 0.02)
    return {"x": x, "c": c, "positions": positions,
            "w_ada": w_ada, "b_ada": b_ada, "w_in": w_in, "b_in": b_in,
            "w_fourier": w_fourier, "w_out": w_out, "b_out": b_out,
            "ln1_gain": ln1_gain, "ln1_bias": ln1_bias,
            "w_peer_q": w_peer_q, "peer_subkeys": peer_subkeys,
            "peer_u": peer_u, "peer_v": peer_v,
            "ln2_gain": ln2_gain, "ln2_bias": ln2_bias}


def reference(x, c, positions, w_ada, b_ada, w_in, b_in, w_fourier, w_out, b_out,
              ln1_gain, ln1_bias, w_peer_q, peer_subkeys, peer_u, peer_v,
              ln2_gain, ln2_bias):
    b, s, _ = x.shape
    cond = jax.nn.silu(c)
    for i in range(DEPTH):
        mod = (cond @ w_ada[i] + b_ada[i])[:, None, :]
        shift1, scale1, gate1, shift2, scale2, gate2 = jnp.split(mod, 6, axis=-1)

        h = _normalize(x) * (1.0 + scale1) + shift1
        proj = h @ w_in[i] + b_in[i]
        f_in = proj[..., :FOURIER_WIDTH]
        q, k, v = jnp.split(proj[..., FOURIER_WIDTH:], 3, axis=-1)
        q = _rope(q.reshape(b, s, ATTN_HEADS, HEAD_DIM), positions).transpose(0, 2, 1, 3)
        k = _rope(k.reshape(b, s, ATTN_HEADS, HEAD_DIM), positions).transpose(0, 2, 1, 3)
        v = v.reshape(b, s, ATTN_HEADS, HEAD_DIM).transpose(0, 2, 1, 3)
        mix_a = _fourier_mixer(f_in, w_fourier[i])
        mix_b = _dilated_attention(q, k, v)
        mix = jnp.concatenate([mix_a, mix_b], axis=-1) @ w_out[i] + b_out[i]
        x = _layer_norm(DEEPNORM_ALPHA * x + (1.0 + gate1) * mix, ln1_gain[i], ln1_bias[i])

        h = _normalize(x) * (1.0 + scale2) + shift2
        ffn = _peer(h, w_peer_q[i], peer_subkeys[i], peer_u[i], peer_v[i])
        x = _layer_norm(DEEPNORM_ALPHA * x + (1.0 + gate2) * ffn, ln2_gain[i], ln2_bias[i])
    return x
```

```cpp
#include <hip/hip_runtime.h>
#include <cstdio>
#include <cstdint>
#include <cmath>

constexpr int DM = 1024, NB = 2, SEQ = 8192, NT = NB * SEQ;
constexpr int NTHREADS = 512;
constexpr float LN_EPS = 1e-5f;
constexpr float ALPHA = 1.189207115002721f;

struct Params {
    const float* x; const float* c; const int* pos; const float* w_ada; const float* b_ada; const float* w_in; const float* b_in;
    const float* w_four; const float* w_out; const float* b_out; const float* g1; const float* be1; const float* w_pq; const float* subk;
    const float* pu; const float* pv; const float* g2; const float* be2; float* out; float* ws;
};
constexpr size_t OFF_MOD = 0;
constexpr size_t OFF_TAB = 12288;
constexpr size_t OFF_R0  = 32768;
constexpr size_t OFF_F   = OFF_R0 + (size_t)NT * 1024;
constexpr size_t OFF_Q   = OFF_F + (size_t)NT * 256;
constexpr size_t OFF_K   = OFF_Q + (size_t)NT * 768;
constexpr size_t OFF_V   = OFF_K + (size_t)NT * 768;
constexpr size_t OFF_END = OFF_V + (size_t)NT * 768;

__device__ __forceinline__ float wave_sum(float v) {
#pragma unroll
    for (int o = 32; o > 0; o >>= 1) v += __shfl_xor(v, o);
    return v;
}
__device__ __forceinline__ float wave_max(float v) {
#pragma unroll
    for (int o = 32; o > 0; o >>= 1) v = fmaxf(v, __shfl_xor(v, o));
    return v;
}

__device__ void ph_mod(const Params& p, int bid, int nblk) {
    float* mod = p.ws + OFF_MOD; float* tab = p.ws + OFF_TAB;
    const int gtid = bid * NTHREADS + threadIdx.x, gn = nblk * NTHREADS;
    for (int idx = gtid; idx < NB * 6144; idx += gn) {
        const int b = idx / 6144, n = idx % 6144;
        float acc = p.b_ada[n];
        for (int k = 0; k < DM; ++k) { const float c = p.c[b * DM + k]; const float s = c / (1.0f + expf(-c)); acc += s * p.w_ada[(size_t)k * 6144 + n]; }
        mod[idx] = acc;
    }
    for (int i = gtid; i < 8192; i += gn) { tab[i] = cospif(2.0f * (float)i / 8192.0f); tab[8192 + i] = sinpif(2.0f * (float)i / 8192.0f); }
}

__device__ void ph_ln0mod(const float* src, const float* mod, int shift_off, int scale_off, float* dst, int bid, int nblk) {
    const int lane = threadIdx.x & 63, wv = threadIdx.x >> 6;
    for (int row = bid * 8 + wv; row < NT; row += nblk * 8) {
        const int b = row / SEQ;
        float v[16]; float s = 0.f;
#pragma unroll
        for (int i = 0; i < 16; ++i) { v[i] = src[(size_t)row * DM + lane + 64 * i]; s += v[i]; }
        const float mu = wave_sum(s) * (1.0f / DM);
        float q = 0.f;
#pragma unroll
        for (int i = 0; i < 16; ++i) { const float d = v[i] - mu; q += d * d; }
        const float rstd = rsqrtf(wave_sum(q) * (1.0f / DM) + LN_EPS);
#pragma unroll
        for (int i = 0; i < 16; ++i) { const int cidx = lane + 64 * i;
            dst[(size_t)row * DM + cidx] = (v[i] - mu) * rstd * (1.0f + mod[b * 6144 + scale_off + cidx]) + mod[b * 6144 + shift_off + cidx]; }
    }
}

template <class LA, class LB, class ST>
__device__ void gemm_naive(int M, int N, int K, LA la, LB lb, ST st, float* smem, int bid, int nblk) {
    float (*As)[132] = (float (*)[132])smem;
    float (*Bs)[68] = (float (*)[68])(smem + 16 * 132);
    const int tid = threadIdx.x, ty = tid >> 4, tx = tid & 15;
    const int ntn = N / 64, ntiles = (M / 128) * ntn;
    for (int tile = bid; tile < ntiles; tile += nblk) {
        const int tm = tile / ntn, tn = tile % ntn;
        float acc[4][4];
#pragma unroll
        for (int i = 0; i < 4; ++i)
#pragma unroll
            for (int j = 0; j < 4; ++j) acc[i][j] = 0.f;
        for (int k0 = 0; k0 < K; k0 += 16) {
#pragma unroll
            for (int i = 0; i < 4; ++i) { const int e = tid + i * 512, m = e >> 4, k = e & 15; As[k][m] = la(tm * 128 + m, k0 + k); }
#pragma unroll
            for (int i = 0; i < 2; ++i) { const int e = tid + i * 512, k = e >> 6, n = e & 63; Bs[k][n] = lb(k0 + k, tn * 64 + n); }
            __syncthreads();
#pragma unroll
            for (int kk = 0; kk < 16; ++kk) {
                float a[4], b[4];
#pragma unroll
                for (int i = 0; i < 4; ++i) a[i] = As[kk][ty * 4 + i];
#pragma unroll
                for (int j = 0; j < 4; ++j) b[j] = Bs[kk][tx * 4 + j];
#pragma unroll
                for (int i = 0; i < 4; ++i)
#pragma unroll
                    for (int j = 0; j < 4; ++j) acc[i][j] += a[i] * b[j];
            }
            __syncthreads();
        }
#pragma unroll
        for (int i = 0; i < 4; ++i)
#pragma unroll
            for (int j = 0; j < 4; ++j) st(tm * 128 + ty * 4 + i, tn * 64 + tx * 4 + j, acc[i][j]);
    }
}

__device__ void ph_inproj(const Params& p, float* smem, int bid, int nblk) {
    const float* h = p.ws + OFF_R0; float* F = p.ws + OFF_F; float* Q = p.ws + OFF_Q; float* Kk = p.ws + OFF_K; float* V = p.ws + OFF_V;
    const float* w = p.w_in; const float* bi = p.b_in;
    gemm_naive(NT, 2560, DM,
        [=](int m, int k) { return h[(size_t)m * DM + k]; },
        [=](int k, int n) { return w[(size_t)k * 2560 + n]; },
        [=](int m, int n, float a) { a += bi[n];
            if (n < 256) F[(size_t)m * 256 + n] = a;
            else if (n < 1024) Q[(size_t)m * 768 + (n - 256)] = a;
            else if (n < 1792) Kk[(size_t)m * 768 + (n - 1024)] = a;
            else V[(size_t)m * 768 + (n - 1792)] = a; },
        smem, bid, nblk);
}

__device__ void ph_rope(const Params& p, int bid, int nblk) {
    float* Q = p.ws + OFF_Q; float* Kk = p.ws + OFF_K;
    const size_t gtid = (size_t)bid * NTHREADS + threadIdx.x, gn = (size_t)nblk * NTHREADS;
    for (size_t idx = gtid; idx < (size_t)NT * 12 * 32; idx += gn) {
        const int i = (int)(idx & 31); const int hh = (int)((idx >> 5) % 12); const int t = (int)(idx / (12 * 32));
        const float inv = powf(10000.0f, -(float)i / 32.0f);
        const float ang = (float)p.pos[t] * inv;
        float sn, cs; sincosf(ang, &sn, &cs);
        const size_t o = (size_t)t * 768 + hh * 64 + i;
        { const float a = Q[o], b = Q[o + 32]; Q[o] = a * cs - b * sn; Q[o + 32] = b * cs + a * sn; }
        { const float a = Kk[o], b = Kk[o + 32]; Kk[o] = a * cs - b * sn; Kk[o + 32] = b * cs + a * sn; }
    }
}

__device__ void ph_chdft(const Params& p, int bid, int nblk) {
    const float* F = p.ws + OFF_F; float* P = p.ws + OFF_R0; float* Qs = P + (size_t)NT * 256; const float* tab = p.ws + OFF_TAB;
    const size_t gtid = (size_t)bid * NTHREADS + threadIdx.x, gn = (size_t)nblk * NTHREADS;
    for (size_t idx = gtid; idx < (size_t)NT * 256; idx += gn) {
        const int ch = (int)(idx & 255), g = ch >> 6, cp = ch & 63; const size_t t = idx >> 8;
        float ac = 0.f, as = 0.f;
        for (int c = 0; c < 64; ++c) { const float f = F[t * 256 + g * 64 + c]; const int ti = ((c * cp) & 63) * 128; ac += f * tab[ti]; as += f * tab[8192 + ti]; }
        P[idx] = ac; Qs[idx] = as;
    }
}
__device__ void ph_seqdft(const Params& p, float* smem, int bid, int nblk) {
    const float* P = p.ws + OFF_R0; const float* Qs = P + (size_t)NT * 256; float* spec = p.ws + OFF_R0 + (size_t)2 * NT * 256; const float* tab = p.ws + OFF_TAB;
    const float norm = 1.0f / sqrtf(8192.0f * 64.0f);
    for (int b = 0; b < NB; ++b) {
        gemm_naive(SEQ, 256, 2 * SEQ,
            [=](int m, int k) { const int kk = k & 8191; const int ti = (m * kk) & 8191; return k < 8192 ? tab[ti] : -tab[8192 + ti]; },
            [=](int k, int n) { return k < 8192 ? P[((size_t)b * SEQ + k) * 256 + n] : Qs[((size_t)b * SEQ + (k - 8192)) * 256 + n]; },
            [=](int m, int n, float a) { spec[((size_t)b * SEQ + m) * 256 + n] = a * norm; },
            smem, bid, nblk);
    }
}
__device__ void ph_fmap(const Params& p, int bid, int nblk) {
    const float* spec = p.ws + OFF_R0 + (size_t)2 * NT * 256; float* F = p.ws + OFF_F;
    const size_t gtid = (size_t)bid * NTHREADS + threadIdx.x, gn = (size_t)nblk * NTHREADS;
    for (size_t idx = gtid; idx < (size_t)NT * 256; idx += gn) {
        const int ch = (int)(idx & 255), g = ch >> 6, d = ch & 63; const size_t t = idx >> 8;
        float a = 0.f;
        for (int c = 0; c < 64; ++c) a += spec[t * 256 + g * 64 + c] * p.w_four[(g * 64 + c) * 64 + d];
        F[idx] = a;
    }
}

__device__ void ph_attn(const Params& p, float* smem, int bid, int nblk) {
    float* Q = p.ws + OFF_Q; const float* Kk = p.ws + OFF_K; const float* V = p.ws + OFF_V;
    const int lane = threadIdx.x & 63, wv = threadIdx.x >> 6;
    float* qs = smem + wv * 256; float* ps = qs + 64;
    const int nitems = NT * 12 / 8;
    for (int it = bid; it < nitems; it += nblk) {
        const int item = it * 8 + wv; const int t = item / 12, hh = item % 12; const int b = t / SEQ, qpos = t % SEQ;
        const size_t qo = (size_t)t * 768 + hh * 64;
        __syncthreads();
        qs[lane] = Q[qo + lane];
        __syncthreads();
        float lse[3], outr[3];
#pragma unroll
        for (int r = 0; r < 3; ++r) {
            const int dil = r == 0 ? 1 : (r == 1 ? 4 : 16);
            float sc[3]; bool vd[3];
#pragma unroll
            for (int jj = 0; jj < 3; ++jj) {
                const int j = lane + 64 * jj; const int idx = qpos + dil * (j - 64);
                vd[jj] = (j < 129) && idx >= 0 && idx < SEQ; float a = 0.f;
                if (vd[jj]) { const float* kp = Kk + ((size_t)b * SEQ + idx) * 768 + hh * 64; for (int d = 0; d < 64; ++d) a += qs[d] * kp[d]; a *= 0.125f; }
                sc[jj] = vd[jj] ? a : -1e30f;
            }
            const float m = wave_max(fmaxf(fmaxf(sc[0], sc[1]), sc[2]));
            float e = 0.f;
#pragma unroll
            for (int jj = 0; jj < 3; ++jj) e += vd[jj] ? expf(sc[jj] - m) : 0.f;
            const float ssum = wave_sum(e);
            lse[r] = m + logf(ssum);
            __syncthreads();
#pragma unroll
            for (int jj = 0; jj < 3; ++jj) ps[lane + 64 * jj] = vd[jj] ? expf(sc[jj] - lse[r]) : 0.f;
            __syncthreads();
            float o = 0.f;
            for (int j = 0; j < 129; ++j) { const int idx = qpos + dil * (j - 64); if (idx >= 0 && idx < SEQ) o += ps[j] * V[((size_t)b * SEQ + idx) * 768 + hh * 64 + lane]; }
            outr[r] = o;
        }
        const float mm = fmaxf(fmaxf(lse[0], lse[1]), lse[2]);
        const float w0 = expf(lse[0] - mm), w1 = expf(lse[1] - mm), w2 = expf(lse[2] - mm);
        Q[qo + lane] = (w0 * outr[0] + w1 * outr[1] + w2 * outr[2]) / (w0 + w1 + w2);
    }
}

__device__ void ph_outproj(const Params& p, float* smem, int bid, int nblk) {
    const float* F = p.ws + OFF_F; const float* Q = p.ws + OFF_Q; float* y1 = p.ws + OFF_K; const float* mod = p.ws + OFF_MOD;
    const float* w = p.w_out; const float* bo = p.b_out; const float* x = p.x;
    gemm_naive(NT, DM, DM,
        [=](int m, int k) { return k < 256 ? F[(size_t)m * 256 + k] : Q[(size_t)m * 768 + (k - 256)]; },
        [=](int k, int n) { return w[(size_t)k * DM + n]; },
        [=](int m, int n, float a) { const int b = m / SEQ; y1[(size_t)m * DM + n] = ALPHA * x[(size_t)m * DM + n] + (1.0f + mod[b * 6144 + 2048 + n]) * (a + bo[n]); },
        smem, bid, nblk);
}
__device__ void ph_ln1(const Params& p, int bid, int nblk) {
    const float* y1 = p.ws + OFF_K; float* x1 = p.ws + OFF_R0; float* h2 = p.ws + OFF_F; const float* mod = p.ws + OFF_MOD;
    const int lane = threadIdx.x & 63, wv = threadIdx.x >> 6;
    for (int row = bid * 8 + wv; row < NT; row += nblk * 8) {
        const int b = row / SEQ;
        float v[16]; float s = 0.f;
#pragma unroll
        for (int i = 0; i < 16; ++i) { v[i] = y1[(size_t)row * DM + lane + 64 * i]; s += v[i]; }
        float mu = wave_sum(s) * (1.0f / DM); float q = 0.f;
#pragma unroll
        for (int i = 0; i < 16; ++i) { const float d = v[i] - mu; q += d * d; }
        float rstd = rsqrtf(wave_sum(q) * (1.0f / DM) + LN_EPS);
        s = 0.f;
#pragma unroll
        for (int i = 0; i < 16; ++i) { const int cidx = lane + 64 * i; v[i] = (v[i] - mu) * rstd * p.g1[cidx] + p.be1[cidx]; x1[(size_t)row * DM + cidx] = v[i]; s += v[i]; }
        mu = wave_sum(s) * (1.0f / DM); q = 0.f;
#pragma unroll
        for (int i = 0; i < 16; ++i) { const float d = v[i] - mu; q += d * d; }
        rstd = rsqrtf(wave_sum(q) * (1.0f / DM) + LN_EPS);
#pragma unroll
        for (int i = 0; i < 16; ++i) { const int cidx = lane + 64 * i;
            h2[(size_t)row * DM + cidx] = (v[i] - mu) * rstd * (1.0f + mod[b * 6144 + 4096 + cidx]) + mod[b * 6144 + 3072 + cidx]; }
    }
}
__device__ void ph_peerq(const Params& p, float* smem, int bid, int nblk) {
    const float* h2 = p.ws + OFF_F; float* pq = p.ws + OFF_K; const float* w = p.w_pq;
    gemm_naive(NT, DM, DM,
        [=](int m, int k) { return h2[(size_t)m * DM + k]; },
        [=](int k, int n) { return w[(size_t)k * DM + n]; },
        [=](int m, int n, float a) { pq[(size_t)m * DM + n] = a; },
        smem, bid, nblk);
}
__device__ __forceinline__ void wave_argmax(float& v, int& i) {
#pragma unroll
    for (int o = 32; o > 0; o >>= 1) { const float ov = __shfl_xor(v, o); const int oi = __shfl_xor(i, o); if (ov > v || (ov == v && oi < i)) { v = ov; i = oi; } }
}
__device__ void ph_topk(const Params& p, float* smem, int bid, int nblk) {
    const float* pq = p.ws + OFF_K; int* ids = (int*)(p.ws + OFF_K + (size_t)NT * 1024); float* gates = p.ws + OFF_K + (size_t)NT * 1024 + (size_t)NT * 128;
    const int lane = threadIdx.x & 63, wv = threadIdx.x >> 6;
    float* sv = smem + wv * 64; int* si = (int*)(sv + 32);
    const int nitems = NT * 8 / 8;
    for (int it = bid; it < nitems; it += nblk) {
        const int item = it * 8 + wv; const int t = item >> 3, hh = item & 7;
        __syncthreads();
        for (int pp = 0; pp < 2; ++pp) {
            const float* qp = pq + (size_t)t * DM + hh * 128 + pp * 64;
            const float* k0 = p.subk + ((size_t)(hh * 2 + pp) * 128 + lane) * 64; const float* k1 = k0 + 64 * 64;
            float s0 = 0.f, s1 = 0.f;
            for (int c = 0; c < 64; ++c) { const float qv = qp[c]; s0 += qv * k0[c]; s1 += qv * k1[c]; }
            for (int r = 0; r < 16; ++r) {
                float bv; int bi; if (s0 >= s1) { bv = s0; bi = lane; } else { bv = s1; bi = lane + 64; }
                wave_argmax(bv, bi);
                if (lane == 0) { sv[pp * 16 + r] = bv; si[pp * 16 + r] = bi; }
                if (bi == lane) s0 = -INFINITY; if (bi == lane + 64) s1 = -INFINITY;
            }
        }
        __syncthreads();
        float cv[4];
#pragma unroll
        for (int m = 0; m < 4; ++m) { const int e = lane + 64 * m; cv[m] = sv[e >> 4] + sv[16 + (e & 15)]; }
        float tv = 0.f; int te = 0;
        for (int r = 0; r < 16; ++r) {
            float bv = cv[0]; int bi = lane;
#pragma unroll
            for (int m = 1; m < 4; ++m) if (cv[m] > bv) { bv = cv[m]; bi = lane + 64 * m; }
            wave_argmax(bv, bi);
            if (lane == r) { tv = bv; te = si[bi >> 4] * 128 + si[16 + (bi & 15)]; }
#pragma unroll
            for (int m = 0; m < 4; ++m) if (bi == lane + 64 * m) cv[m] = -INFINITY;
        }
        const float mx = __shfl(tv, 0);
        float ex = lane < 16 ? expf(tv - mx) : 0.f;
        const float sm = wave_sum(ex);
        if (lane < 16) { ids[(size_t)t * 128 + hh * 16 + lane] = te; gates[(size_t)t * 128 + hh * 16 + lane] = ex / sm; }
    }
}
__device__ void ph_gather(const Params& p, int bid, int nblk) {
    const float* x1 = p.ws + OFF_R0; const float* h2 = p.ws + OFF_F; const float* mod = p.ws + OFF_MOD;
    const int* ids = (const int*)(p.ws + OFF_K + (size_t)NT * 1024); const float* gates = p.ws + OFF_K + (size_t)NT * 1024 + (size_t)NT * 128;
    const int lane = threadIdx.x & 63, wv = threadIdx.x >> 6;
    for (int t = bid * 8 + wv; t < NT; t += nblk * 8) {
        const int b = t / SEQ;
        float h[16], y[16];
#pragma unroll
        for (int i = 0; i < 16; ++i) { h[i] = h2[(size_t)t * DM + lane + 64 * i]; y[i] = 0.f; }
        for (int j = 0; j < 128; ++j) {
            int id = ids[(size_t)t * 128 + j]; id = id < 0 ? 0 : (id > 16383 ? 16383 : id); const float g = gates[(size_t)t * 128 + j];
            const float* u = p.pu + (size_t)id * DM; const float* v = p.pv + (size_t)id * DM;
            float d = 0.f;
#pragma unroll
            for (int i = 0; i < 16; ++i) d += h[i] * u[lane + 64 * i];
            d = wave_sum(d);
            const float act = 0.5f * d * (1.0f + erff(d * 0.70710678118654752f));
            const float w = g * act;
#pragma unroll
            for (int i = 0; i < 16; ++i) y[i] += w * v[lane + 64 * i];
        }
        float s = 0.f;
#pragma unroll
        for (int i = 0; i < 16; ++i) { const int cidx = lane + 64 * i; y[i] = ALPHA * x1[(size_t)t * DM + cidx] + (1.0f + mod[b * 6144 + 5120 + cidx]) * y[i]; s += y[i]; }
        const float mu = wave_sum(s) * (1.0f / DM); float q = 0.f;
#pragma unroll
        for (int i = 0; i < 16; ++i) { const float dd = y[i] - mu; q += dd * dd; }
        const float rstd = rsqrtf(wave_sum(q) * (1.0f / DM) + LN_EPS);
#pragma unroll
        for (int i = 0; i < 16; ++i) { const int cidx = lane + 64 * i; p.out[(size_t)t * DM + cidx] = (y[i] - mu) * rstd * p.g2[cidx] + p.be2[cidx]; }
    }
}

template <int PH>
__global__ void __launch_bounds__(NTHREADS) k_phase(Params p) {
    __shared__ float smem[16 * 132 + 16 * 68];
    const int bid = blockIdx.x, nblk = gridDim.x;
    if constexpr (PH == 0) ph_mod(p, bid, nblk);
    if constexpr (PH == 1) ph_ln0mod(p.x, p.ws + OFF_MOD, 0, 1024, p.ws + OFF_R0, bid, nblk);
    if constexpr (PH == 2) ph_inproj(p, smem, bid, nblk);
    if constexpr (PH == 3) ph_rope(p, bid, nblk);
    if constexpr (PH == 4) ph_chdft(p, bid, nblk);
    if constexpr (PH == 5) ph_seqdft(p, smem, bid, nblk);
    if constexpr (PH == 6) ph_fmap(p, bid, nblk);
    if constexpr (PH == 7) ph_attn(p, smem, bid, nblk);
    if constexpr (PH == 8) ph_outproj(p, smem, bid, nblk);
    if constexpr (PH == 9) ph_ln1(p, bid, nblk);
    if constexpr (PH == 10) ph_peerq(p, smem, bid, nblk);
    if constexpr (PH == 11) ph_topk(p, smem, bid, nblk);
    if constexpr (PH == 12) ph_gather(p, bid, nblk);
}

extern "C" void kernel_launch(void* const* d_in, const int* in_sizes, int n_in, void* d_out, int out_size, void* d_ws, size_t ws_size, hipStream_t stream) {
    Params p{};
    p.x = (const float*)d_in[0]; p.c = (const float*)d_in[1]; p.pos = (const int*)d_in[2]; p.w_ada = (const float*)d_in[3]; p.b_ada = (const float*)d_in[4];
    p.w_in = (const float*)d_in[5]; p.b_in = (const float*)d_in[6]; p.w_four = (const float*)d_in[7]; p.w_out = (const float*)d_in[8]; p.b_out = (const float*)d_in[9];
    p.g1 = (const float*)d_in[10]; p.be1 = (const float*)d_in[11]; p.w_pq = (const float*)d_in[12]; p.subk = (const float*)d_in[13]; p.pu = (const float*)d_in[14]; p.pv = (const float*)d_in[15];
    p.g2 = (const float*)d_in[16]; p.be2 = (const float*)d_in[17]; p.out = (float*)d_out; p.ws = (float*)d_ws;
    if (ws_size < OFF_END * sizeof(float)) { fprintf(stderr, "workspace too small: %zu < %zu\n", ws_size, OFF_END * sizeof(float)); return; }
    const dim3 g(1024), b(NTHREADS);
    k_phase<0><<<g, b, 0, stream>>>(p);
    k_phase<1><<<g, b, 0, stream>>>(p);
    k_phase<2><<<g, b, 0, stream>>>(p);
    k_phase<3><<<g, b, 0, stream>>>(p);
    k_phase<4><<<g, b, 0, stream>>>(p);
    k_phase<5><<<g, b, 0, stream>>>(p);
    k_phase<6><<<g, b, 0, stream>>>(p);
    k_phase<7><<<g, b, 0, stream>>>(p);
    k_phase<8><<<g, b, 0, stream>>>(p);
    k_phase<9><<<g, b, 0, stream>>>(p);
    k_phase<10><<<g, b, 0, stream>>>(p);
    k_phase<11><<<g, b, 0, stream>>>(p);
    k_phase<12><<<g, b, 0, stream>>>(p);
}
```

```cpp
#include <hip/hip_runtime.h>
#include <hip/hip_cooperative_groups.h>
#include <cstdio>
#include <cstdint>
#include <cmath>
namespace cg = cooperative_groups;

namespace pg8 {
#define PG8_LAS __attribute__((address_space(3)))
typedef unsigned short bf16_t;
typedef short bf16x8 __attribute__((ext_vector_type(8)));
typedef float f32x4 __attribute__((ext_vector_type(4)));
typedef unsigned u32x4 __attribute__((ext_vector_type(4)));
constexpr int BM = 256, BK = 64, HALF = 128, HTB = HALF * BK * 2  , STAGE_BYTES = 8 * HTB, NXCD = 8, WGM = 8;

__host__ __device__ __forceinline__ int lds_byte(int r, int c) { const int st = (r >> 4) * 2 + (c >> 5), rr = r & 15, cc = c & 31, ob = rr * 64 + cc * 2; return st * 1024 + (ob ^ (((ob >> 9) & 1) << 5)); }
__host__ __device__ __forceinline__ void stage_rc(int b, int& R, int& C) { const int st = b / 1024, sb = b % 1024, swz = sb ^ (((sb >> 9) & 1) << 5); R = (st >> 1) * 16 + swz / 64; C = (st & 1) * 32 + (swz % 64) / 2; }
__host__ __device__ __forceinline__ int perm32(int rho) { const int n = rho >> 4, i = rho & 15; return 8 * (i >> 2) + 4 * n + (i & 3); }

struct Unit { int pm, pn; };
struct Gemm { const bf16_t* A; const bf16_t* Bt; int M, N, K; };

struct StaticOrder {
    int nM, nN, nwg, G, c;
    __host__ __device__ void init(int M, int N, int G_, int c_) { nM = M / BM; nN = N / BM; nwg = nM * nN; G = G_; c = c_; }
    __host__ __device__ bool next(int i, Unit& u) const {
        const long L = (long)i * G + c; if (L >= nwg) return false;
        int wgid = (int)L; { const int q = nwg / NXCD, r = nwg % NXCD, xcd = wgid % NXCD, off = wgid / NXCD; wgid = (xcd < r ? xcd * (q + 1) : r * (q + 1) + (xcd - r) * q) + off; }
        const int nig = WGM * nN, gid = wgid / nig, fm = gid * WGM, gsz = (nM - fm) < WGM ? (nM - fm) : WGM;
        u.pm = fm + ((wgid % nig) % gsz); u.pn = (wgid % nig) / gsz; return true;
    }
    __device__ __forceinline__ void a_ready(const Unit&) const {}
    __device__ __forceinline__ void done(const Unit&) const {}
};

__device__ __forceinline__ unsigned cvt_pk_bf16(float lo, float hi) { unsigned r; asm volatile("v_cvt_pk_bf16_f32 %0, %1, %2" : "=v"(r) : "v"(lo), "v"(hi)); return r; }
typedef float f32x2 __attribute__((ext_vector_type(2)));
__device__ __forceinline__ f32x2 gelu_pk(f32x2 v) {
    const f32x2 av = __builtin_elementwise_abs(v), d = av * 0.2316418882f + 1.0f;
    f32x2 t; t.x = __builtin_amdgcn_rcpf(d.x); t.y = __builtin_amdgcn_rcpf(d.y);
    f32x2 q = t * 0.5307027145f + (-0.7265760135f); q = q * t + 0.7107068705f; q = q * t + (-0.142248368f); q = q * t + 0.127414796f; q = q * t;
    const f32x2 s = (v * v) * (-0.72134752044f);
    f32x2 e; e.x = __builtin_amdgcn_exp2f(s.x); e.y = __builtin_amdgcn_exp2f(s.y);
    const f32x2 m = v * (q * e), r = v - m;
    f32x2 o; o.x = v.x < 0.f ? m.x : r.x; o.y = v.y < 0.f ? m.y : r.y; return o;
}

template <int ACT  > struct EpiBf16 {
    static constexpr bool PERM = true, AFTER_DRAIN = false; static_assert(ACT == 0 || ACT == 1, "EpiBf16: ACT is 0 (none) or 1 (gelu_pk)");
    bf16_t* O; int ldc; const float* bias; int split_cols; size_t split_stride; float scale0;
    __device__ __forceinline__ void operator()(const f32x4 (&acc)[2][2][4][2], const Unit& u, int wr, int wc, int fr, int fq) const {
        const int row0 = u.pm * BM + wr * 64 + fr; int colt = u.pn * BM; bf16_t* base = O;
        float sc = 1.f; if (split_cols) { const int t = colt / split_cols; base += (size_t)t * split_stride; colt -= t * split_cols; if (t == 0) sc = scale0; }
        const int col0 = colt + wc * 32 + 8 * fq, bcol0 = u.pn * BM + wc * 32 + 8 * fq;
        f32x4 bv[2][2];
#pragma unroll
        for (int bj = 0; bj < 2; ++bj)
#pragma unroll
            for (int n = 0; n < 2; ++n) bv[bj][n] = bias ? *(const f32x4*)(bias + bcol0 + bj * HALF + 4 * n) : (f32x4){0.f, 0.f, 0.f, 0.f};
#pragma unroll
        for (int ai = 0; ai < 2; ++ai)
#pragma unroll
            for (int m = 0; m < 4; ++m) { bf16_t* rowp = base + (size_t)(row0 + ai * HALF + m * 16) * ldc + col0;
#pragma unroll
                for (int bj = 0; bj < 2; ++bj) { f32x4 v0 = acc[ai][bj][m][0] + bv[bj][0], v1 = acc[ai][bj][m][1] + bv[bj][1];
                    if (ACT == 1) { f32x2 a = gelu_pk((f32x2){v0[0], v0[1]}), b = gelu_pk((f32x2){v0[2], v0[3]}), c = gelu_pk((f32x2){v1[0], v1[1]}), d = gelu_pk((f32x2){v1[2], v1[3]});
                        v0 = (f32x4){a.x, a.y, b.x, b.y}; v1 = (f32x4){c.x, c.y, d.x, d.y}; }
                    v0 = v0 * sc; v1 = v1 * sc; u32x4 w; w.x = cvt_pk_bf16(v0[0], v0[1]); w.y = cvt_pk_bf16(v0[2], v0[3]); w.z = cvt_pk_bf16(v1[0], v1[1]); w.w = cvt_pk_bf16(v1[2], v1[3]);
                    *(u32x4*)(rowp + bj * HALF) = w; } }
    }
};
template <class Epi, class Sched, bool ALIGN_EPI = false, bool SP2 = false>
__device__ __forceinline__ void gemm_phase(PG8_LAS unsigned char* lds, const Gemm g, const Sched& S, const Epi& E) {
    int tid_ = threadIdx.x; asm volatile("" : "+v"(tid_)); const int tid = tid_, wid = __builtin_amdgcn_readfirstlane(tid >> 6), lane = tid & 63, wr = wid >> 2, wc = wid & 3, fr = lane & 15, fq = lane >> 4;
    const int K = g.K, nt = K / BK;
    unsigned voffA[2], voffB[2];
#pragma unroll
    for (int i = 0; i < 2; ++i) { int R, C; stage_rc(tid * 16 + i * 8192, R, C); const int Rb = Epi::PERM ? ((R & ~31) + perm32(R & 31)) : R;
        voffA[i] = (unsigned)(R * K + C) * 2u; voffB[i] = (unsigned)(Rb * K + C) * 2u; }
    const size_t kstep = (size_t)(BK * 2);
    const size_t hstep = (size_t)HALF * K * 2;
    const size_t tstep = 2 * hstep;
    const unsigned ldsw = (unsigned)wid * 1024u;
    const int aoff = lds_byte(wr * 64 + fr, fq * 8), boff = lds_byte(wc * 32 + fr, fq * 8);
#define PG8_SA(b, h) (((b) * 2 + (h)) * HTB)
#define PG8_SB(b, h) ((4 + (b) * 2 + (h)) * HTB)
#define PG8_STAGE(bufoff, gbase, voff) do { _Pragma("unroll") for (int _i = 0; _i < 2; ++_i) \
        __builtin_amdgcn_global_load_lds((const unsigned*)((const char*)(gbase) + (voff)[_i]), (PG8_LAS unsigned*)(lds + (bufoff) + ldsw + _i * 8192), 16, 0, 0); } while (0)
#define PG8_LDA(dst, b, h) do { _Pragma("unroll") for (int m = 0; m < 4; ++m) _Pragma("unroll") for (int k = 0; k < 2; ++k) dst[m][k] = *(const PG8_LAS bf16x8*)(lds + PG8_SA(b, h) + aoff + m * 2048 + k * 1024); } while (0)
#define PG8_LDB(dst, b, h) do { _Pragma("unroll") for (int n = 0; n < 2; ++n) _Pragma("unroll") for (int k = 0; k < 2; ++k) dst[n][k] = *(const PG8_LAS bf16x8*)(lds + PG8_SB(b, h) + boff + n * 2048 + k * 1024); } while (0)
#define PG8_MMA(ai, bj, At, Bt) do { __builtin_amdgcn_s_setprio(1); _Pragma("unroll") for (int m = 0; m < 4; ++m) _Pragma("unroll") for (int n = 0; n < 2; ++n) _Pragma("unroll") for (int k = 0; k < 2; ++k) \
        acc[ai][bj][m][n] = __builtin_amdgcn_mfma_f32_16x16x32_bf16(Bt[n][k], At[m][k], acc[ai][bj][m][n], 0, 0, 0); __builtin_amdgcn_s_setprio(0); } while (0)
#define PG8_WAIT_V(n) asm volatile("s_waitcnt vmcnt(" #n ")" ::: "memory")
#define PG8_WAIT_L(n) asm volatile("s_waitcnt lgkmcnt(" #n ")" ::: "memory")
#define PG8_BAR __builtin_amdgcn_s_barrier()
#define PG8_SCHED __builtin_amdgcn_sched_barrier(0)
    Unit cur, nxt; int ui = 0;
    if (!S.next(0, cur)) return;
    f32x4 acc[2][2][4][2];
#pragma unroll
    for (int a = 0; a < 2; ++a)
#pragma unroll
        for (int b = 0; b < 2; ++b)
#pragma unroll
            for (int m = 0; m < 4; ++m)
#pragma unroll
                for (int n = 0; n < 2; ++n) acc[a][b][m][n] = (f32x4){0.f, 0.f, 0.f, 0.f};
    bf16x8 At[4][2], B0[2][2], B1[2][2];
    const char* cA = (const char*)g.A + (size_t)cur.pm * tstep; const char* cB = (const char*)g.Bt + (size_t)cur.pn * tstep;
    S.a_ready(cur);
    if constexpr (SP2) {
        PG8_STAGE(PG8_SB(0, 0), cB, voffB); PG8_STAGE(PG8_SB(0, 1), cB + hstep, voffB); PG8_STAGE(PG8_SA(0, 0), cA, voffA); PG8_STAGE(PG8_SA(0, 1), cA + hstep, voffA);
        if (wr == 1) PG8_BAR;
        PG8_WAIT_V(2); PG8_BAR;
        PG8_STAGE(PG8_SB(1, 0), cB + kstep, voffB); PG8_STAGE(PG8_SA(1, 0), cA + kstep, voffA); PG8_STAGE(PG8_SB(1, 1), cB + hstep + kstep, voffB);
        PG8_WAIT_V(6); PG8_BAR;
    } else {
        PG8_STAGE(PG8_SB(0, 0), cB, voffB); PG8_STAGE(PG8_SA(0, 0), cA, voffA); PG8_STAGE(PG8_SB(0, 1), cB + hstep, voffB); PG8_STAGE(PG8_SA(0, 1), cA + hstep, voffA);
        if (wr == 1) PG8_BAR;
        PG8_WAIT_V(4); PG8_BAR;
        PG8_STAGE(PG8_SB(1, 0), cB + kstep, voffB); PG8_STAGE(PG8_SA(1, 0), cA + kstep, voffA); PG8_STAGE(PG8_SB(1, 1), cB + hstep + kstep, voffB);
        PG8_WAIT_V(6); PG8_BAR;
    }
    for (;;) {
        const bool has_next = S.next(ui + 1, nxt);
        const char* nA = has_next ? (const char*)g.A + (size_t)nxt.pm * tstep : cA; const char* nB = has_next ? (const char*)g.Bt + (size_t)nxt.pn * tstep : cB;
        for (int t = 0; t < nt; t += 2) {
            const bool last = (t == nt - 2);
            const char* a1 = cA + (size_t)(t + 1) * kstep;
            const char* a2 = last ? nA : cA + (size_t)(t + 2) * kstep; const char* b2 = last ? nB : cB + (size_t)(t + 2) * kstep;
            const char* a3 = a2 + kstep; const char* b3 = b2 + kstep;
            if (last && has_next) S.a_ready(nxt);
            if constexpr (SP2) {
            PG8_LDB(B0, 0, 0); PG8_LDB(B1, 0, 1); PG8_SCHED; PG8_LDA(At, 0, 0); PG8_STAGE(PG8_SA(1, 1), a1 + hstep, voffA);
            PG8_WAIT_V(8); PG8_WAIT_L(0); PG8_BAR; PG8_MMA(0, 0, At, B0); PG8_MMA(0, 1, At, B1); PG8_BAR; PG8_SCHED;
            PG8_LDA(At, 0, 1); PG8_STAGE(PG8_SB(0, 0), b2, voffB); PG8_STAGE(PG8_SB(0, 1), b2 + hstep, voffB); PG8_STAGE(PG8_SA(0, 0), a2, voffA);
            PG8_WAIT_V(8); PG8_WAIT_L(0); PG8_BAR; PG8_MMA(1, 0, At, B0); PG8_MMA(1, 1, At, B1); PG8_BAR; PG8_SCHED;
            PG8_LDB(B0, 1, 0); PG8_LDB(B1, 1, 1); PG8_SCHED; PG8_LDA(At, 1, 0); PG8_STAGE(PG8_SA(0, 1), a2 + hstep, voffA);
            PG8_WAIT_V(8); PG8_WAIT_L(0); PG8_BAR; PG8_MMA(0, 0, At, B0); PG8_MMA(0, 1, At, B1); PG8_BAR; PG8_SCHED;
            PG8_LDA(At, 1, 1); PG8_STAGE(PG8_SB(1, 0), b3, voffB); PG8_STAGE(PG8_SB(1, 1), b3 + hstep, voffB); PG8_STAGE(PG8_SA(1, 0), a3, voffA);
            PG8_WAIT_V(8); PG8_WAIT_L(0); PG8_BAR; PG8_MMA(1, 0, At, B0); PG8_MMA(1, 1, At, B1); PG8_BAR; PG8_SCHED;
            } else {
            PG8_LDB(B0, 0, 0); PG8_SCHED; PG8_LDA(At, 0, 0); PG8_STAGE(PG8_SA(1, 1), a1 + hstep, voffA);
            PG8_WAIT_L(8); PG8_BAR; PG8_WAIT_L(0); PG8_MMA(0, 0, At, B0); PG8_BAR; PG8_SCHED;
            PG8_LDB(B1, 0, 1); PG8_STAGE(PG8_SB(0, 0), b2, voffB);
            PG8_BAR; PG8_WAIT_L(0); PG8_MMA(0, 1, At, B1); PG8_BAR;
            PG8_LDA(At, 0, 1); PG8_STAGE(PG8_SA(0, 0), a2, voffA);
            PG8_BAR; PG8_WAIT_L(0); PG8_MMA(1, 0, At, B0); PG8_BAR; PG8_SCHED;
            PG8_STAGE(PG8_SB(0, 1), b2 + hstep, voffB);
            PG8_WAIT_V(6); PG8_BAR; PG8_MMA(1, 1, At, B1); PG8_BAR;
            PG8_LDB(B0, 1, 0); PG8_SCHED; PG8_LDA(At, 1, 0); PG8_STAGE(PG8_SA(0, 1), a2 + hstep, voffA);
            PG8_WAIT_L(8); PG8_BAR; PG8_WAIT_L(0); PG8_MMA(0, 0, At, B0); PG8_BAR; PG8_SCHED;
            PG8_LDB(B1, 1, 1); PG8_STAGE(PG8_SB(1, 0), b3, voffB);
            PG8_BAR; PG8_WAIT_L(0); PG8_MMA(0, 1, At, B1); PG8_BAR;
            PG8_LDA(At, 1, 1); PG8_STAGE(PG8_SA(1, 0), a3, voffA);
            PG8_BAR; PG8_WAIT_L(0); PG8_MMA(1, 0, At, B0); PG8_BAR; PG8_SCHED;
            PG8_STAGE(PG8_SB(1, 1), b3 + hstep, voffB);
            PG8_WAIT_V(6); PG8_BAR; PG8_MMA(1, 1, At, B1); PG8_BAR;
            }
        }
        if constexpr (ALIGN_EPI) { if (wr == 0) PG8_BAR; }
        if constexpr (!Epi::AFTER_DRAIN) { E(acc, cur, wr, wc, fr, fq); S.done(cur); }
        if (!has_next) break;
#pragma unroll
        for (int a = 0; a < 2; ++a)
#pragma unroll
            for (int b = 0; b < 2; ++b)
#pragma unroll
                for (int m = 0; m < 4; ++m)
#pragma unroll
                    for (int n = 0; n < 2; ++n) acc[a][b][m][n] = (f32x4){0.f, 0.f, 0.f, 0.f};
        cur = nxt; cA = nA; cB = nB; ++ui;
        if constexpr (ALIGN_EPI) { if (wr == 1) PG8_BAR; }
    }
    PG8_WAIT_V(0);
    if constexpr (!ALIGN_EPI) { if (wr == 0) PG8_BAR; }
    PG8_BAR;
    if constexpr (Epi::AFTER_DRAIN) { E.fused(acc, cur, wr, wc, fr, fq, lds, wid, lane); S.done(cur); }
#undef PG8_SA
#undef PG8_SB
#undef PG8_STAGE
#undef PG8_LDA
#undef PG8_LDB
#undef PG8_MMA
#undef PG8_WAIT_V
#undef PG8_WAIT_L
#undef PG8_BAR
#undef PG8_SCHED
}
}

#define LAS __attribute__((address_space(3)))
#define GAS __attribute__((address_space(1)))
#define XB_TMO      128
#define XB_XCNT(j)  (256  + 64 * (j))
#define XB_XSUB(j)  (1280 + 64 * (j))
#define XB_XGEN(j)  (2304 + 64 * (j))
#define XB_TOP      3328
#define XB_TOPGEN   3392
#define XCD_BAR_WORDS 3456
#define XB_SPIN_CAP (1u << 18)

__device__ __forceinline__ unsigned xb_ld(unsigned* p)              { return __hip_atomic_load(p, __ATOMIC_RELAXED, __HIP_MEMORY_SCOPE_AGENT); }
__device__ __forceinline__ unsigned xb_add(unsigned* p, unsigned v) { return __hip_atomic_fetch_add(p, v, __ATOMIC_RELAXED, __HIP_MEMORY_SCOPE_AGENT); }
__device__ __forceinline__ unsigned xb_xcc_id() { return (unsigned)__builtin_amdgcn_s_getreg((3 << 11) | 20) & 0xFu; }
#define XB_SPIN(cond, bar) do { unsigned _sp = 0; while (cond) { __builtin_amdgcn_s_sleep(1); \
    if ((++_sp & 255u) == 0u) { if (xb_ld(&(bar)[XB_TMO])) break; if (_sp > XB_SPIN_CAP) { atomicAdd(&(bar)[XB_TMO], 1u); break; } } } } while (0)

struct XcdBarrier {
    unsigned* bar; unsigned x;
    volatile LAS unsigned* st;
};

__device__ __forceinline__ XcdBarrier xcd_barrier_post(unsigned* bar, volatile LAS unsigned* st) {
    XcdBarrier b; b.bar = bar; b.x = xb_xcc_id(); b.st = st;
    if (threadIdx.x == 0) (void)xb_add(&bar[XB_XCNT(b.x)], 1u);
    return b;
}
__device__ __forceinline__ void xcd_barrier_complete(unsigned* bar, unsigned x, unsigned& nloc, unsigned& nx) {
    const unsigned G = gridDim.x * gridDim.y * gridDim.z;
    unsigned sum, cnt, mine, sp = 0u;
    for (;;) {
        sum = 0u; cnt = 0u; mine = 0u;
#pragma unroll
        for (unsigned j = 0; j < 16; ++j) { const unsigned c = xb_ld(&bar[XB_XCNT(j)]); sum += c; cnt += (c > 0u) ? 1u : 0u; mine = (j == x) ? c : mine; }
        if (sum == G) break;
        __builtin_amdgcn_s_sleep(1);
        if ((++sp & 255u) == 0u) { if (xb_ld(&bar[XB_TMO])) break; if (sp > XB_SPIN_CAP) { atomicAdd(&bar[XB_TMO], 1u); break; } }
    }
    nloc = mine > 0u ? mine : 1u; nx = cnt > 0u ? cnt : 1u;
}

__device__ __forceinline__ void xcd_barrier(const XcdBarrier& b) {
    asm volatile("s_waitcnt vmcnt(0)" ::: "memory");
    __syncthreads();
    if (threadIdx.x == 0) {
        unsigned* bar = b.bar;
        __builtin_amdgcn_s_waitcnt(0);
        unsigned nloc = b.st[0], nx = b.st[1];
        if (nloc == 0u) { xcd_barrier_complete(bar, b.x, nloc, nx); b.st[0] = nloc; b.st[1] = nx; }
        const unsigned old = xb_add(&bar[XB_XSUB(b.x)], 1u);
        const unsigned gen = old / nloc;
        if (old + 1u == (gen + 1u) * nloc) {
            __builtin_amdgcn_fence(__ATOMIC_RELEASE, "agent");
            asm volatile("s_waitcnt vmcnt(0)" ::: "memory");
            const unsigned og = xb_add(&bar[XB_TOP], 1u);
            const unsigned tg = og / nx;
            if (og + 1u == (tg + 1u) * nx) xb_add(&bar[XB_TOPGEN], 1u);
            else XB_SPIN(xb_ld(&bar[XB_TOPGEN]) == tg, bar);
            __builtin_amdgcn_fence(__ATOMIC_ACQUIRE, "agent");
            xb_add(&bar[XB_XGEN(b.x)], 1u);
            asm volatile("s_waitcnt vmcnt(0)" ::: "memory");
        } else {
            XB_SPIN(xb_ld(&bar[XB_XGEN(b.x)]) == gen, bar);
            __builtin_amdgcn_fence(__ATOMIC_ACQUIRE, "agent");
            asm volatile("s_waitcnt vmcnt(0)" ::: "memory");
        }
    }
    __syncthreads();
}

constexpr int DM = 1024, NB = 2, SEQ = 8192, NT = NB * SEQ;
constexpr int NTHREADS = 512, NWAVES = 8;
constexpr float LN_EPS = 1e-5f;
constexpr float ALPHA = 1.189207115002721f;
typedef unsigned short bf16;
typedef unsigned v4u __attribute__((ext_vector_type(4)));
typedef unsigned v2u __attribute__((ext_vector_type(2)));
typedef float f32x4 __attribute__((ext_vector_type(4)));
typedef short bf16x8_t __attribute__((ext_vector_type(8)));

constexpr size_t MiB = 1u << 20, KiB = 1u << 10;
constexpr size_t WS_CTL = 0, CTL_ZERO_BYTES = 1 * MiB;
constexpr size_t WS_MOD = 1 * MiB + 768 * KiB;
constexpr size_t WS_MMAT = 1 * MiB;
constexpr size_t WS_ROPE = 2 * MiB;
constexpr size_t WS_WIN = 6 * MiB, WS_WOUT = 12 * MiB, WS_WPQ = 14 * MiB, WS_MISC = 16 * MiB, WS_SUBK = 17 * MiB;
constexpr size_t WS_XN = 18 * MiB;
constexpr size_t WS_FZ = 50 * MiB;
constexpr size_t WS_QB = 66 * MiB, WS_KB = 90 * MiB, WS_VB = 114 * MiB, WS_O3 = 138 * MiB, WS_LSE = 162 * MiB;
constexpr size_t WS_H2Q = 50 * MiB, WS_HS = 66 * MiB, WS_WQ = 67 * MiB, WS_WSC = 69 * MiB, WS_SUA = 75 * MiB, WS_X1 = 83 * MiB;
constexpr size_t WS_Y1 = 116 * MiB, WS_PQ = 116 * MiB, WS_PART = 116 * MiB, WS_Y = 116 * MiB;
constexpr size_t WS_IDS = 180 * MiB, WS_GATES = 188 * MiB;
constexpr size_t WS_TU8 = 200 * MiB, WS_TV8 = 216 * MiB, WS_SU = 232 * MiB, WS_SV = 232 * MiB + 64 * KiB, WS_END = 233 * MiB;
constexpr float QSCALE = 0.125f * 1.4426950408889634f;
constexpr int NIN = 2816;
constexpr int CW_BAR = 4096;

constexpr int RING_BYTES = 131072, LDSCTL_OFF = RING_BYTES, MISC_OFF = LDSCTL_OFF + 320, LDS_BYTES = 147456;

struct Params {
    const float* x; const float* c; const int* pos; const float* w_ada; const float* b_ada; const float* w_in; const float* b_in;
    const float* w_four; const float* w_out; const float* b_out; const float* g1; const float* be1; const float* w_pq; const float* subk;
    const float* pu; const float* pv; const float* g2; const float* be2; float* out; unsigned char* ws;
};

__device__ __forceinline__ unsigned f2bf(float f) { unsigned u = __builtin_bit_cast(unsigned, f); return (u + 0x7fffu + ((u >> 16) & 1u)) >> 16; }
__device__ __forceinline__ unsigned pk2(float lo, float hi) { return f2bf(lo) | (f2bf(hi) << 16); }
__device__ __forceinline__ float wave_sum(float v) {
#pragma unroll
    for (int o = 32; o > 0; o >>= 1) v += __shfl_xor(v, o);
    return v;
}
__device__ __forceinline__ float wave_max(float v) {
#pragma unroll
    for (int o = 32; o > 0; o >>= 1) v = fmaxf(v, __shfl_xor(v, o));
    return v;
}
#define LDS_WAIT() asm volatile("s_waitcnt lgkmcnt(0)" ::: "memory")
__device__ __forceinline__ int opaque_tid() { int t = threadIdx.x; asm volatile("" : "+v"(t)); return t; }
__device__ __forceinline__ int wave_id() { return __builtin_amdgcn_readfirstlane(opaque_tid() >> 6); }
__device__ __forceinline__ float bflo(unsigned u) { return __builtin_bit_cast(float, u << 16); }
__device__ __forceinline__ float bfhi(unsigned u) { return __builtin_bit_cast(float, u & 0xffff0000u); }

template <class SC>
__device__ __forceinline__ void transpose_item(const float* W, int K, int N, bf16* WT, int nout, SC srccol, LAS float* scr, int item, int lane) {
    const int nblk = nout / 32, kb = item / nblk, nb = item % nblk, k0 = 64 * kb, n0 = 32 * nb;
    const int sc = srccol(n0 + (lane & 31));
#pragma unroll 8
    for (int i = 0; i < 32; ++i) { const int kk = 2 * i + (lane >> 5); scr[kk * 33 + (lane & 31)] = W[(size_t)(k0 + kk) * N + sc]; }
    LDS_WAIT(); asm volatile("" ::: "memory");
    const int c = lane & 7;
#pragma unroll
    for (int j = 0; j < 4; ++j) { const int n = (lane >> 3) + 8 * j; const LAS float* s = scr + (8 * c) * 33 + n;
        v4u o; o.x = pk2(s[0 * 33], s[1 * 33]); o.y = pk2(s[2 * 33], s[3 * 33]); o.z = pk2(s[4 * 33], s[5 * 33]); o.w = pk2(s[6 * 33], s[7 * 33]);
        *(v4u*)(WT + (size_t)(n0 + n) * K + k0 + 8 * c) = o; }
    LDS_WAIT(); asm volatile("" ::: "memory");
}
__device__ __forceinline__ void ph_prologue(const Params& p, LAS unsigned char* lds, int bid, int nblk) {
    const int tid = opaque_tid(), lane = tid & 63, wave = __builtin_amdgcn_readfirstlane(tid >> 6);
    {
        LAS float* M = (LAS float*)lds; LAS float* Wl = (LAS float*)(lds + 32768);
        bf16* WT = (bf16*)(p.ws + WS_WIN); float* biasf = (float*)(p.ws + WS_MISC); const float* MM = (const float*)(p.ws + WS_MMAT);
        const bool fallback = !(nblk > 192);
        for (int it = bid; it < 256; it += nblk) {
            const int g = it & 3, kb = it >> 2, k0 = kb * 16;
            __syncthreads();
            if (fallback) { const float norm = 1.0f / sqrtf(8192.0f * 64.0f);
                for (int e = tid; e < 8192; e += NTHREADS) { const int c = e >> 7, nl = e & 127; float a = 0.f;
                    for (int cp = 0; cp < 64; ++cp) { const float ang = 2.0f * (float)((c * cp) & 63) / 64.0f; a += ((nl & 1) ? -sinpif(ang) : cospif(ang)) * p.w_four[(g * 64 + cp) * 64 + (nl >> 1)]; }
                    M[e] = a * norm; } }
            else {
#pragma unroll
                for (int i = 0; i < 4; ++i) *(LAS f32x4*)(lds + (tid + i * 512) * 16) = *(const f32x4*)(MM + (size_t)g * 8192 + (tid + i * 512) * 4); }
#pragma unroll
            for (int i = 0; i < 2; ++i) { const int e = tid + i * 512, k = e >> 6, c = e & 63; Wl[k * 64 + c] = p.w_in[(size_t)(k0 + k) * 2560 + g * 64 + c]; }
            __syncthreads();
            { const int nl = tid & 127, kq = tid >> 7; float a[4] = {0.f, 0.f, 0.f, 0.f};
              for (int c = 0; c < 64; ++c) { const float mv = M[c * 128 + nl];
#pragma unroll
                  for (int j = 0; j < 4; ++j) a[j] += mv * Wl[(kq * 4 + j) * 64 + c]; }
              *(v2u*)(WT + (size_t)(g * 128 + nl) * DM + k0 + kq * 4) = (v2u){pk2(a[0], a[1]), pk2(a[2], a[3])};
              if (kb == 0 && tid < 128) { float bsum = 0.f; for (int c = 0; c < 64; ++c) bsum += p.b_in[g * 64 + c] * M[c * 128 + nl]; biasf[g * 128 + nl] = bsum; } }
        }
        __syncthreads();
        for (int i = bid * NTHREADS + tid; i < 2304; i += nblk * NTHREADS) biasf[512 + i] = p.b_in[256 + i];
    }
    {
        LAS float* scr = (LAS float*)(lds + wave * 16384);
        const int gw = bid * NWAVES + wave, NGW = nblk * NWAVES;
        constexpr int I_IN = 16 * (2304 / 32), I_O = 16 * 32, I_PQ = 16 * 32;
        for (int it = gw; it < I_IN + I_O + I_PQ; it += NGW) {
            int r = it;
            if (r < I_IN) {
                transpose_item(p.w_in, DM, 2560, (bf16*)(p.ws + WS_WIN) + (size_t)512 * DM, 2304,
                    [](int n) { return n < 1536 ? 256 + (n & ~63) + ((n & 63) >> 1) + 32 * (n & 1) : 256 + n; }, scr, r, lane); continue; } r -= I_IN;
            if (r < I_O) { transpose_item(p.w_out, DM, DM, (bf16*)(p.ws + WS_WOUT), DM, [](int n) { return n; }, scr, r, lane); continue; } r -= I_O;
            transpose_item(p.w_pq, DM, DM, (bf16*)(p.ws + WS_WPQ), DM, [](int n) { return n; }, scr, r, lane);
        }
    }
    { float2* rope = (float2*)(p.ws + WS_ROPE);
      for (int idx = bid * NTHREADS + tid; idx < NT * 32; idx += nblk * NTHREADS) { const int t = idx >> 5, i = idx & 31;
          const float inv = powf(10000.0f, -(float)i / 32.0f); float sn, cs; sincosf((float)p.pos[t] * inv, &sn, &cs); rope[idx] = make_float2(cs, sn); } }
    { bf16* SK = (bf16*)(p.ws + WS_SUBK);
      for (int ch = bid * NTHREADS + tid; ch < 8 * 2 * 4 * 4 * 64; ch += nblk * NTHREADS) {
          const int ln = ch & 63, d0 = (ch >> 6) & 3, mt = (ch >> 8) & 3, hp = ch >> 10;
          const float* sp = p.subk + ((size_t)hp * 128 + 32 * mt + (ln & 31)) * 64 + 16 * d0 + 8 * (ln >> 5);
          v4u o; o.x = pk2(sp[0], sp[1]); o.y = pk2(sp[2], sp[3]); o.z = pk2(sp[4], sp[5]); o.w = pk2(sp[6], sp[7]);
          *(v4u*)(SK + (size_t)ch * 8) = o; } }
}
__device__ __forceinline__ void ph_mod(const Params& p, LAS unsigned char* lds, int bid, int nblk) {
    const int tid = opaque_tid(), col = tid & 31, kg = tid >> 5;
    LAS float* cond = (LAS float*)lds; LAS float* red = (LAS float*)(lds + 8192);
    float* mod = (float*)(p.ws + WS_MOD);
    for (int i = tid; i < 2 * DM; i += NTHREADS) { const float c = p.c[i]; cond[i] = c / (1.0f + expf(-c)); }
    __syncthreads();
    if (nblk > 192 && bid >= 192) {
        LAS float* T64 = (LAS float*)(lds + 12288);
        if (tid < 64) { T64[tid] = cospif(2.0f * (float)tid / 64.0f); T64[64 + tid] = -sinpif(2.0f * (float)tid / 64.0f); }
        __syncthreads();
        const float norm = 1.0f / sqrtf(8192.0f * 64.0f); float* MM = (float*)(p.ws + WS_MMAT);
        for (int it = bid - 192; it < 64; it += nblk - 192) {
            const int g = it >> 4, c = (it & 15) * 4 + (tid >> 7), nl = tid & 127; float a = 0.f;
#pragma unroll 8
            for (int cp = 0; cp < 64; ++cp) a += T64[(nl & 1) * 64 + ((c * cp) & 63)] * p.w_four[(g * 64 + cp) * 64 + (nl >> 1)];
            MM[(g * 64 + c) * 128 + nl] = a * norm;
        }
    }
    for (int it = bid; it < 6144 / 32; it += nblk) {
        const int n = it * 32 + col; float a0 = 0.f, a1 = 0.f;
        const float* wp = p.w_ada + (size_t)(kg * 64) * 6144 + n;
#pragma unroll 16
        for (int k = 0; k < 64; ++k) { const float w = wp[(size_t)k * 6144]; a0 += cond[kg * 64 + k] * w; a1 += cond[DM + kg * 64 + k] * w; }
        red[(kg * 2 + 0) * 32 + col] = a0; red[(kg * 2 + 1) * 32 + col] = a1;
        __syncthreads();
        if (tid < 64) { const int b = tid >> 5; float s = p.b_ada[n];
#pragma unroll
            for (int g = 0; g < 16; ++g) s += red[(g * 2 + b) * 32 + col];
            mod[b * 6144 + n] = s; }
        __syncthreads();
    }
}
__device__ __forceinline__ void ph_xn(const Params& p, int bid, int nblk) {
    const int lane = opaque_tid() & 63, wave = wave_id(); const float* mod = (const float*)(p.ws + WS_MOD); bf16* XN = (bf16*)(p.ws + WS_XN);
    for (int row = bid * NWAVES + wave; row < NT; row += nblk * NWAVES) {
        const int b = row / SEQ;
        const f32x4* xr = (const f32x4*)(p.x + (size_t)row * DM) + lane;
        f32x4 v[4]; float s = 0.f;
#pragma unroll
        for (int j = 0; j < 4; ++j) { v[j] = xr[64 * j]; s += (v[j].x + v[j].y) + (v[j].z + v[j].w); }
        const float mean = wave_sum(s) * (1.f / DM); float s2 = 0.f;
#pragma unroll
        for (int j = 0; j < 4; ++j) { v[j] = v[j] - mean; s2 += (v[j].x * v[j].x + v[j].y * v[j].y) + (v[j].z * v[j].z + v[j].w * v[j].w); }
        const float rstd = rsqrtf(wave_sum(s2) * (1.f / DM) + LN_EPS);
        unsigned long long* o8 = (unsigned long long*)(XN + (size_t)row * DM) + lane;
#pragma unroll
        for (int j = 0; j < 4; ++j) {
            const f32x4 sh = *((const f32x4*)(mod + b * 6144 + 0) + lane + 64 * j), sc = *((const f32x4*)(mod + b * 6144 + 1024) + lane + 64 * j);
            const f32x4 o = v[j] * rstd * (1.0f + sc) + sh;
            o8[64 * j] = (unsigned long long)pk2(o.x, o.y) | ((unsigned long long)pk2(o.z, o.w) << 32);
        }
    }
}

struct EpiOut {
    static constexpr bool PERM = true, AFTER_DRAIN = false;
    bf16* Y1; const float* mod; const float* bo;
    __device__ __forceinline__ void operator()(const pg8::f32x4 (&acc)[2][2][4][2], const pg8::Unit& u, int wr, int wc, int fr, int fq) const {
        const int row0 = u.pm * 256 + wr * 64 + fr;
#pragma unroll
        for (int bj = 0; bj < 2; ++bj) {
            const int c0 = u.pn * 256 + bj * 128 + wc * 32 + 8 * fq;
            const pg8::f32x4 b0 = *(const pg8::f32x4*)(bo + c0), b1 = *(const pg8::f32x4*)(bo + c0 + 4);
#pragma unroll
            for (int ai = 0; ai < 2; ++ai) {
                const int bb = (u.pm * 256 + ai * 128) >> 13;
                const pg8::f32x4 g0 = *(const pg8::f32x4*)(mod + bb * 6144 + 2048 + c0) + 1.0f, g1 = *(const pg8::f32x4*)(mod + bb * 6144 + 2048 + c0 + 4) + 1.0f;
#pragma unroll
                for (int m = 0; m < 4; ++m) {
                    const int row = row0 + ai * 128 + m * 16;
                    const pg8::f32x4 v0 = g0 * (acc[ai][bj][m][0] + b0), v1 = g1 * (acc[ai][bj][m][1] + b1);
                    v4u o; o.x = pk2(v0.x, v0.y); o.y = pk2(v0.z, v0.w); o.z = pk2(v1.x, v1.y); o.w = pk2(v1.z, v1.w);
                    *(v4u*)(Y1 + (size_t)row * DM + c0) = o;
                }
            }
        }
    }
};
__device__ __forceinline__ void ph_fft(const Params& p, LAS unsigned char* lds, int bid, int nblk) {
    const int tid = opaque_tid(), lane = tid & 63, wave = __builtin_amdgcn_readfirstlane(tid >> 6), lr = lane & 15, lq = lane >> 4;
    bf16* MIX = (bf16*)(p.ws + WS_XN);
    for (int item = bid; item < 256; item += nblk) {
        const int b = item >> 7, cg = item & 127;
        const unsigned long long* src = (const unsigned long long*)(p.ws + WS_FZ) + (size_t)(b * 128 + cg) * 8192;
#pragma unroll 4
        for (int i = 0; i < 16; ++i) {
            const int q = i * 512 + tid; const int n2 = (q & 7) | (((q >> 6) & 15) << 3), n1 = ((q >> 3) & 7) | (((q >> 10) & 7) << 3);
            const unsigned long long v = src[128 * n1 + n2];
            *(LAS unsigned*)(lds + (2 * n2) * 288 + 4 * n1) = (unsigned)v; *(LAS unsigned*)(lds + (2 * n2 + 1) * 288 + 4 * n1) = (unsigned)(v >> 32);
        }
        bf16x8_t af[4];
        { const int m = 16 * wave + lr, k1 = m >> 1, ri = m & 1;
#pragma unroll
          for (int ks = 0; ks < 4; ++ks)
#pragma unroll
              for (int jj = 0; jj < 4; ++jj) { const int n1 = 16 * ks + 4 * lq + jj; const float x = (float)((n1 * k1) & 63) * (1.0f / 64.0f);
                  const float c = __builtin_amdgcn_cosf(x), s = __builtin_amdgcn_sinf(x);
                  af[ks][2 * jj] = (short)f2bf(ri ? -s : c); af[ks][2 * jj + 1] = (short)f2bf(ri ? c : s); } }
        __syncthreads();
        pg8::f32x4 acc[16];
#pragma unroll
        for (int nt = 0; nt < 16; ++nt) { acc[nt] = (pg8::f32x4){0.f, 0.f, 0.f, 0.f};
#pragma unroll
            for (int ks = 0; ks < 4; ++ks) { const bf16x8_t bf = *(const LAS bf16x8_t*)(lds + (16 * nt + lr) * 288 + (32 * ks + 8 * lq) * 2);
                acc[nt] = __builtin_amdgcn_mfma_f32_16x16x32_bf16(af[ks], bf, acc[nt], 0, 0, 0); } }
        __syncthreads();
#pragma unroll
        for (int nt = 0; nt < 16; ++nt) { const int col = 16 * nt + lr, n2 = col >> 1, ch = col & 1;
#pragma unroll
            for (int h = 0; h < 2; ++h) { const int k1 = 8 * wave + 2 * lq + h; const float yr = acc[nt][2 * h], yi = acc[nt][2 * h + 1];
                const float x = (float)((n2 * k1) & 8191) * (1.0f / 8192.0f); const float c = __builtin_amdgcn_cosf(x), s = __builtin_amdgcn_sinf(x);
                *(LAS unsigned*)(lds + (2 * k1 + ch) * 544 + 4 * n2) = pk2(yr * c + yi * s, yi * c - yr * s); } }
        bf16x8_t a2[8];
        { const int k2 = 16 * wave + lr;
#pragma unroll
          for (int ks = 0; ks < 8; ++ks)
#pragma unroll
              for (int jj = 0; jj < 4; ++jj) { const int n2 = 16 * ks + 4 * lq + jj; const float x = (float)((n2 * k2) & 127) * (1.0f / 128.0f);
                  a2[ks][2 * jj] = (short)f2bf(__builtin_amdgcn_cosf(x)); a2[ks][2 * jj + 1] = (short)f2bf(__builtin_amdgcn_sinf(x)); } }
        __syncthreads();
        pg8::f32x4 o[8];
#pragma unroll
        for (int nt = 0; nt < 8; ++nt) { o[nt] = (pg8::f32x4){0.f, 0.f, 0.f, 0.f};
#pragma unroll
            for (int ks = 0; ks < 8; ++ks) { const bf16x8_t bf = *(const LAS bf16x8_t*)(lds + (16 * nt + lr) * 544 + (32 * ks + 8 * lq) * 2);
                o[nt] = __builtin_amdgcn_mfma_f32_16x16x32_bf16(a2[ks], bf, o[nt], 0, 0, 0); } }
#pragma unroll
        for (int nt = 0; nt < 8; ++nt) { const int col2 = 16 * nt + lr, k1 = col2 >> 1, ch = col2 & 1;
#pragma unroll
            for (int r = 0; r < 4; ++r) { const float v = o[nt][r]; const float w = __shfl_xor(v, 1); const int k2 = 16 * wave + 4 * lq + r;
                if (ch == 0) *(unsigned*)(MIX + ((size_t)b * SEQ + k1 + 64 * k2) * DM + 2 * cg) = pk2(v, w); } }
        __syncthreads();
    }
}


struct EpiIn {
    static constexpr bool PERM = true, AFTER_DRAIN = false;
    bf16* FZ; bf16* QKV; const float* bias; const float* rope;
    __device__ __forceinline__ void operator()(const pg8::f32x4 (&acc)[2][2][4][2], const pg8::Unit& u, int wr, int wc, int fr, int fq) const {
        const int row0 = u.pm * 256 + wr * 64 + fr;
#pragma unroll
        for (int bj = 0; bj < 2; ++bj) {
            const int c0 = u.pn * 256 + bj * 128 + wc * 32 + 8 * fq;
            const pg8::f32x4 b0 = *(const pg8::f32x4*)(bias + c0), b1 = *(const pg8::f32x4*)(bias + c0 + 4);
#pragma unroll
            for (int ai = 0; ai < 2; ++ai)
#pragma unroll
                for (int m = 0; m < 4; ++m) {
                    const int row = row0 + ai * 128 + m * 16;
                    pg8::f32x4 v0 = acc[ai][bj][m][0] + b0, v1 = acc[ai][bj][m][1] + b1;
                    if (u.pn < 2) {
                        const int b = row >> 13, s = row & 8191, cgp = c0 >> 2;
                        unsigned long long* d0 = (unsigned long long*)(FZ + (((size_t)(b * 128 + cgp) * 8192 + s) << 2));
                        d0[0] = (unsigned long long)pk2(v0.x, v0.y) | ((unsigned long long)pk2(v0.z, v0.w) << 32);
                        d0[8192] = (unsigned long long)pk2(v1.x, v1.y) | ((unsigned long long)pk2(v1.z, v1.w) << 32);
                    } else {
                        const int cq = c0 - 512, which = cq / 768, off = cq - which * 768;
                        if (which < 2) {
                            const float sc = which == 0 ? QSCALE : 1.0f;
                            const pg8::f32x4 r0 = *(const pg8::f32x4*)(rope + (size_t)row * 64 + (off & 63)), r1 = *(const pg8::f32x4*)(rope + (size_t)row * 64 + (off & 63) + 4);
                            pg8::f32x4 w0, w1;
                            w0.x = (v0.x * r0.x - v0.y * r0.y) * sc; w0.y = (v0.y * r0.x + v0.x * r0.y) * sc; w0.z = (v0.z * r0.z - v0.w * r0.w) * sc; w0.w = (v0.w * r0.z + v0.z * r0.w) * sc;
                            w1.x = (v1.x * r1.x - v1.y * r1.y) * sc; w1.y = (v1.y * r1.x + v1.x * r1.y) * sc; w1.z = (v1.z * r1.z - v1.w * r1.w) * sc; w1.w = (v1.w * r1.z + v1.z * r1.w) * sc;
                            v0 = w0; v1 = w1;
                        }
                        v4u o; o.x = pk2(v0.x, v0.y); o.y = pk2(v0.z, v0.w); o.z = pk2(v1.x, v1.y); o.w = pk2(v1.z, v1.w);
                        *(v4u*)(QKV + (size_t)which * ((WS_KB - WS_QB) / 2) + (size_t)row * 768 + off) = o;
                    }
                }
        }
    }
};

typedef float f32x16 __attribute__((ext_vector_type(16)));
typedef short s16x4 __attribute__((ext_vector_type(4)));
__device__ __forceinline__ int crow(int r, int hi) { return (r & 3) + 8 * (r >> 2) + 4 * hi; }
__device__ __forceinline__ s16x4 vtr(const LAS unsigned char* p) { return __builtin_bit_cast(s16x4, __builtin_amdgcn_ds_read_tr16_b64_v4i16((LAS s16x4*)p)); }
__device__ __forceinline__ unsigned cvtpk(float lo, float hi) { typedef float f2 __attribute__((ext_vector_type(2))); typedef __bf16 b2 __attribute__((ext_vector_type(2))); f2 v = {lo, hi}; b2 r = __builtin_convertvector(v, b2); return __builtin_bit_cast(unsigned, r); }
struct AttnDesc { int dil, ntile, res, cb, r; size_t rowb; int h; bool valid; };
__device__ __forceinline__ AttnDesc attn_desc(int bi) {
    AttnDesc d; d.valid = bi < 3 * 768; const int b2 = d.valid ? bi : 0;
    const int r = b2 / 768, rem = b2 - r * 768, bh = rem >> 5, q32 = rem & 31, b = bh / 12;
    d.r = r; d.h = bh - b * 12; d.rowb = (size_t)b * SEQ;
    const int ld = 2 * r;
    d.dil = 1 << ld; d.ntile = 256 >> ld; d.res = q32 >> (5 - ld); d.cb = q32 & ((32 >> ld) - 1);
    return d;
}
__device__ __forceinline__ void attn_dma(const AttnDesc& d, const bf16* T, bool swz, LAS unsigned char* img, int wave, int lane) {
#pragma unroll
    for (int i = 0; i < 6; ++i) {
        const int idx = wave * 6 + i, j = idx >> 2, it = idx & 3, kt = 8 * d.cb - 2 + j;
        if (kt >= 0 && kt < d.ntile) {
            const int row = it * 8 + (lane >> 3), ch = lane & 7; const int gch = swz ? (ch ^ ((row >> 1) & 7)) : ch;
            const bf16* src = T + (d.rowb + d.res + d.dil * (32 * kt + row)) * 768 + d.h * 64 + 8 * gch;
            __builtin_amdgcn_global_load_lds((const unsigned*)src, (LAS unsigned*)(img + j * 4096 + it * 1024), 16, 0, 0);
        }
    }
}
__device__ __forceinline__ void attn_qload(const AttnDesc& d, const bf16* QB, bf16x8_t (&qf)[4], int wave, int lane) {
    const bf16* qp = QB + (d.rowb + d.res + d.dil * (32 * (8 * d.cb + wave) + (lane & 31))) * 768 + d.h * 64 + 8 * (lane >> 5);
#pragma unroll
    for (int d0 = 0; d0 < 4; ++d0) qf[d0] = *(const bf16x8_t*)(qp + 16 * d0);
}
#define ATT_SYNC() do { asm volatile("s_waitcnt vmcnt(0) lgkmcnt(0)" ::: "memory"); __builtin_amdgcn_s_barrier(); asm volatile("" ::: "memory"); } while (0)
__device__ __forceinline__ void ph_attn_fast(const Params& p, LAS unsigned char* lds, int bid, int nblk) {
    const int lane = opaque_tid() & 63, wave = wave_id(), r32 = lane & 31, hi = lane >> 5;
    LAS unsigned char* imgK = lds; LAS unsigned char* imgV = lds + 49152; LAS unsigned char* stgb = lds + 98304 + wave * 4096;
    const bf16* QB = (const bf16*)(p.ws + WS_QB); const bf16* KB = (const bf16*)(p.ws + WS_KB); const bf16* VB = (const bf16*)(p.ws + WS_VB);
    const int vb = (nblk & 7) == 0 ? (bid & 7) * (nblk >> 3) + (bid >> 3) : bid;
    int bi = vb;
    AttnDesc d = attn_desc(bi);
    bf16x8_t qf[4];
    if (d.valid) { attn_dma(d, KB, true, imgK, wave, lane); attn_qload(d, QB, qf, wave, lane); }
    ATT_SYNC();
    const int g = lane >> 4, ii = lane & 15;
    const int vb0 = (4 * hi + (ii >> 2)) * 128 + (g & 1) * 32 + (ii & 3) * 8;
    while (d.valid) {
        asm volatile("" : "+v"(qf[0]), "+v"(qf[1]), "+v"(qf[2]), "+v"(qf[3]));
        attn_dma(d, VB, false, imgV, wave, lane);
        const int c = 8 * d.cb + wave;
        f32x16 S[5];
#pragma unroll
        for (int u = 0; u < 5; ++u) {
            const int kt = c - 2 + u;
#pragma unroll
            for (int r = 0; r < 16; ++r) S[u][r] = -1e30f;
            if (kt >= 0 && kt < d.ntile) {
                const LAS unsigned char* slot = imgK + (wave + u) * 4096;
                f32x16 a = {0.f, 0.f, 0.f, 0.f, 0.f, 0.f, 0.f, 0.f, 0.f, 0.f, 0.f, 0.f, 0.f, 0.f, 0.f, 0.f};
#pragma unroll
                for (int d0 = 0; d0 < 4; ++d0) { const bf16x8_t kf = *(const LAS bf16x8_t*)(slot + r32 * 128 + (((2 * d0 + hi) ^ ((r32 >> 1) & 7)) << 4));
                    a = __builtin_amdgcn_mfma_f32_32x32x16_bf16(kf, qf[d0], a, 0, 0, 0); }
                S[u] = a;
            }
        }
#pragma unroll
        for (int r = 0; r < 16; ++r) { const int kk = crow(r, hi); if (kk < r32) S[0][r] = -1e30f; if (kk > r32) S[4][r] = -1e30f; }
        float m = -1e30f;
#pragma unroll
        for (int u = 0; u < 5; ++u)
#pragma unroll
            for (int r = 0; r < 16; ++r) m = fmaxf(m, S[u][r]);
        m = fmaxf(m, __shfl_xor(m, 32));
        float l = 0.f;
        unsigned Pk[5][8];
#pragma unroll
        for (int u = 0; u < 5; ++u)
#pragma unroll
            for (int r = 0; r < 16; r += 2) { const float e0 = __builtin_amdgcn_exp2f(S[u][r] - m), e1 = __builtin_amdgcn_exp2f(S[u][r + 1] - m); l += e0 + e1; Pk[u][r >> 1] = cvtpk(e0, e1); }
        l += __shfl_xor(l, 32);
        ATT_SYNC();
        const AttnDesc dn = attn_desc(bi + nblk);
        if (dn.valid) { attn_dma(dn, KB, true, imgK, wave, lane); attn_qload(dn, QB, qf, wave, lane); }
        f32x16 o[2];
#pragma unroll
        for (int db = 0; db < 2; ++db)
#pragma unroll
            for (int r = 0; r < 16; ++r) o[db][r] = 0.f;
#pragma unroll
        for (int u = 0; u < 5; ++u) {
            const int kt = c - 2 + u;
            if (kt >= 0 && kt < d.ntile) {
                const LAS unsigned char* slot = imgV + (wave + u) * 4096;
#pragma unroll
                for (int s = 0; s < 2; ++s) {
                    bf16x8_t pa;
                    { v4u w; w.x = Pk[u][4 * s + 0]; w.y = Pk[u][4 * s + 1]; w.z = Pk[u][4 * s + 2]; w.w = Pk[u][4 * s + 3]; pa = __builtin_bit_cast(bf16x8_t, w); }
#pragma unroll
                    for (int db = 0; db < 2; ++db) {
                        const s16x4 lo = vtr(slot + vb0 + s * 2048 + db * 64), hh = vtr(slot + vb0 + s * 2048 + 1024 + db * 64);
                        const bf16x8_t vf = {lo[0], lo[1], lo[2], lo[3], hh[0], hh[1], hh[2], hh[3]};
                        o[db] = __builtin_amdgcn_mfma_f32_32x32x16_bf16(pa, vf, o[db], 0, 0, 0);
                    }
                }
            }
        }
        bf16* OB = d.r == 2 ? (bf16*)(p.ws + WS_O3) : (bf16*)p.out + (size_t)d.r * NT * 768;
        float* LSE = (float*)(p.ws + WS_LSE) + (size_t)d.r * NT * 12;
        const float linv = 1.0f / l;
        LAS unsigned short* stg = (LAS unsigned short*)stgb;
#pragma unroll
        for (int r = 0; r < 16; ++r) { const int q = crow(r, hi); const float li = __shfl(linv, q);
#pragma unroll
            for (int db = 0; db < 2; ++db) stg[q * 64 + db * 32 + r32] = (unsigned short)f2bf(o[db][r] * li); }
        int ln2 = lane; asm volatile("" : "+v"(ln2));
#pragma unroll
        for (int i4 = 0; i4 < 4; ++i4) { const int row = i4 * 8 + (ln2 >> 3), ch = ln2 & 7;
            const v4u val = *(const LAS v4u*)((LAS unsigned char*)stg + row * 128 + ch * 16);
            *(v4u*)(OB + (d.rowb + d.res + d.dil * (32 * c + row)) * 768 + d.h * 64 + 8 * ch) = val; }
        if (ln2 < 32) LSE[(d.rowb + d.res + d.dil * (32 * c + ln2)) * 12 + d.h] = m + __builtin_amdgcn_logf(l);
        ATT_SYNC();
        d = dn; bi += nblk;
    }
}
__device__ __forceinline__ void ph_merge(const Params& p, int bid, int nblk) {
    const bf16* O1 = (const bf16*)p.out; const bf16* O2 = O1 + (size_t)NT * 768; const bf16* O3 = (const bf16*)(p.ws + WS_O3);
    const float* L1 = (const float*)(p.ws + WS_LSE); const float* L2 = L1 + (size_t)NT * 12; const float* L3 = L2 + (size_t)NT * 12; bf16* MIX = (bf16*)(p.ws + WS_XN);
    for (int idx = bid * NTHREADS + opaque_tid(); idx < NT * 96; idx += nblk * NTHREADS) {
        const int t = idx / 96, rem = idx - t * 96, h = rem >> 3, ch = rem & 7;
        const float l1 = L1[t * 12 + h], l2 = L2[t * 12 + h], l3 = L3[t * 12 + h]; const float mx = fmaxf(fmaxf(l1, l2), l3);
        float w1 = __builtin_amdgcn_exp2f(l1 - mx), w2 = __builtin_amdgcn_exp2f(l2 - mx), w3 = __builtin_amdgcn_exp2f(l3 - mx); const float inv = 1.0f / (w1 + w2 + w3); w1 *= inv; w2 *= inv; w3 *= inv;
        const size_t off = (size_t)t * 768 + h * 64 + 8 * ch;
        const v4u a = *(const v4u*)(O1 + off), bq = *(const v4u*)(O2 + off), cq = *(const v4u*)(O3 + off);
        v4u o;
        o.x = pk2(w1 * bflo(a.x) + w2 * bflo(bq.x) + w3 * bflo(cq.x), w1 * bfhi(a.x) + w2 * bfhi(bq.x) + w3 * bfhi(cq.x));
        o.y = pk2(w1 * bflo(a.y) + w2 * bflo(bq.y) + w3 * bflo(cq.y), w1 * bfhi(a.y) + w2 * bfhi(bq.y) + w3 * bfhi(cq.y));
        o.z = pk2(w1 * bflo(a.z) + w2 * bflo(bq.z) + w3 * bflo(cq.z), w1 * bfhi(a.z) + w2 * bfhi(bq.z) + w3 * bfhi(cq.z));
        o.w = pk2(w1 * bflo(a.w) + w2 * bflo(bq.w) + w3 * bflo(cq.w), w1 * bfhi(a.w) + w2 * bfhi(bq.w) + w3 * bfhi(cq.w));
        *(v4u*)(MIX + (size_t)t * DM + 256 + h * 64 + 8 * ch) = o;
    }
}


__device__ __forceinline__ unsigned fkey(float s, unsigned low, unsigned mask) { unsigned u = __builtin_bit_cast(unsigned, s); u = (u & 0x80000000u) ? ~u : (u | 0x80000000u); return (u & ~mask) | low; }
__device__ __forceinline__ float fdec(unsigned k, unsigned mask) { unsigned u = (k & ~mask) | (mask >> 1); u = (u & 0x80000000u) ? (u ^ 0x80000000u) : ~u; return __builtin_bit_cast(float, u); }
#define CE_DESC(a, b) do { const unsigned _mx = (a) > (b) ? (a) : (b), _mn = (a) > (b) ? (b) : (a); (a) = _mx; (b) = _mn; } while (0)
__device__ __forceinline__ void sort16_desc(unsigned (&a)[16]) {
#pragma unroll
    for (int k = 2; k <= 16; k <<= 1)
#pragma unroll
        for (int j = k >> 1; j > 0; j >>= 1)
#pragma unroll
            for (int i = 0; i < 16; ++i) { const int l = i ^ j; if (l > i) { if ((i & k) == 0) CE_DESC(a[i], a[l]); else CE_DESC(a[l], a[i]); } }
}
__device__ __forceinline__ void merge16_desc(unsigned (&c)[16]) {
#pragma unroll
    for (int j = 8; j > 0; j >>= 1)
#pragma unroll
        for (int i = 0; i < 16; ++i) { const int l = i ^ j; if (l > i) CE_DESC(c[i], c[l]); }
}
__device__ __forceinline__ void top16_merge(unsigned (&a)[16], const unsigned (&b)[16]) {
#pragma unroll
    for (int i = 0; i < 16; ++i) a[i] = a[i] > b[15 - i] ? a[i] : b[15 - i];
    merge16_desc(a);
}
__device__ __forceinline__ void top16_of_64(unsigned (&g0)[16], unsigned (&g1)[16], unsigned (&g2)[16], unsigned (&g3)[16]) {
    sort16_desc(g0); sort16_desc(g1); sort16_desc(g2); sort16_desc(g3);
    top16_merge(g0, g1); top16_merge(g2, g3); top16_merge(g0, g2);
}
__host__ __device__ constexpr int stair_slot(int i, int j) { int n = 0; for (int a = 0; a < 16; ++a) for (int b = 0; b < 16; ++b) if ((a + 1) * (b + 1) <= 16) { if (a == i && b == j) return n; ++n; } return n; }
__device__ __forceinline__ void ph_topk_fast(const Params& p, LAS unsigned char* lds, int bid, int nblk) {
    const int lane = opaque_tid() & 63, wave = wave_id(), r32 = lane & 31, hi = lane >> 5;
    const bf16* PQ = (const bf16*)(p.ws + WS_PQ); const bf16* SK = (const bf16*)(p.ws + WS_SUBK);
    unsigned short* ids = (unsigned short*)(p.ws + WS_IDS); float* gates = (float*)(p.ws + WS_GATES); float* sua = (float*)(p.ws + WS_SUA);
    const float* SUt = (const float*)(p.ws + WS_SU); const float* SVt = (const float*)(p.ws + WS_SV);
    LAS unsigned* myl = (LAS unsigned*)(lds + wave * 16384 + lane * 128);
    for (int it = bid * NWAVES + wave; it < (NT / 32) * 8; it += nblk * NWAVES) {
        const int tt = it >> 3, h = it & 7, t = tt * 32 + r32;
        unsigned K[2][16];
#pragma unroll
        for (int pp = 0; pp < 2; ++pp) {
            bf16x8_t qf[4];
            { const bf16* qp = PQ + (size_t)t * DM + h * 128 + pp * 64 + 8 * hi;
#pragma unroll
              for (int d0 = 0; d0 < 4; ++d0) qf[d0] = *(const bf16x8_t*)(qp + 16 * d0); }
            unsigned g[4][16];
#pragma unroll
            for (int mt = 0; mt < 4; ++mt) {
                const bf16* kp = SK + ((size_t)((h * 2 + pp) * 4 + mt) * 4 * 64 + lane) * 8;
                f32x16 a = {0.f, 0.f, 0.f, 0.f, 0.f, 0.f, 0.f, 0.f, 0.f, 0.f, 0.f, 0.f, 0.f, 0.f, 0.f, 0.f};
#pragma unroll
                for (int d0 = 0; d0 < 4; ++d0) a = __builtin_amdgcn_mfma_f32_32x32x16_bf16(*(const bf16x8_t*)(kp + d0 * 512), qf[d0], a, 0, 0, 0);
#pragma unroll
                for (int r = 0; r < 16; ++r) g[mt][r] = fkey(a[r], 127u - (unsigned)(32 * mt + crow(r, hi)), 127u);
            }
            top16_of_64(g[0], g[1], g[2], g[3]);
            unsigned o[16];
#pragma unroll
            for (int i = 0; i < 16; ++i) o[i] = (unsigned)__shfl_xor((int)g[0][i], 32);
            top16_merge(g[0], o);
#pragma unroll
            for (int i = 0; i < 16; ++i) K[pp][i] = g[0][i];
        }
#pragma unroll
        for (int i = 0; i < 16; ++i) { myl[i] = K[0][i]; myl[16 + i] = K[1][i]; }
        float v0[16], v1[16];
#pragma unroll
        for (int i = 0; i < 16; ++i) { v0[i] = fdec(K[0][i], 127u); v1[i] = fdec(K[1][i], 127u); }
        unsigned c[4][16];
#pragma unroll
        for (int gi = 0; gi < 4; ++gi)
#pragma unroll
            for (int q = 0; q < 16; ++q) c[gi][q] = 0u;
#pragma unroll
        for (int i = 0; i < 16; ++i)
#pragma unroll
            for (int j = 0; j < 16; ++j) if ((i + 1) * (j + 1) <= 16) { const int n = stair_slot(i, j); c[n >> 4][n & 15] = fkey(v0[i] + v1[j], 255u - (unsigned)(16 * i + j), 255u); }
        top16_of_64(c[0], c[1], c[2], c[3]);
        float e[16]; float sum = 0.f; const float mx = fdec(c[0][0], 255u);
#pragma unroll
        for (int r = 0; r < 16; ++r) { e[r] = __builtin_amdgcn_exp2f((fdec(c[0][r], 255u) - mx) * 1.4426950408889634f); sum += e[r]; }
        const float inv = 1.0f / sum;
        int eid[16];
#pragma unroll
        for (int r = 0; r < 16; ++r) { const unsigned id8 = 255u - (c[0][r] & 255u); const unsigned k0 = myl[id8 >> 4], k1 = myl[16 + (id8 & 15)];
            eid[r] = (int)((127u - (k0 & 127u)) * 128u + (127u - (k1 & 127u))); }
        if (hi == 0) {
#pragma unroll
            for (int q = 0; q < 2; ++q) *(v4u*)(ids + (size_t)t * 128 + h * 16 + 8 * q) = (v4u){(unsigned)eid[8 * q] | ((unsigned)eid[8 * q + 1] << 16), (unsigned)eid[8 * q + 2] | ((unsigned)eid[8 * q + 3] << 16),
                                                                                      (unsigned)eid[8 * q + 4] | ((unsigned)eid[8 * q + 5] << 16), (unsigned)eid[8 * q + 6] | ((unsigned)eid[8 * q + 7] << 16)};
#pragma unroll
            for (int q = 0; q < 4; ++q) *(f32x4*)(sua + (size_t)t * 128 + h * 16 + 4 * q) = (f32x4){SUt[eid[4 * q]], SUt[eid[4 * q + 1]], SUt[eid[4 * q + 2]], SUt[eid[4 * q + 3]]};
        } else {
#pragma unroll
            for (int q = 0; q < 4; ++q) *(f32x4*)(gates + (size_t)t * 128 + h * 16 + 4 * q) = (f32x4){e[4 * q] * inv * SVt[eid[4 * q]], e[4 * q + 1] * inv * SVt[eid[4 * q + 1]], e[4 * q + 2] * inv * SVt[eid[4 * q + 2]], e[4 * q + 3] * inv * SVt[eid[4 * q + 3]]};
        }
    }
}

__device__ __forceinline__ void ph_ln1_fast(const Params& p, int bid, int nblk) {
    const bf16* y1 = (const bf16*)(p.ws + WS_Y1); bf16* x1 = (bf16*)(p.ws + WS_X1); bf16* h2b = (bf16*)(p.ws + WS_XN); const float* mod = (const float*)(p.ws + WS_MOD);
    const int lane = opaque_tid() & 63, wave = wave_id(), stride = nblk * NWAVES;
    for (int row0 = bid * NWAVES + wave; row0 < NT; row0 += 2 * stride) {
        v2u yw[2][4]; f32x4 xw[2][4];
#pragma unroll
        for (int rr = 0; rr < 2; ++rr) { const int row = row0 + rr * stride < NT ? row0 + rr * stride : row0;
#pragma unroll
            for (int j = 0; j < 4; ++j) { yw[rr][j] = *((const v2u*)(y1 + (size_t)row * DM) + lane + 64 * j); xw[rr][j] = *((const f32x4*)(p.x + (size_t)row * DM) + lane + 64 * j); } }
#pragma unroll
        for (int rr = 0; rr < 2; ++rr) {
            const int row = row0 + rr * stride; if (row >= NT) break;
            const int b = row / SEQ;
            f32x4 v[4]; float s = 0.f;
#pragma unroll
            for (int j = 0; j < 4; ++j) { const v2u w = yw[rr][j];
                v[j] = xw[rr][j] * ALPHA + (f32x4){bflo(w.x), bfhi(w.x), bflo(w.y), bfhi(w.y)}; s += (v[j].x + v[j].y) + (v[j].z + v[j].w); }
            float mean = wave_sum(s) * (1.f / DM); float s2 = 0.f;
#pragma unroll
            for (int j = 0; j < 4; ++j) { v[j] = v[j] - mean; s2 += (v[j].x * v[j].x + v[j].y * v[j].y) + (v[j].z * v[j].z + v[j].w * v[j].w); }
            float rstd = rsqrtf(wave_sum(s2) * (1.f / DM) + LN_EPS);
            s = 0.f;
#pragma unroll
            for (int j = 0; j < 4; ++j) { const f32x4 g = *((const f32x4*)p.g1 + lane + 64 * j), be = *((const f32x4*)p.be1 + lane + 64 * j);
                v[j] = v[j] * rstd * g + be; *((v2u*)(x1 + (size_t)row * DM) + lane + 64 * j) = (v2u){pk2(v[j].x, v[j].y), pk2(v[j].z, v[j].w)}; s += (v[j].x + v[j].y) + (v[j].z + v[j].w); }
            mean = wave_sum(s) * (1.f / DM); s2 = 0.f;
#pragma unroll
            for (int j = 0; j < 4; ++j) { v[j] = v[j] - mean; s2 += (v[j].x * v[j].x + v[j].y * v[j].y) + (v[j].z * v[j].z + v[j].w * v[j].w); }
            rstd = rsqrtf(wave_sum(s2) * (1.f / DM) + LN_EPS);
            float amax = 0.f;
#pragma unroll
            for (int j = 0; j < 4; ++j) {
                const f32x4 sh = *((const f32x4*)(mod + b * 6144 + 3072) + lane + 64 * j), sc = *((const f32x4*)(mod + b * 6144 + 4096) + lane + 64 * j);
                const f32x4 o = v[j] * rstd * (1.0f + sc) + sh; v[j] = o;
                amax = fmaxf(amax, fmaxf(fmaxf(fabsf(o.x), fabsf(o.y)), fmaxf(fabsf(o.z), fabsf(o.w))));
                *((v2u*)(h2b + (size_t)row * DM) + lane + 64 * j) = (v2u){pk2(o.x, o.y), pk2(o.z, o.w)};
            }
            amax = wave_max(amax); const float hinv = amax > 0.f ? 127.0f / amax : 0.f;
            unsigned* q4 = (unsigned*)(p.ws + WS_H2Q + (size_t)row * DM) + lane;
#pragma unroll
            for (int j = 0; j < 4; ++j) { unsigned q = 0u;
                q = __builtin_amdgcn_cvt_pk_u8_f32(v[j].x * hinv + 128.0f, 0, q); q = __builtin_amdgcn_cvt_pk_u8_f32(v[j].y * hinv + 128.0f, 1, q);
                q = __builtin_amdgcn_cvt_pk_u8_f32(v[j].z * hinv + 128.0f, 2, q); q = __builtin_amdgcn_cvt_pk_u8_f32(v[j].w * hinv + 128.0f, 3, q);
                q4[64 * j] = q ^ 0x80808080u; }
            if (lane == 0) ((float*)(p.ws + WS_HS))[row] = amax * (1.0f / 127.0f);
        }
    }
}
__device__ __forceinline__ void ph_tables8(const Params& p, int bid, int nblk) {
    const int lane = opaque_tid() & 63, wave = wave_id();
    for (int r = bid * NWAVES + wave; r < 2 * 16384; r += nblk * NWAVES) {
        const bool isv = r >= 16384; const int row = isv ? r - 16384 : r;
        const f32x4* src = (const f32x4*)((isv ? p.pv : p.pu) + (size_t)row * DM + 16 * lane);
        f32x4 a[4]; float amax = 0.f;
#pragma unroll
        for (int j = 0; j < 4; ++j) { a[j] = src[j]; amax = fmaxf(amax, fmaxf(fmaxf(fabsf(a[j].x), fabsf(a[j].y)), fmaxf(fabsf(a[j].z), fabsf(a[j].w)))); }
        amax = wave_max(amax);
        const float inv = amax > 0.f ? 127.0f / amax : 0.f;
        v4u o;
#pragma unroll
        for (int j = 0; j < 4; ++j) { unsigned q = 0u;
            q = __builtin_amdgcn_cvt_pk_u8_f32(a[j].x * inv + 128.0f, 0, q); q = __builtin_amdgcn_cvt_pk_u8_f32(a[j].y * inv + 128.0f, 1, q);
            q = __builtin_amdgcn_cvt_pk_u8_f32(a[j].z * inv + 128.0f, 2, q); q = __builtin_amdgcn_cvt_pk_u8_f32(a[j].w * inv + 128.0f, 3, q);
            o[j] = q ^ 0x80808080u; }
        *(v4u*)(p.ws + (isv ? WS_TV8 : WS_TU8) + (size_t)(lane >> 3) * (2 * MiB) + (size_t)row * 128 + 16 * (lane & 7)) = o;
        if (lane == 0) ((float*)(p.ws + (isv ? WS_SV : WS_SU)))[row] = amax * (1.0f / 127.0f);
    }
}
__device__ __forceinline__ float readlane_f(float v, int l) { return __builtin_bit_cast(float, __builtin_amdgcn_readlane(__builtin_bit_cast(int, v), l)); }
__device__ __forceinline__ float ub0(unsigned u) { return (float)(u & 255u); }
__device__ __forceinline__ float ub1(unsigned u) { return (float)((u >> 8) & 255u); }
__device__ __forceinline__ float ub2(unsigned u) { return (float)((u >> 16) & 255u); }
__device__ __forceinline__ float ub3(unsigned u) { return (float)(u >> 24); }
__device__ __forceinline__ v4u ust_meta(const Params& p, int step, int t0, int stride8, int lane) {
    const int g = step >> 4, k = step & 15; int t = t0 + g * stride8 + (lane >> 3); t = t < NT ? t : NT - 1;
    return *(const v4u*)(p.ws + WS_IDS + (size_t)t * 256 + 16 * k);
}
__device__ __forceinline__ void ust_issue(v4u (&ub)[8], const v4u& idq, const unsigned char* TUs) {
#pragma unroll
    for (int e = 0; e < 8; ++e) { const unsigned w = idq[e >> 1]; const unsigned id = (e & 1) ? (w >> 16) : (w & 0xffffu); ub[e] = *(const v4u*)(TUs + (size_t)id * 128); }
}
__device__ __forceinline__ int ust_compute(const v4u (&ub)[8], const v4u& hq, int lane) {
    int a[8];
#pragma unroll
    for (int e = 0; e < 8; ++e) { int v = __builtin_amdgcn_sdot4((int)ub[e].x, (int)hq.x, 0, false); v = __builtin_amdgcn_sdot4((int)ub[e].y, (int)hq.y, v, false);
        v = __builtin_amdgcn_sdot4((int)ub[e].z, (int)hq.z, v, false); a[e] = __builtin_amdgcn_sdot4((int)ub[e].w, (int)hq.w, v, false); }
    int a4[4];
#pragma unroll
    for (int k = 0; k < 4; ++k) { const bool up = (lane & 4) != 0; const int keep = up ? a[k + 4] : a[k], send = up ? a[k] : a[k + 4]; a4[k] = keep + __shfl_xor(send, 4); }
    int a2[2];
#pragma unroll
    for (int k = 0; k < 2; ++k) { const bool up = (lane & 2) != 0; const int keep = up ? a4[k + 2] : a4[k], send = up ? a4[k] : a4[k + 2]; a2[k] = keep + __shfl_xor(send, 2); }
    const bool up = (lane & 1) != 0; const int keep = up ? a2[1] : a2[0], send = up ? a2[0] : a2[1];
    return keep + __shfl_xor(send, 1);
}
__device__ __forceinline__ void ph_udot(const Params& p, int bid, int nblk) {
    short* P = (short*)(p.ws + WS_PART);
    const int lane = opaque_tid() & 63, wave = wave_id(), c = lane & 7;
    const int s = bid & 7, nper = (nblk - s + 7) >> 3,     stride8 = nper * NWAVES * 8;
    const unsigned char* TUs = p.ws + WS_TU8 + (size_t)s * (2 * MiB) + 16 * c;
    const int t0 = ((bid >> 3) * NWAVES + wave) * 8;
    const int ngroups = t0 < NT ? (NT - t0 + stride8 - 1) / stride8 : 0, nsteps = ngroups * 16;
    if (nsteps == 0) return;
    v4u uA[8], uB[8];
    v4u qa = ust_meta(p, 0, t0, stride8, lane);
    ust_issue(uA, qa, TUs);
    v4u qb = ust_meta(p, 1, t0, stride8, lane);
    v4u hq = {0u, 0u, 0u, 0u};
    for (int st = 0; st < nsteps; st += 2) {
        const int tg = t0 + (st >> 4) * stride8 + (lane >> 3); const int t = tg < NT ? tg : NT - 1;
        if ((st & 15) == 0) hq = *(const v4u*)(p.ws + WS_H2Q + (size_t)t * DM + 128 * s + 16 * c);
        ust_issue(uB, qb, TUs);
        qa = ust_meta(p, st + 2 < nsteps ? st + 2 : st, t0, stride8, lane);
        const int ra = ust_compute(uA, hq, lane);
        if (st + 2 < nsteps) ust_issue(uA, qa, TUs);
        qb = ust_meta(p, st + 3 < nsteps ? st + 3 : st + 1, t0, stride8, lane);
        const int rb = ust_compute(uB, hq, lane);
        if (tg < NT) { short* dst = P + ((size_t)t * 8 + s) * 128 + 8 * (st & 15) + c; dst[0] = (short)((ra + 32) >> 6); dst[8] = (short)((rb + 32) >> 6); }
    }
}
__device__ __forceinline__ void ph_act(const Params& p, int bid, int nblk) {
    const short* P = (const short*)(p.ws + WS_PART); const float* SUA = (const float*)(p.ws + WS_SUA); const float* GS = (const float*)(p.ws + WS_GATES); const float* HS = (const float*)(p.ws + WS_HS);
    unsigned char* WQ = p.ws + WS_WQ; float* WSC = (float*)(p.ws + WS_WSC);
    const int lane = opaque_tid() & 63, wave = wave_id();
    for (int t = bid * NWAVES + wave; t < NT; t += nblk * NWAVES) {
        int a0 = 0, a1 = 0;
#pragma unroll
        for (int s = 0; s < 8; ++s) { a0 += P[((size_t)t * 8 + s) * 128 + lane]; a1 += P[((size_t)t * 8 + s) * 128 + 64 + lane]; }
        const float hs = HS[t] * 64.0f;
        const float d0 = (float)a0 * SUA[(size_t)t * 128 + lane] * hs, d1 = (float)a1 * SUA[(size_t)t * 128 + 64 + lane] * hs;
        const float w0 = GS[(size_t)t * 128 + lane] * 0.5f * d0 * (1.0f + erff(d0 * 0.70710678118654752f));
        const float w1 = GS[(size_t)t * 128 + 64 + lane] * 0.5f * d1 * (1.0f + erff(d1 * 0.70710678118654752f));
        const float wmax = wave_max(fmaxf(fabsf(w0), fabsf(w1))); const float winv = wmax > 0.f ? 127.0f / wmax : 0.f;
        unsigned b2 = __builtin_amdgcn_cvt_pk_u8_f32(w0 * winv + 128.0f, 0, 0u); b2 = __builtin_amdgcn_cvt_pk_u8_f32(w1 * winv + 128.0f, 1, b2); b2 ^= 0x8080u;
        WQ[(size_t)t * 128 + lane] = (unsigned char)(b2 & 255u); WQ[(size_t)t * 128 + 64 + lane] = (unsigned char)((b2 >> 8) & 255u);
        if (lane == 0) WSC[t] = wmax * (1.0f / 127.0f);
    }
}
struct VstepMeta { v4u idq; v2u wq; };
__device__ __forceinline__ VstepMeta vst_meta(const Params& p, int step, int t0, int stride8, int lane) {
    const int g = step >> 4, k = step & 15; int t = t0 + g * stride8 + (lane >> 3); t = t < NT ? t : NT - 1;
    VstepMeta r; r.idq = *(const v4u*)(p.ws + WS_IDS + (size_t)t * 256 + 16 * k); r.wq = *(const v2u*)(p.ws + WS_WQ + (size_t)t * 128 + 8 * k); return r;
}
__device__ __forceinline__ void vst_issue(v4u (&vb)[8], const VstepMeta& q, const unsigned char* TVs) {
#pragma unroll
    for (int e = 0; e < 8; ++e) { const unsigned w = q.idq[e >> 1]; const unsigned id = (e & 1) ? (w >> 16) : (w & 0xffffu); vb[e] = *(const v4u*)(TVs + (size_t)id * 128); }
}
__device__ __forceinline__ void vst_compute(int (&y)[16], const v4u (&vb)[8], const v2u& wq) {
#pragma unroll
    for (int qd = 0; qd < 2; ++qd)
#pragma unroll
        for (int cm = 0; cm < 4; ++cm) {
            const unsigned A = vb[4 * qd][cm], B = vb[4 * qd + 1][cm], C = vb[4 * qd + 2][cm], D = vb[4 * qd + 3][cm];
            const unsigned ab01 = __builtin_amdgcn_perm(B, A, 0x05010400u), ab23 = __builtin_amdgcn_perm(B, A, 0x07030602u);
            const unsigned cd01 = __builtin_amdgcn_perm(D, C, 0x05010400u), cd23 = __builtin_amdgcn_perm(D, C, 0x07030602u);
            const unsigned t0 = __builtin_amdgcn_perm(cd01, ab01, 0x05040100u), t1 = __builtin_amdgcn_perm(cd01, ab01, 0x07060302u);
            const unsigned t2 = __builtin_amdgcn_perm(cd23, ab23, 0x05040100u), t3 = __builtin_amdgcn_perm(cd23, ab23, 0x07060302u);
            y[4 * cm + 0] = __builtin_amdgcn_sdot4((int)t0, (int)wq[qd], y[4 * cm + 0], false); y[4 * cm + 1] = __builtin_amdgcn_sdot4((int)t1, (int)wq[qd], y[4 * cm + 1], false);
            y[4 * cm + 2] = __builtin_amdgcn_sdot4((int)t2, (int)wq[qd], y[4 * cm + 2], false); y[4 * cm + 3] = __builtin_amdgcn_sdot4((int)t3, (int)wq[qd], y[4 * cm + 3], false);
        }
}
__device__ __forceinline__ void ph_vacc(const Params& p, int bid, int nblk) {
    bf16* Y = (bf16*)(p.ws + WS_Y); const float* WSC = (const float*)(p.ws + WS_WSC);
    const int lane = opaque_tid() & 63, wave = wave_id(), c = lane & 7;
    const int s = bid & 7, nper = (nblk - s + 7) >> 3,     stride8 = nper * NWAVES * 8;
    const unsigned char* TVs = p.ws + WS_TV8 + (size_t)s * (2 * MiB) + 16 * c;
    const int t0 = ((bid >> 3) * NWAVES + wave) * 8;
    const int ngroups = t0 < NT ? (NT - t0 + stride8 - 1) / stride8 : 0, nsteps = ngroups * 16;
    if (nsteps == 0) return;
    int y[16];
#pragma unroll
    for (int k = 0; k < 16; ++k) y[k] = 0;
    v4u vA[8], vB[8];
    VstepMeta qa = vst_meta(p, 0, t0, stride8, lane);
    vst_issue(vA, qa, TVs);
    VstepMeta qb = vst_meta(p, 1, t0, stride8, lane);
    for (int st = 0; st < nsteps; st += 2) {
        vst_issue(vB, qb, TVs);
        const v2u wa = qa.wq; qa = vst_meta(p, st + 2 < nsteps ? st + 2 : st, t0, stride8, lane);
        vst_compute(y, vA, wa);
        if (st + 2 < nsteps) vst_issue(vA, qa, TVs);
        const v2u wb = qb.wq; qb = vst_meta(p, st + 3 < nsteps ? st + 3 : st + 1, t0, stride8, lane);
        vst_compute(y, vB, wb);
        if (((st + 1) & 15) == 15) {
            const int t = t0 + (st >> 4) * stride8 + (lane >> 3);
            if (t < NT) { const float sc = WSC[t];
                v4u o0, o1; o0.x = pk2((float)y[0] * sc, (float)y[1] * sc); o0.y = pk2((float)y[2] * sc, (float)y[3] * sc); o0.z = pk2((float)y[4] * sc, (float)y[5] * sc); o0.w = pk2((float)y[6] * sc, (float)y[7] * sc);
                o1.x = pk2((float)y[8] * sc, (float)y[9] * sc); o1.y = pk2((float)y[10] * sc, (float)y[11] * sc); o1.z = pk2((float)y[12] * sc, (float)y[13] * sc); o1.w = pk2((float)y[14] * sc, (float)y[15] * sc);
                v4u* dst = (v4u*)(Y + (size_t)t * DM + 128 * s + 16 * c); dst[0] = o0; dst[1] = o1; }
#pragma unroll
            for (int k = 0; k < 16; ++k) y[k] = 0;
        }
    }
}
__device__ __forceinline__ void ph_final(const Params& p, int bid, int nblk) {
    const bf16* x1 = (const bf16*)(p.ws + WS_X1); const bf16* Y = (const bf16*)(p.ws + WS_Y); const float* mod = (const float*)(p.ws + WS_MOD);
    const int lane = opaque_tid() & 63, wave = wave_id(), stride = nblk * NWAVES;
    for (int t0 = bid * NWAVES + wave; t0 < NT; t0 += 2 * stride) {
        v2u xw[2][4], yw[2][4];
#pragma unroll
        for (int rr = 0; rr < 2; ++rr) { const int t = t0 + rr * stride < NT ? t0 + rr * stride : t0;
#pragma unroll
            for (int j = 0; j < 4; ++j) { xw[rr][j] = *((const v2u*)(x1 + (size_t)t * DM) + lane + 64 * j); yw[rr][j] = *((const v2u*)(Y + (size_t)t * DM) + lane + 64 * j); } }
#pragma unroll
        for (int rr = 0; rr < 2; ++rr) {
            const int t = t0 + rr * stride; if (t >= NT) break;
            const int b = t / SEQ;
            f32x4 v[4]; float s = 0.f;
#pragma unroll
            for (int j = 0; j < 4; ++j) { const v2u a = xw[rr][j], y = yw[rr][j];
                const f32x4 g2 = *((const f32x4*)(mod + b * 6144 + 5120) + lane + 64 * j);
                const f32x4 xv = {bflo(a.x), bfhi(a.x), bflo(a.y), bfhi(a.y)}, yv = {bflo(y.x), bfhi(y.x), bflo(y.y), bfhi(y.y)};
                v[j] = xv * ALPHA + (g2 + 1.0f) * yv; s += (v[j].x + v[j].y) + (v[j].z + v[j].w); }
            const float mean = wave_sum(s) * (1.f / DM); float s2 = 0.f;
#pragma unroll
            for (int j = 0; j < 4; ++j) { v[j] = v[j] - mean; s2 += (v[j].x * v[j].x + v[j].y * v[j].y) + (v[j].z * v[j].z + v[j].w * v[j].w); }
            const float rstd = rsqrtf(wave_sum(s2) * (1.f / DM) + LN_EPS);
#pragma unroll
            for (int j = 0; j < 4; ++j) { const f32x4 g = *((const f32x4*)p.g2 + lane + 64 * j), be = *((const f32x4*)p.be2 + lane + 64 * j);
                *((f32x4*)(p.out + (size_t)t * DM) + lane + 64 * j) = v[j] * rstd * g + be; }
        }
    }
}

#ifndef PROBE_ID
#define PROBE_ID 0
#endif
#define RUN2(id, ...) do { __VA_ARGS__; if (PROBE_ID == (id)) { xcd_barrier(bar); __VA_ARGS__; } } while (0)
__global__ void __launch_bounds__(NTHREADS, 2) mega(Params p) {
    extern __shared__ __attribute__((aligned(16))) unsigned char lds_raw[];

    LAS unsigned char* lds = (LAS unsigned char*)lds_raw;
    const int bid = blockIdx.x, nblk = gridDim.x, tid = opaque_tid();
    for (int u = tid; u < (LDS_BYTES - LDSCTL_OFF) / 4; u += NTHREADS) ((LAS unsigned*)(lds + LDSCTL_OFF))[u] = 0u;
    __syncthreads();
    unsigned* ctl = (unsigned*)(p.ws + WS_CTL);
    XcdBarrier bar = xcd_barrier_post(ctl + CW_BAR, (volatile LAS unsigned*)(lds + MISC_OFF) + 8);
    const float* mod = (const float*)(p.ws + WS_MOD);

    ph_mod(p, lds, bid, nblk);
    xcd_barrier(bar);
    RUN2(1, ph_prologue(p, lds, bid, nblk));
    RUN2(7, ph_xn(p, bid, nblk));
    RUN2(9, ph_tables8(p, bid, nblk));
    xcd_barrier(bar);
    {
        pg8::Gemm g{(const pg8::bf16_t*)(p.ws + WS_XN), (const pg8::bf16_t*)(p.ws + WS_WIN), NT, NIN, DM}; pg8::StaticOrder S; S.init(NT, NIN, nblk, bid);
        EpiIn E{(bf16*)(p.ws + WS_FZ), (bf16*)(p.ws + WS_QB), (const float*)(p.ws + WS_MISC), (const float*)(p.ws + WS_ROPE)};
        pg8::gemm_phase<EpiIn, pg8::StaticOrder, true, true>(lds, g, S, E);
    }
    xcd_barrier(bar);
    RUN2(8, ph_fft(p, lds, bid, nblk));
    RUN2(2, ph_attn_fast(p, lds, bid, nblk));
    xcd_barrier(bar);
    RUN2(3, ph_merge(p, bid, nblk));
    xcd_barrier(bar);
    {
        pg8::Gemm g{(const pg8::bf16_t*)(p.ws + WS_XN), (const pg8::bf16_t*)(p.ws + WS_WOUT), NT, DM, DM}; pg8::StaticOrder S; S.init(NT, DM, nblk, bid);
        EpiOut E{(bf16*)(p.ws + WS_Y1), mod, p.b_out};
        pg8::gemm_phase<EpiOut, pg8::StaticOrder, true, true>(lds, g, S, E);
    }
    xcd_barrier(bar);
    RUN2(4, ph_ln1_fast(p, bid, nblk));
    xcd_barrier(bar);
    {
        pg8::Gemm g{(const pg8::bf16_t*)(p.ws + WS_XN), (const pg8::bf16_t*)(p.ws + WS_WPQ), NT, DM, DM}; pg8::StaticOrder S; S.init(NT, DM, nblk, bid);
        pg8::EpiBf16<0> E{(pg8::bf16_t*)(p.ws + WS_PQ), DM, nullptr, 0, 0, 1.f};
        pg8::gemm_phase<pg8::EpiBf16<0>, pg8::StaticOrder, true, true>(lds, g, S, E);
    }
    xcd_barrier(bar);
    RUN2(5, ph_topk_fast(p, lds, bid, nblk));
    xcd_barrier(bar);
    RUN2(6, ph_udot(p, bid, nblk));
    xcd_barrier(bar);
    RUN2(11, ph_act(p, bid, nblk));
    xcd_barrier(bar);
    RUN2(10, ph_vacc(p, bid, nblk));
    xcd_barrier(bar);
    ph_final(p, bid, nblk);
}

extern "C" void kernel_launch(void* const* d_in, const int* in_sizes, int n_in, void* d_out, int out_size, void* d_ws, size_t ws_size, hipStream_t stream) {
    Params p{};
    p.x = (const float*)d_in[0]; p.c = (const float*)d_in[1]; p.pos = (const int*)d_in[2]; p.w_ada = (const float*)d_in[3]; p.b_ada = (const float*)d_in[4];
    p.w_in = (const float*)d_in[5]; p.b_in = (const float*)d_in[6]; p.w_four = (const float*)d_in[7]; p.w_out = (const float*)d_in[8]; p.b_out = (const float*)d_in[9];
    p.g1 = (const float*)d_in[10]; p.be1 = (const float*)d_in[11]; p.w_pq = (const float*)d_in[12]; p.subk = (const float*)d_in[13]; p.pu = (const float*)d_in[14]; p.pv = (const float*)d_in[15];
    p.g2 = (const float*)d_in[16]; p.be2 = (const float*)d_in[17]; p.out = (float*)d_out; p.ws = (unsigned char*)d_ws;
    static int grid_blocks = 0;
    if (grid_blocks == 0) {
        if (ws_size < WS_END) { fprintf(stderr, "workspace too small: %zu < %zu\n", ws_size, (size_t)WS_END); grid_blocks = -1; return; }
        int dev = 0, cus = 0, per_cu = 0;
        if (hipGetDevice(&dev) != hipSuccess || hipDeviceGetAttribute(&cus, hipDeviceAttributeMultiprocessorCount, dev) != hipSuccess) { grid_blocks = -1; return; }
        if (hipFuncSetAttribute((const void*)mega, hipFuncAttributeMaxDynamicSharedMemorySize, LDS_BYTES) != hipSuccess) { fprintf(stderr, "hipFuncSetAttribute failed\n"); grid_blocks = -1; return; }
        if (hipOccupancyMaxActiveBlocksPerMultiprocessor(&per_cu, (const void*)mega, NTHREADS, LDS_BYTES) != hipSuccess || per_cu < 1) { fprintf(stderr, "occupancy query: %d\n", per_cu); grid_blocks = -1; return; }
        grid_blocks = cus;
    }
    if (grid_blocks < 0) return;
    if (hipMemsetAsync((char*)d_ws + WS_CTL, 0, CTL_ZERO_BYTES, stream) != hipSuccess) { fprintf(stderr, "memset failed\n"); return; }
    void* args[] = {&p};
    hipError_t e = hipLaunchCooperativeKernel((void*)mega, dim3(grid_blocks), dim3(NTHREADS), args, LDS_BYTES, stream);
    if (e != hipSuccess) fprintf(stderr, "cooperative launch failed: %s (grid %d)\n", hipGetErrorString(e), grid_blocks);
}
```

```cpp
#include <hip/hip_runtime.h>
#include <hip/hip_cooperative_groups.h>
#include <cstdio>
#include <cstdint>
#include <cmath>
namespace cg = cooperative_groups;

namespace pg8 {
#define PG8_LAS __attribute__((address_space(3)))
typedef unsigned short bf16_t;
typedef short bf16x8 __attribute__((ext_vector_type(8)));
typedef float f32x4 __attribute__((ext_vector_type(4)));
typedef unsigned u32x4 __attribute__((ext_vector_type(4)));
constexpr int BM = 256, BK = 64, HALF = 128, HTB = HALF * BK * 2  , STAGE_BYTES = 8 * HTB, NXCD = 8, WGM = 8;

__host__ __device__ __forceinline__ int lds_byte(int r, int c) { const int st = (r >> 4) * 2 + (c >> 5), rr = r & 15, cc = c & 31, ob = rr * 64 + cc * 2; return st * 1024 + (ob ^ (((ob >> 9) & 1) << 5)); }
__host__ __device__ __forceinline__ void stage_rc(int b, int& R, int& C) { const int st = b / 1024, sb = b % 1024, swz = sb ^ (((sb >> 9) & 1) << 5); R = (st >> 1) * 16 + swz / 64; C = (st & 1) * 32 + (swz % 64) / 2; }
__host__ __device__ __forceinline__ int perm32(int rho) { const int n = rho >> 4, i = rho & 15; return 8 * (i >> 2) + 4 * n + (i & 3); }

struct Unit { int pm, pn; };
struct Gemm { const bf16_t* A; const bf16_t* Bt; int M, N, K; };

struct StaticOrder {
    int nM, nN, nwg, G, c;
    __host__ __device__ void init(int M, int N, int G_, int c_) { nM = M / BM; nN = N / BM; nwg = nM * nN; G = G_; c = c_; }
    __host__ __device__ bool next(int i, Unit& u) const {
        const long L = (long)i * G + c; if (L >= nwg) return false;
        int wgid = (int)L; { const int q = nwg / NXCD, r = nwg % NXCD, xcd = wgid % NXCD, off = wgid / NXCD; wgid = (xcd < r ? xcd * (q + 1) : r * (q + 1) + (xcd - r) * q) + off; }
        const int nig = WGM * nN, gid = wgid / nig, fm = gid * WGM, gsz = (nM - fm) < WGM ? (nM - fm) : WGM;
        u.pm = fm + ((wgid % nig) % gsz); u.pn = (wgid % nig) / gsz; return true;
    }
    __device__ __forceinline__ void a_ready(const Unit&) const {}
    __device__ __forceinline__ void done(const Unit&) const {}
};

__device__ __forceinline__ unsigned cvt_pk_bf16(float lo, float hi) { unsigned r; asm volatile("v_cvt_pk_bf16_f32 %0, %1, %2" : "=v"(r) : "v"(lo), "v"(hi)); return r; }
typedef float f32x2 __attribute__((ext_vector_type(2)));
__device__ __forceinline__ f32x2 gelu_pk(f32x2 v) {
    const f32x2 av = __builtin_elementwise_abs(v), d = av * 0.2316418882f + 1.0f;
    f32x2 t; t.x = __builtin_amdgcn_rcpf(d.x); t.y = __builtin_amdgcn_rcpf(d.y);
    f32x2 q = t * 0.5307027145f + (-0.7265760135f); q = q * t + 0.7107068705f; q = q * t + (-0.142248368f); q = q * t + 0.127414796f; q = q * t;
    const f32x2 s = (v * v) * (-0.72134752044f);
    f32x2 e; e.x = __builtin_amdgcn_exp2f(s.x); e.y = __builtin_amdgcn_exp2f(s.y);
    const f32x2 m = v * (q * e), r = v - m;
    f32x2 o; o.x = v.x < 0.f ? m.x : r.x; o.y = v.y < 0.f ? m.y : r.y; return o;
}

template <int ACT  > struct EpiBf16 {
    static constexpr bool PERM = true, AFTER_DRAIN = false; static_assert(ACT == 0 || ACT == 1, "EpiBf16: ACT is 0 (none) or 1 (gelu_pk)");
    bf16_t* O; int ldc; const float* bias; int split_cols; size_t split_stride; float scale0;
    __device__ __forceinline__ void operator()(const f32x4 (&acc)[2][2][4][2], const Unit& u, int wr, int wc, int fr, int fq) const {
        const int row0 = u.pm * BM + wr * 64 + fr; int colt = u.pn * BM; bf16_t* base = O;
        float sc = 1.f; if (split_cols) { const int t = colt / split_cols; base += (size_t)t * split_stride; colt -= t * split_cols; if (t == 0) sc = scale0; }
        const int col0 = colt + wc * 32 + 8 * fq, bcol0 = u.pn * BM + wc * 32 + 8 * fq;
        f32x4 bv[2][2];
#pragma unroll
        for (int bj = 0; bj < 2; ++bj)
#pragma unroll
            for (int n = 0; n < 2; ++n) bv[bj][n] = bias ? *(const f32x4*)(bias + bcol0 + bj * HALF + 4 * n) : (f32x4){0.f, 0.f, 0.f, 0.f};
#pragma unroll
        for (int ai = 0; ai < 2; ++ai)
#pragma unroll
            for (int m = 0; m < 4; ++m) { bf16_t* rowp = base + (size_t)(row0 + ai * HALF + m * 16) * ldc + col0;
#pragma unroll
                for (int bj = 0; bj < 2; ++bj) { f32x4 v0 = acc[ai][bj][m][0] + bv[bj][0], v1 = acc[ai][bj][m][1] + bv[bj][1];
                    if (ACT == 1) { f32x2 a = gelu_pk((f32x2){v0[0], v0[1]}), b = gelu_pk((f32x2){v0[2], v0[3]}), c = gelu_pk((f32x2){v1[0], v1[1]}), d = gelu_pk((f32x2){v1[2], v1[3]});
                        v0 = (f32x4){a.x, a.y, b.x, b.y}; v1 = (f32x4){c.x, c.y, d.x, d.y}; }
                    v0 = v0 * sc; v1 = v1 * sc; u32x4 w; w.x = cvt_pk_bf16(v0[0], v0[1]); w.y = cvt_pk_bf16(v0[2], v0[3]); w.z = cvt_pk_bf16(v1[0], v1[1]); w.w = cvt_pk_bf16(v1[2], v1[3]);
                    *(u32x4*)(rowp + bj * HALF) = w; } }
    }
};
template <class Epi, class Sched, bool ALIGN_EPI = false, bool SP2 = false>
__device__ __forceinline__ void gemm_phase(PG8_LAS unsigned char* lds, const Gemm g, const Sched& S, const Epi& E) {
    int tid_ = threadIdx.x; asm volatile("" : "+v"(tid_)); const int tid = tid_, wid = __builtin_amdgcn_readfirstlane(tid >> 6), lane = tid & 63, wr = wid >> 2, wc = wid & 3, fr = lane & 15, fq = lane >> 4;
    const int K = g.K, nt = K / BK;
    unsigned voffA[2], voffB[2];
#pragma unroll
    for (int i = 0; i < 2; ++i) { int R, C; stage_rc(tid * 16 + i * 8192, R, C); const int Rb = Epi::PERM ? ((R & ~31) + perm32(R & 31)) : R;
        voffA[i] = (unsigned)(R * K + C) * 2u; voffB[i] = (unsigned)(Rb * K + C) * 2u; }
    const size_t kstep = (size_t)(BK * 2);
    const size_t hstep = (size_t)HALF * K * 2;
    const size_t tstep = 2 * hstep;
    const unsigned ldsw = (unsigned)wid * 1024u;
    const int aoff = lds_byte(wr * 64 + fr, fq * 8), boff = lds_byte(wc * 32 + fr, fq * 8);
#define PG8_SA(b, h) (((b) * 2 + (h)) * HTB)
#define PG8_SB(b, h) ((4 + (b) * 2 + (h)) * HTB)
#define PG8_STAGE(bufoff, gbase, voff) do { _Pragma("unroll") for (int _i = 0; _i < 2; ++_i) \
        __builtin_amdgcn_global_load_lds((const unsigned*)((const char*)(gbase) + (voff)[_i]), (PG8_LAS unsigned*)(lds + (bufoff) + ldsw + _i * 8192), 16, 0, 0); } while (0)
#define PG8_LDA(dst, b, h) do { _Pragma("unroll") for (int m = 0; m < 4; ++m) _Pragma("unroll") for (int k = 0; k < 2; ++k) dst[m][k] = *(const PG8_LAS bf16x8*)(lds + PG8_SA(b, h) + aoff + m * 2048 + k * 1024); } while (0)
#define PG8_LDB(dst, b, h) do { _Pragma("unroll") for (int n = 0; n < 2; ++n) _Pragma("unroll") for (int k = 0; k < 2; ++k) dst[n][k] = *(const PG8_LAS bf16x8*)(lds + PG8_SB(b, h) + boff + n * 2048 + k * 1024); } while (0)
#define PG8_MMA(ai, bj, At, Bt) do { __builtin_amdgcn_s_setprio(1); _Pragma("unroll") for (int m = 0; m < 4; ++m) _Pragma("unroll") for (int n = 0; n < 2; ++n) _Pragma("unroll") for (int k = 0; k < 2; ++k) \
        acc[ai][bj][m][n] = __builtin_amdgcn_mfma_f32_16x16x32_bf16(Bt[n][k], At[m][k], acc[ai][bj][m][n], 0, 0, 0); __builtin_amdgcn_s_setprio(0); } while (0)
#define PG8_WAIT_V(n) asm volatile("s_waitcnt vmcnt(" #n ")" ::: "memory")
#define PG8_WAIT_L(n) asm volatile("s_waitcnt lgkmcnt(" #n ")" ::: "memory")
#define PG8_BAR __builtin_amdgcn_s_barrier()
#define PG8_SCHED __builtin_amdgcn_sched_barrier(0)
    Unit cur, nxt; int ui = 0;
    if (!S.next(0, cur)) return;
    f32x4 acc[2][2][4][2];
#pragma unroll
    for (int a = 0; a < 2; ++a)
#pragma unroll
        for (int b = 0; b < 2; ++b)
#pragma unroll
            for (int m = 0; m < 4; ++m)
#pragma unroll
                for (int n = 0; n < 2; ++n) acc[a][b][m][n] = (f32x4){0.f, 0.f, 0.f, 0.f};
    bf16x8 At[4][2], B0[2][2], B1[2][2];
    const char* cA = (const char*)g.A + (size_t)cur.pm * tstep; const char* cB = (const char*)g.Bt + (size_t)cur.pn * tstep;
    S.a_ready(cur);
    if constexpr (SP2) {
        PG8_STAGE(PG8_SB(0, 0), cB, voffB); PG8_STAGE(PG8_SB(0, 1), cB + hstep, voffB); PG8_STAGE(PG8_SA(0, 0), cA, voffA); PG8_STAGE(PG8_SA(0, 1), cA + hstep, voffA);
        if (wr == 1) PG8_BAR;
        PG8_WAIT_V(2); PG8_BAR;
        PG8_STAGE(PG8_SB(1, 0), cB + kstep, voffB); PG8_STAGE(PG8_SA(1, 0), cA + kstep, voffA); PG8_STAGE(PG8_SB(1, 1), cB + hstep + kstep, voffB);
        PG8_WAIT_V(6); PG8_BAR;
    } else {
        PG8_STAGE(PG8_SB(0, 0), cB, voffB); PG8_STAGE(PG8_SA(0, 0), cA, voffA); PG8_STAGE(PG8_SB(0, 1), cB + hstep, voffB); PG8_STAGE(PG8_SA(0, 1), cA + hstep, voffA);
        if (wr == 1) PG8_BAR;
        PG8_WAIT_V(4); PG8_BAR;
        PG8_STAGE(PG8_SB(1, 0), cB + kstep, voffB); PG8_STAGE(PG8_SA(1, 0), cA + kstep, voffA); PG8_STAGE(PG8_SB(1, 1), cB + hstep + kstep, voffB);
        PG8_WAIT_V(6); PG8_BAR;
    }
    for (;;) {
        const bool has_next = S.next(ui + 1, nxt);
        const char* nA = has_next ? (const char*)g.A + (size_t)nxt.pm * tstep : cA; const char* nB = has_next ? (const char*)g.Bt + (size_t)nxt.pn * tstep : cB;
        for (int t = 0; t < nt; t += 2) {
            const bool last = (t == nt - 2);
            const char* a1 = cA + (size_t)(t + 1) * kstep;
            const char* a2 = last ? nA : cA + (size_t)(t + 2) * kstep; const char* b2 = last ? nB : cB + (size_t)(t + 2) * kstep;
            const char* a3 = a2 + kstep; const char* b3 = b2 + kstep;
            if (last && has_next) S.a_ready(nxt);
            if constexpr (SP2) {
            PG8_LDB(B0, 0, 0); PG8_LDB(B1, 0, 1); PG8_SCHED; PG8_LDA(At, 0, 0); PG8_STAGE(PG8_SA(1, 1), a1 + hstep, voffA);
            PG8_WAIT_V(8); PG8_WAIT_L(0); PG8_BAR; PG8_MMA(0, 0, At, B0); PG8_MMA(0, 1, At, B1); PG8_BAR; PG8_SCHED;
            PG8_LDA(At, 0, 1); PG8_STAGE(PG8_SB(0, 0), b2, voffB); PG8_STAGE(PG8_SB(0, 1), b2 + hstep, voffB); PG8_STAGE(PG8_SA(0, 0), a2, voffA);
            PG8_WAIT_V(8); PG8_WAIT_L(0); PG8_BAR; PG8_MMA(1, 0, At, B0); PG8_MMA(1, 1, At, B1); PG8_BAR; PG8_SCHED;
            PG8_LDB(B0, 1, 0); PG8_LDB(B1, 1, 1); PG8_SCHED; PG8_LDA(At, 1, 0); PG8_STAGE(PG8_SA(0, 1), a2 + hstep, voffA);
            PG8_WAIT_V(8); PG8_WAIT_L(0); PG8_BAR; PG8_MMA(0, 0, At, B0); PG8_MMA(0, 1, At, B1); PG8_BAR; PG8_SCHED;
            PG8_LDA(At, 1, 1); PG8_STAGE(PG8_SB(1, 0), b3, voffB); PG8_STAGE(PG8_SB(1, 1), b3 + hstep, voffB); PG8_STAGE(PG8_SA(1, 0), a3, voffA);
            PG8_WAIT_V(8); PG8_WAIT_L(0); PG8_BAR; PG8_MMA(1, 0, At, B0); PG8_MMA(1, 1, At, B1); PG8_BAR; PG8_SCHED;
            } else {
            PG8_LDB(B0, 0, 0); PG8_SCHED; PG8_LDA(At, 0, 0); PG8_STAGE(PG8_SA(1, 1), a1 + hstep, voffA);
            PG8_WAIT_L(8); PG8_BAR; PG8_WAIT_L(0); PG8_MMA(0, 0, At, B0); PG8_BAR; PG8_SCHED;
            PG8_LDB(B1, 0, 1); PG8_STAGE(PG8_SB(0, 0), b2, voffB);
            PG8_BAR; PG8_WAIT_L(0); PG8_MMA(0, 1, At, B1); PG8_BAR;
            PG8_LDA(At, 0, 1); PG8_STAGE(PG8_SA(0, 0), a2, voffA);
            PG8_BAR; PG8_WAIT_L(0); PG8_MMA(1, 0, At, B0); PG8_BAR; PG8_SCHED;
            PG8_STAGE(PG8_SB(0, 1), b2 + hstep, voffB);
            PG8_WAIT_V(6); PG8_BAR; PG8_MMA(1, 1, At, B1); PG8_BAR;
            PG8_LDB(B0, 1, 0); PG8_SCHED; PG8_LDA(At, 1, 0); PG8_STAGE(PG8_SA(0, 1), a2 + hstep, voffA);
            PG8_WAIT_L(8); PG8_BAR; PG8_WAIT_L(0); PG8_MMA(0, 0, At, B0); PG8_BAR; PG8_SCHED;
            PG8_LDB(B1, 1, 1); PG8_STAGE(PG8_SB(1, 0), b3, voffB);
            PG8_BAR; PG8_WAIT_L(0); PG8_MMA(0, 1, At, B1); PG8_BAR;
            PG8_LDA(At, 1, 1); PG8_STAGE(PG8_SA(1, 0), a3, voffA);
            PG8_BAR; PG8_WAIT_L(0); PG8_MMA(1, 0, At, B0); PG8_BAR; PG8_SCHED;
            PG8_STAGE(PG8_SB(1, 1), b3 + hstep, voffB);
            PG8_WAIT_V(6); PG8_BAR; PG8_MMA(1, 1, At, B1); PG8_BAR;
            }
        }
        if constexpr (ALIGN_EPI) { if (wr == 0) PG8_BAR; }
        if constexpr (!Epi::AFTER_DRAIN) { E(acc, cur, wr, wc, fr, fq); S.done(cur); }
        if (!has_next) break;
#pragma unroll
        for (int a = 0; a < 2; ++a)
#pragma unroll
            for (int b = 0; b < 2; ++b)
#pragma unroll
                for (int m = 0; m < 4; ++m)
#pragma unroll
                    for (int n = 0; n < 2; ++n) acc[a][b][m][n] = (f32x4){0.f, 0.f, 0.f, 0.f};
        cur = nxt; cA = nA; cB = nB; ++ui;
        if constexpr (ALIGN_EPI) { if (wr == 1) PG8_BAR; }
    }
    PG8_WAIT_V(0);
    if constexpr (!ALIGN_EPI) { if (wr == 0) PG8_BAR; }
    PG8_BAR;
    if constexpr (Epi::AFTER_DRAIN) { E.fused(acc, cur, wr, wc, fr, fq, lds, wid, lane); S.done(cur); }
#undef PG8_SA
#undef PG8_SB
#undef PG8_STAGE
#undef PG8_LDA
#undef PG8_LDB
#undef PG8_MMA
#undef PG8_WAIT_V
#undef PG8_WAIT_L
#undef PG8_BAR
#undef PG8_SCHED
}
}

#define LAS __attribute__((address_space(3)))
#define GAS __attribute__((address_space(1)))
#define XB_TMO      128
#define XB_XCNT(j)  (256  + 64 * (j))
#define XB_XSUB(j)  (1280 + 64 * (j))
#define XB_XGEN(j)  (2304 + 64 * (j))
#define XB_TOP      3328
#define XB_TOPGEN   3392
#define XCD_BAR_WORDS 3456
#define XB_SPIN_CAP (1u << 18)

__device__ __forceinline__ unsigned xb_ld(unsigned* p)              { return __hip_atomic_load(p, __ATOMIC_RELAXED, __HIP_MEMORY_SCOPE_AGENT); }
__device__ __forceinline__ unsigned xb_add(unsigned* p, unsigned v) { return __hip_atomic_fetch_add(p, v, __ATOMIC_RELAXED, __HIP_MEMORY_SCOPE_AGENT); }
__device__ __forceinline__ unsigned xb_xcc_id() { return (unsigned)__builtin_amdgcn_s_getreg((3 << 11) | 20) & 0xFu; }
#define XB_SPIN(cond, bar) do { unsigned _sp = 0; while (cond) { __builtin_amdgcn_s_sleep(1); \
    if ((++_sp & 255u) == 0u) { if (xb_ld(&(bar)[XB_TMO])) break; if (_sp > XB_SPIN_CAP) { atomicAdd(&(bar)[XB_TMO], 1u); break; } } } } while (0)

struct XcdBarrier {
    unsigned* bar; unsigned x;
    volatile LAS unsigned* st;
};

__device__ __forceinline__ XcdBarrier xcd_barrier_post(unsigned* bar, volatile LAS unsigned* st) {
    XcdBarrier b; b.bar = bar; b.x = xb_xcc_id(); b.st = st;
    if (threadIdx.x == 0) (void)xb_add(&bar[XB_XCNT(b.x)], 1u);
    return b;
}
__device__ __forceinline__ void xcd_barrier_complete(unsigned* bar, unsigned x, unsigned& nloc, unsigned& nx) {
    const unsigned G = gridDim.x * gridDim.y * gridDim.z;
    unsigned sum, cnt, mine, sp = 0u;
    for (;;) {
        sum = 0u; cnt = 0u; mine = 0u;
#pragma unroll
        for (unsigned j = 0; j < 16; ++j) { const unsigned c = xb_ld(&bar[XB_XCNT(j)]); sum += c; cnt += (c > 0u) ? 1u : 0u; mine = (j == x) ? c : mine; }
        if (sum == G) break;
        __builtin_amdgcn_s_sleep(1);
        if ((++sp & 255u) == 0u) { if (xb_ld(&bar[XB_TMO])) break; if (sp > XB_SPIN_CAP) { atomicAdd(&bar[XB_TMO], 1u); break; } }
    }
    nloc = mine > 0u ? mine : 1u; nx = cnt > 0u ? cnt : 1u;
}

__device__ __forceinline__ void xcd_barrier(const XcdBarrier& b) {
    asm volatile("s_waitcnt vmcnt(0)" ::: "memory");
    __syncthreads();
    if (threadIdx.x == 0) {
        unsigned* bar = b.bar;
        __builtin_amdgcn_s_waitcnt(0);
        unsigned nloc = b.st[0], nx = b.st[1];
        if (nloc == 0u) { xcd_barrier_complete(bar, b.x, nloc, nx); b.st[0] = nloc; b.st[1] = nx; }
        const unsigned old = xb_add(&bar[XB_XSUB(b.x)], 1u);
        const unsigned gen = old / nloc;
        if (old + 1u == (gen + 1u) * nloc) {
            __builtin_amdgcn_fence(__ATOMIC_RELEASE, "agent");
            asm volatile("s_waitcnt vmcnt(0)" ::: "memory");
            const unsigned og = xb_add(&bar[XB_TOP], 1u);
            const unsigned tg = og / nx;
            if (og + 1u == (tg + 1u) * nx) xb_add(&bar[XB_TOPGEN], 1u);
            else XB_SPIN(xb_ld(&bar[XB_TOPGEN]) == tg, bar);
            __builtin_amdgcn_fence(__ATOMIC_ACQUIRE, "agent");
            xb_add(&bar[XB_XGEN(b.x)], 1u);
            asm volatile("s_waitcnt vmcnt(0)" ::: "memory");
        } else {
            XB_SPIN(xb_ld(&bar[XB_XGEN(b.x)]) == gen, bar);
            __builtin_amdgcn_fence(__ATOMIC_ACQUIRE, "agent");
            asm volatile("s_waitcnt vmcnt(0)" ::: "memory");
        }
    }
    __syncthreads();
}

constexpr int DM = 1024, NB = 2, SEQ = 8192, NT = NB * SEQ;
constexpr int NTHREADS = 512, NWAVES = 8;
constexpr float LN_EPS = 1e-5f;
constexpr float ALPHA = 1.189207115002721f;
typedef unsigned short bf16;
typedef unsigned v4u __attribute__((ext_vector_type(4)));
typedef unsigned v2u __attribute__((ext_vector_type(2)));
typedef float f32x4 __attribute__((ext_vector_type(4)));
typedef short bf16x8_t __attribute__((ext_vector_type(8)));

constexpr size_t MiB = 1u << 20, KiB = 1u << 10;
constexpr size_t WS_CTL = 0, CTL_ZERO_BYTES = 1 * MiB;
constexpr size_t WS_MOD = 1 * MiB + 768 * KiB;
constexpr size_t WS_MMAT = 1 * MiB;
constexpr size_t WS_ROPE = 2 * MiB;
constexpr size_t WS_WIN = 6 * MiB, WS_WOUT = 12 * MiB, WS_WPQ = 14 * MiB, WS_MISC = 16 * MiB, WS_SUBK = 17 * MiB;
constexpr size_t WS_XN = 18 * MiB;
constexpr size_t WS_FZ = 50 * MiB;
constexpr size_t WS_QB = 66 * MiB, WS_KB = 90 * MiB, WS_VB = 114 * MiB, WS_O3 = 138 * MiB, WS_LSE = 162 * MiB;
constexpr size_t WS_H2Q = 50 * MiB, WS_HS = 66 * MiB, WS_WQ = 67 * MiB, WS_WSC = 69 * MiB, WS_SUA = 75 * MiB, WS_X1 = 83 * MiB;
constexpr size_t WS_Y1 = 116 * MiB, WS_PQ = 116 * MiB, WS_PART = 116 * MiB, WS_Y = 116 * MiB;
constexpr size_t WS_IDS = 180 * MiB, WS_GATES = 188 * MiB;
constexpr size_t WS_TU8 = 200 * MiB, WS_TV8 = 216 * MiB, WS_SU = 232 * MiB, WS_SV = 232 * MiB + 64 * KiB, WS_END = 233 * MiB;
constexpr float QSCALE = 0.125f * 1.4426950408889634f;
constexpr int NIN = 2816;
constexpr int CW_BAR = 4096;

constexpr int RING_BYTES = 131072, LDSCTL_OFF = RING_BYTES, MISC_OFF = LDSCTL_OFF + 320, LDS_BYTES = 147456;

struct Params {
    const float* x; const float* c; const int* pos; const float* w_ada; const float* b_ada; const float* w_in; const float* b_in;
    const float* w_four; const float* w_out; const float* b_out; const float* g1; const float* be1; const float* w_pq; const float* subk;
    const float* pu; const float* pv; const float* g2; const float* be2; float* out; unsigned char* ws;
};

__device__ __forceinline__ unsigned f2bf(float f) { unsigned u = __builtin_bit_cast(unsigned, f); return (u + 0x7fffu + ((u >> 16) & 1u)) >> 16; }
__device__ __forceinline__ unsigned pk2(float lo, float hi) { return f2bf(lo) | (f2bf(hi) << 16); }
__device__ __forceinline__ float wave_sum(float v) {
#pragma unroll
    for (int o = 32; o > 0; o >>= 1) v += __shfl_xor(v, o);
    return v;
}
__device__ __forceinline__ float wave_max(float v) {
#pragma unroll
    for (int o = 32; o > 0; o >>= 1) v = fmaxf(v, __shfl_xor(v, o));
    return v;
}
#define LDS_WAIT() asm volatile("s_waitcnt lgkmcnt(0)" ::: "memory")
__device__ __forceinline__ int opaque_tid() { int t = threadIdx.x; asm volatile("" : "+v"(t)); return t; }
__device__ __forceinline__ int wave_id() { return __builtin_amdgcn_readfirstlane(opaque_tid() >> 6); }
__device__ __forceinline__ float bflo(unsigned u) { return __builtin_bit_cast(float, u << 16); }
__device__ __forceinline__ float bfhi(unsigned u) { return __builtin_bit_cast(float, u & 0xffff0000u); }

template <class SC>
__device__ __forceinline__ void transpose_item(const float* W, int K, int N, bf16* WT, int nout, SC srccol, LAS float* scr, int item, int lane) {
    const int nblk = nout / 32, kb = item / nblk, nb = item % nblk, k0 = 64 * kb, n0 = 32 * nb;
    const int sc = srccol(n0 + (lane & 31));
#pragma unroll 8
    for (int i = 0; i < 32; ++i) { const int kk = 2 * i + (lane >> 5); scr[kk * 33 + (lane & 31)] = W[(size_t)(k0 + kk) * N + sc]; }
    LDS_WAIT(); asm volatile("" ::: "memory");
    const int c = lane & 7;
#pragma unroll
    for (int j = 0; j < 4; ++j) { const int n = (lane >> 3) + 8 * j; const LAS float* s = scr + (8 * c) * 33 + n;
        v4u o; o.x = pk2(s[0 * 33], s[1 * 33]); o.y = pk2(s[2 * 33], s[3 * 33]); o.z = pk2(s[4 * 33], s[5 * 33]); o.w = pk2(s[6 * 33], s[7 * 33]);
        *(v4u*)(WT + (size_t)(n0 + n) * K + k0 + 8 * c) = o; }
    LDS_WAIT(); asm volatile("" ::: "memory");
}
__device__ __forceinline__ void ph_prologue(const Params& p, LAS unsigned char* lds, int bid, int nblk) {
    const int tid = opaque_tid(), lane = tid & 63, wave = __builtin_amdgcn_readfirstlane(tid >> 6);
    {
        LAS float* M = (LAS float*)lds; LAS float* Wl = (LAS float*)(lds + 32768);
        bf16* WT = (bf16*)(p.ws + WS_WIN); float* biasf = (float*)(p.ws + WS_MISC); const float* MM = (const float*)(p.ws + WS_MMAT);
        const bool fallback = !(nblk > 192);
        for (int it = bid; it < 256; it += nblk) {
            const int g = it & 3, kb = it >> 2, k0 = kb * 16;
            __syncthreads();
            if (fallback) { const float norm = 1.0f / sqrtf(8192.0f * 64.0f);
                for (int e = tid; e < 8192; e += NTHREADS) { const int c = e >> 7, nl = e & 127; float a = 0.f;
                    for (int cp = 0; cp < 64; ++cp) { const float ang = 2.0f * (float)((c * cp) & 63) / 64.0f; a += ((nl & 1) ? -sinpif(ang) : cospif(ang)) * p.w_four[(g * 64 + cp) * 64 + (nl >> 1)]; }
                    M[e] = a * norm; } }
            else {
#pragma unroll
                for (int i = 0; i < 4; ++i) *(LAS f32x4*)(lds + (tid + i * 512) * 16) = *(const f32x4*)(MM + (size_t)g * 8192 + (tid + i * 512) * 4); }
#pragma unroll
            for (int i = 0; i < 2; ++i) { const int e = tid + i * 512, k = e >> 6, c = e & 63; Wl[k * 64 + c] = p.w_in[(size_t)(k0 + k) * 2560 + g * 64 + c]; }
            __syncthreads();
            { const int nl = tid & 127, kq = tid >> 7; float a[4] = {0.f, 0.f, 0.f, 0.f};
              for (int c = 0; c < 64; ++c) { const float mv = M[c * 128 + nl];
#pragma unroll
                  for (int j = 0; j < 4; ++j) a[j] += mv * Wl[(kq * 4 + j) * 64 + c]; }
              *(v2u*)(WT + (size_t)(g * 128 + nl) * DM + k0 + kq * 4) = (v2u){pk2(a[0], a[1]), pk2(a[2], a[3])};
              if (kb == 0 && tid < 128) { float bsum = 0.f; for (int c = 0; c < 64; ++c) bsum += p.b_in[g * 64 + c] * M[c * 128 + nl]; biasf[g * 128 + nl] = bsum; } }
        }
        __syncthreads();
        for (int i = bid * NTHREADS + tid; i < 2304; i += nblk * NTHREADS) biasf[512 + i] = p.b_in[256 + i];
    }
    {
        LAS float* scr = (LAS float*)(lds + wave * 16384);
        const int gw = bid * NWAVES + wave, NGW = nblk * NWAVES;
        constexpr int I_IN = 16 * (2304 / 32), I_O = 16 * 32, I_PQ = 16 * 32;
        for (int it = gw; it < I_IN + I_O + I_PQ; it += NGW) {
            int r = it;
            if (r < I_IN) {
                transpose_item(p.w_in, DM, 2560, (bf16*)(p.ws + WS_WIN) + (size_t)512 * DM, 2304,
                    [](int n) { return n < 1536 ? 256 + (n & ~63) + ((n & 63) >> 1) + 32 * (n & 1) : 256 + n; }, scr, r, lane); continue; } r -= I_IN;
            if (r < I_O) { transpose_item(p.w_out, DM, DM, (bf16*)(p.ws + WS_WOUT), DM, [](int n) { return n; }, scr, r, lane); continue; } r -= I_O;
            transpose_item(p.w_pq, DM, DM, (bf16*)(p.ws + WS_WPQ), DM, [](int n) { return n; }, scr, r, lane);
        }
    }
    { float2* rope = (float2*)(p.ws + WS_ROPE);
      for (int idx = bid * NTHREADS + tid; idx < NT * 32; idx += nblk * NTHREADS) { const int t = idx >> 5, i = idx & 31;
          const float inv = powf(10000.0f, -(float)i / 32.0f); float sn, cs; sincosf((float)p.pos[t] * inv, &sn, &cs); rope[idx] = make_float2(cs, sn); } }
    { bf16* SK = (bf16*)(p.ws + WS_SUBK);
      for (int ch = bid * NTHREADS + tid; ch < 8 * 2 * 4 * 4 * 64; ch += nblk * NTHREADS) {
          const int ln = ch & 63, d0 = (ch >> 6) & 3, mt = (ch >> 8) & 3, hp = ch >> 10;
          const float* sp = p.subk + ((size_t)hp * 128 + 32 * mt + (ln & 31)) * 64 + 16 * d0 + 8 * (ln >> 5);
          v4u o; o.x = pk2(sp[0], sp[1]); o.y = pk2(sp[2], sp[3]); o.z = pk2(sp[4], sp[5]); o.w = pk2(sp[6], sp[7]);
          *(v4u*)(SK + (size_t)ch * 8) = o; } }
}
__device__ __forceinline__ void ph_mod(const Params& p, LAS unsigned char* lds, int bid, int nblk) {
    const int tid = opaque_tid(), col = tid & 31, kg = tid >> 5;
    LAS float* cond = (LAS float*)lds; LAS float* red = (LAS float*)(lds + 8192);
    float* mod = (float*)(p.ws + WS_MOD);
    for (int i = tid; i < 2 * DM; i += NTHREADS) { const float c = p.c[i]; cond[i] = c / (1.0f + expf(-c)); }
    __syncthreads();
    if (nblk > 192 && bid >= 192) {
        LAS float* T64 = (LAS float*)(lds + 12288);
        if (tid < 64) { T64[tid] = cospif(2.0f * (float)tid / 64.0f); T64[64 + tid] = -sinpif(2.0f * (float)tid / 64.0f); }
        __syncthreads();
        const float norm = 1.0f / sqrtf(8192.0f * 64.0f); float* MM = (float*)(p.ws + WS_MMAT);
        for (int it = bid - 192; it < 64; it += nblk - 192) {
            const int g = it >> 4, c = (it & 15) * 4 + (tid >> 7), nl = tid & 127; float a = 0.f;
#pragma unroll 8
            for (int cp = 0; cp < 64; ++cp) a += T64[(nl & 1) * 64 + ((c * cp) & 63)] * p.w_four[(g * 64 + cp) * 64 + (nl >> 1)];
            MM[(g * 64 + c) * 128 + nl] = a * norm;
        }
    }
    for (int it = bid; it < 6144 / 32; it += nblk) {
        const int n = it * 32 + col; float a0 = 0.f, a1 = 0.f;
        const float* wp = p.w_ada + (size_t)(kg * 64) * 6144 + n;
#pragma unroll 16
        for (int k = 0; k < 64; ++k) { const float w = wp[(size_t)k * 6144]; a0 += cond[kg * 64 + k] * w; a1 += cond[DM + kg * 64 + k] * w; }
        red[(kg * 2 + 0) * 32 + col] = a0; red[(kg * 2 + 1) * 32 + col] = a1;
        __syncthreads();
        if (tid < 64) { const int b = tid >> 5; float s = p.b_ada[n];
#pragma unroll
            for (int g = 0; g < 16; ++g) s += red[(g * 2 + b) * 32 + col];
            mod[b * 6144 + n] = s; }
        __syncthreads();
    }
}
__device__ __forceinline__ void ph_xn(const Params& p, int bid, int nblk) {
    const int lane = opaque_tid() & 63, wave = wave_id(); const float* mod = (const float*)(p.ws + WS_MOD); bf16* XN = (bf16*)(p.ws + WS_XN);
    for (int row = bid * NWAVES + wave; row < NT; row += nblk * NWAVES) {
        const int b = row / SEQ;
        const f32x4* xr = (const f32x4*)(p.x + (size_t)row * DM) + lane;
        f32x4 v[4]; float s = 0.f;
#pragma unroll
        for (int j = 0; j < 4; ++j) { v[j] = xr[64 * j]; s += (v[j].x + v[j].y) + (v[j].z + v[j].w); }
        const float mean = wave_sum(s) * (1.f / DM); float s2 = 0.f;
#pragma unroll
        for (int j = 0; j < 4; ++j) { v[j] = v[j] - mean; s2 += (v[j].x * v[j].x + v[j].y * v[j].y) + (v[j].z * v[j].z + v[j].w * v[j].w); }
        const float rstd = rsqrtf(wave_sum(s2) * (1.f / DM) + LN_EPS);
        unsigned long long* o8 = (unsigned long long*)(XN + (size_t)row * DM) + lane;
#pragma unroll
        for (int j = 0; j < 4; ++j) {
            const f32x4 sh = *((const f32x4*)(mod + b * 6144 + 0) + lane + 64 * j), sc = *((const f32x4*)(mod + b * 6144 + 1024) + lane + 64 * j);
            const f32x4 o = v[j] * rstd * (1.0f + sc) + sh;
            o8[64 * j] = (unsigned long long)pk2(o.x, o.y) | ((unsigned long long)pk2(o.z, o.w) << 32);
        }
    }
}

struct EpiOut {
    static constexpr bool PERM = true, AFTER_DRAIN = false;
    bf16* Y1; const float* x; const float* mod; const float* bo;
    __device__ __forceinline__ void operator()(const pg8::f32x4 (&acc)[2][2][4][2], const pg8::Unit& u, int wr, int wc, int fr, int fq) const {
        const int row0 = u.pm * 256 + wr * 64 + fr;
#pragma unroll
        for (int bj = 0; bj < 2; ++bj) {
            const int c0 = u.pn * 256 + bj * 128 + wc * 32 + 8 * fq;
            const pg8::f32x4 b0 = *(const pg8::f32x4*)(bo + c0), b1 = *(const pg8::f32x4*)(bo + c0 + 4);
#pragma unroll
            for (int ai = 0; ai < 2; ++ai) {
                const int bb = (u.pm * 256 + ai * 128) >> 13;
                const pg8::f32x4 g0 = *(const pg8::f32x4*)(mod + bb * 6144 + 2048 + c0) + 1.0f, g1 = *(const pg8::f32x4*)(mod + bb * 6144 + 2048 + c0 + 4) + 1.0f;
#pragma unroll
                for (int m = 0; m < 4; ++m) {
                    const int row = row0 + ai * 128 + m * 16;
                    const pg8::f32x4 x0 = *(const pg8::f32x4*)(x + (size_t)row * DM + c0), x1 = *(const pg8::f32x4*)(x + (size_t)row * DM + c0 + 4);
                    const pg8::f32x4 v0 = x0 * ALPHA + g0 * (acc[ai][bj][m][0] + b0), v1 = x1 * ALPHA + g1 * (acc[ai][bj][m][1] + b1);
                    v4u o; o.x = pk2(v0.x, v0.y); o.y = pk2(v0.z, v0.w); o.z = pk2(v1.x, v1.y); o.w = pk2(v1.z, v1.w);
                    *(v4u*)(Y1 + (size_t)row * DM + c0) = o;
                }
            }
        }
    }
};
__device__ __forceinline__ void ph_fft(const Params& p, LAS unsigned char* lds, int bid, int nblk) {
    const int tid = opaque_tid(), lane = tid & 63, wave = __builtin_amdgcn_readfirstlane(tid >> 6), lr = lane & 15, lq = lane >> 4;
    bf16* MIX = (bf16*)(p.ws + WS_XN);
    for (int item = bid; item < 256; item += nblk) {
        const int b = item >> 7, cg = item & 127;
        const unsigned long long* src = (const unsigned long long*)(p.ws + WS_FZ) + (size_t)(b * 128 + cg) * 8192;
#pragma unroll 4
        for (int i = 0; i < 16; ++i) {
            const int q = i * 512 + tid; const int n2 = (q & 7) | (((q >> 6) & 15) << 3), n1 = ((q >> 3) & 7) | (((q >> 10) & 7) << 3);
            const unsigned long long v = src[128 * n1 + n2];
            *(LAS unsigned*)(lds + (2 * n2) * 288 + 4 * n1) = (unsigned)v; *(LAS unsigned*)(lds + (2 * n2 + 1) * 288 + 4 * n1) = (unsigned)(v >> 32);
        }
        bf16x8_t af[4];
        { const int m = 16 * wave + lr, k1 = m >> 1, ri = m & 1;
#pragma unroll
          for (int ks = 0; ks < 4; ++ks)
#pragma unroll
              for (int jj = 0; jj < 4; ++jj) { const int n1 = 16 * ks + 4 * lq + jj; const float x = (float)((n1 * k1) & 63) * (1.0f / 64.0f);
                  const float c = __builtin_amdgcn_cosf(x), s = __builtin_amdgcn_sinf(x);
                  af[ks][2 * jj] = (short)f2bf(ri ? -s : c); af[ks][2 * jj + 1] = (short)f2bf(ri ? c : s); } }
        __syncthreads();
        pg8::f32x4 acc[16];
#pragma unroll
        for (int nt = 0; nt < 16; ++nt) { acc[nt] = (pg8::f32x4){0.f, 0.f, 0.f, 0.f};
#pragma unroll
            for (int ks = 0; ks < 4; ++ks) { const bf16x8_t bf = *(const LAS bf16x8_t*)(lds + (16 * nt + lr) * 288 + (32 * ks + 8 * lq) * 2);
                acc[nt] = __builtin_amdgcn_mfma_f32_16x16x32_bf16(af[ks], bf, acc[nt], 0, 0, 0); } }
        __syncthreads();
#pragma unroll
        for (int nt = 0; nt < 16; ++nt) { const int col = 16 * nt + lr, n2 = col >> 1, ch = col & 1;
#pragma unroll
            for (int h = 0; h < 2; ++h) { const int k1 = 8 * wave + 2 * lq + h; const float yr = acc[nt][2 * h], yi = acc[nt][2 * h + 1];
                const float x = (float)((n2 * k1) & 8191) * (1.0f / 8192.0f); const float c = __builtin_amdgcn_cosf(x), s = __builtin_amdgcn_sinf(x);
                *(LAS unsigned*)(lds + (2 * k1 + ch) * 544 + 4 * n2) = pk2(yr * c + yi * s, yi * c - yr * s); } }
        bf16x8_t a2[8];
        { const int k2 = 16 * wave + lr;
#pragma unroll
          for (int ks = 0; ks < 8; ++ks)
#pragma unroll
              for (int jj = 0; jj < 4; ++jj) { const int n2 = 16 * ks + 4 * lq + jj; const float x = (float)((n2 * k2) & 127) * (1.0f / 128.0f);
                  a2[ks][2 * jj] = (short)f2bf(__builtin_amdgcn_cosf(x)); a2[ks][2 * jj + 1] = (short)f2bf(__builtin_amdgcn_sinf(x)); } }
        __syncthreads();
        pg8::f32x4 o[8];
#pragma unroll
        for (int nt = 0; nt < 8; ++nt) { o[nt] = (pg8::f32x4){0.f, 0.f, 0.f, 0.f};
#pragma unroll
            for (int ks = 0; ks < 8; ++ks) { const bf16x8_t bf = *(const LAS bf16x8_t*)(lds + (16 * nt + lr) * 544 + (32 * ks + 8 * lq) * 2);
                o[nt] = __builtin_amdgcn_mfma_f32_16x16x32_bf16(a2[ks], bf, o[nt], 0, 0, 0); } }
#pragma unroll
        for (int nt = 0; nt < 8; ++nt) { const int col2 = 16 * nt + lr, k1 = col2 >> 1, ch = col2 & 1;
#pragma unroll
            for (int r = 0; r < 4; ++r) { const float v = o[nt][r]; const float w = __shfl_xor(v, 1); const int k2 = 16 * wave + 4 * lq + r;
                if (ch == 0) *(unsigned*)(MIX + ((size_t)b * SEQ + k1 + 64 * k2) * DM + 2 * cg) = pk2(v, w); } }
        __syncthreads();
    }
}


struct EpiIn {
    static constexpr bool PERM = true, AFTER_DRAIN = false;
    bf16* FZ; bf16* QKV; const float* bias; const float* rope;
    __device__ __forceinline__ void operator()(const pg8::f32x4 (&acc)[2][2][4][2], const pg8::Unit& u, int wr, int wc, int fr, int fq) const {
        const int row0 = u.pm * 256 + wr * 64 + fr;
#pragma unroll
        for (int bj = 0; bj < 2; ++bj) {
            const int c0 = u.pn * 256 + bj * 128 + wc * 32 + 8 * fq;
            const pg8::f32x4 b0 = *(const pg8::f32x4*)(bias + c0), b1 = *(const pg8::f32x4*)(bias + c0 + 4);
#pragma unroll
            for (int ai = 0; ai < 2; ++ai)
#pragma unroll
                for (int m = 0; m < 4; ++m) {
                    const int row = row0 + ai * 128 + m * 16;
                    pg8::f32x4 v0 = acc[ai][bj][m][0] + b0, v1 = acc[ai][bj][m][1] + b1;
                    if (u.pn < 2) {
                        const int b = row >> 13, s = row & 8191, cgp = c0 >> 2;
                        unsigned long long* d0 = (unsigned long long*)(FZ + (((size_t)(b * 128 + cgp) * 8192 + s) << 2));
                        d0[0] = (unsigned long long)pk2(v0.x, v0.y) | ((unsigned long long)pk2(v0.z, v0.w) << 32);
                        d0[8192] = (unsigned long long)pk2(v1.x, v1.y) | ((unsigned long long)pk2(v1.z, v1.w) << 32);
                    } else {
                        const int cq = c0 - 512, which = cq / 768, off = cq - which * 768;
                        if (which < 2) {
                            const float sc = which == 0 ? QSCALE : 1.0f;
                            const pg8::f32x4 r0 = *(const pg8::f32x4*)(rope + (size_t)row * 64 + (off & 63)), r1 = *(const pg8::f32x4*)(rope + (size_t)row * 64 + (off & 63) + 4);
                            pg8::f32x4 w0, w1;
                            w0.x = (v0.x * r0.x - v0.y * r0.y) * sc; w0.y = (v0.y * r0.x + v0.x * r0.y) * sc; w0.z = (v0.z * r0.z - v0.w * r0.w) * sc; w0.w = (v0.w * r0.z + v0.z * r0.w) * sc;
                            w1.x = (v1.x * r1.x - v1.y * r1.y) * sc; w1.y = (v1.y * r1.x + v1.x * r1.y) * sc; w1.z = (v1.z * r1.z - v1.w * r1.w) * sc; w1.w = (v1.w * r1.z + v1.z * r1.w) * sc;
                            v0 = w0; v1 = w1;
                        }
                        v4u o; o.x = pk2(v0.x, v0.y); o.y = pk2(v0.z, v0.w); o.z = pk2(v1.x, v1.y); o.w = pk2(v1.z, v1.w);
                        *(v4u*)(QKV + (size_t)which * ((WS_KB - WS_QB) / 2) + (size_t)row * 768 + off) = o;
                    }
                }
        }
    }
};

typedef float f32x16 __attribute__((ext_vector_type(16)));
typedef short s16x4 __attribute__((ext_vector_type(4)));
__device__ __forceinline__ int crow(int r, int hi) { return (r & 3) + 8 * (r >> 2) + 4 * hi; }
__device__ __forceinline__ s16x4 vtr(const LAS unsigned char* p) { return __builtin_bit_cast(s16x4, __builtin_amdgcn_ds_read_tr16_b64_v4i16((LAS s16x4*)p)); }
__device__ __forceinline__ unsigned cvtpk(float lo, float hi) { typedef float f2 __attribute__((ext_vector_type(2))); typedef __bf16 b2 __attribute__((ext_vector_type(2))); f2 v = {lo, hi}; b2 r = __builtin_convertvector(v, b2); return __builtin_bit_cast(unsigned, r); }
__device__ __forceinline__ void tbl_load(const Params& p, int r, f32x4 (&a)[4], int lane) {
    const bool isv = r >= 16384; const int row = isv ? r - 16384 : r;
    const f32x4* src = (const f32x4*)((isv ? p.pv : p.pu) + (size_t)row * DM + 16 * lane);
#pragma unroll
    for (int j = 0; j < 4; ++j) a[j] = src[j];
}
__device__ __forceinline__ void tbl_finish(const Params& p, int r, const f32x4 (&a)[4], int lane) {
    const bool isv = r >= 16384; const int row = isv ? r - 16384 : r;
    float amax = 0.f;
#pragma unroll
    for (int j = 0; j < 4; ++j) amax = fmaxf(amax, fmaxf(fmaxf(fabsf(a[j].x), fabsf(a[j].y)), fmaxf(fabsf(a[j].z), fabsf(a[j].w))));
    amax = wave_max(amax);
    const float inv = amax > 0.f ? 127.0f / amax : 0.f;
    v4u o;
#pragma unroll
    for (int j = 0; j < 4; ++j) { unsigned q = 0u;
        q = __builtin_amdgcn_cvt_pk_u8_f32(a[j].x * inv + 128.0f, 0, q); q = __builtin_amdgcn_cvt_pk_u8_f32(a[j].y * inv + 128.0f, 1, q);
        q = __builtin_amdgcn_cvt_pk_u8_f32(a[j].z * inv + 128.0f, 2, q); q = __builtin_amdgcn_cvt_pk_u8_f32(a[j].w * inv + 128.0f, 3, q);
        o[j] = q ^ 0x80808080u; }
    *(v4u*)(p.ws + (isv ? WS_TV8 : WS_TU8) + (size_t)(lane >> 3) * (2 * MiB) + (size_t)row * 128 + 16 * (lane & 7)) = o;
    if (lane == 0) ((float*)(p.ws + (isv ? WS_SV : WS_SU)))[row] = amax * (1.0f / 127.0f);
}
struct AttnDesc { int dil, ntile, res, cb, r; size_t rowb; int h; bool valid; };
__device__ __forceinline__ AttnDesc attn_desc(int bi) {
    AttnDesc d; d.valid = bi < 3 * 768; const int b2 = d.valid ? bi : 0;
    const int r = b2 / 768, rem = b2 - r * 768, bh = rem >> 5, q32 = rem & 31, b = bh / 12;
    d.r = r; d.h = bh - b * 12; d.rowb = (size_t)b * SEQ;
    const int ld = 2 * r;
    d.dil = 1 << ld; d.ntile = 256 >> ld; d.res = q32 >> (5 - ld); d.cb = q32 & ((32 >> ld) - 1);
    return d;
}
__device__ __forceinline__ void attn_dma(const AttnDesc& d, const bf16* T, bool swz, LAS unsigned char* img, int wave, int lane) {
#pragma unroll
    for (int i = 0; i < 6; ++i) {
        const int idx = wave * 6 + i, j = idx >> 2, it = idx & 3, kt = 8 * d.cb - 2 + j;
        if (kt >= 0 && kt < d.ntile) {
            const int row = it * 8 + (lane >> 3), ch = lane & 7; const int gch = swz ? (ch ^ ((row >> 1) & 7)) : ch;
            const bf16* src = T + (d.rowb + d.res + d.dil * (32 * kt + row)) * 768 + d.h * 64 + 8 * gch;
            __builtin_amdgcn_global_load_lds((const unsigned*)src, (LAS unsigned*)(img + j * 4096 + it * 1024), 16, 0, 0);
        }
    }
}
__device__ __forceinline__ void attn_qload(const AttnDesc& d, const bf16* QB, bf16x8_t (&qf)[4], int wave, int lane) {
    const bf16* qp = QB + (d.rowb + d.res + d.dil * (32 * (8 * d.cb + wave) + (lane & 31))) * 768 + d.h * 64 + 8 * (lane >> 5);
#pragma unroll
    for (int d0 = 0; d0 < 4; ++d0) qf[d0] = *(const bf16x8_t*)(qp + 16 * d0);
}
#define ATT_SYNC() do { asm volatile("s_waitcnt vmcnt(0) lgkmcnt(0)" ::: "memory"); __builtin_amdgcn_s_barrier(); asm volatile("" ::: "memory"); } while (0)
__device__ __forceinline__ void ph_attn_fast(const Params& p, LAS unsigned char* lds, int bid, int nblk) {
    const int lane = opaque_tid() & 63, wave = wave_id(), r32 = lane & 31, hi = lane >> 5;
    LAS unsigned char* imgK = lds; LAS unsigned char* imgV = lds + 49152; LAS unsigned char* stgb = lds + 98304 + wave * 4096;
    const bf16* QB = (const bf16*)(p.ws + WS_QB); const bf16* KB = (const bf16*)(p.ws + WS_KB); const bf16* VB = (const bf16*)(p.ws + WS_VB);
    const int vb = (nblk & 7) == 0 ? (bid & 7) * (nblk >> 3) + (bid >> 3) : bid;
    int bi = vb;
    AttnDesc d = attn_desc(bi);
    bf16x8_t qf[4];
    if (d.valid) { attn_dma(d, KB, true, imgK, wave, lane); attn_qload(d, QB, qf, wave, lane); }
    ATT_SYNC();
    const int g = lane >> 4, ii = lane & 15;
    const int vb0 = (4 * hi + (ii >> 2)) * 128 + (g & 1) * 32 + (ii & 3) * 8;
    int trow = bid * NWAVES + wave; const int tstride = nblk * NWAVES;
    f32x4 ta[4];
    while (d.valid) {
        asm volatile("" : "+v"(qf[0]), "+v"(qf[1]), "+v"(qf[2]), "+v"(qf[3]));
        attn_dma(d, VB, false, imgV, wave, lane);
        const bool tb1 = trow < 32768; if (tb1) tbl_load(p, trow, ta, lane);
        const int c = 8 * d.cb + wave;
        f32x16 S[5];
#pragma unroll
        for (int u = 0; u < 5; ++u) {
            const int kt = c - 2 + u;
#pragma unroll
            for (int r = 0; r < 16; ++r) S[u][r] = -1e30f;
            if (kt >= 0 && kt < d.ntile) {
                const LAS unsigned char* slot = imgK + (wave + u) * 4096;
                f32x16 a = {0.f, 0.f, 0.f, 0.f, 0.f, 0.f, 0.f, 0.f, 0.f, 0.f, 0.f, 0.f, 0.f, 0.f, 0.f, 0.f};
#pragma unroll
                for (int d0 = 0; d0 < 4; ++d0) { const bf16x8_t kf = *(const LAS bf16x8_t*)(slot + r32 * 128 + (((2 * d0 + hi) ^ ((r32 >> 1) & 7)) << 4));
                    a = __builtin_amdgcn_mfma_f32_32x32x16_bf16(kf, qf[d0], a, 0, 0, 0); }
                S[u] = a;
            }
        }
#pragma unroll
        for (int r = 0; r < 16; ++r) { const int kk = crow(r, hi); if (kk < r32) S[0][r] = -1e30f; if (kk > r32) S[4][r] = -1e30f; }
        float m = -1e30f;
#pragma unroll
        for (int u = 0; u < 5; ++u)
#pragma unroll
            for (int r = 0; r < 16; ++r) m = fmaxf(m, S[u][r]);
        m = fmaxf(m, __shfl_xor(m, 32));
        float l = 0.f;
        unsigned Pk[5][8];
#pragma unroll
        for (int u = 0; u < 5; ++u)
#pragma unroll
            for (int r = 0; r < 16; r += 2) { const float e0 = __builtin_amdgcn_exp2f(S[u][r] - m), e1 = __builtin_amdgcn_exp2f(S[u][r + 1] - m); l += e0 + e1; Pk[u][r >> 1] = cvtpk(e0, e1); }
        l += __shfl_xor(l, 32);
        if (tb1) { tbl_finish(p, trow, ta, lane); trow += tstride; }
        ATT_SYNC();
        const AttnDesc dn = attn_desc(bi + nblk);
        if (dn.valid) { attn_dma(dn, KB, true, imgK, wave, lane); attn_qload(dn, QB, qf, wave, lane); }
        const bool tb2 = trow < 32768; if (tb2) tbl_load(p, trow, ta, lane);
        f32x16 o[2];
#pragma unroll
        for (int db = 0; db < 2; ++db)
#pragma unroll
            for (int r = 0; r < 16; ++r) o[db][r] = 0.f;
#pragma unroll
        for (int u = 0; u < 5; ++u) {
            const int kt = c - 2 + u;
            if (kt >= 0 && kt < d.ntile) {
                const LAS unsigned char* slot = imgV + (wave + u) * 4096;
#pragma unroll
                for (int s = 0; s < 2; ++s) {
                    bf16x8_t pa;
                    { v4u w; w.x = Pk[u][4 * s + 0]; w.y = Pk[u][4 * s + 1]; w.z = Pk[u][4 * s + 2]; w.w = Pk[u][4 * s + 3]; pa = __builtin_bit_cast(bf16x8_t, w); }
#pragma unroll
                    for (int db = 0; db < 2; ++db) {
                        const s16x4 lo = vtr(slot + vb0 + s * 2048 + db * 64), hh = vtr(slot + vb0 + s * 2048 + 1024 + db * 64);
                        const bf16x8_t vf = {lo[0], lo[1], lo[2], lo[3], hh[0], hh[1], hh[2], hh[3]};
                        o[db] = __builtin_amdgcn_mfma_f32_32x32x16_bf16(pa, vf, o[db], 0, 0, 0);
                    }
                }
            }
        }
        bf16* OB = d.r == 2 ? (bf16*)(p.ws + WS_O3) : (bf16*)p.out + (size_t)d.r * NT * 768;
        float* LSE = (float*)(p.ws + WS_LSE) + (size_t)d.r * NT * 12;
        const float linv = 1.0f / l;
        LAS unsigned short* stg = (LAS unsigned short*)stgb;
#pragma unroll
        for (int r = 0; r < 16; ++r) { const int q = crow(r, hi); const float li = __shfl(linv, q);
#pragma unroll
            for (int db = 0; db < 2; ++db) stg[q * 64 + db * 32 + r32] = (unsigned short)f2bf(o[db][r] * li); }
        int ln2 = lane; asm volatile("" : "+v"(ln2));
#pragma unroll
        for (int i4 = 0; i4 < 4; ++i4) { const int row = i4 * 8 + (ln2 >> 3), ch = ln2 & 7;
            const v4u val = *(const LAS v4u*)((LAS unsigned char*)stg + row * 128 + ch * 16);
            *(v4u*)(OB + (d.rowb + d.res + d.dil * (32 * c + row)) * 768 + d.h * 64 + 8 * ch) = val; }
        if (ln2 < 32) LSE[(d.rowb + d.res + d.dil * (32 * c + ln2)) * 12 + d.h] = m + __builtin_amdgcn_logf(l);
        if (tb2) { tbl_finish(p, trow, ta, lane); trow += tstride; }
        ATT_SYNC();
        d = dn; bi += nblk;
    }
    for (; trow < 32768; trow += tstride) { tbl_load(p, trow, ta, lane); tbl_finish(p, trow, ta, lane); }
}
__device__ __forceinline__ void ph_merge(const Params& p, int bid, int nblk) {
    const bf16* O1 = (const bf16*)p.out; const bf16* O2 = O1 + (size_t)NT * 768; const bf16* O3 = (const bf16*)(p.ws + WS_O3);
    const float* L1 = (const float*)(p.ws + WS_LSE); const float* L2 = L1 + (size_t)NT * 12; const float* L3 = L2 + (size_t)NT * 12; bf16* MIX = (bf16*)(p.ws + WS_XN);
    for (int idx = bid * NTHREADS + opaque_tid(); idx < NT * 96; idx += nblk * NTHREADS) {
        const int t = idx / 96, rem = idx - t * 96, h = rem >> 3, ch = rem & 7;
        const float l1 = L1[t * 12 + h], l2 = L2[t * 12 + h], l3 = L3[t * 12 + h]; const float mx = fmaxf(fmaxf(l1, l2), l3);
        float w1 = __builtin_amdgcn_exp2f(l1 - mx), w2 = __builtin_amdgcn_exp2f(l2 - mx), w3 = __builtin_amdgcn_exp2f(l3 - mx); const float inv = 1.0f / (w1 + w2 + w3); w1 *= inv; w2 *= inv; w3 *= inv;
        const size_t off = (size_t)t * 768 + h * 64 + 8 * ch;
        const v4u a = *(const v4u*)(O1 + off), bq = *(const v4u*)(O2 + off), cq = *(const v4u*)(O3 + off);
        v4u o;
        o.x = pk2(w1 * bflo(a.x) + w2 * bflo(bq.x) + w3 * bflo(cq.x), w1 * bfhi(a.x) + w2 * bfhi(bq.x) + w3 * bfhi(cq.x));
        o.y = pk2(w1 * bflo(a.y) + w2 * bflo(bq.y) + w3 * bflo(cq.y), w1 * bfhi(a.y) + w2 * bfhi(bq.y) + w3 * bfhi(cq.y));
        o.z = pk2(w1 * bflo(a.z) + w2 * bflo(bq.z) + w3 * bflo(cq.z), w1 * bfhi(a.z) + w2 * bfhi(bq.z) + w3 * bfhi(cq.z));
        o.w = pk2(w1 * bflo(a.w) + w2 * bflo(bq.w) + w3 * bflo(cq.w), w1 * bfhi(a.w) + w2 * bfhi(bq.w) + w3 * bfhi(cq.w));
        *(v4u*)(MIX + (size_t)t * DM + 256 + h * 64 + 8 * ch) = o;
    }
}


__device__ __forceinline__ unsigned fkey(float s, unsigned low, unsigned mask) { unsigned u = __builtin_bit_cast(unsigned, s); u = (u & 0x80000000u) ? ~u : (u | 0x80000000u); return (u & ~mask) | low; }
__device__ __forceinline__ float fdec(unsigned k, unsigned mask) { unsigned u = (k & ~mask) | (mask >> 1); u = (u & 0x80000000u) ? (u ^ 0x80000000u) : ~u; return __builtin_bit_cast(float, u); }
#define CE_DESC(a, b) do { const unsigned _mx = (a) > (b) ? (a) : (b), _mn = (a) > (b) ? (b) : (a); (a) = _mx; (b) = _mn; } while (0)
__device__ __forceinline__ void sort16_desc(unsigned (&a)[16]) {
#pragma unroll
    for (int k = 2; k <= 16; k <<= 1)
#pragma unroll
        for (int j = k >> 1; j > 0; j >>= 1)
#pragma unroll
            for (int i = 0; i < 16; ++i) { const int l = i ^ j; if (l > i) { if ((i & k) == 0) CE_DESC(a[i], a[l]); else CE_DESC(a[l], a[i]); } }
}
__device__ __forceinline__ void merge16_desc(unsigned (&c)[16]) {
#pragma unroll
    for (int j = 8; j > 0; j >>= 1)
#pragma unroll
        for (int i = 0; i < 16; ++i) { const int l = i ^ j; if (l > i) CE_DESC(c[i], c[l]); }
}
__device__ __forceinline__ void top16_merge(unsigned (&a)[16], const unsigned (&b)[16]) {
#pragma unroll
    for (int i = 0; i < 16; ++i) a[i] = a[i] > b[15 - i] ? a[i] : b[15 - i];
    merge16_desc(a);
}
__device__ __forceinline__ void top16_of_64(unsigned (&g0)[16], unsigned (&g1)[16], unsigned (&g2)[16], unsigned (&g3)[16]) {
    sort16_desc(g0); sort16_desc(g1); sort16_desc(g2); sort16_desc(g3);
    top16_merge(g0, g1); top16_merge(g2, g3); top16_merge(g0, g2);
}
__host__ __device__ constexpr int stair_slot(int i, int j) { int n = 0; for (int a = 0; a < 16; ++a) for (int b = 0; b < 16; ++b) if ((a + 1) * (b + 1) <= 16) { if (a == i && b == j) return n; ++n; } return n; }
__device__ __forceinline__ void ph_topk_fast(const Params& p, LAS unsigned char* lds, int bid, int nblk) {
    const int lane = opaque_tid() & 63, wave = wave_id(), r32 = lane & 31, hi = lane >> 5;
    const bf16* PQ = (const bf16*)(p.ws + WS_PQ); const bf16* SK = (const bf16*)(p.ws + WS_SUBK);
    unsigned short* ids = (unsigned short*)(p.ws + WS_IDS); float* gates = (float*)(p.ws + WS_GATES); float* sua = (float*)(p.ws + WS_SUA);
    const float* SUt = (const float*)(p.ws + WS_SU); const float* SVt = (const float*)(p.ws + WS_SV);
    LAS unsigned* myl = (LAS unsigned*)(lds + wave * 16384 + lane * 128);
    for (int it = bid * NWAVES + wave; it < (NT / 32) * 8; it += nblk * NWAVES) {
        const int tt = it >> 3, h = it & 7, t = tt * 32 + r32;
        unsigned K[2][16];
#pragma unroll
        for (int pp = 0; pp < 2; ++pp) {
            bf16x8_t qf[4];
            { const bf16* qp = PQ + (size_t)t * DM + h * 128 + pp * 64 + 8 * hi;
#pragma unroll
              for (int d0 = 0; d0 < 4; ++d0) qf[d0] = *(const bf16x8_t*)(qp + 16 * d0); }
            unsigned g[4][16];
#pragma unroll
            for (int mt = 0; mt < 4; ++mt) {
                const bf16* kp = SK + ((size_t)((h * 2 + pp) * 4 + mt) * 4 * 64 + lane) * 8;
                f32x16 a = {0.f, 0.f, 0.f, 0.f, 0.f, 0.f, 0.f, 0.f, 0.f, 0.f, 0.f, 0.f, 0.f, 0.f, 0.f, 0.f};
#pragma unroll
                for (int d0 = 0; d0 < 4; ++d0) a = __builtin_amdgcn_mfma_f32_32x32x16_bf16(*(const bf16x8_t*)(kp + d0 * 512), qf[d0], a, 0, 0, 0);
#pragma unroll
                for (int r = 0; r < 16; ++r) g[mt][r] = fkey(a[r], 127u - (unsigned)(32 * mt + crow(r, hi)), 127u);
            }
            top16_of_64(g[0], g[1], g[2], g[3]);
            unsigned o[16];
#pragma unroll
            for (int i = 0; i < 16; ++i) o[i] = (unsigned)__shfl_xor((int)g[0][i], 32);
            top16_merge(g[0], o);
#pragma unroll
            for (int i = 0; i < 16; ++i) K[pp][i] = g[0][i];
        }
#pragma unroll
        for (int i = 0; i < 16; ++i) { myl[i] = K[0][i]; myl[16 + i] = K[1][i]; }
        float v0[16], v1[16];
#pragma unroll
        for (int i = 0; i < 16; ++i) { v0[i] = fdec(K[0][i], 127u); v1[i] = fdec(K[1][i], 127u); }
        unsigned c[4][16];
#pragma unroll
        for (int gi = 0; gi < 4; ++gi)
#pragma unroll
            for (int q = 0; q < 16; ++q) c[gi][q] = 0u;
#pragma unroll
        for (int i = 0; i < 16; ++i)
#pragma unroll
            for (int j = 0; j < 16; ++j) if ((i + 1) * (j + 1) <= 16) { const int n = stair_slot(i, j); c[n >> 4][n & 15] = fkey(v0[i] + v1[j], 255u - (unsigned)(16 * i + j), 255u); }
        top16_of_64(c[0], c[1], c[2], c[3]);
        float e[16]; float sum = 0.f; const float mx = fdec(c[0][0], 255u);
#pragma unroll
        for (int r = 0; r < 16; ++r) { e[r] = __builtin_amdgcn_exp2f((fdec(c[0][r], 255u) - mx) * 1.4426950408889634f); sum += e[r]; }
        const float inv = 1.0f / sum;
        int eid[16];
#pragma unroll
        for (int r = 0; r < 16; ++r) { const unsigned id8 = 255u - (c[0][r] & 255u); const unsigned k0 = myl[id8 >> 4], k1 = myl[16 + (id8 & 15)];
            eid[r] = (int)((127u - (k0 & 127u)) * 128u + (127u - (k1 & 127u))); }
        if (hi == 0) {
#pragma unroll
            for (int q = 0; q < 2; ++q) *(v4u*)(ids + (size_t)t * 128 + h * 16 + 8 * q) = (v4u){(unsigned)eid[8 * q] | ((unsigned)eid[8 * q + 1] << 16), (unsigned)eid[8 * q + 2] | ((unsigned)eid[8 * q + 3] << 16),
                                                                                      (unsigned)eid[8 * q + 4] | ((unsigned)eid[8 * q + 5] << 16), (unsigned)eid[8 * q + 6] | ((unsigned)eid[8 * q + 7] << 16)};
#pragma unroll
            for (int q = 0; q < 4; ++q) *(f32x4*)(sua + (size_t)t * 128 + h * 16 + 4 * q) = (f32x4){SUt[eid[4 * q]], SUt[eid[4 * q + 1]], SUt[eid[4 * q + 2]], SUt[eid[4 * q + 3]]};
        } else {
#pragma unroll
            for (int q = 0; q < 4; ++q) *(f32x4*)(gates + (size_t)t * 128 + h * 16 + 4 * q) = (f32x4){e[4 * q] * inv * SVt[eid[4 * q]], e[4 * q + 1] * inv * SVt[eid[4 * q + 1]], e[4 * q + 2] * inv * SVt[eid[4 * q + 2]], e[4 * q + 3] * inv * SVt[eid[4 * q + 3]]};
        }
    }
}

__device__ __forceinline__ void ph_ln1_fast(const Params& p, int bid, int nblk) {
    const bf16* y1 = (const bf16*)(p.ws + WS_Y1); bf16* x1 = (bf16*)(p.ws + WS_X1); bf16* h2b = (bf16*)(p.ws + WS_XN); const float* mod = (const float*)(p.ws + WS_MOD);
    const int lane = opaque_tid() & 63, wave = wave_id();
    for (int row = bid * NWAVES + wave; row < NT; row += nblk * NWAVES) {
        const int b = row / SEQ;
        const v2u* yr = (const v2u*)(y1 + (size_t)row * DM) + lane;
        f32x4 v[4]; float s = 0.f;
#pragma unroll
        for (int j = 0; j < 4; ++j) { const v2u w = yr[64 * j]; v[j] = (f32x4){bflo(w.x), bfhi(w.x), bflo(w.y), bfhi(w.y)}; s += (v[j].x + v[j].y) + (v[j].z + v[j].w); }
        float mean = wave_sum(s) * (1.f / DM); float s2 = 0.f;
#pragma unroll
        for (int j = 0; j < 4; ++j) { v[j] = v[j] - mean; s2 += (v[j].x * v[j].x + v[j].y * v[j].y) + (v[j].z * v[j].z + v[j].w * v[j].w); }
        float rstd = rsqrtf(wave_sum(s2) * (1.f / DM) + LN_EPS);
        s = 0.f;
#pragma unroll
        for (int j = 0; j < 4; ++j) { const f32x4 g = *((const f32x4*)p.g1 + lane + 64 * j), be = *((const f32x4*)p.be1 + lane + 64 * j);
            v[j] = v[j] * rstd * g + be; *((v2u*)(x1 + (size_t)row * DM) + lane + 64 * j) = (v2u){pk2(v[j].x, v[j].y), pk2(v[j].z, v[j].w)}; s += (v[j].x + v[j].y) + (v[j].z + v[j].w); }
        mean = wave_sum(s) * (1.f / DM); s2 = 0.f;
#pragma unroll
        for (int j = 0; j < 4; ++j) { v[j] = v[j] - mean; s2 += (v[j].x * v[j].x + v[j].y * v[j].y) + (v[j].z * v[j].z + v[j].w * v[j].w); }
        rstd = rsqrtf(wave_sum(s2) * (1.f / DM) + LN_EPS);
        float amax = 0.f;
#pragma unroll
        for (int j = 0; j < 4; ++j) {
            const f32x4 sh = *((const f32x4*)(mod + b * 6144 + 3072) + lane + 64 * j), sc = *((const f32x4*)(mod + b * 6144 + 4096) + lane + 64 * j);
            const f32x4 o = v[j] * rstd * (1.0f + sc) + sh; v[j] = o;
            amax = fmaxf(amax, fmaxf(fmaxf(fabsf(o.x), fabsf(o.y)), fmaxf(fabsf(o.z), fabsf(o.w))));
            *((v2u*)(h2b + (size_t)row * DM) + lane + 64 * j) = (v2u){pk2(o.x, o.y), pk2(o.z, o.w)};
        }
        amax = wave_max(amax); const float hinv = amax > 0.f ? 127.0f / amax : 0.f;
        unsigned* q4 = (unsigned*)(p.ws + WS_H2Q + (size_t)row * DM) + lane;
#pragma unroll
        for (int j = 0; j < 4; ++j) { unsigned q = 0u;
            q = __builtin_amdgcn_cvt_pk_u8_f32(v[j].x * hinv + 128.0f, 0, q); q = __builtin_amdgcn_cvt_pk_u8_f32(v[j].y * hinv + 128.0f, 1, q);
            q = __builtin_amdgcn_cvt_pk_u8_f32(v[j].z * hinv + 128.0f, 2, q); q = __builtin_amdgcn_cvt_pk_u8_f32(v[j].w * hinv + 128.0f, 3, q);
            q4[64 * j] = q ^ 0x80808080u; }
        if (lane == 0) ((float*)(p.ws + WS_HS))[row] = amax * (1.0f / 127.0f);
    }
}
__device__ __forceinline__ void ph_tables8(const Params& p, int bid, int nblk) {
    const int lane = opaque_tid() & 63, wave = wave_id();
    for (int r = bid * NWAVES + wave; r < 2 * 16384; r += nblk * NWAVES) {
        const bool isv = r >= 16384; const int row = isv ? r - 16384 : r;
        const f32x4* src = (const f32x4*)((isv ? p.pv : p.pu) + (size_t)row * DM + 16 * lane);
        f32x4 a[4]; float amax = 0.f;
#pragma unroll
        for (int j = 0; j < 4; ++j) { a[j] = src[j]; amax = fmaxf(amax, fmaxf(fmaxf(fabsf(a[j].x), fabsf(a[j].y)), fmaxf(fabsf(a[j].z), fabsf(a[j].w)))); }
        amax = wave_max(amax);
        const float inv = amax > 0.f ? 127.0f / amax : 0.f;
        v4u o;
#pragma unroll
        for (int j = 0; j < 4; ++j) { unsigned q = 0u;
            q = __builtin_amdgcn_cvt_pk_u8_f32(a[j].x * inv + 128.0f, 0, q); q = __builtin_amdgcn_cvt_pk_u8_f32(a[j].y * inv + 128.0f, 1, q);
            q = __builtin_amdgcn_cvt_pk_u8_f32(a[j].z * inv + 128.0f, 2, q); q = __builtin_amdgcn_cvt_pk_u8_f32(a[j].w * inv + 128.0f, 3, q);
            o[j] = q ^ 0x80808080u; }
        *(v4u*)(p.ws + (isv ? WS_TV8 : WS_TU8) + (size_t)(lane >> 3) * (2 * MiB) + (size_t)row * 128 + 16 * (lane & 7)) = o;
        if (lane == 0) ((float*)(p.ws + (isv ? WS_SV : WS_SU)))[row] = amax * (1.0f / 127.0f);
    }
}
__device__ __forceinline__ float readlane_f(float v, int l) { return __builtin_bit_cast(float, __builtin_amdgcn_readlane(__builtin_bit_cast(int, v), l)); }
__device__ __forceinline__ float ub0(unsigned u) { return (float)(u & 255u); }
__device__ __forceinline__ float ub1(unsigned u) { return (float)((u >> 8) & 255u); }
__device__ __forceinline__ float ub2(unsigned u) { return (float)((u >> 16) & 255u); }
__device__ __forceinline__ float ub3(unsigned u) { return (float)(u >> 24); }
__device__ __forceinline__ v4u ust_meta(const Params& p, int step, int t0, int stride8, int lane) {
    const int g = step >> 4, k = step & 15; int t = t0 + g * stride8 + (lane >> 3); t = t < NT ? t : NT - 1;
    return *(const v4u*)(p.ws + WS_IDS + (size_t)t * 256 + 16 * k);
}
__device__ __forceinline__ void ust_issue(v4u (&ub)[8], const v4u& idq, const unsigned char* TUs) {
#pragma unroll
    for (int e = 0; e < 8; ++e) { const unsigned w = idq[e >> 1]; const unsigned id = (e & 1) ? (w >> 16) : (w & 0xffffu); ub[e] = *(const v4u*)(TUs + (size_t)id * 128); }
}
__device__ __forceinline__ int ust_compute(const v4u (&ub)[8], const v4u& hq, int lane) {
    int a[8];
#pragma unroll
    for (int e = 0; e < 8; ++e) { int v = __builtin_amdgcn_sdot4((int)ub[e].x, (int)hq.x, 0, false); v = __builtin_amdgcn_sdot4((int)ub[e].y, (int)hq.y, v, false);
        v = __builtin_amdgcn_sdot4((int)ub[e].z, (int)hq.z, v, false); a[e] = __builtin_amdgcn_sdot4((int)ub[e].w, (int)hq.w, v, false); }
    int a4[4];
#pragma unroll
    for (int k = 0; k < 4; ++k) { const bool up = (lane & 4) != 0; const int keep = up ? a[k + 4] : a[k], send = up ? a[k] : a[k + 4]; a4[k] = keep + __shfl_xor(send, 4); }
    int a2[2];
#pragma unroll
    for (int k = 0; k < 2; ++k) { const bool up = (lane & 2) != 0; const int keep = up ? a4[k + 2] : a4[k], send = up ? a4[k] : a4[k + 2]; a2[k] = keep + __shfl_xor(send, 2); }
    const bool up = (lane & 1) != 0; const int keep = up ? a2[1] : a2[0], send = up ? a2[0] : a2[1];
    return keep + __shfl_xor(send, 1);
}
__device__ __forceinline__ void ph_udot(const Params& p, int bid, int nblk) {
    short* P = (short*)(p.ws + WS_PART);
    const int lane = opaque_tid() & 63, wave = wave_id(), c = lane & 7;
    const int s = bid & 7, nper = (nblk - s + 7) >> 3,     stride8 = nper * NWAVES * 8;
    const unsigned char* TUs = p.ws + WS_TU8 + (size_t)s * (2 * MiB) + 16 * c;
    const int t0 = ((bid >> 3) * NWAVES + wave) * 8;
    const int ngroups = t0 < NT ? (NT - t0 + stride8 - 1) / stride8 : 0, nsteps = ngroups * 16;
    if (nsteps == 0) return;
    v4u uA[8], uB[8];
    v4u qa = ust_meta(p, 0, t0, stride8, lane);
    ust_issue(uA, qa, TUs);
    v4u qb = ust_meta(p, 1, t0, stride8, lane);
    v4u hq = {0u, 0u, 0u, 0u};
    for (int st = 0; st < nsteps; st += 2) {
        const int tg = t0 + (st >> 4) * stride8 + (lane >> 3); const int t = tg < NT ? tg : NT - 1;
        if ((st & 15) == 0) hq = *(const v4u*)(p.ws + WS_H2Q + (size_t)t * DM + 128 * s + 16 * c);
        ust_issue(uB, qb, TUs);
        qa = ust_meta(p, st + 2 < nsteps ? st + 2 : st, t0, stride8, lane);
        const int ra = ust_compute(uA, hq, lane);
        if (st + 2 < nsteps) ust_issue(uA, qa, TUs);
        qb = ust_meta(p, st + 3 < nsteps ? st + 3 : st + 1, t0, stride8, lane);
        const int rb = ust_compute(uB, hq, lane);
        if (tg < NT) { short* dst = P + ((size_t)t * 8 + s) * 128 + 8 * (st & 15) + c; dst[0] = (short)((ra + 32) >> 6); dst[8] = (short)((rb + 32) >> 6); }
    }
}
__device__ __forceinline__ void ph_act(const Params& p, int bid, int nblk) {
    const short* P = (const short*)(p.ws + WS_PART); const float* SUA = (const float*)(p.ws + WS_SUA); const float* GS = (const float*)(p.ws + WS_GATES); const float* HS = (const float*)(p.ws + WS_HS);
    unsigned char* WQ = p.ws + WS_WQ; float* WSC = (float*)(p.ws + WS_WSC);
    const int lane = opaque_tid() & 63, wave = wave_id();
    for (int t = bid * NWAVES + wave; t < NT; t += nblk * NWAVES) {
        int a0 = 0, a1 = 0;
#pragma unroll
        for (int s = 0; s < 8; ++s) { a0 += P[((size_t)t * 8 + s) * 128 + lane]; a1 += P[((size_t)t * 8 + s) * 128 + 64 + lane]; }
        const float hs = HS[t] * 64.0f;
        const float d0 = (float)a0 * SUA[(size_t)t * 128 + lane] * hs, d1 = (float)a1 * SUA[(size_t)t * 128 + 64 + lane] * hs;
        const float w0 = GS[(size_t)t * 128 + lane] * 0.5f * d0 * (1.0f + erff(d0 * 0.70710678118654752f));
        const float w1 = GS[(size_t)t * 128 + 64 + lane] * 0.5f * d1 * (1.0f + erff(d1 * 0.70710678118654752f));
        const float wmax = wave_max(fmaxf(fabsf(w0), fabsf(w1))); const float winv = wmax > 0.f ? 127.0f / wmax : 0.f;
        unsigned b2 = __builtin_amdgcn_cvt_pk_u8_f32(w0 * winv + 128.0f, 0, 0u); b2 = __builtin_amdgcn_cvt_pk_u8_f32(w1 * winv + 128.0f, 1, b2); b2 ^= 0x8080u;
        WQ[(size_t)t * 128 + lane] = (unsigned char)(b2 & 255u); WQ[(size_t)t * 128 + 64 + lane] = (unsigned char)((b2 >> 8) & 255u);
        if (lane == 0) WSC[t] = wmax * (1.0f / 127.0f);
    }
}
struct VstepMeta { v4u idq; v2u wq; };
__device__ __forceinline__ VstepMeta vst_meta(const Params& p, int step, int t0, int stride8, int lane) {
    const int g = step >> 4, k = step & 15; int t = t0 + g * stride8 + (lane >> 3); t = t < NT ? t : NT - 1;
    VstepMeta r; r.idq = *(const v4u*)(p.ws + WS_IDS + (size_t)t * 256 + 16 * k); r.wq = *(const v2u*)(p.ws + WS_WQ + (size_t)t * 128 + 8 * k); return r;
}
__device__ __forceinline__ void vst_issue(v4u (&vb)[8], const VstepMeta& q, const unsigned char* TVs) {
#pragma unroll
    for (int e = 0; e < 8; ++e) { const unsigned w = q.idq[e >> 1]; const unsigned id = (e & 1) ? (w >> 16) : (w & 0xffffu); vb[e] = *(const v4u*)(TVs + (size_t)id * 128); }
}
__device__ __forceinline__ void vst_compute(int (&y)[16], const v4u (&vb)[8], const v2u& wq) {
#pragma unroll
    for (int qd = 0; qd < 2; ++qd)
#pragma unroll
        for (int cm = 0; cm < 4; ++cm) {
            const unsigned A = vb[4 * qd][cm], B = vb[4 * qd + 1][cm], C = vb[4 * qd + 2][cm], D = vb[4 * qd + 3][cm];
            const unsigned ab01 = __builtin_amdgcn_perm(B, A, 0x05010400u), ab23 = __builtin_amdgcn_perm(B, A, 0x07030602u);
            const unsigned cd01 = __builtin_amdgcn_perm(D, C, 0x05010400u), cd23 = __builtin_amdgcn_perm(D, C, 0x07030602u);
            const unsigned t0 = __builtin_amdgcn_perm(cd01, ab01, 0x05040100u), t1 = __builtin_amdgcn_perm(cd01, ab01, 0x07060302u);
            const unsigned t2 = __builtin_amdgcn_perm(cd23, ab23, 0x05040100u), t3 = __builtin_amdgcn_perm(cd23, ab23, 0x07060302u);
            y[4 * cm + 0] = __builtin_amdgcn_sdot4((int)t0, (int)wq[qd], y[4 * cm + 0], false); y[4 * cm + 1] = __builtin_amdgcn_sdot4((int)t1, (int)wq[qd], y[4 * cm + 1], false);
            y[4 * cm + 2] = __builtin_amdgcn_sdot4((int)t2, (int)wq[qd], y[4 * cm + 2], false); y[4 * cm + 3] = __builtin_amdgcn_sdot4((int)t3, (int)wq[qd], y[4 * cm + 3], false);
        }
}
__device__ __forceinline__ void ph_vacc(const Params& p, int bid, int nblk) {
    bf16* Y = (bf16*)(p.ws + WS_Y); const float* WSC = (const float*)(p.ws + WS_WSC);
    const int lane = opaque_tid() & 63, wave = wave_id(), c = lane & 7;
    const int s = bid & 7, nper = (nblk - s + 7) >> 3,     stride8 = nper * NWAVES * 8;
    const unsigned char* TVs = p.ws + WS_TV8 + (size_t)s * (2 * MiB) + 16 * c;
    const int t0 = ((bid >> 3) * NWAVES + wave) * 8;
    const int ngroups = t0 < NT ? (NT - t0 + stride8 - 1) / stride8 : 0, nsteps = ngroups * 16;
    if (nsteps == 0) return;
    int y[16];
#pragma unroll
    for (int k = 0; k < 16; ++k) y[k] = 0;
    v4u vA[8], vB[8];
    VstepMeta qa = vst_meta(p, 0, t0, stride8, lane);
    vst_issue(vA, qa, TVs);
    VstepMeta qb = vst_meta(p, 1, t0, stride8, lane);
    for (int st = 0; st < nsteps; st += 2) {
        vst_issue(vB, qb, TVs);
        const v2u wa = qa.wq; qa = vst_meta(p, st + 2 < nsteps ? st + 2 : st, t0, stride8, lane);
        vst_compute(y, vA, wa);
        if (st + 2 < nsteps) vst_issue(vA, qa, TVs);
        const v2u wb = qb.wq; qb = vst_meta(p, st + 3 < nsteps ? st + 3 : st + 1, t0, stride8, lane);
        vst_compute(y, vB, wb);
        if (((st + 1) & 15) == 15) {
            const int t = t0 + (st >> 4) * stride8 + (lane >> 3);
            if (t < NT) { const float sc = WSC[t];
                v4u o0, o1; o0.x = pk2((float)y[0] * sc, (float)y[1] * sc); o0.y = pk2((float)y[2] * sc, (float)y[3] * sc); o0.z = pk2((float)y[4] * sc, (float)y[5] * sc); o0.w = pk2((float)y[6] * sc, (float)y[7] * sc);
                o1.x = pk2((float)y[8] * sc, (float)y[9] * sc); o1.y = pk2((float)y[10] * sc, (float)y[11] * sc); o1.z = pk2((float)y[12] * sc, (float)y[13] * sc); o1.w = pk2((float)y[14] * sc, (float)y[15] * sc);
                v4u* dst = (v4u*)(Y + (size_t)t * DM + 128 * s + 16 * c); dst[0] = o0; dst[1] = o1; }
#pragma unroll
            for (int k = 0; k < 16; ++k) y[k] = 0;
        }
    }
}
__device__ __forceinline__ void ph_final(const Params& p, int bid, int nblk) {
    const bf16* x1 = (const bf16*)(p.ws + WS_X1); const bf16* Y = (const bf16*)(p.ws + WS_Y); const float* mod = (const float*)(p.ws + WS_MOD);
    const int lane = opaque_tid() & 63, wave = wave_id();
    for (int t = bid * NWAVES + wave; t < NT; t += nblk * NWAVES) {
        const int b = t / SEQ;
        f32x4 v[4]; float s = 0.f;
#pragma unroll
        for (int j = 0; j < 4; ++j) { const v2u xw = *((const v2u*)(x1 + (size_t)t * DM) + lane + 64 * j), yw = *((const v2u*)(Y + (size_t)t * DM) + lane + 64 * j);
            const f32x4 g2 = *((const f32x4*)(mod + b * 6144 + 5120) + lane + 64 * j);
            const f32x4 xv = {bflo(xw.x), bfhi(xw.x), bflo(xw.y), bfhi(xw.y)}, yv = {bflo(yw.x), bfhi(yw.x), bflo(yw.y), bfhi(yw.y)};
            v[j] = xv * ALPHA + (g2 + 1.0f) * yv; s += (v[j].x + v[j].y) + (v[j].z + v[j].w); }
        const float mean = wave_sum(s) * (1.f / DM); float s2 = 0.f;
#pragma unroll
        for (int j = 0; j < 4; ++j) { v[j] = v[j] - mean; s2 += (v[j].x * v[j].x + v[j].y * v[j].y) + (v[j].z * v[j].z + v[j].w * v[j].w); }
        const float rstd = rsqrtf(wave_sum(s2) * (1.f / DM) + LN_EPS);
#pragma unroll
        for (int j = 0; j < 4; ++j) { const f32x4 g = *((const f32x4*)p.g2 + lane + 64 * j), be = *((const f32x4*)p.be2 + lane + 64 * j);
            *((f32x4*)(p.out + (size_t)t * DM) + lane + 64 * j) = v[j] * rstd * g + be; }
    }
}

#ifndef PROBE_ID
#define PROBE_ID 0
#endif
#define RUN2(id, ...) do { __VA_ARGS__; if (PROBE_ID == (id)) { xcd_barrier(bar); __VA_ARGS__; } } while (0)
__global__ void __launch_bounds__(NTHREADS, 2) mega(Params p) {
    extern __shared__ __attribute__((aligned(16))) unsigned char lds_raw[];

    LAS unsigned char* lds = (LAS unsigned char*)lds_raw;
    const int bid = blockIdx.x, nblk = gridDim.x, tid = opaque_tid();
    for (int u = tid; u < (LDS_BYTES - LDSCTL_OFF) / 4; u += NTHREADS) ((LAS unsigned*)(lds + LDSCTL_OFF))[u] = 0u;
    __syncthreads();
    unsigned* ctl = (unsigned*)(p.ws + WS_CTL);
    XcdBarrier bar = xcd_barrier_post(ctl + CW_BAR, (volatile LAS unsigned*)(lds + MISC_OFF) + 8);
    const float* mod = (const float*)(p.ws + WS_MOD);

    ph_mod(p, lds, bid, nblk);
    xcd_barrier(bar);
    RUN2(1, ph_prologue(p, lds, bid, nblk));
    RUN2(7, ph_xn(p, bid, nblk));
    xcd_barrier(bar);
    {
        pg8::Gemm g{(const pg8::bf16_t*)(p.ws + WS_XN), (const pg8::bf16_t*)(p.ws + WS_WIN), NT, NIN, DM}; pg8::StaticOrder S; S.init(NT, NIN, nblk, bid);
        EpiIn E{(bf16*)(p.ws + WS_FZ), (bf16*)(p.ws + WS_QB), (const float*)(p.ws + WS_MISC), (const float*)(p.ws + WS_ROPE)};
        pg8::gemm_phase<EpiIn, pg8::StaticOrder, true, true>(lds, g, S, E);
    }
    xcd_barrier(bar);
    RUN2(8, ph_fft(p, lds, bid, nblk));
    RUN2(2, ph_attn_fast(p, lds, bid, nblk));
    xcd_barrier(bar);
    RUN2(3, ph_merge(p, bid, nblk));
    xcd_barrier(bar);
    {
        pg8::Gemm g{(const pg8::bf16_t*)(p.ws + WS_XN), (const pg8::bf16_t*)(p.ws + WS_WOUT), NT, DM, DM}; pg8::StaticOrder S; S.init(NT, DM, nblk, bid);
        EpiOut E{(bf16*)(p.ws + WS_Y1), p.x, mod, p.b_out};
        pg8::gemm_phase<EpiOut, pg8::StaticOrder, true, true>(lds, g, S, E);
    }
    xcd_barrier(bar);
    RUN2(4, ph_ln1_fast(p, bid, nblk));
    xcd_barrier(bar);
    {
        pg8::Gemm g{(const pg8::bf16_t*)(p.ws + WS_XN), (const pg8::bf16_t*)(p.ws + WS_WPQ), NT, DM, DM}; pg8::StaticOrder S; S.init(NT, DM, nblk, bid);
        pg8::EpiBf16<0> E{(pg8::bf16_t*)(p.ws + WS_PQ), DM, nullptr, 0, 0, 1.f};
        pg8::gemm_phase<pg8::EpiBf16<0>, pg8::StaticOrder, true, true>(lds, g, S, E);
    }
    xcd_barrier(bar);
    RUN2(5, ph_topk_fast(p, lds, bid, nblk));
    xcd_barrier(bar);
    RUN2(6, ph_udot(p, bid, nblk));
    xcd_barrier(bar);
    RUN2(11, ph_act(p, bid, nblk));
    xcd_barrier(bar);
    RUN2(10, ph_vacc(p, bid, nblk));
    xcd_barrier(bar);
    ph_final(p, bid, nblk);
}

extern "C" void kernel_launch(void* const* d_in, const int* in_sizes, int n_in, void* d_out, int out_size, void* d_ws, size_t ws_size, hipStream_t stream) {
    Params p{};
    p.x = (const float*)d_in[0]; p.c = (const float*)d_in[1]; p.pos = (const int*)d_in[2]; p.w_ada = (const float*)d_in[3]; p.b_ada = (const float*)d_in[4];
    p.w_in = (const float*)d_in[5]; p.b_in = (const float*)d_in[6]; p.w_four = (const float*)d_in[7]; p.w_out = (const float*)d_in[8]; p.b_out = (const float*)d_in[9];
    p.g1 = (const float*)d_in[10]; p.be1 = (const float*)d_in[11]; p.w_pq = (const float*)d_in[12]; p.subk = (const float*)d_in[13]; p.pu = (const float*)d_in[14]; p.pv = (const float*)d_in[15];
    p.g2 = (const float*)d_in[16]; p.be2 = (const float*)d_in[17]; p.out = (float*)d_out; p.ws = (unsigned char*)d_ws;
    static int grid_blocks = 0;
    if (grid_blocks == 0) {
        if (ws_size < WS_END) { fprintf(stderr, "workspace too small: %zu < %zu\n", ws_size, (size_t)WS_END); grid_blocks = -1; return; }
        int dev = 0, cus = 0, per_cu = 0;
        if (hipGetDevice(&dev) != hipSuccess || hipDeviceGetAttribute(&cus, hipDeviceAttributeMultiprocessorCount, dev) != hipSuccess) { grid_blocks = -1; return; }
        if (hipFuncSetAttribute((const void*)mega, hipFuncAttributeMaxDynamicSharedMemorySize, LDS_BYTES) != hipSuccess) { fprintf(stderr, "hipFuncSetAttribute failed\n"); grid_blocks = -1; return; }
        if (hipOccupancyMaxActiveBlocksPerMultiprocessor(&per_cu, (const void*)mega, NTHREADS, LDS_BYTES) != hipSuccess || per_cu < 1) { fprintf(stderr, "occupancy query: %d\n", per_cu); grid_blocks = -1; return; }
        grid_blocks = cus;
    }
    if (grid_blocks < 0) return;
    if (hipMemsetAsync((char*)d_ws + WS_CTL, 0, CTL_ZERO_BYTES, stream) != hipSuccess) { fprintf(stderr, "memset failed\n"); return; }
    void* args[] = {&p};
    hipError_t e = hipLaunchCooperativeKernel((void*)mega, dim3(grid_blocks), dim3(NTHREADS), args, LDS_BYTES, stream);
    if (e != hipSuccess) fprintf(stderr, "cooperative launch failed: %s (grid %d)\n", hipGetErrorString(e), grid_blocks);
}
```

```cpp
#include <hip/hip_runtime.h>
#include <hip/hip_cooperative_groups.h>
#include <cstdio>
#include <cstdint>
#include <cmath>
namespace cg = cooperative_groups;

namespace pg8 {
#define PG8_LAS __attribute__((address_space(3)))
typedef unsigned short bf16_t;
typedef short bf16x8 __attribute__((ext_vector_type(8)));
typedef float f32x4 __attribute__((ext_vector_type(4)));
typedef unsigned u32x4 __attribute__((ext_vector_type(4)));
constexpr int BM = 256, BK = 64, HALF = 128, HTB = HALF * BK * 2  , STAGE_BYTES = 8 * HTB, NXCD = 8, WGM = 8;

__host__ __device__ __forceinline__ int lds_byte(int r, int c) { const int st = (r >> 4) * 2 + (c >> 5), rr = r & 15, cc = c & 31, ob = rr * 64 + cc * 2; return st * 1024 + (ob ^ (((ob >> 9) & 1) << 5)); }
__host__ __device__ __forceinline__ void stage_rc(int b, int& R, int& C) { const int st = b / 1024, sb = b % 1024, swz = sb ^ (((sb >> 9) & 1) << 5); R = (st >> 1) * 16 + swz / 64; C = (st & 1) * 32 + (swz % 64) / 2; }
__host__ __device__ __forceinline__ int perm32(int rho) { const int n = rho >> 4, i = rho & 15; return 8 * (i >> 2) + 4 * n + (i & 3); }

struct Unit { int pm, pn; };
struct Gemm { const bf16_t* A; const bf16_t* Bt; int M, N, K; };

struct StaticOrder {
    int nM, nN, nwg, G, c;
    __host__ __device__ void init(int M, int N, int G_, int c_) { nM = M / BM; nN = N / BM; nwg = nM * nN; G = G_; c = c_; }
    __host__ __device__ bool next(int i, Unit& u) const {
        const long L = (long)i * G + c; if (L >= nwg) return false;
        int wgid = (int)L; { const int q = nwg / NXCD, r = nwg % NXCD, xcd = wgid % NXCD, off = wgid / NXCD; wgid = (xcd < r ? xcd * (q + 1) : r * (q + 1) + (xcd - r) * q) + off; }
        const int nig = WGM * nN, gid = wgid / nig, fm = gid * WGM, gsz = (nM - fm) < WGM ? (nM - fm) : WGM;
        u.pm = fm + ((wgid % nig) % gsz); u.pn = (wgid % nig) / gsz; return true;
    }
    __device__ __forceinline__ void a_ready(const Unit&) const {}
    __device__ __forceinline__ void done(const Unit&) const {}
};

__device__ __forceinline__ unsigned cvt_pk_bf16(float lo, float hi) { unsigned r; asm volatile("v_cvt_pk_bf16_f32 %0, %1, %2" : "=v"(r) : "v"(lo), "v"(hi)); return r; }
typedef float f32x2 __attribute__((ext_vector_type(2)));
__device__ __forceinline__ f32x2 gelu_pk(f32x2 v) {
    const f32x2 av = __builtin_elementwise_abs(v), d = av * 0.2316418882f + 1.0f;
    f32x2 t; t.x = __builtin_amdgcn_rcpf(d.x); t.y = __builtin_amdgcn_rcpf(d.y);
    f32x2 q = t * 0.5307027145f + (-0.7265760135f); q = q * t + 0.7107068705f; q = q * t + (-0.142248368f); q = q * t + 0.127414796f; q = q * t;
    const f32x2 s = (v * v) * (-0.72134752044f);
    f32x2 e; e.x = __builtin_amdgcn_exp2f(s.x); e.y = __builtin_amdgcn_exp2f(s.y);
    const f32x2 m = v * (q * e), r = v - m;
    f32x2 o; o.x = v.x < 0.f ? m.x : r.x; o.y = v.y < 0.f ? m.y : r.y; return o;
}

template <int ACT  > struct EpiBf16 {
    static constexpr bool PERM = true, AFTER_DRAIN = false; static_assert(ACT == 0 || ACT == 1, "EpiBf16: ACT is 0 (none) or 1 (gelu_pk)");
    bf16_t* O; int ldc; const float* bias; int split_cols; size_t split_stride; float scale0;
    __device__ __forceinline__ void operator()(const f32x4 (&acc)[2][2][4][2], const Unit& u, int wr, int wc, int fr, int fq) const {
        const int row0 = u.pm * BM + wr * 64 + fr; int colt = u.pn * BM; bf16_t* base = O;
        float sc = 1.f; if (split_cols) { const int t = colt / split_cols; base += (size_t)t * split_stride; colt -= t * split_cols; if (t == 0) sc = scale0; }
        const int col0 = colt + wc * 32 + 8 * fq, bcol0 = u.pn * BM + wc * 32 + 8 * fq;
        f32x4 bv[2][2];
#pragma unroll
        for (int bj = 0; bj < 2; ++bj)
#pragma unroll
            for (int n = 0; n < 2; ++n) bv[bj][n] = bias ? *(const f32x4*)(bias + bcol0 + bj * HALF + 4 * n) : (f32x4){0.f, 0.f, 0.f, 0.f};
#pragma unroll
        for (int ai = 0; ai < 2; ++ai)
#pragma unroll
            for (int m = 0; m < 4; ++m) { bf16_t* rowp = base + (size_t)(row0 + ai * HALF + m * 16) * ldc + col0;
#pragma unroll
                for (int bj = 0; bj < 2; ++bj) { f32x4 v0 = acc[ai][bj][m][0] + bv[bj][0], v1 = acc[ai][bj][m][1] + bv[bj][1];
                    if (ACT == 1) { f32x2 a = gelu_pk((f32x2){v0[0], v0[1]}), b = gelu_pk((f32x2){v0[2], v0[3]}), c = gelu_pk((f32x2){v1[0], v1[1]}), d = gelu_pk((f32x2){v1[2], v1[3]});
                        v0 = (f32x4){a.x, a.y, b.x, b.y}; v1 = (f32x4){c.x, c.y, d.x, d.y}; }
                    v0 = v0 * sc; v1 = v1 * sc; u32x4 w; w.x = cvt_pk_bf16(v0[0], v0[1]); w.y = cvt_pk_bf16(v0[2], v0[3]); w.z = cvt_pk_bf16(v1[0], v1[1]); w.w = cvt_pk_bf16(v1[2], v1[3]);
                    *(u32x4*)(rowp + bj * HALF) = w; } }
    }
};
template <class Epi, class Sched, bool ALIGN_EPI = false, bool SP2 = false>
__device__ __forceinline__ void gemm_phase(PG8_LAS unsigned char* lds, const Gemm g, const Sched& S, const Epi& E) {
    int tid_ = threadIdx.x; asm volatile("" : "+v"(tid_)); const int tid = tid_, wid = __builtin_amdgcn_readfirstlane(tid >> 6), lane = tid & 63, wr = wid >> 2, wc = wid & 3, fr = lane & 15, fq = lane >> 4;
    const int K = g.K, nt = K / BK;
    unsigned voffA[2], voffB[2];
#pragma unroll
    for (int i = 0; i < 2; ++i) { int R, C; stage_rc(tid * 16 + i * 8192, R, C); const int Rb = Epi::PERM ? ((R & ~31) + perm32(R & 31)) : R;
        voffA[i] = (unsigned)(R * K + C) * 2u; voffB[i] = (unsigned)(Rb * K + C) * 2u; }
    const size_t kstep = (size_t)(BK * 2);
    const size_t hstep = (size_t)HALF * K * 2;
    const size_t tstep = 2 * hstep;
    const unsigned ldsw = (unsigned)wid * 1024u;
    const int aoff = lds_byte(wr * 64 + fr, fq * 8), boff = lds_byte(wc * 32 + fr, fq * 8);
#define PG8_SA(b, h) (((b) * 2 + (h)) * HTB)
#define PG8_SB(b, h) ((4 + (b) * 2 + (h)) * HTB)
#define PG8_STAGE(bufoff, gbase, voff) do { _Pragma("unroll") for (int _i = 0; _i < 2; ++_i) \
        __builtin_amdgcn_global_load_lds((const unsigned*)((const char*)(gbase) + (voff)[_i]), (PG8_LAS unsigned*)(lds + (bufoff) + ldsw + _i * 8192), 16, 0, 0); } while (0)
#define PG8_LDA(dst, b, h) do { _Pragma("unroll") for (int m = 0; m < 4; ++m) _Pragma("unroll") for (int k = 0; k < 2; ++k) dst[m][k] = *(const PG8_LAS bf16x8*)(lds + PG8_SA(b, h) + aoff + m * 2048 + k * 1024); } while (0)
#define PG8_LDB(dst, b, h) do { _Pragma("unroll") for (int n = 0; n < 2; ++n) _Pragma("unroll") for (int k = 0; k < 2; ++k) dst[n][k] = *(const PG8_LAS bf16x8*)(lds + PG8_SB(b, h) + boff + n * 2048 + k * 1024); } while (0)
#define PG8_MMA(ai, bj, At, Bt) do { __builtin_amdgcn_s_setprio(1); _Pragma("unroll") for (int m = 0; m < 4; ++m) _Pragma("unroll") for (int n = 0; n < 2; ++n) _Pragma("unroll") for (int k = 0; k < 2; ++k) \
        acc[ai][bj][m][n] = __builtin_amdgcn_mfma_f32_16x16x32_bf16(Bt[n][k], At[m][k], acc[ai][bj][m][n], 0, 0, 0); __builtin_amdgcn_s_setprio(0); } while (0)
#define PG8_WAIT_V(n) asm volatile("s_waitcnt vmcnt(" #n ")" ::: "memory")
#define PG8_WAIT_L(n) asm volatile("s_waitcnt lgkmcnt(" #n ")" ::: "memory")
#define PG8_BAR __builtin_amdgcn_s_barrier()
#define PG8_SCHED __builtin_amdgcn_sched_barrier(0)
    Unit cur, nxt; int ui = 0;
    if (!S.next(0, cur)) return;
    f32x4 acc[2][2][4][2];
#pragma unroll
    for (int a = 0; a < 2; ++a)
#pragma unroll
        for (int b = 0; b < 2; ++b)
#pragma unroll
            for (int m = 0; m < 4; ++m)
#pragma unroll
                for (int n = 0; n < 2; ++n) acc[a][b][m][n] = (f32x4){0.f, 0.f, 0.f, 0.f};
    bf16x8 At[4][2], B0[2][2], B1[2][2];
    const char* cA = (const char*)g.A + (size_t)cur.pm * tstep; const char* cB = (const char*)g.Bt + (size_t)cur.pn * tstep;
    S.a_ready(cur);
    if constexpr (SP2) {
        PG8_STAGE(PG8_SB(0, 0), cB, voffB); PG8_STAGE(PG8_SB(0, 1), cB + hstep, voffB); PG8_STAGE(PG8_SA(0, 0), cA, voffA); PG8_STAGE(PG8_SA(0, 1), cA + hstep, voffA);
        if (wr == 1) PG8_BAR;
        PG8_WAIT_V(2); PG8_BAR;
        PG8_STAGE(PG8_SB(1, 0), cB + kstep, voffB); PG8_STAGE(PG8_SA(1, 0), cA + kstep, voffA); PG8_STAGE(PG8_SB(1, 1), cB + hstep + kstep, voffB);
        PG8_WAIT_V(6); PG8_BAR;
    } else {
        PG8_STAGE(PG8_SB(0, 0), cB, voffB); PG8_STAGE(PG8_SA(0, 0), cA, voffA); PG8_STAGE(PG8_SB(0, 1), cB + hstep, voffB); PG8_STAGE(PG8_SA(0, 1), cA + hstep, voffA);
        if (wr == 1) PG8_BAR;
        PG8_WAIT_V(4); PG8_BAR;
        PG8_STAGE(PG8_SB(1, 0), cB + kstep, voffB); PG8_STAGE(PG8_SA(1, 0), cA + kstep, voffA); PG8_STAGE(PG8_SB(1, 1), cB + hstep + kstep, voffB);
        PG8_WAIT_V(6); PG8_BAR;
    }
    for (;;) {
        const bool has_next = S.next(ui + 1, nxt);
        const char* nA = has_next ? (const char*)g.A + (size_t)nxt.pm * tstep : cA; const char* nB = has_next ? (const char*)g.Bt + (size_t)nxt.pn * tstep : cB;
        for (int t = 0; t < nt; t += 2) {
            const bool last = (t == nt - 2);
            const char* a1 = cA + (size_t)(t + 1) * kstep;
            const char* a2 = last ? nA : cA + (size_t)(t + 2) * kstep; const char* b2 = last ? nB : cB + (size_t)(t + 2) * kstep;
            const char* a3 = a2 + kstep; const char* b3 = b2 + kstep;
            if (last && has_next) S.a_ready(nxt);
            if constexpr (SP2) {
            PG8_LDB(B0, 0, 0); PG8_LDB(B1, 0, 1); PG8_SCHED; PG8_LDA(At, 0, 0); PG8_STAGE(PG8_SA(1, 1), a1 + hstep, voffA);
            PG8_WAIT_V(8); PG8_WAIT_L(0); PG8_BAR; PG8_MMA(0, 0, At, B0); PG8_MMA(0, 1, At, B1); PG8_BAR; PG8_SCHED;
            PG8_LDA(At, 0, 1); PG8_STAGE(PG8_SB(0, 0), b2, voffB); PG8_STAGE(PG8_SB(0, 1), b2 + hstep, voffB); PG8_STAGE(PG8_SA(0, 0), a2, voffA);
            PG8_WAIT_V(8); PG8_WAIT_L(0); PG8_BAR; PG8_MMA(1, 0, At, B0); PG8_MMA(1, 1, At, B1); PG8_BAR; PG8_SCHED;
            PG8_LDB(B0, 1, 0); PG8_LDB(B1, 1, 1); PG8_SCHED; PG8_LDA(At, 1, 0); PG8_STAGE(PG8_SA(0, 1), a2 + hstep, voffA);
            PG8_WAIT_V(8); PG8_WAIT_L(0); PG8_BAR; PG8_MMA(0, 0, At, B0); PG8_MMA(0, 1, At, B1); PG8_BAR; PG8_SCHED;
            PG8_LDA(At, 1, 1); PG8_STAGE(PG8_SB(1, 0), b3, voffB); PG8_STAGE(PG8_SB(1, 1), b3 + hstep, voffB); PG8_STAGE(PG8_SA(1, 0), a3, voffA);
            PG8_WAIT_V(8); PG8_WAIT_L(0); PG8_BAR; PG8_MMA(1, 0, At, B0); PG8_MMA(1, 1, At, B1); PG8_BAR; PG8_SCHED;
            } else {
            PG8_LDB(B0, 0, 0); PG8_SCHED; PG8_LDA(At, 0, 0); PG8_STAGE(PG8_SA(1, 1), a1 + hstep, voffA);
            PG8_WAIT_L(8); PG8_BAR; PG8_WAIT_L(0); PG8_MMA(0, 0, At, B0); PG8_BAR; PG8_SCHED;
            PG8_LDB(B1, 0, 1); PG8_STAGE(PG8_SB(0, 0), b2, voffB);
            PG8_BAR; PG8_WAIT_L(0); PG8_MMA(0, 1, At, B1); PG8_BAR;
            PG8_LDA(At, 0, 1); PG8_STAGE(PG8_SA(0, 0), a2, voffA);
            PG8_BAR; PG8_WAIT_L(0); PG8_MMA(1, 0, At, B0); PG8_BAR; PG8_SCHED;
            PG8_STAGE(PG8_SB(0, 1), b2 + hstep, voffB);
            PG8_WAIT_V(6); PG8_BAR; PG8_MMA(1, 1, At, B1); PG8_BAR;
            PG8_LDB(B0, 1, 0); PG8_SCHED; PG8_LDA(At, 1, 0); PG8_STAGE(PG8_SA(0, 1), a2 + hstep, voffA);
            PG8_WAIT_L(8); PG8_BAR; PG8_WAIT_L(0); PG8_MMA(0, 0, At, B0); PG8_BAR; PG8_SCHED;
            PG8_LDB(B1, 1, 1); PG8_STAGE(PG8_SB(1, 0), b3, voffB);
            PG8_BAR; PG8_WAIT_L(0); PG8_MMA(0, 1, At, B1); PG8_BAR;
            PG8_LDA(At, 1, 1); PG8_STAGE(PG8_SA(1, 0), a3, voffA);
            PG8_BAR; PG8_WAIT_L(0); PG8_MMA(1, 0, At, B0); PG8_BAR; PG8_SCHED;
            PG8_STAGE(PG8_SB(1, 1), b3 + hstep, voffB);
            PG8_WAIT_V(6); PG8_BAR; PG8_MMA(1, 1, At, B1); PG8_BAR;
            }
        }
        if constexpr (ALIGN_EPI) { if (wr == 0) PG8_BAR; }
        if constexpr (!Epi::AFTER_DRAIN) { E(acc, cur, wr, wc, fr, fq); S.done(cur); }
        if (!has_next) break;
#pragma unroll
        for (int a = 0; a < 2; ++a)
#pragma unroll
            for (int b = 0; b < 2; ++b)
#pragma unroll
                for (int m = 0; m < 4; ++m)
#pragma unroll
                    for (int n = 0; n < 2; ++n) acc[a][b][m][n] = (f32x4){0.f, 0.f, 0.f, 0.f};
        cur = nxt; cA = nA; cB = nB; ++ui;
        if constexpr (ALIGN_EPI) { if (wr == 1) PG8_BAR; }
    }
    PG8_WAIT_V(0);
    if constexpr (!ALIGN_EPI) { if (wr == 0) PG8_BAR; }
    PG8_BAR;
    if constexpr (Epi::AFTER_DRAIN) { E.fused(acc, cur, wr, wc, fr, fq, lds, wid, lane); S.done(cur); }
#undef PG8_SA
#undef PG8_SB
#undef PG8_STAGE
#undef PG8_LDA
#undef PG8_LDB
#undef PG8_MMA
#undef PG8_WAIT_V
#undef PG8_WAIT_L
#undef PG8_BAR
#undef PG8_SCHED
}
}

#define LAS __attribute__((address_space(3)))
#define GAS __attribute__((address_space(1)))
#define XB_TMO      128
#define XB_XCNT(j)  (256  + 64 * (j))
#define XB_XSUB(j)  (1280 + 64 * (j))
#define XB_XGEN(j)  (2304 + 64 * (j))
#define XB_TOP      3328
#define XB_TOPGEN   3392
#define XCD_BAR_WORDS 3456
#define XB_SPIN_CAP (1u << 18)

__device__ __forceinline__ unsigned xb_ld(unsigned* p)              { return __hip_atomic_load(p, __ATOMIC_RELAXED, __HIP_MEMORY_SCOPE_AGENT); }
__device__ __forceinline__ unsigned xb_add(unsigned* p, unsigned v) { return __hip_atomic_fetch_add(p, v, __ATOMIC_RELAXED, __HIP_MEMORY_SCOPE_AGENT); }
__device__ __forceinline__ unsigned xb_xcc_id() { return (unsigned)__builtin_amdgcn_s_getreg((3 << 11) | 20) & 0xFu; }
#define XB_SPIN(cond, bar) do { unsigned _sp = 0; while (cond) { __builtin_amdgcn_s_sleep(1); \
    if ((++_sp & 255u) == 0u) { if (xb_ld(&(bar)[XB_TMO])) break; if (_sp > XB_SPIN_CAP) { atomicAdd(&(bar)[XB_TMO], 1u); break; } } } } while (0)

struct XcdBarrier {
    unsigned* bar; unsigned x;
    volatile LAS unsigned* st;
};

__device__ __forceinline__ XcdBarrier xcd_barrier_post(unsigned* bar, volatile LAS unsigned* st) {
    XcdBarrier b; b.bar = bar; b.x = xb_xcc_id(); b.st = st;
    if (threadIdx.x == 0) (void)xb_add(&bar[XB_XCNT(b.x)], 1u);
    return b;
}
__device__ __forceinline__ void xcd_barrier_complete(unsigned* bar, unsigned x, unsigned& nloc, unsigned& nx) {
    const unsigned G = gridDim.x * gridDim.y * gridDim.z;
    unsigned sum, cnt, mine, sp = 0u;
    for (;;) {
        sum = 0u; cnt = 0u; mine = 0u;
#pragma unroll
        for (unsigned j = 0; j < 16; ++j) { const unsigned c = xb_ld(&bar[XB_XCNT(j)]); sum += c; cnt += (c > 0u) ? 1u : 0u; mine = (j == x) ? c : mine; }
        if (sum == G) break;
        __builtin_amdgcn_s_sleep(1);
        if ((++sp & 255u) == 0u) { if (xb_ld(&bar[XB_TMO])) break; if (sp > XB_SPIN_CAP) { atomicAdd(&bar[XB_TMO], 1u); break; } }
    }
    nloc = mine > 0u ? mine : 1u; nx = cnt > 0u ? cnt : 1u;
}

__device__ __forceinline__ void xcd_barrier(const XcdBarrier& b) {
    asm volatile("s_waitcnt vmcnt(0)" ::: "memory");
    __syncthreads();
    if (threadIdx.x == 0) {
        unsigned* bar = b.bar;
        __builtin_amdgcn_s_waitcnt(0);
        unsigned nloc = b.st[0], nx = b.st[1];
        if (nloc == 0u) { xcd_barrier_complete(bar, b.x, nloc, nx); b.st[0] = nloc; b.st[1] = nx; }
        const unsigned old = xb_add(&bar[XB_XSUB(b.x)], 1u);
        const unsigned gen = old / nloc;
        if (old + 1u == (gen + 1u) * nloc) {
            __builtin_amdgcn_fence(__ATOMIC_RELEASE, "agent");
            asm volatile("s_waitcnt vmcnt(0)" ::: "memory");
            const unsigned og = xb_add(&bar[XB_TOP], 1u);
            const unsigned tg = og / nx;
            if (og + 1u == (tg + 1u) * nx) xb_add(&bar[XB_TOPGEN], 1u);
            else XB_SPIN(xb_ld(&bar[XB_TOPGEN]) == tg, bar);
            __builtin_amdgcn_fence(__ATOMIC_ACQUIRE, "agent");
            xb_add(&bar[XB_XGEN(b.x)], 1u);
            asm volatile("s_waitcnt vmcnt(0)" ::: "memory");
        } else {
            XB_SPIN(xb_ld(&bar[XB_XGEN(b.x)]) == gen, bar);
            __builtin_amdgcn_fence(__ATOMIC_ACQUIRE, "agent");
            asm volatile("s_waitcnt vmcnt(0)" ::: "memory");
        }
    }
    __syncthreads();
}

constexpr int DM = 1024, NB = 2, SEQ = 8192, NT = NB * SEQ;
constexpr int NTHREADS = 512, NWAVES = 8;
constexpr float LN_EPS = 1e-5f;
constexpr float ALPHA = 1.189207115002721f;
typedef unsigned short bf16;
typedef unsigned v4u __attribute__((ext_vector_type(4)));
typedef unsigned v2u __attribute__((ext_vector_type(2)));
typedef float f32x4 __attribute__((ext_vector_type(4)));
typedef short bf16x8_t __attribute__((ext_vector_type(8)));

constexpr size_t MiB = 1u << 20, KiB = 1u << 10;
constexpr size_t WS_CTL = 0, CTL_ZERO_BYTES = 1 * MiB;
constexpr size_t WS_MOD = 1 * MiB + 768 * KiB;
constexpr size_t WS_MMAT = 1 * MiB;
constexpr size_t WS_ROPE = 2 * MiB;
constexpr size_t WS_WIN = 6 * MiB, WS_WOUT = 12 * MiB, WS_WPQ = 14 * MiB, WS_MISC = 16 * MiB, WS_SUBK = 17 * MiB;
constexpr size_t WS_XN = 18 * MiB;
constexpr size_t WS_FZ = 50 * MiB;
constexpr size_t WS_QB = 66 * MiB, WS_KB = 90 * MiB, WS_VB = 114 * MiB, WS_O3 = 138 * MiB, WS_LSE = 162 * MiB;
constexpr size_t WS_H2Q = 50 * MiB, WS_HS = 66 * MiB, WS_WQ = 67 * MiB, WS_WSC = 69 * MiB, WS_SUA = 75 * MiB, WS_X1 = 83 * MiB;
constexpr size_t WS_Y1 = 116 * MiB, WS_PQ = 116 * MiB, WS_PART = 116 * MiB, WS_Y = 116 * MiB;
constexpr size_t WS_IDS = 180 * MiB, WS_GATES = 188 * MiB;
constexpr size_t WS_TU8 = 200 * MiB, WS_TV8 = 216 * MiB, WS_SU = 232 * MiB, WS_SV = 232 * MiB + 512 * KiB, WS_END = 233 * MiB;
constexpr float QSCALE = 0.125f * 1.4426950408889634f;
constexpr int NIN = 2816;
constexpr int CW_BAR = 4096;

constexpr int RING_BYTES = 131072, LDSCTL_OFF = RING_BYTES, MISC_OFF = LDSCTL_OFF + 320, LDS_BYTES = 147456;

struct Params {
    const float* x; const float* c; const int* pos; const float* w_ada; const float* b_ada; const float* w_in; const float* b_in;
    const float* w_four; const float* w_out; const float* b_out; const float* g1; const float* be1; const float* w_pq; const float* subk;
    const float* pu; const float* pv; const float* g2; const float* be2; float* out; unsigned char* ws;
};

__device__ __forceinline__ unsigned f2bf(float f) { unsigned u = __builtin_bit_cast(unsigned, f); return (u + 0x7fffu + ((u >> 16) & 1u)) >> 16; }
__device__ __forceinline__ unsigned pk2(float lo, float hi) { return f2bf(lo) | (f2bf(hi) << 16); }
__device__ __forceinline__ float wave_sum(float v) {
#pragma unroll
    for (int o = 32; o > 0; o >>= 1) v += __shfl_xor(v, o);
    return v;
}
__device__ __forceinline__ float wave_max(float v) {
#pragma unroll
    for (int o = 32; o > 0; o >>= 1) v = fmaxf(v, __shfl_xor(v, o));
    return v;
}
#define LDS_WAIT() asm volatile("s_waitcnt lgkmcnt(0)" ::: "memory")
__device__ __forceinline__ int opaque_tid() { int t = threadIdx.x; asm volatile("" : "+v"(t)); return t; }
__device__ __forceinline__ int wave_id() { return __builtin_amdgcn_readfirstlane(opaque_tid() >> 6); }
__device__ __forceinline__ float bflo(unsigned u) { return __builtin_bit_cast(float, u << 16); }
__device__ __forceinline__ float bfhi(unsigned u) { return __builtin_bit_cast(float, u & 0xffff0000u); }

template <class SC>
__device__ __forceinline__ void transpose_item(const float* W, int K, int N, bf16* WT, int nout, SC srccol, LAS float* scr, int item, int lane) {
    const int nblk = nout / 32, kb = item / nblk, nb = item % nblk, k0 = 64 * kb, n0 = 32 * nb;
    const int sc = srccol(n0 + (lane & 31));
#pragma unroll 8
    for (int i = 0; i < 32; ++i) { const int kk = 2 * i + (lane >> 5); scr[kk * 33 + (lane & 31)] = W[(size_t)(k0 + kk) * N + sc]; }
    LDS_WAIT(); asm volatile("" ::: "memory");
    const int c = lane & 7;
#pragma unroll
    for (int j = 0; j < 4; ++j) { const int n = (lane >> 3) + 8 * j; const LAS float* s = scr + (8 * c) * 33 + n;
        v4u o; o.x = pk2(s[0 * 33], s[1 * 33]); o.y = pk2(s[2 * 33], s[3 * 33]); o.z = pk2(s[4 * 33], s[5 * 33]); o.w = pk2(s[6 * 33], s[7 * 33]);
        *(v4u*)(WT + (size_t)(n0 + n) * K + k0 + 8 * c) = o; }
    LDS_WAIT(); asm volatile("" ::: "memory");
}
__device__ __forceinline__ void ph_prologue(const Params& p, LAS unsigned char* lds, int bid, int nblk) {
    const int tid = opaque_tid(), lane = tid & 63, wave = __builtin_amdgcn_readfirstlane(tid >> 6);
    {
        LAS float* M = (LAS float*)lds; LAS float* Wl = (LAS float*)(lds + 32768);
        bf16* WT = (bf16*)(p.ws + WS_WIN); float* biasf = (float*)(p.ws + WS_MISC); const float* MM = (const float*)(p.ws + WS_MMAT);
        const bool fallback = !(nblk > 192);
        for (int it = bid; it < 256; it += nblk) {
            const int g = it & 3, kb = it >> 2, k0 = kb * 16;
            __syncthreads();
            if (fallback) { const float norm = 1.0f / sqrtf(8192.0f * 64.0f);
                for (int e = tid; e < 8192; e += NTHREADS) { const int c = e >> 7, nl = e & 127; float a = 0.f;
                    for (int cp = 0; cp < 64; ++cp) { const float ang = 2.0f * (float)((c * cp) & 63) / 64.0f; a += ((nl & 1) ? -sinpif(ang) : cospif(ang)) * p.w_four[(g * 64 + cp) * 64 + (nl >> 1)]; }
                    M[e] = a * norm; } }
            else {
#pragma unroll
                for (int i = 0; i < 4; ++i) *(LAS f32x4*)(lds + (tid + i * 512) * 16) = *(const f32x4*)(MM + (size_t)g * 8192 + (tid + i * 512) * 4); }
#pragma unroll
            for (int i = 0; i < 2; ++i) { const int e = tid + i * 512, k = e >> 6, c = e & 63; Wl[k * 64 + c] = p.w_in[(size_t)(k0 + k) * 2560 + g * 64 + c]; }
            __syncthreads();
            { const int nl = tid & 127, kq = tid >> 7; float a[4] = {0.f, 0.f, 0.f, 0.f};
              for (int c = 0; c < 64; ++c) { const float mv = M[c * 128 + nl];
#pragma unroll
                  for (int j = 0; j < 4; ++j) a[j] += mv * Wl[(kq * 4 + j) * 64 + c]; }
              *(v2u*)(WT + (size_t)(g * 128 + nl) * DM + k0 + kq * 4) = (v2u){pk2(a[0], a[1]), pk2(a[2], a[3])};
              if (kb == 0 && tid < 128) { float bsum = 0.f; for (int c = 0; c < 64; ++c) bsum += p.b_in[g * 64 + c] * M[c * 128 + nl]; biasf[g * 128 + nl] = bsum; } }
        }
        __syncthreads();
        for (int i = bid * NTHREADS + tid; i < 2304; i += nblk * NTHREADS) biasf[512 + i] = p.b_in[256 + i];
    }
    {
        LAS float* scr = (LAS float*)(lds + wave * 16384);
        const int gw = bid * NWAVES + wave, NGW = nblk * NWAVES;
        constexpr int I_IN = 16 * (2304 / 32), I_O = 16 * 32, I_PQ = 16 * 32;
        for (int it = gw; it < I_IN + I_O + I_PQ; it += NGW) {
            int r = it;
            if (r < I_IN) {
                transpose_item(p.w_in, DM, 2560, (bf16*)(p.ws + WS_WIN) + (size_t)512 * DM, 2304,
                    [](int n) { return n < 1536 ? 256 + (n & ~63) + ((n & 63) >> 1) + 32 * (n & 1) : 256 + n; }, scr, r, lane); continue; } r -= I_IN;
            if (r < I_O) { transpose_item(p.w_out, DM, DM, (bf16*)(p.ws + WS_WOUT), DM, [](int n) { return n; }, scr, r, lane); continue; } r -= I_O;
            transpose_item(p.w_pq, DM, DM, (bf16*)(p.ws + WS_WPQ), DM, [](int n) { return n; }, scr, r, lane);
        }
    }
    { float2* rope = (float2*)(p.ws + WS_ROPE);
      for (int idx = bid * NTHREADS + tid; idx < NT * 32; idx += nblk * NTHREADS) { const int t = idx >> 5, i = idx & 31;
          const float inv = powf(10000.0f, -(float)i / 32.0f); float sn, cs; sincosf((float)p.pos[t] * inv, &sn, &cs); rope[idx] = make_float2(cs, sn); } }
    { bf16* SK = (bf16*)(p.ws + WS_SUBK);
      for (int ch = bid * NTHREADS + tid; ch < 8 * 2 * 4 * 4 * 64; ch += nblk * NTHREADS) {
          const int ln = ch & 63, d0 = (ch >> 6) & 3, mt = (ch >> 8) & 3, hp = ch >> 10;
          const float* sp = p.subk + ((size_t)hp * 128 + 32 * mt + (ln & 31)) * 64 + 16 * d0 + 8 * (ln >> 5);
          v4u o; o.x = pk2(sp[0], sp[1]); o.y = pk2(sp[2], sp[3]); o.z = pk2(sp[4], sp[5]); o.w = pk2(sp[6], sp[7]);
          *(v4u*)(SK + (size_t)ch * 8) = o; } }
}
__device__ __forceinline__ void ph_mod(const Params& p, LAS unsigned char* lds, int bid, int nblk) {
    const int tid = opaque_tid(), col = tid & 31, kg = tid >> 5;
    LAS float* cond = (LAS float*)lds; LAS float* red = (LAS float*)(lds + 8192);
    float* mod = (float*)(p.ws + WS_MOD);
    for (int i = tid; i < 2 * DM; i += NTHREADS) { const float c = p.c[i]; cond[i] = c / (1.0f + expf(-c)); }
    __syncthreads();
    if (nblk > 192 && bid >= 192) {
        LAS float* T64 = (LAS float*)(lds + 12288);
        if (tid < 64) { T64[tid] = cospif(2.0f * (float)tid / 64.0f); T64[64 + tid] = -sinpif(2.0f * (float)tid / 64.0f); }
        __syncthreads();
        const float norm = 1.0f / sqrtf(8192.0f * 64.0f); float* MM = (float*)(p.ws + WS_MMAT);
        for (int it = bid - 192; it < 64; it += nblk - 192) {
            const int g = it >> 4, c = (it & 15) * 4 + (tid >> 7), nl = tid & 127; float a = 0.f;
#pragma unroll 8
            for (int cp = 0; cp < 64; ++cp) a += T64[(nl & 1) * 64 + ((c * cp) & 63)] * p.w_four[(g * 64 + cp) * 64 + (nl >> 1)];
            MM[(g * 64 + c) * 128 + nl] = a * norm;
        }
    }
    for (int it = bid; it < 6144 / 32; it += nblk) {
        const int n = it * 32 + col; float a0 = 0.f, a1 = 0.f;
        const float* wp = p.w_ada + (size_t)(kg * 64) * 6144 + n;
#pragma unroll 16
        for (int k = 0; k < 64; ++k) { const float w = wp[(size_t)k * 6144]; a0 += cond[kg * 64 + k] * w; a1 += cond[DM + kg * 64 + k] * w; }
        red[(kg * 2 + 0) * 32 + col] = a0; red[(kg * 2 + 1) * 32 + col] = a1;
        __syncthreads();
        if (tid < 64) { const int b = tid >> 5; float s = p.b_ada[n];
#pragma unroll
            for (int g = 0; g < 16; ++g) s += red[(g * 2 + b) * 32 + col];
            mod[b * 6144 + n] = s; }
        __syncthreads();
    }
}
__device__ __forceinline__ void ph_xn(const Params& p, int bid, int nblk) {
    const int lane = opaque_tid() & 63, wave = wave_id(); const float* mod = (const float*)(p.ws + WS_MOD); bf16* XN = (bf16*)(p.ws + WS_XN);
    for (int row = bid * NWAVES + wave; row < NT; row += nblk * NWAVES) {
        const int b = row / SEQ;
        const f32x4* xr = (const f32x4*)(p.x + (size_t)row * DM) + lane;
        f32x4 v[4]; float s = 0.f;
#pragma unroll
        for (int j = 0; j < 4; ++j) { v[j] = xr[64 * j]; s += (v[j].x + v[j].y) + (v[j].z + v[j].w); }
        const float mean = wave_sum(s) * (1.f / DM); float s2 = 0.f;
#pragma unroll
        for (int j = 0; j < 4; ++j) { v[j] = v[j] - mean; s2 += (v[j].x * v[j].x + v[j].y * v[j].y) + (v[j].z * v[j].z + v[j].w * v[j].w); }
        const float rstd = rsqrtf(wave_sum(s2) * (1.f / DM) + LN_EPS);
        unsigned long long* o8 = (unsigned long long*)(XN + (size_t)row * DM) + lane;
#pragma unroll
        for (int j = 0; j < 4; ++j) {
            const f32x4 sh = *((const f32x4*)(mod + b * 6144 + 0) + lane + 64 * j), sc = *((const f32x4*)(mod + b * 6144 + 1024) + lane + 64 * j);
            const f32x4 o = v[j] * rstd * (1.0f + sc) + sh;
            o8[64 * j] = (unsigned long long)pk2(o.x, o.y) | ((unsigned long long)pk2(o.z, o.w) << 32);
        }
    }
}

struct EpiOut {
    static constexpr bool PERM = true, AFTER_DRAIN = false;
    bf16* Y1; const float* x; const float* mod; const float* bo;
    __device__ __forceinline__ void operator()(const pg8::f32x4 (&acc)[2][2][4][2], const pg8::Unit& u, int wr, int wc, int fr, int fq) const {
        const int row0 = u.pm * 256 + wr * 64 + fr;
#pragma unroll
        for (int bj = 0; bj < 2; ++bj) {
            const int c0 = u.pn * 256 + bj * 128 + wc * 32 + 8 * fq;
            const pg8::f32x4 b0 = *(const pg8::f32x4*)(bo + c0), b1 = *(const pg8::f32x4*)(bo + c0 + 4);
#pragma unroll
            for (int ai = 0; ai < 2; ++ai) {
                const int bb = (u.pm * 256 + ai * 128) >> 13;
                const pg8::f32x4 g0 = *(const pg8::f32x4*)(mod + bb * 6144 + 2048 + c0) + 1.0f, g1 = *(const pg8::f32x4*)(mod + bb * 6144 + 2048 + c0 + 4) + 1.0f;
#pragma unroll
                for (int m = 0; m < 4; ++m) {
                    const int row = row0 + ai * 128 + m * 16;
                    const pg8::f32x4 x0 = *(const pg8::f32x4*)(x + (size_t)row * DM + c0), x1 = *(const pg8::f32x4*)(x + (size_t)row * DM + c0 + 4);
                    const pg8::f32x4 v0 = x0 * ALPHA + g0 * (acc[ai][bj][m][0] + b0), v1 = x1 * ALPHA + g1 * (acc[ai][bj][m][1] + b1);
                    v4u o; o.x = pk2(v0.x, v0.y); o.y = pk2(v0.z, v0.w); o.z = pk2(v1.x, v1.y); o.w = pk2(v1.z, v1.w);
                    *(v4u*)(Y1 + (size_t)row * DM + c0) = o;
                }
            }
        }
    }
};
__device__ __forceinline__ void ph_fft(const Params& p, LAS unsigned char* lds, int bid, int nblk) {
    const int tid = opaque_tid(), lane = tid & 63, wave = __builtin_amdgcn_readfirstlane(tid >> 6), lr = lane & 15, lq = lane >> 4;
    bf16* MIX = (bf16*)(p.ws + WS_XN);
    for (int item = bid; item < 256; item += nblk) {
        const int b = item >> 7, cg = item & 127;
        const unsigned long long* src = (const unsigned long long*)(p.ws + WS_FZ) + (size_t)(b * 128 + cg) * 8192;
#pragma unroll 4
        for (int i = 0; i < 16; ++i) {
            const int q = i * 512 + tid; const int n2 = (q & 7) | (((q >> 6) & 15) << 3), n1 = ((q >> 3) & 7) | (((q >> 10) & 7) << 3);
            const unsigned long long v = src[128 * n1 + n2];
            *(LAS unsigned*)(lds + (2 * n2) * 288 + 4 * n1) = (unsigned)v; *(LAS unsigned*)(lds + (2 * n2 + 1) * 288 + 4 * n1) = (unsigned)(v >> 32);
        }
        bf16x8_t af[4];
        { const int m = 16 * wave + lr, k1 = m >> 1, ri = m & 1;
#pragma unroll
          for (int ks = 0; ks < 4; ++ks)
#pragma unroll
              for (int jj = 0; jj < 4; ++jj) { const int n1 = 16 * ks + 4 * lq + jj; const float x = (float)((n1 * k1) & 63) * (1.0f / 64.0f);
                  const float c = __builtin_amdgcn_cosf(x), s = __builtin_amdgcn_sinf(x);
                  af[ks][2 * jj] = (short)f2bf(ri ? -s : c); af[ks][2 * jj + 1] = (short)f2bf(ri ? c : s); } }
        __syncthreads();
        pg8::f32x4 acc[16];
#pragma unroll
        for (int nt = 0; nt < 16; ++nt) { acc[nt] = (pg8::f32x4){0.f, 0.f, 0.f, 0.f};
#pragma unroll
            for (int ks = 0; ks < 4; ++ks) { const bf16x8_t bf = *(const LAS bf16x8_t*)(lds + (16 * nt + lr) * 288 + (32 * ks + 8 * lq) * 2);
                acc[nt] = __builtin_amdgcn_mfma_f32_16x16x32_bf16(af[ks], bf, acc[nt], 0, 0, 0); } }
        __syncthreads();
#pragma unroll
        for (int nt = 0; nt < 16; ++nt) { const int col = 16 * nt + lr, n2 = col >> 1, ch = col & 1;
#pragma unroll
            for (int h = 0; h < 2; ++h) { const int k1 = 8 * wave + 2 * lq + h; const float yr = acc[nt][2 * h], yi = acc[nt][2 * h + 1];
                const float x = (float)((n2 * k1) & 8191) * (1.0f / 8192.0f); const float c = __builtin_amdgcn_cosf(x), s = __builtin_amdgcn_sinf(x);
                *(LAS unsigned*)(lds + (2 * k1 + ch) * 544 + 4 * n2) = pk2(yr * c + yi * s, yi * c - yr * s); } }
        bf16x8_t a2[8];
        { const int k2 = 16 * wave + lr;
#pragma unroll
          for (int ks = 0; ks < 8; ++ks)
#pragma unroll
              for (int jj = 0; jj < 4; ++jj) { const int n2 = 16 * ks + 4 * lq + jj; const float x = (float)((n2 * k2) & 127) * (1.0f / 128.0f);
                  a2[ks][2 * jj] = (short)f2bf(__builtin_amdgcn_cosf(x)); a2[ks][2 * jj + 1] = (short)f2bf(__builtin_amdgcn_sinf(x)); } }
        __syncthreads();
        pg8::f32x4 o[8];
#pragma unroll
        for (int nt = 0; nt < 8; ++nt) { o[nt] = (pg8::f32x4){0.f, 0.f, 0.f, 0.f};
#pragma unroll
            for (int ks = 0; ks < 8; ++ks) { const bf16x8_t bf = *(const LAS bf16x8_t*)(lds + (16 * nt + lr) * 544 + (32 * ks + 8 * lq) * 2);
                o[nt] = __builtin_amdgcn_mfma_f32_16x16x32_bf16(a2[ks], bf, o[nt], 0, 0, 0); } }
#pragma unroll
        for (int nt = 0; nt < 8; ++nt) { const int col2 = 16 * nt + lr, k1 = col2 >> 1, ch = col2 & 1;
#pragma unroll
            for (int r = 0; r < 4; ++r) { const float v = o[nt][r]; const float w = __shfl_xor(v, 1); const int k2 = 16 * wave + 4 * lq + r;
                if (ch == 0) *(unsigned*)(MIX + ((size_t)b * SEQ + k1 + 64 * k2) * DM + 2 * cg) = pk2(v, w); } }
        __syncthreads();
    }
}


struct EpiIn {
    static constexpr bool PERM = true, AFTER_DRAIN = false;
    bf16* FZ; bf16* QKV; const float* bias; const float* rope;
    __device__ __forceinline__ void operator()(const pg8::f32x4 (&acc)[2][2][4][2], const pg8::Unit& u, int wr, int wc, int fr, int fq) const {
        const int row0 = u.pm * 256 + wr * 64 + fr;
#pragma unroll
        for (int bj = 0; bj < 2; ++bj) {
            const int c0 = u.pn * 256 + bj * 128 + wc * 32 + 8 * fq;
            const pg8::f32x4 b0 = *(const pg8::f32x4*)(bias + c0), b1 = *(const pg8::f32x4*)(bias + c0 + 4);
#pragma unroll
            for (int ai = 0; ai < 2; ++ai)
#pragma unroll
                for (int m = 0; m < 4; ++m) {
                    const int row = row0 + ai * 128 + m * 16;
                    pg8::f32x4 v0 = acc[ai][bj][m][0] + b0, v1 = acc[ai][bj][m][1] + b1;
                    if (u.pn < 2) {
                        const int b = row >> 13, s = row & 8191, cgp = c0 >> 2;
                        unsigned long long* d0 = (unsigned long long*)(FZ + (((size_t)(b * 128 + cgp) * 8192 + s) << 2));
                        d0[0] = (unsigned long long)pk2(v0.x, v0.y) | ((unsigned long long)pk2(v0.z, v0.w) << 32);
                        d0[8192] = (unsigned long long)pk2(v1.x, v1.y) | ((unsigned long long)pk2(v1.z, v1.w) << 32);
                    } else {
                        const int cq = c0 - 512, which = cq / 768, off = cq - which * 768;
                        if (which < 2) {
                            const float sc = which == 0 ? QSCALE : 1.0f;
                            const pg8::f32x4 r0 = *(const pg8::f32x4*)(rope + (size_t)row * 64 + (off & 63)), r1 = *(const pg8::f32x4*)(rope + (size_t)row * 64 + (off & 63) + 4);
                            pg8::f32x4 w0, w1;
                            w0.x = (v0.x * r0.x - v0.y * r0.y) * sc; w0.y = (v0.y * r0.x + v0.x * r0.y) * sc; w0.z = (v0.z * r0.z - v0.w * r0.w) * sc; w0.w = (v0.w * r0.z + v0.z * r0.w) * sc;
                            w1.x = (v1.x * r1.x - v1.y * r1.y) * sc; w1.y = (v1.y * r1.x + v1.x * r1.y) * sc; w1.z = (v1.z * r1.z - v1.w * r1.w) * sc; w1.w = (v1.w * r1.z + v1.z * r1.w) * sc;
                            v0 = w0; v1 = w1;
                        }
                        v4u o; o.x = pk2(v0.x, v0.y); o.y = pk2(v0.z, v0.w); o.z = pk2(v1.x, v1.y); o.w = pk2(v1.z, v1.w);
                        *(v4u*)(QKV + (size_t)which * ((WS_KB - WS_QB) / 2) + (size_t)row * 768 + off) = o;
                    }
                }
        }
    }
};

typedef float f32x16 __attribute__((ext_vector_type(16)));
typedef short s16x4 __attribute__((ext_vector_type(4)));
__device__ __forceinline__ int crow(int r, int hi) { return (r & 3) + 8 * (r >> 2) + 4 * hi; }
__device__ __forceinline__ s16x4 vtr(const LAS unsigned char* p) { return __builtin_bit_cast(s16x4, __builtin_amdgcn_ds_read_tr16_b64_v4i16((LAS s16x4*)p)); }
__device__ __forceinline__ unsigned cvtpk(float lo, float hi) { typedef float f2 __attribute__((ext_vector_type(2))); typedef __bf16 b2 __attribute__((ext_vector_type(2))); f2 v = {lo, hi}; b2 r = __builtin_convertvector(v, b2); return __builtin_bit_cast(unsigned, r); }
__device__ __forceinline__ void tbl_load(const Params& p, int r, f32x4 (&a)[4], int lane) {
    const bool isv = r >= 16384; const int row = isv ? r - 16384 : r;
    const f32x4* src = (const f32x4*)((isv ? p.pv : p.pu) + (size_t)row * DM + 16 * lane);
#pragma unroll
    for (int j = 0; j < 4; ++j) a[j] = src[j];
}
__device__ __forceinline__ void tbl_finish(const Params& p, int r, const f32x4 (&a)[4], int lane) {
    const bool isv = r >= 16384; const int row = isv ? r - 16384 : r;
    float amax = 0.f;
#pragma unroll
    for (int j = 0; j < 4; ++j) amax = fmaxf(amax, fmaxf(fmaxf(fabsf(a[j].x), fabsf(a[j].y)), fmaxf(fabsf(a[j].z), fabsf(a[j].w))));
    if (isv) {
        amax = wave_max(amax);
        const float inv = amax > 0.f ? 127.0f / amax : 0.f;
        v4u o;
#pragma unroll
        for (int j = 0; j < 4; ++j) { unsigned q = 0u;
            q = __builtin_amdgcn_cvt_pk_u8_f32(a[j].x * inv + 128.0f, 0, q); q = __builtin_amdgcn_cvt_pk_u8_f32(a[j].y * inv + 128.0f, 1, q);
            q = __builtin_amdgcn_cvt_pk_u8_f32(a[j].z * inv + 128.0f, 2, q); q = __builtin_amdgcn_cvt_pk_u8_f32(a[j].w * inv + 128.0f, 3, q);
            o[j] = q ^ 0x80808080u; }
        *(v4u*)(p.ws + WS_TV8 + (size_t)(lane >> 3) * (2 * MiB) + (size_t)row * 128 + 16 * (lane & 7)) = o;
        if (lane == 0) ((float*)(p.ws + WS_SV))[row] = amax * (1.0f / 127.0f);
    } else {
        amax = fmaxf(amax, __shfl_xor(amax, 1)); amax = fmaxf(amax, __shfl_xor(amax, 2)); amax = fmaxf(amax, __shfl_xor(amax, 4)); amax = fmaxf(amax, __shfl_xor(amax, 8));
        const float inv = amax > 0.f ? 7.0f / amax : 0.f;
        unsigned d[2];
#pragma unroll
        for (int w = 0; w < 2; ++w) { unsigned lo = 0u, hi = 0u;
            lo = __builtin_amdgcn_cvt_pk_u8_f32(a[2 * w].x * inv + 8.0f, 0, lo); lo = __builtin_amdgcn_cvt_pk_u8_f32(a[2 * w].y * inv + 8.0f, 1, lo);
            lo = __builtin_amdgcn_cvt_pk_u8_f32(a[2 * w].z * inv + 8.0f, 2, lo); lo = __builtin_amdgcn_cvt_pk_u8_f32(a[2 * w].w * inv + 8.0f, 3, lo);
            hi = __builtin_amdgcn_cvt_pk_u8_f32(a[2 * w + 1].x * inv + 8.0f, 0, hi); hi = __builtin_amdgcn_cvt_pk_u8_f32(a[2 * w + 1].y * inv + 8.0f, 1, hi);
            hi = __builtin_amdgcn_cvt_pk_u8_f32(a[2 * w + 1].z * inv + 8.0f, 2, hi); hi = __builtin_amdgcn_cvt_pk_u8_f32(a[2 * w + 1].w * inv + 8.0f, 3, hi);
            d[w] = lo | (hi << 4); }
        *(v2u*)(p.ws + WS_TU8 + (size_t)(lane >> 4) * (2 * MiB) + (size_t)row * 128 + 8 * (lane & 15)) = (v2u){d[0], d[1]};
        if ((lane & 15) == 0) ((float*)(p.ws + WS_SU))[(size_t)(lane >> 4) * 16384 + row] = amax * (1.0f / 7.0f);
    }
}
struct AttnDesc { int dil, ntile, res, cb, r; size_t rowb; int h; bool valid; };
__device__ __forceinline__ AttnDesc attn_desc(int bi) {
    AttnDesc d; d.valid = bi < 3 * 768; const int b2 = d.valid ? bi : 0;
    const int r = b2 / 768, rem = b2 - r * 768, bh = rem >> 5, q32 = rem & 31, b = bh / 12;
    d.r = r; d.h = bh - b * 12; d.rowb = (size_t)b * SEQ;
    const int ld = 2 * r;
    d.dil = 1 << ld; d.ntile = 256 >> ld; d.res = q32 >> (5 - ld); d.cb = q32 & ((32 >> ld) - 1);
    return d;
}
__device__ __forceinline__ void attn_dma(const AttnDesc& d, const bf16* T, bool swz, LAS unsigned char* img, int wave, int lane) {
#pragma unroll
    for (int i = 0; i < 6; ++i) {
        const int idx = wave * 6 + i, j = idx >> 2, it = idx & 3, kt = 8 * d.cb - 2 + j;
        if (kt >= 0 && kt < d.ntile) {
            const int row = it * 8 + (lane >> 3), ch = lane & 7; const int gch = swz ? (ch ^ ((row >> 1) & 7)) : ch;
            const bf16* src = T + (d.rowb + d.res + d.dil * (32 * kt + row)) * 768 + d.h * 64 + 8 * gch;
            __builtin_amdgcn_global_load_lds((const unsigned*)src, (LAS unsigned*)(img + j * 4096 + it * 1024), 16, 0, 0);
        }
    }
}
__device__ __forceinline__ void attn_qload(const AttnDesc& d, const bf16* QB, bf16x8_t (&qf)[4], int wave, int lane) {
    const bf16* qp = QB + (d.rowb + d.res + d.dil * (32 * (8 * d.cb + wave) + (lane & 31))) * 768 + d.h * 64 + 8 * (lane >> 5);
#pragma unroll
    for (int d0 = 0; d0 < 4; ++d0) qf[d0] = *(const bf16x8_t*)(qp + 16 * d0);
}
#define ATT_SYNC() do { asm volatile("s_waitcnt vmcnt(0) lgkmcnt(0)" ::: "memory"); __builtin_amdgcn_s_barrier(); asm volatile("" ::: "memory"); } while (0)
__device__ __forceinline__ void ph_attn_fast(const Params& p, LAS unsigned char* lds, int bid, int nblk) {
    const int lane = opaque_tid() & 63, wave = wave_id(), r32 = lane & 31, hi = lane >> 5;
    LAS unsigned char* imgK = lds; LAS unsigned char* imgV = lds + 49152; LAS unsigned char* stgb = lds + 98304 + wave * 4096;
    const bf16* QB = (const bf16*)(p.ws + WS_QB); const bf16* KB = (const bf16*)(p.ws + WS_KB); const bf16* VB = (const bf16*)(p.ws + WS_VB);
    const int vb = (nblk & 7) == 0 ? (bid & 7) * (nblk >> 3) + (bid >> 3) : bid;
    int bi = vb;
    AttnDesc d = attn_desc(bi);
    bf16x8_t qf[4];
    if (d.valid) { attn_dma(d, KB, true, imgK, wave, lane); attn_qload(d, QB, qf, wave, lane); }
    ATT_SYNC();
    const int g = lane >> 4, ii = lane & 15;
    const int vb0 = (4 * hi + (ii >> 2)) * 128 + (g & 1) * 32 + (ii & 3) * 8;
    int trow = bid * NWAVES + wave; const int tstride = nblk * NWAVES;
    f32x4 ta[4];
    while (d.valid) {
        asm volatile("" : "+v"(qf[0]), "+v"(qf[1]), "+v"(qf[2]), "+v"(qf[3]));
        attn_dma(d, VB, false, imgV, wave, lane);
        const bool tb1 = trow < 32768; if (tb1) tbl_load(p, trow, ta, lane);
        const int c = 8 * d.cb + wave;
        f32x16 S[5];
#pragma unroll
        for (int u = 0; u < 5; ++u) {
            const int kt = c - 2 + u;
#pragma unroll
            for (int r = 0; r < 16; ++r) S[u][r] = -1e30f;
            if (kt >= 0 && kt < d.ntile) {
                const LAS unsigned char* slot = imgK + (wave + u) * 4096;
                f32x16 a = {0.f, 0.f, 0.f, 0.f, 0.f, 0.f, 0.f, 0.f, 0.f, 0.f, 0.f, 0.f, 0.f, 0.f, 0.f, 0.f};
#pragma unroll
                for (int d0 = 0; d0 < 4; ++d0) { const bf16x8_t kf = *(const LAS bf16x8_t*)(slot + r32 * 128 + (((2 * d0 + hi) ^ ((r32 >> 1) & 7)) << 4));
                    a = __builtin_amdgcn_mfma_f32_32x32x16_bf16(kf, qf[d0], a, 0, 0, 0); }
                S[u] = a;
            }
        }
#pragma unroll
        for (int r = 0; r < 16; ++r) { const int kk = crow(r, hi); if (kk < r32) S[0][r] = -1e30f; if (kk > r32) S[4][r] = -1e30f; }
        float m = -1e30f;
#pragma unroll
        for (int u = 0; u < 5; ++u)
#pragma unroll
            for (int r = 0; r < 16; ++r) m = fmaxf(m, S[u][r]);
        m = fmaxf(m, __shfl_xor(m, 32));
        float l = 0.f;
        unsigned Pk[5][8];
#pragma unroll
        for (int u = 0; u < 5; ++u)
#pragma unroll
            for (int r = 0; r < 16; r += 2) { const float e0 = __builtin_amdgcn_exp2f(S[u][r] - m), e1 = __builtin_amdgcn_exp2f(S[u][r + 1] - m); l += e0 + e1; Pk[u][r >> 1] = cvtpk(e0, e1); }
        l += __shfl_xor(l, 32);
        if (tb1) { tbl_finish(p, trow, ta, lane); trow += tstride; }
        ATT_SYNC();
        const AttnDesc dn = attn_desc(bi + nblk);
        if (dn.valid) { attn_dma(dn, KB, true, imgK, wave, lane); attn_qload(dn, QB, qf, wave, lane); }
        const bool tb2 = trow < 32768; if (tb2) tbl_load(p, trow, ta, lane);
        f32x16 o[2];
#pragma unroll
        for (int db = 0; db < 2; ++db)
#pragma unroll
            for (int r = 0; r < 16; ++r) o[db][r] = 0.f;
#pragma unroll
        for (int u = 0; u < 5; ++u) {
            const int kt = c - 2 + u;
            if (kt >= 0 && kt < d.ntile) {
                const LAS unsigned char* slot = imgV + (wave + u) * 4096;
#pragma unroll
                for (int s = 0; s < 2; ++s) {
                    bf16x8_t pa;
                    { v4u w; w.x = Pk[u][4 * s + 0]; w.y = Pk[u][4 * s + 1]; w.z = Pk[u][4 * s + 2]; w.w = Pk[u][4 * s + 3]; pa = __builtin_bit_cast(bf16x8_t, w); }
#pragma unroll
                    for (int db = 0; db < 2; ++db) {
                        const s16x4 lo = vtr(slot + vb0 + s * 2048 + db * 64), hh = vtr(slot + vb0 + s * 2048 + 1024 + db * 64);
                        const bf16x8_t vf = {lo[0], lo[1], lo[2], lo[3], hh[0], hh[1], hh[2], hh[3]};
                        o[db] = __builtin_amdgcn_mfma_f32_32x32x16_bf16(pa, vf, o[db], 0, 0, 0);
                    }
                }
            }
        }
        bf16* OB = d.r == 2 ? (bf16*)(p.ws + WS_O3) : (bf16*)p.out + (size_t)d.r * NT * 768;
        float* LSE = (float*)(p.ws + WS_LSE) + (size_t)d.r * NT * 12;
        const float linv = 1.0f / l;
        LAS unsigned short* stg = (LAS unsigned short*)stgb;
#pragma unroll
        for (int r = 0; r < 16; ++r) { const int q = crow(r, hi); const float li = __shfl(linv, q);
#pragma unroll
            for (int db = 0; db < 2; ++db) stg[q * 64 + db * 32 + r32] = (unsigned short)f2bf(o[db][r] * li); }
        int ln2 = lane; asm volatile("" : "+v"(ln2));
#pragma unroll
        for (int i4 = 0; i4 < 4; ++i4) { const int row = i4 * 8 + (ln2 >> 3), ch = ln2 & 7;
            const v4u val = *(const LAS v4u*)((LAS unsigned char*)stg + row * 128 + ch * 16);
            *(v4u*)(OB + (d.rowb + d.res + d.dil * (32 * c + row)) * 768 + d.h * 64 + 8 * ch) = val; }
        if (ln2 < 32) LSE[(d.rowb + d.res + d.dil * (32 * c + ln2)) * 12 + d.h] = m + __builtin_amdgcn_logf(l);
        if (tb2) { tbl_finish(p, trow, ta, lane); trow += tstride; }
        ATT_SYNC();
        d = dn; bi += nblk;
    }
    for (; trow < 32768; trow += tstride) { tbl_load(p, trow, ta, lane); tbl_finish(p, trow, ta, lane); }
}
__device__ __forceinline__ void ph_merge(const Params& p, int bid, int nblk) {
    const bf16* O1 = (const bf16*)p.out; const bf16* O2 = O1 + (size_t)NT * 768; const bf16* O3 = (const bf16*)(p.ws + WS_O3);
    const float* L1 = (const float*)(p.ws + WS_LSE); const float* L2 = L1 + (size_t)NT * 12; const float* L3 = L2 + (size_t)NT * 12; bf16* MIX = (bf16*)(p.ws + WS_XN);
    for (int idx = bid * NTHREADS + opaque_tid(); idx < NT * 96; idx += nblk * NTHREADS) {
        const int t = idx / 96, rem = idx - t * 96, h = rem >> 3, ch = rem & 7;
        const float l1 = L1[t * 12 + h], l2 = L2[t * 12 + h], l3 = L3[t * 12 + h]; const float mx = fmaxf(fmaxf(l1, l2), l3);
        float w1 = __builtin_amdgcn_exp2f(l1 - mx), w2 = __builtin_amdgcn_exp2f(l2 - mx), w3 = __builtin_amdgcn_exp2f(l3 - mx); const float inv = 1.0f / (w1 + w2 + w3); w1 *= inv; w2 *= inv; w3 *= inv;
        const size_t off = (size_t)t * 768 + h * 64 + 8 * ch;
        const v4u a = *(const v4u*)(O1 + off), bq = *(const v4u*)(O2 + off), cq = *(const v4u*)(O3 + off);
        v4u o;
        o.x = pk2(w1 * bflo(a.x) + w2 * bflo(bq.x) + w3 * bflo(cq.x), w1 * bfhi(a.x) + w2 * bfhi(bq.x) + w3 * bfhi(cq.x));
        o.y = pk2(w1 * bflo(a.y) + w2 * bflo(bq.y) + w3 * bflo(cq.y), w1 * bfhi(a.y) + w2 * bfhi(bq.y) + w3 * bfhi(cq.y));
        o.z = pk2(w1 * bflo(a.z) + w2 * bflo(bq.z) + w3 * bflo(cq.z), w1 * bfhi(a.z) + w2 * bfhi(bq.z) + w3 * bfhi(cq.z));
        o.w = pk2(w1 * bflo(a.w) + w2 * bflo(bq.w) + w3 * bflo(cq.w), w1 * bfhi(a.w) + w2 * bfhi(bq.w) + w3 * bfhi(cq.w));
        *(v4u*)(MIX + (size_t)t * DM + 256 + h * 64 + 8 * ch) = o;
    }
}


__device__ __forceinline__ unsigned fkey(float s, unsigned low, unsigned mask) { unsigned u = __builtin_bit_cast(unsigned, s); u = (u & 0x80000000u) ? ~u : (u | 0x80000000u); return (u & ~mask) | low; }
__device__ __forceinline__ float fdec(unsigned k, unsigned mask) { unsigned u = (k & ~mask) | (mask >> 1); u = (u & 0x80000000u) ? (u ^ 0x80000000u) : ~u; return __builtin_bit_cast(float, u); }
#define CE_DESC(a, b) do { const unsigned _mx = (a) > (b) ? (a) : (b), _mn = (a) > (b) ? (b) : (a); (a) = _mx; (b) = _mn; } while (0)
__device__ __forceinline__ void sort16_desc(unsigned (&a)[16]) {
#pragma unroll
    for (int k = 2; k <= 16; k <<= 1)
#pragma unroll
        for (int j = k >> 1; j > 0; j >>= 1)
#pragma unroll
            for (int i = 0; i < 16; ++i) { const int l = i ^ j; if (l > i) { if ((i & k) == 0) CE_DESC(a[i], a[l]); else CE_DESC(a[l], a[i]); } }
}
__device__ __forceinline__ void merge16_desc(unsigned (&c)[16]) {
#pragma unroll
    for (int j = 8; j > 0; j >>= 1)
#pragma unroll
        for (int i = 0; i < 16; ++i) { const int l = i ^ j; if (l > i) CE_DESC(c[i], c[l]); }
}
__device__ __forceinline__ void top16_merge(unsigned (&a)[16], const unsigned (&b)[16]) {
#pragma unroll
    for (int i = 0; i < 16; ++i) a[i] = a[i] > b[15 - i] ? a[i] : b[15 - i];
    merge16_desc(a);
}
__device__ __forceinline__ void top16_of_64(unsigned (&g0)[16], unsigned (&g1)[16], unsigned (&g2)[16], unsigned (&g3)[16]) {
    sort16_desc(g0); sort16_desc(g1); sort16_desc(g2); sort16_desc(g3);
    top16_merge(g0, g1); top16_merge(g2, g3); top16_merge(g0, g2);
}
__host__ __device__ constexpr int stair_slot(int i, int j) { int n = 0; for (int a = 0; a < 16; ++a) for (int b = 0; b < 16; ++b) if ((a + 1) * (b + 1) <= 16) { if (a == i && b == j) return n; ++n; } return n; }
__device__ __forceinline__ void ph_topk_fast(const Params& p, LAS unsigned char* lds, int bid, int nblk) {
    const int lane = opaque_tid() & 63, wave = wave_id(), r32 = lane & 31, hi = lane >> 5;
    const bf16* PQ = (const bf16*)(p.ws + WS_PQ); const bf16* SK = (const bf16*)(p.ws + WS_SUBK);
    unsigned short* ids = (unsigned short*)(p.ws + WS_IDS); float* gates = (float*)(p.ws + WS_GATES);
    const float* SVt = (const float*)(p.ws + WS_SV);
    LAS unsigned* myl = (LAS unsigned*)(lds + wave * 16384 + lane * 128);
    for (int it = bid * NWAVES + wave; it < (NT / 32) * 8; it += nblk * NWAVES) {
        const int tt = it >> 3, h = it & 7, t = tt * 32 + r32;
        unsigned K[2][16];
#pragma unroll
        for (int pp = 0; pp < 2; ++pp) {
            bf16x8_t qf[4];
            { const bf16* qp = PQ + (size_t)t * DM + h * 128 + pp * 64 + 8 * hi;
#pragma unroll
              for (int d0 = 0; d0 < 4; ++d0) qf[d0] = *(const bf16x8_t*)(qp + 16 * d0); }
            unsigned g[4][16];
#pragma unroll
            for (int mt = 0; mt < 4; ++mt) {
                const bf16* kp = SK + ((size_t)((h * 2 + pp) * 4 + mt) * 4 * 64 + lane) * 8;
                f32x16 a = {0.f, 0.f, 0.f, 0.f, 0.f, 0.f, 0.f, 0.f, 0.f, 0.f, 0.f, 0.f, 0.f, 0.f, 0.f, 0.f};
#pragma unroll
                for (int d0 = 0; d0 < 4; ++d0) a = __builtin_amdgcn_mfma_f32_32x32x16_bf16(*(const bf16x8_t*)(kp + d0 * 512), qf[d0], a, 0, 0, 0);
#pragma unroll
                for (int r = 0; r < 16; ++r) g[mt][r] = fkey(a[r], 127u - (unsigned)(32 * mt + crow(r, hi)), 127u);
            }
            top16_of_64(g[0], g[1], g[2], g[3]);
            unsigned o[16];
#pragma unroll
            for (int i = 0; i < 16; ++i) o[i] = (unsigned)__shfl_xor((int)g[0][i], 32);
            top16_merge(g[0], o);
#pragma unroll
            for (int i = 0; i < 16; ++i) K[pp][i] = g[0][i];
        }
#pragma unroll
        for (int i = 0; i < 16; ++i) { myl[i] = K[0][i]; myl[16 + i] = K[1][i]; }
        float v0[16], v1[16];
#pragma unroll
        for (int i = 0; i < 16; ++i) { v0[i] = fdec(K[0][i], 127u); v1[i] = fdec(K[1][i], 127u); }
        unsigned c[4][16];
#pragma unroll
        for (int gi = 0; gi < 4; ++gi)
#pragma unroll
            for (int q = 0; q < 16; ++q) c[gi][q] = 0u;
#pragma unroll
        for (int i = 0; i < 16; ++i)
#pragma unroll
            for (int j = 0; j < 16; ++j) if ((i + 1) * (j + 1) <= 16) { const int n = stair_slot(i, j); c[n >> 4][n & 15] = fkey(v0[i] + v1[j], 255u - (unsigned)(16 * i + j), 255u); }
        top16_of_64(c[0], c[1], c[2], c[3]);
        float e[16]; float sum = 0.f; const float mx = fdec(c[0][0], 255u);
#pragma unroll
        for (int r = 0; r < 16; ++r) { e[r] = __builtin_amdgcn_exp2f((fdec(c[0][r], 255u) - mx) * 1.4426950408889634f); sum += e[r]; }
        const float inv = 1.0f / sum;
        int eid[16];
#pragma unroll
        for (int r = 0; r < 16; ++r) { const unsigned id8 = 255u - (c[0][r] & 255u); const unsigned k0 = myl[id8 >> 4], k1 = myl[16 + (id8 & 15)];
            eid[r] = (int)((127u - (k0 & 127u)) * 128u + (127u - (k1 & 127u))); }
        if (hi == 0) {
#pragma unroll
            for (int q = 0; q < 2; ++q) *(v4u*)(ids + (size_t)t * 128 + h * 16 + 8 * q) = (v4u){(unsigned)eid[8 * q] | ((unsigned)eid[8 * q + 1] << 16), (unsigned)eid[8 * q + 2] | ((unsigned)eid[8 * q + 3] << 16),
                                                                                      (unsigned)eid[8 * q + 4] | ((unsigned)eid[8 * q + 5] << 16), (unsigned)eid[8 * q + 6] | ((unsigned)eid[8 * q + 7] << 16)};
        } else {
#pragma unroll
            for (int q = 0; q < 4; ++q) *(f32x4*)(gates + (size_t)t * 128 + h * 16 + 4 * q) = (f32x4){e[4 * q] * inv * SVt[eid[4 * q]], e[4 * q + 1] * inv * SVt[eid[4 * q + 1]], e[4 * q + 2] * inv * SVt[eid[4 * q + 2]], e[4 * q + 3] * inv * SVt[eid[4 * q + 3]]};
        }
    }
}

__device__ __forceinline__ void ph_ln1_fast(const Params& p, int bid, int nblk) {
    const bf16* y1 = (const bf16*)(p.ws + WS_Y1); bf16* x1 = (bf16*)(p.ws + WS_X1); bf16* h2b = (bf16*)(p.ws + WS_XN); const float* mod = (const float*)(p.ws + WS_MOD);
    const int lane = opaque_tid() & 63, wave = wave_id();
    for (int row = bid * NWAVES + wave; row < NT; row += nblk * NWAVES) {
        const int b = row / SEQ;
        const v2u* yr = (const v2u*)(y1 + (size_t)row * DM) + lane;
        f32x4 v[4]; float s = 0.f;
#pragma unroll
        for (int j = 0; j < 4; ++j) { const v2u w = yr[64 * j]; v[j] = (f32x4){bflo(w.x), bfhi(w.x), bflo(w.y), bfhi(w.y)}; s += (v[j].x + v[j].y) + (v[j].z + v[j].w); }
        float mean = wave_sum(s) * (1.f / DM); float s2 = 0.f;
#pragma unroll
        for (int j = 0; j < 4; ++j) { v[j] = v[j] - mean; s2 += (v[j].x * v[j].x + v[j].y * v[j].y) + (v[j].z * v[j].z + v[j].w * v[j].w); }
        float rstd = rsqrtf(wave_sum(s2) * (1.f / DM) + LN_EPS);
        s = 0.f;
#pragma unroll
        for (int j = 0; j < 4; ++j) { const f32x4 g = *((const f32x4*)p.g1 + lane + 64 * j), be = *((const f32x4*)p.be1 + lane + 64 * j);
            v[j] = v[j] * rstd * g + be; *((v2u*)(x1 + (size_t)row * DM) + lane + 64 * j) = (v2u){pk2(v[j].x, v[j].y), pk2(v[j].z, v[j].w)}; s += (v[j].x + v[j].y) + (v[j].z + v[j].w); }
        mean = wave_sum(s) * (1.f / DM); s2 = 0.f;
#pragma unroll
        for (int j = 0; j < 4; ++j) { v[j] = v[j] - mean; s2 += (v[j].x * v[j].x + v[j].y * v[j].y) + (v[j].z * v[j].z + v[j].w * v[j].w); }
        rstd = rsqrtf(wave_sum(s2) * (1.f / DM) + LN_EPS);
        float amax = 0.f;
#pragma unroll
        for (int j = 0; j < 4; ++j) {
            const f32x4 sh = *((const f32x4*)(mod + b * 6144 + 3072) + lane + 64 * j), sc = *((const f32x4*)(mod + b * 6144 + 4096) + lane + 64 * j);
            const f32x4 o = v[j] * rstd * (1.0f + sc) + sh; v[j] = o;
            amax = fmaxf(amax, fmaxf(fmaxf(fabsf(o.x), fabsf(o.y)), fmaxf(fabsf(o.z), fabsf(o.w))));
            *((v2u*)(h2b + (size_t)row * DM) + lane + 64 * j) = (v2u){pk2(o.x, o.y), pk2(o.z, o.w)};
        }
        amax = wave_max(amax); const float hinv = amax > 0.f ? 127.0f / amax : 0.f;
        unsigned* q4 = (unsigned*)(p.ws + WS_H2Q + (size_t)row * DM) + lane;
#pragma unroll
        for (int j = 0; j < 4; ++j) { unsigned q = 0u;
            q = __builtin_amdgcn_cvt_pk_u8_f32(v[j].x * hinv + 128.0f, 0, q); q = __builtin_amdgcn_cvt_pk_u8_f32(v[j].y * hinv + 128.0f, 1, q);
            q = __builtin_amdgcn_cvt_pk_u8_f32(v[j].z * hinv + 128.0f, 2, q); q = __builtin_amdgcn_cvt_pk_u8_f32(v[j].w * hinv + 128.0f, 3, q);
            q4[64 * j] = q ^ 0x80808080u; }
        if (lane == 0) ((float*)(p.ws + WS_HS))[row] = amax * (1.0f / 127.0f);
    }
}
__device__ __forceinline__ void ph_tables8(const Params& p, int bid, int nblk) {
    const int lane = opaque_tid() & 63, wave = wave_id();
    for (int r = bid * NWAVES + wave; r < 2 * 16384; r += nblk * NWAVES) {
        const bool isv = r >= 16384; const int row = isv ? r - 16384 : r;
        const f32x4* src = (const f32x4*)((isv ? p.pv : p.pu) + (size_t)row * DM + 16 * lane);
        f32x4 a[4]; float amax = 0.f;
#pragma unroll
        for (int j = 0; j < 4; ++j) { a[j] = src[j]; amax = fmaxf(amax, fmaxf(fmaxf(fabsf(a[j].x), fabsf(a[j].y)), fmaxf(fabsf(a[j].z), fabsf(a[j].w)))); }
        amax = wave_max(amax);
        const float inv = amax > 0.f ? 127.0f / amax : 0.f;
        v4u o;
#pragma unroll
        for (int j = 0; j < 4; ++j) { unsigned q = 0u;
            q = __builtin_amdgcn_cvt_pk_u8_f32(a[j].x * inv + 128.0f, 0, q); q = __builtin_amdgcn_cvt_pk_u8_f32(a[j].y * inv + 128.0f, 1, q);
            q = __builtin_amdgcn_cvt_pk_u8_f32(a[j].z * inv + 128.0f, 2, q); q = __builtin_amdgcn_cvt_pk_u8_f32(a[j].w * inv + 128.0f, 3, q);
            o[j] = q ^ 0x80808080u; }
        *(v4u*)(p.ws + (isv ? WS_TV8 : WS_TU8) + (size_t)(lane >> 3) * (2 * MiB) + (size_t)row * 128 + 16 * (lane & 7)) = o;
        if (lane == 0) ((float*)(p.ws + (isv ? WS_SV : WS_SU)))[row] = amax * (1.0f / 127.0f);
    }
}
__device__ __forceinline__ float readlane_f(float v, int l) { return __builtin_bit_cast(float, __builtin_amdgcn_readlane(__builtin_bit_cast(int, v), l)); }
__device__ __forceinline__ float ub0(unsigned u) { return (float)(u & 255u); }
__device__ __forceinline__ float ub1(unsigned u) { return (float)((u >> 8) & 255u); }
__device__ __forceinline__ float ub2(unsigned u) { return (float)((u >> 16) & 255u); }
__device__ __forceinline__ float ub3(unsigned u) { return (float)(u >> 24); }
__device__ __forceinline__ v4u ust_meta(const Params& p, int step, int t0, int stride8, int lane) {
    const int g = step >> 4, k = step & 15; int t = t0 + g * stride8 + (lane >> 3); t = t < NT ? t : NT - 1;
    return *(const v4u*)(p.ws + WS_IDS + (size_t)t * 256 + 16 * k);
}
__device__ __forceinline__ void ust_issue(v4u (&ub)[8], const v4u& idq, const unsigned char* TUs) {
#pragma unroll
    for (int e = 0; e < 8; ++e) { const unsigned w = idq[e >> 1]; const unsigned id = (e & 1) ? (w >> 16) : (w & 0xffffu); ub[e] = *(const v4u*)(TUs + (size_t)id * 128); }
}
__device__ __forceinline__ unsigned short ust_compute(const v4u (&ub)[8], const v4u& idq, const v4u& h0, const v4u& h1, int off8, const float* SUs, int lane) {
    int a[8];
#pragma unroll
    for (int e = 0; e < 8; ++e) { int v = 0;
#pragma unroll
        for (int j = 0; j < 4; ++j) { const unsigned d = ub[e][j]; const unsigned lo = d & 0x0f0f0f0fu, hi = (d >> 4) & 0x0f0f0f0fu;
            const unsigned hl = j < 2 ? h0[2 * j] : h1[2 * j - 4], hh = j < 2 ? h0[2 * j + 1] : h1[2 * j - 3];
            v = __builtin_amdgcn_sdot4((int)lo, (int)hl, v, false); v = __builtin_amdgcn_sdot4((int)hi, (int)hh, v, false); }
        a[e] = v; }
    int a4[4];
#pragma unroll
    for (int k = 0; k < 4; ++k) { const bool up = (lane & 4) != 0; const int keep = up ? a[k + 4] : a[k], send = up ? a[k] : a[k + 4]; a4[k] = keep + __shfl_xor(send, 4); }
    int a2[2];
#pragma unroll
    for (int k = 0; k < 2; ++k) { const bool up = (lane & 2) != 0; const int keep = up ? a4[k + 2] : a4[k], send = up ? a4[k] : a4[k + 2]; a2[k] = keep + __shfl_xor(send, 2); }
    const bool up = (lane & 1) != 0; const int keep = up ? a2[1] : a2[0], send = up ? a2[0] : a2[1];
    const int tot = keep + __shfl_xor(send, 1);
    const int c = lane & 7; const unsigned w2 = (c >> 1) == 0 ? idq.x : ((c >> 1) == 1 ? idq.y : ((c >> 1) == 2 ? idq.z : idq.w));
    const unsigned id = (c & 1) ? (w2 >> 16) : (w2 & 0xffffu);
    return (unsigned short)f2bf((float)(tot - off8) * SUs[id]);
}
__device__ __forceinline__ void ph_udot(const Params& p, int bid, int nblk) {
    unsigned short* P = (unsigned short*)(p.ws + WS_PART);
    const int lane = opaque_tid() & 63, wave = wave_id(), c = lane & 7;
    const int s8 = bid & 7, s = s8 & 3;
    const int nlo = (nblk - s + 7) >> 3, nhi = (nblk - (s + 4) + 7) >> 3;
    const int widx = ((s8 >> 2) ? nlo : 0) * NWAVES + (bid >> 3) * NWAVES + wave, stride8 = (nlo + nhi) * NWAVES * 8;
    const unsigned char* TUs = p.ws + WS_TU8 + (size_t)s * (2 * MiB) + 16 * c;
    const float* SUs = (const float*)(p.ws + WS_SU) + (size_t)s * 16384;
    const int t0 = widx * 8;
    const int ngroups = t0 < NT ? (NT - t0 + stride8 - 1) / stride8 : 0, nsteps = ngroups * 16;
    if (nsteps == 0) return;
    v4u uA[8], uB[8];
    v4u qa = ust_meta(p, 0, t0, stride8, lane);
    ust_issue(uA, qa, TUs);
    v4u qb = ust_meta(p, 1, t0, stride8, lane);
    v4u h0 = {0u, 0u, 0u, 0u}, h1 = {0u, 0u, 0u, 0u}; int off8 = 0;
    for (int st = 0; st < nsteps; st += 2) {
        const int tg = t0 + (st >> 4) * stride8 + (lane >> 3); const int t = tg < NT ? tg : NT - 1;
        if ((st & 15) == 0) {
            const unsigned char* hp = p.ws + WS_H2Q + (size_t)t * DM + 256 * s + 32 * c; h0 = *(const v4u*)hp; h1 = *(const v4u*)(hp + 16);
            int hs = 0;
#pragma unroll
            for (int j = 0; j < 4; ++j) { hs = __builtin_amdgcn_sdot4((int)h0[j], 0x01010101, hs, false); hs = __builtin_amdgcn_sdot4((int)h1[j], 0x01010101, hs, false); }
            hs += __shfl_xor(hs, 1); hs += __shfl_xor(hs, 2); hs += __shfl_xor(hs, 4); off8 = 8 * hs;
        }
        ust_issue(uB, qb, TUs);
        const v4u ia = qa; qa = ust_meta(p, st + 2 < nsteps ? st + 2 : st, t0, stride8, lane);
        const unsigned short ra = ust_compute(uA, ia, h0, h1, off8, SUs, lane);
        if (st + 2 < nsteps) ust_issue(uA, qa, TUs);
        const v4u ib = qb; qb = ust_meta(p, st + 3 < nsteps ? st + 3 : st + 1, t0, stride8, lane);
        const unsigned short rb = ust_compute(uB, ib, h0, h1, off8, SUs, lane);
        if (tg < NT) { unsigned short* dst = P + ((size_t)t * 4 + s) * 128 + 8 * (st & 15) + c; dst[0] = ra; dst[8] = rb; }
    }
}
__device__ __forceinline__ void ph_act(const Params& p, int bid, int nblk) {
    const bf16* P = (const bf16*)(p.ws + WS_PART); const float* GS = (const float*)(p.ws + WS_GATES); const float* HS = (const float*)(p.ws + WS_HS);
    unsigned char* WQ = p.ws + WS_WQ; float* WSC = (float*)(p.ws + WS_WSC);
    const int lane = opaque_tid() & 63, wave = wave_id();
    for (int t = bid * NWAVES + wave; t < NT; t += nblk * NWAVES) {
        float a0 = 0.f, a1 = 0.f;
#pragma unroll
        for (int s = 0; s < 4; ++s) { a0 += __builtin_bit_cast(float, (unsigned)P[((size_t)t * 4 + s) * 128 + lane] << 16); a1 += __builtin_bit_cast(float, (unsigned)P[((size_t)t * 4 + s) * 128 + 64 + lane] << 16); }
        const float hs = HS[t];
        const float d0 = a0 * hs, d1 = a1 * hs;
        const float w0 = GS[(size_t)t * 128 + lane] * 0.5f * d0 * (1.0f + erff(d0 * 0.70710678118654752f));
        const float w1 = GS[(size_t)t * 128 + 64 + lane] * 0.5f * d1 * (1.0f + erff(d1 * 0.70710678118654752f));
        const float wmax = wave_max(fmaxf(fabsf(w0), fabsf(w1))); const float winv = wmax > 0.f ? 127.0f / wmax : 0.f;
        unsigned b2 = __builtin_amdgcn_cvt_pk_u8_f32(w0 * winv + 128.0f, 0, 0u); b2 = __builtin_amdgcn_cvt_pk_u8_f32(w1 * winv + 128.0f, 1, b2); b2 ^= 0x8080u;
        WQ[(size_t)t * 128 + lane] = (unsigned char)(b2 & 255u); WQ[(size_t)t * 128 + 64 + lane] = (unsigned char)((b2 >> 8) & 255u);
        if (lane == 0) WSC[t] = wmax * (1.0f / 127.0f);
    }
}
struct VstepMeta { v4u idq; v2u wq; };
__device__ __forceinline__ VstepMeta vst_meta(const Params& p, int step, int t0, int stride8, int lane) {
    const int g = step >> 4, k = step & 15; int t = t0 + g * stride8 + (lane >> 3); t = t < NT ? t : NT - 1;
    VstepMeta r; r.idq = *(const v4u*)(p.ws + WS_IDS + (size_t)t * 256 + 16 * k); r.wq = *(const v2u*)(p.ws + WS_WQ + (size_t)t * 128 + 8 * k); return r;
}
__device__ __forceinline__ void vst_issue(v4u (&vb)[8], const VstepMeta& q, const unsigned char* TVs) {
#pragma unroll
    for (int e = 0; e < 8; ++e) { const unsigned w = q.idq[e >> 1]; const unsigned id = (e & 1) ? (w >> 16) : (w & 0xffffu); vb[e] = *(const v4u*)(TVs + (size_t)id * 128); }
}
__device__ __forceinline__ void vst_compute(int (&y)[16], const v4u (&vb)[8], const v2u& wq) {
#pragma unroll
    for (int qd = 0; qd < 2; ++qd)
#pragma unroll
        for (int cm = 0; cm < 4; ++cm) {
            const unsigned A = vb[4 * qd][cm], B = vb[4 * qd + 1][cm], C = vb[4 * qd + 2][cm], D = vb[4 * qd + 3][cm];
            const unsigned ab01 = __builtin_amdgcn_perm(B, A, 0x05010400u), ab23 = __builtin_amdgcn_perm(B, A, 0x07030602u);
            const unsigned cd01 = __builtin_amdgcn_perm(D, C, 0x05010400u), cd23 = __builtin_amdgcn_perm(D, C, 0x07030602u);
            const unsigned t0 = __builtin_amdgcn_perm(cd01, ab01, 0x05040100u), t1 = __builtin_amdgcn_perm(cd01, ab01, 0x07060302u);
            const unsigned t2 = __builtin_amdgcn_perm(cd23, ab23, 0x05040100u), t3 = __builtin_amdgcn_perm(cd23, ab23, 0x07060302u);
            y[4 * cm + 0] = __builtin_amdgcn_sdot4((int)t0, (int)wq[qd], y[4 * cm + 0], false); y[4 * cm + 1] = __builtin_amdgcn_sdot4((int)t1, (int)wq[qd], y[4 * cm + 1], false);
            y[4 * cm + 2] = __builtin_amdgcn_sdot4((int)t2, (int)wq[qd], y[4 * cm + 2], false); y[4 * cm + 3] = __builtin_amdgcn_sdot4((int)t3, (int)wq[qd], y[4 * cm + 3], false);
        }
}
__device__ __forceinline__ void ph_vacc(const Params& p, int bid, int nblk) {
    bf16* Y = (bf16*)(p.ws + WS_Y); const float* WSC = (const float*)(p.ws + WS_WSC);
    const int lane = opaque_tid() & 63, wave = wave_id(), c = lane & 7;
    const int s = bid & 7, nper = (nblk - s + 7) >> 3,     stride8 = nper * NWAVES * 8;
    const unsigned char* TVs = p.ws + WS_TV8 + (size_t)s * (2 * MiB) + 16 * c;
    const int t0 = ((bid >> 3) * NWAVES + wave) * 8;
    const int ngroups = t0 < NT ? (NT - t0 + stride8 - 1) / stride8 : 0, nsteps = ngroups * 16;
    if (nsteps == 0) return;
    int y[16];
#pragma unroll
    for (int k = 0; k < 16; ++k) y[k] = 0;
    v4u vA[8], vB[8];
    VstepMeta qa = vst_meta(p, 0, t0, stride8, lane);
    vst_issue(vA, qa, TVs);
    VstepMeta qb = vst_meta(p, 1, t0, stride8, lane);
    for (int st = 0; st < nsteps; st += 2) {
        vst_issue(vB, qb, TVs);
        const v2u wa = qa.wq; qa = vst_meta(p, st + 2 < nsteps ? st + 2 : st, t0, stride8, lane);
        vst_compute(y, vA, wa);
        if (st + 2 < nsteps) vst_issue(vA, qa, TVs);
        const v2u wb = qb.wq; qb = vst_meta(p, st + 3 < nsteps ? st + 3 : st + 1, t0, stride8, lane);
        vst_compute(y, vB, wb);
        if (((st + 1) & 15) == 15) {
            const int t = t0 + (st >> 4) * stride8 + (lane >> 3);
            if (t < NT) { const float sc = WSC[t];
                v4u o0, o1; o0.x = pk2((float)y[0] * sc, (float)y[1] * sc); o0.y = pk2((float)y[2] * sc, (float)y[3] * sc); o0.z = pk2((float)y[4] * sc, (float)y[5] * sc); o0.w = pk2((float)y[6] * sc, (float)y[7] * sc);
                o1.x = pk2((float)y[8] * sc, (float)y[9] * sc); o1.y = pk2((float)y[10] * sc, (float)y[11] * sc); o1.z = pk2((float)y[12] * sc, (float)y[13] * sc); o1.w = pk2((float)y[14] * sc, (float)y[15] * sc);
                v4u* dst = (v4u*)(Y + (size_t)t * DM + 128 * s + 16 * c); dst[0] = o0; dst[1] = o1; }
#pragma unroll
            for (int k = 0; k < 16; ++k) y[k] = 0;
        }
    }
}
__device__ __forceinline__ void ph_final(const Params& p, int bid, int nblk) {
    const bf16* x1 = (const bf16*)(p.ws + WS_X1); const bf16* Y = (const bf16*)(p.ws + WS_Y); const float* mod = (const float*)(p.ws + WS_MOD);
    const int lane = opaque_tid() & 63, wave = wave_id();
    for (int t = bid * NWAVES + wave; t < NT; t += nblk * NWAVES) {
        const int b = t / SEQ;
        f32x4 v[4]; float s = 0.f;
#pragma unroll
        for (int j = 0; j < 4; ++j) { const v2u xw = *((const v2u*)(x1 + (size_t)t * DM) + lane + 64 * j), yw = *((const v2u*)(Y + (size_t)t * DM) + lane + 64 * j);
            const f32x4 g2 = *((const f32x4*)(mod + b * 6144 + 5120) + lane + 64 * j);
            const f32x4 xv = {bflo(xw.x), bfhi(xw.x), bflo(xw.y), bfhi(xw.y)}, yv = {bflo(yw.x), bfhi(yw.x), bflo(yw.y), bfhi(yw.y)};
            v[j] = xv * ALPHA + (g2 + 1.0f) * yv; s += (v[j].x + v[j].y) + (v[j].z + v[j].w); }
        const float mean = wave_sum(s) * (1.f / DM); float s2 = 0.f;
#pragma unroll
        for (int j = 0; j < 4; ++j) { v[j] = v[j] - mean; s2 += (v[j].x * v[j].x + v[j].y * v[j].y) + (v[j].z * v[j].z + v[j].w * v[j].w); }
        const float rstd = rsqrtf(wave_sum(s2) * (1.f / DM) + LN_EPS);
#pragma unroll
        for (int j = 0; j < 4; ++j) { const f32x4 g = *((const f32x4*)p.g2 + lane + 64 * j), be = *((const f32x4*)p.be2 + lane + 64 * j);
            *((f32x4*)(p.out + (size_t)t * DM) + lane + 64 * j) = v[j] * rstd * g + be; }
    }
}

#ifndef PROBE_ID
#define PROBE_ID 0
#endif
#define RUN2(id, ...) do { __VA_ARGS__; if (PROBE_ID == (id)) { xcd_barrier(bar); __VA_ARGS__; } } while (0)
__global__ void __launch_bounds__(NTHREADS, 2) mega(Params p) {
    extern __shared__ __attribute__((aligned(16))) unsigned char lds_raw[];

    LAS unsigned char* lds = (LAS unsigned char*)lds_raw;
    const int bid = blockIdx.x, nblk = gridDim.x, tid = opaque_tid();
    for (int u = tid; u < (LDS_BYTES - LDSCTL_OFF) / 4; u += NTHREADS) ((LAS unsigned*)(lds + LDSCTL_OFF))[u] = 0u;
    __syncthreads();
    unsigned* ctl = (unsigned*)(p.ws + WS_CTL);
    XcdBarrier bar = xcd_barrier_post(ctl + CW_BAR, (volatile LAS unsigned*)(lds + MISC_OFF) + 8);
    const float* mod = (const float*)(p.ws + WS_MOD);

    ph_mod(p, lds, bid, nblk);
    xcd_barrier(bar);
    RUN2(1, ph_prologue(p, lds, bid, nblk));
    RUN2(7, ph_xn(p, bid, nblk));
    xcd_barrier(bar);
    {
        pg8::Gemm g{(const pg8::bf16_t*)(p.ws + WS_XN), (const pg8::bf16_t*)(p.ws + WS_WIN), NT, NIN, DM}; pg8::StaticOrder S; S.init(NT, NIN, nblk, bid);
        EpiIn E{(bf16*)(p.ws + WS_FZ), (bf16*)(p.ws + WS_QB), (const float*)(p.ws + WS_MISC), (const float*)(p.ws + WS_ROPE)};
        pg8::gemm_phase<EpiIn, pg8::StaticOrder, true, true>(lds, g, S, E);
    }
    xcd_barrier(bar);
    RUN2(8, ph_fft(p, lds, bid, nblk));
    RUN2(2, ph_attn_fast(p, lds, bid, nblk));
    xcd_barrier(bar);
    RUN2(3, ph_merge(p, bid, nblk));
    xcd_barrier(bar);
    {
        pg8::Gemm g{(const pg8::bf16_t*)(p.ws + WS_XN), (const pg8::bf16_t*)(p.ws + WS_WOUT), NT, DM, DM}; pg8::StaticOrder S; S.init(NT, DM, nblk, bid);
        EpiOut E{(bf16*)(p.ws + WS_Y1), p.x, mod, p.b_out};
        pg8::gemm_phase<EpiOut, pg8::StaticOrder, true, true>(lds, g, S, E);
    }
    xcd_barrier(bar);
    RUN2(4, ph_ln1_fast(p, bid, nblk));
    xcd_barrier(bar);
    {
        pg8::Gemm g{(const pg8::bf16_t*)(p.ws + WS_XN), (const pg8::bf16_t*)(p.ws + WS_WPQ), NT, DM, DM}; pg8::StaticOrder S; S.init(NT, DM, nblk, bid);
        pg8::EpiBf16<0> E{(pg8::bf16_t*)(p.ws + WS_PQ), DM, nullptr, 0, 0, 1.f};
        pg8::gemm_phase<pg8::EpiBf16<0>, pg8::StaticOrder, true, true>(lds, g, S, E);
    }
    xcd_barrier(bar);
    RUN2(5, ph_topk_fast(p, lds, bid, nblk));
    xcd_barrier(bar);
    RUN2(6, ph_udot(p, bid, nblk));
    xcd_barrier(bar);
    RUN2(11, ph_act(p, bid, nblk));
    xcd_barrier(bar);
    RUN2(10, ph_vacc(p, bid, nblk));
    xcd_barrier(bar);
    ph_final(p, bid, nblk);
}

extern "C" void kernel_launch(void* const* d_in, const int* in_sizes, int n_in, void* d_out, int out_size, void* d_ws, size_t ws_size, hipStream_t stream) {
    Params p{};
    p.x = (const float*)d_in[0]; p.c = (const float*)d_in[1]; p.pos = (const int*)d_in[2]; p.w_ada = (const float*)d_in[3]; p.b_ada = (const float*)d_in[4];
    p.w_in = (const float*)d_in[5]; p.b_in = (const float*)d_in[6]; p.w_four = (const float*)d_in[7]; p.w_out = (const float*)d_in[8]; p.b_out = (const float*)d_in[9];
    p.g1 = (const float*)d_in[10]; p.be1 = (const float*)d_in[11]; p.w_pq = (const float*)d_in[12]; p.subk = (const float*)d_in[13]; p.pu = (const float*)d_in[14]; p.pv = (const float*)d_in[15];
    p.g2 = (const float*)d_in[16]; p.be2 = (const float*)d_in[17]; p.out = (float*)d_out; p.ws = (unsigned char*)d_ws;
    static int grid_blocks = 0;
    if (grid_blocks == 0) {
        if (ws_size < WS_END) { fprintf(stderr, "workspace too small: %zu < %zu\n", ws_size, (size_t)WS_END); grid_blocks = -1; return; }
        int dev = 0, cus = 0, per_cu = 0;
        if (hipGetDevice(&dev) != hipSuccess || hipDeviceGetAttribute(&cus, hipDeviceAttributeMultiprocessorCount, dev) != hipSuccess) { grid_blocks = -1; return; }
        if (hipFuncSetAttribute((const void*)mega, hipFuncAttributeMaxDynamicSharedMemorySize, LDS_BYTES) != hipSuccess) { fprintf(stderr, "hipFuncSetAttribute failed\n"); grid_blocks = -1; return; }
        if (hipOccupancyMaxActiveBlocksPerMultiprocessor(&per_cu, (const void*)mega, NTHREADS, LDS_BYTES) != hipSuccess || per_cu < 1) { fprintf(stderr, "occupancy query: %d\n", per_cu); grid_blocks = -1; return; }
        grid_blocks = cus;
    }
    if (grid_blocks < 0) return;
    if (hipMemsetAsync((char*)d_ws + WS_CTL, 0, CTL_ZERO_BYTES, stream) != hipSuccess) { fprintf(stderr, "memset failed\n"); return; }
    void* args[] = {&p};
    hipError_t e = hipLaunchCooperativeKernel((void*)mega, dim3(grid_blocks), dim3(NTHREADS), args, LDS_BYTES, stream);
    if (e != hipSuccess) fprintf(stderr, "cooperative launch failed: %s (grid %d)\n", hipGetErrorString(e), grid_blocks);
}
```

```cpp
#include <hip/hip_runtime.h>
#include <hip/hip_cooperative_groups.h>
#include <cstdio>
#include <cstdint>
#include <cmath>
namespace cg = cooperative_groups;

namespace pg8 {
#define PG8_LAS __attribute__((address_space(3)))
typedef unsigned short bf16_t;
typedef short bf16x8 __attribute__((ext_vector_type(8)));
typedef float f32x4 __attribute__((ext_vector_type(4)));
typedef unsigned u32x4 __attribute__((ext_vector_type(4)));
constexpr int BM = 256, BK = 64, HALF = 128, HTB = HALF * BK * 2  , STAGE_BYTES = 8 * HTB, NXCD = 8, WGM = 8;

__host__ __device__ __forceinline__ int lds_byte(int r, int c) { const int st = (r >> 4) * 2 + (c >> 5), rr = r & 15, cc = c & 31, ob = rr * 64 + cc * 2; return st * 1024 + (ob ^ (((ob >> 9) & 1) << 5)); }
__host__ __device__ __forceinline__ void stage_rc(int b, int& R, int& C) { const int st = b / 1024, sb = b % 1024, swz = sb ^ (((sb >> 9) & 1) << 5); R = (st >> 1) * 16 + swz / 64; C = (st & 1) * 32 + (swz % 64) / 2; }
__host__ __device__ __forceinline__ int perm32(int rho) { const int n = rho >> 4, i = rho & 15; return 8 * (i >> 2) + 4 * n + (i & 3); }

struct Unit { int pm, pn; };
struct Gemm { const bf16_t* A; const bf16_t* Bt; int M, N, K; };

struct StaticOrder {
    int nM, nN, nwg, G, c;
    __host__ __device__ void init(int M, int N, int G_, int c_) { nM = M / BM; nN = N / BM; nwg = nM * nN; G = G_; c = c_; }
    __host__ __device__ bool next(int i, Unit& u) const {
        const long L = (long)i * G + c; if (L >= nwg) return false;
        int wgid = (int)L; { const int q = nwg / NXCD, r = nwg % NXCD, xcd = wgid % NXCD, off = wgid / NXCD; wgid = (xcd < r ? xcd * (q + 1) : r * (q + 1) + (xcd - r) * q) + off; }
        const int nig = WGM * nN, gid = wgid / nig, fm = gid * WGM, gsz = (nM - fm) < WGM ? (nM - fm) : WGM;
        u.pm = fm + ((wgid % nig) % gsz); u.pn = (wgid % nig) / gsz; return true;
    }
    __device__ __forceinline__ void a_ready(const Unit&) const {}
    __device__ __forceinline__ void done(const Unit&) const {}
};

__device__ __forceinline__ unsigned cvt_pk_bf16(float lo, float hi) { unsigned r; asm volatile("v_cvt_pk_bf16_f32 %0, %1, %2" : "=v"(r) : "v"(lo), "v"(hi)); return r; }
typedef float f32x2 __attribute__((ext_vector_type(2)));
__device__ __forceinline__ f32x2 gelu_pk(f32x2 v) {
    const f32x2 av = __builtin_elementwise_abs(v), d = av * 0.2316418882f + 1.0f;
    f32x2 t; t.x = __builtin_amdgcn_rcpf(d.x); t.y = __builtin_amdgcn_rcpf(d.y);
    f32x2 q = t * 0.5307027145f + (-0.7265760135f); q = q * t + 0.7107068705f; q = q * t + (-0.142248368f); q = q * t + 0.127414796f; q = q * t;
    const f32x2 s = (v * v) * (-0.72134752044f);
    f32x2 e; e.x = __builtin_amdgcn_exp2f(s.x); e.y = __builtin_amdgcn_exp2f(s.y);
    const f32x2 m = v * (q * e), r = v - m;
    f32x2 o; o.x = v.x < 0.f ? m.x : r.x; o.y = v.y < 0.f ? m.y : r.y; return o;
}

template <int ACT  > struct EpiBf16 {
    static constexpr bool PERM = true, AFTER_DRAIN = false; static_assert(ACT == 0 || ACT == 1, "EpiBf16: ACT is 0 (none) or 1 (gelu_pk)");
    bf16_t* O; int ldc; const float* bias; int split_cols; size_t split_stride; float scale0;
    __device__ __forceinline__ void operator()(const f32x4 (&acc)[2][2][4][2], const Unit& u, int wr, int wc, int fr, int fq) const {
        const int row0 = u.pm * BM + wr * 64 + fr; int colt = u.pn * BM; bf16_t* base = O;
        float sc = 1.f; if (split_cols) { const int t = colt / split_cols; base += (size_t)t * split_stride; colt -= t * split_cols; if (t == 0) sc = scale0; }
        const int col0 = colt + wc * 32 + 8 * fq, bcol0 = u.pn * BM + wc * 32 + 8 * fq;
        f32x4 bv[2][2];
#pragma unroll
        for (int bj = 0; bj < 2; ++bj)
#pragma unroll
            for (int n = 0; n < 2; ++n) bv[bj][n] = bias ? *(const f32x4*)(bias + bcol0 + bj * HALF + 4 * n) : (f32x4){0.f, 0.f, 0.f, 0.f};
#pragma unroll
        for (int ai = 0; ai < 2; ++ai)
#pragma unroll
            for (int m = 0; m < 4; ++m) { bf16_t* rowp = base + (size_t)(row0 + ai * HALF + m * 16) * ldc + col0;
#pragma unroll
                for (int bj = 0; bj < 2; ++bj) { f32x4 v0 = acc[ai][bj][m][0] + bv[bj][0], v1 = acc[ai][bj][m][1] + bv[bj][1];
                    if (ACT == 1) { f32x2 a = gelu_pk((f32x2){v0[0], v0[1]}), b = gelu_pk((f32x2){v0[2], v0[3]}), c = gelu_pk((f32x2){v1[0], v1[1]}), d = gelu_pk((f32x2){v1[2], v1[3]});
                        v0 = (f32x4){a.x, a.y, b.x, b.y}; v1 = (f32x4){c.x, c.y, d.x, d.y}; }
                    v0 = v0 * sc; v1 = v1 * sc; u32x4 w; w.x = cvt_pk_bf16(v0[0], v0[1]); w.y = cvt_pk_bf16(v0[2], v0[3]); w.z = cvt_pk_bf16(v1[0], v1[1]); w.w = cvt_pk_bf16(v1[2], v1[3]);
                    *(u32x4*)(rowp + bj * HALF) = w; } }
    }
};
template <class Epi, class Sched, bool ALIGN_EPI = false, bool SP2 = false>
__device__ __forceinline__ void gemm_phase(PG8_LAS unsigned char* lds, const Gemm g, const Sched& S, const Epi& E) {
    int tid_ = threadIdx.x; asm volatile("" : "+v"(tid_)); const int tid = tid_, wid = __builtin_amdgcn_readfirstlane(tid >> 6), lane = tid & 63, wr = wid >> 2, wc = wid & 3, fr = lane & 15, fq = lane >> 4;
    const int K = g.K, nt = K / BK;
    unsigned voffA[2], voffB[2];
#pragma unroll
    for (int i = 0; i < 2; ++i) { int R, C; stage_rc(tid * 16 + i * 8192, R, C); const int Rb = Epi::PERM ? ((R & ~31) + perm32(R & 31)) : R;
        voffA[i] = (unsigned)(R * K + C) * 2u; voffB[i] = (unsigned)(Rb * K + C) * 2u; }
    const size_t kstep = (size_t)(BK * 2);
    const size_t hstep = (size_t)HALF * K * 2;
    const size_t tstep = 2 * hstep;
    const unsigned ldsw = (unsigned)wid * 1024u;
    const int aoff = lds_byte(wr * 64 + fr, fq * 8), boff = lds_byte(wc * 32 + fr, fq * 8);
#define PG8_SA(b, h) (((b) * 2 + (h)) * HTB)
#define PG8_SB(b, h) ((4 + (b) * 2 + (h)) * HTB)
#define PG8_STAGE(bufoff, gbase, voff) do { _Pragma("unroll") for (int _i = 0; _i < 2; ++_i) \
        __builtin_amdgcn_global_load_lds((const unsigned*)((const char*)(gbase) + (voff)[_i]), (PG8_LAS unsigned*)(lds + (bufoff) + ldsw + _i * 8192), 16, 0, 0); } while (0)
#define PG8_LDA(dst, b, h) do { _Pragma("unroll") for (int m = 0; m < 4; ++m) _Pragma("unroll") for (int k = 0; k < 2; ++k) dst[m][k] = *(const PG8_LAS bf16x8*)(lds + PG8_SA(b, h) + aoff + m * 2048 + k * 1024); } while (0)
#define PG8_LDB(dst, b, h) do { _Pragma("unroll") for (int n = 0; n < 2; ++n) _Pragma("unroll") for (int k = 0; k < 2; ++k) dst[n][k] = *(const PG8_LAS bf16x8*)(lds + PG8_SB(b, h) + boff + n * 2048 + k * 1024); } while (0)
#define PG8_MMA(ai, bj, At, Bt) do { __builtin_amdgcn_s_setprio(1); _Pragma("unroll") for (int m = 0; m < 4; ++m) _Pragma("unroll") for (int n = 0; n < 2; ++n) _Pragma("unroll") for (int k = 0; k < 2; ++k) \
        acc[ai][bj][m][n] = __builtin_amdgcn_mfma_f32_16x16x32_bf16(Bt[n][k], At[m][k], acc[ai][bj][m][n], 0, 0, 0); __builtin_amdgcn_s_setprio(0); } while (0)
#define PG8_WAIT_V(n) asm volatile("s_waitcnt vmcnt(" #n ")" ::: "memory")
#define PG8_WAIT_L(n) asm volatile("s_waitcnt lgkmcnt(" #n ")" ::: "memory")
#define PG8_BAR __builtin_amdgcn_s_barrier()
#define PG8_SCHED __builtin_amdgcn_sched_barrier(0)
    Unit cur, nxt; int ui = 0;
    if (!S.next(0, cur)) return;
    f32x4 acc[2][2][4][2];
#pragma unroll
    for (int a = 0; a < 2; ++a)
#pragma unroll
        for (int b = 0; b < 2; ++b)
#pragma unroll
            for (int m = 0; m < 4; ++m)
#pragma unroll
                for (int n = 0; n < 2; ++n) acc[a][b][m][n] = (f32x4){0.f, 0.f, 0.f, 0.f};
    bf16x8 At[4][2], B0[2][2], B1[2][2];
    const char* cA = (const char*)g.A + (size_t)cur.pm * tstep; const char* cB = (const char*)g.Bt + (size_t)cur.pn * tstep;
    S.a_ready(cur);
    if constexpr (SP2) {
        PG8_STAGE(PG8_SB(0, 0), cB, voffB); PG8_STAGE(PG8_SB(0, 1), cB + hstep, voffB); PG8_STAGE(PG8_SA(0, 0), cA, voffA); PG8_STAGE(PG8_SA(0, 1), cA + hstep, voffA);
        if (wr == 1) PG8_BAR;
        PG8_WAIT_V(2); PG8_BAR;
        PG8_STAGE(PG8_SB(1, 0), cB + kstep, voffB); PG8_STAGE(PG8_SA(1, 0), cA + kstep, voffA); PG8_STAGE(PG8_SB(1, 1), cB + hstep + kstep, voffB);
        PG8_WAIT_V(6); PG8_BAR;
    } else {
        PG8_STAGE(PG8_SB(0, 0), cB, voffB); PG8_STAGE(PG8_SA(0, 0), cA, voffA); PG8_STAGE(PG8_SB(0, 1), cB + hstep, voffB); PG8_STAGE(PG8_SA(0, 1), cA + hstep, voffA);
        if (wr == 1) PG8_BAR;
        PG8_WAIT_V(4); PG8_BAR;
        PG8_STAGE(PG8_SB(1, 0), cB + kstep, voffB); PG8_STAGE(PG8_SA(1, 0), cA + kstep, voffA); PG8_STAGE(PG8_SB(1, 1), cB + hstep + kstep, voffB);
        PG8_WAIT_V(6); PG8_BAR;
    }
    for (;;) {
        const bool has_next = S.next(ui + 1, nxt);
        const char* nA = has_next ? (const char*)g.A + (size_t)nxt.pm * tstep : cA; const char* nB = has_next ? (const char*)g.Bt + (size_t)nxt.pn * tstep : cB;
        for (int t = 0; t < nt; t += 2) {
            const bool last = (t == nt - 2);
            const char* a1 = cA + (size_t)(t + 1) * kstep;
            const char* a2 = last ? nA : cA + (size_t)(t + 2) * kstep; const char* b2 = last ? nB : cB + (size_t)(t + 2) * kstep;
            const char* a3 = a2 + kstep; const char* b3 = b2 + kstep;
            if (last && has_next) S.a_ready(nxt);
            if constexpr (SP2) {
            PG8_LDB(B0, 0, 0); PG8_LDB(B1, 0, 1); PG8_SCHED; PG8_LDA(At, 0, 0); PG8_STAGE(PG8_SA(1, 1), a1 + hstep, voffA);
            PG8_WAIT_V(8); PG8_WAIT_L(0); PG8_BAR; PG8_MMA(0, 0, At, B0); PG8_MMA(0, 1, At, B1); PG8_BAR; PG8_SCHED;
            PG8_LDA(At, 0, 1); PG8_STAGE(PG8_SB(0, 0), b2, voffB); PG8_STAGE(PG8_SB(0, 1), b2 + hstep, voffB); PG8_STAGE(PG8_SA(0, 0), a2, voffA);
            PG8_WAIT_V(8); PG8_WAIT_L(0); PG8_BAR; PG8_MMA(1, 0, At, B0); PG8_MMA(1, 1, At, B1); PG8_BAR; PG8_SCHED;
            PG8_LDB(B0, 1, 0); PG8_LDB(B1, 1, 1); PG8_SCHED; PG8_LDA(At, 1, 0); PG8_STAGE(PG8_SA(0, 1), a2 + hstep, voffA);
            PG8_WAIT_V(8); PG8_WAIT_L(0); PG8_BAR; PG8_MMA(0, 0, At, B0); PG8_MMA(0, 1, At, B1); PG8_BAR; PG8_SCHED;
            PG8_LDA(At, 1, 1); PG8_STAGE(PG8_SB(1, 0), b3, voffB); PG8_STAGE(PG8_SB(1, 1), b3 + hstep, voffB); PG8_STAGE(PG8_SA(1, 0), a3, voffA);
            PG8_WAIT_V(8); PG8_WAIT_L(0); PG8_BAR; PG8_MMA(1, 0, At, B0); PG8_MMA(1, 1, At, B1); PG8_BAR; PG8_SCHED;
            } else {
            PG8_LDB(B0, 0, 0); PG8_SCHED; PG8_LDA(At, 0, 0); PG8_STAGE(PG8_SA(1, 1), a1 + hstep, voffA);
            PG8_WAIT_L(8); PG8_BAR; PG8_WAIT_L(0); PG8_MMA(0, 0, At, B0); PG8_BAR; PG8_SCHED;
            PG8_LDB(B1, 0, 1); PG8_STAGE(PG8_SB(0, 0), b2, voffB);
            PG8_BAR; PG8_WAIT_L(0); PG8_MMA(0, 1, At, B1); PG8_BAR;
            PG8_LDA(At, 0, 1); PG8_STAGE(PG8_SA(0, 0), a2, voffA);
            PG8_BAR; PG8_WAIT_L(0); PG8_MMA(1, 0, At, B0); PG8_BAR; PG8_SCHED;
            PG8_STAGE(PG8_SB(0, 1), b2 + hstep, voffB);
            PG8_WAIT_V(6); PG8_BAR; PG8_MMA(1, 1, At, B1); PG8_BAR;
            PG8_LDB(B0, 1, 0); PG8_SCHED; PG8_LDA(At, 1, 0); PG8_STAGE(PG8_SA(0, 1), a2 + hstep, voffA);
            PG8_WAIT_L(8); PG8_BAR; PG8_WAIT_L(0); PG8_MMA(0, 0, At, B0); PG8_BAR; PG8_SCHED;
            PG8_LDB(B1, 1, 1); PG8_STAGE(PG8_SB(1, 0), b3, voffB);
            PG8_BAR; PG8_WAIT_L(0); PG8_MMA(0, 1, At, B1); PG8_BAR;
            PG8_LDA(At, 1, 1); PG8_STAGE(PG8_SA(1, 0), a3, voffA);
            PG8_BAR; PG8_WAIT_L(0); PG8_MMA(1, 0, At, B0); PG8_BAR; PG8_SCHED;
            PG8_STAGE(PG8_SB(1, 1), b3 + hstep, voffB);
            PG8_WAIT_V(6); PG8_BAR; PG8_MMA(1, 1, At, B1); PG8_BAR;
            }
        }
        if constexpr (ALIGN_EPI) { if (wr == 0) PG8_BAR; }
        if constexpr (!Epi::AFTER_DRAIN) { E(acc, cur, wr, wc, fr, fq); S.done(cur); }
        if (!has_next) break;
#pragma unroll
        for (int a = 0; a < 2; ++a)
#pragma unroll
            for (int b = 0; b < 2; ++b)
#pragma unroll
                for (int m = 0; m < 4; ++m)
#pragma unroll
                    for (int n = 0; n < 2; ++n) acc[a][b][m][n] = (f32x4){0.f, 0.f, 0.f, 0.f};
        cur = nxt; cA = nA; cB = nB; ++ui;
        if constexpr (ALIGN_EPI) { if (wr == 1) PG8_BAR; }
    }
    PG8_WAIT_V(0);
    if constexpr (!ALIGN_EPI) { if (wr == 0) PG8_BAR; }
    PG8_BAR;
    if constexpr (Epi::AFTER_DRAIN) { E.fused(acc, cur, wr, wc, fr, fq, lds, wid, lane); S.done(cur); }
#undef PG8_SA
#undef PG8_SB
#undef PG8_STAGE
#undef PG8_LDA
#undef PG8_LDB
#undef PG8_MMA
#undef PG8_WAIT_V
#undef PG8_WAIT_L
#undef PG8_BAR
#undef PG8_SCHED
}
}

#define LAS __attribute__((address_space(3)))
#define GAS __attribute__((address_space(1)))
#define XB_TMO      128
#define XB_XCNT(j)  (256  + 64 * (j))
#define XB_XSUB(j)  (1280 + 64 * (j))
#define XB_XGEN(j)  (2304 + 64 * (j))
#define XB_TOP      3328
#define XB_TOPGEN   3392
#define XCD_BAR_WORDS 3456
#define XB_SPIN_CAP (1u << 18)

__device__ __forceinline__ unsigned xb_ld(unsigned* p)              { return __hip_atomic_load(p, __ATOMIC_RELAXED, __HIP_MEMORY_SCOPE_AGENT); }
__device__ __forceinline__ unsigned xb_add(unsigned* p, unsigned v) { return __hip_atomic_fetch_add(p, v, __ATOMIC_RELAXED, __HIP_MEMORY_SCOPE_AGENT); }
__device__ __forceinline__ unsigned xb_xcc_id() { return (unsigned)__builtin_amdgcn_s_getreg((3 << 11) | 20) & 0xFu; }
#define XB_SPIN(cond, bar) do { unsigned _sp = 0; while (cond) { __builtin_amdgcn_s_sleep(1); \
    if ((++_sp & 255u) == 0u) { if (xb_ld(&(bar)[XB_TMO])) break; if (_sp > XB_SPIN_CAP) { atomicAdd(&(bar)[XB_TMO], 1u); break; } } } } while (0)

struct XcdBarrier {
    unsigned* bar; unsigned x;
    volatile LAS unsigned* st;
};

__device__ __forceinline__ XcdBarrier xcd_barrier_post(unsigned* bar, volatile LAS unsigned* st) {
    XcdBarrier b; b.bar = bar; b.x = xb_xcc_id(); b.st = st;
    if (threadIdx.x == 0) (void)xb_add(&bar[XB_XCNT(b.x)], 1u);
    return b;
}
__device__ __forceinline__ void xcd_barrier_complete(unsigned* bar, unsigned x, unsigned& nloc, unsigned& nx) {
    const unsigned G = gridDim.x * gridDim.y * gridDim.z;
    unsigned sum, cnt, mine, sp = 0u;
    for (;;) {
        sum = 0u; cnt = 0u; mine = 0u;
#pragma unroll
        for (unsigned j = 0; j < 16; ++j) { const unsigned c = xb_ld(&bar[XB_XCNT(j)]); sum += c; cnt += (c > 0u) ? 1u : 0u; mine = (j == x) ? c : mine; }
        if (sum == G) break;
        __builtin_amdgcn_s_sleep(1);
        if ((++sp & 255u) == 0u) { if (xb_ld(&bar[XB_TMO])) break; if (sp > XB_SPIN_CAP) { atomicAdd(&bar[XB_TMO], 1u); break; } }
    }
    nloc = mine > 0u ? mine : 1u; nx = cnt > 0u ? cnt : 1u;
}

__device__ __forceinline__ void xcd_barrier(const XcdBarrier& b) {
    asm volatile("s_waitcnt vmcnt(0)" ::: "memory");
    __syncthreads();
    if (threadIdx.x == 0) {
        unsigned* bar = b.bar;
        __builtin_amdgcn_s_waitcnt(0);
        unsigned nloc = b.st[0], nx = b.st[1];
        if (nloc == 0u) { xcd_barrier_complete(bar, b.x, nloc, nx); b.st[0] = nloc; b.st[1] = nx; }
        const unsigned old = xb_add(&bar[XB_XSUB(b.x)], 1u);
        const unsigned gen = old / nloc;
        if (old + 1u == (gen + 1u) * nloc) {
            __builtin_amdgcn_fence(__ATOMIC_RELEASE, "agent");
            asm volatile("s_waitcnt vmcnt(0)" ::: "memory");
            const unsigned og = xb_add(&bar[XB_TOP], 1u);
            const unsigned tg = og / nx;
            if (og + 1u == (tg + 1u) * nx) xb_add(&bar[XB_TOPGEN], 1u);
            else XB_SPIN(xb_ld(&bar[XB_TOPGEN]) == tg, bar);
            __builtin_amdgcn_fence(__ATOMIC_ACQUIRE, "agent");
            xb_add(&bar[XB_XGEN(b.x)], 1u);
            asm volatile("s_waitcnt vmcnt(0)" ::: "memory");
        } else {
            XB_SPIN(xb_ld(&bar[XB_XGEN(b.x)]) == gen, bar);
            __builtin_amdgcn_fence(__ATOMIC_ACQUIRE, "agent");
            asm volatile("s_waitcnt vmcnt(0)" ::: "memory");
        }
    }
    __syncthreads();
}

constexpr int DM = 1024, NB = 2, SEQ = 8192, NT = NB * SEQ;
constexpr int NTHREADS = 512, NWAVES = 8;
constexpr float LN_EPS = 1e-5f;
constexpr float ALPHA = 1.189207115002721f;
typedef unsigned short bf16;
typedef unsigned v4u __attribute__((ext_vector_type(4)));
typedef unsigned v2u __attribute__((ext_vector_type(2)));
typedef float f32x4 __attribute__((ext_vector_type(4)));
typedef short bf16x8_t __attribute__((ext_vector_type(8)));

constexpr size_t MiB = 1u << 20, KiB = 1u << 10;
constexpr size_t WS_CTL = 0, CTL_ZERO_BYTES = 1 * MiB;
constexpr size_t WS_MOD = 1 * MiB + 768 * KiB;
constexpr size_t WS_MMAT = 1 * MiB;
constexpr size_t WS_ROPE = 2 * MiB;
constexpr size_t WS_WIN = 6 * MiB, WS_WOUT = 12 * MiB, WS_WPQ = 14 * MiB, WS_MISC = 16 * MiB, WS_SUBK = 17 * MiB;
constexpr size_t WS_XN = 18 * MiB;
constexpr size_t WS_FZ = 50 * MiB;
constexpr size_t WS_QB = 66 * MiB, WS_KB = 90 * MiB, WS_VB = 114 * MiB, WS_O3 = 138 * MiB, WS_LSE = 162 * MiB;
constexpr size_t WS_H2Q = 50 * MiB, WS_HS = 66 * MiB, WS_WQ = 67 * MiB, WS_WSC = 69 * MiB, WS_SUA = 75 * MiB, WS_X1 = 83 * MiB;
constexpr size_t WS_Y1 = 116 * MiB, WS_PQ = 116 * MiB, WS_PART = 116 * MiB, WS_Y = 116 * MiB;
constexpr size_t WS_IDS = 180 * MiB, WS_GATES = 188 * MiB;
constexpr size_t WS_TU8 = 200 * MiB, WS_TV8 = 216 * MiB, WS_SU = 232 * MiB, WS_SV = 232 * MiB + 512 * KiB, WS_END = 233 * MiB;
constexpr float QSCALE = 0.125f * 1.4426950408889634f;
constexpr int NIN = 2816;
constexpr int CW_BAR = 4096;

constexpr int RING_BYTES = 131072, LDSCTL_OFF = RING_BYTES, MISC_OFF = LDSCTL_OFF + 320, LDS_BYTES = 147456;

struct Params {
    const float* x; const float* c; const int* pos; const float* w_ada; const float* b_ada; const float* w_in; const float* b_in;
    const float* w_four; const float* w_out; const float* b_out; const float* g1; const float* be1; const float* w_pq; const float* subk;
    const float* pu; const float* pv; const float* g2; const float* be2; float* out; unsigned char* ws;
};

__device__ __forceinline__ unsigned f2bf(float f) { unsigned u = __builtin_bit_cast(unsigned, f); return (u + 0x7fffu + ((u >> 16) & 1u)) >> 16; }
__device__ __forceinline__ unsigned pk2(float lo, float hi) { return f2bf(lo) | (f2bf(hi) << 16); }
__device__ __forceinline__ float wave_sum(float v) {
#pragma unroll
    for (int o = 32; o > 0; o >>= 1) v += __shfl_xor(v, o);
    return v;
}
__device__ __forceinline__ float wave_max(float v) {
#pragma unroll
    for (int o = 32; o > 0; o >>= 1) v = fmaxf(v, __shfl_xor(v, o));
    return v;
}
#define LDS_WAIT() asm volatile("s_waitcnt lgkmcnt(0)" ::: "memory")
__device__ __forceinline__ int opaque_tid() { int t = threadIdx.x; asm volatile("" : "+v"(t)); return t; }
__device__ __forceinline__ int wave_id() { return __builtin_amdgcn_readfirstlane(opaque_tid() >> 6); }
__device__ __forceinline__ float bflo(unsigned u) { return __builtin_bit_cast(float, u << 16); }
__device__ __forceinline__ float bfhi(unsigned u) { return __builtin_bit_cast(float, u & 0xffff0000u); }

template <class SC>
__device__ __forceinline__ void transpose_item(const float* W, int K, int N, bf16* WT, int nout, SC srccol, LAS float* scr, int item, int lane) {
    const int nblk = nout / 32, kb = item / nblk, nb = item % nblk, k0 = 64 * kb, n0 = 32 * nb;
    const int sc = srccol(n0 + (lane & 31));
#pragma unroll 8
    for (int i = 0; i < 32; ++i) { const int kk = 2 * i + (lane >> 5); scr[kk * 33 + (lane & 31)] = W[(size_t)(k0 + kk) * N + sc]; }
    LDS_WAIT(); asm volatile("" ::: "memory");
    const int c = lane & 7;
#pragma unroll
    for (int j = 0; j < 4; ++j) { const int n = (lane >> 3) + 8 * j; const LAS float* s = scr + (8 * c) * 33 + n;
        v4u o; o.x = pk2(s[0 * 33], s[1 * 33]); o.y = pk2(s[2 * 33], s[3 * 33]); o.z = pk2(s[4 * 33], s[5 * 33]); o.w = pk2(s[6 * 33], s[7 * 33]);
        *(v4u*)(WT + (size_t)(n0 + n) * K + k0 + 8 * c) = o; }
    LDS_WAIT(); asm volatile("" ::: "memory");
}
__device__ __forceinline__ void ph_prologue(const Params& p, LAS unsigned char* lds, int bid, int nblk) {
    const int tid = opaque_tid(), lane = tid & 63, wave = __builtin_amdgcn_readfirstlane(tid >> 6);
    {
        LAS float* M = (LAS float*)lds; LAS float* Wl = (LAS float*)(lds + 32768);
        bf16* WT = (bf16*)(p.ws + WS_WIN); float* biasf = (float*)(p.ws + WS_MISC); const float* MM = (const float*)(p.ws + WS_MMAT);
        const bool fallback = !(nblk > 192);
        for (int it = bid; it < 256; it += nblk) {
            const int g = it & 3, kb = it >> 2, k0 = kb * 16;
            __syncthreads();
            if (fallback) { const float norm = 1.0f / sqrtf(8192.0f * 64.0f);
                for (int e = tid; e < 8192; e += NTHREADS) { const int c = e >> 7, nl = e & 127; float a = 0.f;
                    for (int cp = 0; cp < 64; ++cp) { const float ang = 2.0f * (float)((c * cp) & 63) / 64.0f; a += ((nl & 1) ? -sinpif(ang) : cospif(ang)) * p.w_four[(g * 64 + cp) * 64 + (nl >> 1)]; }
                    M[e] = a * norm; } }
            else {
#pragma unroll
                for (int i = 0; i < 4; ++i) *(LAS f32x4*)(lds + (tid + i * 512) * 16) = *(const f32x4*)(MM + (size_t)g * 8192 + (tid + i * 512) * 4); }
#pragma unroll
            for (int i = 0; i < 2; ++i) { const int e = tid + i * 512, k = e >> 6, c = e & 63; Wl[k * 64 + c] = p.w_in[(size_t)(k0 + k) * 2560 + g * 64 + c]; }
            __syncthreads();
            { const int nl = tid & 127, kq = tid >> 7; float a[4] = {0.f, 0.f, 0.f, 0.f};
              for (int c = 0; c < 64; ++c) { const float mv = M[c * 128 + nl];
#pragma unroll
                  for (int j = 0; j < 4; ++j) a[j] += mv * Wl[(kq * 4 + j) * 64 + c]; }
              *(v2u*)(WT + (size_t)(g * 128 + nl) * DM + k0 + kq * 4) = (v2u){pk2(a[0], a[1]), pk2(a[2], a[3])};
              if (kb == 0 && tid < 128) { float bsum = 0.f; for (int c = 0; c < 64; ++c) bsum += p.b_in[g * 64 + c] * M[c * 128 + nl]; biasf[g * 128 + nl] = bsum; } }
        }
        __syncthreads();
        for (int i = bid * NTHREADS + tid; i < 2304; i += nblk * NTHREADS) biasf[512 + i] = p.b_in[256 + i];
    }
    {
        LAS float* scr = (LAS float*)(lds + wave * 16384);
        const int gw = bid * NWAVES + wave, NGW = nblk * NWAVES;
        constexpr int I_IN = 16 * (2304 / 32), I_O = 16 * 32, I_PQ = 16 * 32;
        for (int it = gw; it < I_IN + I_O + I_PQ; it += NGW) {
            int r = it;
            if (r < I_IN) {
                transpose_item(p.w_in, DM, 2560, (bf16*)(p.ws + WS_WIN) + (size_t)512 * DM, 2304,
                    [](int n) { return n < 1536 ? 256 + (n & ~63) + ((n & 63) >> 1) + 32 * (n & 1) : 256 + n; }, scr, r, lane); continue; } r -= I_IN;
            if (r < I_O) { transpose_item(p.w_out, DM, DM, (bf16*)(p.ws + WS_WOUT), DM, [](int n) { return n; }, scr, r, lane); continue; } r -= I_O;
            transpose_item(p.w_pq, DM, DM, (bf16*)(p.ws + WS_WPQ), DM, [](int n) { return n; }, scr, r, lane);
        }
    }
    { float2* rope = (float2*)(p.ws + WS_ROPE);
      for (int idx = bid * NTHREADS + tid; idx < NT * 32; idx += nblk * NTHREADS) { const int t = idx >> 5, i = idx & 31;
          const float inv = powf(10000.0f, -(float)i / 32.0f); float sn, cs; sincosf((float)p.pos[t] * inv, &sn, &cs); rope[idx] = make_float2(cs, sn); } }
    { bf16* SK = (bf16*)(p.ws + WS_SUBK);
      for (int ch = bid * NTHREADS + tid; ch < 8 * 2 * 4 * 4 * 64; ch += nblk * NTHREADS) {
          const int ln = ch & 63, d0 = (ch >> 6) & 3, mt = (ch >> 8) & 3, hp = ch >> 10;
          const float* sp = p.subk + ((size_t)hp * 128 + 32 * mt + (ln & 31)) * 64 + 16 * d0 + 8 * (ln >> 5);
          v4u o; o.x = pk2(sp[0], sp[1]); o.y = pk2(sp[2], sp[3]); o.z = pk2(sp[4], sp[5]); o.w = pk2(sp[6], sp[7]);
          *(v4u*)(SK + (size_t)ch * 8) = o; } }
}
__device__ __forceinline__ void ph_mod(const Params& p, LAS unsigned char* lds, int bid, int nblk) {
    const int tid = opaque_tid(), col = tid & 31, kg = tid >> 5;
    LAS float* cond = (LAS float*)lds; LAS float* red = (LAS float*)(lds + 8192);
    float* mod = (float*)(p.ws + WS_MOD);
    for (int i = tid; i < 2 * DM; i += NTHREADS) { const float c = p.c[i]; cond[i] = c / (1.0f + expf(-c)); }
    __syncthreads();
    if (nblk > 192 && bid >= 192) {
        LAS float* T64 = (LAS float*)(lds + 12288);
        if (tid < 64) { T64[tid] = cospif(2.0f * (float)tid / 64.0f); T64[64 + tid] = -sinpif(2.0f * (float)tid / 64.0f); }
        __syncthreads();
        const float norm = 1.0f / sqrtf(8192.0f * 64.0f); float* MM = (float*)(p.ws + WS_MMAT);
        for (int it = bid - 192; it < 64; it += nblk - 192) {
            const int g = it >> 4, c = (it & 15) * 4 + (tid >> 7), nl = tid & 127; float a = 0.f;
#pragma unroll 8
            for (int cp = 0; cp < 64; ++cp) a += T64[(nl & 1) * 64 + ((c * cp) & 63)] * p.w_four[(g * 64 + cp) * 64 + (nl >> 1)];
            MM[(g * 64 + c) * 128 + nl] = a * norm;
        }
    }
    for (int it = bid; it < 6144 / 32; it += nblk) {
        const int n = it * 32 + col; float a0 = 0.f, a1 = 0.f;
        const float* wp = p.w_ada + (size_t)(kg * 64) * 6144 + n;
#pragma unroll 16
        for (int k = 0; k < 64; ++k) { const float w = wp[(size_t)k * 6144]; a0 += cond[kg * 64 + k] * w; a1 += cond[DM + kg * 64 + k] * w; }
        red[(kg * 2 + 0) * 32 + col] = a0; red[(kg * 2 + 1) * 32 + col] = a1;
        __syncthreads();
        if (tid < 64) { const int b = tid >> 5; float s = p.b_ada[n];
#pragma unroll
            for (int g = 0; g < 16; ++g) s += red[(g * 2 + b) * 32 + col];
            mod[b * 6144 + n] = s; }
        __syncthreads();
    }
}
__device__ __forceinline__ void ph_xn(const Params& p, int bid, int nblk) {
    const int lane = opaque_tid() & 63, wave = wave_id(); const float* mod = (const float*)(p.ws + WS_MOD); bf16* XN = (bf16*)(p.ws + WS_XN);
    for (int row = bid * NWAVES + wave; row < NT; row += nblk * NWAVES) {
        const int b = row / SEQ;
        const f32x4* xr = (const f32x4*)(p.x + (size_t)row * DM) + lane;
        f32x4 v[4]; float s = 0.f;
#pragma unroll
        for (int j = 0; j < 4; ++j) { v[j] = xr[64 * j]; s += (v[j].x + v[j].y) + (v[j].z + v[j].w); }
        const float mean = wave_sum(s) * (1.f / DM); float s2 = 0.f;
#pragma unroll
        for (int j = 0; j < 4; ++j) { v[j] = v[j] - mean; s2 += (v[j].x * v[j].x + v[j].y * v[j].y) + (v[j].z * v[j].z + v[j].w * v[j].w); }
        const float rstd = rsqrtf(wave_sum(s2) * (1.f / DM) + LN_EPS);
        unsigned long long* o8 = (unsigned long long*)(XN + (size_t)row * DM) + lane;
#pragma unroll
        for (int j = 0; j < 4; ++j) {
            const f32x4 sh = *((const f32x4*)(mod + b * 6144 + 0) + lane + 64 * j), sc = *((const f32x4*)(mod + b * 6144 + 1024) + lane + 64 * j);
            const f32x4 o = v[j] * rstd * (1.0f + sc) + sh;
            o8[64 * j] = (unsigned long long)pk2(o.x, o.y) | ((unsigned long long)pk2(o.z, o.w) << 32);
        }
    }
}

struct EpiOut {
    static constexpr bool PERM = true, AFTER_DRAIN = false;
    bf16* Y1; const float* x; const float* mod; const float* bo;
    __device__ __forceinline__ void operator()(const pg8::f32x4 (&acc)[2][2][4][2], const pg8::Unit& u, int wr, int wc, int fr, int fq) const {
        const int row0 = u.pm * 256 + wr * 64 + fr;
#pragma unroll
        for (int bj = 0; bj < 2; ++bj) {
            const int c0 = u.pn * 256 + bj * 128 + wc * 32 + 8 * fq;
            const pg8::f32x4 b0 = *(const pg8::f32x4*)(bo + c0), b1 = *(const pg8::f32x4*)(bo + c0 + 4);
#pragma unroll
            for (int ai = 0; ai < 2; ++ai) {
                const int bb = (u.pm * 256 + ai * 128) >> 13;
                const pg8::f32x4 g0 = *(const pg8::f32x4*)(mod + bb * 6144 + 2048 + c0) + 1.0f, g1 = *(const pg8::f32x4*)(mod + bb * 6144 + 2048 + c0 + 4) + 1.0f;
#pragma unroll
                for (int m = 0; m < 4; ++m) {
                    const int row = row0 + ai * 128 + m * 16;
                    const pg8::f32x4 x0 = *(const pg8::f32x4*)(x + (size_t)row * DM + c0), x1 = *(const pg8::f32x4*)(x + (size_t)row * DM + c0 + 4);
                    const pg8::f32x4 v0 = x0 * ALPHA + g0 * (acc[ai][bj][m][0] + b0), v1 = x1 * ALPHA + g1 * (acc[ai][bj][m][1] + b1);
                    v4u o; o.x = pk2(v0.x, v0.y); o.y = pk2(v0.z, v0.w); o.z = pk2(v1.x, v1.y); o.w = pk2(v1.z, v1.w);
                    *(v4u*)(Y1 + (size_t)row * DM + c0) = o;
                }
            }
        }
    }
};
__device__ __forceinline__ void ph_fft(const Params& p, LAS unsigned char* lds, int bid, int nblk) {
    const int tid = opaque_tid(), lane = tid & 63, wave = __builtin_amdgcn_readfirstlane(tid >> 6), lr = lane & 15, lq = lane >> 4;
    bf16* MIX = (bf16*)(p.ws + WS_XN);
    for (int item = bid; item < 256; item += nblk) {
        const int b = item >> 7, cg = item & 127;
        const unsigned long long* src = (const unsigned long long*)(p.ws + WS_FZ) + (size_t)(b * 128 + cg) * 8192;
#pragma unroll 4
        for (int i = 0; i < 16; ++i) {
            const int q = i * 512 + tid; const int n2 = (q & 7) | (((q >> 6) & 15) << 3), n1 = ((q >> 3) & 7) | (((q >> 10) & 7) << 3);
            const unsigned long long v = src[128 * n1 + n2];
            *(LAS unsigned*)(lds + (2 * n2) * 288 + 4 * n1) = (unsigned)v; *(LAS unsigned*)(lds + (2 * n2 + 1) * 288 + 4 * n1) = (unsigned)(v >> 32);
        }
        bf16x8_t af[4];
        { const int m = 16 * wave + lr, k1 = m >> 1, ri = m & 1;
#pragma unroll
          for (int ks = 0; ks < 4; ++ks)
#pragma unroll
              for (int jj = 0; jj < 4; ++jj) { const int n1 = 16 * ks + 4 * lq + jj; const float x = (float)((n1 * k1) & 63) * (1.0f / 64.0f);
                  const float c = __builtin_amdgcn_cosf(x), s = __builtin_amdgcn_sinf(x);
                  af[ks][2 * jj] = (short)f2bf(ri ? -s : c); af[ks][2 * jj + 1] = (short)f2bf(ri ? c : s); } }
        __syncthreads();
        pg8::f32x4 acc[16];
#pragma unroll
        for (int nt = 0; nt < 16; ++nt) { acc[nt] = (pg8::f32x4){0.f, 0.f, 0.f, 0.f};
#pragma unroll
            for (int ks = 0; ks < 4; ++ks) { const bf16x8_t bf = *(const LAS bf16x8_t*)(lds + (16 * nt + lr) * 288 + (32 * ks + 8 * lq) * 2);
                acc[nt] = __builtin_amdgcn_mfma_f32_16x16x32_bf16(af[ks], bf, acc[nt], 0, 0, 0); } }
        __syncthreads();
#pragma unroll
        for (int nt = 0; nt < 16; ++nt) { const int col = 16 * nt + lr, n2 = col >> 1, ch = col & 1;
#pragma unroll
            for (int h = 0; h < 2; ++h) { const int k1 = 8 * wave + 2 * lq + h; const float yr = acc[nt][2 * h], yi = acc[nt][2 * h + 1];
                const float x = (float)((n2 * k1) & 8191) * (1.0f / 8192.0f); const float c = __builtin_amdgcn_cosf(x), s = __builtin_amdgcn_sinf(x);
                *(LAS unsigned*)(lds + (2 * k1 + ch) * 544 + 4 * n2) = pk2(yr * c + yi * s, yi * c - yr * s); } }
        bf16x8_t a2[8];
        { const int k2 = 16 * wave + lr;
#pragma unroll
          for (int ks = 0; ks < 8; ++ks)
#pragma unroll
              for (int jj = 0; jj < 4; ++jj) { const int n2 = 16 * ks + 4 * lq + jj; const float x = (float)((n2 * k2) & 127) * (1.0f / 128.0f);
                  a2[ks][2 * jj] = (short)f2bf(__builtin_amdgcn_cosf(x)); a2[ks][2 * jj + 1] = (short)f2bf(__builtin_amdgcn_sinf(x)); } }
        __syncthreads();
        pg8::f32x4 o[8];
#pragma unroll
        for (int nt = 0; nt < 8; ++nt) { o[nt] = (pg8::f32x4){0.f, 0.f, 0.f, 0.f};
#pragma unroll
            for (int ks = 0; ks < 8; ++ks) { const bf16x8_t bf = *(const LAS bf16x8_t*)(lds + (16 * nt + lr) * 544 + (32 * ks + 8 * lq) * 2);
                o[nt] = __builtin_amdgcn_mfma_f32_16x16x32_bf16(a2[ks], bf, o[nt], 0, 0, 0); } }
#pragma unroll
        for (int nt = 0; nt < 8; ++nt) { const int col2 = 16 * nt + lr, k1 = col2 >> 1, ch = col2 & 1;
#pragma unroll
            for (int r = 0; r < 4; ++r) { const float v = o[nt][r]; const float w = __shfl_xor(v, 1); const int k2 = 16 * wave + 4 * lq + r;
                if (ch == 0) *(unsigned*)(MIX + ((size_t)b * SEQ + k1 + 64 * k2) * DM + 2 * cg) = pk2(v, w); } }
        __syncthreads();
    }
}


struct EpiIn {
    static constexpr bool PERM = true, AFTER_DRAIN = false;
    bf16* FZ; bf16* QKV; const float* bias; const float* rope;
    __device__ __forceinline__ void operator()(const pg8::f32x4 (&acc)[2][2][4][2], const pg8::Unit& u, int wr, int wc, int fr, int fq) const {
        const int row0 = u.pm * 256 + wr * 64 + fr;
#pragma unroll
        for (int bj = 0; bj < 2; ++bj) {
            const int c0 = u.pn * 256 + bj * 128 + wc * 32 + 8 * fq;
            const pg8::f32x4 b0 = *(const pg8::f32x4*)(bias + c0), b1 = *(const pg8::f32x4*)(bias + c0 + 4);
#pragma unroll
            for (int ai = 0; ai < 2; ++ai)
#pragma unroll
                for (int m = 0; m < 4; ++m) {
                    const int row = row0 + ai * 128 + m * 16;
                    pg8::f32x4 v0 = acc[ai][bj][m][0] + b0, v1 = acc[ai][bj][m][1] + b1;
                    if (u.pn < 2) {
                        const int b = row >> 13, s = row & 8191, cgp = c0 >> 2;
                        unsigned long long* d0 = (unsigned long long*)(FZ + (((size_t)(b * 128 + cgp) * 8192 + s) << 2));
                        d0[0] = (unsigned long long)pk2(v0.x, v0.y) | ((unsigned long long)pk2(v0.z, v0.w) << 32);
                        d0[8192] = (unsigned long long)pk2(v1.x, v1.y) | ((unsigned long long)pk2(v1.z, v1.w) << 32);
                    } else {
                        const int cq = c0 - 512, which = cq / 768, off = cq - which * 768;
                        if (which < 2) {
                            const float sc = which == 0 ? QSCALE : 1.0f;
                            const pg8::f32x4 r0 = *(const pg8::f32x4*)(rope + (size_t)row * 64 + (off & 63)), r1 = *(const pg8::f32x4*)(rope + (size_t)row * 64 + (off & 63) + 4);
                            pg8::f32x4 w0, w1;
                            w0.x = (v0.x * r0.x - v0.y * r0.y) * sc; w0.y = (v0.y * r0.x + v0.x * r0.y) * sc; w0.z = (v0.z * r0.z - v0.w * r0.w) * sc; w0.w = (v0.w * r0.z + v0.z * r0.w) * sc;
                            w1.x = (v1.x * r1.x - v1.y * r1.y) * sc; w1.y = (v1.y * r1.x + v1.x * r1.y) * sc; w1.z = (v1.z * r1.z - v1.w * r1.w) * sc; w1.w = (v1.w * r1.z + v1.z * r1.w) * sc;
                            v0 = w0; v1 = w1;
                        }
                        v4u o; o.x = pk2(v0.x, v0.y); o.y = pk2(v0.z, v0.w); o.z = pk2(v1.x, v1.y); o.w = pk2(v1.z, v1.w);
                        *(v4u*)(QKV + (size_t)which * ((WS_KB - WS_QB) / 2) + (size_t)row * 768 + off) = o;
                    }
                }
        }
    }
};

typedef float f32x16 __attribute__((ext_vector_type(16)));
typedef short s16x4 __attribute__((ext_vector_type(4)));
__device__ __forceinline__ int crow(int r, int hi) { return (r & 3) + 8 * (r >> 2) + 4 * hi; }
__device__ __forceinline__ s16x4 vtr(const LAS unsigned char* p) { return __builtin_bit_cast(s16x4, __builtin_amdgcn_ds_read_tr16_b64_v4i16((LAS s16x4*)p)); }
__device__ __forceinline__ unsigned cvtpk(float lo, float hi) { typedef float f2 __attribute__((ext_vector_type(2))); typedef __bf16 b2 __attribute__((ext_vector_type(2))); f2 v = {lo, hi}; b2 r = __builtin_convertvector(v, b2); return __builtin_bit_cast(unsigned, r); }
__device__ __forceinline__ void tbl_load(const Params& p, int r, f32x4 (&a)[4], int lane) {
    const bool isv = r >= 16384; const int row = isv ? r - 16384 : r;
    const f32x4* src = (const f32x4*)((isv ? p.pv : p.pu) + (size_t)row * DM + 16 * lane);
#pragma unroll
    for (int j = 0; j < 4; ++j) a[j] = src[j];
}
__device__ __forceinline__ void tbl_finish(const Params& p, int r, const f32x4 (&a)[4], int lane) {
    const bool isv = r >= 16384; const int row = isv ? r - 16384 : r;
    float amax = 0.f;
#pragma unroll
    for (int j = 0; j < 4; ++j) amax = fmaxf(amax, fmaxf(fmaxf(fabsf(a[j].x), fabsf(a[j].y)), fmaxf(fabsf(a[j].z), fabsf(a[j].w))));
    if (isv) {
        amax = wave_max(amax);
        const float inv = amax > 0.f ? 127.0f / amax : 0.f;
        v4u o;
#pragma unroll
        for (int j = 0; j < 4; ++j) { unsigned q = 0u;
            q = __builtin_amdgcn_cvt_pk_u8_f32(a[j].x * inv + 128.0f, 0, q); q = __builtin_amdgcn_cvt_pk_u8_f32(a[j].y * inv + 128.0f, 1, q);
            q = __builtin_amdgcn_cvt_pk_u8_f32(a[j].z * inv + 128.0f, 2, q); q = __builtin_amdgcn_cvt_pk_u8_f32(a[j].w * inv + 128.0f, 3, q);
            o[j] = q ^ 0x80808080u; }
        *(v4u*)(p.ws + WS_TV8 + (size_t)(lane >> 3) * (2 * MiB) + (size_t)row * 128 + 16 * (lane & 7)) = o;
        if (lane == 0) ((float*)(p.ws + WS_SV))[row] = amax * (1.0f / 127.0f);
    } else {
        amax = fmaxf(amax, __shfl_xor(amax, 1)); amax = fmaxf(amax, __shfl_xor(amax, 2)); amax = fmaxf(amax, __shfl_xor(amax, 4)); amax = fmaxf(amax, __shfl_xor(amax, 8));
        const float inv = amax > 0.f ? 7.0f / amax : 0.f;
        unsigned d[2];
#pragma unroll
        for (int w = 0; w < 2; ++w) { unsigned lo = 0u, hi = 0u;
            lo = __builtin_amdgcn_cvt_pk_u8_f32(a[2 * w].x * inv + 8.0f, 0, lo); lo = __builtin_amdgcn_cvt_pk_u8_f32(a[2 * w].y * inv + 8.0f, 1, lo);
            lo = __builtin_amdgcn_cvt_pk_u8_f32(a[2 * w].z * inv + 8.0f, 2, lo); lo = __builtin_amdgcn_cvt_pk_u8_f32(a[2 * w].w * inv + 8.0f, 3, lo);
            hi = __builtin_amdgcn_cvt_pk_u8_f32(a[2 * w + 1].x * inv + 8.0f, 0, hi); hi = __builtin_amdgcn_cvt_pk_u8_f32(a[2 * w + 1].y * inv + 8.0f, 1, hi);
            hi = __builtin_amdgcn_cvt_pk_u8_f32(a[2 * w + 1].z * inv + 8.0f, 2, hi); hi = __builtin_amdgcn_cvt_pk_u8_f32(a[2 * w + 1].w * inv + 8.0f, 3, hi);
            d[w] = lo | (hi << 4); }
        *(v2u*)(p.ws + WS_TU8 + (size_t)(lane >> 4) * (2 * MiB) + (size_t)row * 128 + 8 * (lane & 15)) = (v2u){d[0], d[1]};
        if ((lane & 15) == 0) ((float*)(p.ws + WS_SU))[(size_t)(lane >> 4) * 16384 + row] = amax * (1.0f / 7.0f);
    }
}
struct AttnDesc { int dil, ntile, res, cb, r; size_t rowb; int h; bool valid; };
__device__ __forceinline__ AttnDesc attn_desc(int bi) {
    AttnDesc d; d.valid = bi < 3 * 768; const int b2 = d.valid ? bi : 0;
    const int r = b2 / 768, rem = b2 - r * 768, bh = rem >> 5, q32 = rem & 31, b = bh / 12;
    d.r = r; d.h = bh - b * 12; d.rowb = (size_t)b * SEQ;
    const int ld = 2 * r;
    d.dil = 1 << ld; d.ntile = 256 >> ld; d.res = q32 >> (5 - ld); d.cb = q32 & ((32 >> ld) - 1);
    return d;
}
__device__ __forceinline__ void attn_dma(const AttnDesc& d, const bf16* T, bool swz, LAS unsigned char* img, int wave, int lane) {
#pragma unroll
    for (int i = 0; i < 6; ++i) {
        const int idx = wave * 6 + i, j = idx >> 2, it = idx & 3, kt = 8 * d.cb - 2 + j;
        if (kt >= 0 && kt < d.ntile) {
            const int row = it * 8 + (lane >> 3), ch = lane & 7; const int gch = swz ? (ch ^ ((row >> 1) & 7)) : ch;
            const bf16* src = T + (d.rowb + d.res + d.dil * (32 * kt + row)) * 768 + d.h * 64 + 8 * gch;
            __builtin_amdgcn_global_load_lds((const unsigned*)src, (LAS unsigned*)(img + j * 4096 + it * 1024), 16, 0, 0);
        }
    }
}
__device__ __forceinline__ void attn_qload(const AttnDesc& d, const bf16* QB, bf16x8_t (&qf)[4], int wave, int lane) {
    const bf16* qp = QB + (d.rowb + d.res + d.dil * (32 * (8 * d.cb + wave) + (lane & 31))) * 768 + d.h * 64 + 8 * (lane >> 5);
#pragma unroll
    for (int d0 = 0; d0 < 4; ++d0) qf[d0] = *(const bf16x8_t*)(qp + 16 * d0);
}
#define ATT_SYNC() do { asm volatile("s_waitcnt vmcnt(0) lgkmcnt(0)" ::: "memory"); __builtin_amdgcn_s_barrier(); asm volatile("" ::: "memory"); } while (0)
__device__ __forceinline__ void ph_attn_fast(const Params& p, LAS unsigned char* lds, int bid, int nblk) {
    const int lane = opaque_tid() & 63, wave = wave_id(), r32 = lane & 31, hi = lane >> 5;
    LAS unsigned char* imgK = lds; LAS unsigned char* imgV = lds + 49152; LAS unsigned char* stgb = lds + 98304 + wave * 4096;
    const bf16* QB = (const bf16*)(p.ws + WS_QB); const bf16* KB = (const bf16*)(p.ws + WS_KB); const bf16* VB = (const bf16*)(p.ws + WS_VB);
    const int vb = (nblk & 7) == 0 ? (bid & 7) * (nblk >> 3) + (bid >> 3) : bid;
    int bi = vb;
    AttnDesc d = attn_desc(bi);
    bf16x8_t qf[4];
    if (d.valid) { attn_dma(d, KB, true, imgK, wave, lane); attn_qload(d, QB, qf, wave, lane); }
    ATT_SYNC();
    const int g = lane >> 4, ii = lane & 15;
    const int vb0 = (4 * hi + (ii >> 2)) * 128 + (g & 1) * 32 + (ii & 3) * 8;
    int trow = bid * NWAVES + wave; const int tstride = nblk * NWAVES;
    f32x4 ta[4];
    while (d.valid) {
        asm volatile("" : "+v"(qf[0]), "+v"(qf[1]), "+v"(qf[2]), "+v"(qf[3]));
        attn_dma(d, VB, false, imgV, wave, lane);
        const bool tb1 = trow < 32768; if (tb1) tbl_load(p, trow, ta, lane);
        const int c = 8 * d.cb + wave;
        f32x16 S[5];
#pragma unroll
        for (int u = 0; u < 5; ++u) {
            const int kt = c - 2 + u;
#pragma unroll
            for (int r = 0; r < 16; ++r) S[u][r] = -1e30f;
            if (kt >= 0 && kt < d.ntile) {
                const LAS unsigned char* slot = imgK + (wave + u) * 4096;
                f32x16 a = {0.f, 0.f, 0.f, 0.f, 0.f, 0.f, 0.f, 0.f, 0.f, 0.f, 0.f, 0.f, 0.f, 0.f, 0.f, 0.f};
#pragma unroll
                for (int d0 = 0; d0 < 4; ++d0) { const bf16x8_t kf = *(const LAS bf16x8_t*)(slot + r32 * 128 + (((2 * d0 + hi) ^ ((r32 >> 1) & 7)) << 4));
                    a = __builtin_amdgcn_mfma_f32_32x32x16_bf16(kf, qf[d0], a, 0, 0, 0); }
                S[u] = a;
            }
        }
#pragma unroll
        for (int r = 0; r < 16; ++r) { const int kk = crow(r, hi); if (kk < r32) S[0][r] = -1e30f; if (kk > r32) S[4][r] = -1e30f; }
        float m = -1e30f;
#pragma unroll
        for (int u = 0; u < 5; ++u)
#pragma unroll
            for (int r = 0; r < 16; ++r) m = fmaxf(m, S[u][r]);
        m = fmaxf(m, __shfl_xor(m, 32));
        float l = 0.f;
        unsigned Pk[5][8];
#pragma unroll
        for (int u = 0; u < 5; ++u)
#pragma unroll
            for (int r = 0; r < 16; r += 2) { const float e0 = __builtin_amdgcn_exp2f(S[u][r] - m), e1 = __builtin_amdgcn_exp2f(S[u][r + 1] - m); l += e0 + e1; Pk[u][r >> 1] = cvtpk(e0, e1); }
        l += __shfl_xor(l, 32);
        if (tb1) { tbl_finish(p, trow, ta, lane); trow += tstride; }
        ATT_SYNC();
        const AttnDesc dn = attn_desc(bi + nblk);
        if (dn.valid) { attn_dma(dn, KB, true, imgK, wave, lane); attn_qload(dn, QB, qf, wave, lane); }
        const bool tb2 = trow < 32768; if (tb2) tbl_load(p, trow, ta, lane);
        f32x16 o[2];
#pragma unroll
        for (int db = 0; db < 2; ++db)
#pragma unroll
            for (int r = 0; r < 16; ++r) o[db][r] = 0.f;
#pragma unroll
        for (int u = 0; u < 5; ++u) {
            const int kt = c - 2 + u;
            if (kt >= 0 && kt < d.ntile) {
                const LAS unsigned char* slot = imgV + (wave + u) * 4096;
#pragma unroll
                for (int s = 0; s < 2; ++s) {
                    bf16x8_t pa;
                    { v4u w; w.x = Pk[u][4 * s + 0]; w.y = Pk[u][4 * s + 1]; w.z = Pk[u][4 * s + 2]; w.w = Pk[u][4 * s + 3]; pa = __builtin_bit_cast(bf16x8_t, w); }
#pragma unroll
                    for (int db = 0; db < 2; ++db) {
                        const s16x4 lo = vtr(slot + vb0 + s * 2048 + db * 64), hh = vtr(slot + vb0 + s * 2048 + 1024 + db * 64);
                        const bf16x8_t vf = {lo[0], lo[1], lo[2], lo[3], hh[0], hh[1], hh[2], hh[3]};
                        o[db] = __builtin_amdgcn_mfma_f32_32x32x16_bf16(pa, vf, o[db], 0, 0, 0);
                    }
                }
            }
        }
        bf16* OB = d.r == 2 ? (bf16*)(p.ws + WS_O3) : (bf16*)p.out + (size_t)d.r * NT * 768;
        float* LSE = (float*)(p.ws + WS_LSE) + (size_t)d.r * NT * 12;
        const float linv = 1.0f / l;
        LAS unsigned short* stg = (LAS unsigned short*)stgb;
#pragma unroll
        for (int r = 0; r < 16; ++r) { const int q = crow(r, hi); const float li = __shfl(linv, q);
#pragma unroll
            for (int db = 0; db < 2; ++db) stg[q * 64 + db * 32 + r32] = (unsigned short)f2bf(o[db][r] * li); }
        int ln2 = lane; asm volatile("" : "+v"(ln2));
#pragma unroll
        for (int i4 = 0; i4 < 4; ++i4) { const int row = i4 * 8 + (ln2 >> 3), ch = ln2 & 7;
            const v4u val = *(const LAS v4u*)((LAS unsigned char*)stg + row * 128 + ch * 16);
            *(v4u*)(OB + (d.rowb + d.res + d.dil * (32 * c + row)) * 768 + d.h * 64 + 8 * ch) = val; }
        if (ln2 < 32) LSE[(d.rowb + d.res + d.dil * (32 * c + ln2)) * 12 + d.h] = m + __builtin_amdgcn_logf(l);
        if (tb2) { tbl_finish(p, trow, ta, lane); trow += tstride; }
        ATT_SYNC();
        d = dn; bi += nblk;
    }
    for (; trow < 32768; trow += tstride) { tbl_load(p, trow, ta, lane); tbl_finish(p, trow, ta, lane); }
}
__device__ __forceinline__ void ph_merge(const Params& p, int bid, int nblk) {
    const bf16* O1 = (const bf16*)p.out; const bf16* O2 = O1 + (size_t)NT * 768; const bf16* O3 = (const bf16*)(p.ws + WS_O3);
    const float* L1 = (const float*)(p.ws + WS_LSE); const float* L2 = L1 + (size_t)NT * 12; const float* L3 = L2 + (size_t)NT * 12; bf16* MIX = (bf16*)(p.ws + WS_XN);
    for (int idx = bid * NTHREADS + opaque_tid(); idx < NT * 96; idx += nblk * NTHREADS) {
        const int t = idx / 96, rem = idx - t * 96, h = rem >> 3, ch = rem & 7;
        const float l1 = L1[t * 12 + h], l2 = L2[t * 12 + h], l3 = L3[t * 12 + h]; const float mx = fmaxf(fmaxf(l1, l2), l3);
        float w1 = __builtin_amdgcn_exp2f(l1 - mx), w2 = __builtin_amdgcn_exp2f(l2 - mx), w3 = __builtin_amdgcn_exp2f(l3 - mx); const float inv = 1.0f / (w1 + w2 + w3); w1 *= inv; w2 *= inv; w3 *= inv;
        const size_t off = (size_t)t * 768 + h * 64 + 8 * ch;
        const v4u a = *(const v4u*)(O1 + off), bq = *(const v4u*)(O2 + off), cq = *(const v4u*)(O3 + off);
        v4u o;
        o.x = pk2(w1 * bflo(a.x) + w2 * bflo(bq.x) + w3 * bflo(cq.x), w1 * bfhi(a.x) + w2 * bfhi(bq.x) + w3 * bfhi(cq.x));
        o.y = pk2(w1 * bflo(a.y) + w2 * bflo(bq.y) + w3 * bflo(cq.y), w1 * bfhi(a.y) + w2 * bfhi(bq.y) + w3 * bfhi(cq.y));
        o.z = pk2(w1 * bflo(a.z) + w2 * bflo(bq.z) + w3 * bflo(cq.z), w1 * bfhi(a.z) + w2 * bfhi(bq.z) + w3 * bfhi(cq.z));
        o.w = pk2(w1 * bflo(a.w) + w2 * bflo(bq.w) + w3 * bflo(cq.w), w1 * bfhi(a.w) + w2 * bfhi(bq.w) + w3 * bfhi(cq.w));
        *(v4u*)(MIX + (size_t)t * DM + 256 + h * 64 + 8 * ch) = o;
    }
}


__device__ __forceinline__ unsigned fkey(float s, unsigned low, unsigned mask) { unsigned u = __builtin_bit_cast(unsigned, s); u = (u & 0x80000000u) ? ~u : (u | 0x80000000u); return (u & ~mask) | low; }
__device__ __forceinline__ float fdec(unsigned k, unsigned mask) { unsigned u = (k & ~mask) | (mask >> 1); u = (u & 0x80000000u) ? (u ^ 0x80000000u) : ~u; return __builtin_bit_cast(float, u); }
#define CE_DESC(a, b) do { const unsigned _mx = (a) > (b) ? (a) : (b), _mn = (a) > (b) ? (b) : (a); (a) = _mx; (b) = _mn; } while (0)
__device__ __forceinline__ void sort16_desc(unsigned (&a)[16]) {
#pragma unroll
    for (int k = 2; k <= 16; k <<= 1)
#pragma unroll
        for (int j = k >> 1; j > 0; j >>= 1)
#pragma unroll
            for (int i = 0; i < 16; ++i) { const int l = i ^ j; if (l > i) { if ((i & k) == 0) CE_DESC(a[i], a[l]); else CE_DESC(a[l], a[i]); } }
}
__device__ __forceinline__ void merge16_desc(unsigned (&c)[16]) {
#pragma unroll
    for (int j = 8; j > 0; j >>= 1)
#pragma unroll
        for (int i = 0; i < 16; ++i) { const int l = i ^ j; if (l > i) CE_DESC(c[i], c[l]); }
}
__device__ __forceinline__ void top16_merge(unsigned (&a)[16], const unsigned (&b)[16]) {
#pragma unroll
    for (int i = 0; i < 16; ++i) a[i] = a[i] > b[15 - i] ? a[i] : b[15 - i];
    merge16_desc(a);
}
__device__ __forceinline__ void top16_of_64(unsigned (&g0)[16], unsigned (&g1)[16], unsigned (&g2)[16], unsigned (&g3)[16]) {
    sort16_desc(g0); sort16_desc(g1); sort16_desc(g2); sort16_desc(g3);
    top16_merge(g0, g1); top16_merge(g2, g3); top16_merge(g0, g2);
}
__host__ __device__ constexpr int stair_slot(int i, int j) { int n = 0; for (int a = 0; a < 16; ++a) for (int b = 0; b < 16; ++b) if ((a + 1) * (b + 1) <= 16) { if (a == i && b == j) return n; ++n; } return n; }
__device__ __forceinline__ void ph_topk_fast(const Params& p, LAS unsigned char* lds, int bid, int nblk) {
    const int lane = opaque_tid() & 63, wave = wave_id(), r32 = lane & 31, hi = lane >> 5;
    const bf16* PQ = (const bf16*)(p.ws + WS_PQ); const bf16* SK = (const bf16*)(p.ws + WS_SUBK);
    unsigned short* ids = (unsigned short*)(p.ws + WS_IDS); float* gates = (float*)(p.ws + WS_GATES);
    const float* SVt = (const float*)(p.ws + WS_SV);
    LAS unsigned* myl = (LAS unsigned*)(lds + wave * 16384 + lane * 4);
    for (int it = bid * NWAVES + wave; it < (NT / 32) * 8; it += nblk * NWAVES) {
        const int tt = it >> 3, h = it & 7, t = tt * 32 + r32;
        unsigned K[2][16];
#pragma unroll
        for (int pp = 0; pp < 2; ++pp) {
            bf16x8_t qf[4];
            { const bf16* qp = PQ + (size_t)t * DM + h * 128 + pp * 64 + 8 * hi;
#pragma unroll
              for (int d0 = 0; d0 < 4; ++d0) qf[d0] = *(const bf16x8_t*)(qp + 16 * d0); }
            unsigned g[4][16];
#pragma unroll
            for (int mt = 0; mt < 4; ++mt) {
                const bf16* kp = SK + ((size_t)((h * 2 + pp) * 4 + mt) * 4 * 64 + lane) * 8;
                f32x16 a = {0.f, 0.f, 0.f, 0.f, 0.f, 0.f, 0.f, 0.f, 0.f, 0.f, 0.f, 0.f, 0.f, 0.f, 0.f, 0.f};
#pragma unroll
                for (int d0 = 0; d0 < 4; ++d0) a = __builtin_amdgcn_mfma_f32_32x32x16_bf16(*(const bf16x8_t*)(kp + d0 * 512), qf[d0], a, 0, 0, 0);
#pragma unroll
                for (int r = 0; r < 16; ++r) g[mt][r] = fkey(a[r], 127u - (unsigned)(32 * mt + crow(r, hi)), 127u);
            }
            top16_of_64(g[0], g[1], g[2], g[3]);
            unsigned o[16];
#pragma unroll
            for (int i = 0; i < 16; ++i) o[i] = (unsigned)__shfl_xor((int)g[0][i], 32);
            top16_merge(g[0], o);
#pragma unroll
            for (int i = 0; i < 16; ++i) K[pp][i] = g[0][i];
        }
#pragma unroll
        for (int i = 0; i < 16; ++i) { myl[i * 64] = K[0][i]; myl[(16 + i) * 64] = K[1][i]; }
        float v0[16], v1[16];
#pragma unroll
        for (int i = 0; i < 16; ++i) { v0[i] = fdec(K[0][i], 127u); v1[i] = fdec(K[1][i], 127u); }
        unsigned c[4][16];
#pragma unroll
        for (int gi = 0; gi < 4; ++gi)
#pragma unroll
            for (int q = 0; q < 16; ++q) c[gi][q] = 0u;
#pragma unroll
        for (int i = 0; i < 16; ++i)
#pragma unroll
            for (int j = 0; j < 16; ++j) if ((i + 1) * (j + 1) <= 16) { const int n = stair_slot(i, j); c[n >> 4][n & 15] = fkey(v0[i] + v1[j], 255u - (unsigned)(16 * i + j), 255u); }
        top16_of_64(c[0], c[1], c[2], c[3]);
        float e[16]; float sum = 0.f; const float mx = fdec(c[0][0], 255u);
#pragma unroll
        for (int r = 0; r < 16; ++r) { e[r] = __builtin_amdgcn_exp2f((fdec(c[0][r], 255u) - mx) * 1.4426950408889634f); sum += e[r]; }
        const float inv = 1.0f / sum;
        int eid[16];
#pragma unroll
        for (int r = 0; r < 16; ++r) { const unsigned id8 = 255u - (c[0][r] & 255u); const unsigned k0 = myl[(id8 >> 4) * 64], k1 = myl[(16 + (id8 & 15)) * 64];
            eid[r] = (int)((127u - (k0 & 127u)) * 128u + (127u - (k1 & 127u))); }
        if (hi == 0) {
#pragma unroll
            for (int q = 0; q < 2; ++q) *(v4u*)(ids + (size_t)t * 128 + h * 16 + 8 * q) = (v4u){(unsigned)eid[8 * q] | ((unsigned)eid[8 * q + 1] << 16), (unsigned)eid[8 * q + 2] | ((unsigned)eid[8 * q + 3] << 16),
                                                                                      (unsigned)eid[8 * q + 4] | ((unsigned)eid[8 * q + 5] << 16), (unsigned)eid[8 * q + 6] | ((unsigned)eid[8 * q + 7] << 16)};
        } else {
#pragma unroll
            for (int q = 0; q < 4; ++q) *(f32x4*)(gates + (size_t)t * 128 + h * 16 + 4 * q) = (f32x4){e[4 * q] * inv * SVt[eid[4 * q]], e[4 * q + 1] * inv * SVt[eid[4 * q + 1]], e[4 * q + 2] * inv * SVt[eid[4 * q + 2]], e[4 * q + 3] * inv * SVt[eid[4 * q + 3]]};
        }
    }
}

__device__ __forceinline__ void ph_ln1_fast(const Params& p, int bid, int nblk) {
    const bf16* y1 = (const bf16*)(p.ws + WS_Y1); bf16* x1 = (bf16*)(p.ws + WS_X1); bf16* h2b = (bf16*)(p.ws + WS_XN); const float* mod = (const float*)(p.ws + WS_MOD);
    const int lane = opaque_tid() & 63, wave = wave_id();
    for (int row = bid * NWAVES + wave; row < NT; row += nblk * NWAVES) {
        const int b = row / SEQ;
        const v2u* yr = (const v2u*)(y1 + (size_t)row * DM) + lane;
        f32x4 v[4]; float s = 0.f;
#pragma unroll
        for (int j = 0; j < 4; ++j) { const v2u w = yr[64 * j]; v[j] = (f32x4){bflo(w.x), bfhi(w.x), bflo(w.y), bfhi(w.y)}; s += (v[j].x + v[j].y) + (v[j].z + v[j].w); }
        float mean = wave_sum(s) * (1.f / DM); float s2 = 0.f;
#pragma unroll
        for (int j = 0; j < 4; ++j) { v[j] = v[j] - mean; s2 += (v[j].x * v[j].x + v[j].y * v[j].y) + (v[j].z * v[j].z + v[j].w * v[j].w); }
        float rstd = rsqrtf(wave_sum(s2) * (1.f / DM) + LN_EPS);
        s = 0.f;
#pragma unroll
        for (int j = 0; j < 4; ++j) { const f32x4 g = *((const f32x4*)p.g1 + lane + 64 * j), be = *((const f32x4*)p.be1 + lane + 64 * j);
            v[j] = v[j] * rstd * g + be; *((v2u*)(x1 + (size_t)row * DM) + lane + 64 * j) = (v2u){pk2(v[j].x, v[j].y), pk2(v[j].z, v[j].w)}; s += (v[j].x + v[j].y) + (v[j].z + v[j].w); }
        mean = wave_sum(s) * (1.f / DM); s2 = 0.f;
#pragma unroll
        for (int j = 0; j < 4; ++j) { v[j] = v[j] - mean; s2 += (v[j].x * v[j].x + v[j].y * v[j].y) + (v[j].z * v[j].z + v[j].w * v[j].w); }
        rstd = rsqrtf(wave_sum(s2) * (1.f / DM) + LN_EPS);
        float amax = 0.f;
#pragma unroll
        for (int j = 0; j < 4; ++j) {
            const f32x4 sh = *((const f32x4*)(mod + b * 6144 + 3072) + lane + 64 * j), sc = *((const f32x4*)(mod + b * 6144 + 4096) + lane + 64 * j);
            const f32x4 o = v[j] * rstd * (1.0f + sc) + sh; v[j] = o;
            amax = fmaxf(amax, fmaxf(fmaxf(fabsf(o.x), fabsf(o.y)), fmaxf(fabsf(o.z), fabsf(o.w))));
            *((v2u*)(h2b + (size_t)row * DM) + lane + 64 * j) = (v2u){pk2(o.x, o.y), pk2(o.z, o.w)};
        }
        amax = wave_max(amax); const float hinv = amax > 0.f ? 127.0f / amax : 0.f;
        unsigned* q4 = (unsigned*)(p.ws + WS_H2Q + (size_t)row * DM) + lane;
#pragma unroll
        for (int j = 0; j < 4; ++j) { unsigned q = 0u;
            q = __builtin_amdgcn_cvt_pk_u8_f32(v[j].x * hinv + 128.0f, 0, q); q = __builtin_amdgcn_cvt_pk_u8_f32(v[j].y * hinv + 128.0f, 1, q);
            q = __builtin_amdgcn_cvt_pk_u8_f32(v[j].z * hinv + 128.0f, 2, q); q = __builtin_amdgcn_cvt_pk_u8_f32(v[j].w * hinv + 128.0f, 3, q);
            q4[64 * j] = q ^ 0x80808080u; }
        if (lane == 0) ((float*)(p.ws + WS_HS))[row] = amax * (1.0f / 127.0f);
    }
}
__device__ __forceinline__ void ph_tables8(const Params& p, int bid, int nblk) {
    const int lane = opaque_tid() & 63, wave = wave_id();
    for (int r = bid * NWAVES + wave; r < 2 * 16384; r += nblk * NWAVES) {
        const bool isv = r >= 16384; const int row = isv ? r - 16384 : r;
        const f32x4* src = (const f32x4*)((isv ? p.pv : p.pu) + (size_t)row * DM + 16 * lane);
        f32x4 a[4]; float amax = 0.f;
#pragma unroll
        for (int j = 0; j < 4; ++j) { a[j] = src[j]; amax = fmaxf(amax, fmaxf(fmaxf(fabsf(a[j].x), fabsf(a[j].y)), fmaxf(fabsf(a[j].z), fabsf(a[j].w)))); }
        amax = wave_max(amax);
        const float inv = amax > 0.f ? 127.0f / amax : 0.f;
        v4u o;
#pragma unroll
        for (int j = 0; j < 4; ++j) { unsigned q = 0u;
            q = __builtin_amdgcn_cvt_pk_u8_f32(a[j].x * inv + 128.0f, 0, q); q = __builtin_amdgcn_cvt_pk_u8_f32(a[j].y * inv + 128.0f, 1, q);
            q = __builtin_amdgcn_cvt_pk_u8_f32(a[j].z * inv + 128.0f, 2, q); q = __builtin_amdgcn_cvt_pk_u8_f32(a[j].w * inv + 128.0f, 3, q);
            o[j] = q ^ 0x80808080u; }
        *(v4u*)(p.ws + (isv ? WS_TV8 : WS_TU8) + (size_t)(lane >> 3) * (2 * MiB) + (size_t)row * 128 + 16 * (lane & 7)) = o;
        if (lane == 0) ((float*)(p.ws + (isv ? WS_SV : WS_SU)))[row] = amax * (1.0f / 127.0f);
    }
}
__device__ __forceinline__ float readlane_f(float v, int l) { return __builtin_bit_cast(float, __builtin_amdgcn_readlane(__builtin_bit_cast(int, v), l)); }
__device__ __forceinline__ float ub0(unsigned u) { return (float)(u & 255u); }
__device__ __forceinline__ float ub1(unsigned u) { return (float)((u >> 8) & 255u); }
__device__ __forceinline__ float ub2(unsigned u) { return (float)((u >> 16) & 255u); }
__device__ __forceinline__ float ub3(unsigned u) { return (float)(u >> 24); }
__device__ __forceinline__ v4u ust_meta(const Params& p, int step, int t0, int stride8, int lane) {
    const int g = step >> 4, k = step & 15; int t = t0 + g * stride8 + (lane >> 3); t = t < NT ? t : NT - 1;
    return *(const v4u*)(p.ws + WS_IDS + (size_t)t * 256 + 16 * k);
}
__device__ __forceinline__ void ust_issue(v4u (&ub)[8], const v4u& idq, const unsigned char* TUs) {
#pragma unroll
    for (int e = 0; e < 8; ++e) { const unsigned w = idq[e >> 1]; const unsigned id = (e & 1) ? (w >> 16) : (w & 0xffffu); ub[e] = *(const v4u*)(TUs + (size_t)id * 128); }
}
__device__ __forceinline__ unsigned short ust_compute(const v4u (&ub)[8], const v4u& idq, const v4u& h0, const v4u& h1, int off8, const float* SUs, int lane) {
    int a[8];
#pragma unroll
    for (int e = 0; e < 8; ++e) { int v = 0;
#pragma unroll
        for (int j = 0; j < 4; ++j) { const unsigned d = ub[e][j]; const unsigned lo = d & 0x0f0f0f0fu, hi = (d >> 4) & 0x0f0f0f0fu;
            const unsigned hl = j < 2 ? h0[2 * j] : h1[2 * j - 4], hh = j < 2 ? h0[2 * j + 1] : h1[2 * j - 3];
            v = __builtin_amdgcn_sdot4((int)lo, (int)hl, v, false); v = __builtin_amdgcn_sdot4((int)hi, (int)hh, v, false); }
        a[e] = v; }
    int a4[4];
#pragma unroll
    for (int k = 0; k < 4; ++k) { const bool up = (lane & 4) != 0; const int keep = up ? a[k + 4] : a[k], send = up ? a[k] : a[k + 4]; a4[k] = keep + __shfl_xor(send, 4); }
    int a2[2];
#pragma unroll
    for (int k = 0; k < 2; ++k) { const bool up = (lane & 2) != 0; const int keep = up ? a4[k + 2] : a4[k], send = up ? a4[k] : a4[k + 2]; a2[k] = keep + __shfl_xor(send, 2); }
    const bool up = (lane & 1) != 0; const int keep = up ? a2[1] : a2[0], send = up ? a2[0] : a2[1];
    const int tot = keep + __shfl_xor(send, 1);
    const int c = lane & 7; const unsigned w2 = (c >> 1) == 0 ? idq.x : ((c >> 1) == 1 ? idq.y : ((c >> 1) == 2 ? idq.z : idq.w));
    const unsigned id = (c & 1) ? (w2 >> 16) : (w2 & 0xffffu);
    return (unsigned short)f2bf((float)(tot - off8) * SUs[id]);
}
__device__ __forceinline__ void ph_udot(const Params& p, int bid, int nblk) {
    unsigned short* P = (unsigned short*)(p.ws + WS_PART);
    const int lane = opaque_tid() & 63, wave = wave_id(), c = lane & 7;
    const int s8 = bid & 7, s = s8 & 3;
    const int nlo = (nblk - s + 7) >> 3, nhi = (nblk - (s + 4) + 7) >> 3;
    const int widx = ((s8 >> 2) ? nlo : 0) * NWAVES + (bid >> 3) * NWAVES + wave, stride8 = (nlo + nhi) * NWAVES * 8;
    const unsigned char* TUs = p.ws + WS_TU8 + (size_t)s * (2 * MiB) + 16 * c;
    const float* SUs = (const float*)(p.ws + WS_SU) + (size_t)s * 16384;
    const int t0 = widx * 8;
    const int ngroups = t0 < NT ? (NT - t0 + stride8 - 1) / stride8 : 0, nsteps = ngroups * 16;
    if (nsteps == 0) return;
    v4u uA[8], uB[8];
    v4u qa = ust_meta(p, 0, t0, stride8, lane);
    ust_issue(uA, qa, TUs);
    v4u qb = ust_meta(p, 1, t0, stride8, lane);
    v4u h0 = {0u, 0u, 0u, 0u}, h1 = {0u, 0u, 0u, 0u}; int off8 = 0;
    for (int st = 0; st < nsteps; st += 2) {
        const int tg = t0 + (st >> 4) * stride8 + (lane >> 3); const int t = tg < NT ? tg : NT - 1;
        if ((st & 15) == 0) {
            const unsigned char* hp = p.ws + WS_H2Q + (size_t)t * DM + 256 * s + 32 * c; h0 = *(const v4u*)hp; h1 = *(const v4u*)(hp + 16);
            int hs = 0;
#pragma unroll
            for (int j = 0; j < 4; ++j) { hs = __builtin_amdgcn_sdot4((int)h0[j], 0x01010101, hs, false); hs = __builtin_amdgcn_sdot4((int)h1[j], 0x01010101, hs, false); }
            hs += __shfl_xor(hs, 1); hs += __shfl_xor(hs, 2); hs += __shfl_xor(hs, 4); off8 = 8 * hs;
        }
        ust_issue(uB, qb, TUs);
        const v4u ia = qa; qa = ust_meta(p, st + 2 < nsteps ? st + 2 : st, t0, stride8, lane);
        const unsigned short ra = ust_compute(uA, ia, h0, h1, off8, SUs, lane);
        if (st + 2 < nsteps) ust_issue(uA, qa, TUs);
        const v4u ib = qb; qb = ust_meta(p, st + 3 < nsteps ? st + 3 : st + 1, t0, stride8, lane);
        const unsigned short rb = ust_compute(uB, ib, h0, h1, off8, SUs, lane);
        if (tg < NT) { unsigned short* dst = P + ((size_t)t * 4 + s) * 128 + 8 * (st & 15) + c; dst[0] = ra; dst[8] = rb; }
    }
}
__device__ __forceinline__ void ph_act(const Params& p, int bid, int nblk) {
    const bf16* P = (const bf16*)(p.ws + WS_PART); const float* GS = (const float*)(p.ws + WS_GATES); const float* HS = (const float*)(p.ws + WS_HS);
    unsigned char* WQ = p.ws + WS_WQ; float* WSC = (float*)(p.ws + WS_WSC);
    const int lane = opaque_tid() & 63, wave = wave_id();
    for (int t = bid * NWAVES + wave; t < NT; t += nblk * NWAVES) {
        float a0 = 0.f, a1 = 0.f;
#pragma unroll
        for (int s = 0; s < 4; ++s) { a0 += __builtin_bit_cast(float, (unsigned)P[((size_t)t * 4 + s) * 128 + lane] << 16); a1 += __builtin_bit_cast(float, (unsigned)P[((size_t)t * 4 + s) * 128 + 64 + lane] << 16); }
        const float hs = HS[t];
        const float d0 = a0 * hs, d1 = a1 * hs;
        const float w0 = GS[(size_t)t * 128 + lane] * 0.5f * d0 * (1.0f + erff(d0 * 0.70710678118654752f));
        const float w1 = GS[(size_t)t * 128 + 64 + lane] * 0.5f * d1 * (1.0f + erff(d1 * 0.70710678118654752f));
        const float wmax = wave_max(fmaxf(fabsf(w0), fabsf(w1))); const float winv = wmax > 0.f ? 127.0f / wmax : 0.f;
        unsigned b2 = __builtin_amdgcn_cvt_pk_u8_f32(w0 * winv + 128.0f, 0, 0u); b2 = __builtin_amdgcn_cvt_pk_u8_f32(w1 * winv + 128.0f, 1, b2); b2 ^= 0x8080u;
        WQ[(size_t)t * 128 + lane] = (unsigned char)(b2 & 255u); WQ[(size_t)t * 128 + 64 + lane] = (unsigned char)((b2 >> 8) & 255u);
        if (lane == 0) WSC[t] = wmax * (1.0f / 127.0f);
    }
}
struct VstepMeta { v4u idq; v2u wq; };
__device__ __forceinline__ VstepMeta vst_meta(const Params& p, int step, int t0, int stride8, int lane) {
    const int g = step >> 4, k = step & 15; int t = t0 + g * stride8 + (lane >> 3); t = t < NT ? t : NT - 1;
    VstepMeta r; r.idq = *(const v4u*)(p.ws + WS_IDS + (size_t)t * 256 + 16 * k); r.wq = *(const v2u*)(p.ws + WS_WQ + (size_t)t * 128 + 8 * k); return r;
}
__device__ __forceinline__ void vst_issue(v4u (&vb)[8], const VstepMeta& q, const unsigned char* TVs) {
#pragma unroll
    for (int e = 0; e < 8; ++e) { const unsigned w = q.idq[e >> 1]; const unsigned id = (e & 1) ? (w >> 16) : (w & 0xffffu); vb[e] = *(const v4u*)(TVs + (size_t)id * 128); }
}
__device__ __forceinline__ void vst_compute(int (&y)[16], const v4u (&vb)[8], const v2u& wq) {
#pragma unroll
    for (int qd = 0; qd < 2; ++qd)
#pragma unroll
        for (int cm = 0; cm < 4; ++cm) {
            const unsigned A = vb[4 * qd][cm], B = vb[4 * qd + 1][cm], C = vb[4 * qd + 2][cm], D = vb[4 * qd + 3][cm];
            const unsigned ab01 = __builtin_amdgcn_perm(B, A, 0x05010400u), ab23 = __builtin_amdgcn_perm(B, A, 0x07030602u);
            const unsigned cd01 = __builtin_amdgcn_perm(D, C, 0x05010400u), cd23 = __builtin_amdgcn_perm(D, C, 0x07030602u);
            const unsigned t0 = __builtin_amdgcn_perm(cd01, ab01, 0x05040100u), t1 = __builtin_amdgcn_perm(cd01, ab01, 0x07060302u);
            const unsigned t2 = __builtin_amdgcn_perm(cd23, ab23, 0x05040100u), t3 = __builtin_amdgcn_perm(cd23, ab23, 0x07060302u);
            y[4 * cm + 0] = __builtin_amdgcn_sdot4((int)t0, (int)wq[qd], y[4 * cm + 0], false); y[4 * cm + 1] = __builtin_amdgcn_sdot4((int)t1, (int)wq[qd], y[4 * cm + 1], false);
            y[4 * cm + 2] = __builtin_amdgcn_sdot4((int)t2, (int)wq[qd], y[4 * cm + 2], false); y[4 * cm + 3] = __builtin_amdgcn_sdot4((int)t3, (int)wq[qd], y[4 * cm + 3], false);
        }
}
__device__ __forceinline__ void ph_vacc(const Params& p, int bid, int nblk) {
    bf16* Y = (bf16*)(p.ws + WS_Y); const float* WSC = (const float*)(p.ws + WS_WSC);
    const int lane = opaque_tid() & 63, wave = wave_id(), c = lane & 7;
    const int s = bid & 7, nper = (nblk - s + 7) >> 3,     stride8 = nper * NWAVES * 8;
    const unsigned char* TVs = p.ws + WS_TV8 + (size_t)s * (2 * MiB) + 16 * c;
    const int t0 = ((bid >> 3) * NWAVES + wave) * 8;
    const int ngroups = t0 < NT ? (NT - t0 + stride8 - 1) / stride8 : 0, nsteps = ngroups * 16;
    if (nsteps == 0) return;
    int y[16];
#pragma unroll
    for (int k = 0; k < 16; ++k) y[k] = 0;
    v4u vA[8], vB[8];
    VstepMeta qa = vst_meta(p, 0, t0, stride8, lane);
    vst_issue(vA, qa, TVs);
    VstepMeta qb = vst_meta(p, 1, t0, stride8, lane);
    for (int st = 0; st < nsteps; st += 2) {
        vst_issue(vB, qb, TVs);
        const v2u wa = qa.wq; qa = vst_meta(p, st + 2 < nsteps ? st + 2 : st, t0, stride8, lane);
        vst_compute(y, vA, wa);
        if (st + 2 < nsteps) vst_issue(vA, qa, TVs);
        const v2u wb = qb.wq; qb = vst_meta(p, st + 3 < nsteps ? st + 3 : st + 1, t0, stride8, lane);
        vst_compute(y, vB, wb);
        if (((st + 1) & 15) == 15) {
            const int t = t0 + (st >> 4) * stride8 + (lane >> 3);
            if (t < NT) { const float sc = WSC[t];
                v4u o0, o1; o0.x = pk2((float)y[0] * sc, (float)y[1] * sc); o0.y = pk2((float)y[2] * sc, (float)y[3] * sc); o0.z = pk2((float)y[4] * sc, (float)y[5] * sc); o0.w = pk2((float)y[6] * sc, (float)y[7] * sc);
                o1.x = pk2((float)y[8] * sc, (float)y[9] * sc); o1.y = pk2((float)y[10] * sc, (float)y[11] * sc); o1.z = pk2((float)y[12] * sc, (float)y[13] * sc); o1.w = pk2((float)y[14] * sc, (float)y[15] * sc);
                v4u* dst = (v4u*)(Y + (size_t)t * DM + 128 * s + 16 * c); dst[0] = o0; dst[1] = o1; }
#pragma unroll
            for (int k = 0; k < 16; ++k) y[k] = 0;
        }
    }
}
__device__ __forceinline__ void ph_final(const Params& p, int bid, int nblk) {
    const bf16* x1 = (const bf16*)(p.ws + WS_X1); const bf16* Y = (const bf16*)(p.ws + WS_Y); const float* mod = (const float*)(p.ws + WS_MOD);
    const int lane = opaque_tid() & 63, wave = wave_id();
    for (int t = bid * NWAVES + wave; t < NT; t += nblk * NWAVES) {
        const int b = t / SEQ;
        f32x4 v[4]; float s = 0.f;
#pragma unroll
        for (int j = 0; j < 4; ++j) { const v2u xw = *((const v2u*)(x1 + (size_t)t * DM) + lane + 64 * j), yw = *((const v2u*)(Y + (size_t)t * DM) + lane + 64 * j);
            const f32x4 g2 = *((const f32x4*)(mod + b * 6144 + 5120) + lane + 64 * j);
            const f32x4 xv = {bflo(xw.x), bfhi(xw.x), bflo(xw.y), bfhi(xw.y)}, yv = {bflo(yw.x), bfhi(yw.x), bflo(yw.y), bfhi(yw.y)};
            v[j] = xv * ALPHA + (g2 + 1.0f) * yv; s += (v[j].x + v[j].y) + (v[j].z + v[j].w); }
        const float mean = wave_sum(s) * (1.f / DM); float s2 = 0.f;
#pragma unroll
        for (int j = 0; j < 4; ++j) { v[j] = v[j] - mean; s2 += (v[j].x * v[j].x + v[j].y * v[j].y) + (v[j].z * v[j].z + v[j].w * v[j].w); }
        const float rstd = rsqrtf(wave_sum(s2) * (1.f / DM) + LN_EPS);
#pragma unroll
        for (int j = 0; j < 4; ++j) { const f32x4 g = *((const f32x4*)p.g2 + lane + 64 * j), be = *((const f32x4*)p.be2 + lane + 64 * j);
            *((f32x4*)(p.out + (size_t)t * DM) + lane + 64 * j) = v[j] * rstd * g + be; }
    }
}

#ifndef PROBE_ID
#define PROBE_ID 0
#endif
#define RUN2(id, ...) do { __VA_ARGS__; if (PROBE_ID == (id)) { xcd_barrier(bar); __VA_ARGS__; } } while (0)
__global__ void __launch_bounds__(NTHREADS, 2) mega(Params p) {
    extern __shared__ __attribute__((aligned(16))) unsigned char lds_raw[];

    LAS unsigned char* lds = (LAS unsigned char*)lds_raw;
    const int bid = blockIdx.x, nblk = gridDim.x, tid = opaque_tid();
    for (int u = tid; u < (LDS_BYTES - LDSCTL_OFF) / 4; u += NTHREADS) ((LAS unsigned*)(lds + LDSCTL_OFF))[u] = 0u;
    __syncthreads();
    unsigned* ctl = (unsigned*)(p.ws + WS_CTL);
    XcdBarrier bar = xcd_barrier_post(ctl + CW_BAR, (volatile LAS unsigned*)(lds + MISC_OFF) + 8);
    const float* mod = (const float*)(p.ws + WS_MOD);

    ph_mod(p, lds, bid, nblk);
    xcd_barrier(bar);
    RUN2(1, ph_prologue(p, lds, bid, nblk));
    RUN2(7, ph_xn(p, bid, nblk));
    xcd_barrier(bar);
    {
        pg8::Gemm g{(const pg8::bf16_t*)(p.ws + WS_XN), (const pg8::bf16_t*)(p.ws + WS_WIN), NT, NIN, DM}; pg8::StaticOrder S; S.init(NT, NIN, nblk, bid);
        EpiIn E{(bf16*)(p.ws + WS_FZ), (bf16*)(p.ws + WS_QB), (const float*)(p.ws + WS_MISC), (const float*)(p.ws + WS_ROPE)};
        pg8::gemm_phase<EpiIn, pg8::StaticOrder, true, true>(lds, g, S, E);
    }
    xcd_barrier(bar);
    RUN2(8, ph_fft(p, lds, bid, nblk));
    RUN2(2, ph_attn_fast(p, lds, bid, nblk));
    xcd_barrier(bar);
    RUN2(3, ph_merge(p, bid, nblk));
    xcd_barrier(bar);
    {
        pg8::Gemm g{(const pg8::bf16_t*)(p.ws + WS_XN), (const pg8::bf16_t*)(p.ws + WS_WOUT), NT, DM, DM}; pg8::StaticOrder S; S.init(NT, DM, nblk, bid);
        EpiOut E{(bf16*)(p.ws + WS_Y1), p.x, mod, p.b_out};
        pg8::gemm_phase<EpiOut, pg8::StaticOrder, true, true>(lds, g, S, E);
    }
    xcd_barrier(bar);
    RUN2(4, ph_ln1_fast(p, bid, nblk));
    xcd_barrier(bar);
    {
        pg8::Gemm g{(const pg8::bf16_t*)(p.ws + WS_XN), (const pg8::bf16_t*)(p.ws + WS_WPQ), NT, DM, DM}; pg8::StaticOrder S; S.init(NT, DM, nblk, bid);
        pg8::EpiBf16<0> E{(pg8::bf16_t*)(p.ws + WS_PQ), DM, nullptr, 0, 0, 1.f};
        pg8::gemm_phase<pg8::EpiBf16<0>, pg8::StaticOrder, true, true>(lds, g, S, E);
    }
    xcd_barrier(bar);
    RUN2(5, ph_topk_fast(p, lds, bid, nblk));
    xcd_barrier(bar);
    RUN2(6, ph_udot(p, bid, nblk));
    xcd_barrier(bar);
    RUN2(11, ph_act(p, bid, nblk));
    xcd_barrier(bar);
    RUN2(10, ph_vacc(p, bid, nblk));
    xcd_barrier(bar);
    ph_final(p, bid, nblk);
}

extern "C" void kernel_launch(void* const* d_in, const int* in_sizes, int n_in, void* d_out, int out_size, void* d_ws, size_t ws_size, hipStream_t stream) {
    Params p{};
    p.x = (const float*)d_in[0]; p.c = (const float*)d_in[1]; p.pos = (const int*)d_in[2]; p.w_ada = (const float*)d_in[3]; p.b_ada = (const float*)d_in[4];
    p.w_in = (const float*)d_in[5]; p.b_in = (const float*)d_in[6]; p.w_four = (const float*)d_in[7]; p.w_out = (const float*)d_in[8]; p.b_out = (const float*)d_in[9];
    p.g1 = (const float*)d_in[10]; p.be1 = (const float*)d_in[11]; p.w_pq = (const float*)d_in[12]; p.subk = (const float*)d_in[13]; p.pu = (const float*)d_in[14]; p.pv = (const float*)d_in[15];
    p.g2 = (const float*)d_in[16]; p.be2 = (const float*)d_in[17]; p.out = (float*)d_out; p.ws = (unsigned char*)d_ws;
    static int grid_blocks = 0;
    if (grid_blocks == 0) {
        if (ws_size < WS_END) { fprintf(stderr, "workspace too small: %zu < %zu\n", ws_size, (size_t)WS_END); grid_blocks = -1; return; }
        int dev = 0, cus = 0, per_cu = 0;
        if (hipGetDevice(&dev) != hipSuccess || hipDeviceGetAttribute(&cus, hipDeviceAttributeMultiprocessorCount, dev) != hipSuccess) { grid_blocks = -1; return; }
        if (hipFuncSetAttribute((const void*)mega, hipFuncAttributeMaxDynamicSharedMemorySize, LDS_BYTES) != hipSuccess) { fprintf(stderr, "hipFuncSetAttribute failed\n"); grid_blocks = -1; return; }
        if (hipOccupancyMaxActiveBlocksPerMultiprocessor(&per_cu, (const void*)mega, NTHREADS, LDS_BYTES) != hipSuccess || per_cu < 1) { fprintf(stderr, "occupancy query: %d\n", per_cu); grid_blocks = -1; return; }
        grid_blocks = cus;
    }
    if (grid_blocks < 0) return;
    if (hipMemsetAsync((char*)d_ws + WS_CTL, 0, CTL_ZERO_BYTES, stream) != hipSuccess) { fprintf(stderr, "memset failed\n"); return; }
    void* args[] = {&p};
    hipError_t e = hipLaunchCooperativeKernel((void*)mega, dim3(grid_blocks), dim3(NTHREADS), args, LDS_BYTES, stream);
    if (e != hipSuccess) fprintf(stderr, "cooperative launch failed: %s (grid %d)\n", hipGetErrorString(e), grid_blocks);
}
```

```cpp
#include <hip/hip_runtime.h>
#include <hip/hip_cooperative_groups.h>
#include <cstdio>
#include <cstdint>
#include <cmath>
namespace cg = cooperative_groups;

namespace pg8 {
#define PG8_LAS __attribute__((address_space(3)))
typedef unsigned short bf16_t;
typedef short bf16x8 __attribute__((ext_vector_type(8)));
typedef float f32x4 __attribute__((ext_vector_type(4)));
typedef unsigned u32x4 __attribute__((ext_vector_type(4)));
constexpr int BM = 256, BK = 64, HALF = 128, HTB = HALF * BK * 2  , STAGE_BYTES = 8 * HTB, NXCD = 8, WGM = 8;

__host__ __device__ __forceinline__ int lds_byte(int r, int c) { const int st = (r >> 4) * 2 + (c >> 5), rr = r & 15, cc = c & 31, ob = rr * 64 + cc * 2; return st * 1024 + (ob ^ (((ob >> 9) & 1) << 5)); }
__host__ __device__ __forceinline__ void stage_rc(int b, int& R, int& C) { const int st = b / 1024, sb = b % 1024, swz = sb ^ (((sb >> 9) & 1) << 5); R = (st >> 1) * 16 + swz / 64; C = (st & 1) * 32 + (swz % 64) / 2; }
__host__ __device__ __forceinline__ int perm32(int rho) { const int n = rho >> 4, i = rho & 15; return 8 * (i >> 2) + 4 * n + (i & 3); }

struct Unit { int pm, pn; };
struct Gemm { const bf16_t* A; const bf16_t* Bt; int M, N, K; };

struct StaticOrder {
    int nM, nN, nwg, G, c;
    __host__ __device__ void init(int M, int N, int G_, int c_) { nM = M / BM; nN = N / BM; nwg = nM * nN; G = G_; c = c_; }
    __host__ __device__ bool next(int i, Unit& u) const {
        const long L = (long)i * G + c; if (L >= nwg) return false;
        int wgid = (int)L; { const int q = nwg / NXCD, r = nwg % NXCD, xcd = wgid % NXCD, off = wgid / NXCD; wgid = (xcd < r ? xcd * (q + 1) : r * (q + 1) + (xcd - r) * q) + off; }
        const int nig = WGM * nN, gid = wgid / nig, fm = gid * WGM, gsz = (nM - fm) < WGM ? (nM - fm) : WGM;
        u.pm = fm + ((wgid % nig) % gsz); u.pn = (wgid % nig) / gsz; return true;
    }
    __device__ __forceinline__ void a_ready(const Unit&) const {}
    __device__ __forceinline__ void done(const Unit&) const {}
};

__device__ __forceinline__ unsigned cvt_pk_bf16(float lo, float hi) { unsigned r; asm volatile("v_cvt_pk_bf16_f32 %0, %1, %2" : "=v"(r) : "v"(lo), "v"(hi)); return r; }
typedef float f32x2 __attribute__((ext_vector_type(2)));
__device__ __forceinline__ f32x2 gelu_pk(f32x2 v) {
    const f32x2 av = __builtin_elementwise_abs(v), d = av * 0.2316418882f + 1.0f;
    f32x2 t; t.x = __builtin_amdgcn_rcpf(d.x); t.y = __builtin_amdgcn_rcpf(d.y);
    f32x2 q = t * 0.5307027145f + (-0.7265760135f); q = q * t + 0.7107068705f; q = q * t + (-0.142248368f); q = q * t + 0.127414796f; q = q * t;
    const f32x2 s = (v * v) * (-0.72134752044f);
    f32x2 e; e.x = __builtin_amdgcn_exp2f(s.x); e.y = __builtin_amdgcn_exp2f(s.y);
    const f32x2 m = v * (q * e), r = v - m;
    f32x2 o; o.x = v.x < 0.f ? m.x : r.x; o.y = v.y < 0.f ? m.y : r.y; return o;
}

template <int ACT  > struct EpiBf16 {
    static constexpr bool PERM = true, AFTER_DRAIN = false; static_assert(ACT == 0 || ACT == 1, "EpiBf16: ACT is 0 (none) or 1 (gelu_pk)");
    bf16_t* O; int ldc; const float* bias; int split_cols; size_t split_stride; float scale0;
    __device__ __forceinline__ void operator()(const f32x4 (&acc)[2][2][4][2], const Unit& u, int wr, int wc, int fr, int fq) const {
        const int row0 = u.pm * BM + wr * 64 + fr; int colt = u.pn * BM; bf16_t* base = O;
        float sc = 1.f; if (split_cols) { const int t = colt / split_cols; base += (size_t)t * split_stride; colt -= t * split_cols; if (t == 0) sc = scale0; }
        const int col0 = colt + wc * 32 + 8 * fq, bcol0 = u.pn * BM + wc * 32 + 8 * fq;
        f32x4 bv[2][2];
#pragma unroll
        for (int bj = 0; bj < 2; ++bj)
#pragma unroll
            for (int n = 0; n < 2; ++n) bv[bj][n] = bias ? *(const f32x4*)(bias + bcol0 + bj * HALF + 4 * n) : (f32x4){0.f, 0.f, 0.f, 0.f};
#pragma unroll
        for (int ai = 0; ai < 2; ++ai)
#pragma unroll
            for (int m = 0; m < 4; ++m) { bf16_t* rowp = base + (size_t)(row0 + ai * HALF + m * 16) * ldc + col0;
#pragma unroll
                for (int bj = 0; bj < 2; ++bj) { f32x4 v0 = acc[ai][bj][m][0] + bv[bj][0], v1 = acc[ai][bj][m][1] + bv[bj][1];
                    if (ACT == 1) { f32x2 a = gelu_pk((f32x2){v0[0], v0[1]}), b = gelu_pk((f32x2){v0[2], v0[3]}), c = gelu_pk((f32x2){v1[0], v1[1]}), d = gelu_pk((f32x2){v1[2], v1[3]});
                        v0 = (f32x4){a.x, a.y, b.x, b.y}; v1 = (f32x4){c.x, c.y, d.x, d.y}; }
                    v0 = v0 * sc; v1 = v1 * sc; u32x4 w; w.x = cvt_pk_bf16(v0[0], v0[1]); w.y = cvt_pk_bf16(v0[2], v0[3]); w.z = cvt_pk_bf16(v1[0], v1[1]); w.w = cvt_pk_bf16(v1[2], v1[3]);
                    *(u32x4*)(rowp + bj * HALF) = w; } }
    }
};
template <class Epi, class Sched, bool ALIGN_EPI = false, bool SP2 = false>
__device__ __forceinline__ void gemm_phase(PG8_LAS unsigned char* lds, const Gemm g, const Sched& S, const Epi& E) {
    int tid_ = threadIdx.x; asm volatile("" : "+v"(tid_)); const int tid = tid_, wid = __builtin_amdgcn_readfirstlane(tid >> 6), lane = tid & 63, wr = wid >> 2, wc = wid & 3, fr = lane & 15, fq = lane >> 4;
    const int K = g.K, nt = K / BK;
    unsigned voffA[2], voffB[2];
#pragma unroll
    for (int i = 0; i < 2; ++i) { int R, C; stage_rc(tid * 16 + i * 8192, R, C); const int Rb = Epi::PERM ? ((R & ~31) + perm32(R & 31)) : R;
        voffA[i] = (unsigned)(R * K + C) * 2u; voffB[i] = (unsigned)(Rb * K + C) * 2u; }
    const size_t kstep = (size_t)(BK * 2);
    const size_t hstep = (size_t)HALF * K * 2;
    const size_t tstep = 2 * hstep;
    const unsigned ldsw = (unsigned)wid * 1024u;
    const int aoff = lds_byte(wr * 64 + fr, fq * 8), boff = lds_byte(wc * 32 + fr, fq * 8);
#define PG8_SA(b, h) (((b) * 2 + (h)) * HTB)
#define PG8_SB(b, h) ((4 + (b) * 2 + (h)) * HTB)
#define PG8_STAGE(bufoff, gbase, voff) do { _Pragma("unroll") for (int _i = 0; _i < 2; ++_i) \
        __builtin_amdgcn_global_load_lds((const unsigned*)((const char*)(gbase) + (voff)[_i]), (PG8_LAS unsigned*)(lds + (bufoff) + ldsw + _i * 8192), 16, 0, 0); } while (0)
#define PG8_LDA(dst, b, h) do { _Pragma("unroll") for (int m = 0; m < 4; ++m) _Pragma("unroll") for (int k = 0; k < 2; ++k) dst[m][k] = *(const PG8_LAS bf16x8*)(lds + PG8_SA(b, h) + aoff + m * 2048 + k * 1024); } while (0)
#define PG8_LDB(dst, b, h) do { _Pragma("unroll") for (int n = 0; n < 2; ++n) _Pragma("unroll") for (int k = 0; k < 2; ++k) dst[n][k] = *(const PG8_LAS bf16x8*)(lds + PG8_SB(b, h) + boff + n * 2048 + k * 1024); } while (0)
#define PG8_MMA(ai, bj, At, Bt) do { __builtin_amdgcn_s_setprio(1); _Pragma("unroll") for (int m = 0; m < 4; ++m) _Pragma("unroll") for (int n = 0; n < 2; ++n) _Pragma("unroll") for (int k = 0; k < 2; ++k) \
        acc[ai][bj][m][n] = __builtin_amdgcn_mfma_f32_16x16x32_bf16(Bt[n][k], At[m][k], acc[ai][bj][m][n], 0, 0, 0); __builtin_amdgcn_s_setprio(0); } while (0)
#define PG8_WAIT_V(n) asm volatile("s_waitcnt vmcnt(" #n ")" ::: "memory")
#define PG8_WAIT_L(n) asm volatile("s_waitcnt lgkmcnt(" #n ")" ::: "memory")
#define PG8_BAR __builtin_amdgcn_s_barrier()
#define PG8_SCHED __builtin_amdgcn_sched_barrier(0)
    Unit cur, nxt; int ui = 0;
    if (!S.next(0, cur)) return;
    f32x4 acc[2][2][4][2];
#pragma unroll
    for (int a = 0; a < 2; ++a)
#pragma unroll
        for (int b = 0; b < 2; ++b)
#pragma unroll
            for (int m = 0; m < 4; ++m)
#pragma unroll
                for (int n = 0; n < 2; ++n) acc[a][b][m][n] = (f32x4){0.f, 0.f, 0.f, 0.f};
    bf16x8 At[4][2], B0[2][2], B1[2][2];
    const char* cA = (const char*)g.A + (size_t)cur.pm * tstep; const char* cB = (const char*)g.Bt + (size_t)cur.pn * tstep;
    S.a_ready(cur);
    if constexpr (SP2) {
        PG8_STAGE(PG8_SB(0, 0), cB, voffB); PG8_STAGE(PG8_SB(0, 1), cB + hstep, voffB); PG8_STAGE(PG8_SA(0, 0), cA, voffA); PG8_STAGE(PG8_SA(0, 1), cA + hstep, voffA);
        if (wr == 1) PG8_BAR;
        PG8_WAIT_V(2); PG8_BAR;
        PG8_STAGE(PG8_SB(1, 0), cB + kstep, voffB); PG8_STAGE(PG8_SA(1, 0), cA + kstep, voffA); PG8_STAGE(PG8_SB(1, 1), cB + hstep + kstep, voffB);
        PG8_WAIT_V(6); PG8_BAR;
    } else {
        PG8_STAGE(PG8_SB(0, 0), cB, voffB); PG8_STAGE(PG8_SA(0, 0), cA, voffA); PG8_STAGE(PG8_SB(0, 1), cB + hstep, voffB); PG8_STAGE(PG8_SA(0, 1), cA + hstep, voffA);
        if (wr == 1) PG8_BAR;
        PG8_WAIT_V(4); PG8_BAR;
        PG8_STAGE(PG8_SB(1, 0), cB + kstep, voffB); PG8_STAGE(PG8_SA(1, 0), cA + kstep, voffA); PG8_STAGE(PG8_SB(1, 1), cB + hstep + kstep, voffB);
        PG8_WAIT_V(6); PG8_BAR;
    }
    for (;;) {
        const bool has_next = S.next(ui + 1, nxt);
        const char* nA = has_next ? (const char*)g.A + (size_t)nxt.pm * tstep : cA; const char* nB = has_next ? (const char*)g.Bt + (size_t)nxt.pn * tstep : cB;
        for (int t = 0; t < nt; t += 2) {
            const bool last = (t == nt - 2);
            const char* a1 = cA + (size_t)(t + 1) * kstep;
            const char* a2 = last ? nA : cA + (size_t)(t + 2) * kstep; const char* b2 = last ? nB : cB + (size_t)(t + 2) * kstep;
            const char* a3 = a2 + kstep; const char* b3 = b2 + kstep;
            if (last && has_next) S.a_ready(nxt);
            if constexpr (SP2) {
            PG8_LDB(B0, 0, 0); PG8_LDB(B1, 0, 1); PG8_SCHED; PG8_LDA(At, 0, 0); PG8_STAGE(PG8_SA(1, 1), a1 + hstep, voffA);
            PG8_WAIT_V(8); PG8_WAIT_L(0); PG8_BAR; PG8_MMA(0, 0, At, B0); PG8_MMA(0, 1, At, B1); PG8_BAR; PG8_SCHED;
            PG8_LDA(At, 0, 1); PG8_STAGE(PG8_SB(0, 0), b2, voffB); PG8_STAGE(PG8_SB(0, 1), b2 + hstep, voffB); PG8_STAGE(PG8_SA(0, 0), a2, voffA);
            PG8_WAIT_V(8); PG8_WAIT_L(0); PG8_BAR; PG8_MMA(1, 0, At, B0); PG8_MMA(1, 1, At, B1); PG8_BAR; PG8_SCHED;
            PG8_LDB(B0, 1, 0); PG8_LDB(B1, 1, 1); PG8_SCHED; PG8_LDA(At, 1, 0); PG8_STAGE(PG8_SA(0, 1), a2 + hstep, voffA);
            PG8_WAIT_V(8); PG8_WAIT_L(0); PG8_BAR; PG8_MMA(0, 0, At, B0); PG8_MMA(0, 1, At, B1); PG8_BAR; PG8_SCHED;
            PG8_LDA(At, 1, 1); PG8_STAGE(PG8_SB(1, 0), b3, voffB); PG8_STAGE(PG8_SB(1, 1), b3 + hstep, voffB); PG8_STAGE(PG8_SA(1, 0), a3, voffA);
            PG8_WAIT_V(8); PG8_WAIT_L(0); PG8_BAR; PG8_MMA(1, 0, At, B0); PG8_MMA(1, 1, At, B1); PG8_BAR; PG8_SCHED;
            } else {
            PG8_LDB(B0, 0, 0); PG8_SCHED; PG8_LDA(At, 0, 0); PG8_STAGE(PG8_SA(1, 1), a1 + hstep, voffA);
            PG8_WAIT_L(8); PG8_BAR; PG8_WAIT_L(0); PG8_MMA(0, 0, At, B0); PG8_BAR; PG8_SCHED;
            PG8_LDB(B1, 0, 1); PG8_STAGE(PG8_SB(0, 0), b2, voffB);
            PG8_BAR; PG8_WAIT_L(0); PG8_MMA(0, 1, At, B1); PG8_BAR;
            PG8_LDA(At, 0, 1); PG8_STAGE(PG8_SA(0, 0), a2, voffA);
            PG8_BAR; PG8_WAIT_L(0); PG8_MMA(1, 0, At, B0); PG8_BAR; PG8_SCHED;
            PG8_STAGE(PG8_SB(0, 1), b2 + hstep, voffB);
            PG8_WAIT_V(6); PG8_BAR; PG8_MMA(1, 1, At, B1); PG8_BAR;
            PG8_LDB(B0, 1, 0); PG8_SCHED; PG8_LDA(At, 1, 0); PG8_STAGE(PG8_SA(0, 1), a2 + hstep, voffA);
            PG8_WAIT_L(8); PG8_BAR; PG8_WAIT_L(0); PG8_MMA(0, 0, At, B0); PG8_BAR; PG8_SCHED;
            PG8_LDB(B1, 1, 1); PG8_STAGE(PG8_SB(1, 0), b3, voffB);
            PG8_BAR; PG8_WAIT_L(0); PG8_MMA(0, 1, At, B1); PG8_BAR;
            PG8_LDA(At, 1, 1); PG8_STAGE(PG8_SA(1, 0), a3, voffA);
            PG8_BAR; PG8_WAIT_L(0); PG8_MMA(1, 0, At, B0); PG8_BAR; PG8_SCHED;
            PG8_STAGE(PG8_SB(1, 1), b3 + hstep, voffB);
            PG8_WAIT_V(6); PG8_BAR; PG8_MMA(1, 1, At, B1); PG8_BAR;
            }
        }
        if constexpr (ALIGN_EPI) { if (wr == 0) PG8_BAR; }
        if constexpr (!Epi::AFTER_DRAIN) { E(acc, cur, wr, wc, fr, fq); S.done(cur); }
        if (!has_next) break;
#pragma unroll
        for (int a = 0; a < 2; ++a)
#pragma unroll
            for (int b = 0; b < 2; ++b)
#pragma unroll
                for (int m = 0; m < 4; ++m)
#pragma unroll
                    for (int n = 0; n < 2; ++n) acc[a][b][m][n] = (f32x4){0.f, 0.f, 0.f, 0.f};
        cur = nxt; cA = nA; cB = nB; ++ui;
        if constexpr (ALIGN_EPI) { if (wr == 1) PG8_BAR; }
    }
    PG8_WAIT_V(0);
    if constexpr (!ALIGN_EPI) { if (wr == 0) PG8_BAR; }
    PG8_BAR;
    if constexpr (Epi::AFTER_DRAIN) { E.fused(acc, cur, wr, wc, fr, fq, lds, wid, lane); S.done(cur); }
#undef PG8_SA
#undef PG8_SB
#undef PG8_STAGE
#undef PG8_LDA
#undef PG8_LDB
#undef PG8_MMA
#undef PG8_WAIT_V
#undef PG8_WAIT_L
#undef PG8_BAR
#undef PG8_SCHED
}
}

#define LAS __attribute__((address_space(3)))
#define GAS __attribute__((address_space(1)))
#define XB_TMO      128
#define XB_XCNT(j)  (256  + 64 * (j))
#define XB_XSUB(j)  (1280 + 64 * (j))
#define XB_XGEN(j)  (2304 + 64 * (j))
#define XB_TOP      3328
#define XB_TOPGEN   3392
#define XCD_BAR_WORDS 3456
#define XB_SPIN_CAP (1u << 18)

__device__ __forceinline__ unsigned xb_ld(unsigned* p)              { return __hip_atomic_load(p, __ATOMIC_RELAXED, __HIP_MEMORY_SCOPE_AGENT); }
__device__ __forceinline__ unsigned xb_add(unsigned* p, unsigned v) { return __hip_atomic_fetch_add(p, v, __ATOMIC_RELAXED, __HIP_MEMORY_SCOPE_AGENT); }
__device__ __forceinline__ unsigned xb_xcc_id() { return (unsigned)__builtin_amdgcn_s_getreg((3 << 11) | 20) & 0xFu; }
#define XB_SPIN(cond, bar) do { unsigned _sp = 0; while (cond) { __builtin_amdgcn_s_sleep(1); \
    if ((++_sp & 255u) == 0u) { if (xb_ld(&(bar)[XB_TMO])) break; if (_sp > XB_SPIN_CAP) { atomicAdd(&(bar)[XB_TMO], 1u); break; } } } } while (0)

struct XcdBarrier {
    unsigned* bar; unsigned x;
    volatile LAS unsigned* st;
};

__device__ __forceinline__ XcdBarrier xcd_barrier_post(unsigned* bar, volatile LAS unsigned* st) {
    XcdBarrier b; b.bar = bar; b.x = xb_xcc_id(); b.st = st;
    if (threadIdx.x == 0) (void)xb_add(&bar[XB_XCNT(b.x)], 1u);
    return b;
}
__device__ __forceinline__ void xcd_barrier_complete(unsigned* bar, unsigned x, unsigned& nloc, unsigned& nx) {
    const unsigned G = gridDim.x * gridDim.y * gridDim.z;
    unsigned sum, cnt, mine, sp = 0u;
    for (;;) {
        sum = 0u; cnt = 0u; mine = 0u;
#pragma unroll
        for (unsigned j = 0; j < 16; ++j) { const unsigned c = xb_ld(&bar[XB_XCNT(j)]); sum += c; cnt += (c > 0u) ? 1u : 0u; mine = (j == x) ? c : mine; }
        if (sum == G) break;
        __builtin_amdgcn_s_sleep(1);
        if ((++sp & 255u) == 0u) { if (xb_ld(&bar[XB_TMO])) break; if (sp > XB_SPIN_CAP) { atomicAdd(&bar[XB_TMO], 1u); break; } }
    }
    nloc = mine > 0u ? mine : 1u; nx = cnt > 0u ? cnt : 1u;
}

__device__ __forceinline__ void xcd_barrier(const XcdBarrier& b) {
    asm volatile("s_waitcnt vmcnt(0)" ::: "memory");
    __syncthreads();
    if (threadIdx.x == 0) {
        unsigned* bar = b.bar;
        __builtin_amdgcn_s_waitcnt(0);
        unsigned nloc = b.st[0], nx = b.st[1];
        if (nloc == 0u) { xcd_barrier_complete(bar, b.x, nloc, nx); b.st[0] = nloc; b.st[1] = nx; }
        const unsigned old = xb_add(&bar[XB_XSUB(b.x)], 1u);
        const unsigned gen = old / nloc;
        if (old + 1u == (gen + 1u) * nloc) {
            __builtin_amdgcn_fence(__ATOMIC_RELEASE, "agent");
            asm volatile("s_waitcnt vmcnt(0)" ::: "memory");
            const unsigned og = xb_add(&bar[XB_TOP], 1u);
            const unsigned tg = og / nx;
            if (og + 1u == (tg + 1u) * nx) xb_add(&bar[XB_TOPGEN], 1u);
            else XB_SPIN(xb_ld(&bar[XB_TOPGEN]) == tg, bar);
            __builtin_amdgcn_fence(__ATOMIC_ACQUIRE, "agent");
            xb_add(&bar[XB_XGEN(b.x)], 1u);
            asm volatile("s_waitcnt vmcnt(0)" ::: "memory");
        } else {
            XB_SPIN(xb_ld(&bar[XB_XGEN(b.x)]) == gen, bar);
            __builtin_amdgcn_fence(__ATOMIC_ACQUIRE, "agent");
            asm volatile("s_waitcnt vmcnt(0)" ::: "memory");
        }
    }
    __syncthreads();
}

constexpr int DM = 1024, NB = 2, SEQ = 8192, NT = NB * SEQ;
constexpr int NTHREADS = 512, NWAVES = 8;
constexpr float LN_EPS = 1e-5f;
constexpr float ALPHA = 1.189207115002721f;
typedef unsigned short bf16;
typedef unsigned v4u __attribute__((ext_vector_type(4)));
typedef unsigned v2u __attribute__((ext_vector_type(2)));
typedef float f32x4 __attribute__((ext_vector_type(4)));
typedef short bf16x8_t __attribute__((ext_vector_type(8)));

constexpr size_t MiB = 1u << 20, KiB = 1u << 10;
constexpr size_t WS_CTL = 0, CTL_ZERO_BYTES = 1 * MiB;
constexpr size_t WS_MOD = 1 * MiB + 768 * KiB;
constexpr size_t WS_MMAT = 1 * MiB;
constexpr size_t WS_ROPE = 2 * MiB;
constexpr size_t WS_WIN = 6 * MiB, WS_WOUT = 12 * MiB, WS_WPQ = 14 * MiB, WS_MISC = 16 * MiB, WS_SUBK = 17 * MiB;
constexpr size_t WS_XN = 18 * MiB;
constexpr size_t WS_FZ = 50 * MiB;
constexpr size_t WS_QB = 66 * MiB, WS_KB = 90 * MiB, WS_VB = 114 * MiB, WS_O3 = 138 * MiB, WS_LSE = 162 * MiB;
constexpr size_t WS_H2Q = 50 * MiB, WS_HS = 66 * MiB, WS_WQ = 67 * MiB, WS_WSC = 69 * MiB, WS_SUA = 75 * MiB, WS_X1 = 83 * MiB;
constexpr size_t WS_Y1 = 116 * MiB, WS_PQ = 116 * MiB, WS_PART = 116 * MiB, WS_Y = 116 * MiB;
constexpr size_t WS_IDS = 180 * MiB, WS_GATES = 188 * MiB;
constexpr size_t WS_TU8 = 200 * MiB, WS_TV8 = 216 * MiB, WS_SU = 232 * MiB, WS_SV = 232 * MiB + 512 * KiB, WS_END = 233 * MiB;
constexpr float QSCALE = 0.125f * 1.4426950408889634f;
constexpr int NIN = 2816;
constexpr int CW_BAR = 4096;

constexpr int RING_BYTES = 131072, LDSCTL_OFF = RING_BYTES, MISC_OFF = LDSCTL_OFF + 320, LDS_BYTES = 147456;

struct Params {
    const float* x; const float* c; const int* pos; const float* w_ada; const float* b_ada; const float* w_in; const float* b_in;
    const float* w_four; const float* w_out; const float* b_out; const float* g1; const float* be1; const float* w_pq; const float* subk;
    const float* pu; const float* pv; const float* g2; const float* be2; float* out; unsigned char* ws;
};

__device__ __forceinline__ unsigned f2bf(float f) { unsigned u = __builtin_bit_cast(unsigned, f); return (u + 0x7fffu + ((u >> 16) & 1u)) >> 16; }
__device__ __forceinline__ unsigned pk2(float lo, float hi) { return f2bf(lo) | (f2bf(hi) << 16); }
__device__ __forceinline__ float wave_sum(float v) {
#pragma unroll
    for (int o = 32; o > 0; o >>= 1) v += __shfl_xor(v, o);
    return v;
}
__device__ __forceinline__ float wave_max(float v) {
#pragma unroll
    for (int o = 32; o > 0; o >>= 1) v = fmaxf(v, __shfl_xor(v, o));
    return v;
}
#define LDS_WAIT() asm volatile("s_waitcnt lgkmcnt(0)" ::: "memory")
__device__ __forceinline__ int opaque_tid() { int t = threadIdx.x; asm volatile("" : "+v"(t)); return t; }
__device__ __forceinline__ int wave_id() { return __builtin_amdgcn_readfirstlane(opaque_tid() >> 6); }
__device__ __forceinline__ float bflo(unsigned u) { return __builtin_bit_cast(float, u << 16); }
__device__ __forceinline__ float bfhi(unsigned u) { return __builtin_bit_cast(float, u & 0xffff0000u); }

template <class SC>
__device__ __forceinline__ void transpose_item(const float* W, int K, int N, bf16* WT, int nout, SC srccol, LAS float* scr, int item, int lane) {
    const int nblk = nout / 32, kb = item / nblk, nb = item % nblk, k0 = 64 * kb, n0 = 32 * nb;
    const int sc = srccol(n0 + (lane & 31));
#pragma unroll 8
    for (int i = 0; i < 32; ++i) { const int kk = 2 * i + (lane >> 5); scr[kk * 33 + (lane & 31)] = W[(size_t)(k0 + kk) * N + sc]; }
    LDS_WAIT(); asm volatile("" ::: "memory");
    const int c = lane & 7;
#pragma unroll
    for (int j = 0; j < 4; ++j) { const int n = (lane >> 3) + 8 * j; const LAS float* s = scr + (8 * c) * 33 + n;
        v4u o; o.x = pk2(s[0 * 33], s[1 * 33]); o.y = pk2(s[2 * 33], s[3 * 33]); o.z = pk2(s[4 * 33], s[5 * 33]); o.w = pk2(s[6 * 33], s[7 * 33]);
        *(v4u*)(WT + (size_t)(n0 + n) * K + k0 + 8 * c) = o; }
    LDS_WAIT(); asm volatile("" ::: "memory");
}
__device__ __forceinline__ void ph_prologue(const Params& p, LAS unsigned char* lds, int bid, int nblk) {
    const int tid = opaque_tid(), lane = tid & 63, wave = __builtin_amdgcn_readfirstlane(tid >> 6);
    {
        LAS float* M = (LAS float*)lds; LAS float* Wl = (LAS float*)(lds + 32768);
        bf16* WT = (bf16*)(p.ws + WS_WIN); float* biasf = (float*)(p.ws + WS_MISC); const float* MM = (const float*)(p.ws + WS_MMAT);
        const bool fallback = !(nblk > 192);
        for (int it = bid; it < 256; it += nblk) {
            const int g = it & 3, kb = it >> 2, k0 = kb * 16;
            __syncthreads();
            if (fallback) { const float norm = 1.0f / sqrtf(8192.0f * 64.0f);
                for (int e = tid; e < 8192; e += NTHREADS) { const int c = e >> 7, nl = e & 127; float a = 0.f;
                    for (int cp = 0; cp < 64; ++cp) { const float ang = 2.0f * (float)((c * cp) & 63) / 64.0f; a += ((nl & 1) ? -sinpif(ang) : cospif(ang)) * p.w_four[(g * 64 + cp) * 64 + (nl >> 1)]; }
                    M[e] = a * norm; } }
            else {
#pragma unroll
                for (int i = 0; i < 4; ++i) *(LAS f32x4*)(lds + (tid + i * 512) * 16) = *(const f32x4*)(MM + (size_t)g * 8192 + (tid + i * 512) * 4); }
#pragma unroll
            for (int i = 0; i < 2; ++i) { const int e = tid + i * 512, k = e >> 6, c = e & 63; Wl[k * 64 + c] = p.w_in[(size_t)(k0 + k) * 2560 + g * 64 + c]; }
            __syncthreads();
            { const int nl = tid & 127, kq = tid >> 7; float a[4] = {0.f, 0.f, 0.f, 0.f};
              for (int c = 0; c < 64; ++c) { const float mv = M[c * 128 + nl];
#pragma unroll
                  for (int j = 0; j < 4; ++j) a[j] += mv * Wl[(kq * 4 + j) * 64 + c]; }
              *(v2u*)(WT + (size_t)(g * 128 + nl) * DM + k0 + kq * 4) = (v2u){pk2(a[0], a[1]), pk2(a[2], a[3])};
              if (kb == 0 && tid < 128) { float bsum = 0.f; for (int c = 0; c < 64; ++c) bsum += p.b_in[g * 64 + c] * M[c * 128 + nl]; biasf[g * 128 + nl] = bsum; } }
        }
        __syncthreads();
        for (int i = bid * NTHREADS + tid; i < 2304; i += nblk * NTHREADS) biasf[512 + i] = p.b_in[256 + i];
    }
    {
        LAS float* scr = (LAS float*)(lds + wave * 16384);
        const int gw = bid * NWAVES + wave, NGW = nblk * NWAVES;
        constexpr int I_IN = 16 * (2304 / 32), I_O = 16 * 32, I_PQ = 16 * 32;
        for (int it = gw; it < I_IN + I_O + I_PQ; it += NGW) {
            int r = it;
            if (r < I_IN) {
                transpose_item(p.w_in, DM, 2560, (bf16*)(p.ws + WS_WIN) + (size_t)512 * DM, 2304,
                    [](int n) { return n < 1536 ? 256 + (n & ~63) + ((n & 63) >> 1) + 32 * (n & 1) : 256 + n; }, scr, r, lane); continue; } r -= I_IN;
            if (r < I_O) { transpose_item(p.w_out, DM, DM, (bf16*)(p.ws + WS_WOUT), DM, [](int n) { return n; }, scr, r, lane); continue; } r -= I_O;
            transpose_item(p.w_pq, DM, DM, (bf16*)(p.ws + WS_WPQ), DM, [](int n) { return n; }, scr, r, lane);
        }
    }
    { float2* rope = (float2*)(p.ws + WS_ROPE);
      for (int idx = bid * NTHREADS + tid; idx < NT * 32; idx += nblk * NTHREADS) { const int t = idx >> 5, i = idx & 31;
          const float inv = powf(10000.0f, -(float)i / 32.0f); float sn, cs; sincosf((float)p.pos[t] * inv, &sn, &cs); rope[idx] = make_float2(cs, sn); } }
    { bf16* SK = (bf16*)(p.ws + WS_SUBK);
      for (int ch = bid * NTHREADS + tid; ch < 8 * 2 * 4 * 4 * 64; ch += nblk * NTHREADS) {
          const int ln = ch & 63, d0 = (ch >> 6) & 3, mt = (ch >> 8) & 3, hp = ch >> 10;
          const float* sp = p.subk + ((size_t)hp * 128 + 32 * mt + (ln & 31)) * 64 + 16 * d0 + 8 * (ln >> 5);
          v4u o; o.x = pk2(sp[0], sp[1]); o.y = pk2(sp[2], sp[3]); o.z = pk2(sp[4], sp[5]); o.w = pk2(sp[6], sp[7]);
          *(v4u*)(SK + (size_t)ch * 8) = o; } }
}
__device__ __forceinline__ void ph_mod(const Params& p, LAS unsigned char* lds, int bid, int nblk) {
    const int tid = opaque_tid(), col = tid & 31, kg = tid >> 5;
    LAS float* cond = (LAS float*)lds; LAS float* red = (LAS float*)(lds + 8192);
    float* mod = (float*)(p.ws + WS_MOD);
    for (int i = tid; i < 2 * DM; i += NTHREADS) { const float c = p.c[i]; cond[i] = c / (1.0f + expf(-c)); }
    __syncthreads();
    if (nblk > 192 && bid >= 192) {
        LAS float* T64 = (LAS float*)(lds + 12288);
        if (tid < 64) { T64[tid] = cospif(2.0f * (float)tid / 64.0f); T64[64 + tid] = -sinpif(2.0f * (float)tid / 64.0f); }
        __syncthreads();
        const float norm = 1.0f / sqrtf(8192.0f * 64.0f); float* MM = (float*)(p.ws + WS_MMAT);
        for (int it = bid - 192; it < 64; it += nblk - 192) {
            const int g = it >> 4, c = (it & 15) * 4 + (tid >> 7), nl = tid & 127; float a = 0.f;
#pragma unroll 8
            for (int cp = 0; cp < 64; ++cp) a += T64[(nl & 1) * 64 + ((c * cp) & 63)] * p.w_four[(g * 64 + cp) * 64 + (nl >> 1)];
            MM[(g * 64 + c) * 128 + nl] = a * norm;
        }
    }
    for (int it = bid; it < 6144 / 32; it += nblk) {
        const int n = it * 32 + col; float a0 = 0.f, a1 = 0.f;
        const float* wp = p.w_ada + (size_t)(kg * 64) * 6144 + n;
#pragma unroll 16
        for (int k = 0; k < 64; ++k) { const float w = wp[(size_t)k * 6144]; a0 += cond[kg * 64 + k] * w; a1 += cond[DM + kg * 64 + k] * w; }
        red[(kg * 2 + 0) * 32 + col] = a0; red[(kg * 2 + 1) * 32 + col] = a1;
        __syncthreads();
        if (tid < 64) { const int b = tid >> 5; float s = p.b_ada[n];
#pragma unroll
            for (int g = 0; g < 16; ++g) s += red[(g * 2 + b) * 32 + col];
            mod[b * 6144 + n] = s; }
        __syncthreads();
    }
}
__device__ __forceinline__ void ph_xn(const Params& p, int bid, int nblk) {
    const int lane = opaque_tid() & 63, wave = wave_id(); const float* mod = (const float*)(p.ws + WS_MOD); bf16* XN = (bf16*)(p.ws + WS_XN);
    for (int row = bid * NWAVES + wave; row < NT; row += nblk * NWAVES) {
        const int b = row / SEQ;
        const f32x4* xr = (const f32x4*)(p.x + (size_t)row * DM) + lane;
        f32x4 v[4]; float s = 0.f;
#pragma unroll
        for (int j = 0; j < 4; ++j) { v[j] = xr[64 * j]; s += (v[j].x + v[j].y) + (v[j].z + v[j].w); }
        const float mean = wave_sum(s) * (1.f / DM); float s2 = 0.f;
#pragma unroll
        for (int j = 0; j < 4; ++j) { v[j] = v[j] - mean; s2 += (v[j].x * v[j].x + v[j].y * v[j].y) + (v[j].z * v[j].z + v[j].w * v[j].w); }
        const float rstd = rsqrtf(wave_sum(s2) * (1.f / DM) + LN_EPS);
        unsigned long long* o8 = (unsigned long long*)(XN + (size_t)row * DM) + lane;
#pragma unroll
        for (int j = 0; j < 4; ++j) {
            const f32x4 sh = *((const f32x4*)(mod + b * 6144 + 0) + lane + 64 * j), sc = *((const f32x4*)(mod + b * 6144 + 1024) + lane + 64 * j);
            const f32x4 o = v[j] * rstd * (1.0f + sc) + sh;
            o8[64 * j] = (unsigned long long)pk2(o.x, o.y) | ((unsigned long long)pk2(o.z, o.w) << 32);
        }
    }
}

struct EpiOut {
    static constexpr bool PERM = true, AFTER_DRAIN = false;
    bf16* Y1; const float* x; const float* mod; const float* bo;
    __device__ __forceinline__ void operator()(const pg8::f32x4 (&acc)[2][2][4][2], const pg8::Unit& u, int wr, int wc, int fr, int fq) const {
        const int row0 = u.pm * 256 + wr * 64 + fr;
#pragma unroll
        for (int bj = 0; bj < 2; ++bj) {
            const int c0 = u.pn * 256 + bj * 128 + wc * 32 + 8 * fq;
            const pg8::f32x4 b0 = *(const pg8::f32x4*)(bo + c0), b1 = *(const pg8::f32x4*)(bo + c0 + 4);
#pragma unroll
            for (int ai = 0; ai < 2; ++ai) {
                const int bb = (u.pm * 256 + ai * 128) >> 13;
                const pg8::f32x4 g0 = *(const pg8::f32x4*)(mod + bb * 6144 + 2048 + c0) + 1.0f, g1 = *(const pg8::f32x4*)(mod + bb * 6144 + 2048 + c0 + 4) + 1.0f;
#pragma unroll
                for (int m = 0; m < 4; ++m) {
                    const int row = row0 + ai * 128 + m * 16;
                    const pg8::f32x4 x0 = *(const pg8::f32x4*)(x + (size_t)row * DM + c0), x1 = *(const pg8::f32x4*)(x + (size_t)row * DM + c0 + 4);
                    const pg8::f32x4 v0 = x0 * ALPHA + g0 * (acc[ai][bj][m][0] + b0), v1 = x1 * ALPHA + g1 * (acc[ai][bj][m][1] + b1);
                    v4u o; o.x = pk2(v0.x, v0.y); o.y = pk2(v0.z, v0.w); o.z = pk2(v1.x, v1.y); o.w = pk2(v1.z, v1.w);
                    *(v4u*)(Y1 + (size_t)row * DM + c0) = o;
                }
            }
        }
    }
};
__device__ __forceinline__ void ph_fft(const Params& p, LAS unsigned char* lds, int bid, int nblk) {
    const int tid = opaque_tid(), lane = tid & 63, wave = __builtin_amdgcn_readfirstlane(tid >> 6), lr = lane & 15, lq = lane >> 4;
    bf16* MIX = (bf16*)(p.ws + WS_XN);
    for (int item = bid; item < 256; item += nblk) {
        const int b = item >> 7, cg = item & 127;
        const unsigned long long* src = (const unsigned long long*)(p.ws + WS_FZ) + (size_t)(b * 128 + cg) * 8192;
#pragma unroll 4
        for (int i = 0; i < 16; ++i) {
            const int q = i * 512 + tid; const int n2 = (q & 7) | (((q >> 6) & 15) << 3), n1 = ((q >> 3) & 7) | (((q >> 10) & 7) << 3);
            const unsigned long long v = src[128 * n1 + n2];
            *(LAS unsigned*)(lds + (2 * n2) * 288 + 4 * n1) = (unsigned)v; *(LAS unsigned*)(lds + (2 * n2 + 1) * 288 + 4 * n1) = (unsigned)(v >> 32);
        }
        bf16x8_t af[4];
        { const int m = 16 * wave + lr, k1 = m >> 1, ri = m & 1;
#pragma unroll
          for (int ks = 0; ks < 4; ++ks)
#pragma unroll
              for (int jj = 0; jj < 4; ++jj) { const int n1 = 16 * ks + 4 * lq + jj; const float x = (float)((n1 * k1) & 63) * (1.0f / 64.0f);
                  const float c = __builtin_amdgcn_cosf(x), s = __builtin_amdgcn_sinf(x);
                  af[ks][2 * jj] = (short)f2bf(ri ? -s : c); af[ks][2 * jj + 1] = (short)f2bf(ri ? c : s); } }
        __syncthreads();
        pg8::f32x4 acc[16];
#pragma unroll
        for (int nt = 0; nt < 16; ++nt) { acc[nt] = (pg8::f32x4){0.f, 0.f, 0.f, 0.f};
#pragma unroll
            for (int ks = 0; ks < 4; ++ks) { const bf16x8_t bf = *(const LAS bf16x8_t*)(lds + (16 * nt + lr) * 288 + (32 * ks + 8 * lq) * 2);
                acc[nt] = __builtin_amdgcn_mfma_f32_16x16x32_bf16(af[ks], bf, acc[nt], 0, 0, 0); } }
        __syncthreads();
#pragma unroll
        for (int nt = 0; nt < 16; ++nt) { const int col = 16 * nt + lr, n2 = col >> 1, ch = col & 1;
#pragma unroll
            for (int h = 0; h < 2; ++h) { const int k1 = 8 * wave + 2 * lq + h; const float yr = acc[nt][2 * h], yi = acc[nt][2 * h + 1];
                const float x = (float)((n2 * k1) & 8191) * (1.0f / 8192.0f); const float c = __builtin_amdgcn_cosf(x), s = __builtin_amdgcn_sinf(x);
                *(LAS unsigned*)(lds + (2 * k1 + ch) * 544 + 4 * n2) = pk2(yr * c + yi * s, yi * c - yr * s); } }
        bf16x8_t a2[8];
        { const int k2 = 16 * wave + lr;
#pragma unroll
          for (int ks = 0; ks < 8; ++ks)
#pragma unroll
              for (int jj = 0; jj < 4; ++jj) { const int n2 = 16 * ks + 4 * lq + jj; const float x = (float)((n2 * k2) & 127) * (1.0f / 128.0f);
                  a2[ks][2 * jj] = (short)f2bf(__builtin_amdgcn_cosf(x)); a2[ks][2 * jj + 1] = (short)f2bf(__builtin_amdgcn_sinf(x)); } }
        __syncthreads();
        pg8::f32x4 o[8];
#pragma unroll
        for (int nt = 0; nt < 8; ++nt) { o[nt] = (pg8::f32x4){0.f, 0.f, 0.f, 0.f};
#pragma unroll
            for (int ks = 0; ks < 8; ++ks) { const bf16x8_t bf = *(const LAS bf16x8_t*)(lds + (16 * nt + lr) * 544 + (32 * ks + 8 * lq) * 2);
                o[nt] = __builtin_amdgcn_mfma_f32_16x16x32_bf16(a2[ks], bf, o[nt], 0, 0, 0); } }
#pragma unroll
        for (int nt = 0; nt < 8; ++nt) { const int col2 = 16 * nt + lr, k1 = col2 >> 1, ch = col2 & 1;
#pragma unroll
            for (int r = 0; r < 4; ++r) { const float v = o[nt][r]; const float w = __shfl_xor(v, 1); const int k2 = 16 * wave + 4 * lq + r;
                if (ch == 0) *(unsigned*)(MIX + ((size_t)b * SEQ + k1 + 64 * k2) * DM + 2 * cg) = pk2(v, w); } }
        __syncthreads();
    }
}


struct EpiIn {
    static constexpr bool PERM = true, AFTER_DRAIN = false;
    bf16* FZ; bf16* QKV; const float* bias; const float* rope;
    __device__ __forceinline__ void operator()(const pg8::f32x4 (&acc)[2][2][4][2], const pg8::Unit& u, int wr, int wc, int fr, int fq) const {
        const int row0 = u.pm * 256 + wr * 64 + fr;
#pragma unroll
        for (int bj = 0; bj < 2; ++bj) {
            const int c0 = u.pn * 256 + bj * 128 + wc * 32 + 8 * fq;
            const pg8::f32x4 b0 = *(const pg8::f32x4*)(bias + c0), b1 = *(const pg8::f32x4*)(bias + c0 + 4);
#pragma unroll
            for (int ai = 0; ai < 2; ++ai)
#pragma unroll
                for (int m = 0; m < 4; ++m) {
                    const int row = row0 + ai * 128 + m * 16;
                    pg8::f32x4 v0 = acc[ai][bj][m][0] + b0, v1 = acc[ai][bj][m][1] + b1;
                    if (u.pn < 2) {
                        const int b = row >> 13, s = row & 8191, cgp = c0 >> 2;
                        unsigned long long* d0 = (unsigned long long*)(FZ + (((size_t)(b * 128 + cgp) * 8192 + s) << 2));
                        d0[0] = (unsigned long long)pk2(v0.x, v0.y) | ((unsigned long long)pk2(v0.z, v0.w) << 32);
                        d0[8192] = (unsigned long long)pk2(v1.x, v1.y) | ((unsigned long long)pk2(v1.z, v1.w) << 32);
                    } else {
                        const int cq = c0 - 512, which = cq / 768, off = cq - which * 768;
                        if (which < 2) {
                            const float sc = which == 0 ? QSCALE : 1.0f;
                            const pg8::f32x4 r0 = *(const pg8::f32x4*)(rope + (size_t)row * 64 + (off & 63)), r1 = *(const pg8::f32x4*)(rope + (size_t)row * 64 + (off & 63) + 4);
                            pg8::f32x4 w0, w1;
                            w0.x = (v0.x * r0.x - v0.y * r0.y) * sc; w0.y = (v0.y * r0.x + v0.x * r0.y) * sc; w0.z = (v0.z * r0.z - v0.w * r0.w) * sc; w0.w = (v0.w * r0.z + v0.z * r0.w) * sc;
                            w1.x = (v1.x * r1.x - v1.y * r1.y) * sc; w1.y = (v1.y * r1.x + v1.x * r1.y) * sc; w1.z = (v1.z * r1.z - v1.w * r1.w) * sc; w1.w = (v1.w * r1.z + v1.z * r1.w) * sc;
                            v0 = w0; v1 = w1;
                        }
                        v4u o; o.x = pk2(v0.x, v0.y); o.y = pk2(v0.z, v0.w); o.z = pk2(v1.x, v1.y); o.w = pk2(v1.z, v1.w);
                        *(v4u*)(QKV + (size_t)which * ((WS_KB - WS_QB) / 2) + (size_t)row * 768 + off) = o;
                    }
                }
        }
    }
};

typedef float f32x16 __attribute__((ext_vector_type(16)));
typedef short s16x4 __attribute__((ext_vector_type(4)));
__device__ __forceinline__ int crow(int r, int hi) { return (r & 3) + 8 * (r >> 2) + 4 * hi; }
__device__ __forceinline__ s16x4 vtr(const LAS unsigned char* p) { return __builtin_bit_cast(s16x4, __builtin_amdgcn_ds_read_tr16_b64_v4i16((LAS s16x4*)p)); }
__device__ __forceinline__ unsigned cvtpk(float lo, float hi) { typedef float f2 __attribute__((ext_vector_type(2))); typedef __bf16 b2 __attribute__((ext_vector_type(2))); f2 v = {lo, hi}; b2 r = __builtin_convertvector(v, b2); return __builtin_bit_cast(unsigned, r); }
__device__ __forceinline__ void tbl_load(const Params& p, int r, f32x4 (&a)[4], int lane) {
    const bool isv = r >= 16384; const int row = isv ? r - 16384 : r;
    const f32x4* src = (const f32x4*)((isv ? p.pv : p.pu) + (size_t)row * DM + 16 * lane);
#pragma unroll
    for (int j = 0; j < 4; ++j) a[j] = src[j];
}
__device__ __forceinline__ void tbl_finish(const Params& p, int r, const f32x4 (&a)[4], int lane) {
    const bool isv = r >= 16384; const int row = isv ? r - 16384 : r;
    float amax = 0.f;
#pragma unroll
    for (int j = 0; j < 4; ++j) amax = fmaxf(amax, fmaxf(fmaxf(fabsf(a[j].x), fabsf(a[j].y)), fmaxf(fabsf(a[j].z), fabsf(a[j].w))));
    if (isv) {
        amax = wave_max(amax);
        const float inv = amax > 0.f ? 127.0f / amax : 0.f;
        v4u o;
#pragma unroll
        for (int j = 0; j < 4; ++j) { unsigned q = 0u;
            q = __builtin_amdgcn_cvt_pk_u8_f32(a[j].x * inv + 128.0f, 0, q); q = __builtin_amdgcn_cvt_pk_u8_f32(a[j].y * inv + 128.0f, 1, q);
            q = __builtin_amdgcn_cvt_pk_u8_f32(a[j].z * inv + 128.0f, 2, q); q = __builtin_amdgcn_cvt_pk_u8_f32(a[j].w * inv + 128.0f, 3, q);
            o[j] = q ^ 0x80808080u; }
        *(v4u*)(p.ws + WS_TV8 + (size_t)(lane >> 3) * (2 * MiB) + (size_t)row * 128 + 16 * (lane & 7)) = o;
        if (lane == 0) ((float*)(p.ws + WS_SV))[row] = amax * (1.0f / 127.0f);
    } else {
        amax = fmaxf(amax, __shfl_xor(amax, 1)); amax = fmaxf(amax, __shfl_xor(amax, 2)); amax = fmaxf(amax, __shfl_xor(amax, 4)); amax = fmaxf(amax, __shfl_xor(amax, 8));
        const float inv = amax > 0.f ? 7.0f / amax : 0.f;
        unsigned d[2];
#pragma unroll
        for (int w = 0; w < 2; ++w) { unsigned lo = 0u, hi = 0u;
            lo = __builtin_amdgcn_cvt_pk_u8_f32(a[2 * w].x * inv + 8.0f, 0, lo); lo = __builtin_amdgcn_cvt_pk_u8_f32(a[2 * w].y * inv + 8.0f, 1, lo);
            lo = __builtin_amdgcn_cvt_pk_u8_f32(a[2 * w].z * inv + 8.0f, 2, lo); lo = __builtin_amdgcn_cvt_pk_u8_f32(a[2 * w].w * inv + 8.0f, 3, lo);
            hi = __builtin_amdgcn_cvt_pk_u8_f32(a[2 * w + 1].x * inv + 8.0f, 0, hi); hi = __builtin_amdgcn_cvt_pk_u8_f32(a[2 * w + 1].y * inv + 8.0f, 1, hi);
            hi = __builtin_amdgcn_cvt_pk_u8_f32(a[2 * w + 1].z * inv + 8.0f, 2, hi); hi = __builtin_amdgcn_cvt_pk_u8_f32(a[2 * w + 1].w * inv + 8.0f, 3, hi);
            d[w] = lo | (hi << 4); }
        *(v2u*)(p.ws + WS_TU8 + (size_t)(lane >> 4) * (2 * MiB) + (size_t)row * 128 + 8 * (lane & 15)) = (v2u){d[0], d[1]};
        if ((lane & 15) == 0) ((float*)(p.ws + WS_SU))[(size_t)(lane >> 4) * 16384 + row] = amax * (1.0f / 7.0f);
    }
}
struct AttnDesc { int dil, ntile, res, cb, r; size_t rowb; int h; bool valid; };
__device__ __forceinline__ AttnDesc attn_desc(int bi) {
    AttnDesc d; d.valid = bi < 3 * 768; const int b2 = d.valid ? bi : 0;
    const int r = b2 / 768, rem = b2 - r * 768, bh = rem >> 5, q32 = rem & 31, b = bh / 12;
    d.r = r; d.h = bh - b * 12; d.rowb = (size_t)b * SEQ;
    const int ld = 2 * r;
    d.dil = 1 << ld; d.ntile = 256 >> ld; d.res = q32 >> (5 - ld); d.cb = q32 & ((32 >> ld) - 1);
    return d;
}
__device__ __forceinline__ void attn_dma(const AttnDesc& d, const bf16* T, bool swz, LAS unsigned char* img, int wave, int lane) {
#pragma unroll
    for (int i = 0; i < 6; ++i) {
        const int idx = wave * 6 + i, j = idx >> 2, it = idx & 3, kt = 8 * d.cb - 2 + j;
        if (kt >= 0 && kt < d.ntile) {
            const int row = it * 8 + (lane >> 3), ch = lane & 7; const int gch = swz ? (ch ^ ((row >> 1) & 7)) : ch;
            const bf16* src = T + (d.rowb + d.res + d.dil * (32 * kt + row)) * 768 + d.h * 64 + 8 * gch;
            __builtin_amdgcn_global_load_lds((const unsigned*)src, (LAS unsigned*)(img + j * 4096 + it * 1024), 16, 0, 0);
        }
    }
}
__device__ __forceinline__ void attn_qload(const AttnDesc& d, const bf16* QB, bf16x8_t (&qf)[4], int wave, int lane) {
    const bf16* qp = QB + (d.rowb + d.res + d.dil * (32 * (8 * d.cb + wave) + (lane & 31))) * 768 + d.h * 64 + 8 * (lane >> 5);
#pragma unroll
    for (int d0 = 0; d0 < 4; ++d0) qf[d0] = *(const bf16x8_t*)(qp + 16 * d0);
}
#define ATT_SYNC() do { asm volatile("s_waitcnt vmcnt(0) lgkmcnt(0)" ::: "memory"); __builtin_amdgcn_s_barrier(); asm volatile("" ::: "memory"); } while (0)
__device__ __forceinline__ void ph_attn_fast(const Params& p, LAS unsigned char* lds, int bid, int nblk) {
    const int lane = opaque_tid() & 63, wave = wave_id(), r32 = lane & 31, hi = lane >> 5;
    LAS unsigned char* imgK = lds; LAS unsigned char* imgV = lds + 49152; LAS unsigned char* stgb = lds + 98304 + wave * 4096;
    const bf16* QB = (const bf16*)(p.ws + WS_QB); const bf16* KB = (const bf16*)(p.ws + WS_KB); const bf16* VB = (const bf16*)(p.ws + WS_VB);
    const int vb = (nblk & 7) == 0 ? (bid & 7) * (nblk >> 3) + (bid >> 3) : bid;
    int bi = vb;
    AttnDesc d = attn_desc(bi);
    bf16x8_t qf[4];
    if (d.valid) { attn_dma(d, KB, true, imgK, wave, lane); attn_qload(d, QB, qf, wave, lane); }
    ATT_SYNC();
    const int g = lane >> 4, ii = lane & 15;
    const int vb0 = (4 * hi + (ii >> 2)) * 128 + (g & 1) * 32 + (ii & 3) * 8;
    int trow = bid * NWAVES + wave; const int tstride = nblk * NWAVES;
    f32x4 ta[4];
    while (d.valid) {
        asm volatile("" : "+v"(qf[0]), "+v"(qf[1]), "+v"(qf[2]), "+v"(qf[3]));
        attn_dma(d, VB, false, imgV, wave, lane);
        const bool tb1 = trow < 32768; if (tb1) tbl_load(p, trow, ta, lane);
        const int c = 8 * d.cb + wave;
        f32x16 S[5];
#pragma unroll
        for (int u = 0; u < 5; ++u) {
            const int kt = c - 2 + u;
#pragma unroll
            for (int r = 0; r < 16; ++r) S[u][r] = -1e30f;
            if (kt >= 0 && kt < d.ntile) {
                const LAS unsigned char* slot = imgK + (wave + u) * 4096;
                f32x16 a = {0.f, 0.f, 0.f, 0.f, 0.f, 0.f, 0.f, 0.f, 0.f, 0.f, 0.f, 0.f, 0.f, 0.f, 0.f, 0.f};
#pragma unroll
                for (int d0 = 0; d0 < 4; ++d0) { const bf16x8_t kf = *(const LAS bf16x8_t*)(slot + r32 * 128 + (((2 * d0 + hi) ^ ((r32 >> 1) & 7)) << 4));
                    a = __builtin_amdgcn_mfma_f32_32x32x16_bf16(kf, qf[d0], a, 0, 0, 0); }
                S[u] = a;
            }
        }
#pragma unroll
        for (int r = 0; r < 16; ++r) { const int kk = crow(r, hi); if (kk < r32) S[0][r] = -1e30f; if (kk > r32) S[4][r] = -1e30f; }
        float m = -1e30f;
#pragma unroll
        for (int u = 0; u < 5; ++u)
#pragma unroll
            for (int r = 0; r < 16; ++r) m = fmaxf(m, S[u][r]);
        m = fmaxf(m, __shfl_xor(m, 32));
        float l = 0.f;
        unsigned Pk[5][8];
#pragma unroll
        for (int u = 0; u < 5; ++u)
#pragma unroll
            for (int r = 0; r < 16; r += 2) { const float e0 = __builtin_amdgcn_exp2f(S[u][r] - m), e1 = __builtin_amdgcn_exp2f(S[u][r + 1] - m); l += e0 + e1; Pk[u][r >> 1] = cvtpk(e0, e1); }
        l += __shfl_xor(l, 32);
        if (tb1) { tbl_finish(p, trow, ta, lane); trow += tstride; }
        ATT_SYNC();
        const AttnDesc dn = attn_desc(bi + nblk);
        if (dn.valid) { attn_dma(dn, KB, true, imgK, wave, lane); attn_qload(dn, QB, qf, wave, lane); }
        const bool tb2 = trow < 32768; if (tb2) tbl_load(p, trow, ta, lane);
        f32x16 o[2];
#pragma unroll
        for (int db = 0; db < 2; ++db)
#pragma unroll
            for (int r = 0; r < 16; ++r) o[db][r] = 0.f;
#pragma unroll
        for (int u = 0; u < 5; ++u) {
            const int kt = c - 2 + u;
            if (kt >= 0 && kt < d.ntile) {
                const LAS unsigned char* slot = imgV + (wave + u) * 4096;
#pragma unroll
                for (int s = 0; s < 2; ++s) {
                    bf16x8_t pa;
                    { v4u w; w.x = Pk[u][4 * s + 0]; w.y = Pk[u][4 * s + 1]; w.z = Pk[u][4 * s + 2]; w.w = Pk[u][4 * s + 3]; pa = __builtin_bit_cast(bf16x8_t, w); }
#pragma unroll
                    for (int db = 0; db < 2; ++db) {
                        const s16x4 lo = vtr(slot + vb0 + s * 2048 + db * 64), hh = vtr(slot + vb0 + s * 2048 + 1024 + db * 64);
                        const bf16x8_t vf = {lo[0], lo[1], lo[2], lo[3], hh[0], hh[1], hh[2], hh[3]};
                        o[db] = __builtin_amdgcn_mfma_f32_32x32x16_bf16(pa, vf, o[db], 0, 0, 0);
                    }
                }
            }
        }
        bf16* OB = d.r == 2 ? (bf16*)(p.ws + WS_O3) : (bf16*)p.out + (size_t)d.r * NT * 768;
        float* LSE = (float*)(p.ws + WS_LSE) + (size_t)d.r * NT * 12;
        const float linv = 1.0f / l;
        LAS unsigned short* stg = (LAS unsigned short*)stgb;
#pragma unroll
        for (int r = 0; r < 16; ++r) { const int q = crow(r, hi); const float li = __shfl(linv, q);
#pragma unroll
            for (int db = 0; db < 2; ++db) stg[q * 64 + db * 32 + r32] = (unsigned short)f2bf(o[db][r] * li); }
        int ln2 = lane; asm volatile("" : "+v"(ln2));
#pragma unroll
        for (int i4 = 0; i4 < 4; ++i4) { const int row = i4 * 8 + (ln2 >> 3), ch = ln2 & 7;
            const v4u val = *(const LAS v4u*)((LAS unsigned char*)stg + row * 128 + ch * 16);
            *(v4u*)(OB + (d.rowb + d.res + d.dil * (32 * c + row)) * 768 + d.h * 64 + 8 * ch) = val; }
        if (ln2 < 32) LSE[(d.rowb + d.res + d.dil * (32 * c + ln2)) * 12 + d.h] = m + __builtin_amdgcn_logf(l);
        if (tb2) { tbl_finish(p, trow, ta, lane); trow += tstride; }
        ATT_SYNC();
        d = dn; bi += nblk;
    }
    for (; trow < 32768; trow += tstride) { tbl_load(p, trow, ta, lane); tbl_finish(p, trow, ta, lane); }
}
__device__ __forceinline__ void ph_merge(const Params& p, int bid, int nblk) {
    const bf16* O1 = (const bf16*)p.out; const bf16* O2 = O1 + (size_t)NT * 768; const bf16* O3 = (const bf16*)(p.ws + WS_O3);
    const float* L1 = (const float*)(p.ws + WS_LSE); const float* L2 = L1 + (size_t)NT * 12; const float* L3 = L2 + (size_t)NT * 12; bf16* MIX = (bf16*)(p.ws + WS_XN);
    for (int idx = bid * NTHREADS + opaque_tid(); idx < NT * 96; idx += nblk * NTHREADS) {
        const int t = idx / 96, rem = idx - t * 96, h = rem >> 3, ch = rem & 7;
        const float l1 = L1[t * 12 + h], l2 = L2[t * 12 + h], l3 = L3[t * 12 + h]; const float mx = fmaxf(fmaxf(l1, l2), l3);
        float w1 = __builtin_amdgcn_exp2f(l1 - mx), w2 = __builtin_amdgcn_exp2f(l2 - mx), w3 = __builtin_amdgcn_exp2f(l3 - mx); const float inv = 1.0f / (w1 + w2 + w3); w1 *= inv; w2 *= inv; w3 *= inv;
        const size_t off = (size_t)t * 768 + h * 64 + 8 * ch;
        const v4u a = *(const v4u*)(O1 + off), bq = *(const v4u*)(O2 + off), cq = *(const v4u*)(O3 + off);
        v4u o;
        o.x = pk2(w1 * bflo(a.x) + w2 * bflo(bq.x) + w3 * bflo(cq.x), w1 * bfhi(a.x) + w2 * bfhi(bq.x) + w3 * bfhi(cq.x));
        o.y = pk2(w1 * bflo(a.y) + w2 * bflo(bq.y) + w3 * bflo(cq.y), w1 * bfhi(a.y) + w2 * bfhi(bq.y) + w3 * bfhi(cq.y));
        o.z = pk2(w1 * bflo(a.z) + w2 * bflo(bq.z) + w3 * bflo(cq.z), w1 * bfhi(a.z) + w2 * bfhi(bq.z) + w3 * bfhi(cq.z));
        o.w = pk2(w1 * bflo(a.w) + w2 * bflo(bq.w) + w3 * bflo(cq.w), w1 * bfhi(a.w) + w2 * bfhi(bq.w) + w3 * bfhi(cq.w));
        *(v4u*)(MIX + (size_t)t * DM + 256 + h * 64 + 8 * ch) = o;
    }
}


__host__ __device__ constexpr int stair2_slot(int i, int j) { int n = 0; for (int a = 1; a < 16; ++a) for (int b = 1; b < 16; ++b) if ((a + 1) * (b + 1) <= 16) { if (a == i && b == j) return n; ++n; } return n; }
__device__ __forceinline__ float kmax(float a, float b) { float r; asm("v_max_f32_e32 %0, %1, %2" : "=v"(r) : "v"(a), "v"(b)); return r; }
__device__ __forceinline__ float kmin(float a, float b) { float r; asm("v_min_f32_e32 %0, %1, %2" : "=v"(r) : "v"(a), "v"(b)); return r; }
__device__ __forceinline__ float fkeyf(float s, unsigned low, unsigned mask) { return __builtin_bit_cast(float, (__builtin_bit_cast(unsigned, s) & ~mask) | low); }
__device__ __forceinline__ float fvalf(float k, unsigned mask) { return __builtin_bit_cast(float, (__builtin_bit_cast(unsigned, k) & ~mask) | (mask >> 1)); }
#define CE_DESC(a, b) do { const float _mx = kmax((a), (b)), _mn = kmin((a), (b)); (a) = _mx; (b) = _mn; } while (0)
__device__ __forceinline__ void sort16_desc(float (&a)[16]) {
#pragma unroll
    for (int k = 2; k <= 16; k <<= 1)
#pragma unroll
        for (int j = k >> 1; j > 0; j >>= 1)
#pragma unroll
            for (int i = 0; i < 16; ++i) { const int l = i ^ j; if (l > i) { if ((i & k) == 0) CE_DESC(a[i], a[l]); else CE_DESC(a[l], a[i]); } }
}
__device__ __forceinline__ void merge16_desc(float (&c)[16]) {
#pragma unroll
    for (int j = 8; j > 0; j >>= 1)
#pragma unroll
        for (int i = 0; i < 16; ++i) { const int l = i ^ j; if (l > i) CE_DESC(c[i], c[l]); }
}
__device__ __forceinline__ void top16_merge(float (&a)[16], const float (&b)[16]) {
#pragma unroll
    for (int i = 0; i < 16; ++i) a[i] = kmax(a[i], b[15 - i]);
    merge16_desc(a);
}
__device__ __forceinline__ void top16_of_64(float (&g0)[16], float (&g1)[16], float (&g2)[16], float (&g3)[16]) {
    sort16_desc(g0); sort16_desc(g1); sort16_desc(g2); sort16_desc(g3);
    top16_merge(g0, g1); top16_merge(g2, g3); top16_merge(g0, g2);
}
__device__ __forceinline__ void ph_topk_fast(const Params& p, LAS unsigned char* lds, int bid, int nblk) {
    const int lane = opaque_tid() & 63, wave = wave_id(), r32 = lane & 31, hi = lane >> 5;
    const bf16* PQ = (const bf16*)(p.ws + WS_PQ); const bf16* SK = (const bf16*)(p.ws + WS_SUBK);
    unsigned short* ids = (unsigned short*)(p.ws + WS_IDS); float* gates = (float*)(p.ws + WS_GATES);
    const float* SVt = (const float*)(p.ws + WS_SV);
    LAS unsigned* myl = (LAS unsigned*)(lds + wave * 16384 + lane * 4);
    const float NEGINF = -INFINITY;
    for (int it = bid * NWAVES + wave; it < (NT / 32) * 8; it += nblk * NWAVES) {
        const int tt = it >> 3, h = it & 7, t = tt * 32 + r32;
        float K[2][16];
#pragma unroll
        for (int pp = 0; pp < 2; ++pp) {
            bf16x8_t qf[4];
            { const bf16* qp = PQ + (size_t)t * DM + h * 128 + pp * 64 + 8 * hi;
#pragma unroll
              for (int d0 = 0; d0 < 4; ++d0) qf[d0] = *(const bf16x8_t*)(qp + 16 * d0); }
            float g[4][16];
#pragma unroll
            for (int mt = 0; mt < 4; ++mt) {
                const bf16* kp = SK + ((size_t)((h * 2 + pp) * 4 + mt) * 4 * 64 + lane) * 8;
                f32x16 a = {0.f, 0.f, 0.f, 0.f, 0.f, 0.f, 0.f, 0.f, 0.f, 0.f, 0.f, 0.f, 0.f, 0.f, 0.f, 0.f};
#pragma unroll
                for (int d0 = 0; d0 < 4; ++d0) a = __builtin_amdgcn_mfma_f32_32x32x16_bf16(*(const bf16x8_t*)(kp + d0 * 512), qf[d0], a, 0, 0, 0);
#pragma unroll
                for (int r = 0; r < 16; ++r) g[mt][r] = fkeyf(a[r], 127u - (unsigned)(32 * mt + crow(r, hi)), 127u);
            }
            top16_of_64(g[0], g[1], g[2], g[3]);
            float o[16];
#pragma unroll
            for (int i = 0; i < 16; ++i) o[i] = __shfl_xor(g[0][i], 32);
            top16_merge(g[0], o);
#pragma unroll
            for (int i = 0; i < 16; ++i) K[pp][i] = g[0][i];
        }
#pragma unroll
        for (int i = 0; i < 16; ++i) { myl[i * 64] = __builtin_bit_cast(unsigned, K[0][i]); myl[(16 + i) * 64] = __builtin_bit_cast(unsigned, K[1][i]); }
        float v0[16], v1[16];
#pragma unroll
        for (int i = 0; i < 16; ++i) { v0[i] = fvalf(K[0][i], 127u); v1[i] = fvalf(K[1][i], 127u); }
        float cA[16], cB[16], cC[16], cD[16];
#pragma unroll
        for (int j = 0; j < 16; ++j) cA[j] = fkeyf(v0[0] + v1[j], 255u - (unsigned)j, 255u);
#pragma unroll
        for (int i = 1; i < 16; ++i) cB[i - 1] = fkeyf(v0[i] + v1[0], 255u - (unsigned)(16 * i), 255u);
        cB[15] = NEGINF;
#pragma unroll
        for (int q = 0; q < 16; ++q) { cC[q] = NEGINF; cD[q] = NEGINF; }
        { int n = 0;
#pragma unroll
          for (int i = 1; i < 8; ++i)
#pragma unroll
              for (int j = 1; j < 8; ++j) if ((i + 1) * (j + 1) <= 16) { const int m = stair2_slot(i, j); const float kv = fkeyf(v0[i] + v1[j], 255u - (unsigned)(16 * i + j), 255u); if (m < 16) cC[m] = kv; else cD[m - 16] = kv; }
          (void)n; }
        sort16_desc(cC);
        CE_DESC(cD[0], cD[1]); CE_DESC(cD[1], cD[2]); CE_DESC(cD[0], cD[1]);
        top16_merge(cA, cB); top16_merge(cC, cD); top16_merge(cA, cC);
        float e[16]; float sum = 0.f; const float mx = fvalf(cA[0], 255u);
#pragma unroll
        for (int r = 0; r < 16; ++r) { e[r] = __builtin_amdgcn_exp2f((fvalf(cA[r], 255u) - mx) * 1.4426950408889634f); sum += e[r]; }
        const float inv = __builtin_amdgcn_rcpf(sum);
        int eid[16];
#pragma unroll
        for (int r = 0; r < 16; ++r) { const unsigned id8 = 255u - (__builtin_bit_cast(unsigned, cA[r]) & 255u); const unsigned k0 = myl[(id8 >> 4) * 64], k1 = myl[(16 + (id8 & 15)) * 64];
            eid[r] = (int)((127u - (k0 & 127u)) * 128u + (127u - (k1 & 127u))); }
        int tq = t; asm volatile("" : "+v"(tq));
        if (hi == 0) {
#pragma unroll
            for (int q = 0; q < 2; ++q) *(v4u*)(ids + (size_t)tq * 128 + h * 16 + 8 * q) = (v4u){(unsigned)eid[8 * q] | ((unsigned)eid[8 * q + 1] << 16), (unsigned)eid[8 * q + 2] | ((unsigned)eid[8 * q + 3] << 16),
                                                                                      (unsigned)eid[8 * q + 4] | ((unsigned)eid[8 * q + 5] << 16), (unsigned)eid[8 * q + 6] | ((unsigned)eid[8 * q + 7] << 16)};
        } else {
#pragma unroll
            for (int q = 0; q < 4; ++q) *(f32x4*)(gates + (size_t)tq * 128 + h * 16 + 4 * q) = (f32x4){e[4 * q] * inv * SVt[eid[4 * q]], e[4 * q + 1] * inv * SVt[eid[4 * q + 1]], e[4 * q + 2] * inv * SVt[eid[4 * q + 2]], e[4 * q + 3] * inv * SVt[eid[4 * q + 3]]};
        }
    }
}

__device__ __forceinline__ void ph_ln1_fast(const Params& p, int bid, int nblk) {
    const bf16* y1 = (const bf16*)(p.ws + WS_Y1); bf16* x1 = (bf16*)(p.ws + WS_X1); bf16* h2b = (bf16*)(p.ws + WS_XN); const float* mod = (const float*)(p.ws + WS_MOD);
    const int lane = opaque_tid() & 63, wave = wave_id();
    for (int row = bid * NWAVES + wave; row < NT; row += nblk * NWAVES) {
        const int b = row / SEQ;
        const v2u* yr = (const v2u*)(y1 + (size_t)row * DM) + lane;
        f32x4 v[4]; float s = 0.f;
#pragma unroll
        for (int j = 0; j < 4; ++j) { const v2u w = yr[64 * j]; v[j] = (f32x4){bflo(w.x), bfhi(w.x), bflo(w.y), bfhi(w.y)}; s += (v[j].x + v[j].y) + (v[j].z + v[j].w); }
        float mean = wave_sum(s) * (1.f / DM); float s2 = 0.f;
#pragma unroll
        for (int j = 0; j < 4; ++j) { v[j] = v[j] - mean; s2 += (v[j].x * v[j].x + v[j].y * v[j].y) + (v[j].z * v[j].z + v[j].w * v[j].w); }
        float rstd = rsqrtf(wave_sum(s2) * (1.f / DM) + LN_EPS);
        s = 0.f;
#pragma unroll
        for (int j = 0; j < 4; ++j) { const f32x4 g = *((const f32x4*)p.g1 + lane + 64 * j), be = *((const f32x4*)p.be1 + lane + 64 * j);
            v[j] = v[j] * rstd * g + be; *((v2u*)(x1 + (size_t)row * DM) + lane + 64 * j) = (v2u){pk2(v[j].x, v[j].y), pk2(v[j].z, v[j].w)}; s += (v[j].x + v[j].y) + (v[j].z + v[j].w); }
        mean = wave_sum(s) * (1.f / DM); s2 = 0.f;
#pragma unroll
        for (int j = 0; j < 4; ++j) { v[j] = v[j] - mean; s2 += (v[j].x * v[j].x + v[j].y * v[j].y) + (v[j].z * v[j].z + v[j].w * v[j].w); }
        rstd = rsqrtf(wave_sum(s2) * (1.f / DM) + LN_EPS);
        float amax = 0.f;
#pragma unroll
        for (int j = 0; j < 4; ++j) {
            const f32x4 sh = *((const f32x4*)(mod + b * 6144 + 3072) + lane + 64 * j), sc = *((const f32x4*)(mod + b * 6144 + 4096) + lane + 64 * j);
            const f32x4 o = v[j] * rstd * (1.0f + sc) + sh; v[j] = o;
            amax = fmaxf(amax, fmaxf(fmaxf(fabsf(o.x), fabsf(o.y)), fmaxf(fabsf(o.z), fabsf(o.w))));
            *((v2u*)(h2b + (size_t)row * DM) + lane + 64 * j) = (v2u){pk2(o.x, o.y), pk2(o.z, o.w)};
        }
        amax = wave_max(amax); const float hinv = amax > 0.f ? 127.0f / amax : 0.f;
        unsigned* q4 = (unsigned*)(p.ws + WS_H2Q + (size_t)row * DM) + lane;
#pragma unroll
        for (int j = 0; j < 4; ++j) { unsigned q = 0u;
            q = __builtin_amdgcn_cvt_pk_u8_f32(v[j].x * hinv + 128.0f, 0, q); q = __builtin_amdgcn_cvt_pk_u8_f32(v[j].y * hinv + 128.0f, 1, q);
            q = __builtin_amdgcn_cvt_pk_u8_f32(v[j].z * hinv + 128.0f, 2, q); q = __builtin_amdgcn_cvt_pk_u8_f32(v[j].w * hinv + 128.0f, 3, q);
            q4[64 * j] = q ^ 0x80808080u; }
        if (lane == 0) ((float*)(p.ws + WS_HS))[row] = amax * (1.0f / 127.0f);
    }
}
__device__ __forceinline__ void ph_tables8(const Params& p, int bid, int nblk) {
    const int lane = opaque_tid() & 63, wave = wave_id();
    for (int r = bid * NWAVES + wave; r < 2 * 16384; r += nblk * NWAVES) {
        const bool isv = r >= 16384; const int row = isv ? r - 16384 : r;
        const f32x4* src = (const f32x4*)((isv ? p.pv : p.pu) + (size_t)row * DM + 16 * lane);
        f32x4 a[4]; float amax = 0.f;
#pragma unroll
        for (int j = 0; j < 4; ++j) { a[j] = src[j]; amax = fmaxf(amax, fmaxf(fmaxf(fabsf(a[j].x), fabsf(a[j].y)), fmaxf(fabsf(a[j].z), fabsf(a[j].w)))); }
        amax = wave_max(amax);
        const float inv = amax > 0.f ? 127.0f / amax : 0.f;
        v4u o;
#pragma unroll
        for (int j = 0; j < 4; ++j) { unsigned q = 0u;
            q = __builtin_amdgcn_cvt_pk_u8_f32(a[j].x * inv + 128.0f, 0, q); q = __builtin_amdgcn_cvt_pk_u8_f32(a[j].y * inv + 128.0f, 1, q);
            q = __builtin_amdgcn_cvt_pk_u8_f32(a[j].z * inv + 128.0f, 2, q); q = __builtin_amdgcn_cvt_pk_u8_f32(a[j].w * inv + 128.0f, 3, q);
            o[j] = q ^ 0x80808080u; }
        *(v4u*)(p.ws + (isv ? WS_TV8 : WS_TU8) + (size_t)(lane >> 3) * (2 * MiB) + (size_t)row * 128 + 16 * (lane & 7)) = o;
        if (lane == 0) ((float*)(p.ws + (isv ? WS_SV : WS_SU)))[row] = amax * (1.0f / 127.0f);
    }
}
__device__ __forceinline__ float readlane_f(float v, int l) { return __builtin_bit_cast(float, __builtin_amdgcn_readlane(__builtin_bit_cast(int, v), l)); }
__device__ __forceinline__ float ub0(unsigned u) { return (float)(u & 255u); }
__device__ __forceinline__ float ub1(unsigned u) { return (float)((u >> 8) & 255u); }
__device__ __forceinline__ float ub2(unsigned u) { return (float)((u >> 16) & 255u); }
__device__ __forceinline__ float ub3(unsigned u) { return (float)(u >> 24); }
__device__ __forceinline__ v4u ust_meta(const Params& p, int step, int t0, int stride8, int lane) {
    const int g = step >> 4, k = step & 15; int t = t0 + g * stride8 + (lane >> 3); t = t < NT ? t : NT - 1;
    return *(const v4u*)(p.ws + WS_IDS + (size_t)t * 256 + 16 * k);
}
__device__ __forceinline__ void ust_issue(v4u (&ub)[8], const v4u& idq, const unsigned char* TUs) {
#pragma unroll
    for (int e = 0; e < 8; ++e) { const unsigned w = idq[e >> 1]; const unsigned id = (e & 1) ? (w >> 16) : (w & 0xffffu); ub[e] = *(const v4u*)(TUs + (size_t)id * 128); }
}
__device__ __forceinline__ unsigned short ust_compute(const v4u (&ub)[8], const v4u& idq, const v4u& h0, const v4u& h1, int off8, const float* SUs, int lane) {
    int a[8];
#pragma unroll
    for (int e = 0; e < 8; ++e) { int v = 0;
#pragma unroll
        for (int j = 0; j < 4; ++j) { const unsigned d = ub[e][j]; const unsigned lo = d & 0x0f0f0f0fu, hi = (d >> 4) & 0x0f0f0f0fu;
            const unsigned hl = j < 2 ? h0[2 * j] : h1[2 * j - 4], hh = j < 2 ? h0[2 * j + 1] : h1[2 * j - 3];
            v = __builtin_amdgcn_sdot4((int)lo, (int)hl, v, false); v = __builtin_amdgcn_sdot4((int)hi, (int)hh, v, false); }
        a[e] = v; }
    int a4[4];
#pragma unroll
    for (int k = 0; k < 4; ++k) { const bool up = (lane & 4) != 0; const int keep = up ? a[k + 4] : a[k], send = up ? a[k] : a[k + 4]; a4[k] = keep + __shfl_xor(send, 4); }
    int a2[2];
#pragma unroll
    for (int k = 0; k < 2; ++k) { const bool up = (lane & 2) != 0; const int keep = up ? a4[k + 2] : a4[k], send = up ? a4[k] : a4[k + 2]; a2[k] = keep + __shfl_xor(send, 2); }
    const bool up = (lane & 1) != 0; const int keep = up ? a2[1] : a2[0], send = up ? a2[0] : a2[1];
    const int tot = keep + __shfl_xor(send, 1);
    const int c = lane & 7; const unsigned w2 = (c >> 1) == 0 ? idq.x : ((c >> 1) == 1 ? idq.y : ((c >> 1) == 2 ? idq.z : idq.w));
    const unsigned id = (c & 1) ? (w2 >> 16) : (w2 & 0xffffu);
    return (unsigned short)f2bf((float)(tot - off8) * SUs[id]);
}
__device__ __forceinline__ void ph_udot(const Params& p, int bid, int nblk) {
    unsigned short* P = (unsigned short*)(p.ws + WS_PART);
    const int lane = opaque_tid() & 63, wave = wave_id(), c = lane & 7;
    const int s8 = bid & 7, s = s8 & 3;
    const int nlo = (nblk - s + 7) >> 3, nhi = (nblk - (s + 4) + 7) >> 3;
    const int widx = ((s8 >> 2) ? nlo : 0) * NWAVES + (bid >> 3) * NWAVES + wave, stride8 = (nlo + nhi) * NWAVES * 8;
    const unsigned char* TUs = p.ws + WS_TU8 + (size_t)s * (2 * MiB) + 16 * c;
    const float* SUs = (const float*)(p.ws + WS_SU) + (size_t)s * 16384;
    const int t0 = widx * 8;
    const int ngroups = t0 < NT ? (NT - t0 + stride8 - 1) / stride8 : 0, nsteps = ngroups * 16;
    if (nsteps == 0) return;
    v4u uA[8], uB[8];
    v4u qa = ust_meta(p, 0, t0, stride8, lane);
    ust_issue(uA, qa, TUs);
    v4u qb = ust_meta(p, 1, t0, stride8, lane);
    v4u h0 = {0u, 0u, 0u, 0u}, h1 = {0u, 0u, 0u, 0u}; int off8 = 0;
    for (int st = 0; st < nsteps; st += 2) {
        const int tg = t0 + (st >> 4) * stride8 + (lane >> 3); const int t = tg < NT ? tg : NT - 1;
        if ((st & 15) == 0) {
            const unsigned char* hp = p.ws + WS_H2Q + (size_t)t * DM + 256 * s + 32 * c; h0 = *(const v4u*)hp; h1 = *(const v4u*)(hp + 16);
            int hs = 0;
#pragma unroll
            for (int j = 0; j < 4; ++j) { hs = __builtin_amdgcn_sdot4((int)h0[j], 0x01010101, hs, false); hs = __builtin_amdgcn_sdot4((int)h1[j], 0x01010101, hs, false); }
            hs += __shfl_xor(hs, 1); hs += __shfl_xor(hs, 2); hs += __shfl_xor(hs, 4); off8 = 8 * hs;
        }
        ust_issue(uB, qb, TUs);
        const v4u ia = qa; qa = ust_meta(p, st + 2 < nsteps ? st + 2 : st, t0, stride8, lane);
        const unsigned short ra = ust_compute(uA, ia, h0, h1, off8, SUs, lane);
        if (st + 2 < nsteps) ust_issue(uA, qa, TUs);
        const v4u ib = qb; qb = ust_meta(p, st + 3 < nsteps ? st + 3 : st + 1, t0, stride8, lane);
        const unsigned short rb = ust_compute(uB, ib, h0, h1, off8, SUs, lane);
        if (tg < NT) { unsigned short* dst = P + ((size_t)t * 4 + s) * 128 + 8 * (st & 15) + c; dst[0] = ra; dst[8] = rb; }
    }
}
__device__ __forceinline__ void ph_act(const Params& p, int bid, int nblk) {
    const bf16* P = (const bf16*)(p.ws + WS_PART); const float* GS = (const float*)(p.ws + WS_GATES); const float* HS = (const float*)(p.ws + WS_HS);
    unsigned char* WQ = p.ws + WS_WQ; float* WSC = (float*)(p.ws + WS_WSC);
    const int lane = opaque_tid() & 63, wave = wave_id();
    for (int t = bid * NWAVES + wave; t < NT; t += nblk * NWAVES) {
        float a0 = 0.f, a1 = 0.f;
#pragma unroll
        for (int s = 0; s < 4; ++s) { a0 += __builtin_bit_cast(float, (unsigned)P[((size_t)t * 4 + s) * 128 + lane] << 16); a1 += __builtin_bit_cast(float, (unsigned)P[((size_t)t * 4 + s) * 128 + 64 + lane] << 16); }
        const float hs = HS[t];
        const float d0 = a0 * hs, d1 = a1 * hs;
        const float w0 = GS[(size_t)t * 128 + lane] * 0.5f * d0 * (1.0f + erff(d0 * 0.70710678118654752f));
        const float w1 = GS[(size_t)t * 128 + 64 + lane] * 0.5f * d1 * (1.0f + erff(d1 * 0.70710678118654752f));
        const float wmax = wave_max(fmaxf(fabsf(w0), fabsf(w1))); const float winv = wmax > 0.f ? 127.0f / wmax : 0.f;
        unsigned b2 = __builtin_amdgcn_cvt_pk_u8_f32(w0 * winv + 128.0f, 0, 0u); b2 = __builtin_amdgcn_cvt_pk_u8_f32(w1 * winv + 128.0f, 1, b2); b2 ^= 0x8080u;
        WQ[(size_t)t * 128 + lane] = (unsigned char)(b2 & 255u); WQ[(size_t)t * 128 + 64 + lane] = (unsigned char)((b2 >> 8) & 255u);
        if (lane == 0) WSC[t] = wmax * (1.0f / 127.0f);
    }
}
struct VstepMeta { v4u idq; v2u wq; };
__device__ __forceinline__ VstepMeta vst_meta(const Params& p, int step, int t0, int stride8, int lane) {
    const int g = step >> 4, k = step & 15; int t = t0 + g * stride8 + (lane >> 3); t = t < NT ? t : NT - 1;
    VstepMeta r; r.idq = *(const v4u*)(p.ws + WS_IDS + (size_t)t * 256 + 16 * k); r.wq = *(const v2u*)(p.ws + WS_WQ + (size_t)t * 128 + 8 * k); return r;
}
__device__ __forceinline__ void vst_issue(v4u (&vb)[8], const VstepMeta& q, const unsigned char* TVs) {
#pragma unroll
    for (int e = 0; e < 8; ++e) { const unsigned w = q.idq[e >> 1]; const unsigned id = (e & 1) ? (w >> 16) : (w & 0xffffu); vb[e] = *(const v4u*)(TVs + (size_t)id * 128); }
}
__device__ __forceinline__ void vst_compute(int (&y)[16], const v4u (&vb)[8], const v2u& wq) {
#pragma unroll
    for (int qd = 0; qd < 2; ++qd)
#pragma unroll
        for (int cm = 0; cm < 4; ++cm) {
            const unsigned A = vb[4 * qd][cm], B = vb[4 * qd + 1][cm], C = vb[4 * qd + 2][cm], D = vb[4 * qd + 3][cm];
            const unsigned ab01 = __builtin_amdgcn_perm(B, A, 0x05010400u), ab23 = __builtin_amdgcn_perm(B, A, 0x07030602u);
            const unsigned cd01 = __builtin_amdgcn_perm(D, C, 0x05010400u), cd23 = __builtin_amdgcn_perm(D, C, 0x07030602u);
            const unsigned t0 = __builtin_amdgcn_perm(cd01, ab01, 0x05040100u), t1 = __builtin_amdgcn_perm(cd01, ab01, 0x07060302u);
            const unsigned t2 = __builtin_amdgcn_perm(cd23, ab23, 0x05040100u), t3 = __builtin_amdgcn_perm(cd23, ab23, 0x07060302u);
            y[4 * cm + 0] = __builtin_amdgcn_sdot4((int)t0, (int)wq[qd], y[4 * cm + 0], false); y[4 * cm + 1] = __builtin_amdgcn_sdot4((int)t1, (int)wq[qd], y[4 * cm + 1], false);
            y[4 * cm + 2] = __builtin_amdgcn_sdot4((int)t2, (int)wq[qd], y[4 * cm + 2], false); y[4 * cm + 3] = __builtin_amdgcn_sdot4((int)t3, (int)wq[qd], y[4 * cm + 3], false);
        }
}
__device__ __forceinline__ void ph_vacc(const Params& p, int bid, int nblk) {
    bf16* Y = (bf16*)(p.ws + WS_Y); const float* WSC = (const float*)(p.ws + WS_WSC);
    const int lane = opaque_tid() & 63, wave = wave_id(), c = lane & 7;
    const int s = bid & 7, nper = (nblk - s + 7) >> 3,     stride8 = nper * NWAVES * 8;
    const unsigned char* TVs = p.ws + WS_TV8 + (size_t)s * (2 * MiB) + 16 * c;
    const int t0 = ((bid >> 3) * NWAVES + wave) * 8;
    const int ngroups = t0 < NT ? (NT - t0 + stride8 - 1) / stride8 : 0, nsteps = ngroups * 16;
    if (nsteps == 0) return;
    int y[16];
#pragma unroll
    for (int k = 0; k < 16; ++k) y[k] = 0;
    v4u vA[8], vB[8];
    VstepMeta qa = vst_meta(p, 0, t0, stride8, lane);
    vst_issue(vA, qa, TVs);
    VstepMeta qb = vst_meta(p, 1, t0, stride8, lane);
    for (int st = 0; st < nsteps; st += 2) {
        vst_issue(vB, qb, TVs);
        const v2u wa = qa.wq; qa = vst_meta(p, st + 2 < nsteps ? st + 2 : st, t0, stride8, lane);
        vst_compute(y, vA, wa);
        if (st + 2 < nsteps) vst_issue(vA, qa, TVs);
        const v2u wb = qb.wq; qb = vst_meta(p, st + 3 < nsteps ? st + 3 : st + 1, t0, stride8, lane);
        vst_compute(y, vB, wb);
        if (((st + 1) & 15) == 15) {
            const int t = t0 + (st >> 4) * stride8 + (lane >> 3);
            if (t < NT) { const float sc = WSC[t];
                v4u o0, o1; o0.x = pk2((float)y[0] * sc, (float)y[1] * sc); o0.y = pk2((float)y[2] * sc, (float)y[3] * sc); o0.z = pk2((float)y[4] * sc, (float)y[5] * sc); o0.w = pk2((float)y[6] * sc, (float)y[7] * sc);
                o1.x = pk2((float)y[8] * sc, (float)y[9] * sc); o1.y = pk2((float)y[10] * sc, (float)y[11] * sc); o1.z = pk2((float)y[12] * sc, (float)y[13] * sc); o1.w = pk2((float)y[14] * sc, (float)y[15] * sc);
                v4u* dst = (v4u*)(Y + (size_t)t * DM + 128 * s + 16 * c); dst[0] = o0; dst[1] = o1; }
#pragma unroll
            for (int k = 0; k < 16; ++k) y[k] = 0;
        }
    }
}
__device__ __forceinline__ void ph_final(const Params& p, int bid, int nblk) {
    const bf16* x1 = (const bf16*)(p.ws + WS_X1); const bf16* Y = (const bf16*)(p.ws + WS_Y); const float* mod = (const float*)(p.ws + WS_MOD);
    const int lane = opaque_tid() & 63, wave = wave_id();
    for (int t = bid * NWAVES + wave; t < NT; t += nblk * NWAVES) {
        const int b = t / SEQ;
        f32x4 v[4]; float s = 0.f;
#pragma unroll
        for (int j = 0; j < 4; ++j) { const v2u xw = *((const v2u*)(x1 + (size_t)t * DM) + lane + 64 * j), yw = *((const v2u*)(Y + (size_t)t * DM) + lane + 64 * j);
            const f32x4 g2 = *((const f32x4*)(mod + b * 6144 + 5120) + lane + 64 * j);
            const f32x4 xv = {bflo(xw.x), bfhi(xw.x), bflo(xw.y), bfhi(xw.y)}, yv = {bflo(yw.x), bfhi(yw.x), bflo(yw.y), bfhi(yw.y)};
            v[j] = xv * ALPHA + (g2 + 1.0f) * yv; s += (v[j].x + v[j].y) + (v[j].z + v[j].w); }
        const float mean = wave_sum(s) * (1.f / DM); float s2 = 0.f;
#pragma unroll
        for (int j = 0; j < 4; ++j) { v[j] = v[j] - mean; s2 += (v[j].x * v[j].x + v[j].y * v[j].y) + (v[j].z * v[j].z + v[j].w * v[j].w); }
        const float rstd = rsqrtf(wave_sum(s2) * (1.f / DM) + LN_EPS);
#pragma unroll
        for (int j = 0; j < 4; ++j) { const f32x4 g = *((const f32x4*)p.g2 + lane + 64 * j), be = *((const f32x4*)p.be2 + lane + 64 * j);
            *((f32x4*)(p.out + (size_t)t * DM) + lane + 64 * j) = v[j] * rstd * g + be; }
    }
}

#ifndef PROBE_ID
#define PROBE_ID 0
#endif
#define RUN2(id, ...) do { __VA_ARGS__; if (PROBE_ID == (id)) { xcd_barrier(bar); __VA_ARGS__; } } while (0)
__global__ void __launch_bounds__(NTHREADS, 2) mega(Params p) {
    extern __shared__ __attribute__((aligned(16))) unsigned char lds_raw[];

    LAS unsigned char* lds = (LAS unsigned char*)lds_raw;
    const int bid = blockIdx.x, nblk = gridDim.x, tid = opaque_tid();
    for (int u = tid; u < (LDS_BYTES - LDSCTL_OFF) / 4; u += NTHREADS) ((LAS unsigned*)(lds + LDSCTL_OFF))[u] = 0u;
    __syncthreads();
    unsigned* ctl = (unsigned*)(p.ws + WS_CTL);
    XcdBarrier bar = xcd_barrier_post(ctl + CW_BAR, (volatile LAS unsigned*)(lds + MISC_OFF) + 8);
    const float* mod = (const float*)(p.ws + WS_MOD);

    ph_mod(p, lds, bid, nblk);
    xcd_barrier(bar);
    RUN2(1, ph_prologue(p, lds, bid, nblk));
    RUN2(7, ph_xn(p, bid, nblk));
    xcd_barrier(bar);
    {
        pg8::Gemm g{(const pg8::bf16_t*)(p.ws + WS_XN), (const pg8::bf16_t*)(p.ws + WS_WIN), NT, NIN, DM}; pg8::StaticOrder S; S.init(NT, NIN, nblk, bid);
        EpiIn E{(bf16*)(p.ws + WS_FZ), (bf16*)(p.ws + WS_QB), (const float*)(p.ws + WS_MISC), (const float*)(p.ws + WS_ROPE)};
        pg8::gemm_phase<EpiIn, pg8::StaticOrder, true, true>(lds, g, S, E);
    }
    xcd_barrier(bar);
    RUN2(8, ph_fft(p, lds, bid, nblk));
    RUN2(2, ph_attn_fast(p, lds, bid, nblk));
    xcd_barrier(bar);
    RUN2(3, ph_merge(p, bid, nblk));
    xcd_barrier(bar);
    {
        pg8::Gemm g{(const pg8::bf16_t*)(p.ws + WS_XN), (const pg8::bf16_t*)(p.ws + WS_WOUT), NT, DM, DM}; pg8::StaticOrder S; S.init(NT, DM, nblk, bid);
        EpiOut E{(bf16*)(p.ws + WS_Y1), p.x, mod, p.b_out};
        pg8::gemm_phase<EpiOut, pg8::StaticOrder, true, true>(lds, g, S, E);
    }
    xcd_barrier(bar);
    RUN2(4, ph_ln1_fast(p, bid, nblk));
    xcd_barrier(bar);
    {
        pg8::Gemm g{(const pg8::bf16_t*)(p.ws + WS_XN), (const pg8::bf16_t*)(p.ws + WS_WPQ), NT, DM, DM}; pg8::StaticOrder S; S.init(NT, DM, nblk, bid);
        pg8::EpiBf16<0> E{(pg8::bf16_t*)(p.ws + WS_PQ), DM, nullptr, 0, 0, 1.f};
        pg8::gemm_phase<pg8::EpiBf16<0>, pg8::StaticOrder, true, true>(lds, g, S, E);
    }
    xcd_barrier(bar);
    RUN2(5, ph_topk_fast(p, lds, bid, nblk));
    xcd_barrier(bar);
    RUN2(6, ph_udot(p, bid, nblk));
    xcd_barrier(bar);
    RUN2(11, ph_act(p, bid, nblk));
    xcd_barrier(bar);
    RUN2(10, ph_vacc(p, bid, nblk));
    xcd_barrier(bar);
    ph_final(p, bid, nblk);
}

extern "C" void kernel_launch(void* const* d_in, const int* in_sizes, int n_in, void* d_out, int out_size, void* d_ws, size_t ws_size, hipStream_t stream) {
    Params p{};
    p.x = (const float*)d_in[0]; p.c = (const float*)d_in[1]; p.pos = (const int*)d_in[2]; p.w_ada = (const float*)d_in[3]; p.b_ada = (const float*)d_in[4];
    p.w_in = (const float*)d_in[5]; p.b_in = (const float*)d_in[6]; p.w_four = (const float*)d_in[7]; p.w_out = (const float*)d_in[8]; p.b_out = (const float*)d_in[9];
    p.g1 = (const float*)d_in[10]; p.be1 = (const float*)d_in[11]; p.w_pq = (const float*)d_in[12]; p.subk = (const float*)d_in[13]; p.pu = (const float*)d_in[14]; p.pv = (const float*)d_in[15];
    p.g2 = (const float*)d_in[16]; p.be2 = (const float*)d_in[17]; p.out = (float*)d_out; p.ws = (unsigned char*)d_ws;
    static int grid_blocks = 0;
    if (grid_blocks == 0) {
        if (ws_size < WS_END) { fprintf(stderr, "workspace too small: %zu < %zu\n", ws_size, (size_t)WS_END); grid_blocks = -1; return; }
        int dev = 0, cus = 0, per_cu = 0;
        if (hipGetDevice(&dev) != hipSuccess || hipDeviceGetAttribute(&cus, hipDeviceAttributeMultiprocessorCount, dev) != hipSuccess) { grid_blocks = -1; return; }
        if (hipFuncSetAttribute((const void*)mega, hipFuncAttributeMaxDynamicSharedMemorySize, LDS_BYTES) != hipSuccess) { fprintf(stderr, "hipFuncSetAttribute failed\n"); grid_blocks = -1; return; }
        if (hipOccupancyMaxActiveBlocksPerMultiprocessor(&per_cu, (const void*)mega, NTHREADS, LDS_BYTES) != hipSuccess || per_cu < 1) { fprintf(stderr, "occupancy query: %d\n", per_cu); grid_blocks = -1; return; }
        grid_blocks = cus;
    }
    if (grid_blocks < 0) return;
    if (hipMemsetAsync((char*)d_ws + WS_CTL, 0, CTL_ZERO_BYTES, stream) != hipSuccess) { fprintf(stderr, "memset failed\n"); return; }
    void* args[] = {&p};
    hipError_t e = hipLaunchCooperativeKernel((void*)mega, dim3(grid_blocks), dim3(NTHREADS), args, LDS_BYTES, stream);
    if (e != hipSuccess) fprintf(stderr, "cooperative launch failed: %s (grid %d)\n", hipGetErrorString(e), grid_blocks);
}
```

```cpp
#include <hip/hip_runtime.h>
#include <hip/hip_cooperative_groups.h>
#include <cstdio>
#include <cstdint>
#include <cmath>
namespace cg = cooperative_groups;

namespace pg8 {
#define PG8_LAS __attribute__((address_space(3)))
typedef unsigned short bf16_t;
typedef short bf16x8 __attribute__((ext_vector_type(8)));
typedef float f32x4 __attribute__((ext_vector_type(4)));
typedef unsigned u32x4 __attribute__((ext_vector_type(4)));
constexpr int BM = 256, BK = 64, HALF = 128, HTB = HALF * BK * 2  , STAGE_BYTES = 8 * HTB, NXCD = 8, WGM = 8;

__host__ __device__ __forceinline__ int lds_byte(int r, int c) { const int st = (r >> 4) * 2 + (c >> 5), rr = r & 15, cc = c & 31, ob = rr * 64 + cc * 2; return st * 1024 + (ob ^ (((ob >> 9) & 1) << 5)); }
__host__ __device__ __forceinline__ void stage_rc(int b, int& R, int& C) { const int st = b / 1024, sb = b % 1024, swz = sb ^ (((sb >> 9) & 1) << 5); R = (st >> 1) * 16 + swz / 64; C = (st & 1) * 32 + (swz % 64) / 2; }
__host__ __device__ __forceinline__ int perm32(int rho) { const int n = rho >> 4, i = rho & 15; return 8 * (i >> 2) + 4 * n + (i & 3); }

struct Unit { int pm, pn; };
struct Gemm { const bf16_t* A; const bf16_t* Bt; int M, N, K; };

struct StaticOrder {
    int nM, nN, nwg, G, c;
    __host__ __device__ void init(int M, int N, int G_, int c_) { nM = M / BM; nN = N / BM; nwg = nM * nN; G = G_; c = c_; }
    __host__ __device__ bool next(int i, Unit& u) const {
        const long L = (long)i * G + c; if (L >= nwg) return false;
        int wgid = (int)L; { const int q = nwg / NXCD, r = nwg % NXCD, xcd = wgid % NXCD, off = wgid / NXCD; wgid = (xcd < r ? xcd * (q + 1) : r * (q + 1) + (xcd - r) * q) + off; }
        const int nig = WGM * nN, gid = wgid / nig, fm = gid * WGM, gsz = (nM - fm) < WGM ? (nM - fm) : WGM;
        u.pm = fm + ((wgid % nig) % gsz); u.pn = (wgid % nig) / gsz; return true;
    }
    __device__ __forceinline__ void a_ready(const Unit&) const {}
    __device__ __forceinline__ void done(const Unit&) const {}
};

__device__ __forceinline__ unsigned cvt_pk_bf16(float lo, float hi) { unsigned r; asm volatile("v_cvt_pk_bf16_f32 %0, %1, %2" : "=v"(r) : "v"(lo), "v"(hi)); return r; }
typedef float f32x2 __attribute__((ext_vector_type(2)));
__device__ __forceinline__ f32x2 gelu_pk(f32x2 v) {
    const f32x2 av = __builtin_elementwise_abs(v), d = av * 0.2316418882f + 1.0f;
    f32x2 t; t.x = __builtin_amdgcn_rcpf(d.x); t.y = __builtin_amdgcn_rcpf(d.y);
    f32x2 q = t * 0.5307027145f + (-0.7265760135f); q = q * t + 0.7107068705f; q = q * t + (-0.142248368f); q = q * t + 0.127414796f; q = q * t;
    const f32x2 s = (v * v) * (-0.72134752044f);
    f32x2 e; e.x = __builtin_amdgcn_exp2f(s.x); e.y = __builtin_amdgcn_exp2f(s.y);
    const f32x2 m = v * (q * e), r = v - m;
    f32x2 o; o.x = v.x < 0.f ? m.x : r.x; o.y = v.y < 0.f ? m.y : r.y; return o;
}

template <int ACT  > struct EpiBf16 {
    static constexpr bool PERM = true, AFTER_DRAIN = false; static_assert(ACT == 0 || ACT == 1, "EpiBf16: ACT is 0 (none) or 1 (gelu_pk)");
    bf16_t* O; int ldc; const float* bias; int split_cols; size_t split_stride; float scale0;
    __device__ __forceinline__ void operator()(const f32x4 (&acc)[2][2][4][2], const Unit& u, int wr, int wc, int fr, int fq) const {
        const int row0 = u.pm * BM + wr * 64 + fr; int colt = u.pn * BM; bf16_t* base = O;
        float sc = 1.f; if (split_cols) { const int t = colt / split_cols; base += (size_t)t * split_stride; colt -= t * split_cols; if (t == 0) sc = scale0; }
        const int col0 = colt + wc * 32 + 8 * fq, bcol0 = u.pn * BM + wc * 32 + 8 * fq;
        f32x4 bv[2][2];
#pragma unroll
        for (int bj = 0; bj < 2; ++bj)
#pragma unroll
            for (int n = 0; n < 2; ++n) bv[bj][n] = bias ? *(const f32x4*)(bias + bcol0 + bj * HALF + 4 * n) : (f32x4){0.f, 0.f, 0.f, 0.f};
#pragma unroll
        for (int ai = 0; ai < 2; ++ai)
#pragma unroll
            for (int m = 0; m < 4; ++m) { bf16_t* rowp = base + (size_t)(row0 + ai * HALF + m * 16) * ldc + col0;
#pragma unroll
                for (int bj = 0; bj < 2; ++bj) { f32x4 v0 = acc[ai][bj][m][0] + bv[bj][0], v1 = acc[ai][bj][m][1] + bv[bj][1];
                    if (ACT == 1) { f32x2 a = gelu_pk((f32x2){v0[0], v0[1]}), b = gelu_pk((f32x2){v0[2], v0[3]}), c = gelu_pk((f32x2){v1[0], v1[1]}), d = gelu_pk((f32x2){v1[2], v1[3]});
                        v0 = (f32x4){a.x, a.y, b.x, b.y}; v1 = (f32x4){c.x, c.y, d.x, d.y}; }
                    v0 = v0 * sc; v1 = v1 * sc; u32x4 w; w.x = cvt_pk_bf16(v0[0], v0[1]); w.y = cvt_pk_bf16(v0[2], v0[3]); w.z = cvt_pk_bf16(v1[0], v1[1]); w.w = cvt_pk_bf16(v1[2], v1[3]);
                    *(u32x4*)(rowp + bj * HALF) = w; } }
    }
};
template <class Epi, class Sched, bool ALIGN_EPI = false, bool SP2 = false>
__device__ __forceinline__ void gemm_phase(PG8_LAS unsigned char* lds, const Gemm g, const Sched& S, const Epi& E) {
    int tid_ = threadIdx.x; asm volatile("" : "+v"(tid_)); const int tid = tid_, wid = __builtin_amdgcn_readfirstlane(tid >> 6), lane = tid & 63, wr = wid >> 2, wc = wid & 3, fr = lane & 15, fq = lane >> 4;
    const int K = g.K, nt = K / BK;
    unsigned voffA[2], voffB[2];
#pragma unroll
    for (int i = 0; i < 2; ++i) { int R, C; stage_rc(tid * 16 + i * 8192, R, C); const int Rb = Epi::PERM ? ((R & ~31) + perm32(R & 31)) : R;
        voffA[i] = (unsigned)(R * K + C) * 2u; voffB[i] = (unsigned)(Rb * K + C) * 2u; }
    const size_t kstep = (size_t)(BK * 2);
    const size_t hstep = (size_t)HALF * K * 2;
    const size_t tstep = 2 * hstep;
    const unsigned ldsw = (unsigned)wid * 1024u;
    const int aoff = lds_byte(wr * 64 + fr, fq * 8), boff = lds_byte(wc * 32 + fr, fq * 8);
#define PG8_SA(b, h) (((b) * 2 + (h)) * HTB)
#define PG8_SB(b, h) ((4 + (b) * 2 + (h)) * HTB)
#define PG8_STAGE(bufoff, gbase, voff) do { _Pragma("unroll") for (int _i = 0; _i < 2; ++_i) \
        __builtin_amdgcn_global_load_lds((const unsigned*)((const char*)(gbase) + (voff)[_i]), (PG8_LAS unsigned*)(lds + (bufoff) + ldsw + _i * 8192), 16, 0, 0); } while (0)
#define PG8_LDA(dst, b, h) do { _Pragma("unroll") for (int m = 0; m < 4; ++m) _Pragma("unroll") for (int k = 0; k < 2; ++k) dst[m][k] = *(const PG8_LAS bf16x8*)(lds + PG8_SA(b, h) + aoff + m * 2048 + k * 1024); } while (0)
#define PG8_LDB(dst, b, h) do { _Pragma("unroll") for (int n = 0; n < 2; ++n) _Pragma("unroll") for (int k = 0; k < 2; ++k) dst[n][k] = *(const PG8_LAS bf16x8*)(lds + PG8_SB(b, h) + boff + n * 2048 + k * 1024); } while (0)
#define PG8_MMA(ai, bj, At, Bt) do { __builtin_amdgcn_s_setprio(1); _Pragma("unroll") for (int m = 0; m < 4; ++m) _Pragma("unroll") for (int n = 0; n < 2; ++n) _Pragma("unroll") for (int k = 0; k < 2; ++k) \
        acc[ai][bj][m][n] = __builtin_amdgcn_mfma_f32_16x16x32_bf16(Bt[n][k], At[m][k], acc[ai][bj][m][n], 0, 0, 0); __builtin_amdgcn_s_setprio(0); } while (0)
#define PG8_WAIT_V(n) asm volatile("s_waitcnt vmcnt(" #n ")" ::: "memory")
#define PG8_WAIT_L(n) asm volatile("s_waitcnt lgkmcnt(" #n ")" ::: "memory")
#define PG8_BAR __builtin_amdgcn_s_barrier()
#define PG8_SCHED __builtin_amdgcn_sched_barrier(0)
    Unit cur, nxt; int ui = 0;
    if (!S.next(0, cur)) return;
    f32x4 acc[2][2][4][2];
#pragma unroll
    for (int a = 0; a < 2; ++a)
#pragma unroll
        for (int b = 0; b < 2; ++b)
#pragma unroll
            for (int m = 0; m < 4; ++m)
#pragma unroll
                for (int n = 0; n < 2; ++n) acc[a][b][m][n] = (f32x4){0.f, 0.f, 0.f, 0.f};
    bf16x8 At[4][2], B0[2][2], B1[2][2];
    const char* cA = (const char*)g.A + (size_t)cur.pm * tstep; const char* cB = (const char*)g.Bt + (size_t)cur.pn * tstep;
    S.a_ready(cur);
    if constexpr (SP2) {
        PG8_STAGE(PG8_SB(0, 0), cB, voffB); PG8_STAGE(PG8_SB(0, 1), cB + hstep, voffB); PG8_STAGE(PG8_SA(0, 0), cA, voffA); PG8_STAGE(PG8_SA(0, 1), cA + hstep, voffA);
        if (wr == 1) PG8_BAR;
        PG8_WAIT_V(2); PG8_BAR;
        PG8_STAGE(PG8_SB(1, 0), cB + kstep, voffB); PG8_STAGE(PG8_SA(1, 0), cA + kstep, voffA); PG8_STAGE(PG8_SB(1, 1), cB + hstep + kstep, voffB);
        PG8_WAIT_V(6); PG8_BAR;
    } else {
        PG8_STAGE(PG8_SB(0, 0), cB, voffB); PG8_STAGE(PG8_SA(0, 0), cA, voffA); PG8_STAGE(PG8_SB(0, 1), cB + hstep, voffB); PG8_STAGE(PG8_SA(0, 1), cA + hstep, voffA);
        if (wr == 1) PG8_BAR;
        PG8_WAIT_V(4); PG8_BAR;
        PG8_STAGE(PG8_SB(1, 0), cB + kstep, voffB); PG8_STAGE(PG8_SA(1, 0), cA + kstep, voffA); PG8_STAGE(PG8_SB(1, 1), cB + hstep + kstep, voffB);
        PG8_WAIT_V(6); PG8_BAR;
    }
    for (;;) {
        const bool has_next = S.next(ui + 1, nxt);
        const char* nA = has_next ? (const char*)g.A + (size_t)nxt.pm * tstep : cA; const char* nB = has_next ? (const char*)g.Bt + (size_t)nxt.pn * tstep : cB;
        for (int t = 0; t < nt; t += 2) {
            const bool last = (t == nt - 2);
            const char* a1 = cA + (size_t)(t + 1) * kstep;
            const char* a2 = last ? nA : cA + (size_t)(t + 2) * kstep; const char* b2 = last ? nB : cB + (size_t)(t + 2) * kstep;
            const char* a3 = a2 + kstep; const char* b3 = b2 + kstep;
            if (last && has_next) S.a_ready(nxt);
            if constexpr (SP2) {
            PG8_LDB(B0, 0, 0); PG8_LDB(B1, 0, 1); PG8_SCHED; PG8_LDA(At, 0, 0); PG8_STAGE(PG8_SA(1, 1), a1 + hstep, voffA);
            PG8_WAIT_V(8); PG8_WAIT_L(0); PG8_BAR; PG8_MMA(0, 0, At, B0); PG8_MMA(0, 1, At, B1); PG8_BAR; PG8_SCHED;
            PG8_LDA(At, 0, 1); PG8_STAGE(PG8_SB(0, 0), b2, voffB); PG8_STAGE(PG8_SB(0, 1), b2 + hstep, voffB); PG8_STAGE(PG8_SA(0, 0), a2, voffA);
            PG8_WAIT_V(8); PG8_WAIT_L(0); PG8_BAR; PG8_MMA(1, 0, At, B0); PG8_MMA(1, 1, At, B1); PG8_BAR; PG8_SCHED;
            PG8_LDB(B0, 1, 0); PG8_LDB(B1, 1, 1); PG8_SCHED; PG8_LDA(At, 1, 0); PG8_STAGE(PG8_SA(0, 1), a2 + hstep, voffA);
            PG8_WAIT_V(8); PG8_WAIT_L(0); PG8_BAR; PG8_MMA(0, 0, At, B0); PG8_MMA(0, 1, At, B1); PG8_BAR; PG8_SCHED;
            PG8_LDA(At, 1, 1); PG8_STAGE(PG8_SB(1, 0), b3, voffB); PG8_STAGE(PG8_SB(1, 1), b3 + hstep, voffB); PG8_STAGE(PG8_SA(1, 0), a3, voffA);
            PG8_WAIT_V(8); PG8_WAIT_L(0); PG8_BAR; PG8_MMA(1, 0, At, B0); PG8_MMA(1, 1, At, B1); PG8_BAR; PG8_SCHED;
            } else {
            PG8_LDB(B0, 0, 0); PG8_SCHED; PG8_LDA(At, 0, 0); PG8_STAGE(PG8_SA(1, 1), a1 + hstep, voffA);
            PG8_WAIT_L(8); PG8_BAR; PG8_WAIT_L(0); PG8_MMA(0, 0, At, B0); PG8_BAR; PG8_SCHED;
            PG8_LDB(B1, 0, 1); PG8_STAGE(PG8_SB(0, 0), b2, voffB);
            PG8_BAR; PG8_WAIT_L(0); PG8_MMA(0, 1, At, B1); PG8_BAR;
            PG8_LDA(At, 0, 1); PG8_STAGE(PG8_SA(0, 0), a2, voffA);
            PG8_BAR; PG8_WAIT_L(0); PG8_MMA(1, 0, At, B0); PG8_BAR; PG8_SCHED;
            PG8_STAGE(PG8_SB(0, 1), b2 + hstep, voffB);
            PG8_WAIT_V(6); PG8_BAR; PG8_MMA(1, 1, At, B1); PG8_BAR;
            PG8_LDB(B0, 1, 0); PG8_SCHED; PG8_LDA(At, 1, 0); PG8_STAGE(PG8_SA(0, 1), a2 + hstep, voffA);
            PG8_WAIT_L(8); PG8_BAR; PG8_WAIT_L(0); PG8_MMA(0, 0, At, B0); PG8_BAR; PG8_SCHED;
            PG8_LDB(B1, 1, 1); PG8_STAGE(PG8_SB(1, 0), b3, voffB);
            PG8_BAR; PG8_WAIT_L(0); PG8_MMA(0, 1, At, B1); PG8_BAR;
            PG8_LDA(At, 1, 1); PG8_STAGE(PG8_SA(1, 0), a3, voffA);
            PG8_BAR; PG8_WAIT_L(0); PG8_MMA(1, 0, At, B0); PG8_BAR; PG8_SCHED;
            PG8_STAGE(PG8_SB(1, 1), b3 + hstep, voffB);
            PG8_WAIT_V(6); PG8_BAR; PG8_MMA(1, 1, At, B1); PG8_BAR;
            }
        }
        if constexpr (ALIGN_EPI) { if (wr == 0) PG8_BAR; }
        if constexpr (!Epi::AFTER_DRAIN) { E(acc, cur, wr, wc, fr, fq); S.done(cur); }
        if (!has_next) break;
#pragma unroll
        for (int a = 0; a < 2; ++a)
#pragma unroll
            for (int b = 0; b < 2; ++b)
#pragma unroll
                for (int m = 0; m < 4; ++m)
#pragma unroll
                    for (int n = 0; n < 2; ++n) acc[a][b][m][n] = (f32x4){0.f, 0.f, 0.f, 0.f};
        cur = nxt; cA = nA; cB = nB; ++ui;
        if constexpr (ALIGN_EPI) { if (wr == 1) PG8_BAR; }
    }
    PG8_WAIT_V(0);
    if constexpr (!ALIGN_EPI) { if (wr == 0) PG8_BAR; }
    PG8_BAR;
    if constexpr (Epi::AFTER_DRAIN) { E.fused(acc, cur, wr, wc, fr, fq, lds, wid, lane); S.done(cur); }
#undef PG8_SA
#undef PG8_SB
#undef PG8_STAGE
#undef PG8_LDA
#undef PG8_LDB
#undef PG8_MMA
#undef PG8_WAIT_V
#undef PG8_WAIT_L
#undef PG8_BAR
#undef PG8_SCHED
}
}

#define LAS __attribute__((address_space(3)))
#define GAS __attribute__((address_space(1)))
#define XB_TMO      128
#define XB_XCNT(j)  (256  + 64 * (j))
#define XB_XSUB(j)  (1280 + 64 * (j))
#define XB_XGEN(j)  (2304 + 64 * (j))
#define XB_TOP      3328
#define XB_TOPGEN   3392
#define XCD_BAR_WORDS 3456
#define XB_SPIN_CAP (1u << 18)

__device__ __forceinline__ unsigned xb_ld(unsigned* p)              { return __hip_atomic_load(p, __ATOMIC_RELAXED, __HIP_MEMORY_SCOPE_AGENT); }
__device__ __forceinline__ unsigned xb_add(unsigned* p, unsigned v) { return __hip_atomic_fetch_add(p, v, __ATOMIC_RELAXED, __HIP_MEMORY_SCOPE_AGENT); }
__device__ __forceinline__ unsigned xb_xcc_id() { return (unsigned)__builtin_amdgcn_s_getreg((3 << 11) | 20) & 0xFu; }
#define XB_SPIN(cond, bar) do { unsigned _sp = 0; while (cond) { __builtin_amdgcn_s_sleep(1); \
    if ((++_sp & 255u) == 0u) { if (xb_ld(&(bar)[XB_TMO])) break; if (_sp > XB_SPIN_CAP) { atomicAdd(&(bar)[XB_TMO], 1u); break; } } } } while (0)

struct XcdBarrier {
    unsigned* bar; unsigned x;
    volatile LAS unsigned* st;
};

__device__ __forceinline__ XcdBarrier xcd_barrier_post(unsigned* bar, volatile LAS unsigned* st) {
    XcdBarrier b; b.bar = bar; b.x = xb_xcc_id(); b.st = st;
    if (threadIdx.x == 0) (void)xb_add(&bar[XB_XCNT(b.x)], 1u);
    return b;
}
__device__ __forceinline__ void xcd_barrier_complete(unsigned* bar, unsigned x, unsigned& nloc, unsigned& nx) {
    const unsigned G = gridDim.x * gridDim.y * gridDim.z;
    unsigned sum, cnt, mine, sp = 0u;
    for (;;) {
        sum = 0u; cnt = 0u; mine = 0u;
#pragma unroll
        for (unsigned j = 0; j < 16; ++j) { const unsigned c = xb_ld(&bar[XB_XCNT(j)]); sum += c; cnt += (c > 0u) ? 1u : 0u; mine = (j == x) ? c : mine; }
        if (sum == G) break;
        __builtin_amdgcn_s_sleep(1);
        if ((++sp & 255u) == 0u) { if (xb_ld(&bar[XB_TMO])) break; if (sp > XB_SPIN_CAP) { atomicAdd(&bar[XB_TMO], 1u); break; } }
    }
    nloc = mine > 0u ? mine : 1u; nx = cnt > 0u ? cnt : 1u;
}

__device__ __forceinline__ void xcd_barrier(const XcdBarrier& b) {
    asm volatile("s_waitcnt vmcnt(0)" ::: "memory");
    __syncthreads();
    if (threadIdx.x == 0) {
        unsigned* bar = b.bar;
        __builtin_amdgcn_s_waitcnt(0);
        unsigned nloc = b.st[0], nx = b.st[1];
        if (nloc == 0u) { xcd_barrier_complete(bar, b.x, nloc, nx); b.st[0] = nloc; b.st[1] = nx; }
        const unsigned old = xb_add(&bar[XB_XSUB(b.x)], 1u);
        const unsigned gen = old / nloc;
        if (old + 1u == (gen + 1u) * nloc) {
            __builtin_amdgcn_fence(__ATOMIC_RELEASE, "agent");
            asm volatile("s_waitcnt vmcnt(0)" ::: "memory");
            const unsigned og = xb_add(&bar[XB_TOP], 1u);
            const unsigned tg = og / nx;
            if (og + 1u == (tg + 1u) * nx) xb_add(&bar[XB_TOPGEN], 1u);
            else XB_SPIN(xb_ld(&bar[XB_TOPGEN]) == tg, bar);
            __builtin_amdgcn_fence(__ATOMIC_ACQUIRE, "agent");
            xb_add(&bar[XB_XGEN(b.x)], 1u);
            asm volatile("s_waitcnt vmcnt(0)" ::: "memory");
        } else {
            XB_SPIN(xb_ld(&bar[XB_XGEN(b.x)]) == gen, bar);
            __builtin_amdgcn_fence(__ATOMIC_ACQUIRE, "agent");
            asm volatile("s_waitcnt vmcnt(0)" ::: "memory");
        }
    }
    __syncthreads();
}

constexpr int DM = 1024, NB = 2, SEQ = 8192, NT = NB * SEQ;
constexpr int NTHREADS = 512, NWAVES = 8;
constexpr float LN_EPS = 1e-5f;
constexpr float ALPHA = 1.189207115002721f;
typedef unsigned short bf16;
typedef unsigned v4u __attribute__((ext_vector_type(4)));
typedef unsigned v2u __attribute__((ext_vector_type(2)));
typedef float f32x4 __attribute__((ext_vector_type(4)));
typedef short bf16x8_t __attribute__((ext_vector_type(8)));

constexpr size_t MiB = 1u << 20, KiB = 1u << 10;
constexpr size_t WS_CTL = 0, CTL_ZERO_BYTES = 1 * MiB;
constexpr size_t WS_MOD = 1 * MiB + 768 * KiB;
constexpr size_t WS_MMAT = 1 * MiB;
constexpr size_t WS_ROPE = 2 * MiB;
constexpr size_t WS_WIN = 6 * MiB, WS_WOUT = 12 * MiB, WS_WPQ = 14 * MiB, WS_MISC = 16 * MiB, WS_SUBK = 17 * MiB;
constexpr size_t WS_XN = 18 * MiB;
constexpr size_t WS_FZ = 50 * MiB;
constexpr size_t WS_QB = 66 * MiB, WS_KB = 90 * MiB, WS_VB = 114 * MiB, WS_O3 = 138 * MiB, WS_LSE = 162 * MiB;
constexpr size_t WS_H2Q = 50 * MiB, WS_HS = 66 * MiB, WS_WQ = 67 * MiB, WS_WSC = 69 * MiB, WS_SUA = 75 * MiB, WS_X1 = 83 * MiB;
constexpr size_t WS_Y1 = 116 * MiB, WS_PQ = 116 * MiB, WS_PART = 116 * MiB, WS_Y = 116 * MiB;
constexpr size_t WS_IDS = 180 * MiB, WS_GATES = 188 * MiB;
constexpr size_t WS_TU8 = 200 * MiB, WS_TV8 = 216 * MiB, WS_SU = 232 * MiB, WS_SV = 232 * MiB + 512 * KiB, WS_END = 233 * MiB;
constexpr float QSCALE = 0.125f * 1.4426950408889634f;
constexpr int NIN = 2816;
constexpr int CW_BAR = 4096;

constexpr int RING_BYTES = 131072, LDSCTL_OFF = RING_BYTES, MISC_OFF = LDSCTL_OFF + 320, LDS_BYTES = 147456;

struct Params {
    const float* x; const float* c; const int* pos; const float* w_ada; const float* b_ada; const float* w_in; const float* b_in;
    const float* w_four; const float* w_out; const float* b_out; const float* g1; const float* be1; const float* w_pq; const float* subk;
    const float* pu; const float* pv; const float* g2; const float* be2; float* out; unsigned char* ws;
};

__device__ __forceinline__ unsigned f2bf(float f) { unsigned u = __builtin_bit_cast(unsigned, f); return (u + 0x7fffu + ((u >> 16) & 1u)) >> 16; }
__device__ __forceinline__ unsigned pk2(float lo, float hi) { return f2bf(lo) | (f2bf(hi) << 16); }
__device__ __forceinline__ float wave_sum(float v) {
#pragma unroll
    for (int o = 32; o > 0; o >>= 1) v += __shfl_xor(v, o);
    return v;
}
__device__ __forceinline__ float wave_max(float v) {
#pragma unroll
    for (int o = 32; o > 0; o >>= 1) v = fmaxf(v, __shfl_xor(v, o));
    return v;
}
#define LDS_WAIT() asm volatile("s_waitcnt lgkmcnt(0)" ::: "memory")
__device__ __forceinline__ int opaque_tid() { int t = threadIdx.x; asm volatile("" : "+v"(t)); return t; }
__device__ __forceinline__ int wave_id() { return __builtin_amdgcn_readfirstlane(opaque_tid() >> 6); }
__device__ __forceinline__ float bflo(unsigned u) { return __builtin_bit_cast(float, u << 16); }
__device__ __forceinline__ float bfhi(unsigned u) { return __builtin_bit_cast(float, u & 0xffff0000u); }

template <class SC>
__device__ __forceinline__ void transpose_item(const float* W, int K, int N, bf16* WT, int nout, SC srccol, LAS float* scr, int item, int lane) {
    const int nblk = nout / 32, kb = item / nblk, nb = item % nblk, k0 = 64 * kb, n0 = 32 * nb;
    const int sc = srccol(n0 + (lane & 31));
#pragma unroll 8
    for (int i = 0; i < 32; ++i) { const int kk = 2 * i + (lane >> 5); scr[kk * 33 + (lane & 31)] = W[(size_t)(k0 + kk) * N + sc]; }
    LDS_WAIT(); asm volatile("" ::: "memory");
    const int c = lane & 7;
#pragma unroll
    for (int j = 0; j < 4; ++j) { const int n = (lane >> 3) + 8 * j; const LAS float* s = scr + (8 * c) * 33 + n;
        v4u o; o.x = pk2(s[0 * 33], s[1 * 33]); o.y = pk2(s[2 * 33], s[3 * 33]); o.z = pk2(s[4 * 33], s[5 * 33]); o.w = pk2(s[6 * 33], s[7 * 33]);
        *(v4u*)(WT + (size_t)(n0 + n) * K + k0 + 8 * c) = o; }
    LDS_WAIT(); asm volatile("" ::: "memory");
}
__device__ __forceinline__ void ph_prologue(const Params& p, LAS unsigned char* lds, int bid, int nblk) {
    const int tid = opaque_tid(), lane = tid & 63, wave = __builtin_amdgcn_readfirstlane(tid >> 6);
    {
        LAS float* M = (LAS float*)lds; LAS float* Wl = (LAS float*)(lds + 32768);
        bf16* WT = (bf16*)(p.ws + WS_WIN); float* biasf = (float*)(p.ws + WS_MISC); const float* MM = (const float*)(p.ws + WS_MMAT);
        const bool fallback = !(nblk > 192);
        for (int it = bid; it < 256; it += nblk) {
            const int g = it & 3, kb = it >> 2, k0 = kb * 16;
            __syncthreads();
            if (fallback) { const float norm = 1.0f / sqrtf(8192.0f * 64.0f);
                for (int e = tid; e < 8192; e += NTHREADS) { const int c = e >> 7, nl = e & 127; float a = 0.f;
                    for (int cp = 0; cp < 64; ++cp) { const float ang = 2.0f * (float)((c * cp) & 63) / 64.0f; a += ((nl & 1) ? -sinpif(ang) : cospif(ang)) * p.w_four[(g * 64 + cp) * 64 + (nl >> 1)]; }
                    M[e] = a * norm; } }
            else {
#pragma unroll
                for (int i = 0; i < 4; ++i) *(LAS f32x4*)(lds + (tid + i * 512) * 16) = *(const f32x4*)(MM + (size_t)g * 8192 + (tid + i * 512) * 4); }
#pragma unroll
            for (int i = 0; i < 2; ++i) { const int e = tid + i * 512, k = e >> 6, c = e & 63; Wl[k * 64 + c] = p.w_in[(size_t)(k0 + k) * 2560 + g * 64 + c]; }
            __syncthreads();
            { const int nl = tid & 127, kq = tid >> 7; float a[4] = {0.f, 0.f, 0.f, 0.f};
              for (int c = 0; c < 64; ++c) { const float mv = M[c * 128 + nl];
#pragma unroll
                  for (int j = 0; j < 4; ++j) a[j] += mv * Wl[(kq * 4 + j) * 64 + c]; }
              *(v2u*)(WT + (size_t)(g * 128 + nl) * DM + k0 + kq * 4) = (v2u){pk2(a[0], a[1]), pk2(a[2], a[3])};
              if (kb == 0 && tid < 128) { float bsum = 0.f; for (int c = 0; c < 64; ++c) bsum += p.b_in[g * 64 + c] * M[c * 128 + nl]; biasf[g * 128 + nl] = bsum; } }
        }
        __syncthreads();
        for (int i = bid * NTHREADS + tid; i < 2304; i += nblk * NTHREADS) biasf[512 + i] = p.b_in[256 + i];
    }
    {
        LAS float* scr = (LAS float*)(lds + wave * 16384);
        const int gw = bid * NWAVES + wave, NGW = nblk * NWAVES;
        constexpr int I_IN = 16 * (2304 / 32), I_O = 16 * 32, I_PQ = 16 * 32;
        for (int it = gw; it < I_IN + I_O + I_PQ; it += NGW) {
            int r = it;
            if (r < I_IN) {
                transpose_item(p.w_in, DM, 2560, (bf16*)(p.ws + WS_WIN) + (size_t)512 * DM, 2304,
                    [](int n) { return n < 1536 ? 256 + (n & ~63) + ((n & 63) >> 1) + 32 * (n & 1) : 256 + n; }, scr, r, lane); continue; } r -= I_IN;
            if (r < I_O) { transpose_item(p.w_out, DM, DM, (bf16*)(p.ws + WS_WOUT), DM, [](int n) { return n; }, scr, r, lane); continue; } r -= I_O;
            transpose_item(p.w_pq, DM, DM, (bf16*)(p.ws + WS_WPQ), DM, [](int n) { return n; }, scr, r, lane);
        }
    }
    { float2* rope = (float2*)(p.ws + WS_ROPE);
      for (int idx = bid * NTHREADS + tid; idx < NT * 32; idx += nblk * NTHREADS) { const int t = idx >> 5, i = idx & 31;
          const float inv = powf(10000.0f, -(float)i / 32.0f); float sn, cs; sincosf((float)p.pos[t] * inv, &sn, &cs); rope[idx] = make_float2(cs, sn); } }
    { bf16* SK = (bf16*)(p.ws + WS_SUBK);
      for (int ch = bid * NTHREADS + tid; ch < 8 * 2 * 4 * 4 * 64; ch += nblk * NTHREADS) {
          const int ln = ch & 63, d0 = (ch >> 6) & 3, mt = (ch >> 8) & 3, hp = ch >> 10;
          const float* sp = p.subk + ((size_t)hp * 128 + 32 * mt + (ln & 31)) * 64 + 16 * d0 + 8 * (ln >> 5);
          v4u o; o.x = pk2(sp[0], sp[1]); o.y = pk2(sp[2], sp[3]); o.z = pk2(sp[4], sp[5]); o.w = pk2(sp[6], sp[7]);
          *(v4u*)(SK + (size_t)ch * 8) = o; } }
}
__device__ __forceinline__ void ph_mod(const Params& p, LAS unsigned char* lds, int bid, int nblk) {
    const int tid = opaque_tid(), col = tid & 31, kg = tid >> 5;
    LAS float* cond = (LAS float*)lds; LAS float* red = (LAS float*)(lds + 8192);
    float* mod = (float*)(p.ws + WS_MOD);
    for (int i = tid; i < 2 * DM; i += NTHREADS) { const float c = p.c[i]; cond[i] = c / (1.0f + expf(-c)); }
    __syncthreads();
    if (nblk > 192 && bid >= 192) {
        LAS float* T64 = (LAS float*)(lds + 12288);
        if (tid < 64) { T64[tid] = cospif(2.0f * (float)tid / 64.0f); T64[64 + tid] = -sinpif(2.0f * (float)tid / 64.0f); }
        __syncthreads();
        const float norm = 1.0f / sqrtf(8192.0f * 64.0f); float* MM = (float*)(p.ws + WS_MMAT);
        for (int it = bid - 192; it < 64; it += nblk - 192) {
            const int g = it >> 4, c = (it & 15) * 4 + (tid >> 7), nl = tid & 127; float a = 0.f;
#pragma unroll 8
            for (int cp = 0; cp < 64; ++cp) a += T64[(nl & 1) * 64 + ((c * cp) & 63)] * p.w_four[(g * 64 + cp) * 64 + (nl >> 1)];
            MM[(g * 64 + c) * 128 + nl] = a * norm;
        }
    }
    for (int it = bid; it < 6144 / 32; it += nblk) {
        const int n = it * 32 + col; float a0 = 0.f, a1 = 0.f;
        const float* wp = p.w_ada + (size_t)(kg * 64) * 6144 + n;
#pragma unroll 16
        for (int k = 0; k < 64; ++k) { const float w = wp[(size_t)k * 6144]; a0 += cond[kg * 64 + k] * w; a1 += cond[DM + kg * 64 + k] * w; }
        red[(kg * 2 + 0) * 32 + col] = a0; red[(kg * 2 + 1) * 32 + col] = a1;
        __syncthreads();
        if (tid < 64) { const int b = tid >> 5; float s = p.b_ada[n];
#pragma unroll
            for (int g = 0; g < 16; ++g) s += red[(g * 2 + b) * 32 + col];
            mod[b * 6144 + n] = s; }
        __syncthreads();
    }
}
__device__ __forceinline__ void ph_xn(const Params& p, int bid, int nblk) {
    const int lane = opaque_tid() & 63, wave = wave_id(); const float* mod = (const float*)(p.ws + WS_MOD); bf16* XN = (bf16*)(p.ws + WS_XN);
    for (int row = bid * NWAVES + wave; row < NT; row += nblk * NWAVES) {
        const int b = row / SEQ;
        const f32x4* xr = (const f32x4*)(p.x + (size_t)row * DM) + lane;
        f32x4 v[4]; float s = 0.f;
#pragma unroll
        for (int j = 0; j < 4; ++j) { v[j] = xr[64 * j]; s += (v[j].x + v[j].y) + (v[j].z + v[j].w); }
        const float mean = wave_sum(s) * (1.f / DM); float s2 = 0.f;
#pragma unroll
        for (int j = 0; j < 4; ++j) { v[j] = v[j] - mean; s2 += (v[j].x * v[j].x + v[j].y * v[j].y) + (v[j].z * v[j].z + v[j].w * v[j].w); }
        const float rstd = rsqrtf(wave_sum(s2) * (1.f / DM) + LN_EPS);
        unsigned long long* o8 = (unsigned long long*)(XN + (size_t)row * DM) + lane;
#pragma unroll
        for (int j = 0; j < 4; ++j) {
            const f32x4 sh = *((const f32x4*)(mod + b * 6144 + 0) + lane + 64 * j), sc = *((const f32x4*)(mod + b * 6144 + 1024) + lane + 64 * j);
            const f32x4 o = v[j] * rstd * (1.0f + sc) + sh;
            o8[64 * j] = (unsigned long long)pk2(o.x, o.y) | ((unsigned long long)pk2(o.z, o.w) << 32);
        }
    }
}

struct EpiOut {
    static constexpr bool PERM = true, AFTER_DRAIN = false;
    bf16* Y1; const float* x; const float* mod; const float* bo;
    __device__ __forceinline__ void operator()(const pg8::f32x4 (&acc)[2][2][4][2], const pg8::Unit& u, int wr, int wc, int fr, int fq) const {
        const int row0 = u.pm * 256 + wr * 64 + fr;
#pragma unroll
        for (int bj = 0; bj < 2; ++bj) {
            const int c0 = u.pn * 256 + bj * 128 + wc * 32 + 8 * fq;
            const pg8::f32x4 b0 = *(const pg8::f32x4*)(bo + c0), b1 = *(const pg8::f32x4*)(bo + c0 + 4);
#pragma unroll
            for (int ai = 0; ai < 2; ++ai) {
                const int bb = (u.pm * 256 + ai * 128) >> 13;
                const pg8::f32x4 g0 = *(const pg8::f32x4*)(mod + bb * 6144 + 2048 + c0) + 1.0f, g1 = *(const pg8::f32x4*)(mod + bb * 6144 + 2048 + c0 + 4) + 1.0f;
#pragma unroll
                for (int m = 0; m < 4; ++m) {
                    const int row = row0 + ai * 128 + m * 16;
                    const pg8::f32x4 x0 = *(const pg8::f32x4*)(x + (size_t)row * DM + c0), x1 = *(const pg8::f32x4*)(x + (size_t)row * DM + c0 + 4);
                    const pg8::f32x4 v0 = x0 * ALPHA + g0 * (acc[ai][bj][m][0] + b0), v1 = x1 * ALPHA + g1 * (acc[ai][bj][m][1] + b1);
                    v4u o; o.x = pk2(v0.x, v0.y); o.y = pk2(v0.z, v0.w); o.z = pk2(v1.x, v1.y); o.w = pk2(v1.z, v1.w);
                    *(v4u*)(Y1 + (size_t)row * DM + c0) = o;
                }
            }
        }
    }
};
__device__ __forceinline__ void ph_fft(const Params& p, LAS unsigned char* lds, int bid, int nblk) {
    const int tid = opaque_tid(), lane = tid & 63, wave = __builtin_amdgcn_readfirstlane(tid >> 6), lr = lane & 15, lq = lane >> 4;
    bf16* MIX = (bf16*)(p.ws + WS_XN);
    for (int item = bid; item < 256; item += nblk) {
        const int b = item >> 7, cg = item & 127;
        const unsigned long long* src = (const unsigned long long*)(p.ws + WS_FZ) + (size_t)(b * 128 + cg) * 8192;
        {
            const int n2b = (tid & 7) | ((tid >> 6) << 3), n1b = (tid >> 3) & 7;
            const unsigned long long* sb = src + 128 * n1b + n2b; LAS unsigned char* lb = lds + (2 * n2b) * 288 + 4 * n1b;
#pragma unroll
            for (int hb = 0; hb < 2; ++hb) {
                unsigned long long zin[8];
#pragma unroll
                for (int i = 0; i < 8; ++i) { const int ii = hb * 8 + i; zin[i] = sb[(ii & 1) * 64 + (ii >> 1) * 1024]; }
#pragma unroll
                for (int i = 0; i < 8; ++i) { const int ii = hb * 8 + i; LAS unsigned char* lp = lb + (ii & 1) * 36864 + (ii >> 1) * 32;
                    *(LAS unsigned*)lp = (unsigned)zin[i]; *(LAS unsigned*)(lp + 288) = (unsigned)(zin[i] >> 32); }
            }
        }
        bf16x8_t af[4];
        { const int m = 16 * wave + lr, k1 = m >> 1, ri = m & 1;
#pragma unroll
          for (int ks = 0; ks < 4; ++ks)
#pragma unroll
              for (int jj = 0; jj < 4; ++jj) { const int n1 = 16 * ks + 4 * lq + jj; const float x = (float)((n1 * k1) & 63) * (1.0f / 64.0f);
                  const float c = __builtin_amdgcn_cosf(x), s = __builtin_amdgcn_sinf(x);
                  af[ks][2 * jj] = (short)f2bf(ri ? -s : c); af[ks][2 * jj + 1] = (short)f2bf(ri ? c : s); } }
        __syncthreads();
        pg8::f32x4 acc[16];
#pragma unroll
        for (int nt = 0; nt < 16; ++nt) { acc[nt] = (pg8::f32x4){0.f, 0.f, 0.f, 0.f};
#pragma unroll
            for (int ks = 0; ks < 4; ++ks) { const bf16x8_t bf = *(const LAS bf16x8_t*)(lds + (16 * nt + lr) * 288 + (32 * ks + 8 * lq) * 2);
                acc[nt] = __builtin_amdgcn_mfma_f32_16x16x32_bf16(af[ks], bf, acc[nt], 0, 0, 0); } }
        __syncthreads();
#pragma unroll
        for (int nt = 0; nt < 16; ++nt) { const int col = 16 * nt + lr, n2 = col >> 1, ch = col & 1;
#pragma unroll
            for (int h = 0; h < 2; ++h) { const int k1 = 8 * wave + 2 * lq + h; const float yr = acc[nt][2 * h], yi = acc[nt][2 * h + 1];
                const float x = (float)((n2 * k1) & 8191) * (1.0f / 8192.0f); const float c = __builtin_amdgcn_cosf(x), s = __builtin_amdgcn_sinf(x);
                *(LAS unsigned*)(lds + (2 * k1 + ch) * 544 + 4 * n2) = pk2(yr * c + yi * s, yi * c - yr * s); } }
        bf16x8_t a2[8];
        { const int k2 = 16 * wave + lr;
#pragma unroll
          for (int ks = 0; ks < 8; ++ks)
#pragma unroll
              for (int jj = 0; jj < 4; ++jj) { const int n2 = 16 * ks + 4 * lq + jj; const float x = (float)((n2 * k2) & 127) * (1.0f / 128.0f);
                  a2[ks][2 * jj] = (short)f2bf(__builtin_amdgcn_cosf(x)); a2[ks][2 * jj + 1] = (short)f2bf(__builtin_amdgcn_sinf(x)); } }
        __syncthreads();
        pg8::f32x4 o[8];
#pragma unroll
        for (int nt = 0; nt < 8; ++nt) { o[nt] = (pg8::f32x4){0.f, 0.f, 0.f, 0.f};
#pragma unroll
            for (int ks = 0; ks < 8; ++ks) { const bf16x8_t bf = *(const LAS bf16x8_t*)(lds + (16 * nt + lr) * 544 + (32 * ks + 8 * lq) * 2);
                o[nt] = __builtin_amdgcn_mfma_f32_16x16x32_bf16(a2[ks], bf, o[nt], 0, 0, 0); } }
#pragma unroll
        for (int nt = 0; nt < 8; ++nt) { const int col2 = 16 * nt + lr, k1 = col2 >> 1, ch = col2 & 1;
#pragma unroll
            for (int r = 0; r < 4; ++r) { const float v = o[nt][r]; const float w = __shfl_xor(v, 1); const int k2 = 16 * wave + 4 * lq + r;
                if (ch == 0) *(unsigned*)(MIX + ((size_t)b * SEQ + k1 + 64 * k2) * DM + 2 * cg) = pk2(v, w); } }
        __syncthreads();
    }
}


struct EpiIn {
    static constexpr bool PERM = true, AFTER_DRAIN = false;
    bf16* FZ; bf16* QKV; const float* bias; const float* rope;
    __device__ __forceinline__ void operator()(const pg8::f32x4 (&acc)[2][2][4][2], const pg8::Unit& u, int wr, int wc, int fr, int fq) const {
        const int row0 = u.pm * 256 + wr * 64 + fr;
#pragma unroll
        for (int bj = 0; bj < 2; ++bj) {
            const int c0 = u.pn * 256 + bj * 128 + wc * 32 + 8 * fq;
            const pg8::f32x4 b0 = *(const pg8::f32x4*)(bias + c0), b1 = *(const pg8::f32x4*)(bias + c0 + 4);
#pragma unroll
            for (int ai = 0; ai < 2; ++ai)
#pragma unroll
                for (int m = 0; m < 4; ++m) {
                    const int row = row0 + ai * 128 + m * 16;
                    pg8::f32x4 v0 = acc[ai][bj][m][0] + b0, v1 = acc[ai][bj][m][1] + b1;
                    if (u.pn < 2) {
                        const int b = row >> 13, s = row & 8191, cgp = c0 >> 2;
                        unsigned long long* d0 = (unsigned long long*)(FZ + (((size_t)(b * 128 + cgp) * 8192 + s) << 2));
                        d0[0] = (unsigned long long)pk2(v0.x, v0.y) | ((unsigned long long)pk2(v0.z, v0.w) << 32);
                        d0[8192] = (unsigned long long)pk2(v1.x, v1.y) | ((unsigned long long)pk2(v1.z, v1.w) << 32);
                    } else {
                        const int cq = c0 - 512, which = cq / 768, off = cq - which * 768;
                        if (which < 2) {
                            const float sc = which == 0 ? QSCALE : 1.0f;
                            const pg8::f32x4 r0 = *(const pg8::f32x4*)(rope + (size_t)row * 64 + (off & 63)), r1 = *(const pg8::f32x4*)(rope + (size_t)row * 64 + (off & 63) + 4);
                            pg8::f32x4 w0, w1;
                            w0.x = (v0.x * r0.x - v0.y * r0.y) * sc; w0.y = (v0.y * r0.x + v0.x * r0.y) * sc; w0.z = (v0.z * r0.z - v0.w * r0.w) * sc; w0.w = (v0.w * r0.z + v0.z * r0.w) * sc;
                            w1.x = (v1.x * r1.x - v1.y * r1.y) * sc; w1.y = (v1.y * r1.x + v1.x * r1.y) * sc; w1.z = (v1.z * r1.z - v1.w * r1.w) * sc; w1.w = (v1.w * r1.z + v1.z * r1.w) * sc;
                            v0 = w0; v1 = w1;
                        }
                        v4u o; o.x = pk2(v0.x, v0.y); o.y = pk2(v0.z, v0.w); o.z = pk2(v1.x, v1.y); o.w = pk2(v1.z, v1.w);
                        *(v4u*)(QKV + (size_t)which * ((WS_KB - WS_QB) / 2) + (size_t)row * 768 + off) = o;
                    }
                }
        }
    }
};

typedef float f32x16 __attribute__((ext_vector_type(16)));
typedef short s16x4 __attribute__((ext_vector_type(4)));
__device__ __forceinline__ int crow(int r, int hi) { return (r & 3) + 8 * (r >> 2) + 4 * hi; }
__device__ __forceinline__ s16x4 vtr(const LAS unsigned char* p) { return __builtin_bit_cast(s16x4, __builtin_amdgcn_ds_read_tr16_b64_v4i16((LAS s16x4*)p)); }
__device__ __forceinline__ unsigned cvtpk(float lo, float hi) { typedef float f2 __attribute__((ext_vector_type(2))); typedef __bf16 b2 __attribute__((ext_vector_type(2))); f2 v = {lo, hi}; b2 r = __builtin_convertvector(v, b2); return __builtin_bit_cast(unsigned, r); }
__device__ __forceinline__ void tbl_load(const Params& p, int r, f32x4 (&a)[4], int lane) {
    const bool isv = r >= 16384; const int row = isv ? r - 16384 : r;
    const f32x4* src = (const f32x4*)((isv ? p.pv : p.pu) + (size_t)row * DM + 16 * lane);
#pragma unroll
    for (int j = 0; j < 4; ++j) a[j] = src[j];
}
__device__ __forceinline__ void tbl_finish(const Params& p, int r, const f32x4 (&a)[4], int lane) {
    const bool isv = r >= 16384; const int row = isv ? r - 16384 : r;
    float amax = 0.f;
#pragma unroll
    for (int j = 0; j < 4; ++j) amax = fmaxf(amax, fmaxf(fmaxf(fabsf(a[j].x), fabsf(a[j].y)), fmaxf(fabsf(a[j].z), fabsf(a[j].w))));
    if (isv) {
        amax = wave_max(amax);
        const float inv = amax > 0.f ? 127.0f / amax : 0.f;
        v4u o;
#pragma unroll
        for (int j = 0; j < 4; ++j) { unsigned q = 0u;
            q = __builtin_amdgcn_cvt_pk_u8_f32(a[j].x * inv + 128.0f, 0, q); q = __builtin_amdgcn_cvt_pk_u8_f32(a[j].y * inv + 128.0f, 1, q);
            q = __builtin_amdgcn_cvt_pk_u8_f32(a[j].z * inv + 128.0f, 2, q); q = __builtin_amdgcn_cvt_pk_u8_f32(a[j].w * inv + 128.0f, 3, q);
            o[j] = q ^ 0x80808080u; }
        *(v4u*)(p.ws + WS_TV8 + (size_t)(lane >> 3) * (2 * MiB) + (size_t)row * 128 + 16 * (lane & 7)) = o;
        if (lane == 0) ((float*)(p.ws + WS_SV))[row] = amax * (1.0f / 127.0f);
    } else {
        amax = fmaxf(amax, __shfl_xor(amax, 1)); amax = fmaxf(amax, __shfl_xor(amax, 2)); amax = fmaxf(amax, __shfl_xor(amax, 4)); amax = fmaxf(amax, __shfl_xor(amax, 8));
        const float inv = amax > 0.f ? 7.0f / amax : 0.f;
        unsigned d[2];
#pragma unroll
        for (int w = 0; w < 2; ++w) { unsigned lo = 0u, hi = 0u;
            lo = __builtin_amdgcn_cvt_pk_u8_f32(a[2 * w].x * inv + 8.0f, 0, lo); lo = __builtin_amdgcn_cvt_pk_u8_f32(a[2 * w].y * inv + 8.0f, 1, lo);
            lo = __builtin_amdgcn_cvt_pk_u8_f32(a[2 * w].z * inv + 8.0f, 2, lo); lo = __builtin_amdgcn_cvt_pk_u8_f32(a[2 * w].w * inv + 8.0f, 3, lo);
            hi = __builtin_amdgcn_cvt_pk_u8_f32(a[2 * w + 1].x * inv + 8.0f, 0, hi); hi = __builtin_amdgcn_cvt_pk_u8_f32(a[2 * w + 1].y * inv + 8.0f, 1, hi);
            hi = __builtin_amdgcn_cvt_pk_u8_f32(a[2 * w + 1].z * inv + 8.0f, 2, hi); hi = __builtin_amdgcn_cvt_pk_u8_f32(a[2 * w + 1].w * inv + 8.0f, 3, hi);
            d[w] = lo | (hi << 4); }
        *(v2u*)(p.ws + WS_TU8 + (size_t)(lane >> 4) * (2 * MiB) + (size_t)row * 128 + 8 * (lane & 15)) = (v2u){d[0], d[1]};
        if ((lane & 15) == 0) ((float*)(p.ws + WS_SU))[(size_t)(lane >> 4) * 16384 + row] = amax * (1.0f / 7.0f);
    }
}
struct AttnDesc { int dil, ntile, res, cb, r; size_t rowb; int h; bool valid; };
__device__ __forceinline__ AttnDesc attn_desc(int bi) {
    AttnDesc d; d.valid = bi < 3 * 768; const int b2 = d.valid ? bi : 0;
    const int r = b2 / 768, rem = b2 - r * 768, bh = rem >> 5, q32 = rem & 31, b = bh / 12;
    d.r = r; d.h = bh - b * 12; d.rowb = (size_t)b * SEQ;
    const int ld = 2 * r;
    d.dil = 1 << ld; d.ntile = 256 >> ld; d.res = q32 >> (5 - ld); d.cb = q32 & ((32 >> ld) - 1);
    return d;
}
__device__ __forceinline__ void attn_dma(const AttnDesc& d, const bf16* T, bool swz, LAS unsigned char* img, int wave, int lane) {
#pragma unroll
    for (int i = 0; i < 6; ++i) {
        const int idx = wave * 6 + i, j = idx >> 2, it = idx & 3, kt = 8 * d.cb - 2 + j;
        if (kt >= 0 && kt < d.ntile) {
            const int row = it * 8 + (lane >> 3), ch = lane & 7; const int gch = swz ? (ch ^ ((row >> 1) & 7)) : ch;
            const bf16* src = T + (d.rowb + d.res + d.dil * (32 * kt + row)) * 768 + d.h * 64 + 8 * gch;
            __builtin_amdgcn_global_load_lds((const unsigned*)src, (LAS unsigned*)(img + j * 4096 + it * 1024), 16, 0, 0);
        }
    }
}
__device__ __forceinline__ void attn_qload(const AttnDesc& d, const bf16* QB, bf16x8_t (&qf)[4], int wave, int lane) {
    const bf16* qp = QB + (d.rowb + d.res + d.dil * (32 * (8 * d.cb + wave) + (lane & 31))) * 768 + d.h * 64 + 8 * (lane >> 5);
#pragma unroll
    for (int d0 = 0; d0 < 4; ++d0) qf[d0] = *(const bf16x8_t*)(qp + 16 * d0);
}
#define ATT_SYNC() do { asm volatile("s_waitcnt vmcnt(0) lgkmcnt(0)" ::: "memory"); __builtin_amdgcn_s_barrier(); asm volatile("" ::: "memory"); } while (0)
__device__ __forceinline__ void ph_attn_fast(const Params& p, LAS unsigned char* lds, int bid, int nblk) {
    const int lane = opaque_tid() & 63, wave = wave_id(), r32 = lane & 31, hi = lane >> 5;
    LAS unsigned char* imgK = lds; LAS unsigned char* imgV = lds + 49152; LAS unsigned char* stgb = lds + 98304 + wave * 4096;
    const bf16* QB = (const bf16*)(p.ws + WS_QB); const bf16* KB = (const bf16*)(p.ws + WS_KB); const bf16* VB = (const bf16*)(p.ws + WS_VB);
    const int vb = (nblk & 7) == 0 ? (bid & 7) * (nblk >> 3) + (bid >> 3) : bid;
    int bi = vb;
    AttnDesc d = attn_desc(bi);
    bf16x8_t qf[4];
    if (d.valid) { attn_dma(d, KB, true, imgK, wave, lane); attn_qload(d, QB, qf, wave, lane); }
    ATT_SYNC();
    const int g = lane >> 4, ii = lane & 15;
    const int vb0 = (4 * hi + (ii >> 2)) * 128 + (g & 1) * 32 + (ii & 3) * 8;
    int trow = bid * NWAVES + wave; const int tstride = nblk * NWAVES;
    f32x4 ta[4];
    while (d.valid) {
        asm volatile("" : "+v"(qf[0]), "+v"(qf[1]), "+v"(qf[2]), "+v"(qf[3]));
        attn_dma(d, VB, false, imgV, wave, lane);
        const bool tb1 = trow < 32768; if (tb1) tbl_load(p, trow, ta, lane);
        const int c = 8 * d.cb + wave;
        f32x16 S[5];
#pragma unroll
        for (int u = 0; u < 5; ++u) {
            const int kt = c - 2 + u;
#pragma unroll
            for (int r = 0; r < 16; ++r) S[u][r] = -1e30f;
            if (kt >= 0 && kt < d.ntile) {
                const LAS unsigned char* slot = imgK + (wave + u) * 4096;
                f32x16 a = {0.f, 0.f, 0.f, 0.f, 0.f, 0.f, 0.f, 0.f, 0.f, 0.f, 0.f, 0.f, 0.f, 0.f, 0.f, 0.f};
#pragma unroll
                for (int d0 = 0; d0 < 4; ++d0) { const bf16x8_t kf = *(const LAS bf16x8_t*)(slot + r32 * 128 + (((2 * d0 + hi) ^ ((r32 >> 1) & 7)) << 4));
                    a = __builtin_amdgcn_mfma_f32_32x32x16_bf16(kf, qf[d0], a, 0, 0, 0); }
                S[u] = a;
            }
        }
#pragma unroll
        for (int r = 0; r < 16; ++r) { const int kk = crow(r, hi); if (kk < r32) S[0][r] = -1e30f; if (kk > r32) S[4][r] = -1e30f; }
        float m = -1e30f;
#pragma unroll
        for (int u = 0; u < 5; ++u)
#pragma unroll
            for (int r = 0; r < 16; ++r) m = fmaxf(m, S[u][r]);
        m = fmaxf(m, __shfl_xor(m, 32));
        float l = 0.f;
        unsigned Pk[5][8];
#pragma unroll
        for (int u = 0; u < 5; ++u)
#pragma unroll
            for (int r = 0; r < 16; r += 2) { const float e0 = __builtin_amdgcn_exp2f(S[u][r] - m), e1 = __builtin_amdgcn_exp2f(S[u][r + 1] - m); l += e0 + e1; Pk[u][r >> 1] = cvtpk(e0, e1); }
        l += __shfl_xor(l, 32);
        if (tb1) { tbl_finish(p, trow, ta, lane); trow += tstride; }
        ATT_SYNC();
        const AttnDesc dn = attn_desc(bi + nblk);
        if (dn.valid) { attn_dma(dn, KB, true, imgK, wave, lane); attn_qload(dn, QB, qf, wave, lane); }
        const bool tb2 = trow < 32768; if (tb2) tbl_load(p, trow, ta, lane);
        f32x16 o[2];
#pragma unroll
        for (int db = 0; db < 2; ++db)
#pragma unroll
            for (int r = 0; r < 16; ++r) o[db][r] = 0.f;
#pragma unroll
        for (int u = 0; u < 5; ++u) {
            const int kt = c - 2 + u;
            if (kt >= 0 && kt < d.ntile) {
                const LAS unsigned char* slot = imgV + (wave + u) * 4096;
#pragma unroll
                for (int s = 0; s < 2; ++s) {
                    bf16x8_t pa;
                    { v4u w; w.x = Pk[u][4 * s + 0]; w.y = Pk[u][4 * s + 1]; w.z = Pk[u][4 * s + 2]; w.w = Pk[u][4 * s + 3]; pa = __builtin_bit_cast(bf16x8_t, w); }
#pragma unroll
                    for (int db = 0; db < 2; ++db) {
                        const s16x4 lo = vtr(slot + vb0 + s * 2048 + db * 64), hh = vtr(slot + vb0 + s * 2048 + 1024 + db * 64);
                        const bf16x8_t vf = {lo[0], lo[1], lo[2], lo[3], hh[0], hh[1], hh[2], hh[3]};
                        o[db] = __builtin_amdgcn_mfma_f32_32x32x16_bf16(pa, vf, o[db], 0, 0, 0);
                    }
                }
            }
        }
        bf16* OB = d.r == 2 ? (bf16*)(p.ws + WS_O3) : (bf16*)p.out + (size_t)d.r * NT * 768;
        float* LSE = (float*)(p.ws + WS_LSE) + (size_t)d.r * NT * 12;
        const float linv = 1.0f / l;
        LAS unsigned short* stg = (LAS unsigned short*)stgb;
#pragma unroll
        for (int r = 0; r < 16; ++r) { const int q = crow(r, hi); const float li = __shfl(linv, q);
#pragma unroll
            for (int db = 0; db < 2; ++db) stg[q * 64 + db * 32 + r32] = (unsigned short)f2bf(o[db][r] * li); }
        int ln2 = lane; asm volatile("" : "+v"(ln2));
#pragma unroll
        for (int i4 = 0; i4 < 4; ++i4) { const int row = i4 * 8 + (ln2 >> 3), ch = ln2 & 7;
            const v4u val = *(const LAS v4u*)((LAS unsigned char*)stg + row * 128 + ch * 16);
            *(v4u*)(OB + (d.rowb + d.res + d.dil * (32 * c + row)) * 768 + d.h * 64 + 8 * ch) = val; }
        if (ln2 < 32) LSE[(d.rowb + d.res + d.dil * (32 * c + ln2)) * 12 + d.h] = m + __builtin_amdgcn_logf(l);
        if (tb2) { tbl_finish(p, trow, ta, lane); trow += tstride; }
        ATT_SYNC();
        d = dn; bi += nblk;
    }
    for (; trow < 32768; trow += tstride) { tbl_load(p, trow, ta, lane); tbl_finish(p, trow, ta, lane); }
}
__device__ __forceinline__ void ph_merge(const Params& p, int bid, int nblk) {
    const bf16* O1 = (const bf16*)p.out; const bf16* O2 = O1 + (size_t)NT * 768; const bf16* O3 = (const bf16*)(p.ws + WS_O3);
    const float* L1 = (const float*)(p.ws + WS_LSE); const float* L2 = L1 + (size_t)NT * 12; const float* L3 = L2 + (size_t)NT * 12; bf16* MIX = (bf16*)(p.ws + WS_XN);
    for (int idx = bid * NTHREADS + opaque_tid(); idx < NT * 96; idx += nblk * NTHREADS) {
        const int t = idx / 96, rem = idx - t * 96, h = rem >> 3, ch = rem & 7;
        const float l1 = L1[t * 12 + h], l2 = L2[t * 12 + h], l3 = L3[t * 12 + h]; const float mx = fmaxf(fmaxf(l1, l2), l3);
        float w1 = __builtin_amdgcn_exp2f(l1 - mx), w2 = __builtin_amdgcn_exp2f(l2 - mx), w3 = __builtin_amdgcn_exp2f(l3 - mx); const float inv = 1.0f / (w1 + w2 + w3); w1 *= inv; w2 *= inv; w3 *= inv;
        const size_t off = (size_t)t * 768 + h * 64 + 8 * ch;
        const v4u a = *(const v4u*)(O1 + off), bq = *(const v4u*)(O2 + off), cq = *(const v4u*)(O3 + off);
        v4u o;
        o.x = pk2(w1 * bflo(a.x) + w2 * bflo(bq.x) + w3 * bflo(cq.x), w1 * bfhi(a.x) + w2 * bfhi(bq.x) + w3 * bfhi(cq.x));
        o.y = pk2(w1 * bflo(a.y) + w2 * bflo(bq.y) + w3 * bflo(cq.y), w1 * bfhi(a.y) + w2 * bfhi(bq.y) + w3 * bfhi(cq.y));
        o.z = pk2(w1 * bflo(a.z) + w2 * bflo(bq.z) + w3 * bflo(cq.z), w1 * bfhi(a.z) + w2 * bfhi(bq.z) + w3 * bfhi(cq.z));
        o.w = pk2(w1 * bflo(a.w) + w2 * bflo(bq.w) + w3 * bflo(cq.w), w1 * bfhi(a.w) + w2 * bfhi(bq.w) + w3 * bfhi(cq.w));
        *(v4u*)(MIX + (size_t)t * DM + 256 + h * 64 + 8 * ch) = o;
    }
}


__host__ __device__ constexpr int stair2_slot(int i, int j) { int n = 0; for (int a = 1; a < 16; ++a) for (int b = 1; b < 16; ++b) if ((a + 1) * (b + 1) <= 16) { if (a == i && b == j) return n; ++n; } return n; }
__device__ __forceinline__ float kmax(float a, float b) { float r; asm("v_max_f32_e32 %0, %1, %2" : "=v"(r) : "v"(a), "v"(b)); return r; }
__device__ __forceinline__ float kmin(float a, float b) { float r; asm("v_min_f32_e32 %0, %1, %2" : "=v"(r) : "v"(a), "v"(b)); return r; }
__device__ __forceinline__ float fkeyf(float s, unsigned low, unsigned mask) { return __builtin_bit_cast(float, (__builtin_bit_cast(unsigned, s) & ~mask) | low); }
__device__ __forceinline__ float fvalf(float k, unsigned mask) { return __builtin_bit_cast(float, (__builtin_bit_cast(unsigned, k) & ~mask) | (mask >> 1)); }
#define CE_DESC(a, b) do { const float _mx = kmax((a), (b)), _mn = kmin((a), (b)); (a) = _mx; (b) = _mn; } while (0)
__device__ __forceinline__ void sort16_desc(float (&a)[16]) {
#pragma unroll
    for (int k = 2; k <= 16; k <<= 1)
#pragma unroll
        for (int j = k >> 1; j > 0; j >>= 1)
#pragma unroll
            for (int i = 0; i < 16; ++i) { const int l = i ^ j; if (l > i) { if ((i & k) == 0) CE_DESC(a[i], a[l]); else CE_DESC(a[l], a[i]); } }
}
__device__ __forceinline__ void merge16_desc(float (&c)[16]) {
#pragma unroll
    for (int j = 8; j > 0; j >>= 1)
#pragma unroll
        for (int i = 0; i < 16; ++i) { const int l = i ^ j; if (l > i) CE_DESC(c[i], c[l]); }
}
__device__ __forceinline__ void top16_merge(float (&a)[16], const float (&b)[16]) {
#pragma unroll
    for (int i = 0; i < 16; ++i) a[i] = kmax(a[i], b[15 - i]);
    merge16_desc(a);
}
__device__ __forceinline__ void top16_of_64(float (&g0)[16], float (&g1)[16], float (&g2)[16], float (&g3)[16]) {
    sort16_desc(g0); sort16_desc(g1); sort16_desc(g2); sort16_desc(g3);
    top16_merge(g0, g1); top16_merge(g2, g3); top16_merge(g0, g2);
}
__device__ __forceinline__ void ph_topk_fast(const Params& p, LAS unsigned char* lds, int bid, int nblk) {
    const int lane = opaque_tid() & 63, wave = wave_id(), r32 = lane & 31, hi = lane >> 5;
    const bf16* PQ = (const bf16*)(p.ws + WS_PQ); const bf16* SK = (const bf16*)(p.ws + WS_SUBK);
    unsigned short* ids = (unsigned short*)(p.ws + WS_IDS); float* gates = (float*)(p.ws + WS_GATES);
    const float* SVt = (const float*)(p.ws + WS_SV);
    LAS unsigned* myl = (LAS unsigned*)(lds + wave * 16384 + lane * 4);
    const float NEGINF = -INFINITY;
    for (int it = bid * NWAVES + wave; it < (NT / 32) * 8; it += nblk * NWAVES) {
        const int tt = it >> 3, h = it & 7, t = tt * 32 + r32;
        float K[2][16];
#pragma unroll
        for (int pp = 0; pp < 2; ++pp) {
            bf16x8_t qf[4];
            { const bf16* qp = PQ + (size_t)t * DM + h * 128 + pp * 64 + 8 * hi;
#pragma unroll
              for (int d0 = 0; d0 < 4; ++d0) qf[d0] = *(const bf16x8_t*)(qp + 16 * d0); }
            float g[4][16];
#pragma unroll
            for (int mt = 0; mt < 4; ++mt) {
                const bf16* kp = SK + ((size_t)((h * 2 + pp) * 4 + mt) * 4 * 64 + lane) * 8;
                f32x16 a = {0.f, 0.f, 0.f, 0.f, 0.f, 0.f, 0.f, 0.f, 0.f, 0.f, 0.f, 0.f, 0.f, 0.f, 0.f, 0.f};
#pragma unroll
                for (int d0 = 0; d0 < 4; ++d0) a = __builtin_amdgcn_mfma_f32_32x32x16_bf16(*(const bf16x8_t*)(kp + d0 * 512), qf[d0], a, 0, 0, 0);
#pragma unroll
                for (int r = 0; r < 16; ++r) g[mt][r] = fkeyf(a[r], 127u - (unsigned)(32 * mt + crow(r, hi)), 127u);
            }
            top16_of_64(g[0], g[1], g[2], g[3]);
            float o[16];
#pragma unroll
            for (int i = 0; i < 16; ++i) o[i] = __shfl_xor(g[0][i], 32);
            top16_merge(g[0], o);
#pragma unroll
            for (int i = 0; i < 16; ++i) K[pp][i] = g[0][i];
        }
#pragma unroll
        for (int i = 0; i < 16; ++i) { myl[i * 64] = __builtin_bit_cast(unsigned, K[0][i]); myl[(16 + i) * 64] = __builtin_bit_cast(unsigned, K[1][i]); }
        float v0[16], v1[16];
#pragma unroll
        for (int i = 0; i < 16; ++i) { v0[i] = fvalf(K[0][i], 127u); v1[i] = fvalf(K[1][i], 127u); }
        float cA[16], cB[16], cC[16], cD[16];
#pragma unroll
        for (int j = 0; j < 16; ++j) cA[j] = fkeyf(v0[0] + v1[j], 255u - (unsigned)j, 255u);
#pragma unroll
        for (int i = 1; i < 16; ++i) cB[i - 1] = fkeyf(v0[i] + v1[0], 255u - (unsigned)(16 * i), 255u);
        cB[15] = NEGINF;
#pragma unroll
        for (int q = 0; q < 16; ++q) { cC[q] = NEGINF; cD[q] = NEGINF; }
        { int n = 0;
#pragma unroll
          for (int i = 1; i < 8; ++i)
#pragma unroll
              for (int j = 1; j < 8; ++j) if ((i + 1) * (j + 1) <= 16) { const int m = stair2_slot(i, j); const float kv = fkeyf(v0[i] + v1[j], 255u - (unsigned)(16 * i + j), 255u); if (m < 16) cC[m] = kv; else cD[m - 16] = kv; }
          (void)n; }
        sort16_desc(cC);
        CE_DESC(cD[0], cD[1]); CE_DESC(cD[1], cD[2]); CE_DESC(cD[0], cD[1]);
        top16_merge(cA, cB); top16_merge(cC, cD); top16_merge(cA, cC);
        float e[16]; float sum = 0.f; const float mx = fvalf(cA[0], 255u);
#pragma unroll
        for (int r = 0; r < 16; ++r) { e[r] = __builtin_amdgcn_exp2f((fvalf(cA[r], 255u) - mx) * 1.4426950408889634f); sum += e[r]; }
        const float inv = __builtin_amdgcn_rcpf(sum);
        int eid[16];
#pragma unroll
        for (int r = 0; r < 16; ++r) { const unsigned id8 = 255u - (__builtin_bit_cast(unsigned, cA[r]) & 255u); const unsigned k0 = myl[(id8 >> 4) * 64], k1 = myl[(16 + (id8 & 15)) * 64];
            eid[r] = (int)((127u - (k0 & 127u)) * 128u + (127u - (k1 & 127u))); }
        int tq = t; asm volatile("" : "+v"(tq));
        if (hi == 0) {
#pragma unroll
            for (int q = 0; q < 2; ++q) *(v4u*)(ids + (size_t)tq * 128 + h * 16 + 8 * q) = (v4u){(unsigned)eid[8 * q] | ((unsigned)eid[8 * q + 1] << 16), (unsigned)eid[8 * q + 2] | ((unsigned)eid[8 * q + 3] << 16),
                                                                                      (unsigned)eid[8 * q + 4] | ((unsigned)eid[8 * q + 5] << 16), (unsigned)eid[8 * q + 6] | ((unsigned)eid[8 * q + 7] << 16)};
        } else {
#pragma unroll
            for (int q = 0; q < 4; ++q) *(f32x4*)(gates + (size_t)tq * 128 + h * 16 + 4 * q) = (f32x4){e[4 * q] * inv * SVt[eid[4 * q]], e[4 * q + 1] * inv * SVt[eid[4 * q + 1]], e[4 * q + 2] * inv * SVt[eid[4 * q + 2]], e[4 * q + 3] * inv * SVt[eid[4 * q + 3]]};
        }
    }
}

__device__ __forceinline__ void ph_ln1_fast(const Params& p, int bid, int nblk) {
    const bf16* y1 = (const bf16*)(p.ws + WS_Y1); bf16* x1 = (bf16*)(p.ws + WS_X1); bf16* h2b = (bf16*)(p.ws + WS_XN); const float* mod = (const float*)(p.ws + WS_MOD);
    const int lane = opaque_tid() & 63, wave = wave_id();
    for (int row = bid * NWAVES + wave; row < NT; row += nblk * NWAVES) {
        const int b = row / SEQ;
        const v2u* yr = (const v2u*)(y1 + (size_t)row * DM) + lane;
        f32x4 v[4]; float s = 0.f;
#pragma unroll
        for (int j = 0; j < 4; ++j) { const v2u w = yr[64 * j]; v[j] = (f32x4){bflo(w.x), bfhi(w.x), bflo(w.y), bfhi(w.y)}; s += (v[j].x + v[j].y) + (v[j].z + v[j].w); }
        float mean = wave_sum(s) * (1.f / DM); float s2 = 0.f;
#pragma unroll
        for (int j = 0; j < 4; ++j) { v[j] = v[j] - mean; s2 += (v[j].x * v[j].x + v[j].y * v[j].y) + (v[j].z * v[j].z + v[j].w * v[j].w); }
        float rstd = rsqrtf(wave_sum(s2) * (1.f / DM) + LN_EPS);
        s = 0.f;
#pragma unroll
        for (int j = 0; j < 4; ++j) { const f32x4 g = *((const f32x4*)p.g1 + lane + 64 * j), be = *((const f32x4*)p.be1 + lane + 64 * j);
            v[j] = v[j] * rstd * g + be; *((v2u*)(x1 + (size_t)row * DM) + lane + 64 * j) = (v2u){pk2(v[j].x, v[j].y), pk2(v[j].z, v[j].w)}; s += (v[j].x + v[j].y) + (v[j].z + v[j].w); }
        mean = wave_sum(s) * (1.f / DM); s2 = 0.f;
#pragma unroll
        for (int j = 0; j < 4; ++j) { v[j] = v[j] - mean; s2 += (v[j].x * v[j].x + v[j].y * v[j].y) + (v[j].z * v[j].z + v[j].w * v[j].w); }
        rstd = rsqrtf(wave_sum(s2) * (1.f / DM) + LN_EPS);
        float amax = 0.f;
#pragma unroll
        for (int j = 0; j < 4; ++j) {
            const f32x4 sh = *((const f32x4*)(mod + b * 6144 + 3072) + lane + 64 * j), sc = *((const f32x4*)(mod + b * 6144 + 4096) + lane + 64 * j);
            const f32x4 o = v[j] * rstd * (1.0f + sc) + sh; v[j] = o;
            amax = fmaxf(amax, fmaxf(fmaxf(fabsf(o.x), fabsf(o.y)), fmaxf(fabsf(o.z), fabsf(o.w))));
            *((v2u*)(h2b + (size_t)row * DM) + lane + 64 * j) = (v2u){pk2(o.x, o.y), pk2(o.z, o.w)};
        }
        amax = wave_max(amax); const float hinv = amax > 0.f ? 127.0f / amax : 0.f;
        unsigned* q4 = (unsigned*)(p.ws + WS_H2Q + (size_t)row * DM) + lane;
#pragma unroll
        for (int j = 0; j < 4; ++j) { unsigned q = 0u;
            q = __builtin_amdgcn_cvt_pk_u8_f32(v[j].x * hinv + 128.0f, 0, q); q = __builtin_amdgcn_cvt_pk_u8_f32(v[j].y * hinv + 128.0f, 1, q);
            q = __builtin_amdgcn_cvt_pk_u8_f32(v[j].z * hinv + 128.0f, 2, q); q = __builtin_amdgcn_cvt_pk_u8_f32(v[j].w * hinv + 128.0f, 3, q);
            q4[64 * j] = q ^ 0x80808080u; }
        if (lane == 0) ((float*)(p.ws + WS_HS))[row] = amax * (1.0f / 127.0f);
    }
}
__device__ __forceinline__ void ph_tables8(const Params& p, int bid, int nblk) {
    const int lane = opaque_tid() & 63, wave = wave_id();
    for (int r = bid * NWAVES + wave; r < 2 * 16384; r += nblk * NWAVES) {
        const bool isv = r >= 16384; const int row = isv ? r - 16384 : r;
        const f32x4* src = (const f32x4*)((isv ? p.pv : p.pu) + (size_t)row * DM + 16 * lane);
        f32x4 a[4]; float amax = 0.f;
#pragma unroll
        for (int j = 0; j < 4; ++j) { a[j] = src[j]; amax = fmaxf(amax, fmaxf(fmaxf(fabsf(a[j].x), fabsf(a[j].y)), fmaxf(fabsf(a[j].z), fabsf(a[j].w)))); }
        amax = wave_max(amax);
        const float inv = amax > 0.f ? 127.0f / amax : 0.f;
        v4u o;
#pragma unroll
        for (int j = 0; j < 4; ++j) { unsigned q = 0u;
            q = __builtin_amdgcn_cvt_pk_u8_f32(a[j].x * inv + 128.0f, 0, q); q = __builtin_amdgcn_cvt_pk_u8_f32(a[j].y * inv + 128.0f, 1, q);
            q = __builtin_amdgcn_cvt_pk_u8_f32(a[j].z * inv + 128.0f, 2, q); q = __builtin_amdgcn_cvt_pk_u8_f32(a[j].w * inv + 128.0f, 3, q);
            o[j] = q ^ 0x80808080u; }
        *(v4u*)(p.ws + (isv ? WS_TV8 : WS_TU8) + (size_t)(lane >> 3) * (2 * MiB) + (size_t)row * 128 + 16 * (lane & 7)) = o;
        if (lane == 0) ((float*)(p.ws + (isv ? WS_SV : WS_SU)))[row] = amax * (1.0f / 127.0f);
    }
}
__device__ __forceinline__ float readlane_f(float v, int l) { return __builtin_bit_cast(float, __builtin_amdgcn_readlane(__builtin_bit_cast(int, v), l)); }
__device__ __forceinline__ float ub0(unsigned u) { return (float)(u & 255u); }
__device__ __forceinline__ float ub1(unsigned u) { return (float)((u >> 8) & 255u); }
__device__ __forceinline__ float ub2(unsigned u) { return (float)((u >> 16) & 255u); }
__device__ __forceinline__ float ub3(unsigned u) { return (float)(u >> 24); }
__device__ __forceinline__ v4u ust_meta(const Params& p, int step, int t0, int stride8, int lane) {
    const int g = step >> 4, k = step & 15; int t = t0 + g * stride8 + (lane >> 3); t = t < NT ? t : NT - 1;
    return *(const v4u*)(p.ws + WS_IDS + (size_t)t * 256 + 16 * k);
}
__device__ __forceinline__ void ust_issue(v4u (&ub)[8], const v4u& idq, const unsigned char* TUs) {
#pragma unroll
    for (int e = 0; e < 8; ++e) { const unsigned w = idq[e >> 1]; const unsigned id = (e & 1) ? (w >> 16) : (w & 0xffffu); ub[e] = *(const v4u*)(TUs + (size_t)id * 128); }
}
__device__ __forceinline__ unsigned short ust_compute(const v4u (&ub)[8], const v4u& idq, const v4u& h0, const v4u& h1, int off8, const float* SUs, int lane) {
    int a[8];
#pragma unroll
    for (int e = 0; e < 8; ++e) { int v = 0;
#pragma unroll
        for (int j = 0; j < 4; ++j) { const unsigned d = ub[e][j]; const unsigned lo = d & 0x0f0f0f0fu, hi = (d >> 4) & 0x0f0f0f0fu;
            const unsigned hl = j < 2 ? h0[2 * j] : h1[2 * j - 4], hh = j < 2 ? h0[2 * j + 1] : h1[2 * j - 3];
            v = __builtin_amdgcn_sdot4((int)lo, (int)hl, v, false); v = __builtin_amdgcn_sdot4((int)hi, (int)hh, v, false); }
        a[e] = v; }
    int a4[4];
#pragma unroll
    for (int k = 0; k < 4; ++k) { const bool up = (lane & 4) != 0; const int keep = up ? a[k + 4] : a[k], send = up ? a[k] : a[k + 4]; a4[k] = keep + __shfl_xor(send, 4); }
    int a2[2];
#pragma unroll
    for (int k = 0; k < 2; ++k) { const bool up = (lane & 2) != 0; const int keep = up ? a4[k + 2] : a4[k], send = up ? a4[k] : a4[k + 2]; a2[k] = keep + __shfl_xor(send, 2); }
    const bool up = (lane & 1) != 0; const int keep = up ? a2[1] : a2[0], send = up ? a2[0] : a2[1];
    const int tot = keep + __shfl_xor(send, 1);
    const int c = lane & 7; const unsigned w2 = (c >> 1) == 0 ? idq.x : ((c >> 1) == 1 ? idq.y : ((c >> 1) == 2 ? idq.z : idq.w));
    const unsigned id = (c & 1) ? (w2 >> 16) : (w2 & 0xffffu);
    return (unsigned short)f2bf((float)(tot - off8) * SUs[id]);
}
__device__ __forceinline__ void ph_udot(const Params& p, int bid, int nblk) {
    unsigned short* P = (unsigned short*)(p.ws + WS_PART);
    const int lane = opaque_tid() & 63, wave = wave_id(), c = lane & 7;
    const int s8 = bid & 7, s = s8 & 3;
    const int nlo = (nblk - s + 7) >> 3, nhi = (nblk - (s + 4) + 7) >> 3;
    const int widx = ((s8 >> 2) ? nlo : 0) * NWAVES + (bid >> 3) * NWAVES + wave, stride8 = (nlo + nhi) * NWAVES * 8;
    const unsigned char* TUs = p.ws + WS_TU8 + (size_t)s * (2 * MiB) + 16 * c;
    const float* SUs = (const float*)(p.ws + WS_SU) + (size_t)s * 16384;
    const int t0 = widx * 8;
    const int ngroups = t0 < NT ? (NT - t0 + stride8 - 1) / stride8 : 0, nsteps = ngroups * 16;
    if (nsteps == 0) return;
    v4u uA[8], uB[8];
    v4u qa = ust_meta(p, 0, t0, stride8, lane);
    ust_issue(uA, qa, TUs);
    v4u qb = ust_meta(p, 1, t0, stride8, lane);
    v4u h0 = {0u, 0u, 0u, 0u}, h1 = {0u, 0u, 0u, 0u}; int off8 = 0;
    for (int st = 0; st < nsteps; st += 2) {
        const int tg = t0 + (st >> 4) * stride8 + (lane >> 3); const int t = tg < NT ? tg : NT - 1;
        if ((st & 15) == 0) {
            const unsigned char* hp = p.ws + WS_H2Q + (size_t)t * DM + 256 * s + 32 * c; h0 = *(const v4u*)hp; h1 = *(const v4u*)(hp + 16);
            int hs = 0;
#pragma unroll
            for (int j = 0; j < 4; ++j) { hs = __builtin_amdgcn_sdot4((int)h0[j], 0x01010101, hs, false); hs = __builtin_amdgcn_sdot4((int)h1[j], 0x01010101, hs, false); }
            hs += __shfl_xor(hs, 1); hs += __shfl_xor(hs, 2); hs += __shfl_xor(hs, 4); off8 = 8 * hs;
        }
        ust_issue(uB, qb, TUs);
        const v4u ia = qa; qa = ust_meta(p, st + 2 < nsteps ? st + 2 : st, t0, stride8, lane);
        const unsigned short ra = ust_compute(uA, ia, h0, h1, off8, SUs, lane);
        if (st + 2 < nsteps) ust_issue(uA, qa, TUs);
        const v4u ib = qb; qb = ust_meta(p, st + 3 < nsteps ? st + 3 : st + 1, t0, stride8, lane);
        const unsigned short rb = ust_compute(uB, ib, h0, h1, off8, SUs, lane);
        if (tg < NT) { unsigned short* dst = P + ((size_t)t * 4 + s) * 128 + 8 * (st & 15) + c; dst[0] = ra; dst[8] = rb; }
    }
}
__device__ __forceinline__ void ph_act(const Params& p, int bid, int nblk) {
    const bf16* P = (const bf16*)(p.ws + WS_PART); const float* GS = (const float*)(p.ws + WS_GATES); const float* HS = (const float*)(p.ws + WS_HS);
    unsigned char* WQ = p.ws + WS_WQ; float* WSC = (float*)(p.ws + WS_WSC);
    const int lane = opaque_tid() & 63, wave = wave_id();
    for (int t = bid * NWAVES + wave; t < NT; t += nblk * NWAVES) {
        float a0 = 0.f, a1 = 0.f;
#pragma unroll
        for (int s = 0; s < 4; ++s) { a0 += __builtin_bit_cast(float, (unsigned)P[((size_t)t * 4 + s) * 128 + lane] << 16); a1 += __builtin_bit_cast(float, (unsigned)P[((size_t)t * 4 + s) * 128 + 64 + lane] << 16); }
        const float hs = HS[t];
        const float d0 = a0 * hs, d1 = a1 * hs;
        const float w0 = GS[(size_t)t * 128 + lane] * 0.5f * d0 * (1.0f + erff(d0 * 0.70710678118654752f));
        const float w1 = GS[(size_t)t * 128 + 64 + lane] * 0.5f * d1 * (1.0f + erff(d1 * 0.70710678118654752f));
        const float wmax = wave_max(fmaxf(fabsf(w0), fabsf(w1))); const float winv = wmax > 0.f ? 127.0f / wmax : 0.f;
        unsigned b2 = __builtin_amdgcn_cvt_pk_u8_f32(w0 * winv + 128.0f, 0, 0u); b2 = __builtin_amdgcn_cvt_pk_u8_f32(w1 * winv + 128.0f, 1, b2); b2 ^= 0x8080u;
        WQ[(size_t)t * 128 + lane] = (unsigned char)(b2 & 255u); WQ[(size_t)t * 128 + 64 + lane] = (unsigned char)((b2 >> 8) & 255u);
        if (lane == 0) WSC[t] = wmax * (1.0f / 127.0f);
    }
}
struct VstepMeta { v4u idq; v2u wq; };
__device__ __forceinline__ VstepMeta vst_meta(const Params& p, int step, int t0, int stride8, int lane) {
    const int g = step >> 4, k = step & 15; int t = t0 + g * stride8 + (lane >> 3); t = t < NT ? t : NT - 1;
    VstepMeta r; r.idq = *(const v4u*)(p.ws + WS_IDS + (size_t)t * 256 + 16 * k); r.wq = *(const v2u*)(p.ws + WS_WQ + (size_t)t * 128 + 8 * k); return r;
}
__device__ __forceinline__ void vst_issue(v4u (&vb)[8], const VstepMeta& q, const unsigned char* TVs) {
#pragma unroll
    for (int e = 0; e < 8; ++e) { const unsigned w = q.idq[e >> 1]; const unsigned id = (e & 1) ? (w >> 16) : (w & 0xffffu); vb[e] = *(const v4u*)(TVs + (size_t)id * 128); }
}
__device__ __forceinline__ void vst_compute(int (&y)[16], const v4u (&vb)[8], const v2u& wq) {
#pragma unroll
    for (int qd = 0; qd < 2; ++qd)
#pragma unroll
        for (int cm = 0; cm < 4; ++cm) {
            const unsigned A = vb[4 * qd][cm], B = vb[4 * qd + 1][cm], C = vb[4 * qd + 2][cm], D = vb[4 * qd + 3][cm];
            const unsigned ab01 = __builtin_amdgcn_perm(B, A, 0x05010400u), ab23 = __builtin_amdgcn_perm(B, A, 0x07030602u);
            const unsigned cd01 = __builtin_amdgcn_perm(D, C, 0x05010400u), cd23 = __builtin_amdgcn_perm(D, C, 0x07030602u);
            const unsigned t0 = __builtin_amdgcn_perm(cd01, ab01, 0x05040100u), t1 = __builtin_amdgcn_perm(cd01, ab01, 0x07060302u);
            const unsigned t2 = __builtin_amdgcn_perm(cd23, ab23, 0x05040100u), t3 = __builtin_amdgcn_perm(cd23, ab23, 0x07060302u);
            y[4 * cm + 0] = __builtin_amdgcn_sdot4((int)t0, (int)wq[qd], y[4 * cm + 0], false); y[4 * cm + 1] = __builtin_amdgcn_sdot4((int)t1, (int)wq[qd], y[4 * cm + 1], false);
            y[4 * cm + 2] = __builtin_amdgcn_sdot4((int)t2, (int)wq[qd], y[4 * cm + 2], false); y[4 * cm + 3] = __builtin_amdgcn_sdot4((int)t3, (int)wq[qd], y[4 * cm + 3], false);
        }
}
__device__ __forceinline__ void ph_vacc(const Params& p, int bid, int nblk) {
    bf16* Y = (bf16*)(p.ws + WS_Y); const float* WSC = (const float*)(p.ws + WS_WSC);
    const int lane = opaque_tid() & 63, wave = wave_id(), c = lane & 7;
    const int s = bid & 7, nper = (nblk - s + 7) >> 3,     stride8 = nper * NWAVES * 8;
    const unsigned char* TVs = p.ws + WS_TV8 + (size_t)s * (2 * MiB) + 16 * c;
    const int t0 = ((bid >> 3) * NWAVES + wave) * 8;
    const int ngroups = t0 < NT ? (NT - t0 + stride8 - 1) / stride8 : 0, nsteps = ngroups * 16;
    if (nsteps == 0) return;
    int y[16];
#pragma unroll
    for (int k = 0; k < 16; ++k) y[k] = 0;
    v4u vA[8], vB[8];
    VstepMeta qa = vst_meta(p, 0, t0, stride8, lane);
    vst_issue(vA, qa, TVs);
    VstepMeta qb = vst_meta(p, 1, t0, stride8, lane);
    for (int st = 0; st < nsteps; st += 2) {
        vst_issue(vB, qb, TVs);
        const v2u wa = qa.wq; qa = vst_meta(p, st + 2 < nsteps ? st + 2 : st, t0, stride8, lane);
        vst_compute(y, vA, wa);
        if (st + 2 < nsteps) vst_issue(vA, qa, TVs);
        const v2u wb = qb.wq; qb = vst_meta(p, st + 3 < nsteps ? st + 3 : st + 1, t0, stride8, lane);
        vst_compute(y, vB, wb);
        if (((st + 1) & 15) == 15) {
            const int t = t0 + (st >> 4) * stride8 + (lane >> 3);
            if (t < NT) { const float sc = WSC[t];
                v4u o0, o1; o0.x = pk2((float)y[0] * sc, (float)y[1] * sc); o0.y = pk2((float)y[2] * sc, (float)y[3] * sc); o0.z = pk2((float)y[4] * sc, (float)y[5] * sc); o0.w = pk2((float)y[6] * sc, (float)y[7] * sc);
                o1.x = pk2((float)y[8] * sc, (float)y[9] * sc); o1.y = pk2((float)y[10] * sc, (float)y[11] * sc); o1.z = pk2((float)y[12] * sc, (float)y[13] * sc); o1.w = pk2((float)y[14] * sc, (float)y[15] * sc);
                v4u* dst = (v4u*)(Y + (size_t)t * DM + 128 * s + 16 * c); dst[0] = o0; dst[1] = o1; }
#pragma unroll
            for (int k = 0; k < 16; ++k) y[k] = 0;
        }
    }
}
__device__ __forceinline__ void ph_final(const Params& p, int bid, int nblk) {
    const bf16* x1 = (const bf16*)(p.ws + WS_X1); const bf16* Y = (const bf16*)(p.ws + WS_Y); const float* mod = (const float*)(p.ws + WS_MOD);
    const int lane = opaque_tid() & 63, wave = wave_id();
    for (int t = bid * NWAVES + wave; t < NT; t += nblk * NWAVES) {
        const int b = t / SEQ;
        f32x4 v[4]; float s = 0.f;
#pragma unroll
        for (int j = 0; j < 4; ++j) { const v2u xw = *((const v2u*)(x1 + (size_t)t * DM) + lane + 64 * j), yw = *((const v2u*)(Y + (size_t)t * DM) + lane + 64 * j);
            const f32x4 g2 = *((const f32x4*)(mod + b * 6144 + 5120) + lane + 64 * j);
            const f32x4 xv = {bflo(xw.x), bfhi(xw.x), bflo(xw.y), bfhi(xw.y)}, yv = {bflo(yw.x), bfhi(yw.x), bflo(yw.y), bfhi(yw.y)};
            v[j] = xv * ALPHA + (g2 + 1.0f) * yv; s += (v[j].x + v[j].y) + (v[j].z + v[j].w); }
        const float mean = wave_sum(s) * (1.f / DM); float s2 = 0.f;
#pragma unroll
        for (int j = 0; j < 4; ++j) { v[j] = v[j] - mean; s2 += (v[j].x * v[j].x + v[j].y * v[j].y) + (v[j].z * v[j].z + v[j].w * v[j].w); }
        const float rstd = rsqrtf(wave_sum(s2) * (1.f / DM) + LN_EPS);
#pragma unroll
        for (int j = 0; j < 4; ++j) { const f32x4 g = *((const f32x4*)p.g2 + lane + 64 * j), be = *((const f32x4*)p.be2 + lane + 64 * j);
            *((f32x4*)(p.out + (size_t)t * DM) + lane + 64 * j) = v[j] * rstd * g + be; }
    }
}

#ifndef PROBE_ID
#define PROBE_ID 0
#endif
#define RUN2(id, ...) do { __VA_ARGS__; if (PROBE_ID == (id)) { xcd_barrier(bar); __VA_ARGS__; } } while (0)
__global__ void __launch_bounds__(NTHREADS, 2) mega(Params p) {
    extern __shared__ __attribute__((aligned(16))) unsigned char lds_raw[];

    LAS unsigned char* lds = (LAS unsigned char*)lds_raw;
    const int bid = blockIdx.x, nblk = gridDim.x, tid = opaque_tid();
    for (int u = tid; u < (LDS_BYTES - LDSCTL_OFF) / 4; u += NTHREADS) ((LAS unsigned*)(lds + LDSCTL_OFF))[u] = 0u;
    __syncthreads();
    unsigned* ctl = (unsigned*)(p.ws + WS_CTL);
    XcdBarrier bar = xcd_barrier_post(ctl + CW_BAR, (volatile LAS unsigned*)(lds + MISC_OFF) + 8);
    const float* mod = (const float*)(p.ws + WS_MOD);

    ph_mod(p, lds, bid, nblk);
    xcd_barrier(bar);
    RUN2(1, ph_prologue(p, lds, bid, nblk));
    RUN2(7, ph_xn(p, bid, nblk));
    xcd_barrier(bar);
    {
        pg8::Gemm g{(const pg8::bf16_t*)(p.ws + WS_XN), (const pg8::bf16_t*)(p.ws + WS_WIN), NT, NIN, DM}; pg8::StaticOrder S; S.init(NT, NIN, nblk, bid);
        EpiIn E{(bf16*)(p.ws + WS_FZ), (bf16*)(p.ws + WS_QB), (const float*)(p.ws + WS_MISC), (const float*)(p.ws + WS_ROPE)};
        pg8::gemm_phase<EpiIn, pg8::StaticOrder, true, true>(lds, g, S, E);
    }
    xcd_barrier(bar);
    RUN2(8, ph_fft(p, lds, bid, nblk));
    RUN2(2, ph_attn_fast(p, lds, bid, nblk));
    xcd_barrier(bar);
    RUN2(3, ph_merge(p, bid, nblk));
    xcd_barrier(bar);
    {
        pg8::Gemm g{(const pg8::bf16_t*)(p.ws + WS_XN), (const pg8::bf16_t*)(p.ws + WS_WOUT), NT, DM, DM}; pg8::StaticOrder S; S.init(NT, DM, nblk, bid);
        EpiOut E{(bf16*)(p.ws + WS_Y1), p.x, mod, p.b_out};
        pg8::gemm_phase<EpiOut, pg8::StaticOrder, true, true>(lds, g, S, E);
    }
    xcd_barrier(bar);
    RUN2(4, ph_ln1_fast(p, bid, nblk));
    xcd_barrier(bar);
    {
        pg8::Gemm g{(const pg8::bf16_t*)(p.ws + WS_XN), (const pg8::bf16_t*)(p.ws + WS_WPQ), NT, DM, DM}; pg8::StaticOrder S; S.init(NT, DM, nblk, bid);
        pg8::EpiBf16<0> E{(pg8::bf16_t*)(p.ws + WS_PQ), DM, nullptr, 0, 0, 1.f};
        pg8::gemm_phase<pg8::EpiBf16<0>, pg8::StaticOrder, true, true>(lds, g, S, E);
    }
    xcd_barrier(bar);
    RUN2(5, ph_topk_fast(p, lds, bid, nblk));
    xcd_barrier(bar);
    RUN2(6, ph_udot(p, bid, nblk));
    xcd_barrier(bar);
    RUN2(11, ph_act(p, bid, nblk));
    xcd_barrier(bar);
    RUN2(10, ph_vacc(p, bid, nblk));
    xcd_barrier(bar);
    ph_final(p, bid, nblk);
}

extern "C" void kernel_launch(void* const* d_in, const int* in_sizes, int n_in, void* d_out, int out_size, void* d_ws, size_t ws_size, hipStream_t stream) {
    Params p{};
    p.x = (const float*)d_in[0]; p.c = (const float*)d_in[1]; p.pos = (const int*)d_in[2]; p.w_ada = (const float*)d_in[3]; p.b_ada = (const float*)d_in[4];
    p.w_in = (const float*)d_in[5]; p.b_in = (const float*)d_in[6]; p.w_four = (const float*)d_in[7]; p.w_out = (const float*)d_in[8]; p.b_out = (const float*)d_in[9];
    p.g1 = (const float*)d_in[10]; p.be1 = (const float*)d_in[11]; p.w_pq = (const float*)d_in[12]; p.subk = (const float*)d_in[13]; p.pu = (const float*)d_in[14]; p.pv = (const float*)d_in[15];
    p.g2 = (const float*)d_in[16]; p.be2 = (const float*)d_in[17]; p.out = (float*)d_out; p.ws = (unsigned char*)d_ws;
    static int grid_blocks = 0;
    if (grid_blocks == 0) {
        if (ws_size < WS_END) { fprintf(stderr, "workspace too small: %zu < %zu\n", ws_size, (size_t)WS_END); grid_blocks = -1; return; }
        int dev = 0, cus = 0, per_cu = 0;
        if (hipGetDevice(&dev) != hipSuccess || hipDeviceGetAttribute(&cus, hipDeviceAttributeMultiprocessorCount, dev) != hipSuccess) { grid_blocks = -1; return; }
        if (hipFuncSetAttribute((const void*)mega, hipFuncAttributeMaxDynamicSharedMemorySize, LDS_BYTES) != hipSuccess) { fprintf(stderr, "hipFuncSetAttribute failed\n"); grid_blocks = -1; return; }
        if (hipOccupancyMaxActiveBlocksPerMultiprocessor(&per_cu, (const void*)mega, NTHREADS, LDS_BYTES) != hipSuccess || per_cu < 1) { fprintf(stderr, "occupancy query: %d\n", per_cu); grid_blocks = -1; return; }
        grid_blocks = cus;
    }
    if (grid_blocks < 0) return;
    if (hipMemsetAsync((char*)d_ws + WS_CTL, 0, CTL_ZERO_BYTES, stream) != hipSuccess) { fprintf(stderr, "memset failed\n"); return; }
    void* args[] = {&p};
    hipError_t e = hipLaunchCooperativeKernel((void*)mega, dim3(grid_blocks), dim3(NTHREADS), args, LDS_BYTES, stream);
    if (e != hipSuccess) fprintf(stderr, "cooperative launch failed: %s (grid %d)\n", hipGetErrorString(e), grid_blocks);
}
```

```cpp
#include <hip/hip_runtime.h>
#include <hip/hip_cooperative_groups.h>
#include <cstdio>
#include <cstdint>
#include <cmath>
namespace cg = cooperative_groups;

namespace pg8 {
#define PG8_LAS __attribute__((address_space(3)))
typedef unsigned short bf16_t;
typedef short bf16x8 __attribute__((ext_vector_type(8)));
typedef float f32x4 __attribute__((ext_vector_type(4)));
typedef unsigned u32x4 __attribute__((ext_vector_type(4)));
constexpr int BM = 256, BK = 64, HALF = 128, HTB = HALF * BK * 2  , STAGE_BYTES = 8 * HTB, NXCD = 8, WGM = 8;

__host__ __device__ __forceinline__ int lds_byte(int r, int c) { const int st = (r >> 4) * 2 + (c >> 5), rr = r & 15, cc = c & 31, ob = rr * 64 + cc * 2; return st * 1024 + (ob ^ (((ob >> 9) & 1) << 5)); }
__host__ __device__ __forceinline__ void stage_rc(int b, int& R, int& C) { const int st = b / 1024, sb = b % 1024, swz = sb ^ (((sb >> 9) & 1) << 5); R = (st >> 1) * 16 + swz / 64; C = (st & 1) * 32 + (swz % 64) / 2; }
__host__ __device__ __forceinline__ int perm32(int rho) { const int n = rho >> 4, i = rho & 15; return 8 * (i >> 2) + 4 * n + (i & 3); }

struct Unit { int pm, pn; };
struct Gemm { const bf16_t* A; const bf16_t* Bt; int M, N, K; };

struct StaticOrder {
    int nM, nN, nwg, G, c;
    __host__ __device__ void init(int M, int N, int G_, int c_) { nM = M / BM; nN = N / BM; nwg = nM * nN; G = G_; c = c_; }
    __host__ __device__ bool next(int i, Unit& u) const {
        const long L = (long)i * G + c; if (L >= nwg) return false;
        int wgid = (int)L; { const int q = nwg / NXCD, r = nwg % NXCD, xcd = wgid % NXCD, off = wgid / NXCD; wgid = (xcd < r ? xcd * (q + 1) : r * (q + 1) + (xcd - r) * q) + off; }
        const int nig = WGM * nN, gid = wgid / nig, fm = gid * WGM, gsz = (nM - fm) < WGM ? (nM - fm) : WGM;
        u.pm = fm + ((wgid % nig) % gsz); u.pn = (wgid % nig) / gsz; return true;
    }
    __device__ __forceinline__ void a_ready(const Unit&) const {}
    __device__ __forceinline__ void done(const Unit&) const {}
};

__device__ __forceinline__ unsigned cvt_pk_bf16(float lo, float hi) { unsigned r; asm volatile("v_cvt_pk_bf16_f32 %0, %1, %2" : "=v"(r) : "v"(lo), "v"(hi)); return r; }
typedef float f32x2 __attribute__((ext_vector_type(2)));
__device__ __forceinline__ f32x2 gelu_pk(f32x2 v) {
    const f32x2 av = __builtin_elementwise_abs(v), d = av * 0.2316418882f + 1.0f;
    f32x2 t; t.x = __builtin_amdgcn_rcpf(d.x); t.y = __builtin_amdgcn_rcpf(d.y);
    f32x2 q = t * 0.5307027145f + (-0.7265760135f); q = q * t + 0.7107068705f; q = q * t + (-0.142248368f); q = q * t + 0.127414796f; q = q * t;
    const f32x2 s = (v * v) * (-0.72134752044f);
    f32x2 e; e.x = __builtin_amdgcn_exp2f(s.x); e.y = __builtin_amdgcn_exp2f(s.y);
    const f32x2 m = v * (q * e), r = v - m;
    f32x2 o; o.x = v.x < 0.f ? m.x : r.x; o.y = v.y < 0.f ? m.y : r.y; return o;
}

template <int ACT  > struct EpiBf16 {
    static constexpr bool PERM = true, AFTER_DRAIN = false; static_assert(ACT == 0 || ACT == 1, "EpiBf16: ACT is 0 (none) or 1 (gelu_pk)");
    bf16_t* O; int ldc; const float* bias; int split_cols; size_t split_stride; float scale0;
    __device__ __forceinline__ void operator()(const f32x4 (&acc)[2][2][4][2], const Unit& u, int wr, int wc, int fr, int fq) const {
        const int row0 = u.pm * BM + wr * 64 + fr; int colt = u.pn * BM; bf16_t* base = O;
        float sc = 1.f; if (split_cols) { const int t = colt / split_cols; base += (size_t)t * split_stride; colt -= t * split_cols; if (t == 0) sc = scale0; }
        const int col0 = colt + wc * 32 + 8 * fq, bcol0 = u.pn * BM + wc * 32 + 8 * fq;
        f32x4 bv[2][2];
#pragma unroll
        for (int bj = 0; bj < 2; ++bj)
#pragma unroll
            for (int n = 0; n < 2; ++n) bv[bj][n] = bias ? *(const f32x4*)(bias + bcol0 + bj * HALF + 4 * n) : (f32x4){0.f, 0.f, 0.f, 0.f};
#pragma unroll
        for (int ai = 0; ai < 2; ++ai)
#pragma unroll
            for (int m = 0; m < 4; ++m) { bf16_t* rowp = base + (size_t)(row0 + ai * HALF + m * 16) * ldc + col0;
#pragma unroll
                for (int bj = 0; bj < 2; ++bj) { f32x4 v0 = acc[ai][bj][m][0] + bv[bj][0], v1 = acc[ai][bj][m][1] + bv[bj][1];
                    if (ACT == 1) { f32x2 a = gelu_pk((f32x2){v0[0], v0[1]}), b = gelu_pk((f32x2){v0[2], v0[3]}), c = gelu_pk((f32x2){v1[0], v1[1]}), d = gelu_pk((f32x2){v1[2], v1[3]});
                        v0 = (f32x4){a.x, a.y, b.x, b.y}; v1 = (f32x4){c.x, c.y, d.x, d.y}; }
                    v0 = v0 * sc; v1 = v1 * sc; u32x4 w; w.x = cvt_pk_bf16(v0[0], v0[1]); w.y = cvt_pk_bf16(v0[2], v0[3]); w.z = cvt_pk_bf16(v1[0], v1[1]); w.w = cvt_pk_bf16(v1[2], v1[3]);
                    *(u32x4*)(rowp + bj * HALF) = w; } }
    }
};
template <class Epi, class Sched, bool ALIGN_EPI = false, bool SP2 = false>
__device__ __forceinline__ void gemm_phase(PG8_LAS unsigned char* lds, const Gemm g, const Sched& S, const Epi& E) {
    int tid_ = threadIdx.x; asm volatile("" : "+v"(tid_)); const int tid = tid_, wid = __builtin_amdgcn_readfirstlane(tid >> 6), lane = tid & 63, wr = wid >> 2, wc = wid & 3, fr = lane & 15, fq = lane >> 4;
    const int K = g.K, nt = K / BK;
    unsigned voffA[2], voffB[2];
#pragma unroll
    for (int i = 0; i < 2; ++i) { int R, C; stage_rc(tid * 16 + i * 8192, R, C); const int Rb = Epi::PERM ? ((R & ~31) + perm32(R & 31)) : R;
        voffA[i] = (unsigned)(R * K + C) * 2u; voffB[i] = (unsigned)(Rb * K + C) * 2u; }
    const size_t kstep = (size_t)(BK * 2);
    const size_t hstep = (size_t)HALF * K * 2;
    const size_t tstep = 2 * hstep;
    const unsigned ldsw = (unsigned)wid * 1024u;
    const int aoff = lds_byte(wr * 64 + fr, fq * 8), boff = lds_byte(wc * 32 + fr, fq * 8);
#define PG8_SA(b, h) (((b) * 2 + (h)) * HTB)
#define PG8_SB(b, h) ((4 + (b) * 2 + (h)) * HTB)
#define PG8_STAGE(bufoff, gbase, voff) do { _Pragma("unroll") for (int _i = 0; _i < 2; ++_i) \
        __builtin_amdgcn_global_load_lds((const unsigned*)((const char*)(gbase) + (voff)[_i]), (PG8_LAS unsigned*)(lds + (bufoff) + ldsw + _i * 8192), 16, 0, 0); } while (0)
#define PG8_LDA(dst, b, h) do { _Pragma("unroll") for (int m = 0; m < 4; ++m) _Pragma("unroll") for (int k = 0; k < 2; ++k) dst[m][k] = *(const PG8_LAS bf16x8*)(lds + PG8_SA(b, h) + aoff + m * 2048 + k * 1024); } while (0)
#define PG8_LDB(dst, b, h) do { _Pragma("unroll") for (int n = 0; n < 2; ++n) _Pragma("unroll") for (int k = 0; k < 2; ++k) dst[n][k] = *(const PG8_LAS bf16x8*)(lds + PG8_SB(b, h) + boff + n * 2048 + k * 1024); } while (0)
#define PG8_MMA(ai, bj, At, Bt) do { __builtin_amdgcn_s_setprio(1); _Pragma("unroll") for (int m = 0; m < 4; ++m) _Pragma("unroll") for (int n = 0; n < 2; ++n) _Pragma("unroll") for (int k = 0; k < 2; ++k) \
        acc[ai][bj][m][n] = __builtin_amdgcn_mfma_f32_16x16x32_bf16(Bt[n][k], At[m][k], acc[ai][bj][m][n], 0, 0, 0); __builtin_amdgcn_s_setprio(0); } while (0)
#define PG8_WAIT_V(n) asm volatile("s_waitcnt vmcnt(" #n ")" ::: "memory")
#define PG8_WAIT_L(n) asm volatile("s_waitcnt lgkmcnt(" #n ")" ::: "memory")
#define PG8_BAR __builtin_amdgcn_s_barrier()
#define PG8_SCHED __builtin_amdgcn_sched_barrier(0)
    Unit cur, nxt; int ui = 0;
    if (!S.next(0, cur)) return;
    f32x4 acc[2][2][4][2];
#pragma unroll
    for (int a = 0; a < 2; ++a)
#pragma unroll
        for (int b = 0; b < 2; ++b)
#pragma unroll
            for (int m = 0; m < 4; ++m)
#pragma unroll
                for (int n = 0; n < 2; ++n) acc[a][b][m][n] = (f32x4){0.f, 0.f, 0.f, 0.f};
    bf16x8 At[4][2], B0[2][2], B1[2][2];
    const char* cA = (const char*)g.A + (size_t)cur.pm * tstep; const char* cB = (const char*)g.Bt + (size_t)cur.pn * tstep;
    S.a_ready(cur);
    if constexpr (SP2) {
        PG8_STAGE(PG8_SB(0, 0), cB, voffB); PG8_STAGE(PG8_SB(0, 1), cB + hstep, voffB); PG8_STAGE(PG8_SA(0, 0), cA, voffA); PG8_STAGE(PG8_SA(0, 1), cA + hstep, voffA);
        if (wr == 1) PG8_BAR;
        PG8_WAIT_V(2); PG8_BAR;
        PG8_STAGE(PG8_SB(1, 0), cB + kstep, voffB); PG8_STAGE(PG8_SA(1, 0), cA + kstep, voffA); PG8_STAGE(PG8_SB(1, 1), cB + hstep + kstep, voffB);
        PG8_WAIT_V(6); PG8_BAR;
    } else {
        PG8_STAGE(PG8_SB(0, 0), cB, voffB); PG8_STAGE(PG8_SA(0, 0), cA, voffA); PG8_STAGE(PG8_SB(0, 1), cB + hstep, voffB); PG8_STAGE(PG8_SA(0, 1), cA + hstep, voffA);
        if (wr == 1) PG8_BAR;
        PG8_WAIT_V(4); PG8_BAR;
        PG8_STAGE(PG8_SB(1, 0), cB + kstep, voffB); PG8_STAGE(PG8_SA(1, 0), cA + kstep, voffA); PG8_STAGE(PG8_SB(1, 1), cB + hstep + kstep, voffB);
        PG8_WAIT_V(6); PG8_BAR;
    }
    for (;;) {
        const bool has_next = S.next(ui + 1, nxt);
        const char* nA = has_next ? (const char*)g.A + (size_t)nxt.pm * tstep : cA; const char* nB = has_next ? (const char*)g.Bt + (size_t)nxt.pn * tstep : cB;
        for (int t = 0; t < nt; t += 2) {
            const bool last = (t == nt - 2);
            const char* a1 = cA + (size_t)(t + 1) * kstep;
            const char* a2 = last ? nA : cA + (size_t)(t + 2) * kstep; const char* b2 = last ? nB : cB + (size_t)(t + 2) * kstep;
            const char* a3 = a2 + kstep; const char* b3 = b2 + kstep;
            if (last && has_next) S.a_ready(nxt);
            if constexpr (SP2) {
            PG8_LDB(B0, 0, 0); PG8_LDB(B1, 0, 1); PG8_SCHED; PG8_LDA(At, 0, 0); PG8_STAGE(PG8_SA(1, 1), a1 + hstep, voffA);
            PG8_WAIT_V(8); PG8_WAIT_L(0); PG8_BAR; PG8_MMA(0, 0, At, B0); PG8_MMA(0, 1, At, B1); PG8_BAR; PG8_SCHED;
            PG8_LDA(At, 0, 1); PG8_STAGE(PG8_SB(0, 0), b2, voffB); PG8_STAGE(PG8_SB(0, 1), b2 + hstep, voffB); PG8_STAGE(PG8_SA(0, 0), a2, voffA);
            PG8_WAIT_V(8); PG8_WAIT_L(0); PG8_BAR; PG8_MMA(1, 0, At, B0); PG8_MMA(1, 1, At, B1); PG8_BAR; PG8_SCHED;
            PG8_LDB(B0, 1, 0); PG8_LDB(B1, 1, 1); PG8_SCHED; PG8_LDA(At, 1, 0); PG8_STAGE(PG8_SA(0, 1), a2 + hstep, voffA);
            PG8_WAIT_V(8); PG8_WAIT_L(0); PG8_BAR; PG8_MMA(0, 0, At, B0); PG8_MMA(0, 1, At, B1); PG8_BAR; PG8_SCHED;
            PG8_LDA(At, 1, 1); PG8_STAGE(PG8_SB(1, 0), b3, voffB); PG8_STAGE(PG8_SB(1, 1), b3 + hstep, voffB); PG8_STAGE(PG8_SA(1, 0), a3, voffA);
            PG8_WAIT_V(8); PG8_WAIT_L(0); PG8_BAR; PG8_MMA(1, 0, At, B0); PG8_MMA(1, 1, At, B1); PG8_BAR; PG8_SCHED;
            } else {
            PG8_LDB(B0, 0, 0); PG8_SCHED; PG8_LDA(At, 0, 0); PG8_STAGE(PG8_SA(1, 1), a1 + hstep, voffA);
            PG8_WAIT_L(8); PG8_BAR; PG8_WAIT_L(0); PG8_MMA(0, 0, At, B0); PG8_BAR; PG8_SCHED;
            PG8_LDB(B1, 0, 1); PG8_STAGE(PG8_SB(0, 0), b2, voffB);
            PG8_BAR; PG8_WAIT_L(0); PG8_MMA(0, 1, At, B1); PG8_BAR;
            PG8_LDA(At, 0, 1); PG8_STAGE(PG8_SA(0, 0), a2, voffA);
            PG8_BAR; PG8_WAIT_L(0); PG8_MMA(1, 0, At, B0); PG8_BAR; PG8_SCHED;
            PG8_STAGE(PG8_SB(0, 1), b2 + hstep, voffB);
            PG8_WAIT_V(6); PG8_BAR; PG8_MMA(1, 1, At, B1); PG8_BAR;
            PG8_LDB(B0, 1, 0); PG8_SCHED; PG8_LDA(At, 1, 0); PG8_STAGE(PG8_SA(0, 1), a2 + hstep, voffA);
            PG8_WAIT_L(8); PG8_BAR; PG8_WAIT_L(0); PG8_MMA(0, 0, At, B0); PG8_BAR; PG8_SCHED;
            PG8_LDB(B1, 1, 1); PG8_STAGE(PG8_SB(1, 0), b3, voffB);
            PG8_BAR; PG8_WAIT_L(0); PG8_MMA(0, 1, At, B1); PG8_BAR;
            PG8_LDA(At, 1, 1); PG8_STAGE(PG8_SA(1, 0), a3, voffA);
            PG8_BAR; PG8_WAIT_L(0); PG8_MMA(1, 0, At, B0); PG8_BAR; PG8_SCHED;
            PG8_STAGE(PG8_SB(1, 1), b3 + hstep, voffB);
            PG8_WAIT_V(6); PG8_BAR; PG8_MMA(1, 1, At, B1); PG8_BAR;
            }
        }
        if constexpr (ALIGN_EPI) { if (wr == 0) PG8_BAR; }
        if constexpr (!Epi::AFTER_DRAIN) { E(acc, cur, wr, wc, fr, fq); S.done(cur); }
        if (!has_next) break;
#pragma unroll
        for (int a = 0; a < 2; ++a)
#pragma unroll
            for (int b = 0; b < 2; ++b)
#pragma unroll
                for (int m = 0; m < 4; ++m)
#pragma unroll
                    for (int n = 0; n < 2; ++n) acc[a][b][m][n] = (f32x4){0.f, 0.f, 0.f, 0.f};
        cur = nxt; cA = nA; cB = nB; ++ui;
        if constexpr (ALIGN_EPI) { if (wr == 1) PG8_BAR; }
    }
    PG8_WAIT_V(0);
    if constexpr (!ALIGN_EPI) { if (wr == 0) PG8_BAR; }
    PG8_BAR;
    if constexpr (Epi::AFTER_DRAIN) { E.fused(acc, cur, wr, wc, fr, fq, lds, wid, lane); S.done(cur); }
#undef PG8_SA
#undef PG8_SB
#undef PG8_STAGE
#undef PG8_LDA
#undef PG8_LDB
#undef PG8_MMA
#undef PG8_WAIT_V
#undef PG8_WAIT_L
#undef PG8_BAR
#undef PG8_SCHED
}
}

#define LAS __attribute__((address_space(3)))
#define GAS __attribute__((address_space(1)))
#define XB_TMO      128
#define XB_XCNT(j)  (256  + 64 * (j))
#define XB_XSUB(j)  (1280 + 64 * (j))
#define XB_XGEN(j)  (2304 + 64 * (j))
#define XB_TOP      3328
#define XB_TOPGEN   3392
#define XCD_BAR_WORDS 3456
#define XB_SPIN_CAP (1u << 18)

__device__ __forceinline__ unsigned xb_ld(unsigned* p)              { return __hip_atomic_load(p, __ATOMIC_RELAXED, __HIP_MEMORY_SCOPE_AGENT); }
__device__ __forceinline__ unsigned xb_add(unsigned* p, unsigned v) { return __hip_atomic_fetch_add(p, v, __ATOMIC_RELAXED, __HIP_MEMORY_SCOPE_AGENT); }
__device__ __forceinline__ unsigned xb_xcc_id() { return (unsigned)__builtin_amdgcn_s_getreg((3 << 11) | 20) & 0xFu; }
#define XB_SPIN(cond, bar) do { unsigned _sp = 0; while (cond) { __builtin_amdgcn_s_sleep(1); \
    if ((++_sp & 255u) == 0u) { if (xb_ld(&(bar)[XB_TMO])) break; if (_sp > XB_SPIN_CAP) { atomicAdd(&(bar)[XB_TMO], 1u); break; } } } } while (0)

struct XcdBarrier {
    unsigned* bar; unsigned x;
    volatile LAS unsigned* st;
};

__device__ __forceinline__ XcdBarrier xcd_barrier_post(unsigned* bar, volatile LAS unsigned* st) {
    XcdBarrier b; b.bar = bar; b.x = xb_xcc_id(); b.st = st;
    if (threadIdx.x == 0) (void)xb_add(&bar[XB_XCNT(b.x)], 1u);
    return b;
}
__device__ __forceinline__ void xcd_barrier_complete(unsigned* bar, unsigned x, unsigned& nloc, unsigned& nx) {
    const unsigned G = gridDim.x * gridDim.y * gridDim.z;
    unsigned sum, cnt, mine, sp = 0u;
    for (;;) {
        sum = 0u; cnt = 0u; mine = 0u;
#pragma unroll
        for (unsigned j = 0; j < 16; ++j) { const unsigned c = xb_ld(&bar[XB_XCNT(j)]); sum += c; cnt += (c > 0u) ? 1u : 0u; mine = (j == x) ? c : mine; }
        if (sum == G) break;
        __builtin_amdgcn_s_sleep(1);
        if ((++sp & 255u) == 0u) { if (xb_ld(&bar[XB_TMO])) break; if (sp > XB_SPIN_CAP) { atomicAdd(&bar[XB_TMO], 1u); break; } }
    }
    nloc = mine > 0u ? mine : 1u; nx = cnt > 0u ? cnt : 1u;
}

__device__ __forceinline__ void xcd_barrier(const XcdBarrier& b) {
    asm volatile("s_waitcnt vmcnt(0)" ::: "memory");
    __syncthreads();
    if (threadIdx.x == 0) {
        unsigned* bar = b.bar;
        __builtin_amdgcn_s_waitcnt(0);
        unsigned nloc = b.st[0], nx = b.st[1];
        if (nloc == 0u) { xcd_barrier_complete(bar, b.x, nloc, nx); b.st[0] = nloc; b.st[1] = nx; }
        const unsigned old = xb_add(&bar[XB_XSUB(b.x)], 1u);
        const unsigned gen = old / nloc;
        if (old + 1u == (gen + 1u) * nloc) {
            __builtin_amdgcn_fence(__ATOMIC_RELEASE, "agent");
            asm volatile("s_waitcnt vmcnt(0)" ::: "memory");
            const unsigned og = xb_add(&bar[XB_TOP], 1u);
            const unsigned tg = og / nx;
            if (og + 1u == (tg + 1u) * nx) xb_add(&bar[XB_TOPGEN], 1u);
            else XB_SPIN(xb_ld(&bar[XB_TOPGEN]) == tg, bar);
            __builtin_amdgcn_fence(__ATOMIC_ACQUIRE, "agent");
            xb_add(&bar[XB_XGEN(b.x)], 1u);
            asm volatile("s_waitcnt vmcnt(0)" ::: "memory");
        } else {
            XB_SPIN(xb_ld(&bar[XB_XGEN(b.x)]) == gen, bar);
            __builtin_amdgcn_fence(__ATOMIC_ACQUIRE, "agent");
            asm volatile("s_waitcnt vmcnt(0)" ::: "memory");
        }
    }
    __syncthreads();
}

constexpr int DM = 1024, NB = 2, SEQ = 8192, NT = NB * SEQ;
constexpr int NTHREADS = 512, NWAVES = 8;
constexpr float LN_EPS = 1e-5f;
constexpr float ALPHA = 1.189207115002721f;
typedef unsigned short bf16;
typedef unsigned v4u __attribute__((ext_vector_type(4)));
typedef unsigned v2u __attribute__((ext_vector_type(2)));
typedef float f32x4 __attribute__((ext_vector_type(4)));
typedef short bf16x8_t __attribute__((ext_vector_type(8)));

constexpr size_t MiB = 1u << 20, KiB = 1u << 10;
constexpr size_t WS_CTL = 0, CTL_ZERO_BYTES = 1 * MiB;
constexpr size_t WS_MOD = 1 * MiB + 768 * KiB;
constexpr size_t WS_MMAT = 1 * MiB;
constexpr size_t WS_ROPE = 2 * MiB;
constexpr size_t WS_WIN = 6 * MiB, WS_WOUT = 12 * MiB, WS_WPQ = 14 * MiB, WS_MISC = 16 * MiB, WS_SUBK = 17 * MiB;
constexpr size_t WS_XN = 18 * MiB;
constexpr size_t WS_FZ = 50 * MiB;
constexpr size_t WS_QB = 66 * MiB, WS_KB = 90 * MiB, WS_VB = 114 * MiB, WS_O3 = 138 * MiB, WS_LSE = 162 * MiB;
constexpr size_t WS_H2Q = 50 * MiB, WS_HS = 66 * MiB, WS_WQ = 67 * MiB, WS_WSC = 69 * MiB, WS_SUA = 75 * MiB, WS_X1 = 83 * MiB;
constexpr size_t WS_Y1 = 116 * MiB, WS_PQ = 116 * MiB, WS_PART = 116 * MiB, WS_Y = 116 * MiB;
constexpr size_t WS_IDS = 180 * MiB, WS_GATES = 188 * MiB;
constexpr size_t WS_TU8 = 200 * MiB, WS_TV8 = 216 * MiB, WS_SU = 232 * MiB, WS_SV = 232 * MiB + 512 * KiB, WS_END = 233 * MiB;
constexpr float QSCALE = 0.125f * 1.4426950408889634f;
constexpr int NIN = 2816;
constexpr int CW_BAR = 4096;

constexpr int RING_BYTES = 131072, LDSCTL_OFF = RING_BYTES, MISC_OFF = LDSCTL_OFF + 320, LDS_BYTES = 147456;

struct Params {
    const float* x; const float* c; const int* pos; const float* w_ada; const float* b_ada; const float* w_in; const float* b_in;
    const float* w_four; const float* w_out; const float* b_out; const float* g1; const float* be1; const float* w_pq; const float* subk;
    const float* pu; const float* pv; const float* g2; const float* be2; float* out; unsigned char* ws;
};

__device__ __forceinline__ unsigned f2bf(float f) { unsigned u = __builtin_bit_cast(unsigned, f); return (u + 0x7fffu + ((u >> 16) & 1u)) >> 16; }
__device__ __forceinline__ unsigned pk2(float lo, float hi) { return f2bf(lo) | (f2bf(hi) << 16); }
__device__ __forceinline__ float wave_sum(float v) {
#pragma unroll
    for (int o = 32; o > 0; o >>= 1) v += __shfl_xor(v, o);
    return v;
}
__device__ __forceinline__ float wave_max(float v) {
#pragma unroll
    for (int o = 32; o > 0; o >>= 1) v = fmaxf(v, __shfl_xor(v, o));
    return v;
}
#define LDS_WAIT() asm volatile("s_waitcnt lgkmcnt(0)" ::: "memory")
__device__ __forceinline__ int opaque_tid() { int t = threadIdx.x; asm volatile("" : "+v"(t)); return t; }
__device__ __forceinline__ int wave_id() { return __builtin_amdgcn_readfirstlane(opaque_tid() >> 6); }
__device__ __forceinline__ float bflo(unsigned u) { return __builtin_bit_cast(float, u << 16); }
__device__ __forceinline__ float bfhi(unsigned u) { return __builtin_bit_cast(float, u & 0xffff0000u); }

template <class SC>
__device__ __forceinline__ void transpose_item(const float* W, int K, int N, bf16* WT, int nout, SC srccol, LAS float* scr, int item, int lane) {
    const int nblk = nout / 32, kb = item / nblk, nb = item % nblk, k0 = 64 * kb, n0 = 32 * nb;
    const int sc = srccol(n0 + (lane & 31));
#pragma unroll 8
    for (int i = 0; i < 32; ++i) { const int kk = 2 * i + (lane >> 5); scr[kk * 33 + (lane & 31)] = W[(size_t)(k0 + kk) * N + sc]; }
    LDS_WAIT(); asm volatile("" ::: "memory");
    const int c = lane & 7;
#pragma unroll
    for (int j = 0; j < 4; ++j) { const int n = (lane >> 3) + 8 * j; const LAS float* s = scr + (8 * c) * 33 + n;
        v4u o; o.x = pk2(s[0 * 33], s[1 * 33]); o.y = pk2(s[2 * 33], s[3 * 33]); o.z = pk2(s[4 * 33], s[5 * 33]); o.w = pk2(s[6 * 33], s[7 * 33]);
        *(v4u*)(WT + (size_t)(n0 + n) * K + k0 + 8 * c) = o; }
    LDS_WAIT(); asm volatile("" ::: "memory");
}
__device__ __forceinline__ void ph_prologue(const Params& p, LAS unsigned char* lds, int bid, int nblk) {
    const int tid = opaque_tid(), lane = tid & 63, wave = __builtin_amdgcn_readfirstlane(tid >> 6);
    {
        LAS float* M = (LAS float*)lds; LAS float* Wl = (LAS float*)(lds + 32768);
        bf16* WT = (bf16*)(p.ws + WS_WIN); float* biasf = (float*)(p.ws + WS_MISC); const float* MM = (const float*)(p.ws + WS_MMAT);
        const bool fallback = !(nblk > 192);
        for (int it = bid; it < 256; it += nblk) {
            const int g = it & 3, kb = it >> 2, k0 = kb * 16;
            __syncthreads();
            if (fallback) { const float norm = 1.0f / sqrtf(8192.0f * 64.0f);
                for (int e = tid; e < 8192; e += NTHREADS) { const int c = e >> 7, nl = e & 127; float a = 0.f;
                    for (int cp = 0; cp < 64; ++cp) { const float ang = 2.0f * (float)((c * cp) & 63) / 64.0f; a += ((nl & 1) ? -sinpif(ang) : cospif(ang)) * p.w_four[(g * 64 + cp) * 64 + (nl >> 1)]; }
                    M[e] = a * norm; } }
            else {
#pragma unroll
                for (int i = 0; i < 4; ++i) *(LAS f32x4*)(lds + (tid + i * 512) * 16) = *(const f32x4*)(MM + (size_t)g * 8192 + (tid + i * 512) * 4); }
#pragma unroll
            for (int i = 0; i < 2; ++i) { const int e = tid + i * 512, k = e >> 6, c = e & 63; Wl[k * 64 + c] = p.w_in[(size_t)(k0 + k) * 2560 + g * 64 + c]; }
            __syncthreads();
            { const int nl = tid & 127, kq = tid >> 7; float a[4] = {0.f, 0.f, 0.f, 0.f};
              for (int c = 0; c < 64; ++c) { const float mv = M[c * 128 + nl];
#pragma unroll
                  for (int j = 0; j < 4; ++j) a[j] += mv * Wl[(kq * 4 + j) * 64 + c]; }
              *(v2u*)(WT + (size_t)(g * 128 + nl) * DM + k0 + kq * 4) = (v2u){pk2(a[0], a[1]), pk2(a[2], a[3])};
              if (kb == 0 && tid < 128) { float bsum = 0.f; for (int c = 0; c < 64; ++c) bsum += p.b_in[g * 64 + c] * M[c * 128 + nl]; biasf[g * 128 + nl] = bsum; } }
        }
        __syncthreads();
        for (int i = bid * NTHREADS + tid; i < 2304; i += nblk * NTHREADS) biasf[512 + i] = p.b_in[256 + i];
    }
    {
        LAS float* scr = (LAS float*)(lds + wave * 16384);
        const int gw = bid * NWAVES + wave, NGW = nblk * NWAVES;
        constexpr int I_IN = 16 * (2304 / 32), I_O = 16 * 32, I_PQ = 16 * 32;
        for (int it = gw; it < I_IN + I_O + I_PQ; it += NGW) {
            int r = it;
            if (r < I_IN) {
                transpose_item(p.w_in, DM, 2560, (bf16*)(p.ws + WS_WIN) + (size_t)512 * DM, 2304,
                    [](int n) { return n < 1536 ? 256 + (n & ~63) + ((n & 63) >> 1) + 32 * (n & 1) : 256 + n; }, scr, r, lane); continue; } r -= I_IN;
            if (r < I_O) { transpose_item(p.w_out, DM, DM, (bf16*)(p.ws + WS_WOUT), DM, [](int n) { return n; }, scr, r, lane); continue; } r -= I_O;
            transpose_item(p.w_pq, DM, DM, (bf16*)(p.ws + WS_WPQ), DM, [](int n) { return n; }, scr, r, lane);
        }
    }
    { bf16* SK = (bf16*)(p.ws + WS_SUBK);
      for (int ch = bid * NTHREADS + tid; ch < 8 * 2 * 4 * 4 * 64; ch += nblk * NTHREADS) {
          const int ln = ch & 63, d0 = (ch >> 6) & 3, mt = (ch >> 8) & 3, hp = ch >> 10;
          const float* sp = p.subk + ((size_t)hp * 128 + 32 * mt + (ln & 31)) * 64 + 16 * d0 + 8 * (ln >> 5);
          v4u o; o.x = pk2(sp[0], sp[1]); o.y = pk2(sp[2], sp[3]); o.z = pk2(sp[4], sp[5]); o.w = pk2(sp[6], sp[7]);
          *(v4u*)(SK + (size_t)ch * 8) = o; } }
}
__device__ __forceinline__ void ph_mod(const Params& p, LAS unsigned char* lds, int bid, int nblk) {
    const int tid = opaque_tid(), col = tid & 31, kg = tid >> 5;
    LAS float* cond = (LAS float*)lds; LAS float* red = (LAS float*)(lds + 8192);
    float* mod = (float*)(p.ws + WS_MOD);
    for (int i = tid; i < 2 * DM; i += NTHREADS) { const float c = p.c[i]; cond[i] = c / (1.0f + expf(-c)); }
    __syncthreads();
    if (nblk > 192 && bid >= 192) {
        LAS float* T64 = (LAS float*)(lds + 12288);
        if (tid < 64) { T64[tid] = cospif(2.0f * (float)tid / 64.0f); T64[64 + tid] = -sinpif(2.0f * (float)tid / 64.0f); }
        __syncthreads();
        const float norm = 1.0f / sqrtf(8192.0f * 64.0f); float* MM = (float*)(p.ws + WS_MMAT);
        for (int it = bid - 192; it < 64; it += nblk - 192) {
            const int g = it >> 4, c = (it & 15) * 4 + (tid >> 7), nl = tid & 127; float a = 0.f;
#pragma unroll 8
            for (int cp = 0; cp < 64; ++cp) a += T64[(nl & 1) * 64 + ((c * cp) & 63)] * p.w_four[(g * 64 + cp) * 64 + (nl >> 1)];
            MM[(g * 64 + c) * 128 + nl] = a * norm;
        }
    }
    for (int it = bid; it < 6144 / 32; it += nblk) {
        const int n = it * 32 + col; float a0 = 0.f, a1 = 0.f;
        const float* wp = p.w_ada + (size_t)(kg * 64) * 6144 + n;
#pragma unroll 16
        for (int k = 0; k < 64; ++k) { const float w = wp[(size_t)k * 6144]; a0 += cond[kg * 64 + k] * w; a1 += cond[DM + kg * 64 + k] * w; }
        red[(kg * 2 + 0) * 32 + col] = a0; red[(kg * 2 + 1) * 32 + col] = a1;
        __syncthreads();
        if (tid < 64) { const int b = tid >> 5; float s = p.b_ada[n];
#pragma unroll
            for (int g = 0; g < 16; ++g) s += red[(g * 2 + b) * 32 + col];
            mod[b * 6144 + n] = s; }
        __syncthreads();
    }
}
__device__ __forceinline__ void ph_xn(const Params& p, int bid, int nblk) {
    const int lane = opaque_tid() & 63, wave = wave_id(); const float* mod = (const float*)(p.ws + WS_MOD); bf16* XN = (bf16*)(p.ws + WS_XN);
    for (int row = bid * NWAVES + wave; row < NT; row += nblk * NWAVES) {
        const int b = row / SEQ;
        const f32x4* xr = (const f32x4*)(p.x + (size_t)row * DM) + lane;
        f32x4 v[4]; float s = 0.f;
#pragma unroll
        for (int j = 0; j < 4; ++j) { v[j] = xr[64 * j]; s += (v[j].x + v[j].y) + (v[j].z + v[j].w); }
        const float mean = wave_sum(s) * (1.f / DM); float s2 = 0.f;
#pragma unroll
        for (int j = 0; j < 4; ++j) { v[j] = v[j] - mean; s2 += (v[j].x * v[j].x + v[j].y * v[j].y) + (v[j].z * v[j].z + v[j].w * v[j].w); }
        const float rstd = rsqrtf(wave_sum(s2) * (1.f / DM) + LN_EPS);
        unsigned long long* o8 = (unsigned long long*)(XN + (size_t)row * DM) + lane;
#pragma unroll
        for (int j = 0; j < 4; ++j) {
            const f32x4 sh = *((const f32x4*)(mod + b * 6144 + 0) + lane + 64 * j), sc = *((const f32x4*)(mod + b * 6144 + 1024) + lane + 64 * j);
            const f32x4 o = v[j] * rstd * (1.0f + sc) + sh;
            o8[64 * j] = (unsigned long long)pk2(o.x, o.y) | ((unsigned long long)pk2(o.z, o.w) << 32);
        }
    }
}

struct EpiOut {
    static constexpr bool PERM = true, AFTER_DRAIN = false;
    bf16* Y1; const float* x; const float* mod; const float* bo;
    __device__ __forceinline__ void operator()(const pg8::f32x4 (&acc)[2][2][4][2], const pg8::Unit& u, int wr, int wc, int fr, int fq) const {
        const int row0 = u.pm * 256 + wr * 64 + fr;
#pragma unroll
        for (int bj = 0; bj < 2; ++bj) {
            const int c0 = u.pn * 256 + bj * 128 + wc * 32 + 8 * fq;
            const pg8::f32x4 b0 = *(const pg8::f32x4*)(bo + c0), b1 = *(const pg8::f32x4*)(bo + c0 + 4);
#pragma unroll
            for (int ai = 0; ai < 2; ++ai) {
                const int bb = (u.pm * 256 + ai * 128) >> 13;
                const pg8::f32x4 g0 = *(const pg8::f32x4*)(mod + bb * 6144 + 2048 + c0) + 1.0f, g1 = *(const pg8::f32x4*)(mod + bb * 6144 + 2048 + c0 + 4) + 1.0f;
#pragma unroll
                for (int m = 0; m < 4; ++m) {
                    const int row = row0 + ai * 128 + m * 16;
                    const pg8::f32x4 x0 = *(const pg8::f32x4*)(x + (size_t)row * DM + c0), x1 = *(const pg8::f32x4*)(x + (size_t)row * DM + c0 + 4);
                    const pg8::f32x4 v0 = x0 * ALPHA + g0 * (acc[ai][bj][m][0] + b0), v1 = x1 * ALPHA + g1 * (acc[ai][bj][m][1] + b1);
                    v4u o; o.x = pk2(v0.x, v0.y); o.y = pk2(v0.z, v0.w); o.z = pk2(v1.x, v1.y); o.w = pk2(v1.z, v1.w);
                    *(v4u*)(Y1 + (size_t)row * DM + c0) = o;
                }
            }
        }
    }
};
__device__ __forceinline__ void ph_fft(const Params& p, LAS unsigned char* lds, int bid, int nblk) {
    const int tid = opaque_tid(), lane = tid & 63, wave = __builtin_amdgcn_readfirstlane(tid >> 6), lr = lane & 15, lq = lane >> 4;
    bf16* MIX = (bf16*)(p.ws + WS_XN);
    for (int item = bid; item < 256; item += nblk) {
        const int b = item >> 7, cg = item & 127;
        const unsigned long long* src = (const unsigned long long*)(p.ws + WS_FZ) + (size_t)(b * 128 + cg) * 8192;
        {
            const int n2b = (tid & 7) | ((tid >> 6) << 3), n1b = (tid >> 3) & 7;
            const unsigned long long* sb = src + 128 * n1b + n2b; LAS unsigned char* lb = lds + (2 * n2b) * 288 + 4 * n1b;
#pragma unroll
            for (int hb = 0; hb < 2; ++hb) {
                unsigned long long zin[8];
#pragma unroll
                for (int i = 0; i < 8; ++i) { const int ii = hb * 8 + i; zin[i] = sb[(ii & 1) * 64 + (ii >> 1) * 1024]; }
#pragma unroll
                for (int i = 0; i < 8; ++i) { const int ii = hb * 8 + i; LAS unsigned char* lp = lb + (ii & 1) * 36864 + (ii >> 1) * 32;
                    *(LAS unsigned*)lp = (unsigned)zin[i]; *(LAS unsigned*)(lp + 288) = (unsigned)(zin[i] >> 32); }
            }
        }
        bf16x8_t af[4];
        { const int m = 16 * wave + lr, k1 = m >> 1, ri = m & 1;
#pragma unroll
          for (int ks = 0; ks < 4; ++ks)
#pragma unroll
              for (int jj = 0; jj < 4; ++jj) { const int n1 = 16 * ks + 4 * lq + jj; const float x = (float)((n1 * k1) & 63) * (1.0f / 64.0f);
                  const float c = __builtin_amdgcn_cosf(x), s = __builtin_amdgcn_sinf(x);
                  af[ks][2 * jj] = (short)f2bf(ri ? -s : c); af[ks][2 * jj + 1] = (short)f2bf(ri ? c : s); } }
        __syncthreads();
        pg8::f32x4 acc[16];
#pragma unroll
        for (int nt = 0; nt < 16; ++nt) { acc[nt] = (pg8::f32x4){0.f, 0.f, 0.f, 0.f};
#pragma unroll
            for (int ks = 0; ks < 4; ++ks) { const bf16x8_t bf = *(const LAS bf16x8_t*)(lds + (16 * nt + lr) * 288 + (32 * ks + 8 * lq) * 2);
                acc[nt] = __builtin_amdgcn_mfma_f32_16x16x32_bf16(af[ks], bf, acc[nt], 0, 0, 0); } }
        __syncthreads();
#pragma unroll
        for (int nt = 0; nt < 16; ++nt) { const int col = 16 * nt + lr, n2 = col >> 1, ch = col & 1;
#pragma unroll
            for (int h = 0; h < 2; ++h) { const int k1 = 8 * wave + 2 * lq + h; const float yr = acc[nt][2 * h], yi = acc[nt][2 * h + 1];
                const float x = (float)((n2 * k1) & 8191) * (1.0f / 8192.0f); const float c = __builtin_amdgcn_cosf(x), s = __builtin_amdgcn_sinf(x);
                *(LAS unsigned*)(lds + (2 * k1 + ch) * 544 + 4 * n2) = pk2(yr * c + yi * s, yi * c - yr * s); } }
        bf16x8_t a2[8];
        { const int k2 = 16 * wave + lr;
#pragma unroll
          for (int ks = 0; ks < 8; ++ks)
#pragma unroll
              for (int jj = 0; jj < 4; ++jj) { const int n2 = 16 * ks + 4 * lq + jj; const float x = (float)((n2 * k2) & 127) * (1.0f / 128.0f);
                  a2[ks][2 * jj] = (short)f2bf(__builtin_amdgcn_cosf(x)); a2[ks][2 * jj + 1] = (short)f2bf(__builtin_amdgcn_sinf(x)); } }
        __syncthreads();
        pg8::f32x4 o[8];
#pragma unroll
        for (int nt = 0; nt < 8; ++nt) { o[nt] = (pg8::f32x4){0.f, 0.f, 0.f, 0.f};
#pragma unroll
            for (int ks = 0; ks < 8; ++ks) { const bf16x8_t bf = *(const LAS bf16x8_t*)(lds + (16 * nt + lr) * 544 + (32 * ks + 8 * lq) * 2);
                o[nt] = __builtin_amdgcn_mfma_f32_16x16x32_bf16(a2[ks], bf, o[nt], 0, 0, 0); } }
#pragma unroll
        for (int nt = 0; nt < 8; ++nt) { const int col2 = 16 * nt + lr, k1 = col2 >> 1, ch = col2 & 1;
#pragma unroll
            for (int r = 0; r < 4; ++r) { const float v = o[nt][r]; const float w = __shfl_xor(v, 1); const int k2 = 16 * wave + 4 * lq + r;
                if (ch == 0) *(unsigned*)(MIX + ((size_t)b * SEQ + k1 + 64 * k2) * DM + 2 * cg) = pk2(v, w); } }
        __syncthreads();
    }
}


struct EpiIn {
    static constexpr bool PERM = true, AFTER_DRAIN = false;
    bf16* FZ; bf16* QKV; const float* bias; const int* pos;
    __device__ __forceinline__ void operator()(const pg8::f32x4 (&acc)[2][2][4][2], const pg8::Unit& u, int wr, int wc, int fr, int fq) const {
        const int row0 = u.pm * 256 + wr * 64 + fr;
        float cf[4];
#pragma unroll
        for (int q = 0; q < 4; ++q) cf[q] = __builtin_amdgcn_exp2f(-(float)(16 * (wc & 1) + 4 * fq + q) * (13.287712379549449f / 32.0f)) * 0.15915494309189535f;
        const bool isqk = u.pn >= 2 && u.pn < 8;
        float posf[2][4];
#pragma unroll
        for (int ai = 0; ai < 2; ++ai)
#pragma unroll
            for (int m = 0; m < 4; ++m) posf[ai][m] = isqk ? (float)pos[row0 + ai * 128 + m * 16] : 0.f;
#pragma unroll
        for (int bj = 0; bj < 2; ++bj) {
            const int c0 = u.pn * 256 + bj * 128 + wc * 32 + 8 * fq;
            const pg8::f32x4 b0 = *(const pg8::f32x4*)(bias + c0), b1 = *(const pg8::f32x4*)(bias + c0 + 4);
#pragma unroll
            for (int ai = 0; ai < 2; ++ai)
#pragma unroll
                for (int m = 0; m < 4; ++m) {
                    const int row = row0 + ai * 128 + m * 16;
                    pg8::f32x4 v0 = acc[ai][bj][m][0] + b0, v1 = acc[ai][bj][m][1] + b1;
                    if (u.pn < 2) {
                        const int b = row >> 13, s = row & 8191, cgp = c0 >> 2;
                        unsigned long long* d0 = (unsigned long long*)(FZ + (((size_t)(b * 128 + cgp) * 8192 + s) << 2));
                        d0[0] = (unsigned long long)pk2(v0.x, v0.y) | ((unsigned long long)pk2(v0.z, v0.w) << 32);
                        d0[8192] = (unsigned long long)pk2(v1.x, v1.y) | ((unsigned long long)pk2(v1.z, v1.w) << 32);
                    } else {
                        const int cq = c0 - 512, which = cq / 768, off = cq - which * 768;
                        if (which < 2) {
                            const float sc = which == 0 ? QSCALE : 1.0f;
                            pg8::f32x4 r0, r1;
                            { const float pf = posf[ai][m]; float a0 = pf * cf[0], a1 = pf * cf[1], a2 = pf * cf[2], a3 = pf * cf[3];
                              a0 -= floorf(a0); a1 -= floorf(a1); a2 -= floorf(a2); a3 -= floorf(a3);
                              r0.x = __builtin_amdgcn_cosf(a0); r0.y = __builtin_amdgcn_sinf(a0); r0.z = __builtin_amdgcn_cosf(a1); r0.w = __builtin_amdgcn_sinf(a1);
                              r1.x = __builtin_amdgcn_cosf(a2); r1.y = __builtin_amdgcn_sinf(a2); r1.z = __builtin_amdgcn_cosf(a3); r1.w = __builtin_amdgcn_sinf(a3); }
                            pg8::f32x4 w0, w1;
                            w0.x = (v0.x * r0.x - v0.y * r0.y) * sc; w0.y = (v0.y * r0.x + v0.x * r0.y) * sc; w0.z = (v0.z * r0.z - v0.w * r0.w) * sc; w0.w = (v0.w * r0.z + v0.z * r0.w) * sc;
                            w1.x = (v1.x * r1.x - v1.y * r1.y) * sc; w1.y = (v1.y * r1.x + v1.x * r1.y) * sc; w1.z = (v1.z * r1.z - v1.w * r1.w) * sc; w1.w = (v1.w * r1.z + v1.z * r1.w) * sc;
                            v0 = w0; v1 = w1;
                        }
                        v4u o; o.x = pk2(v0.x, v0.y); o.y = pk2(v0.z, v0.w); o.z = pk2(v1.x, v1.y); o.w = pk2(v1.z, v1.w);
                        *(v4u*)(QKV + (size_t)which * ((WS_KB - WS_QB) / 2) + (size_t)row * 768 + off) = o;
                    }
                }
        }
    }
};

typedef float f32x16 __attribute__((ext_vector_type(16)));
typedef short s16x4 __attribute__((ext_vector_type(4)));
__device__ __forceinline__ int crow(int r, int hi) { return (r & 3) + 8 * (r >> 2) + 4 * hi; }
__device__ __forceinline__ s16x4 vtr(const LAS unsigned char* p) { return __builtin_bit_cast(s16x4, __builtin_amdgcn_ds_read_tr16_b64_v4i16((LAS s16x4*)p)); }
__device__ __forceinline__ unsigned cvtpk(float lo, float hi) { typedef float f2 __attribute__((ext_vector_type(2))); typedef __bf16 b2 __attribute__((ext_vector_type(2))); f2 v = {lo, hi}; b2 r = __builtin_convertvector(v, b2); return __builtin_bit_cast(unsigned, r); }
__device__ __forceinline__ void tbl_load(const Params& p, int r, f32x4 (&a)[4], int lane) {
    const bool isv = r >= 16384; const int row = isv ? r - 16384 : r;
    const f32x4* src = (const f32x4*)((isv ? p.pv : p.pu) + (size_t)row * DM + 16 * lane);
#pragma unroll
    for (int j = 0; j < 4; ++j) a[j] = src[j];
}
__device__ __forceinline__ void tbl_finish(const Params& p, int r, const f32x4 (&a)[4], int lane) {
    const bool isv = r >= 16384; const int row = isv ? r - 16384 : r;
    float amax = 0.f;
#pragma unroll
    for (int j = 0; j < 4; ++j) amax = fmaxf(amax, fmaxf(fmaxf(fabsf(a[j].x), fabsf(a[j].y)), fmaxf(fabsf(a[j].z), fabsf(a[j].w))));
    if (isv) {
        amax = wave_max(amax);
        const float inv = amax > 0.f ? 127.0f / amax : 0.f;
        v4u o;
#pragma unroll
        for (int j = 0; j < 4; ++j) { unsigned q = 0u;
            q = __builtin_amdgcn_cvt_pk_u8_f32(a[j].x * inv + 128.0f, 0, q); q = __builtin_amdgcn_cvt_pk_u8_f32(a[j].y * inv + 128.0f, 1, q);
            q = __builtin_amdgcn_cvt_pk_u8_f32(a[j].z * inv + 128.0f, 2, q); q = __builtin_amdgcn_cvt_pk_u8_f32(a[j].w * inv + 128.0f, 3, q);
            o[j] = q ^ 0x80808080u; }
        *(v4u*)(p.ws + WS_TV8 + (size_t)(lane >> 3) * (2 * MiB) + (size_t)row * 128 + 16 * (lane & 7)) = o;
        if (lane == 0) ((float*)(p.ws + WS_SV))[row] = amax * (1.0f / 127.0f);
    } else {
        amax = fmaxf(amax, __shfl_xor(amax, 1)); amax = fmaxf(amax, __shfl_xor(amax, 2)); amax = fmaxf(amax, __shfl_xor(amax, 4)); amax = fmaxf(amax, __shfl_xor(amax, 8));
        const float inv = amax > 0.f ? 7.0f / amax : 0.f;
        unsigned d[2];
#pragma unroll
        for (int w = 0; w < 2; ++w) { unsigned lo = 0u, hi = 0u;
            lo = __builtin_amdgcn_cvt_pk_u8_f32(a[2 * w].x * inv + 8.0f, 0, lo); lo = __builtin_amdgcn_cvt_pk_u8_f32(a[2 * w].y * inv + 8.0f, 1, lo);
            lo = __builtin_amdgcn_cvt_pk_u8_f32(a[2 * w].z * inv + 8.0f, 2, lo); lo = __builtin_amdgcn_cvt_pk_u8_f32(a[2 * w].w * inv + 8.0f, 3, lo);
            hi = __builtin_amdgcn_cvt_pk_u8_f32(a[2 * w + 1].x * inv + 8.0f, 0, hi); hi = __builtin_amdgcn_cvt_pk_u8_f32(a[2 * w + 1].y * inv + 8.0f, 1, hi);
            hi = __builtin_amdgcn_cvt_pk_u8_f32(a[2 * w + 1].z * inv + 8.0f, 2, hi); hi = __builtin_amdgcn_cvt_pk_u8_f32(a[2 * w + 1].w * inv + 8.0f, 3, hi);
            d[w] = lo | (hi << 4); }
        *(v2u*)(p.ws + WS_TU8 + (size_t)(lane >> 4) * (2 * MiB) + (size_t)row * 128 + 8 * (lane & 15)) = (v2u){d[0], d[1]};
        if ((lane & 15) == 0) ((float*)(p.ws + WS_SU))[(size_t)(lane >> 4) * 16384 + row] = amax * (1.0f / 7.0f);
    }
}
struct AttnDesc { int dil, ntile, res, cb, r; size_t rowb; int h; bool valid; };
__device__ __forceinline__ AttnDesc attn_desc(int bi) {
    AttnDesc d; d.valid = bi < 3 * 768; const int b2 = d.valid ? bi : 0;
    const int r = b2 / 768, rem = b2 - r * 768, bh = rem >> 5, q32 = rem & 31, b = bh / 12;
    d.r = r; d.h = bh - b * 12; d.rowb = (size_t)b * SEQ;
    const int ld = 2 * r;
    d.dil = 1 << ld; d.ntile = 256 >> ld; d.res = q32 >> (5 - ld); d.cb = q32 & ((32 >> ld) - 1);
    return d;
}
__device__ __forceinline__ void attn_dma(const AttnDesc& d, const bf16* T, bool swz, LAS unsigned char* img, int wave, int lane) {
#pragma unroll
    for (int i = 0; i < 6; ++i) {
        const int idx = wave * 6 + i, j = idx >> 2, it = idx & 3, kt = 8 * d.cb - 2 + j;
        if (kt >= 0 && kt < d.ntile) {
            const int row = it * 8 + (lane >> 3), ch = lane & 7; const int gch = swz ? (ch ^ ((row >> 1) & 7)) : ch;
            const bf16* src = T + (d.rowb + d.res + d.dil * (32 * kt + row)) * 768 + d.h * 64 + 8 * gch;
            __builtin_amdgcn_global_load_lds((const unsigned*)src, (LAS unsigned*)(img + j * 4096 + it * 1024), 16, 0, 0);
        }
    }
}
__device__ __forceinline__ void attn_qload(const AttnDesc& d, const bf16* QB, bf16x8_t (&qf)[4], int wave, int lane) {
    const bf16* qp = QB + (d.rowb + d.res + d.dil * (32 * (8 * d.cb + wave) + (lane & 31))) * 768 + d.h * 64 + 8 * (lane >> 5);
#pragma unroll
    for (int d0 = 0; d0 < 4; ++d0) qf[d0] = *(const bf16x8_t*)(qp + 16 * d0);
}
#define ATT_SYNC() do { asm volatile("s_waitcnt vmcnt(0) lgkmcnt(0)" ::: "memory"); __builtin_amdgcn_s_barrier(); asm volatile("" ::: "memory"); } while (0)
__device__ __forceinline__ void ph_attn_fast(const Params& p, LAS unsigned char* lds, int bid, int nblk) {
    const int lane = opaque_tid() & 63, wave = wave_id(), r32 = lane & 31, hi = lane >> 5;
    LAS unsigned char* imgK = lds; LAS unsigned char* imgV = lds + 49152; LAS unsigned char* stgb = lds + 98304 + wave * 4096;
    const bf16* QB = (const bf16*)(p.ws + WS_QB); const bf16* KB = (const bf16*)(p.ws + WS_KB); const bf16* VB = (const bf16*)(p.ws + WS_VB);
    const int vb = (nblk & 7) == 0 ? (bid & 7) * (nblk >> 3) + (bid >> 3) : bid;
    int bi = vb;
    AttnDesc d = attn_desc(bi);
    bf16x8_t qf[4];
    if (d.valid) { attn_dma(d, KB, true, imgK, wave, lane); attn_qload(d, QB, qf, wave, lane); }
    ATT_SYNC();
    const int g = lane >> 4, ii = lane & 15;
    const int vb0 = (4 * hi + (ii >> 2)) * 128 + (g & 1) * 32 + (ii & 3) * 8;
    int trow = bid * NWAVES + wave; const int tstride = nblk * NWAVES;
    f32x4 ta[4];
    while (d.valid) {
        asm volatile("" : "+v"(qf[0]), "+v"(qf[1]), "+v"(qf[2]), "+v"(qf[3]));
        attn_dma(d, VB, false, imgV, wave, lane);
        const bool tb1 = trow < 32768; if (tb1) tbl_load(p, trow, ta, lane);
        const int c = 8 * d.cb + wave;
        f32x16 S[5];
#pragma unroll
        for (int u = 0; u < 5; ++u) {
            const int kt = c - 2 + u;
#pragma unroll
            for (int r = 0; r < 16; ++r) S[u][r] = -1e30f;
            if (kt >= 0 && kt < d.ntile) {
                const LAS unsigned char* slot = imgK + (wave + u) * 4096;
                f32x16 a = {0.f, 0.f, 0.f, 0.f, 0.f, 0.f, 0.f, 0.f, 0.f, 0.f, 0.f, 0.f, 0.f, 0.f, 0.f, 0.f};
#pragma unroll
                for (int d0 = 0; d0 < 4; ++d0) { const bf16x8_t kf = *(const LAS bf16x8_t*)(slot + r32 * 128 + (((2 * d0 + hi) ^ ((r32 >> 1) & 7)) << 4));
                    a = __builtin_amdgcn_mfma_f32_32x32x16_bf16(kf, qf[d0], a, 0, 0, 0); }
                S[u] = a;
            }
        }
#pragma unroll
        for (int r = 0; r < 16; ++r) { const int kk = crow(r, hi); if (kk < r32) S[0][r] = -1e30f; if (kk > r32) S[4][r] = -1e30f; }
        float m = -1e30f;
#pragma unroll
        for (int u = 0; u < 5; ++u)
#pragma unroll
            for (int r = 0; r < 16; ++r) m = fmaxf(m, S[u][r]);
        m = fmaxf(m, __shfl_xor(m, 32));
        float l = 0.f;
        unsigned Pk[5][8];
#pragma unroll
        for (int u = 0; u < 5; ++u)
#pragma unroll
            for (int r = 0; r < 16; r += 2) { const float e0 = __builtin_amdgcn_exp2f(S[u][r] - m), e1 = __builtin_amdgcn_exp2f(S[u][r + 1] - m); l += e0 + e1; Pk[u][r >> 1] = cvtpk(e0, e1); }
        l += __shfl_xor(l, 32);
        if (tb1) { tbl_finish(p, trow, ta, lane); trow += tstride; }
        ATT_SYNC();
        const AttnDesc dn = attn_desc(bi + nblk);
        if (dn.valid) { attn_dma(dn, KB, true, imgK, wave, lane); attn_qload(dn, QB, qf, wave, lane); }
        const bool tb2 = trow < 32768; if (tb2) tbl_load(p, trow, ta, lane);
        f32x16 o[2];
#pragma unroll
        for (int db = 0; db < 2; ++db)
#pragma unroll
            for (int r = 0; r < 16; ++r) o[db][r] = 0.f;
#pragma unroll
        for (int u = 0; u < 5; ++u) {
            const int kt = c - 2 + u;
            if (kt >= 0 && kt < d.ntile) {
                const LAS unsigned char* slot = imgV + (wave + u) * 4096;
#pragma unroll
                for (int s = 0; s < 2; ++s) {
                    bf16x8_t pa;
                    { v4u w; w.x = Pk[u][4 * s + 0]; w.y = Pk[u][4 * s + 1]; w.z = Pk[u][4 * s + 2]; w.w = Pk[u][4 * s + 3]; pa = __builtin_bit_cast(bf16x8_t, w); }
#pragma unroll
                    for (int db = 0; db < 2; ++db) {
                        const s16x4 lo = vtr(slot + vb0 + s * 2048 + db * 64), hh = vtr(slot + vb0 + s * 2048 + 1024 + db * 64);
                        const bf16x8_t vf = {lo[0], lo[1], lo[2], lo[3], hh[0], hh[1], hh[2], hh[3]};
                        o[db] = __builtin_amdgcn_mfma_f32_32x32x16_bf16(pa, vf, o[db], 0, 0, 0);
                    }
                }
            }
        }
        bf16* OB = d.r == 2 ? (bf16*)(p.ws + WS_O3) : (bf16*)p.out + (size_t)d.r * NT * 768;
        float* LSE = (float*)(p.ws + WS_LSE) + (size_t)d.r * NT * 12;
        const float linv = 1.0f / l;
        LAS unsigned short* stg = (LAS unsigned short*)stgb;
#pragma unroll
        for (int r = 0; r < 16; ++r) { const int q = crow(r, hi); const float li = __shfl(linv, q);
#pragma unroll
            for (int db = 0; db < 2; ++db) stg[q * 64 + db * 32 + r32] = (unsigned short)f2bf(o[db][r] * li); }
        int ln2 = lane; asm volatile("" : "+v"(ln2));
#pragma unroll
        for (int i4 = 0; i4 < 4; ++i4) { const int row = i4 * 8 + (ln2 >> 3), ch = ln2 & 7;
            const v4u val = *(const LAS v4u*)((LAS unsigned char*)stg + row * 128 + ch * 16);
            *(v4u*)(OB + (d.rowb + d.res + d.dil * (32 * c + row)) * 768 + d.h * 64 + 8 * ch) = val; }
        if (ln2 < 32) LSE[(d.rowb + d.res + d.dil * (32 * c + ln2)) * 12 + d.h] = m + __builtin_amdgcn_logf(l);
        if (tb2) { tbl_finish(p, trow, ta, lane); trow += tstride; }
        ATT_SYNC();
        d = dn; bi += nblk;
    }
    for (; trow < 32768; trow += tstride) { tbl_load(p, trow, ta, lane); tbl_finish(p, trow, ta, lane); }
}
__device__ __forceinline__ void ph_merge(const Params& p, int bid, int nblk) {
    const bf16* O1 = (const bf16*)p.out; const bf16* O2 = O1 + (size_t)NT * 768; const bf16* O3 = (const bf16*)(p.ws + WS_O3);
    const float* L1 = (const float*)(p.ws + WS_LSE); const float* L2 = L1 + (size_t)NT * 12; const float* L3 = L2 + (size_t)NT * 12; bf16* MIX = (bf16*)(p.ws + WS_XN);
    for (int idx = bid * NTHREADS + opaque_tid(); idx < NT * 96; idx += nblk * NTHREADS) {
        const int t = idx / 96, rem = idx - t * 96, h = rem >> 3, ch = rem & 7;
        const float l1 = L1[t * 12 + h], l2 = L2[t * 12 + h], l3 = L3[t * 12 + h]; const float mx = fmaxf(fmaxf(l1, l2), l3);
        float w1 = __builtin_amdgcn_exp2f(l1 - mx), w2 = __builtin_amdgcn_exp2f(l2 - mx), w3 = __builtin_amdgcn_exp2f(l3 - mx); const float inv = 1.0f / (w1 + w2 + w3); w1 *= inv; w2 *= inv; w3 *= inv;
        const size_t off = (size_t)t * 768 + h * 64 + 8 * ch;
        const v4u a = *(const v4u*)(O1 + off), bq = *(const v4u*)(O2 + off), cq = *(const v4u*)(O3 + off);
        v4u o;
        o.x = pk2(w1 * bflo(a.x) + w2 * bflo(bq.x) + w3 * bflo(cq.x), w1 * bfhi(a.x) + w2 * bfhi(bq.x) + w3 * bfhi(cq.x));
        o.y = pk2(w1 * bflo(a.y) + w2 * bflo(bq.y) + w3 * bflo(cq.y), w1 * bfhi(a.y) + w2 * bfhi(bq.y) + w3 * bfhi(cq.y));
        o.z = pk2(w1 * bflo(a.z) + w2 * bflo(bq.z) + w3 * bflo(cq.z), w1 * bfhi(a.z) + w2 * bfhi(bq.z) + w3 * bfhi(cq.z));
        o.w = pk2(w1 * bflo(a.w) + w2 * bflo(bq.w) + w3 * bflo(cq.w), w1 * bfhi(a.w) + w2 * bfhi(bq.w) + w3 * bfhi(cq.w));
        *(v4u*)(MIX + (size_t)t * DM + 256 + h * 64 + 8 * ch) = o;
    }
}


__host__ __device__ constexpr int stair2_slot(int i, int j) { int n = 0; for (int a = 1; a < 16; ++a) for (int b = 1; b < 16; ++b) if ((a + 1) * (b + 1) <= 16) { if (a == i && b == j) return n; ++n; } return n; }
__device__ __forceinline__ float kmax(float a, float b) { float r; asm("v_max_f32_e32 %0, %1, %2" : "=v"(r) : "v"(a), "v"(b)); return r; }
__device__ __forceinline__ float kmin(float a, float b) { float r; asm("v_min_f32_e32 %0, %1, %2" : "=v"(r) : "v"(a), "v"(b)); return r; }
__device__ __forceinline__ float fkeyf(float s, unsigned low, unsigned mask) { return __builtin_bit_cast(float, (__builtin_bit_cast(unsigned, s) & ~mask) | low); }
__device__ __forceinline__ float fvalf(float k, unsigned mask) { return __builtin_bit_cast(float, (__builtin_bit_cast(unsigned, k) & ~mask) | (mask >> 1)); }
#define CE_DESC(a, b) do { const float _mx = kmax((a), (b)), _mn = kmin((a), (b)); (a) = _mx; (b) = _mn; } while (0)
__device__ __forceinline__ void sort16_desc(float (&a)[16]) {
#pragma unroll
    for (int k = 2; k <= 16; k <<= 1)
#pragma unroll
        for (int j = k >> 1; j > 0; j >>= 1)
#pragma unroll
            for (int i = 0; i < 16; ++i) { const int l = i ^ j; if (l > i) { if ((i & k) == 0) CE_DESC(a[i], a[l]); else CE_DESC(a[l], a[i]); } }
}
__device__ __forceinline__ void merge16_desc(float (&c)[16]) {
#pragma unroll
    for (int j = 8; j > 0; j >>= 1)
#pragma unroll
        for (int i = 0; i < 16; ++i) { const int l = i ^ j; if (l > i) CE_DESC(c[i], c[l]); }
}
__device__ __forceinline__ void top16_merge(float (&a)[16], const float (&b)[16]) {
#pragma unroll
    for (int i = 0; i < 16; ++i) a[i] = kmax(a[i], b[15 - i]);
    merge16_desc(a);
}
__device__ __forceinline__ void top16_of_64(float (&g0)[16], float (&g1)[16], float (&g2)[16], float (&g3)[16]) {
    sort16_desc(g0); sort16_desc(g1); sort16_desc(g2); sort16_desc(g3);
    top16_merge(g0, g1); top16_merge(g2, g3); top16_merge(g0, g2);
}
__device__ __forceinline__ void ph_topk_fast(const Params& p, LAS unsigned char* lds, int bid, int nblk) {
    const int lane = opaque_tid() & 63, wave = wave_id(), r32 = lane & 31, hi = lane >> 5;
    const bf16* PQ = (const bf16*)(p.ws + WS_PQ); const bf16* SK = (const bf16*)(p.ws + WS_SUBK);
    unsigned short* ids = (unsigned short*)(p.ws + WS_IDS); float* gates = (float*)(p.ws + WS_GATES);
    const float* SVt = (const float*)(p.ws + WS_SV);
    LAS unsigned* myl = (LAS unsigned*)(lds + wave * 16384 + lane * 4);
    const float NEGINF = -INFINITY;
    for (int it = bid * NWAVES + wave; it < (NT / 32) * 8; it += nblk * NWAVES) {
        const int tt = it >> 3, h = it & 7, t = tt * 32 + r32;
        float K[2][16];
#pragma unroll
        for (int pp = 0; pp < 2; ++pp) {
            bf16x8_t qf[4];
            { const bf16* qp = PQ + (size_t)t * DM + h * 128 + pp * 64 + 8 * hi;
#pragma unroll
              for (int d0 = 0; d0 < 4; ++d0) qf[d0] = *(const bf16x8_t*)(qp + 16 * d0); }
            float g[4][16];
#pragma unroll
            for (int mt = 0; mt < 4; ++mt) {
                const bf16* kp = SK + ((size_t)((h * 2 + pp) * 4 + mt) * 4 * 64 + lane) * 8;
                f32x16 a = {0.f, 0.f, 0.f, 0.f, 0.f, 0.f, 0.f, 0.f, 0.f, 0.f, 0.f, 0.f, 0.f, 0.f, 0.f, 0.f};
#pragma unroll
                for (int d0 = 0; d0 < 4; ++d0) a = __builtin_amdgcn_mfma_f32_32x32x16_bf16(*(const bf16x8_t*)(kp + d0 * 512), qf[d0], a, 0, 0, 0);
#pragma unroll
                for (int r = 0; r < 16; ++r) g[mt][r] = fkeyf(a[r], 127u - (unsigned)(32 * mt + crow(r, hi)), 127u);
            }
            top16_of_64(g[0], g[1], g[2], g[3]);
            float o[16];
#pragma unroll
            for (int i = 0; i < 16; ++i) o[i] = __shfl_xor(g[0][i], 32);
            top16_merge(g[0], o);
#pragma unroll
            for (int i = 0; i < 16; ++i) K[pp][i] = g[0][i];
        }
#pragma unroll
        for (int i = 0; i < 16; ++i) { myl[i * 64] = __builtin_bit_cast(unsigned, K[0][i]); myl[(16 + i) * 64] = __builtin_bit_cast(unsigned, K[1][i]); }
        float v0[16], v1[16];
#pragma unroll
        for (int i = 0; i < 16; ++i) { v0[i] = fvalf(K[0][i], 127u); v1[i] = fvalf(K[1][i], 127u); }
        float cA[16], cB[16], cC[16], cD[16];
#pragma unroll
        for (int j = 0; j < 16; ++j) cA[j] = fkeyf(v0[0] + v1[j], 255u - (unsigned)j, 255u);
#pragma unroll
        for (int i = 1; i < 16; ++i) cB[i - 1] = fkeyf(v0[i] + v1[0], 255u - (unsigned)(16 * i), 255u);
        cB[15] = NEGINF;
#pragma unroll
        for (int q = 0; q < 16; ++q) { cC[q] = NEGINF; cD[q] = NEGINF; }
        { int n = 0;
#pragma unroll
          for (int i = 1; i < 8; ++i)
#pragma unroll
              for (int j = 1; j < 8; ++j) if ((i + 1) * (j + 1) <= 16) { const int m = stair2_slot(i, j); const float kv = fkeyf(v0[i] + v1[j], 255u - (unsigned)(16 * i + j), 255u); if (m < 16) cC[m] = kv; else cD[m - 16] = kv; }
          (void)n; }
        sort16_desc(cC);
        CE_DESC(cD[0], cD[1]); CE_DESC(cD[1], cD[2]); CE_DESC(cD[0], cD[1]);
        top16_merge(cA, cB); top16_merge(cC, cD); top16_merge(cA, cC);
        float e[16]; float sum = 0.f; const float mx = fvalf(cA[0], 255u);
#pragma unroll
        for (int r = 0; r < 16; ++r) { e[r] = __builtin_amdgcn_exp2f((fvalf(cA[r], 255u) - mx) * 1.4426950408889634f); sum += e[r]; }
        const float inv = __builtin_amdgcn_rcpf(sum);
        int eid[16];
#pragma unroll
        for (int r = 0; r < 16; ++r) { const unsigned id8 = 255u - (__builtin_bit_cast(unsigned, cA[r]) & 255u); const unsigned k0 = myl[(id8 >> 4) * 64], k1 = myl[(16 + (id8 & 15)) * 64];
            eid[r] = (int)((127u - (k0 & 127u)) * 128u + (127u - (k1 & 127u))); }
        int tq = t; asm volatile("" : "+v"(tq));
        if (hi == 0) {
#pragma unroll
            for (int q = 0; q < 2; ++q) *(v4u*)(ids + (size_t)tq * 128 + h * 16 + 8 * q) = (v4u){(unsigned)eid[8 * q] | ((unsigned)eid[8 * q + 1] << 16), (unsigned)eid[8 * q + 2] | ((unsigned)eid[8 * q + 3] << 16),
                                                                                      (unsigned)eid[8 * q + 4] | ((unsigned)eid[8 * q + 5] << 16), (unsigned)eid[8 * q + 6] | ((unsigned)eid[8 * q + 7] << 16)};
        } else {
#pragma unroll
            for (int q = 0; q < 4; ++q) *(f32x4*)(gates + (size_t)tq * 128 + h * 16 + 4 * q) = (f32x4){e[4 * q] * inv * SVt[eid[4 * q]], e[4 * q + 1] * inv * SVt[eid[4 * q + 1]], e[4 * q + 2] * inv * SVt[eid[4 * q + 2]], e[4 * q + 3] * inv * SVt[eid[4 * q + 3]]};
        }
    }
}

__device__ __forceinline__ void ph_ln1_fast(const Params& p, int bid, int nblk) {
    const bf16* y1 = (const bf16*)(p.ws + WS_Y1); bf16* x1 = (bf16*)(p.ws + WS_X1); bf16* h2b = (bf16*)(p.ws + WS_XN); const float* mod = (const float*)(p.ws + WS_MOD);
    const int lane = opaque_tid() & 63, wave = wave_id();
    for (int row = bid * NWAVES + wave; row < NT; row += nblk * NWAVES) {
        const int b = row / SEQ;
        const v2u* yr = (const v2u*)(y1 + (size_t)row * DM) + lane;
        f32x4 v[4]; float s = 0.f;
#pragma unroll
        for (int j = 0; j < 4; ++j) { const v2u w = yr[64 * j]; v[j] = (f32x4){bflo(w.x), bfhi(w.x), bflo(w.y), bfhi(w.y)}; s += (v[j].x + v[j].y) + (v[j].z + v[j].w); }
        float mean = wave_sum(s) * (1.f / DM); float s2 = 0.f;
#pragma unroll
        for (int j = 0; j < 4; ++j) { v[j] = v[j] - mean; s2 += (v[j].x * v[j].x + v[j].y * v[j].y) + (v[j].z * v[j].z + v[j].w * v[j].w); }
        float rstd = rsqrtf(wave_sum(s2) * (1.f / DM) + LN_EPS);
        s = 0.f;
#pragma unroll
        for (int j = 0; j < 4; ++j) { const f32x4 g = *((const f32x4*)p.g1 + lane + 64 * j), be = *((const f32x4*)p.be1 + lane + 64 * j);
            v[j] = v[j] * rstd * g + be; *((v2u*)(x1 + (size_t)row * DM) + lane + 64 * j) = (v2u){pk2(v[j].x, v[j].y), pk2(v[j].z, v[j].w)}; s += (v[j].x + v[j].y) + (v[j].z + v[j].w); }
        mean = wave_sum(s) * (1.f / DM); s2 = 0.f;
#pragma unroll
        for (int j = 0; j < 4; ++j) { v[j] = v[j] - mean; s2 += (v[j].x * v[j].x + v[j].y * v[j].y) + (v[j].z * v[j].z + v[j].w * v[j].w); }
        rstd = rsqrtf(wave_sum(s2) * (1.f / DM) + LN_EPS);
        float amax = 0.f;
#pragma unroll
        for (int j = 0; j < 4; ++j) {
            const f32x4 sh = *((const f32x4*)(mod + b * 6144 + 3072) + lane + 64 * j), sc = *((const f32x4*)(mod + b * 6144 + 4096) + lane + 64 * j);
            const f32x4 o = v[j] * rstd * (1.0f + sc) + sh; v[j] = o;
            amax = fmaxf(amax, fmaxf(fmaxf(fabsf(o.x), fabsf(o.y)), fmaxf(fabsf(o.z), fabsf(o.w))));
            *((v2u*)(h2b + (size_t)row * DM) + lane + 64 * j) = (v2u){pk2(o.x, o.y), pk2(o.z, o.w)};
        }
        amax = wave_max(amax); const float hinv = amax > 0.f ? 127.0f / amax : 0.f;
        unsigned* q4 = (unsigned*)(p.ws + WS_H2Q + (size_t)row * DM) + lane;
#pragma unroll
        for (int j = 0; j < 4; ++j) { unsigned q = 0u;
            q = __builtin_amdgcn_cvt_pk_u8_f32(v[j].x * hinv + 128.0f, 0, q); q = __builtin_amdgcn_cvt_pk_u8_f32(v[j].y * hinv + 128.0f, 1, q);
            q = __builtin_amdgcn_cvt_pk_u8_f32(v[j].z * hinv + 128.0f, 2, q); q = __builtin_amdgcn_cvt_pk_u8_f32(v[j].w * hinv + 128.0f, 3, q);
            q4[64 * j] = q ^ 0x80808080u; }
        if (lane == 0) ((float*)(p.ws + WS_HS))[row] = amax * (1.0f / 127.0f);
    }
}
__device__ __forceinline__ void ph_tables8(const Params& p, int bid, int nblk) {
    const int lane = opaque_tid() & 63, wave = wave_id();
    for (int r = bid * NWAVES + wave; r < 2 * 16384; r += nblk * NWAVES) {
        const bool isv = r >= 16384; const int row = isv ? r - 16384 : r;
        const f32x4* src = (const f32x4*)((isv ? p.pv : p.pu) + (size_t)row * DM + 16 * lane);
        f32x4 a[4]; float amax = 0.f;
#pragma unroll
        for (int j = 0; j < 4; ++j) { a[j] = src[j]; amax = fmaxf(amax, fmaxf(fmaxf(fabsf(a[j].x), fabsf(a[j].y)), fmaxf(fabsf(a[j].z), fabsf(a[j].w)))); }
        amax = wave_max(amax);
        const float inv = amax > 0.f ? 127.0f / amax : 0.f;
        v4u o;
#pragma unroll
        for (int j = 0; j < 4; ++j) { unsigned q = 0u;
            q = __builtin_amdgcn_cvt_pk_u8_f32(a[j].x * inv + 128.0f, 0, q); q = __builtin_amdgcn_cvt_pk_u8_f32(a[j].y * inv + 128.0f, 1, q);
            q = __builtin_amdgcn_cvt_pk_u8_f32(a[j].z * inv + 128.0f, 2, q); q = __builtin_amdgcn_cvt_pk_u8_f32(a[j].w * inv + 128.0f, 3, q);
            o[j] = q ^ 0x80808080u; }
        *(v4u*)(p.ws + (isv ? WS_TV8 : WS_TU8) + (size_t)(lane >> 3) * (2 * MiB) + (size_t)row * 128 + 16 * (lane & 7)) = o;
        if (lane == 0) ((float*)(p.ws + (isv ? WS_SV : WS_SU)))[row] = amax * (1.0f / 127.0f);
    }
}
__device__ __forceinline__ float readlane_f(float v, int l) { return __builtin_bit_cast(float, __builtin_amdgcn_readlane(__builtin_bit_cast(int, v), l)); }
__device__ __forceinline__ float ub0(unsigned u) { return (float)(u & 255u); }
__device__ __forceinline__ float ub1(unsigned u) { return (float)((u >> 8) & 255u); }
__device__ __forceinline__ float ub2(unsigned u) { return (float)((u >> 16) & 255u); }
__device__ __forceinline__ float ub3(unsigned u) { return (float)(u >> 24); }
__device__ __forceinline__ v4u ust_meta(const Params& p, int step, int t0, int stride8, int lane) {
    const int g = step >> 4, k = step & 15; int t = t0 + g * stride8 + (lane >> 3); t = t < NT ? t : NT - 1;
    return *(const v4u*)(p.ws + WS_IDS + (size_t)t * 256 + 16 * k);
}
__device__ __forceinline__ void ust_issue(v4u (&ub)[8], const v4u& idq, const unsigned char* TUs) {
#pragma unroll
    for (int e = 0; e < 8; ++e) { const unsigned w = idq[e >> 1]; const unsigned id = (e & 1) ? (w >> 16) : (w & 0xffffu); ub[e] = *(const v4u*)(TUs + (size_t)id * 128); }
}
__device__ __forceinline__ unsigned short ust_compute(const v4u (&ub)[8], const v4u& idq, const v4u& h0, const v4u& h1, int off8, const float* SUs, int lane) {
    int a[8];
#pragma unroll
    for (int e = 0; e < 8; ++e) { int v = 0;
#pragma unroll
        for (int j = 0; j < 4; ++j) { const unsigned d = ub[e][j]; const unsigned lo = d & 0x0f0f0f0fu, hi = (d >> 4) & 0x0f0f0f0fu;
            const unsigned hl = j < 2 ? h0[2 * j] : h1[2 * j - 4], hh = j < 2 ? h0[2 * j + 1] : h1[2 * j - 3];
            v = __builtin_amdgcn_sdot4((int)lo, (int)hl, v, false); v = __builtin_amdgcn_sdot4((int)hi, (int)hh, v, false); }
        a[e] = v; }
    int a4[4];
#pragma unroll
    for (int k = 0; k < 4; ++k) { const bool up = (lane & 4) != 0; const int keep = up ? a[k + 4] : a[k], send = up ? a[k] : a[k + 4]; a4[k] = keep + __shfl_xor(send, 4); }
    int a2[2];
#pragma unroll
    for (int k = 0; k < 2; ++k) { const bool up = (lane & 2) != 0; const int keep = up ? a4[k + 2] : a4[k], send = up ? a4[k] : a4[k + 2]; a2[k] = keep + __shfl_xor(send, 2); }
    const bool up = (lane & 1) != 0; const int keep = up ? a2[1] : a2[0], send = up ? a2[0] : a2[1];
    const int tot = keep + __shfl_xor(send, 1);
    const int c = lane & 7; const unsigned w2 = (c >> 1) == 0 ? idq.x : ((c >> 1) == 1 ? idq.y : ((c >> 1) == 2 ? idq.z : idq.w));
    const unsigned id = (c & 1) ? (w2 >> 16) : (w2 & 0xffffu);
    return (unsigned short)f2bf((float)(tot - off8) * SUs[id]);
}
__device__ __forceinline__ void ph_udot(const Params& p, int bid, int nblk) {
    unsigned short* P = (unsigned short*)(p.ws + WS_PART);
    const int lane = opaque_tid() & 63, wave = wave_id(), c = lane & 7;
    const int s8 = bid & 7, s = s8 & 3;
    const int nlo = (nblk - s + 7) >> 3, nhi = (nblk - (s + 4) + 7) >> 3;
    const int widx = ((s8 >> 2) ? nlo : 0) * NWAVES + (bid >> 3) * NWAVES + wave, stride8 = (nlo + nhi) * NWAVES * 8;
    const unsigned char* TUs = p.ws + WS_TU8 + (size_t)s * (2 * MiB) + 16 * c;
    const float* SUs = (const float*)(p.ws + WS_SU) + (size_t)s * 16384;
    const int t0 = widx * 8;
    const int ngroups = t0 < NT ? (NT - t0 + stride8 - 1) / stride8 : 0, nsteps = ngroups * 16;
    if (nsteps == 0) return;
    v4u uA[8], uB[8];
    v4u qa = ust_meta(p, 0, t0, stride8, lane);
    ust_issue(uA, qa, TUs);
    v4u qb = ust_meta(p, 1, t0, stride8, lane);
    v4u h0 = {0u, 0u, 0u, 0u}, h1 = {0u, 0u, 0u, 0u}; int off8 = 0;
    for (int st = 0; st < nsteps; st += 2) {
        const int tg = t0 + (st >> 4) * stride8 + (lane >> 3); const int t = tg < NT ? tg : NT - 1;
        if ((st & 15) == 0) {
            const unsigned char* hp = p.ws + WS_H2Q + (size_t)t * DM + 256 * s + 32 * c; h0 = *(const v4u*)hp; h1 = *(const v4u*)(hp + 16);
            int hs = 0;
#pragma unroll
            for (int j = 0; j < 4; ++j) { hs = __builtin_amdgcn_sdot4((int)h0[j], 0x01010101, hs, false); hs = __builtin_amdgcn_sdot4((int)h1[j], 0x01010101, hs, false); }
            hs += __shfl_xor(hs, 1); hs += __shfl_xor(hs, 2); hs += __shfl_xor(hs, 4); off8 = 8 * hs;
        }
        ust_issue(uB, qb, TUs);
        const v4u ia = qa; qa = ust_meta(p, st + 2 < nsteps ? st + 2 : st, t0, stride8, lane);
        const unsigned short ra = ust_compute(uA, ia, h0, h1, off8, SUs, lane);
        if (st + 2 < nsteps) ust_issue(uA, qa, TUs);
        const v4u ib = qb; qb = ust_meta(p, st + 3 < nsteps ? st + 3 : st + 1, t0, stride8, lane);
        const unsigned short rb = ust_compute(uB, ib, h0, h1, off8, SUs, lane);
        if (tg < NT) { unsigned short* dst = P + ((size_t)t * 4 + s) * 128 + 8 * (st & 15) + c; dst[0] = ra; dst[8] = rb; }
    }
}
__device__ __forceinline__ void ph_act(const Params& p, int bid, int nblk) {
    const bf16* P = (const bf16*)(p.ws + WS_PART); const float* GS = (const float*)(p.ws + WS_GATES); const float* HS = (const float*)(p.ws + WS_HS);
    unsigned char* WQ = p.ws + WS_WQ; float* WSC = (float*)(p.ws + WS_WSC);
    const int lane = opaque_tid() & 63, wave = wave_id();
    for (int t = bid * NWAVES + wave; t < NT; t += nblk * NWAVES) {
        float a0 = 0.f, a1 = 0.f;
#pragma unroll
        for (int s = 0; s < 4; ++s) { a0 += __builtin_bit_cast(float, (unsigned)P[((size_t)t * 4 + s) * 128 + lane] << 16); a1 += __builtin_bit_cast(float, (unsigned)P[((size_t)t * 4 + s) * 128 + 64 + lane] << 16); }
        const float hs = HS[t];
        const float d0 = a0 * hs, d1 = a1 * hs;
        const float w0 = GS[(size_t)t * 128 + lane] * 0.5f * d0 * (1.0f + erff(d0 * 0.70710678118654752f));
        const float w1 = GS[(size_t)t * 128 + 64 + lane] * 0.5f * d1 * (1.0f + erff(d1 * 0.70710678118654752f));
        const float wmax = wave_max(fmaxf(fabsf(w0), fabsf(w1))); const float winv = wmax > 0.f ? 127.0f / wmax : 0.f;
        unsigned b2 = __builtin_amdgcn_cvt_pk_u8_f32(w0 * winv + 128.0f, 0, 0u); b2 = __builtin_amdgcn_cvt_pk_u8_f32(w1 * winv + 128.0f, 1, b2); b2 ^= 0x8080u;
        WQ[(size_t)t * 128 + lane] = (unsigned char)(b2 & 255u); WQ[(size_t)t * 128 + 64 + lane] = (unsigned char)((b2 >> 8) & 255u);
        if (lane == 0) WSC[t] = wmax * (1.0f / 127.0f);
    }
}
struct VstepMeta { v4u idq; v2u wq; };
__device__ __forceinline__ VstepMeta vst_meta(const Params& p, int step, int t0, int stride8, int lane) {
    const int g = step >> 4, k = step & 15; int t = t0 + g * stride8 + (lane >> 3); t = t < NT ? t : NT - 1;
    VstepMeta r; r.idq = *(const v4u*)(p.ws + WS_IDS + (size_t)t * 256 + 16 * k); r.wq = *(const v2u*)(p.ws + WS_WQ + (size_t)t * 128 + 8 * k); return r;
}
__device__ __forceinline__ void vst_issue(v4u (&vb)[8], const VstepMeta& q, const unsigned char* TVs) {
#pragma unroll
    for (int e = 0; e < 8; ++e) { const unsigned w = q.idq[e >> 1]; const unsigned id = (e & 1) ? (w >> 16) : (w & 0xffffu); vb[e] = *(const v4u*)(TVs + (size_t)id * 128); }
}
__device__ __forceinline__ void vst_compute(int (&y)[16], const v4u (&vb)[8], const v2u& wq) {
#pragma unroll
    for (int qd = 0; qd < 2; ++qd)
#pragma unroll
        for (int cm = 0; cm < 4; ++cm) {
            const unsigned A = vb[4 * qd][cm], B = vb[4 * qd + 1][cm], C = vb[4 * qd + 2][cm], D = vb[4 * qd + 3][cm];
            const unsigned ab01 = __builtin_amdgcn_perm(B, A, 0x05010400u), ab23 = __builtin_amdgcn_perm(B, A, 0x07030602u);
            const unsigned cd01 = __builtin_amdgcn_perm(D, C, 0x05010400u), cd23 = __builtin_amdgcn_perm(D, C, 0x07030602u);
            const unsigned t0 = __builtin_amdgcn_perm(cd01, ab01, 0x05040100u), t1 = __builtin_amdgcn_perm(cd01, ab01, 0x07060302u);
            const unsigned t2 = __builtin_amdgcn_perm(cd23, ab23, 0x05040100u), t3 = __builtin_amdgcn_perm(cd23, ab23, 0x07060302u);
            y[4 * cm + 0] = __builtin_amdgcn_sdot4((int)t0, (int)wq[qd], y[4 * cm + 0], false); y[4 * cm + 1] = __builtin_amdgcn_sdot4((int)t1, (int)wq[qd], y[4 * cm + 1], false);
            y[4 * cm + 2] = __builtin_amdgcn_sdot4((int)t2, (int)wq[qd], y[4 * cm + 2], false); y[4 * cm + 3] = __builtin_amdgcn_sdot4((int)t3, (int)wq[qd], y[4 * cm + 3], false);
        }
}
__device__ __forceinline__ void ph_vacc(const Params& p, int bid, int nblk) {
    bf16* Y = (bf16*)(p.ws + WS_Y); const float* WSC = (const float*)(p.ws + WS_WSC);
    const int lane = opaque_tid() & 63, wave = wave_id(), c = lane & 7;
    const int s = bid & 7, nper = (nblk - s + 7) >> 3,     stride8 = nper * NWAVES * 8;
    const unsigned char* TVs = p.ws + WS_TV8 + (size_t)s * (2 * MiB) + 16 * c;
    const int t0 = ((bid >> 3) * NWAVES + wave) * 8;
    const int ngroups = t0 < NT ? (NT - t0 + stride8 - 1) / stride8 : 0, nsteps = ngroups * 16;
    if (nsteps == 0) return;
    int y[16];
#pragma unroll
    for (int k = 0; k < 16; ++k) y[k] = 0;
    v4u vA[8], vB[8];
    VstepMeta qa = vst_meta(p, 0, t0, stride8, lane);
    vst_issue(vA, qa, TVs);
    VstepMeta qb = vst_meta(p, 1, t0, stride8, lane);
    for (int st = 0; st < nsteps; st += 2) {
        vst_issue(vB, qb, TVs);
        const v2u wa = qa.wq; qa = vst_meta(p, st + 2 < nsteps ? st + 2 : st, t0, stride8, lane);
        vst_compute(y, vA, wa);
        if (st + 2 < nsteps) vst_issue(vA, qa, TVs);
        const v2u wb = qb.wq; qb = vst_meta(p, st + 3 < nsteps ? st + 3 : st + 1, t0, stride8, lane);
        vst_compute(y, vB, wb);
        if (((st + 1) & 15) == 15) {
            const int t = t0 + (st >> 4) * stride8 + (lane >> 3);
            if (t < NT) { const float sc = WSC[t];
                v4u o0, o1; o0.x = pk2((float)y[0] * sc, (float)y[1] * sc); o0.y = pk2((float)y[2] * sc, (float)y[3] * sc); o0.z = pk2((float)y[4] * sc, (float)y[5] * sc); o0.w = pk2((float)y[6] * sc, (float)y[7] * sc);
                o1.x = pk2((float)y[8] * sc, (float)y[9] * sc); o1.y = pk2((float)y[10] * sc, (float)y[11] * sc); o1.z = pk2((float)y[12] * sc, (float)y[13] * sc); o1.w = pk2((float)y[14] * sc, (float)y[15] * sc);
                v4u* dst = (v4u*)(Y + (size_t)t * DM + 128 * s + 16 * c); dst[0] = o0; dst[1] = o1; }
#pragma unroll
            for (int k = 0; k < 16; ++k) y[k] = 0;
        }
    }
}
__device__ __forceinline__ void ph_final(const Params& p, int bid, int nblk) {
    const bf16* x1 = (const bf16*)(p.ws + WS_X1); const bf16* Y = (const bf16*)(p.ws + WS_Y); const float* mod = (const float*)(p.ws + WS_MOD);
    const int lane = opaque_tid() & 63, wave = wave_id();
    for (int t = bid * NWAVES + wave; t < NT; t += nblk * NWAVES) {
        const int b = t / SEQ;
        f32x4 v[4]; float s = 0.f;
#pragma unroll
        for (int j = 0; j < 4; ++j) { const v2u xw = *((const v2u*)(x1 + (size_t)t * DM) + lane + 64 * j), yw = *((const v2u*)(Y + (size_t)t * DM) + lane + 64 * j);
            const f32x4 g2 = *((const f32x4*)(mod + b * 6144 + 5120) + lane + 64 * j);
            const f32x4 xv = {bflo(xw.x), bfhi(xw.x), bflo(xw.y), bfhi(xw.y)}, yv = {bflo(yw.x), bfhi(yw.x), bflo(yw.y), bfhi(yw.y)};
            v[j] = xv * ALPHA + (g2 + 1.0f) * yv; s += (v[j].x + v[j].y) + (v[j].z + v[j].w); }
        const float mean = wave_sum(s) * (1.f / DM); float s2 = 0.f;
#pragma unroll
        for (int j = 0; j < 4; ++j) { v[j] = v[j] - mean; s2 += (v[j].x * v[j].x + v[j].y * v[j].y) + (v[j].z * v[j].z + v[j].w * v[j].w); }
        const float rstd = rsqrtf(wave_sum(s2) * (1.f / DM) + LN_EPS);
#pragma unroll
        for (int j = 0; j < 4; ++j) { const f32x4 g = *((const f32x4*)p.g2 + lane + 64 * j), be = *((const f32x4*)p.be2 + lane + 64 * j);
            *((f32x4*)(p.out + (size_t)t * DM) + lane + 64 * j) = v[j] * rstd * g + be; }
    }
}

#ifndef PROBE_ID
#define PROBE_ID 0
#endif
#define RUN2(id, ...) do { __VA_ARGS__; if (PROBE_ID == (id)) { xcd_barrier(bar); __VA_ARGS__; } } while (0)
__global__ void __launch_bounds__(NTHREADS, 2) mega(Params p) {
    extern __shared__ __attribute__((aligned(16))) unsigned char lds_raw[];

    LAS unsigned char* lds = (LAS unsigned char*)lds_raw;
    const int bid = blockIdx.x, nblk = gridDim.x, tid = opaque_tid();
    for (int u = tid; u < (LDS_BYTES - LDSCTL_OFF) / 4; u += NTHREADS) ((LAS unsigned*)(lds + LDSCTL_OFF))[u] = 0u;
    __syncthreads();
    unsigned* ctl = (unsigned*)(p.ws + WS_CTL);
    XcdBarrier bar = xcd_barrier_post(ctl + CW_BAR, (volatile LAS unsigned*)(lds + MISC_OFF) + 8);
    const float* mod = (const float*)(p.ws + WS_MOD);

    ph_mod(p, lds, bid, nblk);
    xcd_barrier(bar);
    RUN2(1, ph_prologue(p, lds, bid, nblk));
    RUN2(7, ph_xn(p, bid, nblk));
    xcd_barrier(bar);
    {
        pg8::Gemm g{(const pg8::bf16_t*)(p.ws + WS_XN), (const pg8::bf16_t*)(p.ws + WS_WIN), NT, NIN, DM}; pg8::StaticOrder S; S.init(NT, NIN, nblk, bid);
        EpiIn E{(bf16*)(p.ws + WS_FZ), (bf16*)(p.ws + WS_QB), (const float*)(p.ws + WS_MISC), p.pos};
        pg8::gemm_phase<EpiIn, pg8::StaticOrder, true, true>(lds, g, S, E);
    }
    xcd_barrier(bar);
    RUN2(8, ph_fft(p, lds, bid, nblk));
    RUN2(2, ph_attn_fast(p, lds, bid, nblk));
    xcd_barrier(bar);
    RUN2(3, ph_merge(p, bid, nblk));
    xcd_barrier(bar);
    {
        pg8::Gemm g{(const pg8::bf16_t*)(p.ws + WS_XN), (const pg8::bf16_t*)(p.ws + WS_WOUT), NT, DM, DM}; pg8::StaticOrder S; S.init(NT, DM, nblk, bid);
        EpiOut E{(bf16*)(p.ws + WS_Y1), p.x, mod, p.b_out};
        pg8::gemm_phase<EpiOut, pg8::StaticOrder, true, true>(lds, g, S, E);
    }
    xcd_barrier(bar);
    RUN2(4, ph_ln1_fast(p, bid, nblk));
    xcd_barrier(bar);
    {
        pg8::Gemm g{(const pg8::bf16_t*)(p.ws + WS_XN), (const pg8::bf16_t*)(p.ws + WS_WPQ), NT, DM, DM}; pg8::StaticOrder S; S.init(NT, DM, nblk, bid);
        pg8::EpiBf16<0> E{(pg8::bf16_t*)(p.ws + WS_PQ), DM, nullptr, 0, 0, 1.f};
        pg8::gemm_phase<pg8::EpiBf16<0>, pg8::StaticOrder, true, true>(lds, g, S, E);
    }
    xcd_barrier(bar);
    RUN2(5, ph_topk_fast(p, lds, bid, nblk));
    xcd_barrier(bar);
    RUN2(6, ph_udot(p, bid, nblk));
    xcd_barrier(bar);
    RUN2(11, ph_act(p, bid, nblk));
    xcd_barrier(bar);
    RUN2(10, ph_vacc(p, bid, nblk));
    xcd_barrier(bar);
    ph_final(p, bid, nblk);
}

extern "C" void kernel_launch(void* const* d_in, const int* in_sizes, int n_in, void* d_out, int out_size, void* d_ws, size_t ws_size, hipStream_t stream) {
    Params p{};
    p.x = (const float*)d_in[0]; p.c = (const float*)d_in[1]; p.pos = (const int*)d_in[2]; p.w_ada = (const float*)d_in[3]; p.b_ada = (const float*)d_in[4];
    p.w_in = (const float*)d_in[5]; p.b_in = (const float*)d_in[6]; p.w_four = (const float*)d_in[7]; p.w_out = (const float*)d_in[8]; p.b_out = (const float*)d_in[9];
    p.g1 = (const float*)d_in[10]; p.be1 = (const float*)d_in[11]; p.w_pq = (const float*)d_in[12]; p.subk = (const float*)d_in[13]; p.pu = (const float*)d_in[14]; p.pv = (const float*)d_in[15];
    p.g2 = (const float*)d_in[16]; p.be2 = (const float*)d_in[17]; p.out = (float*)d_out; p.ws = (unsigned char*)d_ws;
    static int grid_blocks = 0;
    if (grid_blocks == 0) {
        if (ws_size < WS_END) { fprintf(stderr, "workspace too small: %zu < %zu\n", ws_size, (size_t)WS_END); grid_blocks = -1; return; }
        int dev = 0, cus = 0, per_cu = 0;
        if (hipGetDevice(&dev) != hipSuccess || hipDeviceGetAttribute(&cus, hipDeviceAttributeMultiprocessorCount, dev) != hipSuccess) { grid_blocks = -1; return; }
        if (hipFuncSetAttribute((const void*)mega, hipFuncAttributeMaxDynamicSharedMemorySize, LDS_BYTES) != hipSuccess) { fprintf(stderr, "hipFuncSetAttribute failed\n"); grid_blocks = -1; return; }
        if (hipOccupancyMaxActiveBlocksPerMultiprocessor(&per_cu, (const void*)mega, NTHREADS, LDS_BYTES) != hipSuccess || per_cu < 1) { fprintf(stderr, "occupancy query: %d\n", per_cu); grid_blocks = -1; return; }
        grid_blocks = cus;
    }
    if (grid_blocks < 0) return;
    if (hipMemsetAsync((char*)d_ws + WS_CTL, 0, CTL_ZERO_BYTES, stream) != hipSuccess) { fprintf(stderr, "memset failed\n"); return; }
    void* args[] = {&p};
    hipError_t e = hipLaunchCooperativeKernel((void*)mega, dim3(grid_blocks), dim3(NTHREADS), args, LDS_BYTES, stream);
    if (e != hipSuccess) fprintf(stderr, "cooperative launch failed: %s (grid %d)\n", hipGetErrorString(e), grid_blocks);
}
```

```cpp
#include <hip/hip_runtime.h>
#include <hip/hip_cooperative_groups.h>
#include <cstdio>
#include <cstdint>
#include <cmath>
namespace cg = cooperative_groups;

namespace pg8 {
#define PG8_LAS __attribute__((address_space(3)))
typedef unsigned short bf16_t;
typedef short bf16x8 __attribute__((ext_vector_type(8)));
typedef float f32x4 __attribute__((ext_vector_type(4)));
typedef unsigned u32x4 __attribute__((ext_vector_type(4)));
constexpr int BM = 256, BK = 64, HALF = 128, HTB = HALF * BK * 2  , STAGE_BYTES = 8 * HTB, NXCD = 8, WGM = 8;

__host__ __device__ __forceinline__ int lds_byte(int r, int c) { const int st = (r >> 4) * 2 + (c >> 5), rr = r & 15, cc = c & 31, ob = rr * 64 + cc * 2; return st * 1024 + (ob ^ (((ob >> 9) & 1) << 5)); }
__host__ __device__ __forceinline__ void stage_rc(int b, int& R, int& C) { const int st = b / 1024, sb = b % 1024, swz = sb ^ (((sb >> 9) & 1) << 5); R = (st >> 1) * 16 + swz / 64; C = (st & 1) * 32 + (swz % 64) / 2; }
__host__ __device__ __forceinline__ int perm32(int rho) { const int n = rho >> 4, i = rho & 15; return 8 * (i >> 2) + 4 * n + (i & 3); }

struct Unit { int pm, pn; };
struct Gemm { const bf16_t* A; const bf16_t* Bt; int M, N, K; };

struct StaticOrder {
    int nM, nN, nwg, G, c;
    __host__ __device__ void init(int M, int N, int G_, int c_) { nM = M / BM; nN = N / BM; nwg = nM * nN; G = G_; c = c_; }
    __host__ __device__ bool next(int i, Unit& u) const {
        const long L = (long)i * G + c; if (L >= nwg) return false;
        int wgid = (int)L; { const int q = nwg / NXCD, r = nwg % NXCD, xcd = wgid % NXCD, off = wgid / NXCD; wgid = (xcd < r ? xcd * (q + 1) : r * (q + 1) + (xcd - r) * q) + off; }
        const int nig = WGM * nN, gid = wgid / nig, fm = gid * WGM, gsz = (nM - fm) < WGM ? (nM - fm) : WGM;
        u.pm = fm + ((wgid % nig) % gsz); u.pn = (wgid % nig) / gsz; return true;
    }
    __device__ __forceinline__ void a_ready(const Unit&) const {}
    __device__ __forceinline__ void done(const Unit&) const {}
};

__device__ __forceinline__ unsigned cvt_pk_bf16(float lo, float hi) { unsigned r; asm volatile("v_cvt_pk_bf16_f32 %0, %1, %2" : "=v"(r) : "v"(lo), "v"(hi)); return r; }
typedef float f32x2 __attribute__((ext_vector_type(2)));
__device__ __forceinline__ f32x2 gelu_pk(f32x2 v) {
    const f32x2 av = __builtin_elementwise_abs(v), d = av * 0.2316418882f + 1.0f;
    f32x2 t; t.x = __builtin_amdgcn_rcpf(d.x); t.y = __builtin_amdgcn_rcpf(d.y);
    f32x2 q = t * 0.5307027145f + (-0.7265760135f); q = q * t + 0.7107068705f; q = q * t + (-0.142248368f); q = q * t + 0.127414796f; q = q * t;
    const f32x2 s = (v * v) * (-0.72134752044f);
    f32x2 e; e.x = __builtin_amdgcn_exp2f(s.x); e.y = __builtin_amdgcn_exp2f(s.y);
    const f32x2 m = v * (q * e), r = v - m;
    f32x2 o; o.x = v.x < 0.f ? m.x : r.x; o.y = v.y < 0.f ? m.y : r.y; return o;
}

template <int ACT  > struct EpiBf16 {
    static constexpr bool PERM = true, AFTER_DRAIN = false; static_assert(ACT == 0 || ACT == 1, "EpiBf16: ACT is 0 (none) or 1 (gelu_pk)");
    bf16_t* O; int ldc; const float* bias; int split_cols; size_t split_stride; float scale0;
    __device__ __forceinline__ void operator()(const f32x4 (&acc)[2][2][4][2], const Unit& u, int wr, int wc, int fr, int fq) const {
        const int row0 = u.pm * BM + wr * 64 + fr; int colt = u.pn * BM; bf16_t* base = O;
        float sc = 1.f; if (split_cols) { const int t = colt / split_cols; base += (size_t)t * split_stride; colt -= t * split_cols; if (t == 0) sc = scale0; }
        const int col0 = colt + wc * 32 + 8 * fq, bcol0 = u.pn * BM + wc * 32 + 8 * fq;
        f32x4 bv[2][2];
#pragma unroll
        for (int bj = 0; bj < 2; ++bj)
#pragma unroll
            for (int n = 0; n < 2; ++n) bv[bj][n] = bias ? *(const f32x4*)(bias + bcol0 + bj * HALF + 4 * n) : (f32x4){0.f, 0.f, 0.f, 0.f};
#pragma unroll
        for (int ai = 0; ai < 2; ++ai)
#pragma unroll
            for (int m = 0; m < 4; ++m) { bf16_t* rowp = base + (size_t)(row0 + ai * HALF + m * 16) * ldc + col0;
#pragma unroll
                for (int bj = 0; bj < 2; ++bj) { f32x4 v0 = acc[ai][bj][m][0] + bv[bj][0], v1 = acc[ai][bj][m][1] + bv[bj][1];
                    if (ACT == 1) { f32x2 a = gelu_pk((f32x2){v0[0], v0[1]}), b = gelu_pk((f32x2){v0[2], v0[3]}), c = gelu_pk((f32x2){v1[0], v1[1]}), d = gelu_pk((f32x2){v1[2], v1[3]});
                        v0 = (f32x4){a.x, a.y, b.x, b.y}; v1 = (f32x4){c.x, c.y, d.x, d.y}; }
                    v0 = v0 * sc; v1 = v1 * sc; u32x4 w; w.x = cvt_pk_bf16(v0[0], v0[1]); w.y = cvt_pk_bf16(v0[2], v0[3]); w.z = cvt_pk_bf16(v1[0], v1[1]); w.w = cvt_pk_bf16(v1[2], v1[3]);
                    *(u32x4*)(rowp + bj * HALF) = w; } }
    }
};
template <class Epi, class Sched, bool ALIGN_EPI = false, bool SP2 = false>
__device__ __forceinline__ void gemm_phase(PG8_LAS unsigned char* lds, const Gemm g, const Sched& S, const Epi& E) {
    int tid_ = threadIdx.x; asm volatile("" : "+v"(tid_)); const int tid = tid_, wid = __builtin_amdgcn_readfirstlane(tid >> 6), lane = tid & 63, wr = wid >> 2, wc = wid & 3, fr = lane & 15, fq = lane >> 4;
    const int K = g.K, nt = K / BK;
    unsigned voffA[2], voffB[2];
#pragma unroll
    for (int i = 0; i < 2; ++i) { int R, C; stage_rc(tid * 16 + i * 8192, R, C); const int Rb = Epi::PERM ? ((R & ~31) + perm32(R & 31)) : R;
        voffA[i] = (unsigned)(R * K + C) * 2u; voffB[i] = (unsigned)(Rb * K + C) * 2u; }
    const size_t kstep = (size_t)(BK * 2);
    const size_t hstep = (size_t)HALF * K * 2;
    const size_t tstep = 2 * hstep;
    const unsigned ldsw = (unsigned)wid * 1024u;
    const int aoff = lds_byte(wr * 64 + fr, fq * 8), boff = lds_byte(wc * 32 + fr, fq * 8);
#define PG8_SA(b, h) (((b) * 2 + (h)) * HTB)
#define PG8_SB(b, h) ((4 + (b) * 2 + (h)) * HTB)
#define PG8_STAGE(bufoff, gbase, voff) do { _Pragma("unroll") for (int _i = 0; _i < 2; ++_i) \
        __builtin_amdgcn_global_load_lds((const unsigned*)((const char*)(gbase) + (voff)[_i]), (PG8_LAS unsigned*)(lds + (bufoff) + ldsw + _i * 8192), 16, 0, 0); } while (0)
#define PG8_LDA(dst, b, h) do { _Pragma("unroll") for (int m = 0; m < 4; ++m) _Pragma("unroll") for (int k = 0; k < 2; ++k) dst[m][k] = *(const PG8_LAS bf16x8*)(lds + PG8_SA(b, h) + aoff + m * 2048 + k * 1024); } while (0)
#define PG8_LDB(dst, b, h) do { _Pragma("unroll") for (int n = 0; n < 2; ++n) _Pragma("unroll") for (int k = 0; k < 2; ++k) dst[n][k] = *(const PG8_LAS bf16x8*)(lds + PG8_SB(b, h) + boff + n * 2048 + k * 1024); } while (0)
#define PG8_MMA(ai, bj, At, Bt) do { __builtin_amdgcn_s_setprio(1); _Pragma("unroll") for (int m = 0; m < 4; ++m) _Pragma("unroll") for (int n = 0; n < 2; ++n) _Pragma("unroll") for (int k = 0; k < 2; ++k) \
        acc[ai][bj][m][n] = __builtin_amdgcn_mfma_f32_16x16x32_bf16(Bt[n][k], At[m][k], acc[ai][bj][m][n], 0, 0, 0); __builtin_amdgcn_s_setprio(0); } while (0)
#define PG8_WAIT_V(n) asm volatile("s_waitcnt vmcnt(" #n ")" ::: "memory")
#define PG8_WAIT_L(n) asm volatile("s_waitcnt lgkmcnt(" #n ")" ::: "memory")
#define PG8_BAR __builtin_amdgcn_s_barrier()
#define PG8_SCHED __builtin_amdgcn_sched_barrier(0)
    Unit cur, nxt; int ui = 0;
    if (!S.next(0, cur)) return;
    f32x4 acc[2][2][4][2];
#pragma unroll
    for (int a = 0; a < 2; ++a)
#pragma unroll
        for (int b = 0; b < 2; ++b)
#pragma unroll
            for (int m = 0; m < 4; ++m)
#pragma unroll
                for (int n = 0; n < 2; ++n) acc[a][b][m][n] = (f32x4){0.f, 0.f, 0.f, 0.f};
    bf16x8 At[4][2], B0[2][2], B1[2][2];
    const char* cA = (const char*)g.A + (size_t)cur.pm * tstep; const char* cB = (const char*)g.Bt + (size_t)cur.pn * tstep;
    S.a_ready(cur);
    if constexpr (SP2) {
        PG8_STAGE(PG8_SB(0, 0), cB, voffB); PG8_STAGE(PG8_SB(0, 1), cB + hstep, voffB); PG8_STAGE(PG8_SA(0, 0), cA, voffA); PG8_STAGE(PG8_SA(0, 1), cA + hstep, voffA);
        if (wr == 1) PG8_BAR;
        PG8_WAIT_V(2); PG8_BAR;
        PG8_STAGE(PG8_SB(1, 0), cB + kstep, voffB); PG8_STAGE(PG8_SA(1, 0), cA + kstep, voffA); PG8_STAGE(PG8_SB(1, 1), cB + hstep + kstep, voffB);
        PG8_WAIT_V(6); PG8_BAR;
    } else {
        PG8_STAGE(PG8_SB(0, 0), cB, voffB); PG8_STAGE(PG8_SA(0, 0), cA, voffA); PG8_STAGE(PG8_SB(0, 1), cB + hstep, voffB); PG8_STAGE(PG8_SA(0, 1), cA + hstep, voffA);
        if (wr == 1) PG8_BAR;
        PG8_WAIT_V(4); PG8_BAR;
        PG8_STAGE(PG8_SB(1, 0), cB + kstep, voffB); PG8_STAGE(PG8_SA(1, 0), cA + kstep, voffA); PG8_STAGE(PG8_SB(1, 1), cB + hstep + kstep, voffB);
        PG8_WAIT_V(6); PG8_BAR;
    }
    for (;;) {
        const bool has_next = S.next(ui + 1, nxt);
        const char* nA = has_next ? (const char*)g.A + (size_t)nxt.pm * tstep : cA; const char* nB = has_next ? (const char*)g.Bt + (size_t)nxt.pn * tstep : cB;
        for (int t = 0; t < nt; t += 2) {
            const bool last = (t == nt - 2);
            const char* a1 = cA + (size_t)(t + 1) * kstep;
            const char* a2 = last ? nA : cA + (size_t)(t + 2) * kstep; const char* b2 = last ? nB : cB + (size_t)(t + 2) * kstep;
            const char* a3 = a2 + kstep; const char* b3 = b2 + kstep;
            if (last && has_next) S.a_ready(nxt);
            if constexpr (SP2) {
            PG8_LDB(B0, 0, 0); PG8_LDB(B1, 0, 1); PG8_SCHED; PG8_LDA(At, 0, 0); PG8_STAGE(PG8_SA(1, 1), a1 + hstep, voffA);
            PG8_WAIT_V(8); PG8_WAIT_L(0); PG8_BAR; PG8_MMA(0, 0, At, B0); PG8_MMA(0, 1, At, B1); PG8_BAR; PG8_SCHED;
            PG8_LDA(At, 0, 1); PG8_STAGE(PG8_SB(0, 0), b2, voffB); PG8_STAGE(PG8_SB(0, 1), b2 + hstep, voffB); PG8_STAGE(PG8_SA(0, 0), a2, voffA);
            PG8_WAIT_V(8); PG8_WAIT_L(0); PG8_BAR; PG8_MMA(1, 0, At, B0); PG8_MMA(1, 1, At, B1); PG8_BAR; PG8_SCHED;
            PG8_LDB(B0, 1, 0); PG8_LDB(B1, 1, 1); PG8_SCHED; PG8_LDA(At, 1, 0); PG8_STAGE(PG8_SA(0, 1), a2 + hstep, voffA);
            PG8_WAIT_V(8); PG8_WAIT_L(0); PG8_BAR; PG8_MMA(0, 0, At, B0); PG8_MMA(0, 1, At, B1); PG8_BAR; PG8_SCHED;
            PG8_LDA(At, 1, 1); PG8_STAGE(PG8_SB(1, 0), b3, voffB); PG8_STAGE(PG8_SB(1, 1), b3 + hstep, voffB); PG8_STAGE(PG8_SA(1, 0), a3, voffA);
            PG8_WAIT_V(8); PG8_WAIT_L(0); PG8_BAR; PG8_MMA(1, 0, At, B0); PG8_MMA(1, 1, At, B1); PG8_BAR; PG8_SCHED;
            } else {
            PG8_LDB(B0, 0, 0); PG8_SCHED; PG8_LDA(At, 0, 0); PG8_STAGE(PG8_SA(1, 1), a1 + hstep, voffA);
            PG8_WAIT_L(8); PG8_BAR; PG8_WAIT_L(0); PG8_MMA(0, 0, At, B0); PG8_BAR; PG8_SCHED;
            PG8_LDB(B1, 0, 1); PG8_STAGE(PG8_SB(0, 0), b2, voffB);
            PG8_BAR; PG8_WAIT_L(0); PG8_MMA(0, 1, At, B1); PG8_BAR;
            PG8_LDA(At, 0, 1); PG8_STAGE(PG8_SA(0, 0), a2, voffA);
            PG8_BAR; PG8_WAIT_L(0); PG8_MMA(1, 0, At, B0); PG8_BAR; PG8_SCHED;
            PG8_STAGE(PG8_SB(0, 1), b2 + hstep, voffB);
            PG8_WAIT_V(6); PG8_BAR; PG8_MMA(1, 1, At, B1); PG8_BAR;
            PG8_LDB(B0, 1, 0); PG8_SCHED; PG8_LDA(At, 1, 0); PG8_STAGE(PG8_SA(0, 1), a2 + hstep, voffA);
            PG8_WAIT_L(8); PG8_BAR; PG8_WAIT_L(0); PG8_MMA(0, 0, At, B0); PG8_BAR; PG8_SCHED;
            PG8_LDB(B1, 1, 1); PG8_STAGE(PG8_SB(1, 0), b3, voffB);
            PG8_BAR; PG8_WAIT_L(0); PG8_MMA(0, 1, At, B1); PG8_BAR;
            PG8_LDA(At, 1, 1); PG8_STAGE(PG8_SA(1, 0), a3, voffA);
            PG8_BAR; PG8_WAIT_L(0); PG8_MMA(1, 0, At, B0); PG8_BAR; PG8_SCHED;
            PG8_STAGE(PG8_SB(1, 1), b3 + hstep, voffB);
            PG8_WAIT_V(6); PG8_BAR; PG8_MMA(1, 1, At, B1); PG8_BAR;
            }
        }
        if constexpr (ALIGN_EPI) { if (wr == 0) PG8_BAR; }
        if constexpr (!Epi::AFTER_DRAIN) { E(acc, cur, wr, wc, fr, fq); S.done(cur); }
        if (!has_next) break;
#pragma unroll
        for (int a = 0; a < 2; ++a)
#pragma unroll
            for (int b = 0; b < 2; ++b)
#pragma unroll
                for (int m = 0; m < 4; ++m)
#pragma unroll
                    for (int n = 0; n < 2; ++n) acc[a][b][m][n] = (f32x4){0.f, 0.f, 0.f, 0.f};
        cur = nxt; cA = nA; cB = nB; ++ui;
        if constexpr (ALIGN_EPI) { if (wr == 1) PG8_BAR; }
    }
    PG8_WAIT_V(0);
    if constexpr (!ALIGN_EPI) { if (wr == 0) PG8_BAR; }
    PG8_BAR;
    if constexpr (Epi::AFTER_DRAIN) { E.fused(acc, cur, wr, wc, fr, fq, lds, wid, lane); S.done(cur); }
#undef PG8_SA
#undef PG8_SB
#undef PG8_STAGE
#undef PG8_LDA
#undef PG8_LDB
#undef PG8_MMA
#undef PG8_WAIT_V
#undef PG8_WAIT_L
#undef PG8_BAR
#undef PG8_SCHED
}
}

#define LAS __attribute__((address_space(3)))
#define GAS __attribute__((address_space(1)))
#define XB_TMO      128
#define XB_XCNT(j)  (256  + 64 * (j))
#define XB_XSUB(j)  (1280 + 64 * (j))
#define XB_XGEN(j)  (2304 + 64 * (j))
#define XB_TOP      3328
#define XB_TOPGEN   3392
#define XCD_BAR_WORDS 3456
#define XB_SPIN_CAP (1u << 18)

__device__ __forceinline__ unsigned xb_ld(unsigned* p)              { return __hip_atomic_load(p, __ATOMIC_RELAXED, __HIP_MEMORY_SCOPE_AGENT); }
__device__ __forceinline__ unsigned xb_add(unsigned* p, unsigned v) { return __hip_atomic_fetch_add(p, v, __ATOMIC_RELAXED, __HIP_MEMORY_SCOPE_AGENT); }
__device__ __forceinline__ unsigned xb_xcc_id() { return (unsigned)__builtin_amdgcn_s_getreg((3 << 11) | 20) & 0xFu; }
#define XB_SPIN(cond, bar) do { unsigned _sp = 0; while (cond) { __builtin_amdgcn_s_sleep(1); \
    if ((++_sp & 255u) == 0u) { if (xb_ld(&(bar)[XB_TMO])) break; if (_sp > XB_SPIN_CAP) { atomicAdd(&(bar)[XB_TMO], 1u); break; } } } } while (0)

struct XcdBarrier {
    unsigned* bar; unsigned x;
    volatile LAS unsigned* st;
};

__device__ __forceinline__ XcdBarrier xcd_barrier_post(unsigned* bar, volatile LAS unsigned* st) {
    XcdBarrier b; b.bar = bar; b.x = xb_xcc_id(); b.st = st;
    if (threadIdx.x == 0) (void)xb_add(&bar[XB_XCNT(b.x)], 1u);
    return b;
}
__device__ __forceinline__ void xcd_barrier_complete(unsigned* bar, unsigned x, unsigned& nloc, unsigned& nx) {
    const unsigned G = gridDim.x * gridDim.y * gridDim.z;
    unsigned sum, cnt, mine, sp = 0u;
    for (;;) {
        sum = 0u; cnt = 0u; mine = 0u;
#pragma unroll
        for (unsigned j = 0; j < 16; ++j) { const unsigned c = xb_ld(&bar[XB_XCNT(j)]); sum += c; cnt += (c > 0u) ? 1u : 0u; mine = (j == x) ? c : mine; }
        if (sum == G) break;
        __builtin_amdgcn_s_sleep(1);
        if ((++sp & 255u) == 0u) { if (xb_ld(&bar[XB_TMO])) break; if (sp > XB_SPIN_CAP) { atomicAdd(&bar[XB_TMO], 1u); break; } }
    }
    nloc = mine > 0u ? mine : 1u; nx = cnt > 0u ? cnt : 1u;
}

__device__ __forceinline__ void xcd_barrier(const XcdBarrier& b) {
    asm volatile("s_waitcnt vmcnt(0)" ::: "memory");
    __syncthreads();
    if (threadIdx.x == 0) {
        unsigned* bar = b.bar;
        __builtin_amdgcn_s_waitcnt(0);
        unsigned nloc = b.st[0], nx = b.st[1];
        if (nloc == 0u) { xcd_barrier_complete(bar, b.x, nloc, nx); b.st[0] = nloc; b.st[1] = nx; }
        const unsigned old = xb_add(&bar[XB_XSUB(b.x)], 1u);
        const unsigned gen = old / nloc;
        if (old + 1u == (gen + 1u) * nloc) {
            __builtin_amdgcn_fence(__ATOMIC_RELEASE, "agent");
            asm volatile("s_waitcnt vmcnt(0)" ::: "memory");
            const unsigned og = xb_add(&bar[XB_TOP], 1u);
            const unsigned tg = og / nx;
            if (og + 1u == (tg + 1u) * nx) xb_add(&bar[XB_TOPGEN], 1u);
            else XB_SPIN(xb_ld(&bar[XB_TOPGEN]) == tg, bar);
            __builtin_amdgcn_fence(__ATOMIC_ACQUIRE, "agent");
            xb_add(&bar[XB_XGEN(b.x)], 1u);
            asm volatile("s_waitcnt vmcnt(0)" ::: "memory");
        } else {
            XB_SPIN(xb_ld(&bar[XB_XGEN(b.x)]) == gen, bar);
            __builtin_amdgcn_fence(__ATOMIC_ACQUIRE, "agent");
            asm volatile("s_waitcnt vmcnt(0)" ::: "memory");
        }
    }
    __syncthreads();
}

constexpr int DM = 1024, NB = 2, SEQ = 8192, NT = NB * SEQ;
constexpr int NTHREADS = 512, NWAVES = 8;
constexpr float LN_EPS = 1e-5f;
constexpr float ALPHA = 1.189207115002721f;
typedef unsigned short bf16;
typedef unsigned v4u __attribute__((ext_vector_type(4)));
typedef unsigned v2u __attribute__((ext_vector_type(2)));
typedef float f32x4 __attribute__((ext_vector_type(4)));
typedef short bf16x8_t __attribute__((ext_vector_type(8)));

constexpr size_t MiB = 1u << 20, KiB = 1u << 10;
constexpr size_t WS_CTL = 0, CTL_ZERO_BYTES = 1 * MiB;
constexpr size_t WS_MOD = 1 * MiB + 768 * KiB;
constexpr size_t WS_MMAT = 1 * MiB;
constexpr size_t WS_ROPE = 2 * MiB;
constexpr size_t WS_WIN = 6 * MiB, WS_WOUT = 12 * MiB, WS_WPQ = 14 * MiB, WS_MISC = 16 * MiB, WS_SUBK = 17 * MiB;
constexpr size_t WS_XN = 18 * MiB;
constexpr size_t WS_FZ = 50 * MiB;
constexpr size_t WS_QB = 66 * MiB, WS_KB = 90 * MiB, WS_VB = 114 * MiB, WS_O3 = 138 * MiB, WS_LSE = 162 * MiB;
constexpr size_t WS_H2Q = 50 * MiB, WS_HS = 66 * MiB, WS_WQ = 67 * MiB, WS_WSC = 69 * MiB, WS_SUA = 75 * MiB, WS_X1 = 83 * MiB;
constexpr size_t WS_Y1 = 116 * MiB, WS_PQ = 116 * MiB, WS_PART = 116 * MiB, WS_Y = 116 * MiB;
constexpr size_t WS_IDS = 180 * MiB, WS_GATES = 188 * MiB;
constexpr size_t WS_TU8 = 200 * MiB, WS_TV8 = 216 * MiB, WS_SU = 232 * MiB, WS_SV = 232 * MiB + 512 * KiB, WS_END = 233 * MiB;
constexpr float QSCALE = 0.125f * 1.4426950408889634f;
constexpr int NIN = 2816;
constexpr int CW_BAR = 4096;

constexpr int RING_BYTES = 131072, LDSCTL_OFF = RING_BYTES, MISC_OFF = LDSCTL_OFF + 320, LDS_BYTES = 147456;

struct Params {
    const float* x; const float* c; const int* pos; const float* w_ada; const float* b_ada; const float* w_in; const float* b_in;
    const float* w_four; const float* w_out; const float* b_out; const float* g1; const float* be1; const float* w_pq; const float* subk;
    const float* pu; const float* pv; const float* g2; const float* be2; float* out; unsigned char* ws;
};

__device__ __forceinline__ unsigned f2bf(float f) { unsigned u = __builtin_bit_cast(unsigned, f); return (u + 0x7fffu + ((u >> 16) & 1u)) >> 16; }
__device__ __forceinline__ unsigned pk2(float lo, float hi) { return f2bf(lo) | (f2bf(hi) << 16); }
__device__ __forceinline__ float wave_sum(float v) {
#pragma unroll
    for (int o = 32; o > 0; o >>= 1) v += __shfl_xor(v, o);
    return v;
}
__device__ __forceinline__ float wave_max(float v) {
#pragma unroll
    for (int o = 32; o > 0; o >>= 1) v = fmaxf(v, __shfl_xor(v, o));
    return v;
}
#define LDS_WAIT() asm volatile("s_waitcnt lgkmcnt(0)" ::: "memory")
__device__ __forceinline__ int opaque_tid() { int t = threadIdx.x; asm volatile("" : "+v"(t)); return t; }
__device__ __forceinline__ int wave_id() { return __builtin_amdgcn_readfirstlane(opaque_tid() >> 6); }
__device__ __forceinline__ float bflo(unsigned u) { return __builtin_bit_cast(float, u << 16); }
__device__ __forceinline__ float bfhi(unsigned u) { return __builtin_bit_cast(float, u & 0xffff0000u); }

template <class SC>
__device__ __forceinline__ void transpose_item(const float* W, int K, int N, bf16* WT, int nout, SC srccol, LAS float* scr, int item, int lane) {
    const int nblk = nout / 32, kb = item / nblk, nb = item % nblk, k0 = 64 * kb, n0 = 32 * nb;
    const int sc = srccol(n0 + (lane & 31));
#pragma unroll 8
    for (int i = 0; i < 32; ++i) { const int kk = 2 * i + (lane >> 5); scr[kk * 33 + (lane & 31)] = W[(size_t)(k0 + kk) * N + sc]; }
    LDS_WAIT(); asm volatile("" ::: "memory");
    const int c = lane & 7;
#pragma unroll
    for (int j = 0; j < 4; ++j) { const int n = (lane >> 3) + 8 * j; const LAS float* s = scr + (8 * c) * 33 + n;
        v4u o; o.x = pk2(s[0 * 33], s[1 * 33]); o.y = pk2(s[2 * 33], s[3 * 33]); o.z = pk2(s[4 * 33], s[5 * 33]); o.w = pk2(s[6 * 33], s[7 * 33]);
        *(v4u*)(WT + (size_t)(n0 + n) * K + k0 + 8 * c) = o; }
    LDS_WAIT(); asm volatile("" ::: "memory");
}
__device__ __forceinline__ void ph_prologue(const Params& p, LAS unsigned char* lds, int bid, int nblk) {
    const int tid = opaque_tid(), lane = tid & 63, wave = __builtin_amdgcn_readfirstlane(tid >> 6);
    {
        LAS float* M = (LAS float*)lds; LAS float* Wl = (LAS float*)(lds + 32768);
        bf16* WT = (bf16*)(p.ws + WS_WIN); float* biasf = (float*)(p.ws + WS_MISC); const float* MM = (const float*)(p.ws + WS_MMAT);
        const bool fallback = !(nblk > 192);
        for (int it = bid; it < 256; it += nblk) {
            const int g = it & 3, kb = it >> 2, k0 = kb * 16;
            __syncthreads();
            if (fallback) { const float norm = 1.0f / sqrtf(8192.0f * 64.0f);
                for (int e = tid; e < 8192; e += NTHREADS) { const int c = e >> 7, nl = e & 127; float a = 0.f;
                    for (int cp = 0; cp < 64; ++cp) { const float ang = 2.0f * (float)((c * cp) & 63) / 64.0f; a += ((nl & 1) ? -sinpif(ang) : cospif(ang)) * p.w_four[(g * 64 + cp) * 64 + (nl >> 1)]; }
                    M[e] = a * norm; } }
            else {
#pragma unroll
                for (int i = 0; i < 4; ++i) *(LAS f32x4*)(lds + (tid + i * 512) * 16) = *(const f32x4*)(MM + (size_t)g * 8192 + (tid + i * 512) * 4); }
#pragma unroll
            for (int i = 0; i < 2; ++i) { const int e = tid + i * 512, k = e >> 6, c = e & 63; Wl[k * 64 + c] = p.w_in[(size_t)(k0 + k) * 2560 + g * 64 + c]; }
            __syncthreads();
            { const int nl = tid & 127, kq = tid >> 7; float a[4] = {0.f, 0.f, 0.f, 0.f};
              for (int c = 0; c < 64; ++c) { const float mv = M[c * 128 + nl];
#pragma unroll
                  for (int j = 0; j < 4; ++j) a[j] += mv * Wl[(kq * 4 + j) * 64 + c]; }
              *(v2u*)(WT + (size_t)(g * 128 + nl) * DM + k0 + kq * 4) = (v2u){pk2(a[0], a[1]), pk2(a[2], a[3])};
              if (kb == 0 && tid < 128) { float bsum = 0.f; for (int c = 0; c < 64; ++c) bsum += p.b_in[g * 64 + c] * M[c * 128 + nl]; biasf[g * 128 + nl] = bsum; } }
        }
        __syncthreads();
        for (int i = bid * NTHREADS + tid; i < 2304; i += nblk * NTHREADS) biasf[512 + i] = p.b_in[256 + i];
    }
    {
        LAS float* scr = (LAS float*)(lds + wave * 16384);
        const int gw = bid * NWAVES + wave, NGW = nblk * NWAVES;
        constexpr int I_IN = 16 * (2304 / 32), I_O = 16 * 32, I_PQ = 16 * 32;
        for (int it = gw; it < I_IN + I_O + I_PQ; it += NGW) {
            int r = it;
            if (r < I_IN) {
                transpose_item(p.w_in, DM, 2560, (bf16*)(p.ws + WS_WIN) + (size_t)512 * DM, 2304,
                    [](int n) { return n < 1536 ? 256 + (n & ~63) + ((n & 63) >> 1) + 32 * (n & 1) : 256 + n; }, scr, r, lane); continue; } r -= I_IN;
            if (r < I_O) { transpose_item(p.w_out, DM, DM, (bf16*)(p.ws + WS_WOUT), DM, [](int n) { return n; }, scr, r, lane); continue; } r -= I_O;
            transpose_item(p.w_pq, DM, DM, (bf16*)(p.ws + WS_WPQ), DM, [](int n) { return n; }, scr, r, lane);
        }
    }
    { bf16* SK = (bf16*)(p.ws + WS_SUBK);
      for (int ch = bid * NTHREADS + tid; ch < 8 * 2 * 4 * 4 * 64; ch += nblk * NTHREADS) {
          const int ln = ch & 63, d0 = (ch >> 6) & 3, mt = (ch >> 8) & 3, hp = ch >> 10;
          const float* sp = p.subk + ((size_t)hp * 128 + 32 * mt + (ln & 31)) * 64 + 16 * d0 + 8 * (ln >> 5);
          v4u o; o.x = pk2(sp[0], sp[1]); o.y = pk2(sp[2], sp[3]); o.z = pk2(sp[4], sp[5]); o.w = pk2(sp[6], sp[7]);
          *(v4u*)(SK + (size_t)ch * 8) = o; } }
}
__device__ __forceinline__ void ph_mod(const Params& p, LAS unsigned char* lds, int bid, int nblk) {
    const int tid = opaque_tid(), col = tid & 31, kg = tid >> 5;
    LAS float* cond = (LAS float*)lds; LAS float* red = (LAS float*)(lds + 8192);
    float* mod = (float*)(p.ws + WS_MOD);
    for (int i = tid; i < 2 * DM; i += NTHREADS) { const float c = p.c[i]; cond[i] = c / (1.0f + expf(-c)); }
    __syncthreads();
    if (nblk > 192 && bid >= 192) {
        LAS float* T64 = (LAS float*)(lds + 12288);
        if (tid < 64) { T64[tid] = cospif(2.0f * (float)tid / 64.0f); T64[64 + tid] = -sinpif(2.0f * (float)tid / 64.0f); }
        __syncthreads();
        const float norm = 1.0f / sqrtf(8192.0f * 64.0f); float* MM = (float*)(p.ws + WS_MMAT);
        for (int it = bid - 192; it < 64; it += nblk - 192) {
            const int g = it >> 4, c = (it & 15) * 4 + (tid >> 7), nl = tid & 127; float a = 0.f;
#pragma unroll 8
            for (int cp = 0; cp < 64; ++cp) a += T64[(nl & 1) * 64 + ((c * cp) & 63)] * p.w_four[(g * 64 + cp) * 64 + (nl >> 1)];
            MM[(g * 64 + c) * 128 + nl] = a * norm;
        }
    }
    for (int it = bid; it < 6144 / 32; it += nblk) {
        const int n = it * 32 + col; float a0 = 0.f, a1 = 0.f;
        const float* wp = p.w_ada + (size_t)(kg * 64) * 6144 + n;
#pragma unroll 16
        for (int k = 0; k < 64; ++k) { const float w = wp[(size_t)k * 6144]; a0 += cond[kg * 64 + k] * w; a1 += cond[DM + kg * 64 + k] * w; }
        red[(kg * 2 + 0) * 32 + col] = a0; red[(kg * 2 + 1) * 32 + col] = a1;
        __syncthreads();
        if (tid < 64) { const int b = tid >> 5; float s = p.b_ada[n];
#pragma unroll
            for (int g = 0; g < 16; ++g) s += red[(g * 2 + b) * 32 + col];
            mod[b * 6144 + n] = s; }
        __syncthreads();
    }
}
__device__ __forceinline__ void ph_xn(const Params& p, int bid, int nblk) {
    const int lane = opaque_tid() & 63, wave = wave_id(); const float* mod = (const float*)(p.ws + WS_MOD); bf16* XN = (bf16*)(p.ws + WS_XN);
    for (int row = bid * NWAVES + wave; row < NT; row += nblk * NWAVES) {
        const int b = row / SEQ;
        const f32x4* xr = (const f32x4*)(p.x + (size_t)row * DM) + lane;
        f32x4 v[4]; float s = 0.f;
#pragma unroll
        for (int j = 0; j < 4; ++j) { v[j] = xr[64 * j]; s += (v[j].x + v[j].y) + (v[j].z + v[j].w); }
        const float mean = wave_sum(s) * (1.f / DM); float s2 = 0.f;
#pragma unroll
        for (int j = 0; j < 4; ++j) { v[j] = v[j] - mean; s2 += (v[j].x * v[j].x + v[j].y * v[j].y) + (v[j].z * v[j].z + v[j].w * v[j].w); }
        const float rstd = rsqrtf(wave_sum(s2) * (1.f / DM) + LN_EPS);
        unsigned long long* o8 = (unsigned long long*)(XN + (size_t)row * DM) + lane;
#pragma unroll
        for (int j = 0; j < 4; ++j) {
            const f32x4 sh = *((const f32x4*)(mod + b * 6144 + 0) + lane + 64 * j), sc = *((const f32x4*)(mod + b * 6144 + 1024) + lane + 64 * j);
            const f32x4 o = v[j] * rstd * (1.0f + sc) + sh;
            o8[64 * j] = (unsigned long long)pk2(o.x, o.y) | ((unsigned long long)pk2(o.z, o.w) << 32);
        }
    }
}

struct EpiOut {
    static constexpr bool PERM = true, AFTER_DRAIN = false;
    bf16* Y1; const float* x; const float* mod; const float* bo;
    __device__ __forceinline__ void operator()(const pg8::f32x4 (&acc)[2][2][4][2], const pg8::Unit& u, int wr, int wc, int fr, int fq) const {
        const int row0 = u.pm * 256 + wr * 64 + fr;
#pragma unroll
        for (int bj = 0; bj < 2; ++bj) {
            const int c0 = u.pn * 256 + bj * 128 + wc * 32 + 8 * fq;
            const pg8::f32x4 b0 = *(const pg8::f32x4*)(bo + c0), b1 = *(const pg8::f32x4*)(bo + c0 + 4);
#pragma unroll
            for (int ai = 0; ai < 2; ++ai) {
                const int bb = (u.pm * 256 + ai * 128) >> 13;
                const pg8::f32x4 g0 = *(const pg8::f32x4*)(mod + bb * 6144 + 2048 + c0) + 1.0f, g1 = *(const pg8::f32x4*)(mod + bb * 6144 + 2048 + c0 + 4) + 1.0f;
#pragma unroll
                for (int m = 0; m < 4; ++m) {
                    const int row = row0 + ai * 128 + m * 16;
                    const pg8::f32x4 x0 = *(const pg8::f32x4*)(x + (size_t)row * DM + c0), x1 = *(const pg8::f32x4*)(x + (size_t)row * DM + c0 + 4);
                    const pg8::f32x4 v0 = x0 * ALPHA + g0 * (acc[ai][bj][m][0] + b0), v1 = x1 * ALPHA + g1 * (acc[ai][bj][m][1] + b1);
                    v4u o; o.x = pk2(v0.x, v0.y); o.y = pk2(v0.z, v0.w); o.z = pk2(v1.x, v1.y); o.w = pk2(v1.z, v1.w);
                    *(v4u*)(Y1 + (size_t)row * DM + c0) = o;
                }
            }
        }
    }
};
__device__ __forceinline__ void ph_fft(const Params& p, LAS unsigned char* lds, int bid, int nblk) {
    const int tid = opaque_tid(), lane = tid & 63, wave = __builtin_amdgcn_readfirstlane(tid >> 6), lr = lane & 15, lq = lane >> 4;
    bf16* MIX = (bf16*)(p.ws + WS_XN);
    for (int item = bid; item < 256; item += nblk) {
        const int b = item >> 7, cg = item & 127;
        const unsigned long long* src = (const unsigned long long*)(p.ws + WS_FZ) + (size_t)(b * 128 + cg) * 8192;
        {
            const int n2b = (tid & 7) | ((tid >> 6) << 3), n1b = (tid >> 3) & 7;
            const unsigned long long* sb = src + 128 * n1b + n2b; LAS unsigned char* lb = lds + (2 * n2b) * 288 + 4 * n1b;
#pragma unroll
            for (int hb = 0; hb < 2; ++hb) {
                unsigned long long zin[8];
#pragma unroll
                for (int i = 0; i < 8; ++i) { const int ii = hb * 8 + i; zin[i] = sb[(ii & 1) * 64 + (ii >> 1) * 1024]; }
#pragma unroll
                for (int i = 0; i < 8; ++i) { const int ii = hb * 8 + i; LAS unsigned char* lp = lb + (ii & 1) * 36864 + (ii >> 1) * 32;
                    *(LAS unsigned*)lp = (unsigned)zin[i]; *(LAS unsigned*)(lp + 288) = (unsigned)(zin[i] >> 32); }
            }
        }
        bf16x8_t af[4];
        { const int m = 16 * wave + lr, k1 = m >> 1, ri = m & 1;
#pragma unroll
          for (int ks = 0; ks < 4; ++ks)
#pragma unroll
              for (int jj = 0; jj < 4; ++jj) { const int n1 = 16 * ks + 4 * lq + jj; const float x = (float)((n1 * k1) & 63) * (1.0f / 64.0f);
                  const float c = __builtin_amdgcn_cosf(x), s = __builtin_amdgcn_sinf(x);
                  af[ks][2 * jj] = (short)f2bf(ri ? -s : c); af[ks][2 * jj + 1] = (short)f2bf(ri ? c : s); } }
        __syncthreads();
        pg8::f32x4 acc[16];
#pragma unroll
        for (int nt = 0; nt < 16; ++nt) { acc[nt] = (pg8::f32x4){0.f, 0.f, 0.f, 0.f};
#pragma unroll
            for (int ks = 0; ks < 4; ++ks) { const bf16x8_t bf = *(const LAS bf16x8_t*)(lds + (16 * nt + lr) * 288 + (32 * ks + 8 * lq) * 2);
                acc[nt] = __builtin_amdgcn_mfma_f32_16x16x32_bf16(af[ks], bf, acc[nt], 0, 0, 0); } }
        __syncthreads();
#pragma unroll
        for (int nt = 0; nt < 16; ++nt) { const int col = 16 * nt + lr, n2 = col >> 1, ch = col & 1;
#pragma unroll
            for (int h = 0; h < 2; ++h) { const int k1 = 8 * wave + 2 * lq + h; const float yr = acc[nt][2 * h], yi = acc[nt][2 * h + 1];
                const float x = (float)((n2 * k1) & 8191) * (1.0f / 8192.0f); const float c = __builtin_amdgcn_cosf(x), s = __builtin_amdgcn_sinf(x);
                *(LAS unsigned*)(lds + (2 * k1 + ch) * 544 + 4 * n2) = pk2(yr * c + yi * s, yi * c - yr * s); } }
        bf16x8_t a2[8];
        { const int k2 = 16 * wave + lr;
#pragma unroll
          for (int ks = 0; ks < 8; ++ks)
#pragma unroll
              for (int jj = 0; jj < 4; ++jj) { const int n2 = 16 * ks + 4 * lq + jj; const float x = (float)((n2 * k2) & 127) * (1.0f / 128.0f);
                  a2[ks][2 * jj] = (short)f2bf(__builtin_amdgcn_cosf(x)); a2[ks][2 * jj + 1] = (short)f2bf(__builtin_amdgcn_sinf(x)); } }
        __syncthreads();
        pg8::f32x4 o[8];
#pragma unroll
        for (int nt = 0; nt < 8; ++nt) { o[nt] = (pg8::f32x4){0.f, 0.f, 0.f, 0.f};
#pragma unroll
            for (int ks = 0; ks < 8; ++ks) { const bf16x8_t bf = *(const LAS bf16x8_t*)(lds + (16 * nt + lr) * 544 + (32 * ks + 8 * lq) * 2);
                o[nt] = __builtin_amdgcn_mfma_f32_16x16x32_bf16(a2[ks], bf, o[nt], 0, 0, 0); } }
#pragma unroll
        for (int nt = 0; nt < 8; ++nt) { const int col2 = 16 * nt + lr, k1 = col2 >> 1, ch = col2 & 1;
#pragma unroll
            for (int r = 0; r < 4; ++r) { const float v = o[nt][r]; const float w = __shfl_xor(v, 1); const int k2 = 16 * wave + 4 * lq + r;
                if (ch == 0) *(unsigned*)(MIX + ((size_t)b * SEQ + k1 + 64 * k2) * DM + 2 * cg) = pk2(v, w); } }
        __syncthreads();
    }
}


struct EpiIn {
    static constexpr bool PERM = true, AFTER_DRAIN = false;
    bf16* FZ; bf16* QKV; const float* bias; const int* pos;
    __device__ __forceinline__ void operator()(const pg8::f32x4 (&acc)[2][2][4][2], const pg8::Unit& u, int wr, int wc, int fr, int fq) const {
        const int row0 = u.pm * 256 + wr * 64 + fr;
        float cf[4];
#pragma unroll
        for (int q = 0; q < 4; ++q) cf[q] = __builtin_amdgcn_exp2f(-(float)(16 * (wc & 1) + 4 * fq + q) * (13.287712379549449f / 32.0f)) * 0.15915494309189535f;
        const bool isqk = u.pn >= 2 && u.pn < 8;
        float posf[2][4];
#pragma unroll
        for (int ai = 0; ai < 2; ++ai)
#pragma unroll
            for (int m = 0; m < 4; ++m) posf[ai][m] = isqk ? (float)pos[row0 + ai * 128 + m * 16] : 0.f;
#pragma unroll
        for (int bj = 0; bj < 2; ++bj) {
            const int c0 = u.pn * 256 + bj * 128 + wc * 32 + 8 * fq;
            const pg8::f32x4 b0 = *(const pg8::f32x4*)(bias + c0), b1 = *(const pg8::f32x4*)(bias + c0 + 4);
#pragma unroll
            for (int ai = 0; ai < 2; ++ai)
#pragma unroll
                for (int m = 0; m < 4; ++m) {
                    const int row = row0 + ai * 128 + m * 16;
                    pg8::f32x4 v0 = acc[ai][bj][m][0] + b0, v1 = acc[ai][bj][m][1] + b1;
                    if (u.pn < 2) {
                        const int b = row >> 13, s = row & 8191, cgp = c0 >> 2;
                        unsigned long long* d0 = (unsigned long long*)(FZ + (((size_t)(b * 128 + cgp) * 8192 + s) << 2));
                        d0[0] = (unsigned long long)pk2(v0.x, v0.y) | ((unsigned long long)pk2(v0.z, v0.w) << 32);
                        d0[8192] = (unsigned long long)pk2(v1.x, v1.y) | ((unsigned long long)pk2(v1.z, v1.w) << 32);
                    } else {
                        const int cq = c0 - 512, which = cq / 768, off = cq - which * 768;
                        if (which < 2) {
                            const float sc = which == 0 ? QSCALE : 1.0f;
                            pg8::f32x4 r0, r1;
                            { const float pf = posf[ai][m]; float a0 = pf * cf[0], a1 = pf * cf[1], a2 = pf * cf[2], a3 = pf * cf[3];
                              a0 -= floorf(a0); a1 -= floorf(a1); a2 -= floorf(a2); a3 -= floorf(a3);
                              r0.x = __builtin_amdgcn_cosf(a0); r0.y = __builtin_amdgcn_sinf(a0); r0.z = __builtin_amdgcn_cosf(a1); r0.w = __builtin_amdgcn_sinf(a1);
                              r1.x = __builtin_amdgcn_cosf(a2); r1.y = __builtin_amdgcn_sinf(a2); r1.z = __builtin_amdgcn_cosf(a3); r1.w = __builtin_amdgcn_sinf(a3); }
                            pg8::f32x4 w0, w1;
                            w0.x = (v0.x * r0.x - v0.y * r0.y) * sc; w0.y = (v0.y * r0.x + v0.x * r0.y) * sc; w0.z = (v0.z * r0.z - v0.w * r0.w) * sc; w0.w = (v0.w * r0.z + v0.z * r0.w) * sc;
                            w1.x = (v1.x * r1.x - v1.y * r1.y) * sc; w1.y = (v1.y * r1.x + v1.x * r1.y) * sc; w1.z = (v1.z * r1.z - v1.w * r1.w) * sc; w1.w = (v1.w * r1.z + v1.z * r1.w) * sc;
                            v0 = w0; v1 = w1;
                        }
                        v4u o; o.x = pk2(v0.x, v0.y); o.y = pk2(v0.z, v0.w); o.z = pk2(v1.x, v1.y); o.w = pk2(v1.z, v1.w);
                        *(v4u*)(QKV + (size_t)which * ((WS_KB - WS_QB) / 2) + (size_t)row * 768 + off) = o;
                    }
                }
        }
    }
};

typedef float f32x16 __attribute__((ext_vector_type(16)));
typedef short s16x4 __attribute__((ext_vector_type(4)));
__device__ __forceinline__ int crow(int r, int hi) { return (r & 3) + 8 * (r >> 2) + 4 * hi; }
__device__ __forceinline__ s16x4 vtr(const LAS unsigned char* p) { return __builtin_bit_cast(s16x4, __builtin_amdgcn_ds_read_tr16_b64_v4i16((LAS s16x4*)p)); }
__device__ __forceinline__ unsigned cvtpk(float lo, float hi) { typedef float f2 __attribute__((ext_vector_type(2))); typedef __bf16 b2 __attribute__((ext_vector_type(2))); f2 v = {lo, hi}; b2 r = __builtin_convertvector(v, b2); return __builtin_bit_cast(unsigned, r); }
__device__ __forceinline__ void tbl_load(const Params& p, int r, f32x4 (&a)[4], int lane) {
    const bool isv = r >= 16384; const int row = isv ? r - 16384 : r;
    const f32x4* src = (const f32x4*)((isv ? p.pv : p.pu) + (size_t)row * DM + 16 * lane);
#pragma unroll
    for (int j = 0; j < 4; ++j) a[j] = src[j];
}
__device__ __forceinline__ void tbl_finish(const Params& p, int r, const f32x4 (&a)[4], int lane) {
    const bool isv = r >= 16384; const int row = isv ? r - 16384 : r;
    float amax = 0.f;
#pragma unroll
    for (int j = 0; j < 4; ++j) amax = fmaxf(amax, fmaxf(fmaxf(fabsf(a[j].x), fabsf(a[j].y)), fmaxf(fabsf(a[j].z), fabsf(a[j].w))));
    if (isv) {
        amax = wave_max(amax);
        const float inv = amax > 0.f ? 127.0f / amax : 0.f;
        v4u o;
#pragma unroll
        for (int j = 0; j < 4; ++j) { unsigned q = 0u;
            q = __builtin_amdgcn_cvt_pk_u8_f32(a[j].x * inv + 128.0f, 0, q); q = __builtin_amdgcn_cvt_pk_u8_f32(a[j].y * inv + 128.0f, 1, q);
            q = __builtin_amdgcn_cvt_pk_u8_f32(a[j].z * inv + 128.0f, 2, q); q = __builtin_amdgcn_cvt_pk_u8_f32(a[j].w * inv + 128.0f, 3, q);
            o[j] = q ^ 0x80808080u; }
        *(v4u*)(p.ws + WS_TV8 + (size_t)(lane >> 3) * (2 * MiB) + (size_t)row * 128 + 16 * (lane & 7)) = o;
        if (lane == 0) ((float*)(p.ws + WS_SV))[row] = amax * (1.0f / 127.0f);
    } else {
        amax = fmaxf(amax, __shfl_xor(amax, 1)); amax = fmaxf(amax, __shfl_xor(amax, 2)); amax = fmaxf(amax, __shfl_xor(amax, 4)); amax = fmaxf(amax, __shfl_xor(amax, 8));
        const float inv = amax > 0.f ? 7.0f / amax : 0.f;
        unsigned d[2];
#pragma unroll
        for (int w = 0; w < 2; ++w) { unsigned lo = 0u, hi = 0u;
            lo = __builtin_amdgcn_cvt_pk_u8_f32(a[2 * w].x * inv + 8.0f, 0, lo); lo = __builtin_amdgcn_cvt_pk_u8_f32(a[2 * w].y * inv + 8.0f, 1, lo);
            lo = __builtin_amdgcn_cvt_pk_u8_f32(a[2 * w].z * inv + 8.0f, 2, lo); lo = __builtin_amdgcn_cvt_pk_u8_f32(a[2 * w].w * inv + 8.0f, 3, lo);
            hi = __builtin_amdgcn_cvt_pk_u8_f32(a[2 * w + 1].x * inv + 8.0f, 0, hi); hi = __builtin_amdgcn_cvt_pk_u8_f32(a[2 * w + 1].y * inv + 8.0f, 1, hi);
            hi = __builtin_amdgcn_cvt_pk_u8_f32(a[2 * w + 1].z * inv + 8.0f, 2, hi); hi = __builtin_amdgcn_cvt_pk_u8_f32(a[2 * w + 1].w * inv + 8.0f, 3, hi);
            d[w] = lo | (hi << 4); }
        *(v2u*)(p.ws + WS_TU8 + (size_t)(lane >> 4) * (2 * MiB) + (size_t)row * 128 + 8 * (lane & 15)) = (v2u){d[0], d[1]};
        if ((lane & 15) == 0) ((float*)(p.ws + WS_SU))[(size_t)(lane >> 4) * 16384 + row] = amax * (1.0f / 7.0f);
    }
}
struct AttnDesc { int dil, ntile, res, cb, r; size_t rowb; int h; bool valid; };
__device__ __forceinline__ AttnDesc attn_desc(int bi) {
    AttnDesc d; d.valid = bi < 3 * 768; const int b2 = d.valid ? bi : 0;
    const int r = b2 / 768, rem = b2 - r * 768, bh = rem >> 5, q32 = rem & 31, b = bh / 12;
    d.r = r; d.h = bh - b * 12; d.rowb = (size_t)b * SEQ;
    const int ld = 2 * r;
    d.dil = 1 << ld; d.ntile = 256 >> ld; d.res = q32 >> (5 - ld); d.cb = q32 & ((32 >> ld) - 1);
    return d;
}
__device__ __forceinline__ void attn_dma(const AttnDesc& d, const bf16* T, bool swz, LAS unsigned char* img, int wave, int lane) {
#pragma unroll
    for (int i = 0; i < 6; ++i) {
        const int idx = wave * 6 + i, j = idx >> 2, it = idx & 3, kt = 8 * d.cb - 2 + j;
        if (kt >= 0 && kt < d.ntile) {
            const int row = it * 8 + (lane >> 3), ch = lane & 7; const int gch = swz ? (ch ^ ((row >> 1) & 7)) : ch;
            const bf16* src = T + (d.rowb + d.res + d.dil * (32 * kt + row)) * 768 + d.h * 64 + 8 * gch;
            __builtin_amdgcn_global_load_lds((const unsigned*)src, (LAS unsigned*)(img + j * 4096 + it * 1024), 16, 0, 0);
        }
    }
}
__device__ __forceinline__ void attn_qload(const AttnDesc& d, const bf16* QB, bf16x8_t (&qf)[4], int wave, int lane) {
    const bf16* qp = QB + (d.rowb + d.res + d.dil * (32 * (8 * d.cb + wave) + (lane & 31))) * 768 + d.h * 64 + 8 * (lane >> 5);
#pragma unroll
    for (int d0 = 0; d0 < 4; ++d0) qf[d0] = *(const bf16x8_t*)(qp + 16 * d0);
}
#define ATT_SYNC() do { asm volatile("s_waitcnt vmcnt(0) lgkmcnt(0)" ::: "memory"); __builtin_amdgcn_s_barrier(); asm volatile("" ::: "memory"); } while (0)
__device__ __forceinline__ void ph_attn_fast(const Params& p, LAS unsigned char* lds, int bid, int nblk) {
    const int lane = opaque_tid() & 63, wave = wave_id(), r32 = lane & 31, hi = lane >> 5;
    LAS unsigned char* imgK = lds; LAS unsigned char* imgV = lds + 49152; LAS unsigned char* stgb = lds + 98304 + wave * 4096;
    const bf16* QB = (const bf16*)(p.ws + WS_QB); const bf16* KB = (const bf16*)(p.ws + WS_KB); const bf16* VB = (const bf16*)(p.ws + WS_VB);
    const int vb = (nblk & 7) == 0 ? (bid & 7) * (nblk >> 3) + (bid >> 3) : bid;
    int bi = vb;
    AttnDesc d = attn_desc(bi);
    bf16x8_t qf[4];
    if (d.valid) { attn_dma(d, KB, true, imgK, wave, lane); attn_qload(d, QB, qf, wave, lane); }
    ATT_SYNC();
    const int g = lane >> 4, ii = lane & 15;
    const int vb0 = (4 * hi + (ii >> 2)) * 128 + (g & 1) * 32 + (ii & 3) * 8;
    int trow = bid * NWAVES + wave; const int tstride = nblk * NWAVES;
    f32x4 ta[4];
    while (d.valid) {
        asm volatile("" : "+v"(qf[0]), "+v"(qf[1]), "+v"(qf[2]), "+v"(qf[3]));
        attn_dma(d, VB, false, imgV, wave, lane);
        const bool tb1 = trow < 32768; if (tb1) tbl_load(p, trow, ta, lane);
        const int c = 8 * d.cb + wave;
        f32x16 S[5];
#pragma unroll
        for (int u = 0; u < 5; ++u) {
            const int kt = c - 2 + u;
#pragma unroll
            for (int r = 0; r < 16; ++r) S[u][r] = -1e30f;
            if (kt >= 0 && kt < d.ntile) {
                const LAS unsigned char* slot = imgK + (wave + u) * 4096;
                f32x16 a = {0.f, 0.f, 0.f, 0.f, 0.f, 0.f, 0.f, 0.f, 0.f, 0.f, 0.f, 0.f, 0.f, 0.f, 0.f, 0.f};
#pragma unroll
                for (int d0 = 0; d0 < 4; ++d0) { const bf16x8_t kf = *(const LAS bf16x8_t*)(slot + r32 * 128 + (((2 * d0 + hi) ^ ((r32 >> 1) & 7)) << 4));
                    a = __builtin_amdgcn_mfma_f32_32x32x16_bf16(kf, qf[d0], a, 0, 0, 0); }
                S[u] = a;
            }
        }
#pragma unroll
        for (int r = 0; r < 16; ++r) { const int kk = crow(r, hi); if (kk < r32) S[0][r] = -1e30f; if (kk > r32) S[4][r] = -1e30f; }
        float m = -1e30f;
#pragma unroll
        for (int u = 0; u < 5; ++u)
#pragma unroll
            for (int r = 0; r < 16; ++r) m = fmaxf(m, S[u][r]);
        m = fmaxf(m, __shfl_xor(m, 32));
        float l = 0.f;
        unsigned Pk[5][8];
#pragma unroll
        for (int u = 0; u < 5; ++u)
#pragma unroll
            for (int r = 0; r < 16; r += 2) { const float e0 = __builtin_amdgcn_exp2f(S[u][r] - m), e1 = __builtin_amdgcn_exp2f(S[u][r + 1] - m); l += e0 + e1; Pk[u][r >> 1] = cvtpk(e0, e1); }
        l += __shfl_xor(l, 32);
        if (tb1) { tbl_finish(p, trow, ta, lane); trow += tstride; }
        ATT_SYNC();
        const AttnDesc dn = attn_desc(bi + nblk);
        if (dn.valid) { attn_dma(dn, KB, true, imgK, wave, lane); attn_qload(dn, QB, qf, wave, lane); }
        const bool tb2 = trow < 32768; if (tb2) tbl_load(p, trow, ta, lane);
        f32x16 o[2];
#pragma unroll
        for (int db = 0; db < 2; ++db)
#pragma unroll
            for (int r = 0; r < 16; ++r) o[db][r] = 0.f;
#pragma unroll
        for (int u = 0; u < 5; ++u) {
            const int kt = c - 2 + u;
            if (kt >= 0 && kt < d.ntile) {
                const LAS unsigned char* slot = imgV + (wave + u) * 4096;
#pragma unroll
                for (int s = 0; s < 2; ++s) {
                    bf16x8_t pa;
                    { v4u w; w.x = Pk[u][4 * s + 0]; w.y = Pk[u][4 * s + 1]; w.z = Pk[u][4 * s + 2]; w.w = Pk[u][4 * s + 3]; pa = __builtin_bit_cast(bf16x8_t, w); }
#pragma unroll
                    for (int db = 0; db < 2; ++db) {
                        const s16x4 lo = vtr(slot + vb0 + s * 2048 + db * 64), hh = vtr(slot + vb0 + s * 2048 + 1024 + db * 64);
                        const bf16x8_t vf = {lo[0], lo[1], lo[2], lo[3], hh[0], hh[1], hh[2], hh[3]};
                        o[db] = __builtin_amdgcn_mfma_f32_32x32x16_bf16(pa, vf, o[db], 0, 0, 0);
                    }
                }
            }
        }
        bf16* OB = d.r == 2 ? (bf16*)(p.ws + WS_O3) : (bf16*)p.out + (size_t)d.r * NT * 768;
        float* LSE = (float*)(p.ws + WS_LSE) + (size_t)d.r * NT * 12;
        const float linv = 1.0f / l;
        LAS unsigned short* stg = (LAS unsigned short*)stgb;
#pragma unroll
        for (int r = 0; r < 16; ++r) { const int q = crow(r, hi); const float li = __shfl(linv, q);
#pragma unroll
            for (int db = 0; db < 2; ++db) stg[q * 64 + db * 32 + r32] = (unsigned short)f2bf(o[db][r] * li); }
        int ln2 = lane; asm volatile("" : "+v"(ln2));
#pragma unroll
        for (int i4 = 0; i4 < 4; ++i4) { const int row = i4 * 8 + (ln2 >> 3), ch = ln2 & 7;
            const v4u val = *(const LAS v4u*)((LAS unsigned char*)stg + row * 128 + ch * 16);
            *(v4u*)(OB + (d.rowb + d.res + d.dil * (32 * c + row)) * 768 + d.h * 64 + 8 * ch) = val; }
        if (ln2 < 32) LSE[(d.rowb + d.res + d.dil * (32 * c + ln2)) * 12 + d.h] = m + __builtin_amdgcn_logf(l);
        if (tb2) { tbl_finish(p, trow, ta, lane); trow += tstride; }
        ATT_SYNC();
        d = dn; bi += nblk;
    }
    for (; trow < 32768; trow += tstride) { tbl_load(p, trow, ta, lane); tbl_finish(p, trow, ta, lane); }
}
__device__ __forceinline__ void ph_merge(const Params& p, int bid, int nblk) {
    const bf16* O1 = (const bf16*)p.out; const bf16* O2 = O1 + (size_t)NT * 768; const bf16* O3 = (const bf16*)(p.ws + WS_O3);
    const float* L1 = (const float*)(p.ws + WS_LSE); const float* L2 = L1 + (size_t)NT * 12; const float* L3 = L2 + (size_t)NT * 12; bf16* MIX = (bf16*)(p.ws + WS_XN);
    for (int idx = bid * NTHREADS + opaque_tid(); idx < NT * 96; idx += nblk * NTHREADS) {
        const int t = idx / 96, rem = idx - t * 96, h = rem >> 3, ch = rem & 7;
        const float l1 = L1[t * 12 + h], l2 = L2[t * 12 + h], l3 = L3[t * 12 + h]; const float mx = fmaxf(fmaxf(l1, l2), l3);
        float w1 = __builtin_amdgcn_exp2f(l1 - mx), w2 = __builtin_amdgcn_exp2f(l2 - mx), w3 = __builtin_amdgcn_exp2f(l3 - mx); const float inv = 1.0f / (w1 + w2 + w3); w1 *= inv; w2 *= inv; w3 *= inv;
        const size_t off = (size_t)t * 768 + h * 64 + 8 * ch;
        const v4u a = *(const v4u*)(O1 + off), bq = *(const v4u*)(O2 + off), cq = *(const v4u*)(O3 + off);
        v4u o;
        o.x = pk2(w1 * bflo(a.x) + w2 * bflo(bq.x) + w3 * bflo(cq.x), w1 * bfhi(a.x) + w2 * bfhi(bq.x) + w3 * bfhi(cq.x));
        o.y = pk2(w1 * bflo(a.y) + w2 * bflo(bq.y) + w3 * bflo(cq.y), w1 * bfhi(a.y) + w2 * bfhi(bq.y) + w3 * bfhi(cq.y));
        o.z = pk2(w1 * bflo(a.z) + w2 * bflo(bq.z) + w3 * bflo(cq.z), w1 * bfhi(a.z) + w2 * bfhi(bq.z) + w3 * bfhi(cq.z));
        o.w = pk2(w1 * bflo(a.w) + w2 * bflo(bq.w) + w3 * bflo(cq.w), w1 * bfhi(a.w) + w2 * bfhi(bq.w) + w3 * bfhi(cq.w));
        *(v4u*)(MIX + (size_t)t * DM + 256 + h * 64 + 8 * ch) = o;
    }
}


__host__ __device__ constexpr int stair2_slot(int i, int j) { int n = 0; for (int a = 1; a < 16; ++a) for (int b = 1; b < 16; ++b) if ((a + 1) * (b + 1) <= 16) { if (a == i && b == j) return n; ++n; } return n; }
__device__ __forceinline__ float kmax(float a, float b) { float r; asm("v_max_f32_e32 %0, %1, %2" : "=v"(r) : "v"(a), "v"(b)); return r; }
__device__ __forceinline__ float kmin(float a, float b) { float r; asm("v_min_f32_e32 %0, %1, %2" : "=v"(r) : "v"(a), "v"(b)); return r; }
__device__ __forceinline__ float fkeyf(float s, unsigned low, unsigned mask) { return __builtin_bit_cast(float, (__builtin_bit_cast(unsigned, s) & ~mask) | low); }
__device__ __forceinline__ float fvalf(float k, unsigned mask) { return __builtin_bit_cast(float, (__builtin_bit_cast(unsigned, k) & ~mask) | (mask >> 1)); }
#define CE_DESC(a, b) do { const float _mx = kmax((a), (b)), _mn = kmin((a), (b)); (a) = _mx; (b) = _mn; } while (0)
__device__ __forceinline__ void sort16_desc(float (&a)[16]) {
#pragma unroll
    for (int k = 2; k <= 16; k <<= 1)
#pragma unroll
        for (int j = k >> 1; j > 0; j >>= 1)
#pragma unroll
            for (int i = 0; i < 16; ++i) { const int l = i ^ j; if (l > i) { if ((i & k) == 0) CE_DESC(a[i], a[l]); else CE_DESC(a[l], a[i]); } }
}
__device__ __forceinline__ void merge16_desc(float (&c)[16]) {
#pragma unroll
    for (int j = 8; j > 0; j >>= 1)
#pragma unroll
        for (int i = 0; i < 16; ++i) { const int l = i ^ j; if (l > i) CE_DESC(c[i], c[l]); }
}
__device__ __forceinline__ void top16_merge(float (&a)[16], const float (&b)[16]) {
#pragma unroll
    for (int i = 0; i < 16; ++i) a[i] = kmax(a[i], b[15 - i]);
    merge16_desc(a);
}
__device__ __forceinline__ void top16_of_64(float (&g0)[16], float (&g1)[16], float (&g2)[16], float (&g3)[16]) {
    sort16_desc(g0); sort16_desc(g1); sort16_desc(g2); sort16_desc(g3);
    top16_merge(g0, g1); top16_merge(g2, g3); top16_merge(g0, g2);
}
template <int MST>
__device__ __forceinline__ void topk_item(const bf16x8_t (&qf)[2][4], const bf16* SK, int h, int t, LAS unsigned* myl, unsigned short* ids, float* gates, const float* SVt, int lane) {
    const int hi = lane >> 5; const float NEGINF = -INFINITY;
        float K[2][16];
#pragma unroll
    for (int pp = 0; pp < 2; ++pp) {
        float g[4][16];
#pragma unroll
        for (int mt = 0; mt < 4; ++mt) {
            const bf16* kp = SK + ((size_t)((h * 2 + pp) * 4 + mt) * 4 * 64 + lane) * 8;
            f32x16 a = {0.f, 0.f, 0.f, 0.f, 0.f, 0.f, 0.f, 0.f, 0.f, 0.f, 0.f, 0.f, 0.f, 0.f, 0.f, 0.f};
#pragma unroll
            for (int d0 = 0; d0 < 4; ++d0) a = __builtin_amdgcn_mfma_f32_32x32x16_bf16(*(const bf16x8_t*)(kp + d0 * 512), qf[pp][d0], a, 0, 0, 0);
#pragma unroll
            for (int r = 0; r < 16; ++r) g[mt][r] = fkeyf(a[r], 127u - (unsigned)(32 * mt + crow(r, hi)), 127u);
        }
        top16_of_64(g[0], g[1], g[2], g[3]);
        float o[16];
#pragma unroll
        for (int i = 0; i < 16; ++i) o[i] = __shfl_xor(g[0][i], 32);
        top16_merge(g[0], o);
#pragma unroll
        for (int i = 0; i < 16; ++i) K[pp][i] = g[0][i];
    }
#pragma unroll
    for (int i = 0; i < 16; ++i) { myl[i * MST] = __builtin_bit_cast(unsigned, K[0][i]); myl[(16 + i) * MST] = __builtin_bit_cast(unsigned, K[1][i]); }
    float v0[16], v1[16];
#pragma unroll
    for (int i = 0; i < 16; ++i) { v0[i] = fvalf(K[0][i], 127u); v1[i] = fvalf(K[1][i], 127u); }
    float cA[16], cB[16], cC[16], cD[16];
#pragma unroll
    for (int j = 0; j < 16; ++j) cA[j] = fkeyf(v0[0] + v1[j], 255u - (unsigned)j, 255u);
#pragma unroll
    for (int i = 1; i < 16; ++i) cB[i - 1] = fkeyf(v0[i] + v1[0], 255u - (unsigned)(16 * i), 255u);
    cB[15] = NEGINF;
#pragma unroll
    for (int q = 0; q < 16; ++q) { cC[q] = NEGINF; cD[q] = NEGINF; }
    { int n = 0;
#pragma unroll
      for (int i = 1; i < 8; ++i)
#pragma unroll
          for (int j = 1; j < 8; ++j) if ((i + 1) * (j + 1) <= 16) { const int m = stair2_slot(i, j); const float kv = fkeyf(v0[i] + v1[j], 255u - (unsigned)(16 * i + j), 255u); if (m < 16) cC[m] = kv; else cD[m - 16] = kv; }
      (void)n; }
    sort16_desc(cC);
    CE_DESC(cD[0], cD[1]); CE_DESC(cD[1], cD[2]); CE_DESC(cD[0], cD[1]);
    top16_merge(cA, cB); top16_merge(cC, cD); top16_merge(cA, cC);
    float e[16]; float sum = 0.f; const float mx = fvalf(cA[0], 255u);
#pragma unroll
    for (int r = 0; r < 16; ++r) { e[r] = __builtin_amdgcn_exp2f((fvalf(cA[r], 255u) - mx) * 1.4426950408889634f); sum += e[r]; }
    const float inv = __builtin_amdgcn_rcpf(sum);
    int eid[16];
#pragma unroll
    for (int r = 0; r < 16; ++r) { const unsigned id8 = 255u - (__builtin_bit_cast(unsigned, cA[r]) & 255u); const unsigned k0 = myl[(id8 >> 4) * MST], k1 = myl[(16 + (id8 & 15)) * MST];
        eid[r] = (int)((127u - (k0 & 127u)) * 128u + (127u - (k1 & 127u))); }
    int tq = t; asm volatile("" : "+v"(tq));
    if (hi == 0) {
#pragma unroll
        for (int q = 0; q < 2; ++q) *(v4u*)(ids + (size_t)tq * 128 + h * 16 + 8 * q) = (v4u){(unsigned)eid[8 * q] | ((unsigned)eid[8 * q + 1] << 16), (unsigned)eid[8 * q + 2] | ((unsigned)eid[8 * q + 3] << 16),
                                                                                  (unsigned)eid[8 * q + 4] | ((unsigned)eid[8 * q + 5] << 16), (unsigned)eid[8 * q + 6] | ((unsigned)eid[8 * q + 7] << 16)};
    } else {
#pragma unroll
        for (int q = 0; q < 4; ++q) *(f32x4*)(gates + (size_t)tq * 128 + h * 16 + 4 * q) = (f32x4){e[4 * q] * inv * SVt[eid[4 * q]], e[4 * q + 1] * inv * SVt[eid[4 * q + 1]], e[4 * q + 2] * inv * SVt[eid[4 * q + 2]], e[4 * q + 3] * inv * SVt[eid[4 * q + 3]]};
    }
}
struct EpiPeerTopk {
    static constexpr bool PERM = true, AFTER_DRAIN = true;
    const bf16* SK; unsigned short* ids; float* gates; const float* SVt;
    __device__ __forceinline__ void fused(pg8::f32x4 (&acc)[2][2][4][2], const pg8::Unit& u, int wr, int wc, int fr, int fq, PG8_LAS unsigned char* lds, int wid, int lane) const {
#pragma unroll
        for (int bj = 0; bj < 2; ++bj) {
            const int cc = (bj * 128 + wc * 32 + 8 * fq) >> 3;
#pragma unroll
            for (int ai = 0; ai < 2; ++ai)
#pragma unroll
                for (int m = 0; m < 4; ++m) {
                    const int rl = ai * 128 + wr * 64 + m * 16 + fr; const pg8::f32x4 v0 = acc[ai][bj][m][0], v1 = acc[ai][bj][m][1];
                    v4u o; o.x = pk2(v0.x, v0.y); o.y = pk2(v0.z, v0.w); o.z = pk2(v1.x, v1.y); o.w = pk2(v1.z, v1.w);
                    *(PG8_LAS v4u*)(lds + rl * 512 + ((cc ^ (rl & 15)) << 4)) = o;
                }
        }
        asm volatile("s_waitcnt lgkmcnt(0)" ::: "memory"); __builtin_amdgcn_s_barrier(); asm volatile("" ::: "memory");
        const int r32 = lane & 31, hi = lane >> 5;
#pragma unroll 1
        for (int rep = 0; rep < 2; ++rep) {
            const int it2 = wid + 8 * rep, tl = it2 >> 1, hl = it2 & 1, rl = tl * 32 + r32;
            bf16x8_t qf[2][4];
#pragma unroll
            for (int pp = 0; pp < 2; ++pp)
#pragma unroll
                for (int d0 = 0; d0 < 4; ++d0) { const int cc = hl * 16 + pp * 8 + 2 * d0 + hi; qf[pp][d0] = *(const PG8_LAS bf16x8_t*)(lds + rl * 512 + ((cc ^ (rl & 15)) << 4)); }
            asm volatile("s_waitcnt lgkmcnt(0)" ::: "memory");
            LAS unsigned* myl = (LAS unsigned*)(lds + (tl * 32) * 512 + hl * 256) + lane;
            topk_item<128>(qf, SK, 2 * u.pn + hl, u.pm * 256 + rl, myl, ids, gates, SVt, lane);
        }
    }
};

__device__ __forceinline__ void ph_ln1_fast(const Params& p, int bid, int nblk) {
    const bf16* y1 = (const bf16*)(p.ws + WS_Y1); bf16* x1 = (bf16*)(p.ws + WS_X1); bf16* h2b = (bf16*)(p.ws + WS_XN); const float* mod = (const float*)(p.ws + WS_MOD);
    const int lane = opaque_tid() & 63, wave = wave_id();
    for (int row = bid * NWAVES + wave; row < NT; row += nblk * NWAVES) {
        const int b = row / SEQ;
        const v2u* yr = (const v2u*)(y1 + (size_t)row * DM) + lane;
        f32x4 v[4]; float s = 0.f;
#pragma unroll
        for (int j = 0; j < 4; ++j) { const v2u w = yr[64 * j]; v[j] = (f32x4){bflo(w.x), bfhi(w.x), bflo(w.y), bfhi(w.y)}; s += (v[j].x + v[j].y) + (v[j].z + v[j].w); }
        float mean = wave_sum(s) * (1.f / DM); float s2 = 0.f;
#pragma unroll
        for (int j = 0; j < 4; ++j) { v[j] = v[j] - mean; s2 += (v[j].x * v[j].x + v[j].y * v[j].y) + (v[j].z * v[j].z + v[j].w * v[j].w); }
        float rstd = rsqrtf(wave_sum(s2) * (1.f / DM) + LN_EPS);
        s = 0.f;
#pragma unroll
        for (int j = 0; j < 4; ++j) { const f32x4 g = *((const f32x4*)p.g1 + lane + 64 * j), be = *((const f32x4*)p.be1 + lane + 64 * j);
            v[j] = v[j] * rstd * g + be; *((v2u*)(x1 + (size_t)row * DM) + lane + 64 * j) = (v2u){pk2(v[j].x, v[j].y), pk2(v[j].z, v[j].w)}; s += (v[j].x + v[j].y) + (v[j].z + v[j].w); }
        mean = wave_sum(s) * (1.f / DM); s2 = 0.f;
#pragma unroll
        for (int j = 0; j < 4; ++j) { v[j] = v[j] - mean; s2 += (v[j].x * v[j].x + v[j].y * v[j].y) + (v[j].z * v[j].z + v[j].w * v[j].w); }
        rstd = rsqrtf(wave_sum(s2) * (1.f / DM) + LN_EPS);
        float amax = 0.f;
#pragma unroll
        for (int j = 0; j < 4; ++j) {
            const f32x4 sh = *((const f32x4*)(mod + b * 6144 + 3072) + lane + 64 * j), sc = *((const f32x4*)(mod + b * 6144 + 4096) + lane + 64 * j);
            const f32x4 o = v[j] * rstd * (1.0f + sc) + sh; v[j] = o;
            amax = fmaxf(amax, fmaxf(fmaxf(fabsf(o.x), fabsf(o.y)), fmaxf(fabsf(o.z), fabsf(o.w))));
            *((v2u*)(h2b + (size_t)row * DM) + lane + 64 * j) = (v2u){pk2(o.x, o.y), pk2(o.z, o.w)};
        }
        amax = wave_max(amax); const float hinv = amax > 0.f ? 127.0f / amax : 0.f;
        unsigned* q4 = (unsigned*)(p.ws + WS_H2Q + (size_t)row * DM) + lane;
#pragma unroll
        for (int j = 0; j < 4; ++j) { unsigned q = 0u;
            q = __builtin_amdgcn_cvt_pk_u8_f32(v[j].x * hinv + 128.0f, 0, q); q = __builtin_amdgcn_cvt_pk_u8_f32(v[j].y * hinv + 128.0f, 1, q);
            q = __builtin_amdgcn_cvt_pk_u8_f32(v[j].z * hinv + 128.0f, 2, q); q = __builtin_amdgcn_cvt_pk_u8_f32(v[j].w * hinv + 128.0f, 3, q);
            q4[64 * j] = q ^ 0x80808080u; }
        if (lane == 0) ((float*)(p.ws + WS_HS))[row] = amax * (1.0f / 127.0f);
    }
}
__device__ __forceinline__ void ph_tables8(const Params& p, int bid, int nblk) {
    const int lane = opaque_tid() & 63, wave = wave_id();
    for (int r = bid * NWAVES + wave; r < 2 * 16384; r += nblk * NWAVES) {
        const bool isv = r >= 16384; const int row = isv ? r - 16384 : r;
        const f32x4* src = (const f32x4*)((isv ? p.pv : p.pu) + (size_t)row * DM + 16 * lane);
        f32x4 a[4]; float amax = 0.f;
#pragma unroll
        for (int j = 0; j < 4; ++j) { a[j] = src[j]; amax = fmaxf(amax, fmaxf(fmaxf(fabsf(a[j].x), fabsf(a[j].y)), fmaxf(fabsf(a[j].z), fabsf(a[j].w)))); }
        amax = wave_max(amax);
        const float inv = amax > 0.f ? 127.0f / amax : 0.f;
        v4u o;
#pragma unroll
        for (int j = 0; j < 4; ++j) { unsigned q = 0u;
            q = __builtin_amdgcn_cvt_pk_u8_f32(a[j].x * inv + 128.0f, 0, q); q = __builtin_amdgcn_cvt_pk_u8_f32(a[j].y * inv + 128.0f, 1, q);
            q = __builtin_amdgcn_cvt_pk_u8_f32(a[j].z * inv + 128.0f, 2, q); q = __builtin_amdgcn_cvt_pk_u8_f32(a[j].w * inv + 128.0f, 3, q);
            o[j] = q ^ 0x80808080u; }
        *(v4u*)(p.ws + (isv ? WS_TV8 : WS_TU8) + (size_t)(lane >> 3) * (2 * MiB) + (size_t)row * 128 + 16 * (lane & 7)) = o;
        if (lane == 0) ((float*)(p.ws + (isv ? WS_SV : WS_SU)))[row] = amax * (1.0f / 127.0f);
    }
}
__device__ __forceinline__ float readlane_f(float v, int l) { return __builtin_bit_cast(float, __builtin_amdgcn_readlane(__builtin_bit_cast(int, v), l)); }
__device__ __forceinline__ float ub0(unsigned u) { return (float)(u & 255u); }
__device__ __forceinline__ float ub1(unsigned u) { return (float)((u >> 8) & 255u); }
__device__ __forceinline__ float ub2(unsigned u) { return (float)((u >> 16) & 255u); }
__device__ __forceinline__ float ub3(unsigned u) { return (float)(u >> 24); }
__device__ __forceinline__ v4u ust_meta(const Params& p, int step, int t0, int stride8, int lane) {
    const int g = step >> 4, k = step & 15; int t = t0 + g * stride8 + (lane >> 3); t = t < NT ? t : NT - 1;
    return *(const v4u*)(p.ws + WS_IDS + (size_t)t * 256 + 16 * k);
}
__device__ __forceinline__ void ust_issue(v4u (&ub)[8], const v4u& idq, const unsigned char* TUs) {
#pragma unroll
    for (int e = 0; e < 8; ++e) { const unsigned w = idq[e >> 1]; const unsigned id = (e & 1) ? (w >> 16) : (w & 0xffffu); ub[e] = *(const v4u*)(TUs + (size_t)id * 128); }
}
__device__ __forceinline__ unsigned short ust_compute(const v4u (&ub)[8], const v4u& idq, const v4u& h0, const v4u& h1, int off8, const float* SUs, int lane) {
    int a[8];
#pragma unroll
    for (int e = 0; e < 8; ++e) { int v = 0;
#pragma unroll
        for (int j = 0; j < 4; ++j) { const unsigned d = ub[e][j]; const unsigned lo = d & 0x0f0f0f0fu, hi = (d >> 4) & 0x0f0f0f0fu;
            const unsigned hl = j < 2 ? h0[2 * j] : h1[2 * j - 4], hh = j < 2 ? h0[2 * j + 1] : h1[2 * j - 3];
            v = __builtin_amdgcn_sdot4((int)lo, (int)hl, v, false); v = __builtin_amdgcn_sdot4((int)hi, (int)hh, v, false); }
        a[e] = v; }
    int a4[4];
#pragma unroll
    for (int k = 0; k < 4; ++k) { const bool up = (lane & 4) != 0; const int keep = up ? a[k + 4] : a[k], send = up ? a[k] : a[k + 4]; a4[k] = keep + __shfl_xor(send, 4); }
    int a2[2];
#pragma unroll
    for (int k = 0; k < 2; ++k) { const bool up = (lane & 2) != 0; const int keep = up ? a4[k + 2] : a4[k], send = up ? a4[k] : a4[k + 2]; a2[k] = keep + __shfl_xor(send, 2); }
    const bool up = (lane & 1) != 0; const int keep = up ? a2[1] : a2[0], send = up ? a2[0] : a2[1];
    const int tot = keep + __shfl_xor(send, 1);
    const int c = lane & 7; const unsigned w2 = (c >> 1) == 0 ? idq.x : ((c >> 1) == 1 ? idq.y : ((c >> 1) == 2 ? idq.z : idq.w));
    const unsigned id = (c & 1) ? (w2 >> 16) : (w2 & 0xffffu);
    return (unsigned short)f2bf((float)(tot - off8) * SUs[id]);
}
__device__ __forceinline__ void ph_udot(const Params& p, int bid, int nblk) {
    unsigned short* P = (unsigned short*)(p.ws + WS_PART);
    const int lane = opaque_tid() & 63, wave = wave_id(), c = lane & 7;
    const int s8 = bid & 7, s = s8 & 3;
    const int nlo = (nblk - s + 7) >> 3, nhi = (nblk - (s + 4) + 7) >> 3;
    const int widx = ((s8 >> 2) ? nlo : 0) * NWAVES + (bid >> 3) * NWAVES + wave, stride8 = (nlo + nhi) * NWAVES * 8;
    const unsigned char* TUs = p.ws + WS_TU8 + (size_t)s * (2 * MiB) + 16 * c;
    const float* SUs = (const float*)(p.ws + WS_SU) + (size_t)s * 16384;
    const int t0 = widx * 8;
    const int ngroups = t0 < NT ? (NT - t0 + stride8 - 1) / stride8 : 0, nsteps = ngroups * 16;
    if (nsteps == 0) return;
    v4u uA[8], uB[8];
    v4u qa = ust_meta(p, 0, t0, stride8, lane);
    ust_issue(uA, qa, TUs);
    v4u qb = ust_meta(p, 1, t0, stride8, lane);
    v4u h0 = {0u, 0u, 0u, 0u}, h1 = {0u, 0u, 0u, 0u}; int off8 = 0;
    for (int st = 0; st < nsteps; st += 2) {
        const int tg = t0 + (st >> 4) * stride8 + (lane >> 3); const int t = tg < NT ? tg : NT - 1;
        if ((st & 15) == 0) {
            const unsigned char* hp = p.ws + WS_H2Q + (size_t)t * DM + 256 * s + 32 * c; h0 = *(const v4u*)hp; h1 = *(const v4u*)(hp + 16);
            int hs = 0;
#pragma unroll
            for (int j = 0; j < 4; ++j) { hs = __builtin_amdgcn_sdot4((int)h0[j], 0x01010101, hs, false); hs = __builtin_amdgcn_sdot4((int)h1[j], 0x01010101, hs, false); }
            hs += __shfl_xor(hs, 1); hs += __shfl_xor(hs, 2); hs += __shfl_xor(hs, 4); off8 = 8 * hs;
        }
        ust_issue(uB, qb, TUs);
        const v4u ia = qa; qa = ust_meta(p, st + 2 < nsteps ? st + 2 : st, t0, stride8, lane);
        const unsigned short ra = ust_compute(uA, ia, h0, h1, off8, SUs, lane);
        if (st + 2 < nsteps) ust_issue(uA, qa, TUs);
        const v4u ib = qb; qb = ust_meta(p, st + 3 < nsteps ? st + 3 : st + 1, t0, stride8, lane);
        const unsigned short rb = ust_compute(uB, ib, h0, h1, off8, SUs, lane);
        if (tg < NT) { unsigned short* dst = P + ((size_t)t * 4 + s) * 128 + 8 * (st & 15) + c; dst[0] = ra; dst[8] = rb; }
    }
}
__device__ __forceinline__ void ph_act(const Params& p, int bid, int nblk) {
    const bf16* P = (const bf16*)(p.ws + WS_PART); const float* GS = (const float*)(p.ws + WS_GATES); const float* HS = (const float*)(p.ws + WS_HS);
    unsigned char* WQ = p.ws + WS_WQ; float* WSC = (float*)(p.ws + WS_WSC);
    const int lane = opaque_tid() & 63, wave = wave_id();
    for (int t = bid * NWAVES + wave; t < NT; t += nblk * NWAVES) {
        float a0 = 0.f, a1 = 0.f;
#pragma unroll
        for (int s = 0; s < 4; ++s) { a0 += __builtin_bit_cast(float, (unsigned)P[((size_t)t * 4 + s) * 128 + lane] << 16); a1 += __builtin_bit_cast(float, (unsigned)P[((size_t)t * 4 + s) * 128 + 64 + lane] << 16); }
        const float hs = HS[t];
        const float d0 = a0 * hs, d1 = a1 * hs;
        const float w0 = GS[(size_t)t * 128 + lane] * 0.5f * d0 * (1.0f + erff(d0 * 0.70710678118654752f));
        const float w1 = GS[(size_t)t * 128 + 64 + lane] * 0.5f * d1 * (1.0f + erff(d1 * 0.70710678118654752f));
        const float wmax = wave_max(fmaxf(fabsf(w0), fabsf(w1))); const float winv = wmax > 0.f ? 127.0f / wmax : 0.f;
        unsigned b2 = __builtin_amdgcn_cvt_pk_u8_f32(w0 * winv + 128.0f, 0, 0u); b2 = __builtin_amdgcn_cvt_pk_u8_f32(w1 * winv + 128.0f, 1, b2); b2 ^= 0x8080u;
        WQ[(size_t)t * 128 + lane] = (unsigned char)(b2 & 255u); WQ[(size_t)t * 128 + 64 + lane] = (unsigned char)((b2 >> 8) & 255u);
        if (lane == 0) WSC[t] = wmax * (1.0f / 127.0f);
    }
}
struct VstepMeta { v4u idq; v2u wq; };
__device__ __forceinline__ VstepMeta vst_meta(const Params& p, int step, int t0, int stride8, int lane) {
    const int g = step >> 4, k = step & 15; int t = t0 + g * stride8 + (lane >> 3); t = t < NT ? t : NT - 1;
    VstepMeta r; r.idq = *(const v4u*)(p.ws + WS_IDS + (size_t)t * 256 + 16 * k); r.wq = *(const v2u*)(p.ws + WS_WQ + (size_t)t * 128 + 8 * k); return r;
}
__device__ __forceinline__ void vst_issue(v4u (&vb)[8], const VstepMeta& q, const unsigned char* TVs) {
#pragma unroll
    for (int e = 0; e < 8; ++e) { const unsigned w = q.idq[e >> 1]; const unsigned id = (e & 1) ? (w >> 16) : (w & 0xffffu); vb[e] = *(const v4u*)(TVs + (size_t)id * 128); }
}
__device__ __forceinline__ void vst_compute(int (&y)[16], const v4u (&vb)[8], const v2u& wq) {
#pragma unroll
    for (int qd = 0; qd < 2; ++qd)
#pragma unroll
        for (int cm = 0; cm < 4; ++cm) {
            const unsigned A = vb[4 * qd][cm], B = vb[4 * qd + 1][cm], C = vb[4 * qd + 2][cm], D = vb[4 * qd + 3][cm];
            const unsigned ab01 = __builtin_amdgcn_perm(B, A, 0x05010400u), ab23 = __builtin_amdgcn_perm(B, A, 0x07030602u);
            const unsigned cd01 = __builtin_amdgcn_perm(D, C, 0x05010400u), cd23 = __builtin_amdgcn_perm(D, C, 0x07030602u);
            const unsigned t0 = __builtin_amdgcn_perm(cd01, ab01, 0x05040100u), t1 = __builtin_amdgcn_perm(cd01, ab01, 0x07060302u);
            const unsigned t2 = __builtin_amdgcn_perm(cd23, ab23, 0x05040100u), t3 = __builtin_amdgcn_perm(cd23, ab23, 0x07060302u);
            y[4 * cm + 0] = __builtin_amdgcn_sdot4((int)t0, (int)wq[qd], y[4 * cm + 0], false); y[4 * cm + 1] = __builtin_amdgcn_sdot4((int)t1, (int)wq[qd], y[4 * cm + 1], false);
            y[4 * cm + 2] = __builtin_amdgcn_sdot4((int)t2, (int)wq[qd], y[4 * cm + 2], false); y[4 * cm + 3] = __builtin_amdgcn_sdot4((int)t3, (int)wq[qd], y[4 * cm + 3], false);
        }
}
__device__ __forceinline__ void ph_vacc(const Params& p, int bid, int nblk) {
    bf16* Y = (bf16*)(p.ws + WS_Y); const float* WSC = (const float*)(p.ws + WS_WSC);
    const int lane = opaque_tid() & 63, wave = wave_id(), c = lane & 7;
    const int s = bid & 7, nper = (nblk - s + 7) >> 3,     stride8 = nper * NWAVES * 8;
    const unsigned char* TVs = p.ws + WS_TV8 + (size_t)s * (2 * MiB) + 16 * c;
    const int t0 = ((bid >> 3) * NWAVES + wave) * 8;
    const int ngroups = t0 < NT ? (NT - t0 + stride8 - 1) / stride8 : 0, nsteps = ngroups * 16;
    if (nsteps == 0) return;
    int y[16];
#pragma unroll
    for (int k = 0; k < 16; ++k) y[k] = 0;
    v4u vA[8], vB[8];
    VstepMeta qa = vst_meta(p, 0, t0, stride8, lane);
    vst_issue(vA, qa, TVs);
    VstepMeta qb = vst_meta(p, 1, t0, stride8, lane);
    for (int st = 0; st < nsteps; st += 2) {
        vst_issue(vB, qb, TVs);
        const v2u wa = qa.wq; qa = vst_meta(p, st + 2 < nsteps ? st + 2 : st, t0, stride8, lane);
        vst_compute(y, vA, wa);
        if (st + 2 < nsteps) vst_issue(vA, qa, TVs);
        const v2u wb = qb.wq; qb = vst_meta(p, st + 3 < nsteps ? st + 3 : st + 1, t0, stride8, lane);
        vst_compute(y, vB, wb);
        if (((st + 1) & 15) == 15) {
            const int t = t0 + (st >> 4) * stride8 + (lane >> 3);
            if (t < NT) { const float sc = WSC[t];
                v4u o0, o1; o0.x = pk2((float)y[0] * sc, (float)y[1] * sc); o0.y = pk2((float)y[2] * sc, (float)y[3] * sc); o0.z = pk2((float)y[4] * sc, (float)y[5] * sc); o0.w = pk2((float)y[6] * sc, (float)y[7] * sc);
                o1.x = pk2((float)y[8] * sc, (float)y[9] * sc); o1.y = pk2((float)y[10] * sc, (float)y[11] * sc); o1.z = pk2((float)y[12] * sc, (float)y[13] * sc); o1.w = pk2((float)y[14] * sc, (float)y[15] * sc);
                v4u* dst = (v4u*)(Y + (size_t)t * DM + 128 * s + 16 * c); dst[0] = o0; dst[1] = o1; }
#pragma unroll
            for (int k = 0; k < 16; ++k) y[k] = 0;
        }
    }
}
__device__ __forceinline__ void ph_final(const Params& p, int bid, int nblk) {
    const bf16* x1 = (const bf16*)(p.ws + WS_X1); const bf16* Y = (const bf16*)(p.ws + WS_Y); const float* mod = (const float*)(p.ws + WS_MOD);
    const int lane = opaque_tid() & 63, wave = wave_id();
    for (int t = bid * NWAVES + wave; t < NT; t += nblk * NWAVES) {
        const int b = t / SEQ;
        f32x4 v[4]; float s = 0.f;
#pragma unroll
        for (int j = 0; j < 4; ++j) { const v2u xw = *((const v2u*)(x1 + (size_t)t * DM) + lane + 64 * j), yw = *((const v2u*)(Y + (size_t)t * DM) + lane + 64 * j);
            const f32x4 g2 = *((const f32x4*)(mod + b * 6144 + 5120) + lane + 64 * j);
            const f32x4 xv = {bflo(xw.x), bfhi(xw.x), bflo(xw.y), bfhi(xw.y)}, yv = {bflo(yw.x), bfhi(yw.x), bflo(yw.y), bfhi(yw.y)};
            v[j] = xv * ALPHA + (g2 + 1.0f) * yv; s += (v[j].x + v[j].y) + (v[j].z + v[j].w); }
        const float mean = wave_sum(s) * (1.f / DM); float s2 = 0.f;
#pragma unroll
        for (int j = 0; j < 4; ++j) { v[j] = v[j] - mean; s2 += (v[j].x * v[j].x + v[j].y * v[j].y) + (v[j].z * v[j].z + v[j].w * v[j].w); }
        const float rstd = rsqrtf(wave_sum(s2) * (1.f / DM) + LN_EPS);
#pragma unroll
        for (int j = 0; j < 4; ++j) { const f32x4 g = *((const f32x4*)p.g2 + lane + 64 * j), be = *((const f32x4*)p.be2 + lane + 64 * j);
            *((f32x4*)(p.out + (size_t)t * DM) + lane + 64 * j) = v[j] * rstd * g + be; }
    }
}

#ifndef PROBE_ID
#define PROBE_ID 0
#endif
#define RUN2(id, ...) do { __VA_ARGS__; if (PROBE_ID == (id)) { xcd_barrier(bar); __VA_ARGS__; } } while (0)
__global__ void __launch_bounds__(NTHREADS, 2) mega(Params p) {
    extern __shared__ __attribute__((aligned(16))) unsigned char lds_raw[];

    LAS unsigned char* lds = (LAS unsigned char*)lds_raw;
    const int bid = blockIdx.x, nblk = gridDim.x, tid = opaque_tid();
    for (int u = tid; u < (LDS_BYTES - LDSCTL_OFF) / 4; u += NTHREADS) ((LAS unsigned*)(lds + LDSCTL_OFF))[u] = 0u;
    __syncthreads();
    unsigned* ctl = (unsigned*)(p.ws + WS_CTL);
    XcdBarrier bar = xcd_barrier_post(ctl + CW_BAR, (volatile LAS unsigned*)(lds + MISC_OFF) + 8);
    const float* mod = (const float*)(p.ws + WS_MOD);

    ph_mod(p, lds, bid, nblk);
    xcd_barrier(bar);
    RUN2(1, ph_prologue(p, lds, bid, nblk));
    RUN2(7, ph_xn(p, bid, nblk));
    xcd_barrier(bar);
    {
        pg8::Gemm g{(const pg8::bf16_t*)(p.ws + WS_XN), (const pg8::bf16_t*)(p.ws + WS_WIN), NT, NIN, DM}; pg8::StaticOrder S; S.init(NT, NIN, nblk, bid);
        EpiIn E{(bf16*)(p.ws + WS_FZ), (bf16*)(p.ws + WS_QB), (const float*)(p.ws + WS_MISC), p.pos};
        pg8::gemm_phase<EpiIn, pg8::StaticOrder, true, true>(lds, g, S, E);
    }
    xcd_barrier(bar);
    RUN2(8, ph_fft(p, lds, bid, nblk));
    RUN2(2, ph_attn_fast(p, lds, bid, nblk));
    xcd_barrier(bar);
    RUN2(3, ph_merge(p, bid, nblk));
    xcd_barrier(bar);
    {
        pg8::Gemm g{(const pg8::bf16_t*)(p.ws + WS_XN), (const pg8::bf16_t*)(p.ws + WS_WOUT), NT, DM, DM}; pg8::StaticOrder S; S.init(NT, DM, nblk, bid);
        EpiOut E{(bf16*)(p.ws + WS_Y1), p.x, mod, p.b_out};
        pg8::gemm_phase<EpiOut, pg8::StaticOrder, true, true>(lds, g, S, E);
    }
    xcd_barrier(bar);
    RUN2(4, ph_ln1_fast(p, bid, nblk));
    xcd_barrier(bar);
    {
        pg8::Gemm g{(const pg8::bf16_t*)(p.ws + WS_XN), (const pg8::bf16_t*)(p.ws + WS_WPQ), NT, DM, DM}; pg8::StaticOrder S; S.init(NT, DM, nblk, bid);
        EpiPeerTopk E{(const bf16*)(p.ws + WS_SUBK), (unsigned short*)(p.ws + WS_IDS), (float*)(p.ws + WS_GATES), (const float*)(p.ws + WS_SV)};
        pg8::gemm_phase<EpiPeerTopk, pg8::StaticOrder, false, true>(lds, g, S, E);
    }
    xcd_barrier(bar);
    RUN2(6, ph_udot(p, bid, nblk));
    xcd_barrier(bar);
    RUN2(11, ph_act(p, bid, nblk));
    xcd_barrier(bar);
    RUN2(10, ph_vacc(p, bid, nblk));
    xcd_barrier(bar);
    ph_final(p, bid, nblk);
}

extern "C" void kernel_launch(void* const* d_in, const int* in_sizes, int n_in, void* d_out, int out_size, void* d_ws, size_t ws_size, hipStream_t stream) {
    Params p{};
    p.x = (const float*)d_in[0]; p.c = (const float*)d_in[1]; p.pos = (const int*)d_in[2]; p.w_ada = (const float*)d_in[3]; p.b_ada = (const float*)d_in[4];
    p.w_in = (const float*)d_in[5]; p.b_in = (const float*)d_in[6]; p.w_four = (const float*)d_in[7]; p.w_out = (const float*)d_in[8]; p.b_out = (const float*)d_in[9];
    p.g1 = (const float*)d_in[10]; p.be1 = (const float*)d_in[11]; p.w_pq = (const float*)d_in[12]; p.subk = (const float*)d_in[13]; p.pu = (const float*)d_in[14]; p.pv = (const float*)d_in[15];
    p.g2 = (const float*)d_in[16]; p.be2 = (const float*)d_in[17]; p.out = (float*)d_out; p.ws = (unsigned char*)d_ws;
    static int grid_blocks = 0;
    if (grid_blocks == 0) {
        if (ws_size < WS_END) { fprintf(stderr, "workspace too small: %zu < %zu\n", ws_size, (size_t)WS_END); grid_blocks = -1; return; }
        int dev = 0, cus = 0, per_cu = 0;
        if (hipGetDevice(&dev) != hipSuccess || hipDeviceGetAttribute(&cus, hipDeviceAttributeMultiprocessorCount, dev) != hipSuccess) { grid_blocks = -1; return; }
        if (hipFuncSetAttribute((const void*)mega, hipFuncAttributeMaxDynamicSharedMemorySize, LDS_BYTES) != hipSuccess) { fprintf(stderr, "hipFuncSetAttribute failed\n"); grid_blocks = -1; return; }
        if (hipOccupancyMaxActiveBlocksPerMultiprocessor(&per_cu, (const void*)mega, NTHREADS, LDS_BYTES) != hipSuccess || per_cu < 1) { fprintf(stderr, "occupancy query: %d\n", per_cu); grid_blocks = -1; return; }
        grid_blocks = cus;
    }
    if (grid_blocks < 0) return;
    if (hipMemsetAsync((char*)d_ws + WS_CTL, 0, CTL_ZERO_BYTES, stream) != hipSuccess) { fprintf(stderr, "memset failed\n"); return; }
    void* args[] = {&p};
    hipError_t e = hipLaunchCooperativeKernel((void*)mega, dim3(grid_blocks), dim3(NTHREADS), args, LDS_BYTES, stream);
    if (e != hipSuccess) fprintf(stderr, "cooperative launch failed: %s (grid %d)\n", hipGetErrorString(e), grid_blocks);
}
```

```cpp
#include <hip/hip_runtime.h>
#include <hip/hip_cooperative_groups.h>
#include <cstdio>
#include <cstdint>
#include <cmath>
namespace cg = cooperative_groups;

namespace pg8 {
#define PG8_LAS __attribute__((address_space(3)))
typedef unsigned short bf16_t;
typedef short bf16x8 __attribute__((ext_vector_type(8)));
typedef float f32x4 __attribute__((ext_vector_type(4)));
typedef unsigned u32x4 __attribute__((ext_vector_type(4)));
constexpr int BM = 256, BK = 64, HALF = 128, HTB = HALF * BK * 2  , STAGE_BYTES = 8 * HTB, NXCD = 8, WGM = 8;

__host__ __device__ __forceinline__ int lds_byte(int r, int c) { const int st = (r >> 4) * 2 + (c >> 5), rr = r & 15, cc = c & 31, ob = rr * 64 + cc * 2; return st * 1024 + (ob ^ (((ob >> 9) & 1) << 5)); }
__host__ __device__ __forceinline__ void stage_rc(int b, int& R, int& C) { const int st = b / 1024, sb = b % 1024, swz = sb ^ (((sb >> 9) & 1) << 5); R = (st >> 1) * 16 + swz / 64; C = (st & 1) * 32 + (swz % 64) / 2; }
__host__ __device__ __forceinline__ int perm32(int rho) { const int n = rho >> 4, i = rho & 15; return 8 * (i >> 2) + 4 * n + (i & 3); }

struct Unit { int pm, pn; };
struct Gemm { const bf16_t* A; const bf16_t* Bt; int M, N, K; };

struct StaticOrder {
    int nM, nN, nwg, G, c;
    __host__ __device__ void init(int M, int N, int G_, int c_) { nM = M / BM; nN = N / BM; nwg = nM * nN; G = G_; c = c_; }
    __host__ __device__ bool next(int i, Unit& u) const {
        const long L = (long)i * G + c; if (L >= nwg) return false;
        int wgid = (int)L; { const int q = nwg / NXCD, r = nwg % NXCD, xcd = wgid % NXCD, off = wgid / NXCD; wgid = (xcd < r ? xcd * (q + 1) : r * (q + 1) + (xcd - r) * q) + off; }
        const int nig = WGM * nN, gid = wgid / nig, fm = gid * WGM, gsz = (nM - fm) < WGM ? (nM - fm) : WGM;
        u.pm = fm + ((wgid % nig) % gsz); u.pn = (wgid % nig) / gsz; return true;
    }
    __device__ __forceinline__ void a_ready(const Unit&) const {}
    __device__ __forceinline__ void done(const Unit&) const {}
};

__device__ __forceinline__ unsigned cvt_pk_bf16(float lo, float hi) { unsigned r; asm volatile("v_cvt_pk_bf16_f32 %0, %1, %2" : "=v"(r) : "v"(lo), "v"(hi)); return r; }
typedef float f32x2 __attribute__((ext_vector_type(2)));
__device__ __forceinline__ f32x2 gelu_pk(f32x2 v) {
    const f32x2 av = __builtin_elementwise_abs(v), d = av * 0.2316418882f + 1.0f;
    f32x2 t; t.x = __builtin_amdgcn_rcpf(d.x); t.y = __builtin_amdgcn_rcpf(d.y);
    f32x2 q = t * 0.5307027145f + (-0.7265760135f); q = q * t + 0.7107068705f; q = q * t + (-0.142248368f); q = q * t + 0.127414796f; q = q * t;
    const f32x2 s = (v * v) * (-0.72134752044f);
    f32x2 e; e.x = __builtin_amdgcn_exp2f(s.x); e.y = __builtin_amdgcn_exp2f(s.y);
    const f32x2 m = v * (q * e), r = v - m;
    f32x2 o; o.x = v.x < 0.f ? m.x : r.x; o.y = v.y < 0.f ? m.y : r.y; return o;
}

template <int ACT  > struct EpiBf16 {
    static constexpr bool PERM = true, AFTER_DRAIN = false; static_assert(ACT == 0 || ACT == 1, "EpiBf16: ACT is 0 (none) or 1 (gelu_pk)");
    bf16_t* O; int ldc; const float* bias; int split_cols; size_t split_stride; float scale0;
    __device__ __forceinline__ void operator()(const f32x4 (&acc)[2][2][4][2], const Unit& u, int wr, int wc, int fr, int fq) const {
        const int row0 = u.pm * BM + wr * 64 + fr; int colt = u.pn * BM; bf16_t* base = O;
        float sc = 1.f; if (split_cols) { const int t = colt / split_cols; base += (size_t)t * split_stride; colt -= t * split_cols; if (t == 0) sc = scale0; }
        const int col0 = colt + wc * 32 + 8 * fq, bcol0 = u.pn * BM + wc * 32 + 8 * fq;
        f32x4 bv[2][2];
#pragma unroll
        for (int bj = 0; bj < 2; ++bj)
#pragma unroll
            for (int n = 0; n < 2; ++n) bv[bj][n] = bias ? *(const f32x4*)(bias + bcol0 + bj * HALF + 4 * n) : (f32x4){0.f, 0.f, 0.f, 0.f};
#pragma unroll
        for (int ai = 0; ai < 2; ++ai)
#pragma unroll
            for (int m = 0; m < 4; ++m) { bf16_t* rowp = base + (size_t)(row0 + ai * HALF + m * 16) * ldc + col0;
#pragma unroll
                for (int bj = 0; bj < 2; ++bj) { f32x4 v0 = acc[ai][bj][m][0] + bv[bj][0], v1 = acc[ai][bj][m][1] + bv[bj][1];
                    if (ACT == 1) { f32x2 a = gelu_pk((f32x2){v0[0], v0[1]}), b = gelu_pk((f32x2){v0[2], v0[3]}), c = gelu_pk((f32x2){v1[0], v1[1]}), d = gelu_pk((f32x2){v1[2], v1[3]});
                        v0 = (f32x4){a.x, a.y, b.x, b.y}; v1 = (f32x4){c.x, c.y, d.x, d.y}; }
                    v0 = v0 * sc; v1 = v1 * sc; u32x4 w; w.x = cvt_pk_bf16(v0[0], v0[1]); w.y = cvt_pk_bf16(v0[2], v0[3]); w.z = cvt_pk_bf16(v1[0], v1[1]); w.w = cvt_pk_bf16(v1[2], v1[3]);
                    *(u32x4*)(rowp + bj * HALF) = w; } }
    }
};
template <class Epi, class Sched, bool ALIGN_EPI = false, bool SP2 = false>
__device__ __forceinline__ void gemm_phase(PG8_LAS unsigned char* lds, const Gemm g, const Sched& S, const Epi& E) {
    int tid_ = threadIdx.x; asm volatile("" : "+v"(tid_)); const int tid = tid_, wid = __builtin_amdgcn_readfirstlane(tid >> 6), lane = tid & 63, wr = wid >> 2, wc = wid & 3, fr = lane & 15, fq = lane >> 4;
    const int K = g.K, nt = K / BK;
    unsigned voffA[2], voffB[2];
#pragma unroll
    for (int i = 0; i < 2; ++i) { int R, C; stage_rc(tid * 16 + i * 8192, R, C); const int Rb = Epi::PERM ? ((R & ~31) + perm32(R & 31)) : R;
        voffA[i] = (unsigned)(R * K + C) * 2u; voffB[i] = (unsigned)(Rb * K + C) * 2u; }
    const size_t kstep = (size_t)(BK * 2);
    const size_t hstep = (size_t)HALF * K * 2;
    const size_t tstep = 2 * hstep;
    const unsigned ldsw = (unsigned)wid * 1024u;
    const int aoff = lds_byte(wr * 64 + fr, fq * 8), boff = lds_byte(wc * 32 + fr, fq * 8);
#define PG8_SA(b, h) (((b) * 2 + (h)) * HTB)
#define PG8_SB(b, h) ((4 + (b) * 2 + (h)) * HTB)
#define PG8_STAGE(bufoff, gbase, voff) do { _Pragma("unroll") for (int _i = 0; _i < 2; ++_i) \
        __builtin_amdgcn_global_load_lds((const unsigned*)((const char*)(gbase) + (voff)[_i]), (PG8_LAS unsigned*)(lds + (bufoff) + ldsw + _i * 8192), 16, 0, 0); } while (0)
#define PG8_LDA(dst, b, h) do { _Pragma("unroll") for (int m = 0; m < 4; ++m) _Pragma("unroll") for (int k = 0; k < 2; ++k) dst[m][k] = *(const PG8_LAS bf16x8*)(lds + PG8_SA(b, h) + aoff + m * 2048 + k * 1024); } while (0)
#define PG8_LDB(dst, b, h) do { _Pragma("unroll") for (int n = 0; n < 2; ++n) _Pragma("unroll") for (int k = 0; k < 2; ++k) dst[n][k] = *(const PG8_LAS bf16x8*)(lds + PG8_SB(b, h) + boff + n * 2048 + k * 1024); } while (0)
#define PG8_MMA(ai, bj, At, Bt) do { __builtin_amdgcn_s_setprio(1); _Pragma("unroll") for (int m = 0; m < 4; ++m) _Pragma("unroll") for (int n = 0; n < 2; ++n) _Pragma("unroll") for (int k = 0; k < 2; ++k) \
        acc[ai][bj][m][n] = __builtin_amdgcn_mfma_f32_16x16x32_bf16(Bt[n][k], At[m][k], acc[ai][bj][m][n], 0, 0, 0); __builtin_amdgcn_s_setprio(0); } while (0)
#define PG8_WAIT_V(n) asm volatile("s_waitcnt vmcnt(" #n ")" ::: "memory")
#define PG8_WAIT_L(n) asm volatile("s_waitcnt lgkmcnt(" #n ")" ::: "memory")
#define PG8_BAR __builtin_amdgcn_s_barrier()
#define PG8_SCHED __builtin_amdgcn_sched_barrier(0)
    Unit cur, nxt; int ui = 0;
    if (!S.next(0, cur)) return;
    f32x4 acc[2][2][4][2];
#pragma unroll
    for (int a = 0; a < 2; ++a)
#pragma unroll
        for (int b = 0; b < 2; ++b)
#pragma unroll
            for (int m = 0; m < 4; ++m)
#pragma unroll
                for (int n = 0; n < 2; ++n) acc[a][b][m][n] = (f32x4){0.f, 0.f, 0.f, 0.f};
    bf16x8 At[4][2], B0[2][2], B1[2][2];
    const char* cA = (const char*)g.A + (size_t)cur.pm * tstep; const char* cB = (const char*)g.Bt + (size_t)cur.pn * tstep;
    S.a_ready(cur);
    if constexpr (SP2) {
        PG8_STAGE(PG8_SB(0, 0), cB, voffB); PG8_STAGE(PG8_SB(0, 1), cB + hstep, voffB); PG8_STAGE(PG8_SA(0, 0), cA, voffA); PG8_STAGE(PG8_SA(0, 1), cA + hstep, voffA);
        if (wr == 1) PG8_BAR;
        PG8_WAIT_V(2); PG8_BAR;
        PG8_STAGE(PG8_SB(1, 0), cB + kstep, voffB); PG8_STAGE(PG8_SA(1, 0), cA + kstep, voffA); PG8_STAGE(PG8_SB(1, 1), cB + hstep + kstep, voffB);
        PG8_WAIT_V(6); PG8_BAR;
    } else {
        PG8_STAGE(PG8_SB(0, 0), cB, voffB); PG8_STAGE(PG8_SA(0, 0), cA, voffA); PG8_STAGE(PG8_SB(0, 1), cB + hstep, voffB); PG8_STAGE(PG8_SA(0, 1), cA + hstep, voffA);
        if (wr == 1) PG8_BAR;
        PG8_WAIT_V(4); PG8_BAR;
        PG8_STAGE(PG8_SB(1, 0), cB + kstep, voffB); PG8_STAGE(PG8_SA(1, 0), cA + kstep, voffA); PG8_STAGE(PG8_SB(1, 1), cB + hstep + kstep, voffB);
        PG8_WAIT_V(6); PG8_BAR;
    }
    for (;;) {
        const bool has_next = S.next(ui + 1, nxt);
        const char* nA = has_next ? (const char*)g.A + (size_t)nxt.pm * tstep : cA; const char* nB = has_next ? (const char*)g.Bt + (size_t)nxt.pn * tstep : cB;
        for (int t = 0; t < nt; t += 2) {
            const bool last = (t == nt - 2);
            const char* a1 = cA + (size_t)(t + 1) * kstep;
            const char* a2 = last ? nA : cA + (size_t)(t + 2) * kstep; const char* b2 = last ? nB : cB + (size_t)(t + 2) * kstep;
            const char* a3 = a2 + kstep; const char* b3 = b2 + kstep;
            if (last && has_next) S.a_ready(nxt);
            if constexpr (SP2) {
            PG8_LDB(B0, 0, 0); PG8_LDB(B1, 0, 1); PG8_SCHED; PG8_LDA(At, 0, 0); PG8_STAGE(PG8_SA(1, 1), a1 + hstep, voffA);
            PG8_WAIT_V(8); PG8_WAIT_L(0); PG8_BAR; PG8_MMA(0, 0, At, B0); PG8_MMA(0, 1, At, B1); PG8_BAR; PG8_SCHED;
            PG8_LDA(At, 0, 1); PG8_STAGE(PG8_SB(0, 0), b2, voffB); PG8_STAGE(PG8_SB(0, 1), b2 + hstep, voffB); PG8_STAGE(PG8_SA(0, 0), a2, voffA);
            PG8_WAIT_V(8); PG8_WAIT_L(0); PG8_BAR; PG8_MMA(1, 0, At, B0); PG8_MMA(1, 1, At, B1); PG8_BAR; PG8_SCHED;
            PG8_LDB(B0, 1, 0); PG8_LDB(B1, 1, 1); PG8_SCHED; PG8_LDA(At, 1, 0); PG8_STAGE(PG8_SA(0, 1), a2 + hstep, voffA);
            PG8_WAIT_V(8); PG8_WAIT_L(0); PG8_BAR; PG8_MMA(0, 0, At, B0); PG8_MMA(0, 1, At, B1); PG8_BAR; PG8_SCHED;
            PG8_LDA(At, 1, 1); PG8_STAGE(PG8_SB(1, 0), b3, voffB); PG8_STAGE(PG8_SB(1, 1), b3 + hstep, voffB); PG8_STAGE(PG8_SA(1, 0), a3, voffA);
            PG8_WAIT_V(8); PG8_WAIT_L(0); PG8_BAR; PG8_MMA(1, 0, At, B0); PG8_MMA(1, 1, At, B1); PG8_BAR; PG8_SCHED;
            } else {
            PG8_LDB(B0, 0, 0); PG8_SCHED; PG8_LDA(At, 0, 0); PG8_STAGE(PG8_SA(1, 1), a1 + hstep, voffA);
            PG8_WAIT_L(8); PG8_BAR; PG8_WAIT_L(0); PG8_MMA(0, 0, At, B0); PG8_BAR; PG8_SCHED;
            PG8_LDB(B1, 0, 1); PG8_STAGE(PG8_SB(0, 0), b2, voffB);
            PG8_BAR; PG8_WAIT_L(0); PG8_MMA(0, 1, At, B1); PG8_BAR;
            PG8_LDA(At, 0, 1); PG8_STAGE(PG8_SA(0, 0), a2, voffA);
            PG8_BAR; PG8_WAIT_L(0); PG8_MMA(1, 0, At, B0); PG8_BAR; PG8_SCHED;
            PG8_STAGE(PG8_SB(0, 1), b2 + hstep, voffB);
            PG8_WAIT_V(6); PG8_BAR; PG8_MMA(1, 1, At, B1); PG8_BAR;
            PG8_LDB(B0, 1, 0); PG8_SCHED; PG8_LDA(At, 1, 0); PG8_STAGE(PG8_SA(0, 1), a2 + hstep, voffA);
            PG8_WAIT_L(8); PG8_BAR; PG8_WAIT_L(0); PG8_MMA(0, 0, At, B0); PG8_BAR; PG8_SCHED;
            PG8_LDB(B1, 1, 1); PG8_STAGE(PG8_SB(1, 0), b3, voffB);
            PG8_BAR; PG8_WAIT_L(0); PG8_MMA(0, 1, At, B1); PG8_BAR;
            PG8_LDA(At, 1, 1); PG8_STAGE(PG8_SA(1, 0), a3, voffA);
            PG8_BAR; PG8_WAIT_L(0); PG8_MMA(1, 0, At, B0); PG8_BAR; PG8_SCHED;
            PG8_STAGE(PG8_SB(1, 1), b3 + hstep, voffB);
            PG8_WAIT_V(6); PG8_BAR; PG8_MMA(1, 1, At, B1); PG8_BAR;
            }
        }
        if constexpr (ALIGN_EPI) { if (wr == 0) PG8_BAR; }
        if constexpr (!Epi::AFTER_DRAIN) { E(acc, cur, wr, wc, fr, fq); S.done(cur); }
        if (!has_next) break;
#pragma unroll
        for (int a = 0; a < 2; ++a)
#pragma unroll
            for (int b = 0; b < 2; ++b)
#pragma unroll
                for (int m = 0; m < 4; ++m)
#pragma unroll
                    for (int n = 0; n < 2; ++n) acc[a][b][m][n] = (f32x4){0.f, 0.f, 0.f, 0.f};
        cur = nxt; cA = nA; cB = nB; ++ui;
        if constexpr (ALIGN_EPI) { if (wr == 1) PG8_BAR; }
    }
    PG8_WAIT_V(0);
    if constexpr (!ALIGN_EPI) { if (wr == 0) PG8_BAR; }
    PG8_BAR;
    if constexpr (Epi::AFTER_DRAIN) { E.fused(acc, cur, wr, wc, fr, fq, lds, wid, lane); S.done(cur); }
#undef PG8_SA
#undef PG8_SB
#undef PG8_STAGE
#undef PG8_LDA
#undef PG8_LDB
#undef PG8_MMA
#undef PG8_WAIT_V
#undef PG8_WAIT_L
#undef PG8_BAR
#undef PG8_SCHED
}
}

#define LAS __attribute__((address_space(3)))
#define GAS __attribute__((address_space(1)))
#define XB_TMO      128
#define XB_XCNT(j)  (256  + 64 * (j))
#define XB_XSUB(j)  (1280 + 64 * (j))
#define XB_XGEN(j)  (2304 + 64 * (j))
#define XB_TOP      3328
#define XB_TOPGEN   3392
#define XCD_BAR_WORDS 3456
#define XB_SPIN_CAP (1u << 18)

__device__ __forceinline__ unsigned xb_ld(unsigned* p)              { return __hip_atomic_load(p, __ATOMIC_RELAXED, __HIP_MEMORY_SCOPE_AGENT); }
__device__ __forceinline__ unsigned xb_add(unsigned* p, unsigned v) { return __hip_atomic_fetch_add(p, v, __ATOMIC_RELAXED, __HIP_MEMORY_SCOPE_AGENT); }
__device__ __forceinline__ unsigned xb_xcc_id() { return (unsigned)__builtin_amdgcn_s_getreg((3 << 11) | 20) & 0xFu; }
#define XB_SPIN(cond, bar) do { unsigned _sp = 0; while (cond) { __builtin_amdgcn_s_sleep(1); \
    if ((++_sp & 255u) == 0u) { if (xb_ld(&(bar)[XB_TMO])) break; if (_sp > XB_SPIN_CAP) { atomicAdd(&(bar)[XB_TMO], 1u); break; } } } } while (0)

struct XcdBarrier {
    unsigned* bar; unsigned x;
    volatile LAS unsigned* st;
};

__device__ __forceinline__ XcdBarrier xcd_barrier_post(unsigned* bar, volatile LAS unsigned* st) {
    XcdBarrier b; b.bar = bar; b.x = xb_xcc_id(); b.st = st;
    if (threadIdx.x == 0) (void)xb_add(&bar[XB_XCNT(b.x)], 1u);
    return b;
}
__device__ __forceinline__ void xcd_barrier_complete(unsigned* bar, unsigned x, unsigned& nloc, unsigned& nx) {
    const unsigned G = gridDim.x * gridDim.y * gridDim.z;
    unsigned sum, cnt, mine, sp = 0u;
    for (;;) {
        sum = 0u; cnt = 0u; mine = 0u;
#pragma unroll
        for (unsigned j = 0; j < 16; ++j) { const unsigned c = xb_ld(&bar[XB_XCNT(j)]); sum += c; cnt += (c > 0u) ? 1u : 0u; mine = (j == x) ? c : mine; }
        if (sum == G) break;
        __builtin_amdgcn_s_sleep(1);
        if ((++sp & 255u) == 0u) { if (xb_ld(&bar[XB_TMO])) break; if (sp > XB_SPIN_CAP) { atomicAdd(&bar[XB_TMO], 1u); break; } }
    }
    nloc = mine > 0u ? mine : 1u; nx = cnt > 0u ? cnt : 1u;
}

__device__ __forceinline__ void xcd_barrier(const XcdBarrier& b) {
    asm volatile("s_waitcnt vmcnt(0)" ::: "memory");
    __syncthreads();
    if (threadIdx.x == 0) {
        unsigned* bar = b.bar;
        __builtin_amdgcn_s_waitcnt(0);
        unsigned nloc = b.st[0], nx = b.st[1];
        if (nloc == 0u) { xcd_barrier_complete(bar, b.x, nloc, nx); b.st[0] = nloc; b.st[1] = nx; }
        const unsigned old = xb_add(&bar[XB_XSUB(b.x)], 1u);
        const unsigned gen = old / nloc;
        if (old + 1u == (gen + 1u) * nloc) {
            __builtin_amdgcn_fence(__ATOMIC_RELEASE, "agent");
            asm volatile("s_waitcnt vmcnt(0)" ::: "memory");
            const unsigned og = xb_add(&bar[XB_TOP], 1u);
            const unsigned tg = og / nx;
            if (og + 1u == (tg + 1u) * nx) xb_add(&bar[XB_TOPGEN], 1u);
            else XB_SPIN(xb_ld(&bar[XB_TOPGEN]) == tg, bar);
            __builtin_amdgcn_fence(__ATOMIC_ACQUIRE, "agent");
            xb_add(&bar[XB_XGEN(b.x)], 1u);
            asm volatile("s_waitcnt vmcnt(0)" ::: "memory");
        } else {
            XB_SPIN(xb_ld(&bar[XB_XGEN(b.x)]) == gen, bar);
            __builtin_amdgcn_fence(__ATOMIC_ACQUIRE, "agent");
            asm volatile("s_waitcnt vmcnt(0)" ::: "memory");
        }
    }
    __syncthreads();
}

constexpr int DM = 1024, NB = 2, SEQ = 8192, NT = NB * SEQ;
constexpr int NTHREADS = 512, NWAVES = 8;
constexpr float LN_EPS = 1e-5f;
constexpr float ALPHA = 1.189207115002721f;
typedef unsigned short bf16;
typedef unsigned v4u __attribute__((ext_vector_type(4)));
typedef unsigned v2u __attribute__((ext_vector_type(2)));
typedef float f32x4 __attribute__((ext_vector_type(4)));
typedef short bf16x8_t __attribute__((ext_vector_type(8)));

constexpr size_t MiB = 1u << 20, KiB = 1u << 10;
constexpr size_t WS_CTL = 0, CTL_ZERO_BYTES = 1 * MiB;
constexpr size_t WS_MOD = 1 * MiB + 768 * KiB;
constexpr size_t WS_MMAT = 1 * MiB;
constexpr size_t WS_ROPE = 2 * MiB;
constexpr size_t WS_WIN = 6 * MiB, WS_WOUT = 12 * MiB, WS_WPQ = 14 * MiB, WS_MISC = 16 * MiB, WS_SUBK = 17 * MiB;
constexpr size_t WS_XN = 18 * MiB;
constexpr size_t WS_FZ = 50 * MiB;
constexpr size_t WS_QB = 66 * MiB, WS_KB = 90 * MiB, WS_VB = 114 * MiB, WS_O3 = 138 * MiB, WS_LSE = 162 * MiB;
constexpr size_t WS_H2Q = 50 * MiB, WS_HS = 66 * MiB, WS_WQ = 67 * MiB, WS_WSC = 69 * MiB, WS_SUA = 75 * MiB, WS_X1 = 83 * MiB;
constexpr size_t WS_Y1 = 116 * MiB, WS_PQ = 116 * MiB, WS_PART = 116 * MiB, WS_Y = 116 * MiB;
constexpr size_t WS_IDS = 180 * MiB, WS_GATES = 188 * MiB;
constexpr size_t WS_TU8 = 200 * MiB, WS_TV8 = 216 * MiB, WS_SU = 232 * MiB, WS_SV = 232 * MiB + 512 * KiB, WS_END = 233 * MiB;
constexpr float QSCALE = 0.125f * 1.4426950408889634f;
constexpr int NIN = 2816;
constexpr int CW_BAR = 4096;

constexpr int RING_BYTES = 131072, LDSCTL_OFF = RING_BYTES, MISC_OFF = LDSCTL_OFF + 320, LDS_BYTES = 147456;

struct Params {
    const float* x; const float* c; const int* pos; const float* w_ada; const float* b_ada; const float* w_in; const float* b_in;
    const float* w_four; const float* w_out; const float* b_out; const float* g1; const float* be1; const float* w_pq; const float* subk;
    const float* pu; const float* pv; const float* g2; const float* be2; float* out; unsigned char* ws;
};

__device__ __forceinline__ unsigned f2bf(float f) { unsigned u = __builtin_bit_cast(unsigned, f); return (u + 0x7fffu + ((u >> 16) & 1u)) >> 16; }
__device__ __forceinline__ unsigned pk2(float lo, float hi) { return f2bf(lo) | (f2bf(hi) << 16); }
__device__ __forceinline__ float wave_sum(float v) {
#pragma unroll
    for (int o = 32; o > 0; o >>= 1) v += __shfl_xor(v, o);
    return v;
}
__device__ __forceinline__ float wave_max(float v) {
#pragma unroll
    for (int o = 32; o > 0; o >>= 1) v = fmaxf(v, __shfl_xor(v, o));
    return v;
}
#define LDS_WAIT() asm volatile("s_waitcnt lgkmcnt(0)" ::: "memory")
__device__ __forceinline__ int opaque_tid() { int t = threadIdx.x; asm volatile("" : "+v"(t)); return t; }
__device__ __forceinline__ int wave_id() { return __builtin_amdgcn_readfirstlane(opaque_tid() >> 6); }
__device__ __forceinline__ float bflo(unsigned u) { return __builtin_bit_cast(float, u << 16); }
__device__ __forceinline__ float bfhi(unsigned u) { return __builtin_bit_cast(float, u & 0xffff0000u); }

template <class SC>
__device__ __forceinline__ void transpose_item(const float* W, int K, int N, bf16* WT, int nout, SC srccol, LAS float* scr, int item, int lane) {
    const int nblk = nout / 32, kb = item / nblk, nb = item % nblk, k0 = 64 * kb, n0 = 32 * nb;
    const int sc = srccol(n0 + (lane & 31));
#pragma unroll 8
    for (int i = 0; i < 32; ++i) { const int kk = 2 * i + (lane >> 5); scr[kk * 33 + (lane & 31)] = W[(size_t)(k0 + kk) * N + sc]; }
    LDS_WAIT(); asm volatile("" ::: "memory");
    const int c = lane & 7;
#pragma unroll
    for (int j = 0; j < 4; ++j) { const int n = (lane >> 3) + 8 * j; const LAS float* s = scr + (8 * c) * 33 + n;
        v4u o; o.x = pk2(s[0 * 33], s[1 * 33]); o.y = pk2(s[2 * 33], s[3 * 33]); o.z = pk2(s[4 * 33], s[5 * 33]); o.w = pk2(s[6 * 33], s[7 * 33]);
        *(v4u*)(WT + (size_t)(n0 + n) * K + k0 + 8 * c) = o; }
    LDS_WAIT(); asm volatile("" ::: "memory");
}
__device__ __forceinline__ void ph_prologue(const Params& p, LAS unsigned char* lds, int bid, int nblk) {
    const int tid = opaque_tid(), lane = tid & 63, wave = __builtin_amdgcn_readfirstlane(tid >> 6);
    {
        LAS float* M = (LAS float*)lds; LAS float* Wl = (LAS float*)(lds + 32768);
        bf16* WT = (bf16*)(p.ws + WS_WIN); float* biasf = (float*)(p.ws + WS_MISC); const float* MM = (const float*)(p.ws + WS_MMAT);
        const bool fallback = !(nblk > 192);
        for (int it = bid; it < 256; it += nblk) {
            const int g = it & 3, kb = it >> 2, k0 = kb * 16;
            __syncthreads();
            if (fallback) { const float norm = 1.0f / sqrtf(8192.0f * 64.0f);
                for (int e = tid; e < 8192; e += NTHREADS) { const int c = e >> 7, nl = e & 127; float a = 0.f;
                    for (int cp = 0; cp < 64; ++cp) { const float ang = 2.0f * (float)((c * cp) & 63) / 64.0f; a += ((nl & 1) ? -sinpif(ang) : cospif(ang)) * p.w_four[(g * 64 + cp) * 64 + (nl >> 1)]; }
                    M[e] = a * norm; } }
            else {
#pragma unroll
                for (int i = 0; i < 4; ++i) *(LAS f32x4*)(lds + (tid + i * 512) * 16) = *(const f32x4*)(MM + (size_t)g * 8192 + (tid + i * 512) * 4); }
#pragma unroll
            for (int i = 0; i < 2; ++i) { const int e = tid + i * 512, k = e >> 6, c = e & 63; Wl[k * 64 + c] = p.w_in[(size_t)(k0 + k) * 2560 + g * 64 + c]; }
            __syncthreads();
            { const int nl = tid & 127, kq = tid >> 7; float a[4] = {0.f, 0.f, 0.f, 0.f};
              for (int c = 0; c < 64; ++c) { const float mv = M[c * 128 + nl];
#pragma unroll
                  for (int j = 0; j < 4; ++j) a[j] += mv * Wl[(kq * 4 + j) * 64 + c]; }
              *(v2u*)(WT + (size_t)(g * 128 + nl) * DM + k0 + kq * 4) = (v2u){pk2(a[0], a[1]), pk2(a[2], a[3])};
              if (kb == 0 && tid < 128) { float bsum = 0.f; for (int c = 0; c < 64; ++c) bsum += p.b_in[g * 64 + c] * M[c * 128 + nl]; biasf[g * 128 + nl] = bsum; } }
        }
        __syncthreads();
        for (int i = bid * NTHREADS + tid; i < 2304; i += nblk * NTHREADS) biasf[512 + i] = p.b_in[256 + i];
    }
    {
        LAS float* scr = (LAS float*)(lds + wave * 16384);
        const int gw = bid * NWAVES + wave, NGW = nblk * NWAVES;
        constexpr int I_IN = 16 * (2304 / 32), I_O = 16 * 32, I_PQ = 16 * 32;
        for (int it = gw; it < I_IN + I_O + I_PQ; it += NGW) {
            int r = it;
            if (r < I_IN) {
                transpose_item(p.w_in, DM, 2560, (bf16*)(p.ws + WS_WIN) + (size_t)512 * DM, 2304,
                    [](int n) { return n < 1536 ? 256 + (n & ~63) + ((n & 63) >> 1) + 32 * (n & 1) : 256 + n; }, scr, r, lane); continue; } r -= I_IN;
            if (r < I_O) { transpose_item(p.w_out, DM, DM, (bf16*)(p.ws + WS_WOUT), DM, [](int n) { return n; }, scr, r, lane); continue; } r -= I_O;
            transpose_item(p.w_pq, DM, DM, (bf16*)(p.ws + WS_WPQ), DM, [](int n) { return n; }, scr, r, lane);
        }
    }
    { bf16* SK = (bf16*)(p.ws + WS_SUBK);
      for (int ch = bid * NTHREADS + tid; ch < 8 * 2 * 4 * 4 * 64; ch += nblk * NTHREADS) {
          const int ln = ch & 63, d0 = (ch >> 6) & 3, mt = (ch >> 8) & 3, hp = ch >> 10;
          const float* sp = p.subk + ((size_t)hp * 128 + 32 * mt + (ln & 31)) * 64 + 16 * d0 + 8 * (ln >> 5);
          v4u o; o.x = pk2(sp[0], sp[1]); o.y = pk2(sp[2], sp[3]); o.z = pk2(sp[4], sp[5]); o.w = pk2(sp[6], sp[7]);
          *(v4u*)(SK + (size_t)ch * 8) = o; } }
}
__device__ __forceinline__ void ph_mod(const Params& p, LAS unsigned char* lds, int bid, int nblk) {
    const int tid = opaque_tid(), col = tid & 31, kg = tid >> 5;
    LAS float* cond = (LAS float*)lds; LAS float* red = (LAS float*)(lds + 8192);
    float* mod = (float*)(p.ws + WS_MOD);
    for (int i = tid; i < 2 * DM; i += NTHREADS) { const float c = p.c[i]; cond[i] = c / (1.0f + expf(-c)); }
    __syncthreads();
    if (nblk > 192 && bid >= 192) {
        LAS float* T64 = (LAS float*)(lds + 12288);
        if (tid < 64) { T64[tid] = cospif(2.0f * (float)tid / 64.0f); T64[64 + tid] = -sinpif(2.0f * (float)tid / 64.0f); }
        __syncthreads();
        const float norm = 1.0f / sqrtf(8192.0f * 64.0f); float* MM = (float*)(p.ws + WS_MMAT);
        for (int it = bid - 192; it < 64; it += nblk - 192) {
            const int g = it >> 4, c = (it & 15) * 4 + (tid >> 7), nl = tid & 127; float a = 0.f;
#pragma unroll 8
            for (int cp = 0; cp < 64; ++cp) a += T64[(nl & 1) * 64 + ((c * cp) & 63)] * p.w_four[(g * 64 + cp) * 64 + (nl >> 1)];
            MM[(g * 64 + c) * 128 + nl] = a * norm;
        }
    }
    for (int it = bid; it < 6144 / 32; it += nblk) {
        const int n = it * 32 + col; float a0 = 0.f, a1 = 0.f;
        const float* wp = p.w_ada + (size_t)(kg * 64) * 6144 + n;
#pragma unroll 16
        for (int k = 0; k < 64; ++k) { const float w = wp[(size_t)k * 6144]; a0 += cond[kg * 64 + k] * w; a1 += cond[DM + kg * 64 + k] * w; }
        red[(kg * 2 + 0) * 32 + col] = a0; red[(kg * 2 + 1) * 32 + col] = a1;
        __syncthreads();
        if (tid < 64) { const int b = tid >> 5; float s = p.b_ada[n];
#pragma unroll
            for (int g = 0; g < 16; ++g) s += red[(g * 2 + b) * 32 + col];
            mod[b * 6144 + n] = s; }
        __syncthreads();
    }
}
__device__ __forceinline__ void ph_xn(const Params& p, int bid, int nblk) {
    const int lane = opaque_tid() & 63, wave = wave_id(); const float* mod = (const float*)(p.ws + WS_MOD); bf16* XN = (bf16*)(p.ws + WS_XN);
    for (int row = bid * NWAVES + wave; row < NT; row += nblk * NWAVES) {
        const int b = row / SEQ;
        const f32x4* xr = (const f32x4*)(p.x + (size_t)row * DM) + lane;
        f32x4 v[4]; float s = 0.f;
#pragma unroll
        for (int j = 0; j < 4; ++j) { v[j] = xr[64 * j]; s += (v[j].x + v[j].y) + (v[j].z + v[j].w); }
        const float mean = wave_sum(s) * (1.f / DM); float s2 = 0.f;
#pragma unroll
        for (int j = 0; j < 4; ++j) { v[j] = v[j] - mean; s2 += (v[j].x * v[j].x + v[j].y * v[j].y) + (v[j].z * v[j].z + v[j].w * v[j].w); }
        const float rstd = rsqrtf(wave_sum(s2) * (1.f / DM) + LN_EPS);
        unsigned long long* o8 = (unsigned long long*)(XN + (size_t)row * DM) + lane;
#pragma unroll
        for (int j = 0; j < 4; ++j) {
            const f32x4 sh = *((const f32x4*)(mod + b * 6144 + 0) + lane + 64 * j), sc = *((const f32x4*)(mod + b * 6144 + 1024) + lane + 64 * j);
            const f32x4 o = v[j] * rstd * (1.0f + sc) + sh;
            o8[64 * j] = (unsigned long long)pk2(o.x, o.y) | ((unsigned long long)pk2(o.z, o.w) << 32);
        }
    }
}

struct EpiOut {
    static constexpr bool PERM = true, AFTER_DRAIN = false;
    bf16* Y1; const float* x; const float* mod; const float* bo;
    __device__ __forceinline__ void operator()(const pg8::f32x4 (&acc)[2][2][4][2], const pg8::Unit& u, int wr, int wc, int fr, int fq) const {
        const int row0 = u.pm * 256 + wr * 64 + fr;
#pragma unroll
        for (int bj = 0; bj < 2; ++bj) {
            const int c0 = u.pn * 256 + bj * 128 + wc * 32 + 8 * fq;
            const pg8::f32x4 b0 = *(const pg8::f32x4*)(bo + c0), b1 = *(const pg8::f32x4*)(bo + c0 + 4);
#pragma unroll
            for (int ai = 0; ai < 2; ++ai) {
                const int bb = (u.pm * 256 + ai * 128) >> 13;
                const pg8::f32x4 g0 = *(const pg8::f32x4*)(mod + bb * 6144 + 2048 + c0) + 1.0f, g1 = *(const pg8::f32x4*)(mod + bb * 6144 + 2048 + c0 + 4) + 1.0f;
#pragma unroll
                for (int m = 0; m < 4; ++m) {
                    const int row = row0 + ai * 128 + m * 16;
                    const pg8::f32x4 x0 = *(const pg8::f32x4*)(x + (size_t)row * DM + c0), x1 = *(const pg8::f32x4*)(x + (size_t)row * DM + c0 + 4);
                    const pg8::f32x4 v0 = x0 * ALPHA + g0 * (acc[ai][bj][m][0] + b0), v1 = x1 * ALPHA + g1 * (acc[ai][bj][m][1] + b1);
                    v4u o; o.x = pk2(v0.x, v0.y); o.y = pk2(v0.z, v0.w); o.z = pk2(v1.x, v1.y); o.w = pk2(v1.z, v1.w);
                    *(v4u*)(Y1 + (size_t)row * DM + c0) = o;
                }
            }
        }
    }
};
__device__ __forceinline__ void ph_fft(const Params& p, LAS unsigned char* lds, int bid, int nblk) {
    const int tid = opaque_tid(), lane = tid & 63, wave = __builtin_amdgcn_readfirstlane(tid >> 6), lr = lane & 15, lq = lane >> 4;
    bf16* MIX = (bf16*)(p.ws + WS_XN);
    for (int item = bid; item < 256; item += nblk) {
        const int b = item >> 7, cg = item & 127;
        const unsigned long long* src = (const unsigned long long*)(p.ws + WS_FZ) + (size_t)(b * 128 + cg) * 8192;
        {
            const int n2b = (tid & 7) | ((tid >> 6) << 3), n1b = (tid >> 3) & 7;
            const unsigned long long* sb = src + 128 * n1b + n2b; LAS unsigned char* lb = lds + (2 * n2b) * 288 + 4 * n1b;
#pragma unroll
            for (int hb = 0; hb < 2; ++hb) {
                unsigned long long zin[8];
#pragma unroll
                for (int i = 0; i < 8; ++i) { const int ii = hb * 8 + i; zin[i] = sb[(ii & 1) * 64 + (ii >> 1) * 1024]; }
#pragma unroll
                for (int i = 0; i < 8; ++i) { const int ii = hb * 8 + i; LAS unsigned char* lp = lb + (ii & 1) * 36864 + (ii >> 1) * 32;
                    *(LAS unsigned*)lp = (unsigned)zin[i]; *(LAS unsigned*)(lp + 288) = (unsigned)(zin[i] >> 32); }
            }
        }
        bf16x8_t af[4];
        { const int m = 16 * wave + lr, k1 = m >> 1, ri = m & 1;
#pragma unroll
          for (int ks = 0; ks < 4; ++ks)
#pragma unroll
              for (int jj = 0; jj < 4; ++jj) { const int n1 = 16 * ks + 4 * lq + jj; const float x = (float)((n1 * k1) & 63) * (1.0f / 64.0f);
                  const float c = __builtin_amdgcn_cosf(x), s = __builtin_amdgcn_sinf(x);
                  af[ks][2 * jj] = (short)f2bf(ri ? -s : c); af[ks][2 * jj + 1] = (short)f2bf(ri ? c : s); } }
        __syncthreads();
        pg8::f32x4 acc[16];
#pragma unroll
        for (int nt = 0; nt < 16; ++nt) { acc[nt] = (pg8::f32x4){0.f, 0.f, 0.f, 0.f};
#pragma unroll
            for (int ks = 0; ks < 4; ++ks) { const bf16x8_t bf = *(const LAS bf16x8_t*)(lds + (16 * nt + lr) * 288 + (32 * ks + 8 * lq) * 2);
                acc[nt] = __builtin_amdgcn_mfma_f32_16x16x32_bf16(af[ks], bf, acc[nt], 0, 0, 0); } }
        __syncthreads();
#pragma unroll
        for (int nt = 0; nt < 16; ++nt) { const int col = 16 * nt + lr, n2 = col >> 1, ch = col & 1;
#pragma unroll
            for (int h = 0; h < 2; ++h) { const int k1 = 8 * wave + 2 * lq + h; const float yr = acc[nt][2 * h], yi = acc[nt][2 * h + 1];
                const float x = (float)((n2 * k1) & 8191) * (1.0f / 8192.0f); const float c = __builtin_amdgcn_cosf(x), s = __builtin_amdgcn_sinf(x);
                *(LAS unsigned*)(lds + (2 * k1 + ch) * 544 + 4 * n2) = pk2(yr * c + yi * s, yi * c - yr * s); } }
        bf16x8_t a2[8];
        { const int k2 = 16 * wave + lr;
#pragma unroll
          for (int ks = 0; ks < 8; ++ks)
#pragma unroll
              for (int jj = 0; jj < 4; ++jj) { const int n2 = 16 * ks + 4 * lq + jj; const float x = (float)((n2 * k2) & 127) * (1.0f / 128.0f);
                  a2[ks][2 * jj] = (short)f2bf(__builtin_amdgcn_cosf(x)); a2[ks][2 * jj + 1] = (short)f2bf(__builtin_amdgcn_sinf(x)); } }
        __syncthreads();
        pg8::f32x4 o[8];
#pragma unroll
        for (int nt = 0; nt < 8; ++nt) { o[nt] = (pg8::f32x4){0.f, 0.f, 0.f, 0.f};
#pragma unroll
            for (int ks = 0; ks < 8; ++ks) { const bf16x8_t bf = *(const LAS bf16x8_t*)(lds + (16 * nt + lr) * 544 + (32 * ks + 8 * lq) * 2);
                o[nt] = __builtin_amdgcn_mfma_f32_16x16x32_bf16(a2[ks], bf, o[nt], 0, 0, 0); } }
#pragma unroll
        for (int nt = 0; nt < 8; ++nt) { const int col2 = 16 * nt + lr, k1 = col2 >> 1, ch = col2 & 1;
#pragma unroll
            for (int r = 0; r < 4; ++r) { const float v = o[nt][r]; const float w = __shfl_xor(v, 1); const int k2 = 16 * wave + 4 * lq + r;
                if (ch == 0) *(unsigned*)(MIX + ((size_t)b * SEQ + k1 + 64 * k2) * DM + 2 * cg) = pk2(v, w); } }
        __syncthreads();
    }
}


struct EpiIn {
    static constexpr bool PERM = true, AFTER_DRAIN = false;
    bf16* FZ; bf16* QKV; const float* bias; const int* pos;
    __device__ __forceinline__ void operator()(const pg8::f32x4 (&acc)[2][2][4][2], const pg8::Unit& u, int wr, int wc, int fr, int fq) const {
        const int row0 = u.pm * 256 + wr * 64 + fr;
        float cf[4];
#pragma unroll
        for (int q = 0; q < 4; ++q) cf[q] = __builtin_amdgcn_exp2f(-(float)(16 * (wc & 1) + 4 * fq + q) * (13.287712379549449f / 32.0f)) * 0.15915494309189535f;
        const bool isqk = u.pn >= 2 && u.pn < 8;
        float posf[2][4];
#pragma unroll
        for (int ai = 0; ai < 2; ++ai)
#pragma unroll
            for (int m = 0; m < 4; ++m) posf[ai][m] = isqk ? (float)pos[row0 + ai * 128 + m * 16] : 0.f;
#pragma unroll
        for (int bj = 0; bj < 2; ++bj) {
            const int c0 = u.pn * 256 + bj * 128 + wc * 32 + 8 * fq;
            const pg8::f32x4 b0 = *(const pg8::f32x4*)(bias + c0), b1 = *(const pg8::f32x4*)(bias + c0 + 4);
#pragma unroll
            for (int ai = 0; ai < 2; ++ai)
#pragma unroll
                for (int m = 0; m < 4; ++m) {
                    const int row = row0 + ai * 128 + m * 16;
                    pg8::f32x4 v0 = acc[ai][bj][m][0] + b0, v1 = acc[ai][bj][m][1] + b1;
                    if (u.pn < 2) {
                        const int b = row >> 13, s = row & 8191, cgp = c0 >> 2;
                        unsigned long long* d0 = (unsigned long long*)(FZ + (((size_t)(b * 128 + cgp) * 8192 + s) << 2));
                        d0[0] = (unsigned long long)pk2(v0.x, v0.y) | ((unsigned long long)pk2(v0.z, v0.w) << 32);
                        d0[8192] = (unsigned long long)pk2(v1.x, v1.y) | ((unsigned long long)pk2(v1.z, v1.w) << 32);
                    } else {
                        const int cq = c0 - 512, which = cq / 768, off = cq - which * 768;
                        if (which < 2) {
                            const float sc = which == 0 ? QSCALE : 1.0f;
                            pg8::f32x4 r0, r1;
                            { const float pf = posf[ai][m]; float a0 = pf * cf[0], a1 = pf * cf[1], a2 = pf * cf[2], a3 = pf * cf[3];
                              a0 -= floorf(a0); a1 -= floorf(a1); a2 -= floorf(a2); a3 -= floorf(a3);
                              r0.x = __builtin_amdgcn_cosf(a0); r0.y = __builtin_amdgcn_sinf(a0); r0.z = __builtin_amdgcn_cosf(a1); r0.w = __builtin_amdgcn_sinf(a1);
                              r1.x = __builtin_amdgcn_cosf(a2); r1.y = __builtin_amdgcn_sinf(a2); r1.z = __builtin_amdgcn_cosf(a3); r1.w = __builtin_amdgcn_sinf(a3); }
                            pg8::f32x4 w0, w1;
                            w0.x = (v0.x * r0.x - v0.y * r0.y) * sc; w0.y = (v0.y * r0.x + v0.x * r0.y) * sc; w0.z = (v0.z * r0.z - v0.w * r0.w) * sc; w0.w = (v0.w * r0.z + v0.z * r0.w) * sc;
                            w1.x = (v1.x * r1.x - v1.y * r1.y) * sc; w1.y = (v1.y * r1.x + v1.x * r1.y) * sc; w1.z = (v1.z * r1.z - v1.w * r1.w) * sc; w1.w = (v1.w * r1.z + v1.z * r1.w) * sc;
                            v0 = w0; v1 = w1;
                        }
                        v4u o; o.x = pk2(v0.x, v0.y); o.y = pk2(v0.z, v0.w); o.z = pk2(v1.x, v1.y); o.w = pk2(v1.z, v1.w);
                        *(v4u*)(QKV + (size_t)which * ((WS_KB - WS_QB) / 2) + (size_t)row * 768 + off) = o;
                    }
                }
        }
    }
};

typedef float f32x16 __attribute__((ext_vector_type(16)));
typedef short s16x4 __attribute__((ext_vector_type(4)));
__device__ __forceinline__ int crow(int r, int hi) { return (r & 3) + 8 * (r >> 2) + 4 * hi; }
__device__ __forceinline__ s16x4 vtr(const LAS unsigned char* p) { return __builtin_bit_cast(s16x4, __builtin_amdgcn_ds_read_tr16_b64_v4i16((LAS s16x4*)p)); }
__device__ __forceinline__ unsigned cvtpk(float lo, float hi) { typedef float f2 __attribute__((ext_vector_type(2))); typedef __bf16 b2 __attribute__((ext_vector_type(2))); f2 v = {lo, hi}; b2 r = __builtin_convertvector(v, b2); return __builtin_bit_cast(unsigned, r); }
__device__ __forceinline__ void tbl_load(const Params& p, int r, f32x4 (&a)[4], int lane) {
    const bool isv = r >= 16384; const int row = isv ? r - 16384 : r;
    const f32x4* src = (const f32x4*)((isv ? p.pv : p.pu) + (size_t)row * DM + 16 * lane);
#pragma unroll
    for (int j = 0; j < 4; ++j) a[j] = src[j];
}
__device__ __forceinline__ void tbl_finish(const Params& p, int r, const f32x4 (&a)[4], int lane) {
    const bool isv = r >= 16384; const int row = isv ? r - 16384 : r;
    float amax = 0.f;
#pragma unroll
    for (int j = 0; j < 4; ++j) amax = fmaxf(amax, fmaxf(fmaxf(fabsf(a[j].x), fabsf(a[j].y)), fmaxf(fabsf(a[j].z), fabsf(a[j].w))));
    if (isv) {
        amax = wave_max(amax);
        const float inv = amax > 0.f ? 127.0f / amax : 0.f;
        v4u o;
#pragma unroll
        for (int j = 0; j < 4; ++j) { unsigned q = 0u;
            q = __builtin_amdgcn_cvt_pk_u8_f32(a[j].x * inv + 128.0f, 0, q); q = __builtin_amdgcn_cvt_pk_u8_f32(a[j].y * inv + 128.0f, 1, q);
            q = __builtin_amdgcn_cvt_pk_u8_f32(a[j].z * inv + 128.0f, 2, q); q = __builtin_amdgcn_cvt_pk_u8_f32(a[j].w * inv + 128.0f, 3, q);
            o[j] = q ^ 0x80808080u; }
        *(v4u*)(p.ws + WS_TV8 + (size_t)(lane >> 3) * (2 * MiB) + (size_t)row * 128 + 16 * (lane & 7)) = o;
        if (lane == 0) ((float*)(p.ws + WS_SV))[row] = amax * (1.0f / 127.0f);
    } else {
        amax = fmaxf(amax, __shfl_xor(amax, 1)); amax = fmaxf(amax, __shfl_xor(amax, 2)); amax = fmaxf(amax, __shfl_xor(amax, 4)); amax = fmaxf(amax, __shfl_xor(amax, 8));
        const float inv = amax > 0.f ? 7.0f / amax : 0.f;
        unsigned d[2];
#pragma unroll
        for (int w = 0; w < 2; ++w) { unsigned lo = 0u, hi = 0u;
            lo = __builtin_amdgcn_cvt_pk_u8_f32(a[2 * w].x * inv + 8.0f, 0, lo); lo = __builtin_amdgcn_cvt_pk_u8_f32(a[2 * w].y * inv + 8.0f, 1, lo);
            lo = __builtin_amdgcn_cvt_pk_u8_f32(a[2 * w].z * inv + 8.0f, 2, lo); lo = __builtin_amdgcn_cvt_pk_u8_f32(a[2 * w].w * inv + 8.0f, 3, lo);
            hi = __builtin_amdgcn_cvt_pk_u8_f32(a[2 * w + 1].x * inv + 8.0f, 0, hi); hi = __builtin_amdgcn_cvt_pk_u8_f32(a[2 * w + 1].y * inv + 8.0f, 1, hi);
            hi = __builtin_amdgcn_cvt_pk_u8_f32(a[2 * w + 1].z * inv + 8.0f, 2, hi); hi = __builtin_amdgcn_cvt_pk_u8_f32(a[2 * w + 1].w * inv + 8.0f, 3, hi);
            d[w] = lo | (hi << 4); }
        *(v2u*)(p.ws + WS_TU8 + (size_t)(lane >> 4) * (2 * MiB) + (size_t)row * 128 + 8 * (lane & 15)) = (v2u){d[0], d[1]};
        if ((lane & 15) == 0) ((float*)(p.ws + WS_SU))[(size_t)(lane >> 4) * 16384 + row] = amax * (1.0f / 7.0f);
    }
}
struct AttnDesc { int dil, ntile, res, cb, r; size_t rowb; int h; bool valid; };
__device__ __forceinline__ AttnDesc attn_desc(int bi) {
    AttnDesc d; d.valid = bi < 3 * 768; const int b2 = d.valid ? bi : 0;
    const int r = b2 / 768, rem = b2 - r * 768, bh = rem >> 5, q32 = rem & 31, b = bh / 12;
    d.r = r; d.h = bh - b * 12; d.rowb = (size_t)b * SEQ;
    const int ld = 2 * r;
    d.dil = 1 << ld; d.ntile = 256 >> ld; d.res = q32 >> (5 - ld); d.cb = q32 & ((32 >> ld) - 1);
    return d;
}
__device__ __forceinline__ void attn_dma(const AttnDesc& d, const bf16* T, bool swz, LAS unsigned char* img, int wave, int lane) {
#pragma unroll
    for (int i = 0; i < 6; ++i) {
        const int idx = wave * 6 + i, j = idx >> 2, it = idx & 3, kt = 8 * d.cb - 2 + j;
        if (kt >= 0 && kt < d.ntile) {
            const int row = it * 8 + (lane >> 3), ch = lane & 7; const int gch = swz ? (ch ^ ((row >> 1) & 7)) : ch;
            const bf16* src = T + (d.rowb + d.res + d.dil * (32 * kt + row)) * 768 + d.h * 64 + 8 * gch;
            __builtin_amdgcn_global_load_lds((const unsigned*)src, (LAS unsigned*)(img + j * 4096 + it * 1024), 16, 0, 0);
        }
    }
}
__device__ __forceinline__ void attn_qload(const AttnDesc& d, const bf16* QB, bf16x8_t (&qf)[4], int wave, int lane) {
    const bf16* qp = QB + (d.rowb + d.res + d.dil * (32 * (8 * d.cb + wave) + (lane & 31))) * 768 + d.h * 64 + 8 * (lane >> 5);
#pragma unroll
    for (int d0 = 0; d0 < 4; ++d0) qf[d0] = *(const bf16x8_t*)(qp + 16 * d0);
}
#define ATT_SYNC() do { asm volatile("s_waitcnt vmcnt(0) lgkmcnt(0)" ::: "memory"); __builtin_amdgcn_s_barrier(); asm volatile("" ::: "memory"); } while (0)
#define ATT_SYNC_N(N) do { asm volatile("s_waitcnt vmcnt(" #N ") lgkmcnt(0)" ::: "memory"); __builtin_amdgcn_s_barrier(); asm volatile("" ::: "memory"); } while (0)
__device__ __forceinline__ void ph_attn_fast(const Params& p, LAS unsigned char* lds, int bid, int nblk) {
    const int lane = opaque_tid() & 63, wave = wave_id(), r32 = lane & 31, hi = lane >> 5;
    LAS unsigned char* imgK = lds; LAS unsigned char* imgV = lds + 49152; LAS unsigned char* stgb = lds + 98304 + wave * 4096;
    const bf16* QB = (const bf16*)(p.ws + WS_QB); const bf16* KB = (const bf16*)(p.ws + WS_KB); const bf16* VB = (const bf16*)(p.ws + WS_VB);
    const int vb = (nblk & 7) == 0 ? (bid & 7) * (nblk >> 3) + (bid >> 3) : bid;
    int bi = vb;
    AttnDesc d = attn_desc(bi);
    bf16x8_t qf[4];
    if (d.valid) { attn_dma(d, KB, true, imgK, wave, lane); attn_qload(d, QB, qf, wave, lane); }
    ATT_SYNC();
    const int g = lane >> 4, ii = lane & 15;
    const int vb0 = (4 * hi + (ii >> 2)) * 128 + (g & 1) * 32 + (ii & 3) * 8;
    int trow = bid * NWAVES + wave; const int tstride = nblk * NWAVES;
    f32x4 ta[4], tb[4]; int rowA = -1, rowB = -1;
    while (d.valid) {
        asm volatile("" : "+v"(qf[0]), "+v"(qf[1]), "+v"(qf[2]), "+v"(qf[3]));
        if (rowB >= 0) { tbl_finish(p, rowB, tb, lane); rowB = -1; }
        attn_dma(d, VB, false, imgV, wave, lane);
        asm volatile("" ::: "memory");
        if (trow < 32768) { rowA = trow; trow += tstride; tbl_load(p, rowA, ta, lane); }
        asm volatile("" ::: "memory");
        const int c = 8 * d.cb + wave;
        f32x16 S[5];
#pragma unroll
        for (int u = 0; u < 5; ++u) {
            const int kt = c - 2 + u;
#pragma unroll
            for (int r = 0; r < 16; ++r) S[u][r] = -1e30f;
            if (kt >= 0 && kt < d.ntile) {
                const LAS unsigned char* slot = imgK + (wave + u) * 4096;
                f32x16 a = {0.f, 0.f, 0.f, 0.f, 0.f, 0.f, 0.f, 0.f, 0.f, 0.f, 0.f, 0.f, 0.f, 0.f, 0.f, 0.f};
#pragma unroll
                for (int d0 = 0; d0 < 4; ++d0) { const bf16x8_t kf = *(const LAS bf16x8_t*)(slot + r32 * 128 + (((2 * d0 + hi) ^ ((r32 >> 1) & 7)) << 4));
                    a = __builtin_amdgcn_mfma_f32_32x32x16_bf16(kf, qf[d0], a, 0, 0, 0); }
                S[u] = a;
            }
        }
#pragma unroll
        for (int r = 0; r < 16; ++r) { const int kk = crow(r, hi); if (kk < r32) S[0][r] = -1e30f; if (kk > r32) S[4][r] = -1e30f; }
        float m = -1e30f;
#pragma unroll
        for (int u = 0; u < 5; ++u)
#pragma unroll
            for (int r = 0; r < 16; ++r) m = fmaxf(m, S[u][r]);
        m = fmaxf(m, __shfl_xor(m, 32));
        float l = 0.f;
        unsigned Pk[5][8];
#pragma unroll
        for (int u = 0; u < 5; ++u)
#pragma unroll
            for (int r = 0; r < 16; r += 2) { const float e0 = __builtin_amdgcn_exp2f(S[u][r] - m), e1 = __builtin_amdgcn_exp2f(S[u][r + 1] - m); l += e0 + e1; Pk[u][r >> 1] = cvtpk(e0, e1); }
        l += __shfl_xor(l, 32);
        if (rowA >= 0) ATT_SYNC_N(4); else ATT_SYNC();
        const AttnDesc dn = attn_desc(bi + nblk);
        if (rowA >= 0) { tbl_finish(p, rowA, ta, lane); rowA = -1; }
        if (dn.valid) { attn_dma(dn, KB, true, imgK, wave, lane); attn_qload(dn, QB, qf, wave, lane); }
        asm volatile("" ::: "memory");
        if (trow < 32768) { rowB = trow; trow += tstride; tbl_load(p, rowB, tb, lane); }
        asm volatile("" ::: "memory");
        f32x16 o[2];
#pragma unroll
        for (int db = 0; db < 2; ++db)
#pragma unroll
            for (int r = 0; r < 16; ++r) o[db][r] = 0.f;
#pragma unroll
        for (int u = 0; u < 5; ++u) {
            const int kt = c - 2 + u;
            if (kt >= 0 && kt < d.ntile) {
                const LAS unsigned char* slot = imgV + (wave + u) * 4096;
#pragma unroll
                for (int s = 0; s < 2; ++s) {
                    bf16x8_t pa;
                    { v4u w; w.x = Pk[u][4 * s + 0]; w.y = Pk[u][4 * s + 1]; w.z = Pk[u][4 * s + 2]; w.w = Pk[u][4 * s + 3]; pa = __builtin_bit_cast(bf16x8_t, w); }
#pragma unroll
                    for (int db = 0; db < 2; ++db) {
                        const s16x4 lo = vtr(slot + vb0 + s * 2048 + db * 64), hh = vtr(slot + vb0 + s * 2048 + 1024 + db * 64);
                        const bf16x8_t vf = {lo[0], lo[1], lo[2], lo[3], hh[0], hh[1], hh[2], hh[3]};
                        o[db] = __builtin_amdgcn_mfma_f32_32x32x16_bf16(pa, vf, o[db], 0, 0, 0);
                    }
                }
            }
        }
        bf16* OB = d.r == 2 ? (bf16*)(p.ws + WS_O3) : (bf16*)p.out + (size_t)d.r * NT * 768;
        float* LSE = (float*)(p.ws + WS_LSE) + (size_t)d.r * NT * 12;
        const float linv = 1.0f / l;
        LAS unsigned short* stg = (LAS unsigned short*)stgb;
#pragma unroll
        for (int r = 0; r < 16; ++r) { const int q = crow(r, hi); const float li = __shfl(linv, q);
#pragma unroll
            for (int db = 0; db < 2; ++db) stg[q * 64 + db * 32 + r32] = (unsigned short)f2bf(o[db][r] * li); }
        int ln2 = lane; asm volatile("" : "+v"(ln2));
#pragma unroll
        for (int i4 = 0; i4 < 4; ++i4) { const int row = i4 * 8 + (ln2 >> 3), ch = ln2 & 7;
            const v4u val = *(const LAS v4u*)((LAS unsigned char*)stg + row * 128 + ch * 16);
            *(v4u*)(OB + (d.rowb + d.res + d.dil * (32 * c + row)) * 768 + d.h * 64 + 8 * ch) = val; }
        if (ln2 < 32) LSE[(d.rowb + d.res + d.dil * (32 * c + ln2)) * 12 + d.h] = m + __builtin_amdgcn_logf(l);
        if (rowB >= 0) ATT_SYNC_N(9); else ATT_SYNC_N(5);
        d = dn; bi += nblk;
    }
    if (rowA >= 0) tbl_finish(p, rowA, ta, lane);
    if (rowB >= 0) tbl_finish(p, rowB, tb, lane);
    for (; trow < 32768; trow += tstride) { tbl_load(p, trow, ta, lane); tbl_finish(p, trow, ta, lane); }
}
__device__ __forceinline__ void ph_merge(const Params& p, int bid, int nblk) {
    const bf16* O1 = (const bf16*)p.out; const bf16* O2 = O1 + (size_t)NT * 768; const bf16* O3 = (const bf16*)(p.ws + WS_O3);
    const float* L1 = (const float*)(p.ws + WS_LSE); const float* L2 = L1 + (size_t)NT * 12; const float* L3 = L2 + (size_t)NT * 12; bf16* MIX = (bf16*)(p.ws + WS_XN);
    for (int idx = bid * NTHREADS + opaque_tid(); idx < NT * 96; idx += nblk * NTHREADS) {
        const int t = idx / 96, rem = idx - t * 96, h = rem >> 3, ch = rem & 7;
        const float l1 = L1[t * 12 + h], l2 = L2[t * 12 + h], l3 = L3[t * 12 + h]; const float mx = fmaxf(fmaxf(l1, l2), l3);
        float w1 = __builtin_amdgcn_exp2f(l1 - mx), w2 = __builtin_amdgcn_exp2f(l2 - mx), w3 = __builtin_amdgcn_exp2f(l3 - mx); const float inv = 1.0f / (w1 + w2 + w3); w1 *= inv; w2 *= inv; w3 *= inv;
        const size_t off = (size_t)t * 768 + h * 64 + 8 * ch;
        const v4u a = *(const v4u*)(O1 + off), bq = *(const v4u*)(O2 + off), cq = *(const v4u*)(O3 + off);
        v4u o;
        o.x = pk2(w1 * bflo(a.x) + w2 * bflo(bq.x) + w3 * bflo(cq.x), w1 * bfhi(a.x) + w2 * bfhi(bq.x) + w3 * bfhi(cq.x));
        o.y = pk2(w1 * bflo(a.y) + w2 * bflo(bq.y) + w3 * bflo(cq.y), w1 * bfhi(a.y) + w2 * bfhi(bq.y) + w3 * bfhi(cq.y));
        o.z = pk2(w1 * bflo(a.z) + w2 * bflo(bq.z) + w3 * bflo(cq.z), w1 * bfhi(a.z) + w2 * bfhi(bq.z) + w3 * bfhi(cq.z));
        o.w = pk2(w1 * bflo(a.w) + w2 * bflo(bq.w) + w3 * bflo(cq.w), w1 * bfhi(a.w) + w2 * bfhi(bq.w) + w3 * bfhi(cq.w));
        *(v4u*)(MIX + (size_t)t * DM + 256 + h * 64 + 8 * ch) = o;
    }
}


__host__ __device__ constexpr int stair2_slot(int i, int j) { int n = 0; for (int a = 1; a < 16; ++a) for (int b = 1; b < 16; ++b) if ((a + 1) * (b + 1) <= 16) { if (a == i && b == j) return n; ++n; } return n; }
__device__ __forceinline__ float kmax(float a, float b) { float r; asm("v_max_f32_e32 %0, %1, %2" : "=v"(r) : "v"(a), "v"(b)); return r; }
__device__ __forceinline__ float kmin(float a, float b) { float r; asm("v_min_f32_e32 %0, %1, %2" : "=v"(r) : "v"(a), "v"(b)); return r; }
__device__ __forceinline__ float fkeyf(float s, unsigned low, unsigned mask) { return __builtin_bit_cast(float, (__builtin_bit_cast(unsigned, s) & ~mask) | low); }
__device__ __forceinline__ float fvalf(float k, unsigned mask) { return __builtin_bit_cast(float, (__builtin_bit_cast(unsigned, k) & ~mask) | (mask >> 1)); }
#define CE_DESC(a, b) do { const float _mx = kmax((a), (b)), _mn = kmin((a), (b)); (a) = _mx; (b) = _mn; } while (0)
__device__ __forceinline__ void sort16_desc(float (&a)[16]) {
#pragma unroll
    for (int k = 2; k <= 16; k <<= 1)
#pragma unroll
        for (int j = k >> 1; j > 0; j >>= 1)
#pragma unroll
            for (int i = 0; i < 16; ++i) { const int l = i ^ j; if (l > i) { if ((i & k) == 0) CE_DESC(a[i], a[l]); else CE_DESC(a[l], a[i]); } }
}
__device__ __forceinline__ void merge16_desc(float (&c)[16]) {
#pragma unroll
    for (int j = 8; j > 0; j >>= 1)
#pragma unroll
        for (int i = 0; i < 16; ++i) { const int l = i ^ j; if (l > i) CE_DESC(c[i], c[l]); }
}
__device__ __forceinline__ void top16_merge(float (&a)[16], const float (&b)[16]) {
#pragma unroll
    for (int i = 0; i < 16; ++i) a[i] = kmax(a[i], b[15 - i]);
    merge16_desc(a);
}
__device__ __forceinline__ void top16_of_64(float (&g0)[16], float (&g1)[16], float (&g2)[16], float (&g3)[16]) {
    sort16_desc(g0); sort16_desc(g1); sort16_desc(g2); sort16_desc(g3);
    top16_merge(g0, g1); top16_merge(g2, g3); top16_merge(g0, g2);
}
template <int MST>
__device__ __forceinline__ void topk_item(const bf16x8_t (&qf)[2][4], const bf16* SK, int h, int t, LAS unsigned* myl, unsigned short* ids, float* gates, const float* SVt, int lane) {
    const int hi = lane >> 5; const float NEGINF = -INFINITY;
        float K[2][16];
#pragma unroll
    for (int pp = 0; pp < 2; ++pp) {
        float g[4][16];
#pragma unroll
        for (int mt = 0; mt < 4; ++mt) {
            const bf16* kp = SK + ((size_t)((h * 2 + pp) * 4 + mt) * 4 * 64 + lane) * 8;
            f32x16 a = {0.f, 0.f, 0.f, 0.f, 0.f, 0.f, 0.f, 0.f, 0.f, 0.f, 0.f, 0.f, 0.f, 0.f, 0.f, 0.f};
#pragma unroll
            for (int d0 = 0; d0 < 4; ++d0) a = __builtin_amdgcn_mfma_f32_32x32x16_bf16(*(const bf16x8_t*)(kp + d0 * 512), qf[pp][d0], a, 0, 0, 0);
#pragma unroll
            for (int r = 0; r < 16; ++r) g[mt][r] = fkeyf(a[r], 127u - (unsigned)(32 * mt + crow(r, hi)), 127u);
        }
        top16_of_64(g[0], g[1], g[2], g[3]);
        float o[16];
#pragma unroll
        for (int i = 0; i < 16; ++i) o[i] = __shfl_xor(g[0][i], 32);
        top16_merge(g[0], o);
#pragma unroll
        for (int i = 0; i < 16; ++i) K[pp][i] = g[0][i];
    }
#pragma unroll
    for (int i = 0; i < 16; ++i) { myl[i * MST] = __builtin_bit_cast(unsigned, K[0][i]); myl[(16 + i) * MST] = __builtin_bit_cast(unsigned, K[1][i]); }
    float v0[16], v1[16];
#pragma unroll
    for (int i = 0; i < 16; ++i) { v0[i] = fvalf(K[0][i], 127u); v1[i] = fvalf(K[1][i], 127u); }
    float cA[16], cB[16], cC[16], cD[16];
#pragma unroll
    for (int j = 0; j < 16; ++j) cA[j] = fkeyf(v0[0] + v1[j], 255u - (unsigned)j, 255u);
#pragma unroll
    for (int i = 1; i < 16; ++i) cB[i - 1] = fkeyf(v0[i] + v1[0], 255u - (unsigned)(16 * i), 255u);
    cB[15] = NEGINF;
#pragma unroll
    for (int q = 0; q < 16; ++q) { cC[q] = NEGINF; cD[q] = NEGINF; }
    { int n = 0;
#pragma unroll
      for (int i = 1; i < 8; ++i)
#pragma unroll
          for (int j = 1; j < 8; ++j) if ((i + 1) * (j + 1) <= 16) { const int m = stair2_slot(i, j); const float kv = fkeyf(v0[i] + v1[j], 255u - (unsigned)(16 * i + j), 255u); if (m < 16) cC[m] = kv; else cD[m - 16] = kv; }
      (void)n; }
    sort16_desc(cC);
    CE_DESC(cD[0], cD[1]); CE_DESC(cD[1], cD[2]); CE_DESC(cD[0], cD[1]);
    top16_merge(cA, cB); top16_merge(cC, cD); top16_merge(cA, cC);
    float e[16]; float sum = 0.f; const float mx = fvalf(cA[0], 255u);
#pragma unroll
    for (int r = 0; r < 16; ++r) { e[r] = __builtin_amdgcn_exp2f((fvalf(cA[r], 255u) - mx) * 1.4426950408889634f); sum += e[r]; }
    const float inv = __builtin_amdgcn_rcpf(sum);
    int eid[16];
#pragma unroll
    for (int r = 0; r < 16; ++r) { const unsigned id8 = 255u - (__builtin_bit_cast(unsigned, cA[r]) & 255u); const unsigned k0 = myl[(id8 >> 4) * MST], k1 = myl[(16 + (id8 & 15)) * MST];
        eid[r] = (int)((127u - (k0 & 127u)) * 128u + (127u - (k1 & 127u))); }
    int tq = t; asm volatile("" : "+v"(tq));
    if (hi == 0) {
#pragma unroll
        for (int q = 0; q < 2; ++q) *(v4u*)(ids + (size_t)tq * 128 + h * 16 + 8 * q) = (v4u){(unsigned)eid[8 * q] | ((unsigned)eid[8 * q + 1] << 16), (unsigned)eid[8 * q + 2] | ((unsigned)eid[8 * q + 3] << 16),
                                                                                  (unsigned)eid[8 * q + 4] | ((unsigned)eid[8 * q + 5] << 16), (unsigned)eid[8 * q + 6] | ((unsigned)eid[8 * q + 7] << 16)};
    } else {
#pragma unroll
        for (int q = 0; q < 4; ++q) *(f32x4*)(gates + (size_t)tq * 128 + h * 16 + 4 * q) = (f32x4){e[4 * q] * inv * SVt[eid[4 * q]], e[4 * q + 1] * inv * SVt[eid[4 * q + 1]], e[4 * q + 2] * inv * SVt[eid[4 * q + 2]], e[4 * q + 3] * inv * SVt[eid[4 * q + 3]]};
    }
}
struct EpiPeerTopk {
    static constexpr bool PERM = true, AFTER_DRAIN = true;
    const bf16* SK; unsigned short* ids; float* gates; const float* SVt;
    __device__ __forceinline__ void fused(pg8::f32x4 (&acc)[2][2][4][2], const pg8::Unit& u, int wr, int wc, int fr, int fq, PG8_LAS unsigned char* lds, int wid, int lane) const {
#pragma unroll
        for (int bj = 0; bj < 2; ++bj) {
            const int cc = (bj * 128 + wc * 32 + 8 * fq) >> 3;
#pragma unroll
            for (int ai = 0; ai < 2; ++ai)
#pragma unroll
                for (int m = 0; m < 4; ++m) {
                    const int rl = ai * 128 + wr * 64 + m * 16 + fr; const pg8::f32x4 v0 = acc[ai][bj][m][0], v1 = acc[ai][bj][m][1];
                    v4u o; o.x = pk2(v0.x, v0.y); o.y = pk2(v0.z, v0.w); o.z = pk2(v1.x, v1.y); o.w = pk2(v1.z, v1.w);
                    *(PG8_LAS v4u*)(lds + rl * 512 + ((cc ^ (rl & 15)) << 4)) = o;
                }
        }
        asm volatile("s_waitcnt lgkmcnt(0)" ::: "memory"); __builtin_amdgcn_s_barrier(); asm volatile("" ::: "memory");
        const int r32 = lane & 31, hi = lane >> 5;
#pragma unroll 1
        for (int rep = 0; rep < 2; ++rep) {
            const int it2 = wid + 8 * rep, tl = it2 >> 1, hl = it2 & 1, rl = tl * 32 + r32;
            bf16x8_t qf[2][4];
#pragma unroll
            for (int pp = 0; pp < 2; ++pp)
#pragma unroll
                for (int d0 = 0; d0 < 4; ++d0) { const int cc = hl * 16 + pp * 8 + 2 * d0 + hi; qf[pp][d0] = *(const PG8_LAS bf16x8_t*)(lds + rl * 512 + ((cc ^ (rl & 15)) << 4)); }
            asm volatile("s_waitcnt lgkmcnt(0)" ::: "memory");
            LAS unsigned* myl = (LAS unsigned*)(lds + (tl * 32) * 512 + hl * 256) + lane;
            topk_item<128>(qf, SK, 2 * u.pn + hl, u.pm * 256 + rl, myl, ids, gates, SVt, lane);
        }
    }
};

__device__ __forceinline__ void ph_ln1_fast(const Params& p, int bid, int nblk) {
    const bf16* y1 = (const bf16*)(p.ws + WS_Y1); bf16* x1 = (bf16*)(p.ws + WS_X1); bf16* h2b = (bf16*)(p.ws + WS_XN); const float* mod = (const float*)(p.ws + WS_MOD);
    const int lane = opaque_tid() & 63, wave = wave_id();
    for (int row = bid * NWAVES + wave; row < NT; row += nblk * NWAVES) {
        const int b = row / SEQ;
        const v2u* yr = (const v2u*)(y1 + (size_t)row * DM) + lane;
        f32x4 v[4]; float s = 0.f;
#pragma unroll
        for (int j = 0; j < 4; ++j) { const v2u w = yr[64 * j]; v[j] = (f32x4){bflo(w.x), bfhi(w.x), bflo(w.y), bfhi(w.y)}; s += (v[j].x + v[j].y) + (v[j].z + v[j].w); }
        float mean = wave_sum(s) * (1.f / DM); float s2 = 0.f;
#pragma unroll
        for (int j = 0; j < 4; ++j) { v[j] = v[j] - mean; s2 += (v[j].x * v[j].x + v[j].y * v[j].y) + (v[j].z * v[j].z + v[j].w * v[j].w); }
        float rstd = rsqrtf(wave_sum(s2) * (1.f / DM) + LN_EPS);
        s = 0.f;
#pragma unroll
        for (int j = 0; j < 4; ++j) { const f32x4 g = *((const f32x4*)p.g1 + lane + 64 * j), be = *((const f32x4*)p.be1 + lane + 64 * j);
            v[j] = v[j] * rstd * g + be; *((v2u*)(x1 + (size_t)row * DM) + lane + 64 * j) = (v2u){pk2(v[j].x, v[j].y), pk2(v[j].z, v[j].w)}; s += (v[j].x + v[j].y) + (v[j].z + v[j].w); }
        mean = wave_sum(s) * (1.f / DM); s2 = 0.f;
#pragma unroll
        for (int j = 0; j < 4; ++j) { v[j] = v[j] - mean; s2 += (v[j].x * v[j].x + v[j].y * v[j].y) + (v[j].z * v[j].z + v[j].w * v[j].w); }
        rstd = rsqrtf(wave_sum(s2) * (1.f / DM) + LN_EPS);
        float amax = 0.f;
#pragma unroll
        for (int j = 0; j < 4; ++j) {
            const f32x4 sh = *((const f32x4*)(mod + b * 6144 + 3072) + lane + 64 * j), sc = *((const f32x4*)(mod + b * 6144 + 4096) + lane + 64 * j);
            const f32x4 o = v[j] * rstd * (1.0f + sc) + sh; v[j] = o;
            amax = fmaxf(amax, fmaxf(fmaxf(fabsf(o.x), fabsf(o.y)), fmaxf(fabsf(o.z), fabsf(o.w))));
            *((v2u*)(h2b + (size_t)row * DM) + lane + 64 * j) = (v2u){pk2(o.x, o.y), pk2(o.z, o.w)};
        }
        amax = wave_max(amax); const float hinv = amax > 0.f ? 127.0f / amax : 0.f;
        unsigned* q4 = (unsigned*)(p.ws + WS_H2Q + (size_t)row * DM) + lane;
#pragma unroll
        for (int j = 0; j < 4; ++j) { unsigned q = 0u;
            q = __builtin_amdgcn_cvt_pk_u8_f32(v[j].x * hinv + 128.0f, 0, q); q = __builtin_amdgcn_cvt_pk_u8_f32(v[j].y * hinv + 128.0f, 1, q);
            q = __builtin_amdgcn_cvt_pk_u8_f32(v[j].z * hinv + 128.0f, 2, q); q = __builtin_amdgcn_cvt_pk_u8_f32(v[j].w * hinv + 128.0f, 3, q);
            q4[64 * j] = q ^ 0x80808080u; }
        if (lane == 0) ((float*)(p.ws + WS_HS))[row] = amax * (1.0f / 127.0f);
    }
}
__device__ __forceinline__ void ph_tables8(const Params& p, int bid, int nblk) {
    const int lane = opaque_tid() & 63, wave = wave_id();
    for (int r = bid * NWAVES + wave; r < 2 * 16384; r += nblk * NWAVES) {
        const bool isv = r >= 16384; const int row = isv ? r - 16384 : r;
        const f32x4* src = (const f32x4*)((isv ? p.pv : p.pu) + (size_t)row * DM + 16 * lane);
        f32x4 a[4]; float amax = 0.f;
#pragma unroll
        for (int j = 0; j < 4; ++j) { a[j] = src[j]; amax = fmaxf(amax, fmaxf(fmaxf(fabsf(a[j].x), fabsf(a[j].y)), fmaxf(fabsf(a[j].z), fabsf(a[j].w)))); }
        amax = wave_max(amax);
        const float inv = amax > 0.f ? 127.0f / amax : 0.f;
        v4u o;
#pragma unroll
        for (int j = 0; j < 4; ++j) { unsigned q = 0u;
            q = __builtin_amdgcn_cvt_pk_u8_f32(a[j].x * inv + 128.0f, 0, q); q = __builtin_amdgcn_cvt_pk_u8_f32(a[j].y * inv + 128.0f, 1, q);
            q = __builtin_amdgcn_cvt_pk_u8_f32(a[j].z * inv + 128.0f, 2, q); q = __builtin_amdgcn_cvt_pk_u8_f32(a[j].w * inv + 128.0f, 3, q);
            o[j] = q ^ 0x80808080u; }
        *(v4u*)(p.ws + (isv ? WS_TV8 : WS_TU8) + (size_t)(lane >> 3) * (2 * MiB) + (size_t)row * 128 + 16 * (lane & 7)) = o;
        if (lane == 0) ((float*)(p.ws + (isv ? WS_SV : WS_SU)))[row] = amax * (1.0f / 127.0f);
    }
}
__device__ __forceinline__ float readlane_f(float v, int l) { return __builtin_bit_cast(float, __builtin_amdgcn_readlane(__builtin_bit_cast(int, v), l)); }
__device__ __forceinline__ float ub0(unsigned u) { return (float)(u & 255u); }
__device__ __forceinline__ float ub1(unsigned u) { return (float)((u >> 8) & 255u); }
__device__ __forceinline__ float ub2(unsigned u) { return (float)((u >> 16) & 255u); }
__device__ __forceinline__ float ub3(unsigned u) { return (float)(u >> 24); }
__device__ __forceinline__ v4u ust_meta(const Params& p, int step, int t0, int stride8, int lane) {
    const int g = step >> 4, k = step & 15; int t = t0 + g * stride8 + (lane >> 3); t = t < NT ? t : NT - 1;
    return *(const v4u*)(p.ws + WS_IDS + (size_t)t * 256 + 16 * k);
}
__device__ __forceinline__ void ust_issue(v4u (&ub)[8], const v4u& idq, const unsigned char* TUs) {
#pragma unroll
    for (int e = 0; e < 8; ++e) { const unsigned w = idq[e >> 1]; const unsigned id = (e & 1) ? (w >> 16) : (w & 0xffffu); ub[e] = *(const v4u*)(TUs + (size_t)id * 128); }
}
__device__ __forceinline__ unsigned short ust_compute(const v4u (&ub)[8], const v4u& idq, const v4u& h0, const v4u& h1, int off8, const float* SUs, int lane) {
    int a[8];
#pragma unroll
    for (int e = 0; e < 8; ++e) { int v = 0;
#pragma unroll
        for (int j = 0; j < 4; ++j) { const unsigned d = ub[e][j]; const unsigned lo = d & 0x0f0f0f0fu, hi = (d >> 4) & 0x0f0f0f0fu;
            const unsigned hl = j < 2 ? h0[2 * j] : h1[2 * j - 4], hh = j < 2 ? h0[2 * j + 1] : h1[2 * j - 3];
            v = __builtin_amdgcn_sdot4((int)lo, (int)hl, v, false); v = __builtin_amdgcn_sdot4((int)hi, (int)hh, v, false); }
        a[e] = v; }
    int a4[4];
#pragma unroll
    for (int k = 0; k < 4; ++k) { const bool up = (lane & 4) != 0; const int keep = up ? a[k + 4] : a[k], send = up ? a[k] : a[k + 4]; a4[k] = keep + __shfl_xor(send, 4); }
    int a2[2];
#pragma unroll
    for (int k = 0; k < 2; ++k) { const bool up = (lane & 2) != 0; const int keep = up ? a4[k + 2] : a4[k], send = up ? a4[k] : a4[k + 2]; a2[k] = keep + __shfl_xor(send, 2); }
    const bool up = (lane & 1) != 0; const int keep = up ? a2[1] : a2[0], send = up ? a2[0] : a2[1];
    const int tot = keep + __shfl_xor(send, 1);
    const int c = lane & 7; const unsigned w2 = (c >> 1) == 0 ? idq.x : ((c >> 1) == 1 ? idq.y : ((c >> 1) == 2 ? idq.z : idq.w));
    const unsigned id = (c & 1) ? (w2 >> 16) : (w2 & 0xffffu);
    return (unsigned short)f2bf((float)(tot - off8) * SUs[id]);
}
__device__ __forceinline__ void ph_udot(const Params& p, int bid, int nblk) {
    unsigned short* P = (unsigned short*)(p.ws + WS_PART);
    const int lane = opaque_tid() & 63, wave = wave_id(), c = lane & 7;
    const int s8 = bid & 7, s = s8 & 3;
    const int nlo = (nblk - s + 7) >> 3, nhi = (nblk - (s + 4) + 7) >> 3;
    const int widx = ((s8 >> 2) ? nlo : 0) * NWAVES + (bid >> 3) * NWAVES + wave, stride8 = (nlo + nhi) * NWAVES * 8;
    const unsigned char* TUs = p.ws + WS_TU8 + (size_t)s * (2 * MiB) + 16 * c;
    const float* SUs = (const float*)(p.ws + WS_SU) + (size_t)s * 16384;
    const int t0 = widx * 8;
    const int ngroups = t0 < NT ? (NT - t0 + stride8 - 1) / stride8 : 0, nsteps = ngroups * 16;
    if (nsteps == 0) return;
    v4u uA[8], uB[8];
    v4u qa = ust_meta(p, 0, t0, stride8, lane);
    ust_issue(uA, qa, TUs);
    v4u qb = ust_meta(p, 1, t0, stride8, lane);
    v4u h0 = {0u, 0u, 0u, 0u}, h1 = {0u, 0u, 0u, 0u}; int off8 = 0;
    for (int st = 0; st < nsteps; st += 2) {
        const int tg = t0 + (st >> 4) * stride8 + (lane >> 3); const int t = tg < NT ? tg : NT - 1;
        if ((st & 15) == 0) {
            const unsigned char* hp = p.ws + WS_H2Q + (size_t)t * DM + 256 * s + 32 * c; h0 = *(const v4u*)hp; h1 = *(const v4u*)(hp + 16);
            int hs = 0;
#pragma unroll
            for (int j = 0; j < 4; ++j) { hs = __builtin_amdgcn_sdot4((int)h0[j], 0x01010101, hs, false); hs = __builtin_amdgcn_sdot4((int)h1[j], 0x01010101, hs, false); }
            hs += __shfl_xor(hs, 1); hs += __shfl_xor(hs, 2); hs += __shfl_xor(hs, 4); off8 = 8 * hs;
        }
        ust_issue(uB, qb, TUs);
        const v4u ia = qa; qa = ust_meta(p, st + 2 < nsteps ? st + 2 : st, t0, stride8, lane);
        const unsigned short ra = ust_compute(uA, ia, h0, h1, off8, SUs, lane);
        if (st + 2 < nsteps) ust_issue(uA, qa, TUs);
        const v4u ib = qb; qb = ust_meta(p, st + 3 < nsteps ? st + 3 : st + 1, t0, stride8, lane);
        const unsigned short rb = ust_compute(uB, ib, h0, h1, off8, SUs, lane);
        if (tg < NT) { unsigned short* dst = P + ((size_t)t * 4 + s) * 128 + 8 * (st & 15) + c; dst[0] = ra; dst[8] = rb; }
    }
}
__device__ __forceinline__ void ph_act(const Params& p, int bid, int nblk) {
    const bf16* P = (const bf16*)(p.ws + WS_PART); const float* GS = (const float*)(p.ws + WS_GATES); const float* HS = (const float*)(p.ws + WS_HS);
    unsigned char* WQ = p.ws + WS_WQ; float* WSC = (float*)(p.ws + WS_WSC);
    const int lane = opaque_tid() & 63, wave = wave_id();
    for (int t = bid * NWAVES + wave; t < NT; t += nblk * NWAVES) {
        float a0 = 0.f, a1 = 0.f;
#pragma unroll
        for (int s = 0; s < 4; ++s) { a0 += __builtin_bit_cast(float, (unsigned)P[((size_t)t * 4 + s) * 128 + lane] << 16); a1 += __builtin_bit_cast(float, (unsigned)P[((size_t)t * 4 + s) * 128 + 64 + lane] << 16); }
        const float hs = HS[t];
        const float d0 = a0 * hs, d1 = a1 * hs;
        const float w0 = GS[(size_t)t * 128 + lane] * 0.5f * d0 * (1.0f + erff(d0 * 0.70710678118654752f));
        const float w1 = GS[(size_t)t * 128 + 64 + lane] * 0.5f * d1 * (1.0f + erff(d1 * 0.70710678118654752f));
        const float wmax = wave_max(fmaxf(fabsf(w0), fabsf(w1))); const float winv = wmax > 0.f ? 127.0f / wmax : 0.f;
        unsigned b2 = __builtin_amdgcn_cvt_pk_u8_f32(w0 * winv + 128.0f, 0, 0u); b2 = __builtin_amdgcn_cvt_pk_u8_f32(w1 * winv + 128.0f, 1, b2); b2 ^= 0x8080u;
        WQ[(size_t)t * 128 + lane] = (unsigned char)(b2 & 255u); WQ[(size_t)t * 128 + 64 + lane] = (unsigned char)((b2 >> 8) & 255u);
        if (lane == 0) WSC[t] = wmax * (1.0f / 127.0f);
    }
}
struct VstepMeta { v4u idq; v2u wq; };
__device__ __forceinline__ VstepMeta vst_meta(const Params& p, int step, int t0, int stride8, int lane) {
    const int g = step >> 4, k = step & 15; int t = t0 + g * stride8 + (lane >> 3); t = t < NT ? t : NT - 1;
    VstepMeta r; r.idq = *(const v4u*)(p.ws + WS_IDS + (size_t)t * 256 + 16 * k); r.wq = *(const v2u*)(p.ws + WS_WQ + (size_t)t * 128 + 8 * k); return r;
}
__device__ __forceinline__ void vst_issue(v4u (&vb)[8], const VstepMeta& q, const unsigned char* TVs) {
#pragma unroll
    for (int e = 0; e < 8; ++e) { const unsigned w = q.idq[e >> 1]; const unsigned id = (e & 1) ? (w >> 16) : (w & 0xffffu); vb[e] = *(const v4u*)(TVs + (size_t)id * 128); }
}
__device__ __forceinline__ void vst_compute(int (&y)[16], const v4u (&vb)[8], const v2u& wq) {
#pragma unroll
    for (int qd = 0; qd < 2; ++qd)
#pragma unroll
        for (int cm = 0; cm < 4; ++cm) {
            const unsigned A = vb[4 * qd][cm], B = vb[4 * qd + 1][cm], C = vb[4 * qd + 2][cm], D = vb[4 * qd + 3][cm];
            const unsigned ab01 = __builtin_amdgcn_perm(B, A, 0x05010400u), ab23 = __builtin_amdgcn_perm(B, A, 0x07030602u);
            const unsigned cd01 = __builtin_amdgcn_perm(D, C, 0x05010400u), cd23 = __builtin_amdgcn_perm(D, C, 0x07030602u);
            const unsigned t0 = __builtin_amdgcn_perm(cd01, ab01, 0x05040100u), t1 = __builtin_amdgcn_perm(cd01, ab01, 0x07060302u);
            const unsigned t2 = __builtin_amdgcn_perm(cd23, ab23, 0x05040100u), t3 = __builtin_amdgcn_perm(cd23, ab23, 0x07060302u);
            y[4 * cm + 0] = __builtin_amdgcn_sdot4((int)t0, (int)wq[qd], y[4 * cm + 0], false); y[4 * cm + 1] = __builtin_amdgcn_sdot4((int)t1, (int)wq[qd], y[4 * cm + 1], false);
            y[4 * cm + 2] = __builtin_amdgcn_sdot4((int)t2, (int)wq[qd], y[4 * cm + 2], false); y[4 * cm + 3] = __builtin_amdgcn_sdot4((int)t3, (int)wq[qd], y[4 * cm + 3], false);
        }
}
__device__ __forceinline__ void ph_vacc(const Params& p, int bid, int nblk) {
    bf16* Y = (bf16*)(p.ws + WS_Y); const float* WSC = (const float*)(p.ws + WS_WSC);
    const int lane = opaque_tid() & 63, wave = wave_id(), c = lane & 7;
    const int s = bid & 7, nper = (nblk - s + 7) >> 3,     stride8 = nper * NWAVES * 8;
    const unsigned char* TVs = p.ws + WS_TV8 + (size_t)s * (2 * MiB) + 16 * c;
    const int t0 = ((bid >> 3) * NWAVES + wave) * 8;
    const int ngroups = t0 < NT ? (NT - t0 + stride8 - 1) / stride8 : 0, nsteps = ngroups * 16;
    if (nsteps == 0) return;
    int y[16];
#pragma unroll
    for (int k = 0; k < 16; ++k) y[k] = 0;
    v4u vA[8], vB[8];
    VstepMeta qa = vst_meta(p, 0, t0, stride8, lane);
    vst_issue(vA, qa, TVs);
    VstepMeta qb = vst_meta(p, 1, t0, stride8, lane);
    for (int st = 0; st < nsteps; st += 2) {
        vst_issue(vB, qb, TVs);
        const v2u wa = qa.wq; qa = vst_meta(p, st + 2 < nsteps ? st + 2 : st, t0, stride8, lane);
        vst_compute(y, vA, wa);
        if (st + 2 < nsteps) vst_issue(vA, qa, TVs);
        const v2u wb = qb.wq; qb = vst_meta(p, st + 3 < nsteps ? st + 3 : st + 1, t0, stride8, lane);
        vst_compute(y, vB, wb);
        if (((st + 1) & 15) == 15) {
            const int t = t0 + (st >> 4) * stride8 + (lane >> 3);
            if (t < NT) { const float sc = WSC[t];
                v4u o0, o1; o0.x = pk2((float)y[0] * sc, (float)y[1] * sc); o0.y = pk2((float)y[2] * sc, (float)y[3] * sc); o0.z = pk2((float)y[4] * sc, (float)y[5] * sc); o0.w = pk2((float)y[6] * sc, (float)y[7] * sc);
                o1.x = pk2((float)y[8] * sc, (float)y[9] * sc); o1.y = pk2((float)y[10] * sc, (float)y[11] * sc); o1.z = pk2((float)y[12] * sc, (float)y[13] * sc); o1.w = pk2((float)y[14] * sc, (float)y[15] * sc);
                v4u* dst = (v4u*)(Y + (size_t)t * DM + 128 * s + 16 * c); dst[0] = o0; dst[1] = o1; }
#pragma unroll
            for (int k = 0; k < 16; ++k) y[k] = 0;
        }
    }
}
__device__ __forceinline__ void ph_final(const Params& p, int bid, int nblk) {
    const bf16* x1 = (const bf16*)(p.ws + WS_X1); const bf16* Y = (const bf16*)(p.ws + WS_Y); const float* mod = (const float*)(p.ws + WS_MOD);
    const int lane = opaque_tid() & 63, wave = wave_id();
    for (int t = bid * NWAVES + wave; t < NT; t += nblk * NWAVES) {
        const int b = t / SEQ;
        f32x4 v[4]; float s = 0.f;
#pragma unroll
        for (int j = 0; j < 4; ++j) { const v2u xw = *((const v2u*)(x1 + (size_t)t * DM) + lane + 64 * j), yw = *((const v2u*)(Y + (size_t)t * DM) + lane + 64 * j);
            const f32x4 g2 = *((const f32x4*)(mod + b * 6144 + 5120) + lane + 64 * j);
            const f32x4 xv = {bflo(xw.x), bfhi(xw.x), bflo(xw.y), bfhi(xw.y)}, yv = {bflo(yw.x), bfhi(yw.x), bflo(yw.y), bfhi(yw.y)};
            v[j] = xv * ALPHA + (g2 + 1.0f) * yv; s += (v[j].x + v[j].y) + (v[j].z + v[j].w); }
        const float mean = wave_sum(s) * (1.f / DM); float s2 = 0.f;
#pragma unroll
        for (int j = 0; j < 4; ++j) { v[j] = v[j] - mean; s2 += (v[j].x * v[j].x + v[j].y * v[j].y) + (v[j].z * v[j].z + v[j].w * v[j].w); }
        const float rstd = rsqrtf(wave_sum(s2) * (1.f / DM) + LN_EPS);
#pragma unroll
        for (int j = 0; j < 4; ++j) { const f32x4 g = *((const f32x4*)p.g2 + lane + 64 * j), be = *((const f32x4*)p.be2 + lane + 64 * j);
            *((f32x4*)(p.out + (size_t)t * DM) + lane + 64 * j) = v[j] * rstd * g + be; }
    }
}

#ifndef PROBE_ID
#define PROBE_ID 0
#endif
#define RUN2(id, ...) do { __VA_ARGS__; if (PROBE_ID == (id)) { xcd_barrier(bar); __VA_ARGS__; } } while (0)
__global__ void __launch_bounds__(NTHREADS, 2) mega(Params p) {
    extern __shared__ __attribute__((aligned(16))) unsigned char lds_raw[];

    LAS unsigned char* lds = (LAS unsigned char*)lds_raw;
    const int bid = blockIdx.x, nblk = gridDim.x, tid = opaque_tid();
    for (int u = tid; u < (LDS_BYTES - LDSCTL_OFF) / 4; u += NTHREADS) ((LAS unsigned*)(lds + LDSCTL_OFF))[u] = 0u;
    __syncthreads();
    unsigned* ctl = (unsigned*)(p.ws + WS_CTL);
    XcdBarrier bar = xcd_barrier_post(ctl + CW_BAR, (volatile LAS unsigned*)(lds + MISC_OFF) + 8);
    const float* mod = (const float*)(p.ws + WS_MOD);

    ph_mod(p, lds, bid, nblk);
    xcd_barrier(bar);
    RUN2(1, ph_prologue(p, lds, bid, nblk));
    RUN2(7, ph_xn(p, bid, nblk));
    xcd_barrier(bar);
    {
        pg8::Gemm g{(const pg8::bf16_t*)(p.ws + WS_XN), (const pg8::bf16_t*)(p.ws + WS_WIN), NT, NIN, DM}; pg8::StaticOrder S; S.init(NT, NIN, nblk, bid);
        EpiIn E{(bf16*)(p.ws + WS_FZ), (bf16*)(p.ws + WS_QB), (const float*)(p.ws + WS_MISC), p.pos};
        pg8::gemm_phase<EpiIn, pg8::StaticOrder, true, true>(lds, g, S, E);
    }
    xcd_barrier(bar);
    RUN2(8, ph_fft(p, lds, bid, nblk));
    RUN2(2, ph_attn_fast(p, lds, bid, nblk));
    xcd_barrier(bar);
    RUN2(3, ph_merge(p, bid, nblk));
    xcd_barrier(bar);
    {
        pg8::Gemm g{(const pg8::bf16_t*)(p.ws + WS_XN), (const pg8::bf16_t*)(p.ws + WS_WOUT), NT, DM, DM}; pg8::StaticOrder S; S.init(NT, DM, nblk, bid);
        EpiOut E{(bf16*)(p.ws + WS_Y1), p.x, mod, p.b_out};
        pg8::gemm_phase<EpiOut, pg8::StaticOrder, true, true>(lds, g, S, E);
    }
    xcd_barrier(bar);
    RUN2(4, ph_ln1_fast(p, bid, nblk));
    xcd_barrier(bar);
    {
        pg8::Gemm g{(const pg8::bf16_t*)(p.ws + WS_XN), (const pg8::bf16_t*)(p.ws + WS_WPQ), NT, DM, DM}; pg8::StaticOrder S; S.init(NT, DM, nblk, bid);
        EpiPeerTopk E{(const bf16*)(p.ws + WS_SUBK), (unsigned short*)(p.ws + WS_IDS), (float*)(p.ws + WS_GATES), (const float*)(p.ws + WS_SV)};
        pg8::gemm_phase<EpiPeerTopk, pg8::StaticOrder, false, true>(lds, g, S, E);
    }
    xcd_barrier(bar);
    RUN2(6, ph_udot(p, bid, nblk));
    xcd_barrier(bar);
    RUN2(11, ph_act(p, bid, nblk));
    xcd_barrier(bar);
    RUN2(10, ph_vacc(p, bid, nblk));
    xcd_barrier(bar);
    ph_final(p, bid, nblk);
}

extern "C" void kernel_launch(void* const* d_in, const int* in_sizes, int n_in, void* d_out, int out_size, void* d_ws, size_t ws_size, hipStream_t stream) {
    Params p{};
    p.x = (const float*)d_in[0]; p.c = (const float*)d_in[1]; p.pos = (const int*)d_in[2]; p.w_ada = (const float*)d_in[3]; p.b_ada = (const float*)d_in[4];
    p.w_in = (const float*)d_in[5]; p.b_in = (const float*)d_in[6]; p.w_four = (const float*)d_in[7]; p.w_out = (const float*)d_in[8]; p.b_out = (const float*)d_in[9];
    p.g1 = (const float*)d_in[10]; p.be1 = (const float*)d_in[11]; p.w_pq = (const float*)d_in[12]; p.subk = (const float*)d_in[13]; p.pu = (const float*)d_in[14]; p.pv = (const float*)d_in[15];
    p.g2 = (const float*)d_in[16]; p.be2 = (const float*)d_in[17]; p.out = (float*)d_out; p.ws = (unsigned char*)d_ws;
    static int grid_blocks = 0;
    if (grid_blocks == 0) {
        if (ws_size < WS_END) { fprintf(stderr, "workspace too small: %zu < %zu\n", ws_size, (size_t)WS_END); grid_blocks = -1; return; }
        int dev = 0, cus = 0, per_cu = 0;
        if (hipGetDevice(&dev) != hipSuccess || hipDeviceGetAttribute(&cus, hipDeviceAttributeMultiprocessorCount, dev) != hipSuccess) { grid_blocks = -1; return; }
        if (hipFuncSetAttribute((const void*)mega, hipFuncAttributeMaxDynamicSharedMemorySize, LDS_BYTES) != hipSuccess) { fprintf(stderr, "hipFuncSetAttribute failed\n"); grid_blocks = -1; return; }
        if (hipOccupancyMaxActiveBlocksPerMultiprocessor(&per_cu, (const void*)mega, NTHREADS, LDS_BYTES) != hipSuccess || per_cu < 1) { fprintf(stderr, "occupancy query: %d\n", per_cu); grid_blocks = -1; return; }
        if (cus < 256) { fprintf(stderr, "this kernel needs 256 CUs (one workgroup per CU, 256 workgroups); device has %d\n", cus); grid_blocks = -1; return; }
        grid_blocks = 256;
    }
    if (grid_blocks < 0) return;
    if (hipMemsetAsync((char*)d_ws + WS_CTL, 0, CTL_ZERO_BYTES, stream) != hipSuccess) { fprintf(stderr, "memset failed\n"); return; }
    void* args[] = {&p};
    hipError_t e = hipLaunchCooperativeKernel((void*)mega, dim3(grid_blocks), dim3(NTHREADS), args, LDS_BYTES, stream);
    if (e != hipSuccess) fprintf(stderr, "cooperative launch failed: %s (grid %d)\n", hipGetErrorString(e), grid_blocks);
}
```

```cpp
#include <hip/hip_runtime.h>
#include <hip/hip_cooperative_groups.h>
#include <cstdio>
#include <cstdint>
#include <cmath>
namespace cg = cooperative_groups;

namespace pg8 {
#define PG8_LAS __attribute__((address_space(3)))
typedef unsigned short bf16_t;
typedef short bf16x8 __attribute__((ext_vector_type(8)));
typedef float f32x4 __attribute__((ext_vector_type(4)));
typedef unsigned u32x4 __attribute__((ext_vector_type(4)));
constexpr int BM = 256, BK = 64, HALF = 128, HTB = HALF * BK * 2  , STAGE_BYTES = 8 * HTB, NXCD = 8, WGM = 8;

__host__ __device__ __forceinline__ int lds_byte(int r, int c) { const int st = (r >> 4) * 2 + (c >> 5), rr = r & 15, cc = c & 31, ob = rr * 64 + cc * 2; return st * 1024 + (ob ^ (((ob >> 9) & 1) << 5)); }
__host__ __device__ __forceinline__ void stage_rc(int b, int& R, int& C) { const int st = b / 1024, sb = b % 1024, swz = sb ^ (((sb >> 9) & 1) << 5); R = (st >> 1) * 16 + swz / 64; C = (st & 1) * 32 + (swz % 64) / 2; }
__host__ __device__ __forceinline__ int perm32(int rho) { const int n = rho >> 4, i = rho & 15; return 8 * (i >> 2) + 4 * n + (i & 3); }

struct Unit { int pm, pn; };
struct Gemm { const bf16_t* A; const bf16_t* Bt; int M, N, K; };

struct StaticOrder {
    int nM, nN, nwg, G, c;
    __host__ __device__ void init(int M, int N, int G_, int c_) { nM = M / BM; nN = N / BM; nwg = nM * nN; G = G_; c = c_; }
    __host__ __device__ bool next(int i, Unit& u) const {
        const long L = (long)i * G + c; if (L >= nwg) return false;
        int wgid = (int)L; { const int q = nwg / NXCD, r = nwg % NXCD, xcd = wgid % NXCD, off = wgid / NXCD; wgid = (xcd < r ? xcd * (q + 1) : r * (q + 1) + (xcd - r) * q) + off; }
        const int nig = WGM * nN, gid = wgid / nig, fm = gid * WGM, gsz = (nM - fm) < WGM ? (nM - fm) : WGM;
        u.pm = fm + ((wgid % nig) % gsz); u.pn = (wgid % nig) / gsz; return true;
    }
    __device__ __forceinline__ void a_ready(const Unit&) const {}
    __device__ __forceinline__ void done(const Unit&) const {}
};

__device__ __forceinline__ unsigned cvt_pk_bf16(float lo, float hi) { unsigned r; asm volatile("v_cvt_pk_bf16_f32 %0, %1, %2" : "=v"(r) : "v"(lo), "v"(hi)); return r; }
typedef float f32x2 __attribute__((ext_vector_type(2)));
__device__ __forceinline__ f32x2 gelu_pk(f32x2 v) {
    const f32x2 av = __builtin_elementwise_abs(v), d = av * 0.2316418882f + 1.0f;
    f32x2 t; t.x = __builtin_amdgcn_rcpf(d.x); t.y = __builtin_amdgcn_rcpf(d.y);
    f32x2 q = t * 0.5307027145f + (-0.7265760135f); q = q * t + 0.7107068705f; q = q * t + (-0.142248368f); q = q * t + 0.127414796f; q = q * t;
    const f32x2 s = (v * v) * (-0.72134752044f);
    f32x2 e; e.x = __builtin_amdgcn_exp2f(s.x); e.y = __builtin_amdgcn_exp2f(s.y);
    const f32x2 m = v * (q * e), r = v - m;
    f32x2 o; o.x = v.x < 0.f ? m.x : r.x; o.y = v.y < 0.f ? m.y : r.y; return o;
}

template <int ACT  > struct EpiBf16 {
    static constexpr bool PERM = true, AFTER_DRAIN = false; static_assert(ACT == 0 || ACT == 1, "EpiBf16: ACT is 0 (none) or 1 (gelu_pk)");
    bf16_t* O; int ldc; const float* bias; int split_cols; size_t split_stride; float scale0;
    __device__ __forceinline__ void operator()(const f32x4 (&acc)[2][2][4][2], const Unit& u, int wr, int wc, int fr, int fq) const {
        const int row0 = u.pm * BM + wr * 64 + fr; int colt = u.pn * BM; bf16_t* base = O;
        float sc = 1.f; if (split_cols) { const int t = colt / split_cols; base += (size_t)t * split_stride; colt -= t * split_cols; if (t == 0) sc = scale0; }
        const int col0 = colt + wc * 32 + 8 * fq, bcol0 = u.pn * BM + wc * 32 + 8 * fq;
        f32x4 bv[2][2];
#pragma unroll
        for (int bj = 0; bj < 2; ++bj)
#pragma unroll
            for (int n = 0; n < 2; ++n) bv[bj][n] = bias ? *(const f32x4*)(bias + bcol0 + bj * HALF + 4 * n) : (f32x4){0.f, 0.f, 0.f, 0.f};
#pragma unroll
        for (int ai = 0; ai < 2; ++ai)
#pragma unroll
            for (int m = 0; m < 4; ++m) { bf16_t* rowp = base + (size_t)(row0 + ai * HALF + m * 16) * ldc + col0;
#pragma unroll
                for (int bj = 0; bj < 2; ++bj) { f32x4 v0 = acc[ai][bj][m][0] + bv[bj][0], v1 = acc[ai][bj][m][1] + bv[bj][1];
                    if (ACT == 1) { f32x2 a = gelu_pk((f32x2){v0[0], v0[1]}), b = gelu_pk((f32x2){v0[2], v0[3]}), c = gelu_pk((f32x2){v1[0], v1[1]}), d = gelu_pk((f32x2){v1[2], v1[3]});
                        v0 = (f32x4){a.x, a.y, b.x, b.y}; v1 = (f32x4){c.x, c.y, d.x, d.y}; }
                    v0 = v0 * sc; v1 = v1 * sc; u32x4 w; w.x = cvt_pk_bf16(v0[0], v0[1]); w.y = cvt_pk_bf16(v0[2], v0[3]); w.z = cvt_pk_bf16(v1[0], v1[1]); w.w = cvt_pk_bf16(v1[2], v1[3]);
                    *(u32x4*)(rowp + bj * HALF) = w; } }
    }
};
template <class Epi, class Sched, bool ALIGN_EPI = false, bool SP2 = false>
__device__ __forceinline__ void gemm_phase(PG8_LAS unsigned char* lds, const Gemm g, const Sched& S, const Epi& E) {
    int tid_ = threadIdx.x; asm volatile("" : "+v"(tid_)); const int tid = tid_, wid = __builtin_amdgcn_readfirstlane(tid >> 6), lane = tid & 63, wr = wid >> 2, wc = wid & 3, fr = lane & 15, fq = lane >> 4;
    const int K = g.K, nt = K / BK;
    unsigned voffA[2], voffB[2];
#pragma unroll
    for (int i = 0; i < 2; ++i) { int R, C; stage_rc(tid * 16 + i * 8192, R, C); const int Rb = Epi::PERM ? ((R & ~31) + perm32(R & 31)) : R;
        voffA[i] = (unsigned)(R * K + C) * 2u; voffB[i] = (unsigned)(Rb * K + C) * 2u; }
    const size_t kstep = (size_t)(BK * 2);
    const size_t hstep = (size_t)HALF * K * 2;
    const size_t tstep = 2 * hstep;
    const unsigned ldsw = (unsigned)wid * 1024u;
    const int aoff = lds_byte(wr * 64 + fr, fq * 8), boff = lds_byte(wc * 32 + fr, fq * 8);
#define PG8_SA(b, h) (((b) * 2 + (h)) * HTB)
#define PG8_SB(b, h) ((4 + (b) * 2 + (h)) * HTB)
#define PG8_STAGE(bufoff, gbase, voff) do { _Pragma("unroll") for (int _i = 0; _i < 2; ++_i) \
        __builtin_amdgcn_global_load_lds((const unsigned*)((const char*)(gbase) + (voff)[_i]), (PG8_LAS unsigned*)(lds + (bufoff) + ldsw + _i * 8192), 16, 0, 0); } while (0)
#define PG8_LDA(dst, b, h) do { _Pragma("unroll") for (int m = 0; m < 4; ++m) _Pragma("unroll") for (int k = 0; k < 2; ++k) dst[m][k] = *(const PG8_LAS bf16x8*)(lds + PG8_SA(b, h) + aoff + m * 2048 + k * 1024); } while (0)
#define PG8_LDB(dst, b, h) do { _Pragma("unroll") for (int n = 0; n < 2; ++n) _Pragma("unroll") for (int k = 0; k < 2; ++k) dst[n][k] = *(const PG8_LAS bf16x8*)(lds + PG8_SB(b, h) + boff + n * 2048 + k * 1024); } while (0)
#define PG8_MMA(ai, bj, At, Bt) do { __builtin_amdgcn_s_setprio(1); _Pragma("unroll") for (int m = 0; m < 4; ++m) _Pragma("unroll") for (int n = 0; n < 2; ++n) _Pragma("unroll") for (int k = 0; k < 2; ++k) \
        acc[ai][bj][m][n] = __builtin_amdgcn_mfma_f32_16x16x32_bf16(Bt[n][k], At[m][k], acc[ai][bj][m][n], 0, 0, 0); __builtin_amdgcn_s_setprio(0); } while (0)
#define PG8_WAIT_V(n) asm volatile("s_waitcnt vmcnt(" #n ")" ::: "memory")
#define PG8_WAIT_L(n) asm volatile("s_waitcnt lgkmcnt(" #n ")" ::: "memory")
#define PG8_BAR __builtin_amdgcn_s_barrier()
#define PG8_SCHED __builtin_amdgcn_sched_barrier(0)
    Unit cur, nxt; int ui = 0;
    if (!S.next(0, cur)) return;
    f32x4 acc[2][2][4][2];
#pragma unroll
    for (int a = 0; a < 2; ++a)
#pragma unroll
        for (int b = 0; b < 2; ++b)
#pragma unroll
            for (int m = 0; m < 4; ++m)
#pragma unroll
                for (int n = 0; n < 2; ++n) acc[a][b][m][n] = (f32x4){0.f, 0.f, 0.f, 0.f};
    bf16x8 At[4][2], B0[2][2], B1[2][2];
    const char* cA = (const char*)g.A + (size_t)cur.pm * tstep; const char* cB = (const char*)g.Bt + (size_t)cur.pn * tstep;
    S.a_ready(cur);
    if constexpr (SP2) {
        PG8_STAGE(PG8_SB(0, 0), cB, voffB); PG8_STAGE(PG8_SB(0, 1), cB + hstep, voffB); PG8_STAGE(PG8_SA(0, 0), cA, voffA); PG8_STAGE(PG8_SA(0, 1), cA + hstep, voffA);
        if (wr == 1) PG8_BAR;
        PG8_WAIT_V(2); PG8_BAR;
        PG8_STAGE(PG8_SB(1, 0), cB + kstep, voffB); PG8_STAGE(PG8_SA(1, 0), cA + kstep, voffA); PG8_STAGE(PG8_SB(1, 1), cB + hstep + kstep, voffB);
        PG8_WAIT_V(6); PG8_BAR;
    } else {
        PG8_STAGE(PG8_SB(0, 0), cB, voffB); PG8_STAGE(PG8_SA(0, 0), cA, voffA); PG8_STAGE(PG8_SB(0, 1), cB + hstep, voffB); PG8_STAGE(PG8_SA(0, 1), cA + hstep, voffA);
        if (wr == 1) PG8_BAR;
        PG8_WAIT_V(4); PG8_BAR;
        PG8_STAGE(PG8_SB(1, 0), cB + kstep, voffB); PG8_STAGE(PG8_SA(1, 0), cA + kstep, voffA); PG8_STAGE(PG8_SB(1, 1), cB + hstep + kstep, voffB);
        PG8_WAIT_V(6); PG8_BAR;
    }
    for (;;) {
        const bool has_next = S.next(ui + 1, nxt);
        const char* nA = has_next ? (const char*)g.A + (size_t)nxt.pm * tstep : cA; const char* nB = has_next ? (const char*)g.Bt + (size_t)nxt.pn * tstep : cB;
        for (int t = 0; t < nt; t += 2) {
            const bool last = (t == nt - 2);
            const char* a1 = cA + (size_t)(t + 1) * kstep;
            const char* a2 = last ? nA : cA + (size_t)(t + 2) * kstep; const char* b2 = last ? nB : cB + (size_t)(t + 2) * kstep;
            const char* a3 = a2 + kstep; const char* b3 = b2 + kstep;
            if (last && has_next) S.a_ready(nxt);
            if constexpr (SP2) {
            PG8_LDB(B0, 0, 0); PG8_LDB(B1, 0, 1); PG8_SCHED; PG8_LDA(At, 0, 0); PG8_STAGE(PG8_SA(1, 1), a1 + hstep, voffA);
            PG8_WAIT_V(8); PG8_WAIT_L(0); PG8_BAR; PG8_MMA(0, 0, At, B0); PG8_MMA(0, 1, At, B1); PG8_BAR; PG8_SCHED;
            PG8_LDA(At, 0, 1); PG8_STAGE(PG8_SB(0, 0), b2, voffB); PG8_STAGE(PG8_SB(0, 1), b2 + hstep, voffB); PG8_STAGE(PG8_SA(0, 0), a2, voffA);
            PG8_WAIT_V(8); PG8_WAIT_L(0); PG8_BAR; PG8_MMA(1, 0, At, B0); PG8_MMA(1, 1, At, B1); PG8_BAR; PG8_SCHED;
            PG8_LDB(B0, 1, 0); PG8_LDB(B1, 1, 1); PG8_SCHED; PG8_LDA(At, 1, 0); PG8_STAGE(PG8_SA(0, 1), a2 + hstep, voffA);
            PG8_WAIT_V(8); PG8_WAIT_L(0); PG8_BAR; PG8_MMA(0, 0, At, B0); PG8_MMA(0, 1, At, B1); PG8_BAR; PG8_SCHED;
            PG8_LDA(At, 1, 1); PG8_STAGE(PG8_SB(1, 0), b3, voffB); PG8_STAGE(PG8_SB(1, 1), b3 + hstep, voffB); PG8_STAGE(PG8_SA(1, 0), a3, voffA);
            PG8_WAIT_V(8); PG8_WAIT_L(0); PG8_BAR; PG8_MMA(1, 0, At, B0); PG8_MMA(1, 1, At, B1); PG8_BAR; PG8_SCHED;
            } else {
            PG8_LDB(B0, 0, 0); PG8_SCHED; PG8_LDA(At, 0, 0); PG8_STAGE(PG8_SA(1, 1), a1 + hstep, voffA);
            PG8_WAIT_L(8); PG8_BAR; PG8_WAIT_L(0); PG8_MMA(0, 0, At, B0); PG8_BAR; PG8_SCHED;
            PG8_LDB(B1, 0, 1); PG8_STAGE(PG8_SB(0, 0), b2, voffB);
            PG8_BAR; PG8_WAIT_L(0); PG8_MMA(0, 1, At, B1); PG8_BAR;
            PG8_LDA(At, 0, 1); PG8_STAGE(PG8_SA(0, 0), a2, voffA);
            PG8_BAR; PG8_WAIT_L(0); PG8_MMA(1, 0, At, B0); PG8_BAR; PG8_SCHED;
            PG8_STAGE(PG8_SB(0, 1), b2 + hstep, voffB);
            PG8_WAIT_V(6); PG8_BAR; PG8_MMA(1, 1, At, B1); PG8_BAR;
            PG8_LDB(B0, 1, 0); PG8_SCHED; PG8_LDA(At, 1, 0); PG8_STAGE(PG8_SA(0, 1), a2 + hstep, voffA);
            PG8_WAIT_L(8); PG8_BAR; PG8_WAIT_L(0); PG8_MMA(0, 0, At, B0); PG8_BAR; PG8_SCHED;
            PG8_LDB(B1, 1, 1); PG8_STAGE(PG8_SB(1, 0), b3, voffB);
            PG8_BAR; PG8_WAIT_L(0); PG8_MMA(0, 1, At, B1); PG8_BAR;
            PG8_LDA(At, 1, 1); PG8_STAGE(PG8_SA(1, 0), a3, voffA);
            PG8_BAR; PG8_WAIT_L(0); PG8_MMA(1, 0, At, B0); PG8_BAR; PG8_SCHED;
            PG8_STAGE(PG8_SB(1, 1), b3 + hstep, voffB);
            PG8_WAIT_V(6); PG8_BAR; PG8_MMA(1, 1, At, B1); PG8_BAR;
            }
        }
        if constexpr (ALIGN_EPI) { if (wr == 0) PG8_BAR; }
        if constexpr (!Epi::AFTER_DRAIN) { E(acc, cur, wr, wc, fr, fq); S.done(cur); }
        if (!has_next) break;
#pragma unroll
        for (int a = 0; a < 2; ++a)
#pragma unroll
            for (int b = 0; b < 2; ++b)
#pragma unroll
                for (int m = 0; m < 4; ++m)
#pragma unroll
                    for (int n = 0; n < 2; ++n) acc[a][b][m][n] = (f32x4){0.f, 0.f, 0.f, 0.f};
        cur = nxt; cA = nA; cB = nB; ++ui;
        if constexpr (ALIGN_EPI) { if (wr == 1) PG8_BAR; }
    }
    PG8_WAIT_V(0);
    if constexpr (!ALIGN_EPI) { if (wr == 0) PG8_BAR; }
    PG8_BAR;
    if constexpr (Epi::AFTER_DRAIN) { E.fused(acc, cur, wr, wc, fr, fq, lds, wid, lane); S.done(cur); }
#undef PG8_SA
#undef PG8_SB
#undef PG8_STAGE
#undef PG8_LDA
#undef PG8_LDB
#undef PG8_MMA
#undef PG8_WAIT_V
#undef PG8_WAIT_L
#undef PG8_BAR
#undef PG8_SCHED
}
}

#define LAS __attribute__((address_space(3)))
#define GAS __attribute__((address_space(1)))
#define XB_TMO      128
#define XB_XCNT(j)  (256  + 64 * (j))
#define XB_XSUB(j)  (1280 + 64 * (j))
#define XB_XGEN(j)  (2304 + 64 * (j))
#define XB_TOP      3328
#define XB_TOPGEN   3392
#define XCD_BAR_WORDS 3456
#define XB_SPIN_CAP (1u << 18)

__device__ __forceinline__ unsigned xb_ld(unsigned* p)              { return __hip_atomic_load(p, __ATOMIC_RELAXED, __HIP_MEMORY_SCOPE_AGENT); }
__device__ __forceinline__ unsigned xb_add(unsigned* p, unsigned v) { return __hip_atomic_fetch_add(p, v, __ATOMIC_RELAXED, __HIP_MEMORY_SCOPE_AGENT); }
__device__ __forceinline__ unsigned xb_xcc_id() { return (unsigned)__builtin_amdgcn_s_getreg((3 << 11) | 20) & 0xFu; }
#define XB_SPIN(cond, bar) do { unsigned _sp = 0; while (cond) { __builtin_amdgcn_s_sleep(1); \
    if ((++_sp & 255u) == 0u) { if (xb_ld(&(bar)[XB_TMO])) break; if (_sp > XB_SPIN_CAP) { atomicAdd(&(bar)[XB_TMO], 1u); break; } } } } while (0)

struct XcdBarrier {
    unsigned* bar; unsigned x;
    volatile LAS unsigned* st;
};

__device__ __forceinline__ XcdBarrier xcd_barrier_post(unsigned* bar, volatile LAS unsigned* st) {
    XcdBarrier b; b.bar = bar; b.x = xb_xcc_id(); b.st = st;
    if (threadIdx.x == 0) (void)xb_add(&bar[XB_XCNT(b.x)], 1u);
    return b;
}
__device__ __forceinline__ void xcd_barrier_complete(unsigned* bar, unsigned x, unsigned& nloc, unsigned& nx) {
    const unsigned G = gridDim.x * gridDim.y * gridDim.z;
    unsigned sum, cnt, mine, sp = 0u;
    for (;;) {
        sum = 0u; cnt = 0u; mine = 0u;
#pragma unroll
        for (unsigned j = 0; j < 16; ++j) { const unsigned c = xb_ld(&bar[XB_XCNT(j)]); sum += c; cnt += (c > 0u) ? 1u : 0u; mine = (j == x) ? c : mine; }
        if (sum == G) break;
        __builtin_amdgcn_s_sleep(1);
        if ((++sp & 255u) == 0u) { if (xb_ld(&bar[XB_TMO])) break; if (sp > XB_SPIN_CAP) { atomicAdd(&bar[XB_TMO], 1u); break; } }
    }
    nloc = mine > 0u ? mine : 1u; nx = cnt > 0u ? cnt : 1u;
}

__device__ __forceinline__ void xcd_barrier(const XcdBarrier& b) {
    asm volatile("s_waitcnt vmcnt(0)" ::: "memory");
    __syncthreads();
    if (threadIdx.x == 0) {
        unsigned* bar = b.bar;
        __builtin_amdgcn_s_waitcnt(0);
        unsigned nloc = b.st[0], nx = b.st[1];
        if (nloc == 0u) { xcd_barrier_complete(bar, b.x, nloc, nx); b.st[0] = nloc; b.st[1] = nx; }
        const unsigned old = xb_add(&bar[XB_XSUB(b.x)], 1u);
        const unsigned gen = old / nloc;
        if (old + 1u == (gen + 1u) * nloc) {
            __builtin_amdgcn_fence(__ATOMIC_RELEASE, "agent");
            asm volatile("s_waitcnt vmcnt(0)" ::: "memory");
            const unsigned og = xb_add(&bar[XB_TOP], 1u);
            const unsigned tg = og / nx;
            if (og + 1u == (tg + 1u) * nx) xb_add(&bar[XB_TOPGEN], 1u);
            else XB_SPIN(xb_ld(&bar[XB_TOPGEN]) == tg, bar);
            __builtin_amdgcn_fence(__ATOMIC_ACQUIRE, "agent");
            xb_add(&bar[XB_XGEN(b.x)], 1u);
            asm volatile("s_waitcnt vmcnt(0)" ::: "memory");
        } else {
            XB_SPIN(xb_ld(&bar[XB_XGEN(b.x)]) == gen, bar);
            __builtin_amdgcn_fence(__ATOMIC_ACQUIRE, "agent");
            asm volatile("s_waitcnt vmcnt(0)" ::: "memory");
        }
    }
    __syncthreads();
}

constexpr int DM = 1024, NB = 2, SEQ = 8192, NT = NB * SEQ;
constexpr int NTHREADS = 512, NWAVES = 8;
constexpr float LN_EPS = 1e-5f;
constexpr float ALPHA = 1.189207115002721f;
typedef unsigned short bf16;
typedef unsigned v4u __attribute__((ext_vector_type(4)));
typedef unsigned v2u __attribute__((ext_vector_type(2)));
typedef float f32x4 __attribute__((ext_vector_type(4)));
typedef short bf16x8_t __attribute__((ext_vector_type(8)));

constexpr size_t MiB = 1u << 20, KiB = 1u << 10;
constexpr size_t WS_CTL = 0, CTL_ZERO_BYTES = 1 * MiB;
constexpr size_t WS_MOD = 1 * MiB + 768 * KiB;
constexpr size_t WS_MMAT = 1 * MiB;
constexpr size_t WS_ROPE = 2 * MiB;
constexpr size_t WS_WIN = 6 * MiB, WS_WOUT = 12 * MiB, WS_WPQ = 14 * MiB, WS_MISC = 16 * MiB, WS_SUBK = 17 * MiB;
constexpr size_t WS_XN = 18 * MiB;
constexpr size_t WS_FZ = 50 * MiB;
constexpr size_t WS_QB = 66 * MiB, WS_KB = 90 * MiB, WS_VB = 114 * MiB, WS_O3 = 138 * MiB, WS_LSE = 162 * MiB;
constexpr size_t WS_H2Q = 50 * MiB, WS_HS = 66 * MiB, WS_WQ = 67 * MiB, WS_WSC = 69 * MiB, WS_SUA = 75 * MiB, WS_X1 = 83 * MiB;
constexpr size_t WS_Y1 = 116 * MiB, WS_PQ = 116 * MiB, WS_PART = 116 * MiB, WS_Y = 116 * MiB;
constexpr size_t WS_IDS = 180 * MiB, WS_GATES = 188 * MiB;
constexpr size_t WS_TU8 = 200 * MiB, WS_TV8 = 216 * MiB, WS_SU = 232 * MiB, WS_SV = 232 * MiB + 512 * KiB, WS_END = 233 * MiB;
constexpr float QSCALE = 0.125f * 1.4426950408889634f;
constexpr int NIN = 2816;
constexpr int CW_BAR = 4096;

constexpr int RING_BYTES = 131072, LDSCTL_OFF = RING_BYTES, MISC_OFF = LDSCTL_OFF + 320, LDS_BYTES = 147456;

struct Params {
    const float* x; const float* c; const int* pos; const float* w_ada; const float* b_ada; const float* w_in; const float* b_in;
    const float* w_four; const float* w_out; const float* b_out; const float* g1; const float* be1; const float* w_pq; const float* subk;
    const float* pu; const float* pv; const float* g2; const float* be2; float* out; unsigned char* ws;
};

__device__ __forceinline__ unsigned f2bf(float f) { unsigned u = __builtin_bit_cast(unsigned, f); return (u + 0x7fffu + ((u >> 16) & 1u)) >> 16; }
__device__ __forceinline__ unsigned pk2(float lo, float hi) { return f2bf(lo) | (f2bf(hi) << 16); }
__device__ __forceinline__ float wave_sum(float v) {
#pragma unroll
    for (int o = 32; o > 0; o >>= 1) v += __shfl_xor(v, o);
    return v;
}
__device__ __forceinline__ float wave_max(float v) {
#pragma unroll
    for (int o = 32; o > 0; o >>= 1) v = fmaxf(v, __shfl_xor(v, o));
    return v;
}
#define LDS_WAIT() asm volatile("s_waitcnt lgkmcnt(0)" ::: "memory")
__device__ __forceinline__ int opaque_tid() { int t = threadIdx.x; asm volatile("" : "+v"(t)); return t; }
__device__ __forceinline__ int wave_id() { return __builtin_amdgcn_readfirstlane(opaque_tid() >> 6); }
__device__ __forceinline__ float bflo(unsigned u) { return __builtin_bit_cast(float, u << 16); }
__device__ __forceinline__ float bfhi(unsigned u) { return __builtin_bit_cast(float, u & 0xffff0000u); }

template <class SC>
__device__ __forceinline__ void transpose_item(const float* W, int K, int N, bf16* WT, int nout, SC srccol, LAS float* scr, int item, int lane) {
    const int nblk = nout / 32, kb = item / nblk, nb = item % nblk, k0 = 64 * kb, n0 = 32 * nb;
    const int sc = srccol(n0 + (lane & 31));
#pragma unroll 8
    for (int i = 0; i < 32; ++i) { const int kk = 2 * i + (lane >> 5); scr[kk * 33 + (lane & 31)] = W[(size_t)(k0 + kk) * N + sc]; }
    LDS_WAIT(); asm volatile("" ::: "memory");
    const int c = lane & 7;
#pragma unroll
    for (int j = 0; j < 4; ++j) { const int n = (lane >> 3) + 8 * j; const LAS float* s = scr + (8 * c) * 33 + n;
        v4u o; o.x = pk2(s[0 * 33], s[1 * 33]); o.y = pk2(s[2 * 33], s[3 * 33]); o.z = pk2(s[4 * 33], s[5 * 33]); o.w = pk2(s[6 * 33], s[7 * 33]);
        *(v4u*)(WT + (size_t)(n0 + n) * K + k0 + 8 * c) = o; }
    LDS_WAIT(); asm volatile("" ::: "memory");
}
__device__ __forceinline__ void ph_prologue(const Params& p, LAS unsigned char* lds, int bid, int nblk) {
    const int tid = opaque_tid(), lane = tid & 63, wave = __builtin_amdgcn_readfirstlane(tid >> 6);
    {
        LAS float* M = (LAS float*)lds; LAS float* Wl = (LAS float*)(lds + 32768);
        bf16* WT = (bf16*)(p.ws + WS_WIN); float* biasf = (float*)(p.ws + WS_MISC); const float* MM = (const float*)(p.ws + WS_MMAT);
        const bool fallback = !(nblk > 192);
        for (int it = bid; it < 256; it += nblk) {
            const int g = it & 3, kb = it >> 2, k0 = kb * 16;
            __syncthreads();
            if (fallback) { const float norm = 1.0f / sqrtf(8192.0f * 64.0f);
                for (int e = tid; e < 8192; e += NTHREADS) { const int c = e >> 7, nl = e & 127; float a = 0.f;
                    for (int cp = 0; cp < 64; ++cp) { const float ang = 2.0f * (float)((c * cp) & 63) / 64.0f; a += ((nl & 1) ? -sinpif(ang) : cospif(ang)) * p.w_four[(g * 64 + cp) * 64 + (nl >> 1)]; }
                    M[e] = a * norm; } }
            else {
#pragma unroll
                for (int i = 0; i < 4; ++i) *(LAS f32x4*)(lds + (tid + i * 512) * 16) = *(const f32x4*)(MM + (size_t)g * 8192 + (tid + i * 512) * 4); }
#pragma unroll
            for (int i = 0; i < 2; ++i) { const int e = tid + i * 512, k = e >> 6, c = e & 63; Wl[k * 64 + c] = p.w_in[(size_t)(k0 + k) * 2560 + g * 64 + c]; }
            __syncthreads();
            { const int nl = tid & 127, kq = tid >> 7; float a[4] = {0.f, 0.f, 0.f, 0.f};
              for (int c = 0; c < 64; ++c) { const float mv = M[c * 128 + nl];
#pragma unroll
                  for (int j = 0; j < 4; ++j) a[j] += mv * Wl[(kq * 4 + j) * 64 + c]; }
              *(v2u*)(WT + (size_t)(g * 128 + nl) * DM + k0 + kq * 4) = (v2u){pk2(a[0], a[1]), pk2(a[2], a[3])};
              if (kb == 0 && tid < 128) { float bsum = 0.f; for (int c = 0; c < 64; ++c) bsum += p.b_in[g * 64 + c] * M[c * 128 + nl]; biasf[g * 128 + nl] = bsum; } }
        }
        __syncthreads();
        for (int i = bid * NTHREADS + tid; i < 2304; i += nblk * NTHREADS) biasf[512 + i] = p.b_in[256 + i];
    }
    {
        LAS float* scr = (LAS float*)(lds + wave * 16384);
        const int gw = bid * NWAVES + wave, NGW = nblk * NWAVES;
        constexpr int I_IN = 16 * (2304 / 32), I_O = 16 * 32, I_PQ = 16 * 32;
        for (int it = gw; it < I_IN + I_O + I_PQ; it += NGW) {
            int r = it;
            if (r < I_IN) {
                transpose_item(p.w_in, DM, 2560, (bf16*)(p.ws + WS_WIN) + (size_t)512 * DM, 2304,
                    [](int n) { return n < 1536 ? 256 + (n & ~63) + ((n & 63) >> 1) + 32 * (n & 1) : 256 + n; }, scr, r, lane); continue; } r -= I_IN;
            if (r < I_O) { transpose_item(p.w_out, DM, DM, (bf16*)(p.ws + WS_WOUT), DM, [](int n) { return n; }, scr, r, lane); continue; } r -= I_O;
            transpose_item(p.w_pq, DM, DM, (bf16*)(p.ws + WS_WPQ), DM, [](int n) { return n; }, scr, r, lane);
        }
    }
    { bf16* SK = (bf16*)(p.ws + WS_SUBK);
      for (int ch = bid * NTHREADS + tid; ch < 8 * 2 * 4 * 4 * 64; ch += nblk * NTHREADS) {
          const int ln = ch & 63, d0 = (ch >> 6) & 3, mt = (ch >> 8) & 3, hp = ch >> 10;
          const float* sp = p.subk + ((size_t)hp * 128 + 32 * mt + (ln & 31)) * 64 + 16 * d0 + 8 * (ln >> 5);
          v4u o; o.x = pk2(sp[0], sp[1]); o.y = pk2(sp[2], sp[3]); o.z = pk2(sp[4], sp[5]); o.w = pk2(sp[6], sp[7]);
          *(v4u*)(SK + (size_t)ch * 8) = o; } }
}
__device__ __forceinline__ void ph_mod(const Params& p, LAS unsigned char* lds, int bid, int nblk) {
    const int tid = opaque_tid(), col = tid & 31, kg = tid >> 5;
    LAS float* cond = (LAS float*)lds; LAS float* red = (LAS float*)(lds + 8192);
    float* mod = (float*)(p.ws + WS_MOD);
    for (int i = tid; i < 2 * DM; i += NTHREADS) { const float c = p.c[i]; cond[i] = c / (1.0f + expf(-c)); }
    __syncthreads();
    if (nblk > 192 && bid >= 192) {
        LAS float* T64 = (LAS float*)(lds + 12288);
        if (tid < 64) { T64[tid] = cospif(2.0f * (float)tid / 64.0f); T64[64 + tid] = -sinpif(2.0f * (float)tid / 64.0f); }
        __syncthreads();
        const float norm = 1.0f / sqrtf(8192.0f * 64.0f); float* MM = (float*)(p.ws + WS_MMAT);
        for (int it = bid - 192; it < 64; it += nblk - 192) {
            const int g = it >> 4, c = (it & 15) * 4 + (tid >> 7), nl = tid & 127; float a = 0.f;
#pragma unroll 8
            for (int cp = 0; cp < 64; ++cp) a += T64[(nl & 1) * 64 + ((c * cp) & 63)] * p.w_four[(g * 64 + cp) * 64 + (nl >> 1)];
            MM[(g * 64 + c) * 128 + nl] = a * norm;
        }
    }
    for (int it = bid; it < 6144 / 32; it += nblk) {
        const int n = it * 32 + col; float a0 = 0.f, a1 = 0.f;
        const float* wp = p.w_ada + (size_t)(kg * 64) * 6144 + n;
#pragma unroll 16
        for (int k = 0; k < 64; ++k) { const float w = wp[(size_t)k * 6144]; a0 += cond[kg * 64 + k] * w; a1 += cond[DM + kg * 64 + k] * w; }
        red[(kg * 2 + 0) * 32 + col] = a0; red[(kg * 2 + 1) * 32 + col] = a1;
        __syncthreads();
        if (tid < 64) { const int b = tid >> 5; float s = p.b_ada[n];
#pragma unroll
            for (int g = 0; g < 16; ++g) s += red[(g * 2 + b) * 32 + col];
            mod[b * 6144 + n] = s; }
        __syncthreads();
    }
}
__device__ __forceinline__ void ph_xn(const Params& p, int bid, int nblk) {
    const int lane = opaque_tid() & 63, wave = wave_id(); const float* mod = (const float*)(p.ws + WS_MOD); bf16* XN = (bf16*)(p.ws + WS_XN);
    for (int row = bid * NWAVES + wave; row < NT; row += nblk * NWAVES) {
        const int b = row / SEQ;
        const f32x4* xr = (const f32x4*)(p.x + (size_t)row * DM) + lane;
        f32x4 v[4]; float s = 0.f;
#pragma unroll
        for (int j = 0; j < 4; ++j) { v[j] = xr[64 * j]; s += (v[j].x + v[j].y) + (v[j].z + v[j].w); }
        const float mean = wave_sum(s) * (1.f / DM); float s2 = 0.f;
#pragma unroll
        for (int j = 0; j < 4; ++j) { v[j] = v[j] - mean; s2 += (v[j].x * v[j].x + v[j].y * v[j].y) + (v[j].z * v[j].z + v[j].w * v[j].w); }
        const float rstd = rsqrtf(wave_sum(s2) * (1.f / DM) + LN_EPS);
        unsigned long long* o8 = (unsigned long long*)(XN + (size_t)row * DM) + lane;
#pragma unroll
        for (int j = 0; j < 4; ++j) {
            const f32x4 sh = *((const f32x4*)(mod + b * 6144 + 0) + lane + 64 * j), sc = *((const f32x4*)(mod + b * 6144 + 1024) + lane + 64 * j);
            const f32x4 o = v[j] * rstd * (1.0f + sc) + sh;
            o8[64 * j] = (unsigned long long)pk2(o.x, o.y) | ((unsigned long long)pk2(o.z, o.w) << 32);
        }
    }
}

struct EpiOut {
    static constexpr bool PERM = true, AFTER_DRAIN = false;
    bf16* Y1; const float* x; const float* mod; const float* bo;
    __device__ __forceinline__ void operator()(const pg8::f32x4 (&acc)[2][2][4][2], const pg8::Unit& u, int wr, int wc, int fr, int fq) const {
        const int row0 = u.pm * 256 + wr * 64 + fr;
#pragma unroll
        for (int bj = 0; bj < 2; ++bj) {
            const int c0 = u.pn * 256 + bj * 128 + wc * 32 + 8 * fq;
            const pg8::f32x4 b0 = *(const pg8::f32x4*)(bo + c0), b1 = *(const pg8::f32x4*)(bo + c0 + 4);
#pragma unroll
            for (int ai = 0; ai < 2; ++ai) {
                const int bb = (u.pm * 256 + ai * 128) >> 13;
                const pg8::f32x4 g0 = *(const pg8::f32x4*)(mod + bb * 6144 + 2048 + c0) + 1.0f, g1 = *(const pg8::f32x4*)(mod + bb * 6144 + 2048 + c0 + 4) + 1.0f;
#pragma unroll
                for (int m = 0; m < 4; ++m) {
                    const int row = row0 + ai * 128 + m * 16;
                    const pg8::f32x4 x0 = *(const pg8::f32x4*)(x + (size_t)row * DM + c0), x1 = *(const pg8::f32x4*)(x + (size_t)row * DM + c0 + 4);
                    const pg8::f32x4 v0 = x0 * ALPHA + g0 * (acc[ai][bj][m][0] + b0), v1 = x1 * ALPHA + g1 * (acc[ai][bj][m][1] + b1);
                    v4u o; o.x = pk2(v0.x, v0.y); o.y = pk2(v0.z, v0.w); o.z = pk2(v1.x, v1.y); o.w = pk2(v1.z, v1.w);
                    *(v4u*)(Y1 + (size_t)row * DM + c0) = o;
                }
            }
        }
    }
};
__device__ __forceinline__ void ph_fft(const Params& p, LAS unsigned char* lds, int bid, int nblk) {
    const int tid = opaque_tid(), lane = tid & 63, wave = __builtin_amdgcn_readfirstlane(tid >> 6), lr = lane & 15, lq = lane >> 4;
    bf16* MIX = (bf16*)(p.ws + WS_XN);
    for (int item = bid; item < 256; item += nblk) {
        const int b = item >> 7, cg = item & 127;
        const unsigned long long* src = (const unsigned long long*)(p.ws + WS_FZ) + (size_t)(b * 128 + cg) * 8192;
        {
            const int n2b = (tid & 7) | ((tid >> 6) << 3), n1b = (tid >> 3) & 7;
            const unsigned long long* sb = src + 128 * n1b + n2b; LAS unsigned char* lb = lds + (2 * n2b) * 288 + 4 * n1b;
#pragma unroll
            for (int hb = 0; hb < 2; ++hb) {
                unsigned long long zin[8];
#pragma unroll
                for (int i = 0; i < 8; ++i) { const int ii = hb * 8 + i; zin[i] = sb[(ii & 1) * 64 + (ii >> 1) * 1024]; }
#pragma unroll
                for (int i = 0; i < 8; ++i) { const int ii = hb * 8 + i; LAS unsigned char* lp = lb + (ii & 1) * 36864 + (ii >> 1) * 32;
                    *(LAS unsigned*)lp = (unsigned)zin[i]; *(LAS unsigned*)(lp + 288) = (unsigned)(zin[i] >> 32); }
            }
        }
        bf16x8_t af[4];
        { const int m = 16 * wave + lr, k1 = m >> 1, ri = m & 1;
#pragma unroll
          for (int ks = 0; ks < 4; ++ks)
#pragma unroll
              for (int jj = 0; jj < 4; ++jj) { const int n1 = 16 * ks + 4 * lq + jj; const float x = (float)((n1 * k1) & 63) * (1.0f / 64.0f);
                  const float c = __builtin_amdgcn_cosf(x), s = __builtin_amdgcn_sinf(x);
                  af[ks][2 * jj] = (short)f2bf(ri ? -s : c); af[ks][2 * jj + 1] = (short)f2bf(ri ? c : s); } }
        __syncthreads();
        pg8::f32x4 acc[16];
#pragma unroll
        for (int nt = 0; nt < 16; ++nt) { acc[nt] = (pg8::f32x4){0.f, 0.f, 0.f, 0.f};
#pragma unroll
            for (int ks = 0; ks < 4; ++ks) { const bf16x8_t bf = *(const LAS bf16x8_t*)(lds + (16 * nt + lr) * 288 + (32 * ks + 8 * lq) * 2);
                acc[nt] = __builtin_amdgcn_mfma_f32_16x16x32_bf16(af[ks], bf, acc[nt], 0, 0, 0); } }
        __syncthreads();
#pragma unroll
        for (int nt = 0; nt < 16; ++nt) { const int col = 16 * nt + lr, n2 = col >> 1, ch = col & 1;
#pragma unroll
            for (int h = 0; h < 2; ++h) { const int k1 = 8 * wave + 2 * lq + h; const float yr = acc[nt][2 * h], yi = acc[nt][2 * h + 1];
                const float x = (float)((n2 * k1) & 8191) * (1.0f / 8192.0f); const float c = __builtin_amdgcn_cosf(x), s = __builtin_amdgcn_sinf(x);
                *(LAS unsigned*)(lds + (2 * k1 + ch) * 544 + 4 * n2) = pk2(yr * c + yi * s, yi * c - yr * s); } }
        bf16x8_t a2[8];
        { const int k2 = 16 * wave + lr;
#pragma unroll
          for (int ks = 0; ks < 8; ++ks)
#pragma unroll
              for (int jj = 0; jj < 4; ++jj) { const int n2 = 16 * ks + 4 * lq + jj; const float x = (float)((n2 * k2) & 127) * (1.0f / 128.0f);
                  a2[ks][2 * jj] = (short)f2bf(__builtin_amdgcn_cosf(x)); a2[ks][2 * jj + 1] = (short)f2bf(__builtin_amdgcn_sinf(x)); } }
        __syncthreads();
        pg8::f32x4 o[8];
#pragma unroll
        for (int nt = 0; nt < 8; ++nt) { o[nt] = (pg8::f32x4){0.f, 0.f, 0.f, 0.f};
#pragma unroll
            for (int ks = 0; ks < 8; ++ks) { const bf16x8_t bf = *(const LAS bf16x8_t*)(lds + (16 * nt + lr) * 544 + (32 * ks + 8 * lq) * 2);
                o[nt] = __builtin_amdgcn_mfma_f32_16x16x32_bf16(a2[ks], bf, o[nt], 0, 0, 0); } }
#pragma unroll
        for (int nt = 0; nt < 8; ++nt) { const int col2 = 16 * nt + lr, k1 = col2 >> 1, ch = col2 & 1;
#pragma unroll
            for (int r = 0; r < 4; ++r) { const float v = o[nt][r]; const float w = __shfl_xor(v, 1); const int k2 = 16 * wave + 4 * lq + r;
                if (ch == 0) *(unsigned*)(MIX + ((size_t)b * SEQ + k1 + 64 * k2) * DM + 2 * cg) = pk2(v, w); } }
        __syncthreads();
    }
}


struct EpiIn {
    static constexpr bool PERM = true, AFTER_DRAIN = false;
    bf16* FZ; bf16* QKV; const float* bias; const int* pos;
    __device__ __forceinline__ void operator()(const pg8::f32x4 (&acc)[2][2][4][2], const pg8::Unit& u, int wr, int wc, int fr, int fq) const {
        const int row0 = u.pm * 256 + wr * 64 + fr;
        float cf[4];
#pragma unroll
        for (int q = 0; q < 4; ++q) cf[q] = __builtin_amdgcn_exp2f(-(float)(16 * (wc & 1) + 4 * fq + q) * (13.287712379549449f / 32.0f)) * 0.15915494309189535f;
        const bool isqk = u.pn >= 2 && u.pn < 8;
        float posf[2][4];
#pragma unroll
        for (int ai = 0; ai < 2; ++ai)
#pragma unroll
            for (int m = 0; m < 4; ++m) posf[ai][m] = isqk ? (float)pos[row0 + ai * 128 + m * 16] : 0.f;
#pragma unroll
        for (int bj = 0; bj < 2; ++bj) {
            const int c0 = u.pn * 256 + bj * 128 + wc * 32 + 8 * fq;
            const pg8::f32x4 b0 = *(const pg8::f32x4*)(bias + c0), b1 = *(const pg8::f32x4*)(bias + c0 + 4);
#pragma unroll
            for (int ai = 0; ai < 2; ++ai)
#pragma unroll
                for (int m = 0; m < 4; ++m) {
                    const int row = row0 + ai * 128 + m * 16;
                    pg8::f32x4 v0 = acc[ai][bj][m][0] + b0, v1 = acc[ai][bj][m][1] + b1;
                    if (u.pn < 2) {
                        const int b = row >> 13, s = row & 8191, cgp = c0 >> 2;
                        unsigned long long* d0 = (unsigned long long*)(FZ + (((size_t)(b * 128 + cgp) * 8192 + s) << 2));
                        d0[0] = (unsigned long long)pk2(v0.x, v0.y) | ((unsigned long long)pk2(v0.z, v0.w) << 32);
                        d0[8192] = (unsigned long long)pk2(v1.x, v1.y) | ((unsigned long long)pk2(v1.z, v1.w) << 32);
                    } else {
                        const int cq = c0 - 512, which = cq / 768, off = cq - which * 768;
                        if (which < 2) {
                            const float sc = which == 0 ? QSCALE : 1.0f;
                            pg8::f32x4 r0, r1;
                            { const float pf = posf[ai][m]; float a0 = pf * cf[0], a1 = pf * cf[1], a2 = pf * cf[2], a3 = pf * cf[3];
                              a0 -= floorf(a0); a1 -= floorf(a1); a2 -= floorf(a2); a3 -= floorf(a3);
                              r0.x = __builtin_amdgcn_cosf(a0); r0.y = __builtin_amdgcn_sinf(a0); r0.z = __builtin_amdgcn_cosf(a1); r0.w = __builtin_amdgcn_sinf(a1);
                              r1.x = __builtin_amdgcn_cosf(a2); r1.y = __builtin_amdgcn_sinf(a2); r1.z = __builtin_amdgcn_cosf(a3); r1.w = __builtin_amdgcn_sinf(a3); }
                            pg8::f32x4 w0, w1;
                            w0.x = (v0.x * r0.x - v0.y * r0.y) * sc; w0.y = (v0.y * r0.x + v0.x * r0.y) * sc; w0.z = (v0.z * r0.z - v0.w * r0.w) * sc; w0.w = (v0.w * r0.z + v0.z * r0.w) * sc;
                            w1.x = (v1.x * r1.x - v1.y * r1.y) * sc; w1.y = (v1.y * r1.x + v1.x * r1.y) * sc; w1.z = (v1.z * r1.z - v1.w * r1.w) * sc; w1.w = (v1.w * r1.z + v1.z * r1.w) * sc;
                            v0 = w0; v1 = w1;
                        }
                        v4u o; o.x = pk2(v0.x, v0.y); o.y = pk2(v0.z, v0.w); o.z = pk2(v1.x, v1.y); o.w = pk2(v1.z, v1.w);
                        *(v4u*)(QKV + (size_t)which * ((WS_KB - WS_QB) / 2) + (size_t)row * 768 + off) = o;
                    }
                }
        }
    }
};

typedef float f32x16 __attribute__((ext_vector_type(16)));
typedef short s16x4 __attribute__((ext_vector_type(4)));
__device__ __forceinline__ int crow(int r, int hi) { return (r & 3) + 8 * (r >> 2) + 4 * hi; }
__device__ __forceinline__ s16x4 vtr(const LAS unsigned char* p) { return __builtin_bit_cast(s16x4, __builtin_amdgcn_ds_read_tr16_b64_v4i16((LAS s16x4*)p)); }
__device__ __forceinline__ unsigned cvtpk(float lo, float hi) { typedef float f2 __attribute__((ext_vector_type(2))); typedef __bf16 b2 __attribute__((ext_vector_type(2))); f2 v = {lo, hi}; b2 r = __builtin_convertvector(v, b2); return __builtin_bit_cast(unsigned, r); }
__device__ __forceinline__ void tbl_load(const Params& p, int r, f32x4 (&a)[4], int lane) {
    const bool isv = r >= 16384; const int row = isv ? r - 16384 : r;
    const f32x4* src = (const f32x4*)((isv ? p.pv : p.pu) + (size_t)row * DM + 16 * lane);
#pragma unroll
    for (int j = 0; j < 4; ++j) a[j] = src[j];
}
__device__ __forceinline__ void tbl_finish(const Params& p, int r, const f32x4 (&a)[4], int lane) {
    const bool isv = r >= 16384; const int row = isv ? r - 16384 : r;
    float amax = 0.f;
#pragma unroll
    for (int j = 0; j < 4; ++j) amax = fmaxf(amax, fmaxf(fmaxf(fabsf(a[j].x), fabsf(a[j].y)), fmaxf(fabsf(a[j].z), fabsf(a[j].w))));
    if (isv) {
        amax = wave_max(amax);
        const float inv = amax > 0.f ? 127.0f / amax : 0.f;
        v4u o;
#pragma unroll
        for (int j = 0; j < 4; ++j) { unsigned q = 0u;
            q = __builtin_amdgcn_cvt_pk_u8_f32(a[j].x * inv + 128.0f, 0, q); q = __builtin_amdgcn_cvt_pk_u8_f32(a[j].y * inv + 128.0f, 1, q);
            q = __builtin_amdgcn_cvt_pk_u8_f32(a[j].z * inv + 128.0f, 2, q); q = __builtin_amdgcn_cvt_pk_u8_f32(a[j].w * inv + 128.0f, 3, q);
            o[j] = q ^ 0x80808080u; }
        *(v4u*)(p.ws + WS_TV8 + (size_t)(lane >> 3) * (2 * MiB) + (size_t)row * 128 + 16 * (lane & 7)) = o;
        if (lane == 0) ((float*)(p.ws + WS_SV))[row] = amax * (1.0f / 127.0f);
    } else {
        amax = fmaxf(amax, __shfl_xor(amax, 1)); amax = fmaxf(amax, __shfl_xor(amax, 2)); amax = fmaxf(amax, __shfl_xor(amax, 4)); amax = fmaxf(amax, __shfl_xor(amax, 8));
        const float inv = amax > 0.f ? 7.0f / amax : 0.f;
        unsigned d[2];
#pragma unroll
        for (int w = 0; w < 2; ++w) { unsigned lo = 0u, hi = 0u;
            lo = __builtin_amdgcn_cvt_pk_u8_f32(a[2 * w].x * inv + 8.0f, 0, lo); lo = __builtin_amdgcn_cvt_pk_u8_f32(a[2 * w].y * inv + 8.0f, 1, lo);
            lo = __builtin_amdgcn_cvt_pk_u8_f32(a[2 * w].z * inv + 8.0f, 2, lo); lo = __builtin_amdgcn_cvt_pk_u8_f32(a[2 * w].w * inv + 8.0f, 3, lo);
            hi = __builtin_amdgcn_cvt_pk_u8_f32(a[2 * w + 1].x * inv + 8.0f, 0, hi); hi = __builtin_amdgcn_cvt_pk_u8_f32(a[2 * w + 1].y * inv + 8.0f, 1, hi);
            hi = __builtin_amdgcn_cvt_pk_u8_f32(a[2 * w + 1].z * inv + 8.0f, 2, hi); hi = __builtin_amdgcn_cvt_pk_u8_f32(a[2 * w + 1].w * inv + 8.0f, 3, hi);
            d[w] = lo | (hi << 4); }
        *(v2u*)(p.ws + WS_TU8 + (size_t)(lane >> 4) * (2 * MiB) + (size_t)row * 128 + 8 * (lane & 15)) = (v2u){d[0], d[1]};
        if ((lane & 15) == 0) ((float*)(p.ws + WS_SU))[(size_t)(lane >> 4) * 16384 + row] = amax * (1.0f / 7.0f);
    }
}
constexpr int TBL_TAIL = 6144;
__device__ __forceinline__ void ph_tables_tail(const Params& p, int k, int nk) {
    const int lane = opaque_tid() & 63, wave = wave_id();
    const int st = nk * NWAVES; int r = k * NWAVES + wave;
    f32x4 a0[4], a1[4], a2[4], a3[4], b0[4], b1[4], b2[4], b3[4];
    if (r + 3 * st < TBL_TAIL) { tbl_load(p, r, a0, lane); tbl_load(p, r + st, a1, lane); tbl_load(p, r + 2 * st, a2, lane); tbl_load(p, r + 3 * st, a3, lane); }
    while (r + 3 * st < TBL_TAIL) {
        const int rn = r + 4 * st; const bool hb = rn + 3 * st < TBL_TAIL;
        if (hb) { tbl_load(p, rn, b0, lane); tbl_load(p, rn + st, b1, lane); tbl_load(p, rn + 2 * st, b2, lane); tbl_load(p, rn + 3 * st, b3, lane); }
        tbl_finish(p, r, a0, lane); tbl_finish(p, r + st, a1, lane); tbl_finish(p, r + 2 * st, a2, lane); tbl_finish(p, r + 3 * st, a3, lane);
        if (!hb) { r = rn; break; }
        const int rm = rn + 4 * st; const bool ha = rm + 3 * st < TBL_TAIL;
        if (ha) { tbl_load(p, rm, a0, lane); tbl_load(p, rm + st, a1, lane); tbl_load(p, rm + 2 * st, a2, lane); tbl_load(p, rm + 3 * st, a3, lane); }
        tbl_finish(p, rn, b0, lane); tbl_finish(p, rn + st, b1, lane); tbl_finish(p, rn + 2 * st, b2, lane); tbl_finish(p, rn + 3 * st, b3, lane);
        r = rm;
    }
    for (; r < TBL_TAIL; r += st) { tbl_load(p, r, a0, lane); tbl_finish(p, r, a0, lane); }
}
struct AttnDesc { int dil, ntile, res, cb, r; size_t rowb; int h; bool valid; };
__device__ __forceinline__ AttnDesc attn_desc(int bi) {
    AttnDesc d; d.valid = bi < 3 * 768; const int b2 = d.valid ? bi : 0;
    const int r = b2 / 768, rem = b2 - r * 768, bh = rem >> 5, q32 = rem & 31, b = bh / 12;
    d.r = r; d.h = bh - b * 12; d.rowb = (size_t)b * SEQ;
    const int ld = 2 * r;
    d.dil = 1 << ld; d.ntile = 256 >> ld; d.res = q32 >> (5 - ld); d.cb = q32 & ((32 >> ld) - 1);
    return d;
}
__device__ __forceinline__ void attn_dma(const AttnDesc& d, const bf16* T, bool swz, LAS unsigned char* img, int wave, int lane) {
#pragma unroll
    for (int i = 0; i < 6; ++i) {
        const int idx = wave * 6 + i, j = idx >> 2, it = idx & 3, kt = 8 * d.cb - 2 + j;
        if (kt >= 0 && kt < d.ntile) {
            const int row = it * 8 + (lane >> 3), ch = lane & 7; const int gch = swz ? (ch ^ ((row >> 1) & 7)) : ch;
            const bf16* src = T + (d.rowb + d.res + d.dil * (32 * kt + row)) * 768 + d.h * 64 + 8 * gch;
            __builtin_amdgcn_global_load_lds((const unsigned*)src, (LAS unsigned*)(img + j * 4096 + it * 1024), 16, 0, 0);
        }
    }
}
__device__ __forceinline__ void attn_qload(const AttnDesc& d, const bf16* QB, bf16x8_t (&qf)[4], int wave, int lane) {
    const bf16* qp = QB + (d.rowb + d.res + d.dil * (32 * (8 * d.cb + wave) + (lane & 31))) * 768 + d.h * 64 + 8 * (lane >> 5);
#pragma unroll
    for (int d0 = 0; d0 < 4; ++d0) qf[d0] = *(const bf16x8_t*)(qp + 16 * d0);
}
#define ATT_SYNC() do { asm volatile("s_waitcnt vmcnt(0) lgkmcnt(0)" ::: "memory"); __builtin_amdgcn_s_barrier(); asm volatile("" ::: "memory"); } while (0)
#define ATT_SYNC_N(N) do { asm volatile("s_waitcnt vmcnt(" #N ") lgkmcnt(0)" ::: "memory"); __builtin_amdgcn_s_barrier(); asm volatile("" ::: "memory"); } while (0)
__device__ __forceinline__ void ph_attn_fast(const Params& p, LAS unsigned char* lds, int bid, int nblk) {
    const int lane = opaque_tid() & 63, wave = wave_id(), r32 = lane & 31, hi = lane >> 5;
    LAS unsigned char* imgK = lds; LAS unsigned char* imgV = lds + 49152; LAS unsigned char* stgb = lds + 98304 + wave * 4096;
    const bf16* QB = (const bf16*)(p.ws + WS_QB); const bf16* KB = (const bf16*)(p.ws + WS_KB); const bf16* VB = (const bf16*)(p.ws + WS_VB);
    const int vb = (nblk & 7) == 0 ? (bid & 7) * (nblk >> 3) + (bid >> 3) : bid;
    int bi = vb;
    AttnDesc d = attn_desc(bi);
    bf16x8_t qf[4];
    if (d.valid) { attn_dma(d, KB, true, imgK, wave, lane); attn_qload(d, QB, qf, wave, lane); }
    ATT_SYNC();
    const int g = lane >> 4, ii = lane & 15;
    const int vb0 = (4 * hi + (ii >> 2)) * 128 + (g & 1) * 32 + (ii & 3) * 8;
    int trow = TBL_TAIL + bid * NWAVES + wave; const int tstride = nblk * NWAVES;
    f32x4 ta[4], tb[4]; int rowA = -1, rowB = -1;
    while (d.valid) {
        asm volatile("" : "+v"(qf[0]), "+v"(qf[1]), "+v"(qf[2]), "+v"(qf[3]));
        if (rowB >= 0) { tbl_finish(p, rowB, tb, lane); rowB = -1; }
        attn_dma(d, VB, false, imgV, wave, lane);
        asm volatile("" ::: "memory");
        if (trow < 32768) { rowA = trow; trow += tstride; tbl_load(p, rowA, ta, lane); }
        asm volatile("" ::: "memory");
        const int c = 8 * d.cb + wave;
        f32x16 S[5];
#pragma unroll
        for (int u = 0; u < 5; ++u) {
            const int kt = c - 2 + u;
#pragma unroll
            for (int r = 0; r < 16; ++r) S[u][r] = -1e30f;
            if (kt >= 0 && kt < d.ntile) {
                const LAS unsigned char* slot = imgK + (wave + u) * 4096;
                f32x16 a = {0.f, 0.f, 0.f, 0.f, 0.f, 0.f, 0.f, 0.f, 0.f, 0.f, 0.f, 0.f, 0.f, 0.f, 0.f, 0.f};
#pragma unroll
                for (int d0 = 0; d0 < 4; ++d0) { const bf16x8_t kf = *(const LAS bf16x8_t*)(slot + r32 * 128 + (((2 * d0 + hi) ^ ((r32 >> 1) & 7)) << 4));
                    a = __builtin_amdgcn_mfma_f32_32x32x16_bf16(kf, qf[d0], a, 0, 0, 0); }
                S[u] = a;
            }
        }
#pragma unroll
        for (int r = 0; r < 16; ++r) { const int kk = crow(r, hi); if (kk < r32) S[0][r] = -1e30f; if (kk > r32) S[4][r] = -1e30f; }
        float m = -1e30f;
#pragma unroll
        for (int u = 0; u < 5; ++u)
#pragma unroll
            for (int r = 0; r < 16; ++r) m = fmaxf(m, S[u][r]);
        m = fmaxf(m, __shfl_xor(m, 32));
        float l = 0.f;
        unsigned Pk[5][8];
#pragma unroll
        for (int u = 0; u < 5; ++u)
#pragma unroll
            for (int r = 0; r < 16; r += 2) { const float e0 = __builtin_amdgcn_exp2f(S[u][r] - m), e1 = __builtin_amdgcn_exp2f(S[u][r + 1] - m); l += e0 + e1; Pk[u][r >> 1] = cvtpk(e0, e1); }
        l += __shfl_xor(l, 32);
        if (rowA >= 0) ATT_SYNC_N(4); else ATT_SYNC();
        const AttnDesc dn = attn_desc(bi + nblk);
        if (rowA >= 0) { tbl_finish(p, rowA, ta, lane); rowA = -1; }
        if (dn.valid) { attn_dma(dn, KB, true, imgK, wave, lane); attn_qload(dn, QB, qf, wave, lane); }
        asm volatile("" ::: "memory");
        if (trow < 32768) { rowB = trow; trow += tstride; tbl_load(p, rowB, tb, lane); }
        asm volatile("" ::: "memory");
        f32x16 o[2];
#pragma unroll
        for (int db = 0; db < 2; ++db)
#pragma unroll
            for (int r = 0; r < 16; ++r) o[db][r] = 0.f;
#pragma unroll
        for (int u = 0; u < 5; ++u) {
            const int kt = c - 2 + u;
            if (kt >= 0 && kt < d.ntile) {
                const LAS unsigned char* slot = imgV + (wave + u) * 4096;
#pragma unroll
                for (int s = 0; s < 2; ++s) {
                    bf16x8_t pa;
                    { v4u w; w.x = Pk[u][4 * s + 0]; w.y = Pk[u][4 * s + 1]; w.z = Pk[u][4 * s + 2]; w.w = Pk[u][4 * s + 3]; pa = __builtin_bit_cast(bf16x8_t, w); }
#pragma unroll
                    for (int db = 0; db < 2; ++db) {
                        const s16x4 lo = vtr(slot + vb0 + s * 2048 + db * 64), hh = vtr(slot + vb0 + s * 2048 + 1024 + db * 64);
                        const bf16x8_t vf = {lo[0], lo[1], lo[2], lo[3], hh[0], hh[1], hh[2], hh[3]};
                        o[db] = __builtin_amdgcn_mfma_f32_32x32x16_bf16(pa, vf, o[db], 0, 0, 0);
                    }
                }
            }
        }
        bf16* OB = d.r == 2 ? (bf16*)(p.ws + WS_O3) : (bf16*)p.out + (size_t)d.r * NT * 768;
        float* LSE = (float*)(p.ws + WS_LSE) + (size_t)d.r * NT * 12;
        const float linv = 1.0f / l;
        LAS unsigned short* stg = (LAS unsigned short*)stgb;
#pragma unroll
        for (int r = 0; r < 16; ++r) { const int q = crow(r, hi); const float li = __shfl(linv, q);
#pragma unroll
            for (int db = 0; db < 2; ++db) stg[q * 64 + db * 32 + r32] = (unsigned short)f2bf(o[db][r] * li); }
        int ln2 = lane; asm volatile("" : "+v"(ln2));
#pragma unroll
        for (int i4 = 0; i4 < 4; ++i4) { const int row = i4 * 8 + (ln2 >> 3), ch = ln2 & 7;
            const v4u val = *(const LAS v4u*)((LAS unsigned char*)stg + row * 128 + ch * 16);
            *(v4u*)(OB + (d.rowb + d.res + d.dil * (32 * c + row)) * 768 + d.h * 64 + 8 * ch) = val; }
        if (ln2 < 32) LSE[(d.rowb + d.res + d.dil * (32 * c + ln2)) * 12 + d.h] = m + __builtin_amdgcn_logf(l);
        if (rowB >= 0) ATT_SYNC_N(9); else ATT_SYNC_N(5);
        d = dn; bi += nblk;
    }
    if (rowA >= 0) tbl_finish(p, rowA, ta, lane);
    if (rowB >= 0) tbl_finish(p, rowB, tb, lane);
    for (; trow < 32768; trow += tstride) { tbl_load(p, trow, ta, lane); tbl_finish(p, trow, ta, lane); }
}
__device__ __forceinline__ void ph_merge(const Params& p, int bid, int nblk) {
    const bf16* O1 = (const bf16*)p.out; const bf16* O2 = O1 + (size_t)NT * 768; const bf16* O3 = (const bf16*)(p.ws + WS_O3);
    const float* L1 = (const float*)(p.ws + WS_LSE); const float* L2 = L1 + (size_t)NT * 12; const float* L3 = L2 + (size_t)NT * 12; bf16* MIX = (bf16*)(p.ws + WS_XN);
    for (int idx = bid * NTHREADS + opaque_tid(); idx < NT * 96; idx += nblk * NTHREADS) {
        const int t = idx / 96, rem = idx - t * 96, h = rem >> 3, ch = rem & 7;
        const float l1 = L1[t * 12 + h], l2 = L2[t * 12 + h], l3 = L3[t * 12 + h]; const float mx = fmaxf(fmaxf(l1, l2), l3);
        float w1 = __builtin_amdgcn_exp2f(l1 - mx), w2 = __builtin_amdgcn_exp2f(l2 - mx), w3 = __builtin_amdgcn_exp2f(l3 - mx); const float inv = 1.0f / (w1 + w2 + w3); w1 *= inv; w2 *= inv; w3 *= inv;
        const size_t off = (size_t)t * 768 + h * 64 + 8 * ch;
        const v4u a = *(const v4u*)(O1 + off), bq = *(const v4u*)(O2 + off), cq = *(const v4u*)(O3 + off);
        v4u o;
        o.x = pk2(w1 * bflo(a.x) + w2 * bflo(bq.x) + w3 * bflo(cq.x), w1 * bfhi(a.x) + w2 * bfhi(bq.x) + w3 * bfhi(cq.x));
        o.y = pk2(w1 * bflo(a.y) + w2 * bflo(bq.y) + w3 * bflo(cq.y), w1 * bfhi(a.y) + w2 * bfhi(bq.y) + w3 * bfhi(cq.y));
        o.z = pk2(w1 * bflo(a.z) + w2 * bflo(bq.z) + w3 * bflo(cq.z), w1 * bfhi(a.z) + w2 * bfhi(bq.z) + w3 * bfhi(cq.z));
        o.w = pk2(w1 * bflo(a.w) + w2 * bflo(bq.w) + w3 * bflo(cq.w), w1 * bfhi(a.w) + w2 * bfhi(bq.w) + w3 * bfhi(cq.w));
        *(v4u*)(MIX + (size_t)t * DM + 256 + h * 64 + 8 * ch) = o;
    }
}


__host__ __device__ constexpr int stair2_slot(int i, int j) { int n = 0; for (int a = 1; a < 16; ++a) for (int b = 1; b < 16; ++b) if ((a + 1) * (b + 1) <= 16) { if (a == i && b == j) return n; ++n; } return n; }
__device__ __forceinline__ float kmax(float a, float b) { float r; asm("v_max_f32_e32 %0, %1, %2" : "=v"(r) : "v"(a), "v"(b)); return r; }
__device__ __forceinline__ float kmin(float a, float b) { float r; asm("v_min_f32_e32 %0, %1, %2" : "=v"(r) : "v"(a), "v"(b)); return r; }
__device__ __forceinline__ float fkeyf(float s, unsigned low, unsigned mask) { return __builtin_bit_cast(float, (__builtin_bit_cast(unsigned, s) & ~mask) | low); }
__device__ __forceinline__ float fvalf(float k, unsigned mask) { return __builtin_bit_cast(float, (__builtin_bit_cast(unsigned, k) & ~mask) | (mask >> 1)); }
#define CE_DESC(a, b) do { const float _mx = kmax((a), (b)), _mn = kmin((a), (b)); (a) = _mx; (b) = _mn; } while (0)
__device__ __forceinline__ void sort16_desc(float (&a)[16]) {
#pragma unroll
    for (int k = 2; k <= 16; k <<= 1)
#pragma unroll
        for (int j = k >> 1; j > 0; j >>= 1)
#pragma unroll
            for (int i = 0; i < 16; ++i) { const int l = i ^ j; if (l > i) { if ((i & k) == 0) CE_DESC(a[i], a[l]); else CE_DESC(a[l], a[i]); } }
}
__device__ __forceinline__ void merge16_desc(float (&c)[16]) {
#pragma unroll
    for (int j = 8; j > 0; j >>= 1)
#pragma unroll
        for (int i = 0; i < 16; ++i) { const int l = i ^ j; if (l > i) CE_DESC(c[i], c[l]); }
}
__device__ __forceinline__ void top16_merge(float (&a)[16], const float (&b)[16]) {
#pragma unroll
    for (int i = 0; i < 16; ++i) a[i] = kmax(a[i], b[15 - i]);
    merge16_desc(a);
}
__device__ __forceinline__ void top16_of_64(float (&g0)[16], float (&g1)[16], float (&g2)[16], float (&g3)[16]) {
    sort16_desc(g0); sort16_desc(g1); sort16_desc(g2); sort16_desc(g3);
    top16_merge(g0, g1); top16_merge(g2, g3); top16_merge(g0, g2);
}
template <int MST>
__device__ __forceinline__ void topk_item(const bf16x8_t (&qf)[2][4], const bf16* SK, int h, int t, LAS unsigned* myl, unsigned short* ids, float* gates, const float* SVt, int lane) {
    const int hi = lane >> 5; const float NEGINF = -INFINITY;
        float K[2][16];
#pragma unroll
    for (int pp = 0; pp < 2; ++pp) {
        float g[4][16];
#pragma unroll
        for (int mt = 0; mt < 4; ++mt) {
            const bf16* kp = SK + ((size_t)((h * 2 + pp) * 4 + mt) * 4 * 64 + lane) * 8;
            f32x16 a = {0.f, 0.f, 0.f, 0.f, 0.f, 0.f, 0.f, 0.f, 0.f, 0.f, 0.f, 0.f, 0.f, 0.f, 0.f, 0.f};
#pragma unroll
            for (int d0 = 0; d0 < 4; ++d0) a = __builtin_amdgcn_mfma_f32_32x32x16_bf16(*(const bf16x8_t*)(kp + d0 * 512), qf[pp][d0], a, 0, 0, 0);
#pragma unroll
            for (int r = 0; r < 16; ++r) g[mt][r] = fkeyf(a[r], 127u - (unsigned)(32 * mt + crow(r, hi)), 127u);
        }
        top16_of_64(g[0], g[1], g[2], g[3]);
        float o[16];
#pragma unroll
        for (int i = 0; i < 16; ++i) o[i] = __shfl_xor(g[0][i], 32);
        top16_merge(g[0], o);
#pragma unroll
        for (int i = 0; i < 16; ++i) K[pp][i] = g[0][i];
    }
#pragma unroll
    for (int i = 0; i < 16; ++i) { myl[i * MST] = __builtin_bit_cast(unsigned, K[0][i]); myl[(16 + i) * MST] = __builtin_bit_cast(unsigned, K[1][i]); }
    float v0[16], v1[16];
#pragma unroll
    for (int i = 0; i < 16; ++i) { v0[i] = fvalf(K[0][i], 127u); v1[i] = fvalf(K[1][i], 127u); }
    float cA[16], cB[16], cC[16], cD[16];
#pragma unroll
    for (int j = 0; j < 16; ++j) cA[j] = fkeyf(v0[0] + v1[j], 255u - (unsigned)j, 255u);
#pragma unroll
    for (int i = 1; i < 16; ++i) cB[i - 1] = fkeyf(v0[i] + v1[0], 255u - (unsigned)(16 * i), 255u);
    cB[15] = NEGINF;
#pragma unroll
    for (int q = 0; q < 16; ++q) { cC[q] = NEGINF; cD[q] = NEGINF; }
    { int n = 0;
#pragma unroll
      for (int i = 1; i < 8; ++i)
#pragma unroll
          for (int j = 1; j < 8; ++j) if ((i + 1) * (j + 1) <= 16) { const int m = stair2_slot(i, j); const float kv = fkeyf(v0[i] + v1[j], 255u - (unsigned)(16 * i + j), 255u); if (m < 16) cC[m] = kv; else cD[m - 16] = kv; }
      (void)n; }
    sort16_desc(cC);
    CE_DESC(cD[0], cD[1]); CE_DESC(cD[1], cD[2]); CE_DESC(cD[0], cD[1]);
    top16_merge(cA, cB); top16_merge(cC, cD); top16_merge(cA, cC);
    float e[16]; float sum = 0.f; const float mx = fvalf(cA[0], 255u);
#pragma unroll
    for (int r = 0; r < 16; ++r) { e[r] = __builtin_amdgcn_exp2f((fvalf(cA[r], 255u) - mx) * 1.4426950408889634f); sum += e[r]; }
    const float inv = __builtin_amdgcn_rcpf(sum);
    int eid[16];
#pragma unroll
    for (int r = 0; r < 16; ++r) { const unsigned id8 = 255u - (__builtin_bit_cast(unsigned, cA[r]) & 255u); const unsigned k0 = myl[(id8 >> 4) * MST], k1 = myl[(16 + (id8 & 15)) * MST];
        eid[r] = (int)((127u - (k0 & 127u)) * 128u + (127u - (k1 & 127u))); }
    int tq = t; asm volatile("" : "+v"(tq));
    if (hi == 0) {
#pragma unroll
        for (int q = 0; q < 2; ++q) *(v4u*)(ids + (size_t)tq * 128 + h * 16 + 8 * q) = (v4u){(unsigned)eid[8 * q] | ((unsigned)eid[8 * q + 1] << 16), (unsigned)eid[8 * q + 2] | ((unsigned)eid[8 * q + 3] << 16),
                                                                                  (unsigned)eid[8 * q + 4] | ((unsigned)eid[8 * q + 5] << 16), (unsigned)eid[8 * q + 6] | ((unsigned)eid[8 * q + 7] << 16)};
    } else {
#pragma unroll
        for (int q = 0; q < 4; ++q) *(f32x4*)(gates + (size_t)tq * 128 + h * 16 + 4 * q) = (f32x4){e[4 * q] * inv * SVt[eid[4 * q]], e[4 * q + 1] * inv * SVt[eid[4 * q + 1]], e[4 * q + 2] * inv * SVt[eid[4 * q + 2]], e[4 * q + 3] * inv * SVt[eid[4 * q + 3]]};
    }
}
struct EpiPeerTopk {
    static constexpr bool PERM = true, AFTER_DRAIN = true;
    const bf16* SK; unsigned short* ids; float* gates; const float* SVt;
    __device__ __forceinline__ void fused(pg8::f32x4 (&acc)[2][2][4][2], const pg8::Unit& u, int wr, int wc, int fr, int fq, PG8_LAS unsigned char* lds, int wid, int lane) const {
#pragma unroll
        for (int bj = 0; bj < 2; ++bj) {
            const int cc = (bj * 128 + wc * 32 + 8 * fq) >> 3;
#pragma unroll
            for (int ai = 0; ai < 2; ++ai)
#pragma unroll
                for (int m = 0; m < 4; ++m) {
                    const int rl = ai * 128 + wr * 64 + m * 16 + fr; const pg8::f32x4 v0 = acc[ai][bj][m][0], v1 = acc[ai][bj][m][1];
                    v4u o; o.x = pk2(v0.x, v0.y); o.y = pk2(v0.z, v0.w); o.z = pk2(v1.x, v1.y); o.w = pk2(v1.z, v1.w);
                    *(PG8_LAS v4u*)(lds + rl * 512 + ((cc ^ (rl & 15)) << 4)) = o;
                }
        }
        asm volatile("s_waitcnt lgkmcnt(0)" ::: "memory"); __builtin_amdgcn_s_barrier(); asm volatile("" ::: "memory");
        const int r32 = lane & 31, hi = lane >> 5;
#pragma unroll 1
        for (int rep = 0; rep < 2; ++rep) {
            const int it2 = wid + 8 * rep, tl = it2 >> 1, hl = it2 & 1, rl = tl * 32 + r32;
            bf16x8_t qf[2][4];
#pragma unroll
            for (int pp = 0; pp < 2; ++pp)
#pragma unroll
                for (int d0 = 0; d0 < 4; ++d0) { const int cc = hl * 16 + pp * 8 + 2 * d0 + hi; qf[pp][d0] = *(const PG8_LAS bf16x8_t*)(lds + rl * 512 + ((cc ^ (rl & 15)) << 4)); }
            asm volatile("s_waitcnt lgkmcnt(0)" ::: "memory");
            LAS unsigned* myl = (LAS unsigned*)(lds + (tl * 32) * 512 + hl * 256) + lane;
            topk_item<128>(qf, SK, 2 * u.pn + hl, u.pm * 256 + rl, myl, ids, gates, SVt, lane);
        }
    }
};

__device__ __forceinline__ void ph_ln1_fast(const Params& p, int bid, int nblk) {
    const bf16* y1 = (const bf16*)(p.ws + WS_Y1); bf16* x1 = (bf16*)(p.ws + WS_X1); bf16* h2b = (bf16*)(p.ws + WS_XN); const float* mod = (const float*)(p.ws + WS_MOD);
    const int lane = opaque_tid() & 63, wave = wave_id();
    for (int row = bid * NWAVES + wave; row < NT; row += nblk * NWAVES) {
        const int b = row / SEQ;
        const v2u* yr = (const v2u*)(y1 + (size_t)row * DM) + lane;
        f32x4 v[4]; float s = 0.f;
#pragma unroll
        for (int j = 0; j < 4; ++j) { const v2u w = yr[64 * j]; v[j] = (f32x4){bflo(w.x), bfhi(w.x), bflo(w.y), bfhi(w.y)}; s += (v[j].x + v[j].y) + (v[j].z + v[j].w); }
        float mean = wave_sum(s) * (1.f / DM); float s2 = 0.f;
#pragma unroll
        for (int j = 0; j < 4; ++j) { v[j] = v[j] - mean; s2 += (v[j].x * v[j].x + v[j].y * v[j].y) + (v[j].z * v[j].z + v[j].w * v[j].w); }
        float rstd = rsqrtf(wave_sum(s2) * (1.f / DM) + LN_EPS);
        s = 0.f;
#pragma unroll
        for (int j = 0; j < 4; ++j) { const f32x4 g = *((const f32x4*)p.g1 + lane + 64 * j), be = *((const f32x4*)p.be1 + lane + 64 * j);
            v[j] = v[j] * rstd * g + be; *((v2u*)(x1 + (size_t)row * DM) + lane + 64 * j) = (v2u){pk2(v[j].x, v[j].y), pk2(v[j].z, v[j].w)}; s += (v[j].x + v[j].y) + (v[j].z + v[j].w); }
        mean = wave_sum(s) * (1.f / DM); s2 = 0.f;
#pragma unroll
        for (int j = 0; j < 4; ++j) { v[j] = v[j] - mean; s2 += (v[j].x * v[j].x + v[j].y * v[j].y) + (v[j].z * v[j].z + v[j].w * v[j].w); }
        rstd = rsqrtf(wave_sum(s2) * (1.f / DM) + LN_EPS);
        float amax = 0.f;
#pragma unroll
        for (int j = 0; j < 4; ++j) {
            const f32x4 sh = *((const f32x4*)(mod + b * 6144 + 3072) + lane + 64 * j), sc = *((const f32x4*)(mod + b * 6144 + 4096) + lane + 64 * j);
            const f32x4 o = v[j] * rstd * (1.0f + sc) + sh; v[j] = o;
            amax = fmaxf(amax, fmaxf(fmaxf(fabsf(o.x), fabsf(o.y)), fmaxf(fabsf(o.z), fabsf(o.w))));
            *((v2u*)(h2b + (size_t)row * DM) + lane + 64 * j) = (v2u){pk2(o.x, o.y), pk2(o.z, o.w)};
        }
        amax = wave_max(amax); const float hinv = amax > 0.f ? 127.0f / amax : 0.f;
        unsigned* q4 = (unsigned*)(p.ws + WS_H2Q + (size_t)row * DM) + lane;
#pragma unroll
        for (int j = 0; j < 4; ++j) { unsigned q = 0u;
            q = __builtin_amdgcn_cvt_pk_u8_f32(v[j].x * hinv + 128.0f, 0, q); q = __builtin_amdgcn_cvt_pk_u8_f32(v[j].y * hinv + 128.0f, 1, q);
            q = __builtin_amdgcn_cvt_pk_u8_f32(v[j].z * hinv + 128.0f, 2, q); q = __builtin_amdgcn_cvt_pk_u8_f32(v[j].w * hinv + 128.0f, 3, q);
            q4[64 * j] = q ^ 0x80808080u; }
        if (lane == 0) ((float*)(p.ws + WS_HS))[row] = amax * (1.0f / 127.0f);
    }
}
__device__ __forceinline__ void ph_tables8(const Params& p, int bid, int nblk) {
    const int lane = opaque_tid() & 63, wave = wave_id();
    for (int r = bid * NWAVES + wave; r < 2 * 16384; r += nblk * NWAVES) {
        const bool isv = r >= 16384; const int row = isv ? r - 16384 : r;
        const f32x4* src = (const f32x4*)((isv ? p.pv : p.pu) + (size_t)row * DM + 16 * lane);
        f32x4 a[4]; float amax = 0.f;
#pragma unroll
        for (int j = 0; j < 4; ++j) { a[j] = src[j]; amax = fmaxf(amax, fmaxf(fmaxf(fabsf(a[j].x), fabsf(a[j].y)), fmaxf(fabsf(a[j].z), fabsf(a[j].w)))); }
        amax = wave_max(amax);
        const float inv = amax > 0.f ? 127.0f / amax : 0.f;
        v4u o;
#pragma unroll
        for (int j = 0; j < 4; ++j) { unsigned q = 0u;
            q = __builtin_amdgcn_cvt_pk_u8_f32(a[j].x * inv + 128.0f, 0, q); q = __builtin_amdgcn_cvt_pk_u8_f32(a[j].y * inv + 128.0f, 1, q);
            q = __builtin_amdgcn_cvt_pk_u8_f32(a[j].z * inv + 128.0f, 2, q); q = __builtin_amdgcn_cvt_pk_u8_f32(a[j].w * inv + 128.0f, 3, q);
            o[j] = q ^ 0x80808080u; }
        *(v4u*)(p.ws + (isv ? WS_TV8 : WS_TU8) + (size_t)(lane >> 3) * (2 * MiB) + (size_t)row * 128 + 16 * (lane & 7)) = o;
        if (lane == 0) ((float*)(p.ws + (isv ? WS_SV : WS_SU)))[row] = amax * (1.0f / 127.0f);
    }
}
__device__ __forceinline__ float readlane_f(float v, int l) { return __builtin_bit_cast(float, __builtin_amdgcn_readlane(__builtin_bit_cast(int, v), l)); }
__device__ __forceinline__ float ub0(unsigned u) { return (float)(u & 255u); }
__device__ __forceinline__ float ub1(unsigned u) { return (float)((u >> 8) & 255u); }
__device__ __forceinline__ float ub2(unsigned u) { return (float)((u >> 16) & 255u); }
__device__ __forceinline__ float ub3(unsigned u) { return (float)(u >> 24); }
__device__ __forceinline__ v4u ust_meta(const Params& p, int step, int t0, int stride8, int lane) {
    const int g = step >> 4, k = step & 15; int t = t0 + g * stride8 + (lane >> 3); t = t < NT ? t : NT - 1;
    return *(const v4u*)(p.ws + WS_IDS + (size_t)t * 256 + 16 * k);
}
__device__ __forceinline__ void ust_issue(v4u (&ub)[8], const v4u& idq, const unsigned char* TUs) {
#pragma unroll
    for (int e = 0; e < 8; ++e) { const unsigned w = idq[e >> 1]; const unsigned id = (e & 1) ? (w >> 16) : (w & 0xffffu); ub[e] = *(const v4u*)(TUs + (size_t)id * 128); }
}
__device__ __forceinline__ unsigned short ust_compute(const v4u (&ub)[8], const v4u& idq, const v4u& h0, const v4u& h1, int off8, const float* SUs, int lane) {
    int a[8];
#pragma unroll
    for (int e = 0; e < 8; ++e) { int v = 0;
#pragma unroll
        for (int j = 0; j < 4; ++j) { const unsigned d = ub[e][j]; const unsigned lo = d & 0x0f0f0f0fu, hi = (d >> 4) & 0x0f0f0f0fu;
            const unsigned hl = j < 2 ? h0[2 * j] : h1[2 * j - 4], hh = j < 2 ? h0[2 * j + 1] : h1[2 * j - 3];
            v = __builtin_amdgcn_sdot4((int)lo, (int)hl, v, false); v = __builtin_amdgcn_sdot4((int)hi, (int)hh, v, false); }
        a[e] = v; }
    int a4[4];
#pragma unroll
    for (int k = 0; k < 4; ++k) { const bool up = (lane & 4) != 0; const int keep = up ? a[k + 4] : a[k], send = up ? a[k] : a[k + 4]; a4[k] = keep + __shfl_xor(send, 4); }
    int a2[2];
#pragma unroll
    for (int k = 0; k < 2; ++k) { const bool up = (lane & 2) != 0; const int keep = up ? a4[k + 2] : a4[k], send = up ? a4[k] : a4[k + 2]; a2[k] = keep + __shfl_xor(send, 2); }
    const bool up = (lane & 1) != 0; const int keep = up ? a2[1] : a2[0], send = up ? a2[0] : a2[1];
    const int tot = keep + __shfl_xor(send, 1);
    const int c = lane & 7; const unsigned w2 = (c >> 1) == 0 ? idq.x : ((c >> 1) == 1 ? idq.y : ((c >> 1) == 2 ? idq.z : idq.w));
    const unsigned id = (c & 1) ? (w2 >> 16) : (w2 & 0xffffu);
    return (unsigned short)f2bf((float)(tot - off8) * SUs[id]);
}
__device__ __forceinline__ void ph_udot(const Params& p, int bid, int nblk) {
    unsigned short* P = (unsigned short*)(p.ws + WS_PART);
    const int lane = opaque_tid() & 63, wave = wave_id(), c = lane & 7;
    const int s8 = bid & 7, s = s8 & 3;
    const int nlo = (nblk - s + 7) >> 3, nhi = (nblk - (s + 4) + 7) >> 3;
    const int widx = ((s8 >> 2) ? nlo : 0) * NWAVES + (bid >> 3) * NWAVES + wave, stride8 = (nlo + nhi) * NWAVES * 8;
    const unsigned char* TUs = p.ws + WS_TU8 + (size_t)s * (2 * MiB) + 16 * c;
    const float* SUs = (const float*)(p.ws + WS_SU) + (size_t)s * 16384;
    const int t0 = widx * 8;
    const int ngroups = t0 < NT ? (NT - t0 + stride8 - 1) / stride8 : 0, nsteps = ngroups * 16;
    if (nsteps == 0) return;
    v4u uA[8], uB[8];
    v4u qa = ust_meta(p, 0, t0, stride8, lane);
    ust_issue(uA, qa, TUs);
    v4u qb = ust_meta(p, 1, t0, stride8, lane);
    v4u h0 = {0u, 0u, 0u, 0u}, h1 = {0u, 0u, 0u, 0u}; int off8 = 0;
    for (int st = 0; st < nsteps; st += 2) {
        const int tg = t0 + (st >> 4) * stride8 + (lane >> 3); const int t = tg < NT ? tg : NT - 1;
        if ((st & 15) == 0) {
            const unsigned char* hp = p.ws + WS_H2Q + (size_t)t * DM + 256 * s + 32 * c; h0 = *(const v4u*)hp; h1 = *(const v4u*)(hp + 16);
            int hs = 0;
#pragma unroll
            for (int j = 0; j < 4; ++j) { hs = __builtin_amdgcn_sdot4((int)h0[j], 0x01010101, hs, false); hs = __builtin_amdgcn_sdot4((int)h1[j], 0x01010101, hs, false); }
            hs += __shfl_xor(hs, 1); hs += __shfl_xor(hs, 2); hs += __shfl_xor(hs, 4); off8 = 8 * hs;
        }
        ust_issue(uB, qb, TUs);
        const v4u ia = qa; qa = ust_meta(p, st + 2 < nsteps ? st + 2 : st, t0, stride8, lane);
        const unsigned short ra = ust_compute(uA, ia, h0, h1, off8, SUs, lane);
        if (st + 2 < nsteps) ust_issue(uA, qa, TUs);
        const v4u ib = qb; qb = ust_meta(p, st + 3 < nsteps ? st + 3 : st + 1, t0, stride8, lane);
        const unsigned short rb = ust_compute(uB, ib, h0, h1, off8, SUs, lane);
        if (tg < NT) { unsigned short* dst = P + ((size_t)t * 4 + s) * 128 + 8 * (st & 15) + c; dst[0] = ra; dst[8] = rb; }
    }
}
__device__ __forceinline__ void ph_act(const Params& p, int bid, int nblk) {
    const bf16* P = (const bf16*)(p.ws + WS_PART); const float* GS = (const float*)(p.ws + WS_GATES); const float* HS = (const float*)(p.ws + WS_HS);
    unsigned char* WQ = p.ws + WS_WQ; float* WSC = (float*)(p.ws + WS_WSC);
    const int lane = opaque_tid() & 63, wave = wave_id();
    for (int t = bid * NWAVES + wave; t < NT; t += nblk * NWAVES) {
        float a0 = 0.f, a1 = 0.f;
#pragma unroll
        for (int s = 0; s < 4; ++s) { a0 += __builtin_bit_cast(float, (unsigned)P[((size_t)t * 4 + s) * 128 + lane] << 16); a1 += __builtin_bit_cast(float, (unsigned)P[((size_t)t * 4 + s) * 128 + 64 + lane] << 16); }
        const float hs = HS[t];
        const float d0 = a0 * hs, d1 = a1 * hs;
        const float w0 = GS[(size_t)t * 128 + lane] * 0.5f * d0 * (1.0f + erff(d0 * 0.70710678118654752f));
        const float w1 = GS[(size_t)t * 128 + 64 + lane] * 0.5f * d1 * (1.0f + erff(d1 * 0.70710678118654752f));
        const float wmax = wave_max(fmaxf(fabsf(w0), fabsf(w1))); const float winv = wmax > 0.f ? 127.0f / wmax : 0.f;
        unsigned b2 = __builtin_amdgcn_cvt_pk_u8_f32(w0 * winv + 128.0f, 0, 0u); b2 = __builtin_amdgcn_cvt_pk_u8_f32(w1 * winv + 128.0f, 1, b2); b2 ^= 0x8080u;
        WQ[(size_t)t * 128 + lane] = (unsigned char)(b2 & 255u); WQ[(size_t)t * 128 + 64 + lane] = (unsigned char)((b2 >> 8) & 255u);
        if (lane == 0) WSC[t] = wmax * (1.0f / 127.0f);
    }
}
struct VstepMeta { v4u idq; v2u wq; };
__device__ __forceinline__ VstepMeta vst_meta(const Params& p, int step, int t0, int stride8, int lane) {
    const int g = step >> 4, k = step & 15; int t = t0 + g * stride8 + (lane >> 3); t = t < NT ? t : NT - 1;
    VstepMeta r; r.idq = *(const v4u*)(p.ws + WS_IDS + (size_t)t * 256 + 16 * k); r.wq = *(const v2u*)(p.ws + WS_WQ + (size_t)t * 128 + 8 * k); return r;
}
__device__ __forceinline__ void vst_issue(v4u (&vb)[8], const VstepMeta& q, const unsigned char* TVs) {
#pragma unroll
    for (int e = 0; e < 8; ++e) { const unsigned w = q.idq[e >> 1]; const unsigned id = (e & 1) ? (w >> 16) : (w & 0xffffu); vb[e] = *(const v4u*)(TVs + (size_t)id * 128); }
}
__device__ __forceinline__ void vst_compute(int (&y)[16], const v4u (&vb)[8], const v2u& wq) {
#pragma unroll
    for (int qd = 0; qd < 2; ++qd)
#pragma unroll
        for (int cm = 0; cm < 4; ++cm) {
            const unsigned A = vb[4 * qd][cm], B = vb[4 * qd + 1][cm], C = vb[4 * qd + 2][cm], D = vb[4 * qd + 3][cm];
            const unsigned ab01 = __builtin_amdgcn_perm(B, A, 0x05010400u), ab23 = __builtin_amdgcn_perm(B, A, 0x07030602u);
            const unsigned cd01 = __builtin_amdgcn_perm(D, C, 0x05010400u), cd23 = __builtin_amdgcn_perm(D, C, 0x07030602u);
            const unsigned t0 = __builtin_amdgcn_perm(cd01, ab01, 0x05040100u), t1 = __builtin_amdgcn_perm(cd01, ab01, 0x07060302u);
            const unsigned t2 = __builtin_amdgcn_perm(cd23, ab23, 0x05040100u), t3 = __builtin_amdgcn_perm(cd23, ab23, 0x07060302u);
            y[4 * cm + 0] = __builtin_amdgcn_sdot4((int)t0, (int)wq[qd], y[4 * cm + 0], false); y[4 * cm + 1] = __builtin_amdgcn_sdot4((int)t1, (int)wq[qd], y[4 * cm + 1], false);
            y[4 * cm + 2] = __builtin_amdgcn_sdot4((int)t2, (int)wq[qd], y[4 * cm + 2], false); y[4 * cm + 3] = __builtin_amdgcn_sdot4((int)t3, (int)wq[qd], y[4 * cm + 3], false);
        }
}
__device__ __forceinline__ void ph_vacc(const Params& p, int bid, int nblk) {
    bf16* Y = (bf16*)(p.ws + WS_Y); const float* WSC = (const float*)(p.ws + WS_WSC);
    const int lane = opaque_tid() & 63, wave = wave_id(), c = lane & 7;
    const int s = bid & 7, nper = (nblk - s + 7) >> 3,     stride8 = nper * NWAVES * 8;
    const unsigned char* TVs = p.ws + WS_TV8 + (size_t)s * (2 * MiB) + 16 * c;
    const int t0 = ((bid >> 3) * NWAVES + wave) * 8;
    const int ngroups = t0 < NT ? (NT - t0 + stride8 - 1) / stride8 : 0, nsteps = ngroups * 16;
    if (nsteps == 0) return;
    int y[16];
#pragma unroll
    for (int k = 0; k < 16; ++k) y[k] = 0;
    v4u vA[8], vB[8];
    VstepMeta qa = vst_meta(p, 0, t0, stride8, lane);
    vst_issue(vA, qa, TVs);
    VstepMeta qb = vst_meta(p, 1, t0, stride8, lane);
    for (int st = 0; st < nsteps; st += 2) {
        vst_issue(vB, qb, TVs);
        const v2u wa = qa.wq; qa = vst_meta(p, st + 2 < nsteps ? st + 2 : st, t0, stride8, lane);
        vst_compute(y, vA, wa);
        if (st + 2 < nsteps) vst_issue(vA, qa, TVs);
        const v2u wb = qb.wq; qb = vst_meta(p, st + 3 < nsteps ? st + 3 : st + 1, t0, stride8, lane);
        vst_compute(y, vB, wb);
        if (((st + 1) & 15) == 15) {
            const int t = t0 + (st >> 4) * stride8 + (lane >> 3);
            if (t < NT) { const float sc = WSC[t];
                v4u o0, o1; o0.x = pk2((float)y[0] * sc, (float)y[1] * sc); o0.y = pk2((float)y[2] * sc, (float)y[3] * sc); o0.z = pk2((float)y[4] * sc, (float)y[5] * sc); o0.w = pk2((float)y[6] * sc, (float)y[7] * sc);
                o1.x = pk2((float)y[8] * sc, (float)y[9] * sc); o1.y = pk2((float)y[10] * sc, (float)y[11] * sc); o1.z = pk2((float)y[12] * sc, (float)y[13] * sc); o1.w = pk2((float)y[14] * sc, (float)y[15] * sc);
                v4u* dst = (v4u*)(Y + (size_t)t * DM + 128 * s + 16 * c); dst[0] = o0; dst[1] = o1; }
#pragma unroll
            for (int k = 0; k < 16; ++k) y[k] = 0;
        }
    }
}
__device__ __forceinline__ void ph_final(const Params& p, int bid, int nblk) {
    const bf16* x1 = (const bf16*)(p.ws + WS_X1); const bf16* Y = (const bf16*)(p.ws + WS_Y); const float* mod = (const float*)(p.ws + WS_MOD);
    const int lane = opaque_tid() & 63, wave = wave_id();
    for (int t = bid * NWAVES + wave; t < NT; t += nblk * NWAVES) {
        const int b = t / SEQ;
        f32x4 v[4]; float s = 0.f;
#pragma unroll
        for (int j = 0; j < 4; ++j) { const v2u xw = *((const v2u*)(x1 + (size_t)t * DM) + lane + 64 * j), yw = *((const v2u*)(Y + (size_t)t * DM) + lane + 64 * j);
            const f32x4 g2 = *((const f32x4*)(mod + b * 6144 + 5120) + lane + 64 * j);
            const f32x4 xv = {bflo(xw.x), bfhi(xw.x), bflo(xw.y), bfhi(xw.y)}, yv = {bflo(yw.x), bfhi(yw.x), bflo(yw.y), bfhi(yw.y)};
            v[j] = xv * ALPHA + (g2 + 1.0f) * yv; s += (v[j].x + v[j].y) + (v[j].z + v[j].w); }
        const float mean = wave_sum(s) * (1.f / DM); float s2 = 0.f;
#pragma unroll
        for (int j = 0; j < 4; ++j) { v[j] = v[j] - mean; s2 += (v[j].x * v[j].x + v[j].y * v[j].y) + (v[j].z * v[j].z + v[j].w * v[j].w); }
        const float rstd = rsqrtf(wave_sum(s2) * (1.f / DM) + LN_EPS);
#pragma unroll
        for (int j = 0; j < 4; ++j) { const f32x4 g = *((const f32x4*)p.g2 + lane + 64 * j), be = *((const f32x4*)p.be2 + lane + 64 * j);
            *((f32x4*)(p.out + (size_t)t * DM) + lane + 64 * j) = v[j] * rstd * g + be; }
    }
}

#ifndef PROBE_ID
#define PROBE_ID 0
#endif
#define RUN2(id, ...) do { __VA_ARGS__; if (PROBE_ID == (id)) { xcd_barrier(bar); __VA_ARGS__; } } while (0)
__global__ void __launch_bounds__(NTHREADS, 2) mega(Params p) {
    extern __shared__ __attribute__((aligned(16))) unsigned char lds_raw[];

    LAS unsigned char* lds = (LAS unsigned char*)lds_raw;
    const int bid = blockIdx.x, nblk = gridDim.x, tid = opaque_tid();
    for (int u = tid; u < (LDS_BYTES - LDSCTL_OFF) / 4; u += NTHREADS) ((LAS unsigned*)(lds + LDSCTL_OFF))[u] = 0u;
    __syncthreads();
    unsigned* ctl = (unsigned*)(p.ws + WS_CTL);
    XcdBarrier bar = xcd_barrier_post(ctl + CW_BAR, (volatile LAS unsigned*)(lds + MISC_OFF) + 8);
    const float* mod = (const float*)(p.ws + WS_MOD);

    ph_mod(p, lds, bid, nblk);
    xcd_barrier(bar);
    RUN2(1, ph_prologue(p, lds, bid, nblk));
    RUN2(7, ph_xn(p, bid, nblk));
    xcd_barrier(bar);
    {
        pg8::Gemm g{(const pg8::bf16_t*)(p.ws + WS_XN), (const pg8::bf16_t*)(p.ws + WS_WIN), NT, NIN, DM}; pg8::StaticOrder S; S.init(NT, NIN, nblk, bid);
        EpiIn E{(bf16*)(p.ws + WS_FZ), (bf16*)(p.ws + WS_QB), (const float*)(p.ws + WS_MISC), p.pos};
        pg8::gemm_phase<EpiIn, pg8::StaticOrder, true, true>(lds, g, S, E);
        const int nun = (NT / 256) * (NIN / 256), maxu = (nun + nblk - 1) / nblk, first = nun - (maxu - 1) * nblk;
        if (first < nblk) { if (bid >= first) ph_tables_tail(p, bid - first, nblk - first); }
        else if (TBL_TAIL > 0) ph_tables_tail(p, bid, nblk);
    }
    xcd_barrier(bar);
    RUN2(8, ph_fft(p, lds, bid, nblk));
    RUN2(2, ph_attn_fast(p, lds, bid, nblk));
    xcd_barrier(bar);
    RUN2(3, ph_merge(p, bid, nblk));
    xcd_barrier(bar);
    {
        pg8::Gemm g{(const pg8::bf16_t*)(p.ws + WS_XN), (const pg8::bf16_t*)(p.ws + WS_WOUT), NT, DM, DM}; pg8::StaticOrder S; S.init(NT, DM, nblk, bid);
        EpiOut E{(bf16*)(p.ws + WS_Y1), p.x, mod, p.b_out};
        pg8::gemm_phase<EpiOut, pg8::StaticOrder, true, true>(lds, g, S, E);
    }
    xcd_barrier(bar);
    RUN2(4, ph_ln1_fast(p, bid, nblk));
    xcd_barrier(bar);
    {
        pg8::Gemm g{(const pg8::bf16_t*)(p.ws + WS_XN), (const pg8::bf16_t*)(p.ws + WS_WPQ), NT, DM, DM}; pg8::StaticOrder S; S.init(NT, DM, nblk, bid);
        EpiPeerTopk E{(const bf16*)(p.ws + WS_SUBK), (unsigned short*)(p.ws + WS_IDS), (float*)(p.ws + WS_GATES), (const float*)(p.ws + WS_SV)};
        pg8::gemm_phase<EpiPeerTopk, pg8::StaticOrder, false, true>(lds, g, S, E);
    }
    xcd_barrier(bar);
    RUN2(6, ph_udot(p, bid, nblk));
    xcd_barrier(bar);
    RUN2(11, ph_act(p, bid, nblk));
    xcd_barrier(bar);
    RUN2(10, ph_vacc(p, bid, nblk));
    xcd_barrier(bar);
    ph_final(p, bid, nblk);
}

extern "C" void kernel_launch(void* const* d_in, const int* in_sizes, int n_in, void* d_out, int out_size, void* d_ws, size_t ws_size, hipStream_t stream) {
    Params p{};
    p.x = (const float*)d_in[0]; p.c = (const float*)d_in[1]; p.pos = (const int*)d_in[2]; p.w_ada = (const float*)d_in[3]; p.b_ada = (const float*)d_in[4];
    p.w_in = (const float*)d_in[5]; p.b_in = (const float*)d_in[6]; p.w_four = (const float*)d_in[7]; p.w_out = (const float*)d_in[8]; p.b_out = (const float*)d_in[9];
    p.g1 = (const float*)d_in[10]; p.be1 = (const float*)d_in[11]; p.w_pq = (const float*)d_in[12]; p.subk = (const float*)d_in[13]; p.pu = (const float*)d_in[14]; p.pv = (const float*)d_in[15];
    p.g2 = (const float*)d_in[16]; p.be2 = (const float*)d_in[17]; p.out = (float*)d_out; p.ws = (unsigned char*)d_ws;
    static int grid_blocks = 0;
    if (grid_blocks == 0) {
        if (ws_size < WS_END) { fprintf(stderr, "workspace too small: %zu < %zu\n", ws_size, (size_t)WS_END); grid_blocks = -1; return; }
        int dev = 0, cus = 0, per_cu = 0;
        if (hipGetDevice(&dev) != hipSuccess || hipDeviceGetAttribute(&cus, hipDeviceAttributeMultiprocessorCount, dev) != hipSuccess) { grid_blocks = -1; return; }
        if (hipFuncSetAttribute((const void*)mega, hipFuncAttributeMaxDynamicSharedMemorySize, LDS_BYTES) != hipSuccess) { fprintf(stderr, "hipFuncSetAttribute failed\n"); grid_blocks = -1; return; }
        if (hipOccupancyMaxActiveBlocksPerMultiprocessor(&per_cu, (const void*)mega, NTHREADS, LDS_BYTES) != hipSuccess || per_cu < 1) { fprintf(stderr, "occupancy query: %d\n", per_cu); grid_blocks = -1; return; }
        if (cus < 256) { fprintf(stderr, "this kernel needs 256 CUs (one workgroup per CU, 256 workgroups); device has %d\n", cus); grid_blocks = -1; return; }
        grid_blocks = 256;
    }
    if (grid_blocks < 0) return;
    if (hipMemsetAsync((char*)d_ws + WS_CTL, 0, CTL_ZERO_BYTES, stream) != hipSuccess) { fprintf(stderr, "memset failed\n"); return; }
    void* args[] = {&p};
    hipError_t e = hipLaunchCooperativeKernel((void*)mega, dim3(grid_blocks), dim3(NTHREADS), args, LDS_BYTES, stream);
    if (e != hipSuccess) fprintf(stderr, "cooperative launch failed: %s (grid %d)\n", hipGetErrorString(e), grid_blocks);
}
```

```cpp
#include <hip/hip_runtime.h>
#include <hip/hip_cooperative_groups.h>
#include <cstdio>
#include <cstdint>
#include <cmath>
namespace cg = cooperative_groups;

namespace pg8 {
#define PG8_LAS __attribute__((address_space(3)))
typedef unsigned short bf16_t;
typedef short bf16x8 __attribute__((ext_vector_type(8)));
typedef float f32x4 __attribute__((ext_vector_type(4)));
typedef unsigned u32x4 __attribute__((ext_vector_type(4)));
constexpr int BM = 256, BK = 64, HALF = 128, HTB = HALF * BK * 2  , STAGE_BYTES = 8 * HTB, NXCD = 8, WGM = 8;

__host__ __device__ __forceinline__ int lds_byte(int r, int c) { const int st = (r >> 4) * 2 + (c >> 5), rr = r & 15, cc = c & 31, ob = rr * 64 + cc * 2; return st * 1024 + (ob ^ (((ob >> 9) & 1) << 5)); }
__host__ __device__ __forceinline__ void stage_rc(int b, int& R, int& C) { const int st = b / 1024, sb = b % 1024, swz = sb ^ (((sb >> 9) & 1) << 5); R = (st >> 1) * 16 + swz / 64; C = (st & 1) * 32 + (swz % 64) / 2; }
__host__ __device__ __forceinline__ int perm32(int rho) { const int n = rho >> 4, i = rho & 15; return 8 * (i >> 2) + 4 * n + (i & 3); }

struct Unit { int pm, pn; };
struct Gemm { const bf16_t* A; const bf16_t* Bt; int M, N, K; };

struct StaticOrder {
    int nM, nN, nwg, G, c;
    __host__ __device__ void init(int M, int N, int G_, int c_) { nM = M / BM; nN = N / BM; nwg = nM * nN; G = G_; c = c_; }
    __host__ __device__ bool next(int i, Unit& u) const {
        const long L = (long)i * G + c; if (L >= nwg) return false;
        int wgid = (int)L; { const int q = nwg / NXCD, r = nwg % NXCD, xcd = wgid % NXCD, off = wgid / NXCD; wgid = (xcd < r ? xcd * (q + 1) : r * (q + 1) + (xcd - r) * q) + off; }
        const int nig = WGM * nN, gid = wgid / nig, fm = gid * WGM, gsz = (nM - fm) < WGM ? (nM - fm) : WGM;
        u.pm = fm + ((wgid % nig) % gsz); u.pn = (wgid % nig) / gsz; return true;
    }
    __device__ __forceinline__ void a_ready(const Unit&) const {}
    __device__ __forceinline__ void done(const Unit&) const {}
};

__device__ __forceinline__ unsigned cvt_pk_bf16(float lo, float hi) { unsigned r; asm volatile("v_cvt_pk_bf16_f32 %0, %1, %2" : "=v"(r) : "v"(lo), "v"(hi)); return r; }
typedef float f32x2 __attribute__((ext_vector_type(2)));
__device__ __forceinline__ f32x2 gelu_pk(f32x2 v) {
    const f32x2 av = __builtin_elementwise_abs(v), d = av * 0.2316418882f + 1.0f;
    f32x2 t; t.x = __builtin_amdgcn_rcpf(d.x); t.y = __builtin_amdgcn_rcpf(d.y);
    f32x2 q = t * 0.5307027145f + (-0.7265760135f); q = q * t + 0.7107068705f; q = q * t + (-0.142248368f); q = q * t + 0.127414796f; q = q * t;
    const f32x2 s = (v * v) * (-0.72134752044f);
    f32x2 e; e.x = __builtin_amdgcn_exp2f(s.x); e.y = __builtin_amdgcn_exp2f(s.y);
    const f32x2 m = v * (q * e), r = v - m;
    f32x2 o; o.x = v.x < 0.f ? m.x : r.x; o.y = v.y < 0.f ? m.y : r.y; return o;
}

template <int ACT  > struct EpiBf16 {
    static constexpr bool PERM = true, AFTER_DRAIN = false; static_assert(ACT == 0 || ACT == 1, "EpiBf16: ACT is 0 (none) or 1 (gelu_pk)");
    bf16_t* O; int ldc; const float* bias; int split_cols; size_t split_stride; float scale0;
    __device__ __forceinline__ void operator()(const f32x4 (&acc)[2][2][4][2], const Unit& u, int wr, int wc, int fr, int fq) const {
        const int row0 = u.pm * BM + wr * 64 + fr; int colt = u.pn * BM; bf16_t* base = O;
        float sc = 1.f; if (split_cols) { const int t = colt / split_cols; base += (size_t)t * split_stride; colt -= t * split_cols; if (t == 0) sc = scale0; }
        const int col0 = colt + wc * 32 + 8 * fq, bcol0 = u.pn * BM + wc * 32 + 8 * fq;
        f32x4 bv[2][2];
#pragma unroll
        for (int bj = 0; bj < 2; ++bj)
#pragma unroll
            for (int n = 0; n < 2; ++n) bv[bj][n] = bias ? *(const f32x4*)(bias + bcol0 + bj * HALF + 4 * n) : (f32x4){0.f, 0.f, 0.f, 0.f};
#pragma unroll
        for (int ai = 0; ai < 2; ++ai)
#pragma unroll
            for (int m = 0; m < 4; ++m) { bf16_t* rowp = base + (size_t)(row0 + ai * HALF + m * 16) * ldc + col0;
#pragma unroll
                for (int bj = 0; bj < 2; ++bj) { f32x4 v0 = acc[ai][bj][m][0] + bv[bj][0], v1 = acc[ai][bj][m][1] + bv[bj][1];
                    if (ACT == 1) { f32x2 a = gelu_pk((f32x2){v0[0], v0[1]}), b = gelu_pk((f32x2){v0[2], v0[3]}), c = gelu_pk((f32x2){v1[0], v1[1]}), d = gelu_pk((f32x2){v1[2], v1[3]});
                        v0 = (f32x4){a.x, a.y, b.x, b.y}; v1 = (f32x4){c.x, c.y, d.x, d.y}; }
                    v0 = v0 * sc; v1 = v1 * sc; u32x4 w; w.x = cvt_pk_bf16(v0[0], v0[1]); w.y = cvt_pk_bf16(v0[2], v0[3]); w.z = cvt_pk_bf16(v1[0], v1[1]); w.w = cvt_pk_bf16(v1[2], v1[3]);
                    *(u32x4*)(rowp + bj * HALF) = w; } }
    }
};
template <class Epi, class Sched, bool ALIGN_EPI = false, bool SP2 = false>
__device__ __forceinline__ void gemm_phase(PG8_LAS unsigned char* lds, const Gemm g, const Sched& S, const Epi& E) {
    int tid_ = threadIdx.x; asm volatile("" : "+v"(tid_)); const int tid = tid_, wid = __builtin_amdgcn_readfirstlane(tid >> 6), lane = tid & 63, wr = wid >> 2, wc = wid & 3, fr = lane & 15, fq = lane >> 4;
    const int K = g.K, nt = K / BK;
    unsigned voffA[2], voffB[2];
#pragma unroll
    for (int i = 0; i < 2; ++i) { int R, C; stage_rc(tid * 16 + i * 8192, R, C); const int Rb = Epi::PERM ? ((R & ~31) + perm32(R & 31)) : R;
        voffA[i] = (unsigned)(R * K + C) * 2u; voffB[i] = (unsigned)(Rb * K + C) * 2u; }
    const size_t kstep = (size_t)(BK * 2);
    const size_t hstep = (size_t)HALF * K * 2;
    const size_t tstep = 2 * hstep;
    const unsigned ldsw = (unsigned)wid * 1024u;
    const int aoff = lds_byte(wr * 64 + fr, fq * 8), boff = lds_byte(wc * 32 + fr, fq * 8);
#define PG8_SA(b, h) (((b) * 2 + (h)) * HTB)
#define PG8_SB(b, h) ((4 + (b) * 2 + (h)) * HTB)
#define PG8_STAGE(bufoff, gbase, voff) do { _Pragma("unroll") for (int _i = 0; _i < 2; ++_i) \
        __builtin_amdgcn_global_load_lds((const unsigned*)((const char*)(gbase) + (voff)[_i]), (PG8_LAS unsigned*)(lds + (bufoff) + ldsw + _i * 8192), 16, 0, 0); } while (0)
#define PG8_LDA(dst, b, h) do { _Pragma("unroll") for (int m = 0; m < 4; ++m) _Pragma("unroll") for (int k = 0; k < 2; ++k) dst[m][k] = *(const PG8_LAS bf16x8*)(lds + PG8_SA(b, h) + aoff + m * 2048 + k * 1024); } while (0)
#define PG8_LDB(dst, b, h) do { _Pragma("unroll") for (int n = 0; n < 2; ++n) _Pragma("unroll") for (int k = 0; k < 2; ++k) dst[n][k] = *(const PG8_LAS bf16x8*)(lds + PG8_SB(b, h) + boff + n * 2048 + k * 1024); } while (0)
#define PG8_MMA(ai, bj, At, Bt) do { __builtin_amdgcn_s_setprio(1); _Pragma("unroll") for (int m = 0; m < 4; ++m) _Pragma("unroll") for (int n = 0; n < 2; ++n) _Pragma("unroll") for (int k = 0; k < 2; ++k) \
        acc[ai][bj][m][n] = __builtin_amdgcn_mfma_f32_16x16x32_bf16(Bt[n][k], At[m][k], acc[ai][bj][m][n], 0, 0, 0); __builtin_amdgcn_s_setprio(0); } while (0)
#define PG8_WAIT_V(n) asm volatile("s_waitcnt vmcnt(" #n ")" ::: "memory")
#define PG8_WAIT_L(n) asm volatile("s_waitcnt lgkmcnt(" #n ")" ::: "memory")
#define PG8_BAR __builtin_amdgcn_s_barrier()
#define PG8_SCHED __builtin_amdgcn_sched_barrier(0)
    Unit cur, nxt; int ui = 0;
    if (!S.next(0, cur)) return;
    f32x4 acc[2][2][4][2];
#pragma unroll
    for (int a = 0; a < 2; ++a)
#pragma unroll
        for (int b = 0; b < 2; ++b)
#pragma unroll
            for (int m = 0; m < 4; ++m)
#pragma unroll
                for (int n = 0; n < 2; ++n) acc[a][b][m][n] = (f32x4){0.f, 0.f, 0.f, 0.f};
    bf16x8 At[4][2], B0[2][2], B1[2][2];
    const char* cA = (const char*)g.A + (size_t)cur.pm * tstep; const char* cB = (const char*)g.Bt + (size_t)cur.pn * tstep;
    S.a_ready(cur);
    if constexpr (SP2) {
        PG8_STAGE(PG8_SB(0, 0), cB, voffB); PG8_STAGE(PG8_SB(0, 1), cB + hstep, voffB); PG8_STAGE(PG8_SA(0, 0), cA, voffA); PG8_STAGE(PG8_SA(0, 1), cA + hstep, voffA);
        if (wr == 1) PG8_BAR;
        PG8_WAIT_V(2); PG8_BAR;
        PG8_STAGE(PG8_SB(1, 0), cB + kstep, voffB); PG8_STAGE(PG8_SA(1, 0), cA + kstep, voffA); PG8_STAGE(PG8_SB(1, 1), cB + hstep + kstep, voffB);
        PG8_WAIT_V(6); PG8_BAR;
    } else {
        PG8_STAGE(PG8_SB(0, 0), cB, voffB); PG8_STAGE(PG8_SA(0, 0), cA, voffA); PG8_STAGE(PG8_SB(0, 1), cB + hstep, voffB); PG8_STAGE(PG8_SA(0, 1), cA + hstep, voffA);
        if (wr == 1) PG8_BAR;
        PG8_WAIT_V(4); PG8_BAR;
        PG8_STAGE(PG8_SB(1, 0), cB + kstep, voffB); PG8_STAGE(PG8_SA(1, 0), cA + kstep, voffA); PG8_STAGE(PG8_SB(1, 1), cB + hstep + kstep, voffB);
        PG8_WAIT_V(6); PG8_BAR;
    }
    for (;;) {
        const bool has_next = S.next(ui + 1, nxt);
        const char* nA = has_next ? (const char*)g.A + (size_t)nxt.pm * tstep : cA; const char* nB = has_next ? (const char*)g.Bt + (size_t)nxt.pn * tstep : cB;
        for (int t = 0; t < nt; t += 2) {
            const bool last = (t == nt - 2);
            const char* a1 = cA + (size_t)(t + 1) * kstep;
            const char* a2 = last ? nA : cA + (size_t)(t + 2) * kstep; const char* b2 = last ? nB : cB + (size_t)(t + 2) * kstep;
            const char* a3 = a2 + kstep; const char* b3 = b2 + kstep;
            if (last && has_next) S.a_ready(nxt);
            if constexpr (SP2) {
            PG8_LDB(B0, 0, 0); PG8_LDB(B1, 0, 1); PG8_SCHED; PG8_LDA(At, 0, 0); PG8_STAGE(PG8_SA(1, 1), a1 + hstep, voffA);
            PG8_WAIT_V(8); PG8_WAIT_L(0); PG8_BAR; PG8_MMA(0, 0, At, B0); PG8_MMA(0, 1, At, B1); PG8_BAR; PG8_SCHED;
            PG8_LDA(At, 0, 1); PG8_STAGE(PG8_SB(0, 0), b2, voffB); PG8_STAGE(PG8_SB(0, 1), b2 + hstep, voffB); PG8_STAGE(PG8_SA(0, 0), a2, voffA);
            PG8_WAIT_V(8); PG8_WAIT_L(0); PG8_BAR; PG8_MMA(1, 0, At, B0); PG8_MMA(1, 1, At, B1); PG8_BAR; PG8_SCHED;
            PG8_LDB(B0, 1, 0); PG8_LDB(B1, 1, 1); PG8_SCHED; PG8_LDA(At, 1, 0); PG8_STAGE(PG8_SA(0, 1), a2 + hstep, voffA);
            PG8_WAIT_V(8); PG8_WAIT_L(0); PG8_BAR; PG8_MMA(0, 0, At, B0); PG8_MMA(0, 1, At, B1); PG8_BAR; PG8_SCHED;
            PG8_LDA(At, 1, 1); PG8_STAGE(PG8_SB(1, 0), b3, voffB); PG8_STAGE(PG8_SB(1, 1), b3 + hstep, voffB); PG8_STAGE(PG8_SA(1, 0), a3, voffA);
            PG8_WAIT_V(8); PG8_WAIT_L(0); PG8_BAR; PG8_MMA(1, 0, At, B0); PG8_MMA(1, 1, At, B1); PG8_BAR; PG8_SCHED;
            } else {
            PG8_LDB(B0, 0, 0); PG8_SCHED; PG8_LDA(At, 0, 0); PG8_STAGE(PG8_SA(1, 1), a1 + hstep, voffA);
            PG8_WAIT_L(8); PG8_BAR; PG8_WAIT_L(0); PG8_MMA(0, 0, At, B0); PG8_BAR; PG8_SCHED;
            PG8_LDB(B1, 0, 1); PG8_STAGE(PG8_SB(0, 0), b2, voffB);
            PG8_BAR; PG8_WAIT_L(0); PG8_MMA(0, 1, At, B1); PG8_BAR;
            PG8_LDA(At, 0, 1); PG8_STAGE(PG8_SA(0, 0), a2, voffA);
            PG8_BAR; PG8_WAIT_L(0); PG8_MMA(1, 0, At, B0); PG8_BAR; PG8_SCHED;
            PG8_STAGE(PG8_SB(0, 1), b2 + hstep, voffB);
            PG8_WAIT_V(6); PG8_BAR; PG8_MMA(1, 1, At, B1); PG8_BAR;
            PG8_LDB(B0, 1, 0); PG8_SCHED; PG8_LDA(At, 1, 0); PG8_STAGE(PG8_SA(0, 1), a2 + hstep, voffA);
            PG8_WAIT_L(8); PG8_BAR; PG8_WAIT_L(0); PG8_MMA(0, 0, At, B0); PG8_BAR; PG8_SCHED;
            PG8_LDB(B1, 1, 1); PG8_STAGE(PG8_SB(1, 0), b3, voffB);
            PG8_BAR; PG8_WAIT_L(0); PG8_MMA(0, 1, At, B1); PG8_BAR;
            PG8_LDA(At, 1, 1); PG8_STAGE(PG8_SA(1, 0), a3, voffA);
            PG8_BAR; PG8_WAIT_L(0); PG8_MMA(1, 0, At, B0); PG8_BAR; PG8_SCHED;
            PG8_STAGE(PG8_SB(1, 1), b3 + hstep, voffB);
            PG8_WAIT_V(6); PG8_BAR; PG8_MMA(1, 1, At, B1); PG8_BAR;
            }
        }
        if constexpr (ALIGN_EPI) { if (wr == 0) PG8_BAR; }
        if constexpr (!Epi::AFTER_DRAIN) { E(acc, cur, wr, wc, fr, fq); S.done(cur); }
        if (!has_next) break;
#pragma unroll
        for (int a = 0; a < 2; ++a)
#pragma unroll
            for (int b = 0; b < 2; ++b)
#pragma unroll
                for (int m = 0; m < 4; ++m)
#pragma unroll
                    for (int n = 0; n < 2; ++n) acc[a][b][m][n] = (f32x4){0.f, 0.f, 0.f, 0.f};
        cur = nxt; cA = nA; cB = nB; ++ui;
        if constexpr (ALIGN_EPI) { if (wr == 1) PG8_BAR; }
    }
    PG8_WAIT_V(0);
    if constexpr (!ALIGN_EPI) { if (wr == 0) PG8_BAR; }
    PG8_BAR;
    if constexpr (Epi::AFTER_DRAIN) { E.fused(acc, cur, wr, wc, fr, fq, lds, wid, lane); S.done(cur); }
#undef PG8_SA
#undef PG8_SB
#undef PG8_STAGE
#undef PG8_LDA
#undef PG8_LDB
#undef PG8_MMA
#undef PG8_WAIT_V
#undef PG8_WAIT_L
#undef PG8_BAR
#undef PG8_SCHED
}
}

#define LAS __attribute__((address_space(3)))
#define GAS __attribute__((address_space(1)))
#define XB_TMO      128
#define XB_XCNT(j)  (256  + 64 * (j))
#define XB_XSUB(j)  (1280 + 64 * (j))
#define XB_XGEN(j)  (2304 + 64 * (j))
#define XB_TOP      3328
#define XB_TOPGEN   3392
#define XCD_BAR_WORDS 3456
#define XB_SPIN_CAP (1u << 18)

__device__ __forceinline__ unsigned xb_ld(unsigned* p)              { return __hip_atomic_load(p, __ATOMIC_RELAXED, __HIP_MEMORY_SCOPE_AGENT); }
__device__ __forceinline__ unsigned xb_add(unsigned* p, unsigned v) { return __hip_atomic_fetch_add(p, v, __ATOMIC_RELAXED, __HIP_MEMORY_SCOPE_AGENT); }
__device__ __forceinline__ unsigned xb_xcc_id() { return (unsigned)__builtin_amdgcn_s_getreg((3 << 11) | 20) & 0xFu; }
#define XB_SPIN(cond, bar) do { unsigned _sp = 0; while (cond) { __builtin_amdgcn_s_sleep(1); \
    if ((++_sp & 255u) == 0u) { if (xb_ld(&(bar)[XB_TMO])) break; if (_sp > XB_SPIN_CAP) { atomicAdd(&(bar)[XB_TMO], 1u); break; } } } } while (0)

struct XcdBarrier {
    unsigned* bar; unsigned x;
    volatile LAS unsigned* st;
};

__device__ __forceinline__ XcdBarrier xcd_barrier_post(unsigned* bar, volatile LAS unsigned* st) {
    XcdBarrier b; b.bar = bar; b.x = xb_xcc_id(); b.st = st;
    if (threadIdx.x == 0) st[2] = xb_add(&bar[XB_XCNT(b.x)], 1u);
    return b;
}
__device__ __forceinline__ void xcd_barrier_complete(unsigned* bar, unsigned x, unsigned& nloc, unsigned& nx, unsigned& xidx, unsigned& uni) {
    const unsigned G = gridDim.x * gridDim.y * gridDim.z;
    unsigned sum, cnt, mine, sp = 0u, below, even;
    for (;;) {
        sum = 0u; cnt = 0u; mine = 0u; below = 0u; even = 1u;
#pragma unroll
        for (unsigned j = 0; j < 16; ++j) { const unsigned c = xb_ld(&bar[XB_XCNT(j)]); sum += c; cnt += (c > 0u) ? 1u : 0u; mine = (j == x) ? c : mine;
            below += (c > 0u && j < x) ? 1u : 0u; even &= (c == 0u || c * 8u == G) ? 1u : 0u; }
        if (sum == G) break;
        __builtin_amdgcn_s_sleep(1);
        if ((++sp & 255u) == 0u) { if (xb_ld(&bar[XB_TMO])) break; if (sp > XB_SPIN_CAP) { atomicAdd(&bar[XB_TMO], 1u); break; } }
    }
    nloc = mine > 0u ? mine : 1u; nx = cnt > 0u ? cnt : 1u;
    xidx = below; uni = (sum == G && cnt == 8u && even) ? 1u : 0u;
}

__device__ __forceinline__ void xcd_barrier(const XcdBarrier& b) {
    asm volatile("s_waitcnt vmcnt(0)" ::: "memory");
    __syncthreads();
    if (threadIdx.x == 0) {
        unsigned* bar = b.bar;
        __builtin_amdgcn_s_waitcnt(0);
        unsigned nloc = b.st[0], nx = b.st[1];
        if (nloc == 0u) { unsigned xidx, uni; xcd_barrier_complete(bar, b.x, nloc, nx, xidx, uni); b.st[0] = nloc; b.st[1] = nx; b.st[3] = xidx; b.st[4] = uni; }
        const unsigned old = xb_add(&bar[XB_XSUB(b.x)], 1u);
        const unsigned gen = old / nloc;
        if (old + 1u == (gen + 1u) * nloc) {
            __builtin_amdgcn_fence(__ATOMIC_RELEASE, "agent");
            asm volatile("s_waitcnt vmcnt(0)" ::: "memory");
            const unsigned og = xb_add(&bar[XB_TOP], 1u);
            const unsigned tg = og / nx;
            if (og + 1u == (tg + 1u) * nx) xb_add(&bar[XB_TOPGEN], 1u);
            else XB_SPIN(xb_ld(&bar[XB_TOPGEN]) == tg, bar);
            __builtin_amdgcn_fence(__ATOMIC_ACQUIRE, "agent");
            xb_add(&bar[XB_XGEN(b.x)], 1u);
            asm volatile("s_waitcnt vmcnt(0)" ::: "memory");
        } else {
            XB_SPIN(xb_ld(&bar[XB_XGEN(b.x)]) == gen, bar);
            __builtin_amdgcn_fence(__ATOMIC_ACQUIRE, "agent");
            asm volatile("s_waitcnt vmcnt(0)" ::: "memory");
        }
    }
    __syncthreads();
}

__device__ __forceinline__ void xcd_local_barrier(const XcdBarrier& b) {
    asm volatile("s_waitcnt vmcnt(0)" ::: "memory");
    __syncthreads();
    if (threadIdx.x == 0) {
        unsigned* bar = b.bar;
        __builtin_amdgcn_s_waitcnt(0);
        const unsigned nloc = b.st[0];
        const unsigned old = xb_add(&bar[XB_XSUB(b.x)], 1u);
        const unsigned gen = old / nloc;
        if (old + 1u == (gen + 1u) * nloc) xb_add(&bar[XB_XGEN(b.x)], 1u);
        else XB_SPIN(xb_ld(&bar[XB_XGEN(b.x)]) == gen, bar);
        __builtin_amdgcn_fence(__ATOMIC_ACQUIRE, "agent");
        asm volatile("s_waitcnt vmcnt(0)" ::: "memory");
    }
    __syncthreads();
}

constexpr int DM = 1024, NB = 2, SEQ = 8192, NT = NB * SEQ;
constexpr int NTHREADS = 512, NWAVES = 8;
constexpr float LN_EPS = 1e-5f;
constexpr float ALPHA = 1.189207115002721f;
typedef unsigned short bf16;
typedef unsigned v4u __attribute__((ext_vector_type(4)));
typedef unsigned v2u __attribute__((ext_vector_type(2)));
typedef float f32x4 __attribute__((ext_vector_type(4)));
typedef short bf16x8_t __attribute__((ext_vector_type(8)));

constexpr size_t MiB = 1u << 20, KiB = 1u << 10;
constexpr size_t WS_CTL = 0, CTL_ZERO_BYTES = 1 * MiB;
constexpr size_t WS_MOD = 1 * MiB + 768 * KiB;
constexpr size_t WS_MMAT = 1 * MiB;
constexpr size_t WS_ROPE = 2 * MiB;
constexpr size_t WS_WIN = 6 * MiB, WS_WOUT = 12 * MiB, WS_WPQ = 14 * MiB, WS_MISC = 16 * MiB, WS_SUBK = 17 * MiB;
constexpr size_t WS_XN = 18 * MiB;
constexpr size_t WS_FZ = 50 * MiB;
constexpr size_t WS_QB = 66 * MiB, WS_KB = 90 * MiB, WS_VB = 114 * MiB, WS_O3 = 138 * MiB, WS_LSE = 162 * MiB;
constexpr size_t WS_H2Q = 50 * MiB, WS_HS = 66 * MiB, WS_WQ = 67 * MiB, WS_WSC = 69 * MiB, WS_SUA = 75 * MiB, WS_X1 = 83 * MiB;
constexpr size_t WS_Y1 = 116 * MiB, WS_PQ = 116 * MiB, WS_PART = 116 * MiB, WS_Y = 116 * MiB;
constexpr size_t WS_IDS = 180 * MiB, WS_GATES = 188 * MiB;
constexpr size_t WS_TU8 = 200 * MiB, WS_TV8 = 216 * MiB, WS_SU = 232 * MiB, WS_SV = 232 * MiB + 512 * KiB, WS_END = 233 * MiB;
constexpr float QSCALE = 0.125f * 1.4426950408889634f;
constexpr int NIN = 2816;
constexpr int CW_MDONE = 8192;
constexpr int CW_MG = 8448;
constexpr int CW_MODD = 8768;
constexpr int CW_BAR = 4096;

constexpr int RING_BYTES = 131072, LDSCTL_OFF = RING_BYTES, MISC_OFF = LDSCTL_OFF + 320, LDS_BYTES = 147456;

struct Params {
    const float* x; const float* c; const int* pos; const float* w_ada; const float* b_ada; const float* w_in; const float* b_in;
    const float* w_four; const float* w_out; const float* b_out; const float* g1; const float* be1; const float* w_pq; const float* subk;
    const float* pu; const float* pv; const float* g2; const float* be2; float* out; unsigned char* ws;
};

__device__ __forceinline__ unsigned f2bf(float f) { unsigned u = __builtin_bit_cast(unsigned, f); return (u + 0x7fffu + ((u >> 16) & 1u)) >> 16; }
__device__ __forceinline__ unsigned pk2(float lo, float hi) { return f2bf(lo) | (f2bf(hi) << 16); }
__device__ __forceinline__ float wave_sum(float v) {
    v += __builtin_bit_cast(float, __builtin_amdgcn_update_dpp(0, __builtin_bit_cast(int, v), 0xB1, 0xf, 0xf, true));
    v += __builtin_bit_cast(float, __builtin_amdgcn_update_dpp(0, __builtin_bit_cast(int, v), 0x4E, 0xf, 0xf, true));
    v += __builtin_bit_cast(float, __builtin_amdgcn_update_dpp(0, __builtin_bit_cast(int, v), 0x141, 0xf, 0xf, true));
    v += __builtin_bit_cast(float, __builtin_amdgcn_update_dpp(0, __builtin_bit_cast(int, v), 0x140, 0xf, 0xf, true));
    v += __builtin_bit_cast(float, __builtin_amdgcn_update_dpp(0, __builtin_bit_cast(int, v), 0x142, 0xa, 0xf, false));
    v += __builtin_bit_cast(float, __builtin_amdgcn_update_dpp(0, __builtin_bit_cast(int, v), 0x143, 0xc, 0xf, false));
    return __builtin_bit_cast(float, __builtin_amdgcn_readlane(__builtin_bit_cast(int, v), 63));
}
__device__ __forceinline__ float wave_max(float v) {
    const int ninf = (int)0xff7fffffu;
    v = fmaxf(v, __builtin_bit_cast(float, __builtin_amdgcn_update_dpp(ninf, __builtin_bit_cast(int, v), 0xB1, 0xf, 0xf, false)));
    v = fmaxf(v, __builtin_bit_cast(float, __builtin_amdgcn_update_dpp(ninf, __builtin_bit_cast(int, v), 0x4E, 0xf, 0xf, false)));
    v = fmaxf(v, __builtin_bit_cast(float, __builtin_amdgcn_update_dpp(ninf, __builtin_bit_cast(int, v), 0x141, 0xf, 0xf, false)));
    v = fmaxf(v, __builtin_bit_cast(float, __builtin_amdgcn_update_dpp(ninf, __builtin_bit_cast(int, v), 0x140, 0xf, 0xf, false)));
    v = fmaxf(v, __builtin_bit_cast(float, __builtin_amdgcn_update_dpp(ninf, __builtin_bit_cast(int, v), 0x142, 0xa, 0xf, false)));
    v = fmaxf(v, __builtin_bit_cast(float, __builtin_amdgcn_update_dpp(ninf, __builtin_bit_cast(int, v), 0x143, 0xc, 0xf, false)));
    return __builtin_bit_cast(float, __builtin_amdgcn_readlane(__builtin_bit_cast(int, v), 63));
}
#define LDS_WAIT() asm volatile("s_waitcnt lgkmcnt(0)" ::: "memory")
__device__ __forceinline__ int opaque_tid() { int t = threadIdx.x; asm volatile("" : "+v"(t)); return t; }
__device__ __forceinline__ int wave_id() { return __builtin_amdgcn_readfirstlane(opaque_tid() >> 6); }
__device__ __forceinline__ float bflo(unsigned u) { return __builtin_bit_cast(float, u << 16); }
__device__ __forceinline__ float bfhi(unsigned u) { return __builtin_bit_cast(float, u & 0xffff0000u); }

template <class SC>
__device__ __forceinline__ void transpose_item(const float* W, int K, int N, bf16* WT, int nout, SC srccol, LAS float* scr, int item, int lane) {
    const int nblk = nout / 32, kb = item / nblk, nb = item % nblk, k0 = 64 * kb, n0 = 32 * nb;
    const int sc = srccol(n0 + (lane & 31));
#pragma unroll 8
    for (int i = 0; i < 32; ++i) { const int kk = 2 * i + (lane >> 5); scr[kk * 33 + (lane & 31)] = W[(size_t)(k0 + kk) * N + sc]; }
    LDS_WAIT(); asm volatile("" ::: "memory");
    const int c = lane & 7;
#pragma unroll
    for (int j = 0; j < 4; ++j) { const int n = (lane >> 3) + 8 * j; const LAS float* s = scr + (8 * c) * 33 + n;
        v4u o; o.x = pk2(s[0 * 33], s[1 * 33]); o.y = pk2(s[2 * 33], s[3 * 33]); o.z = pk2(s[4 * 33], s[5 * 33]); o.w = pk2(s[6 * 33], s[7 * 33]);
        *(v4u*)(WT + (size_t)(n0 + n) * K + k0 + 8 * c) = o; }
    LDS_WAIT(); asm volatile("" ::: "memory");
}
__device__ __forceinline__ void ph_prologue(const Params& p, LAS unsigned char* lds, int bid, int nblk) {
    const int tid = opaque_tid(), lane = tid & 63, wave = __builtin_amdgcn_readfirstlane(tid >> 6);
    {
        LAS float* M = (LAS float*)lds; LAS float* Wl = (LAS float*)(lds + 32768);
        bf16* WT = (bf16*)(p.ws + WS_WIN); float* biasf = (float*)(p.ws + WS_MISC); const float* MM = (const float*)(p.ws + WS_MMAT);
        const bool fallback = !(nblk > 192);
        for (int it = bid; it < 256; it += nblk) {
            const int g = it & 3, kb = it >> 2, k0 = kb * 16;
            __syncthreads();
            if (fallback) { const float norm = 1.0f / sqrtf(8192.0f * 64.0f);
                for (int e = tid; e < 8192; e += NTHREADS) { const int c = e >> 7, nl = e & 127; float a = 0.f;
                    for (int cp = 0; cp < 64; ++cp) { const float ang = 2.0f * (float)((c * cp) & 63) / 64.0f; a += ((nl & 1) ? -sinpif(ang) : cospif(ang)) * p.w_four[(g * 64 + cp) * 64 + (nl >> 1)]; }
                    M[e] = a * norm; } }
            else {
                if (tid == 0) { unsigned* cw = (unsigned*)(p.ws + WS_CTL) + CW_MG + 64 * g; unsigned* tmo = (unsigned*)(p.ws + WS_CTL) + CW_BAR;
                    XB_SPIN(xb_ld(cw) < 16u, tmo);
                    __builtin_amdgcn_fence(__ATOMIC_ACQUIRE, "agent"); asm volatile("s_waitcnt vmcnt(0)" ::: "memory"); }
                __syncthreads();
#pragma unroll
                for (int i = 0; i < 4; ++i) *(LAS f32x4*)(lds + (tid + i * 512) * 16) = *(const f32x4*)(MM + (size_t)g * 8192 + (tid + i * 512) * 4); }
#pragma unroll
            for (int i = 0; i < 2; ++i) { const int e = tid + i * 512, k = e >> 6, c = e & 63; Wl[k * 64 + c] = p.w_in[(size_t)(k0 + k) * 2560 + g * 64 + c]; }
            __syncthreads();
            { const int nl = tid & 127, kq = tid >> 7; float a[4] = {0.f, 0.f, 0.f, 0.f};
              for (int c = 0; c < 64; ++c) { const float mv = M[c * 128 + nl];
#pragma unroll
                  for (int j = 0; j < 4; ++j) a[j] += mv * Wl[(kq * 4 + j) * 64 + c]; }
              *(v2u*)(WT + (size_t)(g * 128 + nl) * DM + k0 + kq * 4) = (v2u){pk2(a[0], a[1]), pk2(a[2], a[3])};
              if (kb == 0 && tid < 128) { float bsum = 0.f; for (int c = 0; c < 64; ++c) bsum += p.b_in[g * 64 + c] * M[c * 128 + nl]; biasf[g * 128 + nl] = bsum; } }
        }
        __syncthreads();
        for (int i = bid * NTHREADS + tid; i < 2304; i += nblk * NTHREADS) biasf[512 + i] = p.b_in[256 + i];
    }
    {
        LAS float* scr = (LAS float*)(lds + wave * 16384);
        const int gw = bid * NWAVES + wave, NGW = nblk * NWAVES;
        constexpr int I_IN = 16 * (2304 / 32), I_O = 16 * 32, I_PQ = 16 * 32;
        for (int it = gw; it < I_IN + I_O + I_PQ; it += NGW) {
            int r = it;
            if (r < I_IN) {
                transpose_item(p.w_in, DM, 2560, (bf16*)(p.ws + WS_WIN) + (size_t)512 * DM, 2304,
                    [](int n) { return n < 1536 ? 256 + (n & ~63) + ((n & 63) >> 1) + 32 * (n & 1) : 256 + n; }, scr, r, lane); continue; } r -= I_IN;
            if (r < I_O) { transpose_item(p.w_out, DM, DM, (bf16*)(p.ws + WS_WOUT), DM, [](int n) { return n; }, scr, r, lane); continue; } r -= I_O;
            transpose_item(p.w_pq, DM, DM, (bf16*)(p.ws + WS_WPQ), DM, [](int n) { return n; }, scr, r, lane);
        }
    }
    { bf16* SK = (bf16*)(p.ws + WS_SUBK);
      for (int ch = bid * NTHREADS + tid; ch < 8 * 2 * 4 * 4 * 64; ch += nblk * NTHREADS) {
          const int ln = ch & 63, d0 = (ch >> 6) & 3, mt = (ch >> 8) & 3, hp = ch >> 10;
          const float* sp = p.subk + ((size_t)hp * 128 + 32 * mt + (ln & 31)) * 64 + 16 * d0 + 8 * (ln >> 5);
          v4u o; o.x = pk2(sp[0], sp[1]); o.y = pk2(sp[2], sp[3]); o.z = pk2(sp[4], sp[5]); o.w = pk2(sp[6], sp[7]);
          *(v4u*)(SK + (size_t)ch * 8) = o; } }
}
__device__ __forceinline__ void ph_mod(const Params& p, LAS unsigned char* lds, int bid, int nblk) {
    const int tid = opaque_tid(), col = tid & 31, kg = tid >> 5;
    LAS float* cond = (LAS float*)lds; LAS float* red = (LAS float*)(lds + 8192);
    float* mod = (float*)(p.ws + WS_MOD);
    for (int i = tid; i < 2 * DM; i += NTHREADS) { const float c = p.c[i]; cond[i] = c / (1.0f + expf(-c)); }
    __syncthreads();
    if (nblk > 192 && bid >= 192) {
        LAS float* T64 = (LAS float*)(lds + 12288);
        if (tid < 64) { T64[tid] = cospif(2.0f * (float)tid / 64.0f); T64[64 + tid] = -sinpif(2.0f * (float)tid / 64.0f); }
        __syncthreads();
        const float norm = 1.0f / sqrtf(8192.0f * 64.0f); float* MM = (float*)(p.ws + WS_MMAT);
        for (int it = bid - 192; it < 64; it += nblk - 192) {
            const int g = it >> 4, c = (it & 15) * 4 + (tid >> 7), nl = tid & 127; float a = 0.f;
#pragma unroll 8
            for (int cp = 0; cp < 64; ++cp) a += T64[(nl & 1) * 64 + ((c * cp) & 63)] * p.w_four[(g * 64 + cp) * 64 + (nl >> 1)];
            __hip_atomic_store(&MM[(g * 64 + c) * 128 + nl], a * norm, __ATOMIC_RELAXED, __HIP_MEMORY_SCOPE_AGENT);
            asm volatile("s_waitcnt vmcnt(0)" ::: "memory");
            __syncthreads();
            if (tid == 0) (void)xb_add((unsigned*)(p.ws + WS_CTL) + CW_MG + 64 * g, 1u);
        }
    }
    for (int it = bid; it < 6144 / 32; it += nblk) {
        const int n = it * 32 + col; float a0 = 0.f, a1 = 0.f;
        const float* wp = p.w_ada + (size_t)(kg * 64) * 6144 + n;
#pragma unroll 16
        for (int k = 0; k < 64; ++k) { const float w = wp[(size_t)k * 6144]; a0 += cond[kg * 64 + k] * w; a1 += cond[DM + kg * 64 + k] * w; }
        red[(kg * 2 + 0) * 32 + col] = a0; red[(kg * 2 + 1) * 32 + col] = a1;
        __syncthreads();
        if (tid < 64) { const int b = tid >> 5; float s = p.b_ada[n];
#pragma unroll
            for (int g = 0; g < 16; ++g) s += red[(g * 2 + b) * 32 + col];
            __hip_atomic_store(&mod[b * 6144 + n], s, __ATOMIC_RELAXED, __HIP_MEMORY_SCOPE_AGENT); }
        asm volatile("s_waitcnt vmcnt(0)" ::: "memory");
        __syncthreads();
        if (tid == 0) (void)xb_add((unsigned*)(p.ws + WS_CTL) + CW_MODD, 1u);
    }
}
__device__ __forceinline__ void ph_xn(const Params& p, int bid, int nblk) {
    const int lane = opaque_tid() & 63, wave = wave_id(); const float* mod = (const float*)(p.ws + WS_MOD); bf16* XN = (bf16*)(p.ws + WS_XN);
    const int stride = nblk * NWAVES; int row = bid * NWAVES + wave; int bcur = -1;
    f32x4 shc[4], scc[4], nx[4];
    if (row < NT) { const f32x4* xr = (const f32x4*)(p.x + (size_t)row * DM) + lane;
#pragma unroll
        for (int j = 0; j < 4; ++j) nx[j] = xr[64 * j]; }
    for (; row < NT; row += stride) {
        const int b = row / SEQ;
        if (b != bcur) { bcur = b;
#pragma unroll
            for (int j = 0; j < 4; ++j) { shc[j] = *((const f32x4*)(mod + b * 6144 + 0) + lane + 64 * j); scc[j] = *((const f32x4*)(mod + b * 6144 + 1024) + lane + 64 * j) + 1.0f; } }
        f32x4 v[4]; float s = 0.f;
#pragma unroll
        for (int j = 0; j < 4; ++j) { v[j] = nx[j]; s += (v[j].x + v[j].y) + (v[j].z + v[j].w); }
        if (row + stride < NT) { const f32x4* xr = (const f32x4*)(p.x + (size_t)(row + stride) * DM) + lane;
#pragma unroll
            for (int j = 0; j < 4; ++j) nx[j] = xr[64 * j]; }
        const float mean = wave_sum(s) * (1.f / DM); float s2 = 0.f;
#pragma unroll
        for (int j = 0; j < 4; ++j) { v[j] = v[j] - mean; s2 += (v[j].x * v[j].x + v[j].y * v[j].y) + (v[j].z * v[j].z + v[j].w * v[j].w); }
        const float rstd = rsqrtf(wave_sum(s2) * (1.f / DM) + LN_EPS);
        unsigned long long* o8 = (unsigned long long*)(XN + (size_t)row * DM) + lane;
#pragma unroll
        for (int j = 0; j < 4; ++j) {
            const f32x4 o = v[j] * rstd * scc[j] + shc[j];
            o8[64 * j] = (unsigned long long)pk2(o.x, o.y) | ((unsigned long long)pk2(o.z, o.w) << 32);
        }
    }
}

struct EpiOut {
    static constexpr bool PERM = true, AFTER_DRAIN = false;
    bf16* Y1; const float* x; const float* mod; const float* bo; unsigned* mdone; unsigned need;
    __device__ __forceinline__ void operator()(const pg8::f32x4 (&acc)[2][2][4][2], const pg8::Unit& u, int wr, int wc, int fr, int fq) const {
        { unsigned sp = 0u; while (__hip_atomic_load(mdone, __ATOMIC_RELAXED, __HIP_MEMORY_SCOPE_AGENT) < need) { __builtin_amdgcn_s_sleep(2); if (++sp > (1u << 20)) break; } }
        const int row0 = u.pm * 256 + wr * 64 + fr;
#pragma unroll
        for (int bj = 0; bj < 2; ++bj) {
            const int c0 = u.pn * 256 + bj * 128 + wc * 32 + 8 * fq;
            const pg8::f32x4 b0 = *(const pg8::f32x4*)(bo + c0), b1 = *(const pg8::f32x4*)(bo + c0 + 4);
#pragma unroll
            for (int ai = 0; ai < 2; ++ai) {
                const int bb = (u.pm * 256 + ai * 128) >> 13;
                const pg8::f32x4 g0 = *(const pg8::f32x4*)(mod + bb * 6144 + 2048 + c0) + 1.0f, g1 = *(const pg8::f32x4*)(mod + bb * 6144 + 2048 + c0 + 4) + 1.0f;
#pragma unroll
                for (int m = 0; m < 4; ++m) {
                    const int row = row0 + ai * 128 + m * 16;
                    const pg8::f32x4 x0 = *(const pg8::f32x4*)(x + (size_t)row * DM + c0), x1 = *(const pg8::f32x4*)(x + (size_t)row * DM + c0 + 4);
                    const pg8::f32x4 v0 = x0 * ALPHA + g0 * (acc[ai][bj][m][0] + b0), v1 = x1 * ALPHA + g1 * (acc[ai][bj][m][1] + b1);
                    v4u o; o.x = pk2(v0.x, v0.y); o.y = pk2(v0.z, v0.w); o.z = pk2(v1.x, v1.y); o.w = pk2(v1.z, v1.w);
                    *(v4u*)(Y1 + (size_t)row * DM + c0) = o;
                }
            }
        }
    }
};
__device__ __forceinline__ void ph_fft(const Params& p, LAS unsigned char* lds, int bid, int nblk) {
    const int tid = opaque_tid(), lane = tid & 63, wave = __builtin_amdgcn_readfirstlane(tid >> 6), lr = lane & 15, lq = lane >> 4;
    bf16* MIX = (bf16*)(p.ws + WS_XN);
    for (int item = bid; item < 256; item += nblk) {
        const int b = item >> 7, cg = item & 127;
        const unsigned long long* src = (const unsigned long long*)(p.ws + WS_FZ) + (size_t)(b * 128 + cg) * 8192;
        {
            const int n2b = (tid & 7) | ((tid >> 6) << 3), n1b = (tid >> 3) & 7;
            const unsigned long long* sb = src + 128 * n1b + n2b; LAS unsigned char* lb = lds + (2 * n2b) * 288 + 4 * n1b;
#pragma unroll
            for (int hb = 0; hb < 2; ++hb) {
                unsigned long long zin[8];
#pragma unroll
                for (int i = 0; i < 8; ++i) { const int ii = hb * 8 + i; zin[i] = sb[(ii & 1) * 64 + (ii >> 1) * 1024]; }
#pragma unroll
                for (int i = 0; i < 8; ++i) { const int ii = hb * 8 + i; LAS unsigned char* lp = lb + (ii & 1) * 36864 + (ii >> 1) * 32;
                    *(LAS unsigned*)lp = (unsigned)zin[i]; *(LAS unsigned*)(lp + 288) = (unsigned)(zin[i] >> 32); }
            }
        }
        bf16x8_t af[4];
        { const int m = 16 * wave + lr, k1 = m >> 1, ri = m & 1;
#pragma unroll
          for (int ks = 0; ks < 4; ++ks)
#pragma unroll
              for (int jj = 0; jj < 4; ++jj) { const int n1 = 16 * ks + 4 * lq + jj; const float x = (float)((n1 * k1) & 63) * (1.0f / 64.0f);
                  const float c = __builtin_amdgcn_cosf(x), s = __builtin_amdgcn_sinf(x);
                  af[ks][2 * jj] = (short)f2bf(ri ? -s : c); af[ks][2 * jj + 1] = (short)f2bf(ri ? c : s); } }
        __syncthreads();
        pg8::f32x4 acc[16];
#pragma unroll
        for (int nt = 0; nt < 16; ++nt) { acc[nt] = (pg8::f32x4){0.f, 0.f, 0.f, 0.f};
#pragma unroll
            for (int ks = 0; ks < 4; ++ks) { const bf16x8_t bf = *(const LAS bf16x8_t*)(lds + (16 * nt + lr) * 288 + (32 * ks + 8 * lq) * 2);
                acc[nt] = __builtin_amdgcn_mfma_f32_16x16x32_bf16(af[ks], bf, acc[nt], 0, 0, 0); } }
        __syncthreads();
#pragma unroll
        for (int nt = 0; nt < 16; ++nt) { const int col = 16 * nt + lr, n2 = col >> 1, ch = col & 1;
#pragma unroll
            for (int h = 0; h < 2; ++h) { const int k1 = 8 * wave + 2 * lq + h; const float yr = acc[nt][2 * h], yi = acc[nt][2 * h + 1];
                const float x = (float)((n2 * k1) & 8191) * (1.0f / 8192.0f); const float c = __builtin_amdgcn_cosf(x), s = __builtin_amdgcn_sinf(x);
                *(LAS unsigned*)(lds + (2 * k1 + ch) * 544 + 4 * n2) = pk2(yr * c + yi * s, yi * c - yr * s); } }
        bf16x8_t a2[8];
        { const int k2 = 16 * wave + lr;
#pragma unroll
          for (int ks = 0; ks < 8; ++ks)
#pragma unroll
              for (int jj = 0; jj < 4; ++jj) { const int n2 = 16 * ks + 4 * lq + jj; const float x = (float)((n2 * k2) & 127) * (1.0f / 128.0f);
                  a2[ks][2 * jj] = (short)f2bf(__builtin_amdgcn_cosf(x)); a2[ks][2 * jj + 1] = (short)f2bf(__builtin_amdgcn_sinf(x)); } }
        __syncthreads();
        pg8::f32x4 o[8];
#pragma unroll
        for (int nt = 0; nt < 8; ++nt) { o[nt] = (pg8::f32x4){0.f, 0.f, 0.f, 0.f};
#pragma unroll
            for (int ks = 0; ks < 8; ++ks) { const bf16x8_t bf = *(const LAS bf16x8_t*)(lds + (16 * nt + lr) * 544 + (32 * ks + 8 * lq) * 2);
                o[nt] = __builtin_amdgcn_mfma_f32_16x16x32_bf16(a2[ks], bf, o[nt], 0, 0, 0); } }
#pragma unroll
        for (int nt = 0; nt < 8; ++nt) { const int col2 = 16 * nt + lr, k1 = col2 >> 1, ch = col2 & 1;
#pragma unroll
            for (int r = 0; r < 4; ++r) { const float v = o[nt][r]; const float w = __builtin_bit_cast(float, __builtin_amdgcn_update_dpp(0, __builtin_bit_cast(int, v), 0xB1, 0xf, 0xf, true)); const int k2 = 16 * wave + 4 * lq + r;
                if (ch == 0) *(unsigned*)(MIX + ((size_t)b * SEQ + k1 + 64 * k2) * DM + 2 * cg) = pk2(v, w); } }
        __syncthreads();
    }
}


struct EpiIn {
    static constexpr bool PERM = true, AFTER_DRAIN = false;
    bf16* FZ; bf16* QKV; const float* bias; const int* pos;
    __device__ __forceinline__ void operator()(const pg8::f32x4 (&acc)[2][2][4][2], const pg8::Unit& u, int wr, int wc, int fr, int fq) const {
        const int row0 = u.pm * 256 + wr * 64 + fr;
        float cf[4];
#pragma unroll
        for (int q = 0; q < 4; ++q) cf[q] = __builtin_amdgcn_exp2f(-(float)(16 * (wc & 1) + 4 * fq + q) * (13.287712379549449f / 32.0f)) * 0.15915494309189535f;
        const bool isqk = u.pn >= 2 && u.pn < 8;
        float posf[2][4];
#pragma unroll
        for (int ai = 0; ai < 2; ++ai)
#pragma unroll
            for (int m = 0; m < 4; ++m) posf[ai][m] = isqk ? (float)pos[row0 + ai * 128 + m * 16] : 0.f;
#pragma unroll
        for (int bj = 0; bj < 2; ++bj) {
            const int c0 = u.pn * 256 + bj * 128 + wc * 32 + 8 * fq;
            const pg8::f32x4 b0 = *(const pg8::f32x4*)(bias + c0), b1 = *(const pg8::f32x4*)(bias + c0 + 4);
#pragma unroll
            for (int ai = 0; ai < 2; ++ai)
#pragma unroll
                for (int m = 0; m < 4; ++m) {
                    const int row = row0 + ai * 128 + m * 16;
                    pg8::f32x4 v0 = acc[ai][bj][m][0] + b0, v1 = acc[ai][bj][m][1] + b1;
                    if (u.pn < 2) {
                        const int b = row >> 13, s = row & 8191, cgp = c0 >> 2;
                        unsigned long long* d0 = (unsigned long long*)(FZ + (((size_t)(b * 128 + cgp) * 8192 + s) << 2));
                        d0[0] = (unsigned long long)pk2(v0.x, v0.y) | ((unsigned long long)pk2(v0.z, v0.w) << 32);
                        d0[8192] = (unsigned long long)pk2(v1.x, v1.y) | ((unsigned long long)pk2(v1.z, v1.w) << 32);
                    } else {
                        const int cq = c0 - 512, which = cq / 768, off = cq - which * 768;
                        if (which < 2) {
                            const float sc = which == 0 ? QSCALE : 1.0f;
                            pg8::f32x4 r0, r1;
                            { const float pf = posf[ai][m]; float a0 = pf * cf[0], a1 = pf * cf[1], a2 = pf * cf[2], a3 = pf * cf[3];
                              a0 -= floorf(a0); a1 -= floorf(a1); a2 -= floorf(a2); a3 -= floorf(a3);
                              r0.x = __builtin_amdgcn_cosf(a0); r0.y = __builtin_amdgcn_sinf(a0); r0.z = __builtin_amdgcn_cosf(a1); r0.w = __builtin_amdgcn_sinf(a1);
                              r1.x = __builtin_amdgcn_cosf(a2); r1.y = __builtin_amdgcn_sinf(a2); r1.z = __builtin_amdgcn_cosf(a3); r1.w = __builtin_amdgcn_sinf(a3); }
                            pg8::f32x4 w0, w1;
                            w0.x = (v0.x * r0.x - v0.y * r0.y) * sc; w0.y = (v0.y * r0.x + v0.x * r0.y) * sc; w0.z = (v0.z * r0.z - v0.w * r0.w) * sc; w0.w = (v0.w * r0.z + v0.z * r0.w) * sc;
                            w1.x = (v1.x * r1.x - v1.y * r1.y) * sc; w1.y = (v1.y * r1.x + v1.x * r1.y) * sc; w1.z = (v1.z * r1.z - v1.w * r1.w) * sc; w1.w = (v1.w * r1.z + v1.z * r1.w) * sc;
                            v0 = w0; v1 = w1;
                        }
                        v4u o; o.x = pk2(v0.x, v0.y); o.y = pk2(v0.z, v0.w); o.z = pk2(v1.x, v1.y); o.w = pk2(v1.z, v1.w);
                        *(v4u*)(QKV + (size_t)which * ((WS_KB - WS_QB) / 2) + (size_t)row * 768 + off) = o;
                    }
                }
        }
    }
};

typedef float f32x16 __attribute__((ext_vector_type(16)));
typedef short s16x4 __attribute__((ext_vector_type(4)));
__device__ __forceinline__ int crow(int r, int hi) { return (r & 3) + 8 * (r >> 2) + 4 * hi; }
__device__ __forceinline__ s16x4 vtr(const LAS unsigned char* p) { return __builtin_bit_cast(s16x4, __builtin_amdgcn_ds_read_tr16_b64_v4i16((LAS s16x4*)p)); }
__device__ __forceinline__ unsigned cvtpk(float lo, float hi) { typedef float f2 __attribute__((ext_vector_type(2))); typedef __bf16 b2 __attribute__((ext_vector_type(2))); f2 v = {lo, hi}; b2 r = __builtin_convertvector(v, b2); return __builtin_bit_cast(unsigned, r); }
__device__ __forceinline__ void tbl_load(const Params& p, int r, f32x4 (&a)[4], int lane) {
    const bool isv = r >= 16384; const int row = isv ? r - 16384 : r;
    const f32x4* src = (const f32x4*)((isv ? p.pv : p.pu) + (size_t)row * DM + 16 * lane);
#pragma unroll
    for (int j = 0; j < 4; ++j) a[j] = src[j];
}
__device__ __forceinline__ void tbl_finish(const Params& p, int r, const f32x4 (&a)[4], int lane) {
    const bool isv = r >= 16384; const int row = isv ? r - 16384 : r;
    float amax = 0.f;
#pragma unroll
    for (int j = 0; j < 4; ++j) amax = fmaxf(amax, fmaxf(fmaxf(fabsf(a[j].x), fabsf(a[j].y)), fmaxf(fabsf(a[j].z), fabsf(a[j].w))));
    if (isv) {
        float ss = 0.f;
#pragma unroll
        for (int j = 0; j < 4; ++j) ss += (a[j].x * a[j].x + a[j].y * a[j].y) + (a[j].z * a[j].z + a[j].w * a[j].w);
        amax = wave_max(amax); ss = wave_sum(ss);
        const float clip = fminf(amax, 2.5f * sqrtf(ss * (1.0f / DM)));
        const float inv = clip > 0.f ? 7.0f / clip : 0.f;
        unsigned n[4];
#pragma unroll
        for (int j = 0; j < 4; ++j) { unsigned q = 0u;
            q = __builtin_amdgcn_cvt_pk_u8_f32(__builtin_amdgcn_fmed3f(a[j].x * inv + 8.0f, 1.0f, 15.0f), 0, q); q = __builtin_amdgcn_cvt_pk_u8_f32(__builtin_amdgcn_fmed3f(a[j].y * inv + 8.0f, 1.0f, 15.0f), 1, q);
            q = __builtin_amdgcn_cvt_pk_u8_f32(__builtin_amdgcn_fmed3f(a[j].z * inv + 8.0f, 1.0f, 15.0f), 2, q); q = __builtin_amdgcn_cvt_pk_u8_f32(__builtin_amdgcn_fmed3f(a[j].w * inv + 8.0f, 1.0f, 15.0f), 3, q);
            n[j] = q; }
        const bool odd = (lane & 1) != 0;
        if (odd) {
#pragma unroll
            for (int j = 0; j < 4; ++j) n[j] ^= 0x08080808u; }
        const unsigned s0 = odd ? n[0] : n[2], s1 = odd ? n[1] : n[3];
        const unsigned r0 = (unsigned)__builtin_amdgcn_update_dpp(0, (int)s0, 0xB1, 0xf, 0xf, true), r1 = (unsigned)__builtin_amdgcn_update_dpp(0, (int)s1, 0xB1, 0xf, 0xf, true);
        const v2u o = odd ? (v2u){r0 | (n[2] << 4), r1 | (n[3] << 4)} : (v2u){n[0] | (r0 << 4), n[1] | (r1 << 4)};
        *(v2u*)(p.ws + WS_TV8 + (size_t)(lane >> 4) * (2 * MiB) + (size_t)row * 128 + 8 * (lane & 15)) = o;
        if (lane == 0) ((float*)(p.ws + WS_SV))[row] = clip * (1.0f / 7.0f);
    } else {
        float ss = 0.f;
#pragma unroll
        for (int j = 0; j < 4; ++j) ss += (a[j].x * a[j].x + a[j].y * a[j].y) + (a[j].z * a[j].z + a[j].w * a[j].w);
        amax = wave_max(amax); ss = wave_sum(ss);
        const float clip = fminf(amax, 2.5f * sqrtf(ss * (1.0f / DM)));
        const float inv = clip > 0.f ? 7.0f / clip : 0.f;
        unsigned d[2];
#pragma unroll
        for (int w = 0; w < 2; ++w) { unsigned lo = 0u, hi = 0u;
            lo = __builtin_amdgcn_cvt_pk_u8_f32(__builtin_amdgcn_fmed3f(a[2 * w].x * inv + 8.0f, 1.0f, 15.0f), 0, lo); lo = __builtin_amdgcn_cvt_pk_u8_f32(__builtin_amdgcn_fmed3f(a[2 * w].y * inv + 8.0f, 1.0f, 15.0f), 1, lo);
            lo = __builtin_amdgcn_cvt_pk_u8_f32(__builtin_amdgcn_fmed3f(a[2 * w].z * inv + 8.0f, 1.0f, 15.0f), 2, lo); lo = __builtin_amdgcn_cvt_pk_u8_f32(__builtin_amdgcn_fmed3f(a[2 * w].w * inv + 8.0f, 1.0f, 15.0f), 3, lo);
            hi = __builtin_amdgcn_cvt_pk_u8_f32(__builtin_amdgcn_fmed3f(a[2 * w + 1].x * inv + 8.0f, 1.0f, 15.0f), 0, hi); hi = __builtin_amdgcn_cvt_pk_u8_f32(__builtin_amdgcn_fmed3f(a[2 * w + 1].y * inv + 8.0f, 1.0f, 15.0f), 1, hi);
            hi = __builtin_amdgcn_cvt_pk_u8_f32(__builtin_amdgcn_fmed3f(a[2 * w + 1].z * inv + 8.0f, 1.0f, 15.0f), 2, hi); hi = __builtin_amdgcn_cvt_pk_u8_f32(__builtin_amdgcn_fmed3f(a[2 * w + 1].w * inv + 8.0f, 1.0f, 15.0f), 3, hi);
            d[w] = (lo | (hi << 4)) ^ 0x88888888u; }
        *(v2u*)(p.ws + WS_TU8 + (size_t)(lane >> 4) * (2 * MiB) + (size_t)row * 128 + 8 * (lane & 15)) = (v2u){d[0], d[1]};
        if (lane == 0) ((float*)(p.ws + WS_SU))[row] = clip * (1.0f / 7.0f);
    }
}
constexpr int TBL_TAIL = 6144;
__device__ __forceinline__ void ph_tables_tail(const Params& p, int k, int nk) {
    const int lane = opaque_tid() & 63, wave = wave_id();
    const int st = nk * NWAVES; int r = k * NWAVES + wave;
    f32x4 a0[4], a1[4], a2[4], a3[4], b0[4], b1[4], b2[4], b3[4];
    if (r + 3 * st < TBL_TAIL) { tbl_load(p, r, a0, lane); tbl_load(p, r + st, a1, lane); tbl_load(p, r + 2 * st, a2, lane); tbl_load(p, r + 3 * st, a3, lane); }
    while (r + 3 * st < TBL_TAIL) {
        const int rn = r + 4 * st; const bool hb = rn + 3 * st < TBL_TAIL;
        if (hb) { tbl_load(p, rn, b0, lane); tbl_load(p, rn + st, b1, lane); tbl_load(p, rn + 2 * st, b2, lane); tbl_load(p, rn + 3 * st, b3, lane); }
        tbl_finish(p, r, a0, lane); tbl_finish(p, r + st, a1, lane); tbl_finish(p, r + 2 * st, a2, lane); tbl_finish(p, r + 3 * st, a3, lane);
        if (!hb) { r = rn; break; }
        const int rm = rn + 4 * st; const bool ha = rm + 3 * st < TBL_TAIL;
        if (ha) { tbl_load(p, rm, a0, lane); tbl_load(p, rm + st, a1, lane); tbl_load(p, rm + 2 * st, a2, lane); tbl_load(p, rm + 3 * st, a3, lane); }
        tbl_finish(p, rn, b0, lane); tbl_finish(p, rn + st, b1, lane); tbl_finish(p, rn + 2 * st, b2, lane); tbl_finish(p, rn + 3 * st, b3, lane);
        r = rm;
    }
    for (; r < TBL_TAIL; r += st) { tbl_load(p, r, a0, lane); tbl_finish(p, r, a0, lane); }
}
struct AttnDesc { int dil, ntile, res, cb, r; size_t rowb; int h; bool valid; };
__device__ __forceinline__ AttnDesc attn_desc(int bi) {
    AttnDesc d; d.valid = bi < 3 * 768; const int b2 = d.valid ? bi : 0;
    const int r = b2 / 768, rem = b2 - r * 768, bh = rem >> 5, q32 = rem & 31, b = bh / 12;
    d.r = r; d.h = bh - b * 12; d.rowb = (size_t)b * SEQ;
    const int ld = 2 * r;
    d.dil = 1 << ld; d.ntile = 256 >> ld; d.res = q32 >> (5 - ld); d.cb = q32 & ((32 >> ld) - 1);
    return d;
}
__device__ __forceinline__ void attn_dma(const AttnDesc& d, const bf16* T, bool swz, LAS unsigned char* img, int wave, int lane) {
    const int lr = lane >> 3, ch = lane & 7;
    const int g0 = swz ? (ch ^ ((lr >> 1) & 7)) : (ch ^ (((lr >> 1) & 1) << 2));
    const int g1 = swz ? (g0 ^ 4) : g0;
    const long long rowbase = (long long)d.rowb + d.res + (long long)d.dil * (32 * (8 * d.cb - 2) + lr);
    const bf16* base = T + rowbase * 768 + d.h * 64;
    const bf16* p0 = base + 8 * g0; const bf16* p1 = base + 8 * g1;
#pragma unroll
    for (int i = 0; i < 6; ++i) {
        const int idx = wave * 6 + i, j = idx >> 2, it = idx & 3, kt = 8 * d.cb - 2 + j;
        if (kt >= 0 && kt < d.ntile) {
            const long long off = (long long)d.dil * (32 * j + 8 * it) * 768;
            const bf16* src = ((it & 1) ? p1 : p0) + off;
            __builtin_amdgcn_global_load_lds((const unsigned*)src, (LAS unsigned*)(img + j * 4096 + it * 1024), 16, 0, 0);
        }
    }
}
__device__ __forceinline__ void attn_qload(const AttnDesc& d, const bf16* QB, bf16x8_t (&qf)[4], int wave, int lane) {
    const bf16* qp = QB + (d.rowb + d.res + d.dil * (32 * (8 * d.cb + wave) + (lane & 31))) * 768 + d.h * 64 + 8 * (lane >> 5);
#pragma unroll
    for (int d0 = 0; d0 < 4; ++d0) qf[d0] = *(const bf16x8_t*)(qp + 16 * d0);
}
#define ATT_SYNC() do { asm volatile("s_waitcnt vmcnt(0) lgkmcnt(0)" ::: "memory"); __builtin_amdgcn_s_barrier(); asm volatile("" ::: "memory"); } while (0)
#define ATT_SYNC_N(N) do { asm volatile("s_waitcnt vmcnt(" #N ") lgkmcnt(0)" ::: "memory"); __builtin_amdgcn_s_barrier(); asm volatile("" ::: "memory"); } while (0)
__device__ __forceinline__ void ph_attn_fast(const Params& p, LAS unsigned char* lds, int bid, int nblk) {
    const int lane = opaque_tid() & 63, wave = wave_id(), r32 = lane & 31, hi = lane >> 5;
    LAS unsigned char* imgK = lds; LAS unsigned char* imgV = lds + 49152; LAS unsigned char* stgb = lds + 98304 + wave * 4096;
    const bf16* QB = (const bf16*)(p.ws + WS_QB); const bf16* KB = (const bf16*)(p.ws + WS_KB); const bf16* VB = (const bf16*)(p.ws + WS_VB);
    const int vb = (nblk & 7) == 0 ? (bid & 7) * (nblk >> 3) + (bid >> 3) : bid;
    int bi = vb;
    AttnDesc d = attn_desc(bi);
    bf16x8_t qf[4];
    if (d.valid) { attn_dma(d, KB, true, imgK, wave, lane); attn_qload(d, QB, qf, wave, lane); }
    ATT_SYNC();
    const int g = lane >> 4, ii = lane & 15;
    const int vb0 = (4 * hi + (ii >> 2)) * 128 + (g & 1) * 32 + (ii & 3) * 8, vsw = ((ii >> 3) & 1) * 64;
    int trow = TBL_TAIL + bid * NWAVES + wave; const int tstride = nblk * NWAVES;
    f32x4 ta[4], tb[4]; int rowA = -1, rowB = -1;
    while (d.valid) {
        asm volatile("" : "+v"(qf[0]), "+v"(qf[1]), "+v"(qf[2]), "+v"(qf[3]));
        if (rowB >= 0) { tbl_finish(p, rowB, tb, lane); rowB = -1; }
        attn_dma(d, VB, false, imgV, wave, lane);
        asm volatile("" ::: "memory");
        if (trow < 32768) { rowA = trow; trow += tstride; tbl_load(p, rowA, ta, lane); }
        asm volatile("" ::: "memory");
        const int c = 8 * d.cb + wave;
        f32x16 S[5];
#pragma unroll
        for (int u = 0; u < 5; ++u) {
            const int kt = c - 2 + u;
#pragma unroll
            for (int r = 0; r < 16; ++r) S[u][r] = -1e30f;
            if (kt >= 0 && kt < d.ntile) {
                const LAS unsigned char* slot = imgK + (wave + u) * 4096;
                f32x16 a = {0.f, 0.f, 0.f, 0.f, 0.f, 0.f, 0.f, 0.f, 0.f, 0.f, 0.f, 0.f, 0.f, 0.f, 0.f, 0.f};
#pragma unroll
                for (int d0 = 0; d0 < 4; ++d0) { const bf16x8_t kf = *(const LAS bf16x8_t*)(slot + r32 * 128 + (((2 * d0 + hi) ^ ((r32 >> 1) & 7)) << 4));
                    a = __builtin_amdgcn_mfma_f32_32x32x16_bf16(kf, qf[d0], a, 0, 0, 0); }
                S[u] = a;
            }
        }
        int tq = r32 - 4 * hi; asm volatile("" : "+v"(tq));
#pragma unroll
        for (int r = 0; r < 16; ++r) { const int kc = crow(r, 0); if (kc < tq) S[0][r] = -1e30f; if (kc > tq) S[4][r] = -1e30f; }
        float m = -1e30f;
#pragma unroll
        for (int u = 0; u < 5; ++u)
#pragma unroll
            for (int r = 0; r < 16; ++r) m = fmaxf(m, S[u][r]);
        m = fmaxf(m, __shfl_xor(m, 32));
        float l = 0.f;
        unsigned Pk[5][8];
#pragma unroll
        for (int u = 0; u < 5; ++u)
#pragma unroll
            for (int r = 0; r < 16; r += 2) { const float e0 = __builtin_amdgcn_exp2f(S[u][r] - m), e1 = __builtin_amdgcn_exp2f(S[u][r + 1] - m); l += e0 + e1; Pk[u][r >> 1] = cvtpk(e0, e1); }
        l += __shfl_xor(l, 32);
        if (rowA >= 0) ATT_SYNC_N(4); else ATT_SYNC();
        const AttnDesc dn = attn_desc(bi + nblk);
        if (rowA >= 0) { tbl_finish(p, rowA, ta, lane); rowA = -1; }
        if (dn.valid) { attn_dma(dn, KB, true, imgK, wave, lane); attn_qload(dn, QB, qf, wave, lane); }
        asm volatile("" ::: "memory");
        if (trow < 32768) { rowB = trow; trow += tstride; tbl_load(p, rowB, tb, lane); }
        asm volatile("" ::: "memory");
        f32x16 o[2];
#pragma unroll
        for (int db = 0; db < 2; ++db)
#pragma unroll
            for (int r = 0; r < 16; ++r) o[db][r] = 0.f;
#pragma unroll
        for (int u = 0; u < 5; ++u) {
            const int kt = c - 2 + u;
            if (kt >= 0 && kt < d.ntile) {
                const LAS unsigned char* slot = imgV + (wave + u) * 4096;
#pragma unroll
                for (int s = 0; s < 2; ++s) {
                    bf16x8_t pa;
                    { v4u w; w.x = Pk[u][4 * s + 0]; w.y = Pk[u][4 * s + 1]; w.z = Pk[u][4 * s + 2]; w.w = Pk[u][4 * s + 3]; pa = __builtin_bit_cast(bf16x8_t, w); }
#pragma unroll
                    for (int db = 0; db < 2; ++db) {
                        const s16x4 lo = vtr(slot + vb0 + s * 2048 + ((db * 64) ^ vsw)), hh = vtr(slot + vb0 + s * 2048 + 1024 + ((db * 64) ^ vsw));
                        const bf16x8_t vf = {lo[0], lo[1], lo[2], lo[3], hh[0], hh[1], hh[2], hh[3]};
                        o[db] = __builtin_amdgcn_mfma_f32_32x32x16_bf16(vf, pa, o[db], 0, 0, 0);
                    }
                }
            }
        }
        bf16* OB = d.r == 2 ? (bf16*)(p.ws + WS_O3) : (bf16*)p.out + (size_t)d.r * NT * 768;
        float* LSE = (float*)(p.ws + WS_LSE) + (size_t)d.r * NT * 12;
        const float linv = 1.0f / l;
        LAS unsigned char* stg = stgb;
#pragma unroll
        for (int db = 0; db < 2; ++db)
#pragma unroll
            for (int g4 = 0; g4 < 4; ++g4) {
                const unsigned w0 = cvtpk(o[db][4 * g4] * linv, o[db][4 * g4 + 1] * linv), w1 = cvtpk(o[db][4 * g4 + 2] * linv, o[db][4 * g4 + 3] * linv);
                *(LAS v2u*)(stg + r32 * 128 + (((db * 4 + g4) ^ (r32 & 7)) << 4) + 8 * hi) = (v2u){w0, w1};
            }
        int ln2 = lane; asm volatile("" : "+v"(ln2));
        bf16* ob0 = OB + (d.rowb + d.res + d.dil * (32 * c + (ln2 >> 3))) * 768 + d.h * 64 + 8 * (ln2 & 7);
#pragma unroll
        for (int i4 = 0; i4 < 4; ++i4) { const int row = i4 * 8 + (ln2 >> 3), ch = ln2 & 7;
            const v4u val = *(const LAS v4u*)(stg + row * 128 + ((ch ^ (row & 7)) << 4));
            *(v4u*)(ob0 + (size_t)d.dil * (8 * i4) * 768) = val; }
        if (ln2 < 32) LSE[(d.rowb + d.res + d.dil * (32 * c + ln2)) * 12 + d.h] = m + __builtin_amdgcn_logf(l);
        if (rowB >= 0) ATT_SYNC_N(8); else ATT_SYNC_N(4);
        d = dn; bi += nblk;
    }
    if (rowA >= 0) tbl_finish(p, rowA, ta, lane);
    if (rowB >= 0) tbl_finish(p, rowB, tb, lane);
    for (; trow < 32768; trow += tstride) { tbl_load(p, trow, ta, lane); tbl_finish(p, trow, ta, lane); }
}
__device__ __forceinline__ void ph_merge(const Params& p, int bid, int nblk) {
    const bf16* O1 = (const bf16*)p.out; const bf16* O2 = O1 + (size_t)NT * 768; const bf16* O3 = (const bf16*)(p.ws + WS_O3);
    const float* L1 = (const float*)(p.ws + WS_LSE); const float* L2 = L1 + (size_t)NT * 12; const float* L3 = L2 + (size_t)NT * 12; bf16* MIX = (bf16*)(p.ws + WS_XN);
    for (int idx = (bid >> 3) * NTHREADS + opaque_tid(); idx < (NT / 8) * 96; idx += (nblk >> 3) * NTHREADS) {
        const int tl = idx / 96, t = (bid & 7) * (NT / 8) + tl, rem = idx - tl * 96, h = rem >> 3, ch = rem & 7;
        const float l1 = L1[t * 12 + h], l2 = L2[t * 12 + h], l3 = L3[t * 12 + h]; const float mx = fmaxf(fmaxf(l1, l2), l3);
        float w1 = __builtin_amdgcn_exp2f(l1 - mx), w2 = __builtin_amdgcn_exp2f(l2 - mx), w3 = __builtin_amdgcn_exp2f(l3 - mx); const float inv = 1.0f / (w1 + w2 + w3); w1 *= inv; w2 *= inv; w3 *= inv;
        const size_t off = (size_t)t * 768 + h * 64 + 8 * ch;
        const v4u a = *(const v4u*)(O1 + off), bq = *(const v4u*)(O2 + off), cq = *(const v4u*)(O3 + off);
        v4u o;
        o.x = pk2(w1 * bflo(a.x) + w2 * bflo(bq.x) + w3 * bflo(cq.x), w1 * bfhi(a.x) + w2 * bfhi(bq.x) + w3 * bfhi(cq.x));
        o.y = pk2(w1 * bflo(a.y) + w2 * bflo(bq.y) + w3 * bflo(cq.y), w1 * bfhi(a.y) + w2 * bfhi(bq.y) + w3 * bfhi(cq.y));
        o.z = pk2(w1 * bflo(a.z) + w2 * bflo(bq.z) + w3 * bflo(cq.z), w1 * bfhi(a.z) + w2 * bfhi(bq.z) + w3 * bfhi(cq.z));
        o.w = pk2(w1 * bflo(a.w) + w2 * bflo(bq.w) + w3 * bflo(cq.w), w1 * bfhi(a.w) + w2 * bfhi(bq.w) + w3 * bfhi(cq.w));
        *(v4u*)(MIX + (size_t)t * DM + 256 + h * 64 + 8 * ch) = o;
    }
}


__host__ __device__ constexpr int stair2_slot(int i, int j) { int n = 0; for (int a = 1; a < 16; ++a) for (int b = 1; b < 16; ++b) if ((a + 1) * (b + 1) <= 16) { if (a == i && b == j) return n; ++n; } return n; }
__device__ __forceinline__ float kmax(float a, float b) { float r; asm("v_max_f32_e32 %0, %1, %2" : "=v"(r) : "v"(a), "v"(b)); return r; }
__device__ __forceinline__ float kmin(float a, float b) { float r; asm("v_min_f32_e32 %0, %1, %2" : "=v"(r) : "v"(a), "v"(b)); return r; }
__device__ __forceinline__ float fkeyf(float s, unsigned low, unsigned mask) { return __builtin_bit_cast(float, (__builtin_bit_cast(unsigned, s) & ~mask) | low); }
__device__ __forceinline__ float fvalf(float k, unsigned mask) { return __builtin_bit_cast(float, (__builtin_bit_cast(unsigned, k) & ~mask) | (mask >> 1)); }
#define CE_DESC(a, b) do { const float _mx = kmax((a), (b)), _mn = kmin((a), (b)); (a) = _mx; (b) = _mn; } while (0)
__device__ __forceinline__ void sort16_desc(float (&a)[16]) {
#pragma unroll
    for (int k = 2; k <= 16; k <<= 1)
#pragma unroll
        for (int j = k >> 1; j > 0; j >>= 1)
#pragma unroll
            for (int i = 0; i < 16; ++i) { const int l = i ^ j; if (l > i) { if ((i & k) == 0) CE_DESC(a[i], a[l]); else CE_DESC(a[l], a[i]); } }
}
__device__ __forceinline__ void merge16_desc(float (&c)[16]) {
#pragma unroll
    for (int j = 8; j > 0; j >>= 1)
#pragma unroll
        for (int i = 0; i < 16; ++i) { const int l = i ^ j; if (l > i) CE_DESC(c[i], c[l]); }
}
__device__ __forceinline__ void top16_merge(float (&a)[16], const float (&b)[16]) {
#pragma unroll
    for (int i = 0; i < 16; ++i) a[i] = kmax(a[i], b[15 - i]);
    merge16_desc(a);
}
__device__ __forceinline__ void top16_of_64(float (&g0)[16], float (&g1)[16], float (&g2)[16], float (&g3)[16]) {
    sort16_desc(g0); sort16_desc(g1); sort16_desc(g2); sort16_desc(g3);
    top16_merge(g0, g1); top16_merge(g2, g3); top16_merge(g0, g2);
}
template <int MST>
__device__ __forceinline__ void topk_item(const bf16x8_t (&qf)[2][4], const bf16* SK, int h, int t, LAS unsigned* myl, unsigned short* ids, float* gates, const float* SVt, int lane) {
    const int hi = lane >> 5; const float NEGINF = -INFINITY;
        float K[2][16];
#pragma unroll
    for (int pp = 0; pp < 2; ++pp) {
        float g[4][16];
#pragma unroll
        for (int mt = 0; mt < 4; ++mt) {
            const bf16* kp = SK + ((size_t)((h * 2 + pp) * 4 + mt) * 4 * 64 + lane) * 8;
            f32x16 a = {0.f, 0.f, 0.f, 0.f, 0.f, 0.f, 0.f, 0.f, 0.f, 0.f, 0.f, 0.f, 0.f, 0.f, 0.f, 0.f};
#pragma unroll
            for (int d0 = 0; d0 < 4; ++d0) a = __builtin_amdgcn_mfma_f32_32x32x16_bf16(*(const bf16x8_t*)(kp + d0 * 512), qf[pp][d0], a, 0, 0, 0);
#pragma unroll
            for (int r = 0; r < 16; ++r) g[mt][r] = fkeyf(a[r], 127u - (unsigned)(32 * mt + crow(r, hi)), 127u);
        }
        top16_of_64(g[0], g[1], g[2], g[3]);
        float o[16];
#pragma unroll
        for (int i = 0; i < 16; ++i) o[i] = __shfl_xor(g[0][i], 32);
        top16_merge(g[0], o);
#pragma unroll
        for (int i = 0; i < 16; ++i) K[pp][i] = g[0][i];
    }
#pragma unroll
    for (int i = 0; i < 16; ++i) { myl[i * MST] = __builtin_bit_cast(unsigned, K[0][i]); myl[(16 + i) * MST] = __builtin_bit_cast(unsigned, K[1][i]); }
    float v0[16], v1[16];
#pragma unroll
    for (int i = 0; i < 16; ++i) { v0[i] = fvalf(K[0][i], 127u); v1[i] = fvalf(K[1][i], 127u); }
    float cA[16], cB[16], cC[16], cD[16];
#pragma unroll
    for (int j = 0; j < 16; ++j) cA[j] = fkeyf(v0[0] + v1[j], 255u - (unsigned)j, 255u);
#pragma unroll
    for (int i = 1; i < 16; ++i) cB[i - 1] = fkeyf(v0[i] + v1[0], 255u - (unsigned)(16 * i), 255u);
    cB[15] = NEGINF;
#pragma unroll
    for (int q = 0; q < 16; ++q) { cC[q] = NEGINF; cD[q] = NEGINF; }
    { int n = 0;
#pragma unroll
      for (int i = 1; i < 8; ++i)
#pragma unroll
          for (int j = 1; j < 8; ++j) if ((i + 1) * (j + 1) <= 16) { const int m = stair2_slot(i, j); const float kv = fkeyf(v0[i] + v1[j], 255u - (unsigned)(16 * i + j), 255u); if (m < 16) cC[m] = kv; else cD[m - 16] = kv; }
      (void)n; }
    sort16_desc(cC);
    CE_DESC(cD[0], cD[1]); CE_DESC(cD[1], cD[2]); CE_DESC(cD[0], cD[1]);
    top16_merge(cA, cB); top16_merge(cC, cD); top16_merge(cA, cC);
    float e[16]; float sum = 0.f; const float mx = fvalf(cA[0], 255u);
#pragma unroll
    for (int r = 0; r < 16; ++r) { e[r] = __builtin_amdgcn_exp2f((fvalf(cA[r], 255u) - mx) * 1.4426950408889634f); sum += e[r]; }
    const float inv = __builtin_amdgcn_rcpf(sum);
    int eid[16];
#pragma unroll
    for (int r = 0; r < 16; ++r) { const unsigned id8 = 255u - (__builtin_bit_cast(unsigned, cA[r]) & 255u); const unsigned k0 = myl[(id8 >> 4) * MST], k1 = myl[(16 + (id8 & 15)) * MST];
        eid[r] = (int)((127u - (k0 & 127u)) * 128u + (127u - (k1 & 127u))); }
    int tq = t; asm volatile("" : "+v"(tq));
    if (hi == 0) {
#pragma unroll
        for (int q = 0; q < 2; ++q) *(v4u*)(ids + (size_t)tq * 128 + h * 16 + 8 * q) = (v4u){(unsigned)eid[8 * q] | ((unsigned)eid[8 * q + 1] << 16), (unsigned)eid[8 * q + 2] | ((unsigned)eid[8 * q + 3] << 16),
                                                                                  (unsigned)eid[8 * q + 4] | ((unsigned)eid[8 * q + 5] << 16), (unsigned)eid[8 * q + 6] | ((unsigned)eid[8 * q + 7] << 16)};
    } else {
#pragma unroll
        for (int q = 0; q < 4; ++q) *(f32x4*)(gates + (size_t)tq * 128 + h * 16 + 4 * q) = (f32x4){e[4 * q] * inv * SVt[eid[4 * q]], e[4 * q + 1] * inv * SVt[eid[4 * q + 1]], e[4 * q + 2] * inv * SVt[eid[4 * q + 2]], e[4 * q + 3] * inv * SVt[eid[4 * q + 3]]};
    }
}
struct EpiPeerTopk {
    static constexpr bool PERM = true, AFTER_DRAIN = true;
    const bf16* SK; unsigned short* ids; float* gates; const float* SVt;
    __device__ __forceinline__ void fused(pg8::f32x4 (&acc)[2][2][4][2], const pg8::Unit& u, int wr, int wc, int fr, int fq, PG8_LAS unsigned char* lds, int wid, int lane) const {
#pragma unroll
        for (int bj = 0; bj < 2; ++bj) {
            const int cc = (bj * 128 + wc * 32 + 8 * fq) >> 3;
#pragma unroll
            for (int ai = 0; ai < 2; ++ai)
#pragma unroll
                for (int m = 0; m < 4; ++m) {
                    const int rl = ai * 128 + wr * 64 + m * 16 + fr; const pg8::f32x4 v0 = acc[ai][bj][m][0], v1 = acc[ai][bj][m][1];
                    v4u o; o.x = pk2(v0.x, v0.y); o.y = pk2(v0.z, v0.w); o.z = pk2(v1.x, v1.y); o.w = pk2(v1.z, v1.w);
                    *(PG8_LAS v4u*)(lds + rl * 512 + ((cc ^ (rl & 15)) << 4)) = o;
                }
        }
        asm volatile("s_waitcnt lgkmcnt(0)" ::: "memory"); __builtin_amdgcn_s_barrier(); asm volatile("" ::: "memory");
        const int r32 = lane & 31, hi = lane >> 5;
#pragma unroll 1
        for (int rep = 0; rep < 2; ++rep) {
            const int it2 = wid + 8 * rep, tl = it2 >> 1, hl = it2 & 1, rl = tl * 32 + r32;
            bf16x8_t qf[2][4];
#pragma unroll
            for (int pp = 0; pp < 2; ++pp)
#pragma unroll
                for (int d0 = 0; d0 < 4; ++d0) { const int cc = hl * 16 + pp * 8 + 2 * d0 + hi; qf[pp][d0] = *(const PG8_LAS bf16x8_t*)(lds + rl * 512 + ((cc ^ (rl & 15)) << 4)); }
            asm volatile("s_waitcnt lgkmcnt(0)" ::: "memory");
            LAS unsigned* myl = (LAS unsigned*)(lds + (tl * 32) * 512 + hl * 256) + lane;
            topk_item<128>(qf, SK, 2 * u.pn + hl, u.pm * 256 + rl, myl, ids, gates, SVt, lane);
        }
    }
};

__device__ __forceinline__ void ph_ln1_fast(const Params& p, int bid, int nblk) {
    const bf16* y1 = (const bf16*)(p.ws + WS_Y1); bf16* x1 = (bf16*)(p.ws + WS_X1); bf16* h2b = (bf16*)(p.ws + WS_XN); const float* mod = (const float*)(p.ws + WS_MOD);
    const int lane = opaque_tid() & 63, wave = wave_id();
    const int stride = (nblk >> 3) * NWAVES, rend = ((bid & 7) + 1) * (NT / 8); int row = (bid & 7) * (NT / 8) + (bid >> 3) * NWAVES + wave; int bcur = -1;
    f32x4 gc[4], bec[4], shc[4], scc[4]; v2u nx[4];
#pragma unroll
    for (int j = 0; j < 4; ++j) { gc[j] = *((const f32x4*)p.g1 + lane + 64 * j); bec[j] = *((const f32x4*)p.be1 + lane + 64 * j); }
    if (row < rend) { const v2u* yr = (const v2u*)(y1 + (size_t)row * DM) + lane;
#pragma unroll
        for (int j = 0; j < 4; ++j) nx[j] = yr[64 * j]; }
    for (; row < rend; row += stride) {
        const int b = row / SEQ;
        if (b != bcur) { bcur = b;
#pragma unroll
            for (int j = 0; j < 4; ++j) { shc[j] = *((const f32x4*)(mod + b * 6144 + 3072) + lane + 64 * j); scc[j] = *((const f32x4*)(mod + b * 6144 + 4096) + lane + 64 * j) + 1.0f; } }
        f32x4 v[4]; float s = 0.f;
#pragma unroll
        for (int j = 0; j < 4; ++j) { const v2u w = nx[j]; v[j] = (f32x4){bflo(w.x), bfhi(w.x), bflo(w.y), bfhi(w.y)}; s += (v[j].x + v[j].y) + (v[j].z + v[j].w); }
        if (row + stride < rend) { const v2u* yr = (const v2u*)(y1 + (size_t)(row + stride) * DM) + lane;
#pragma unroll
            for (int j = 0; j < 4; ++j) nx[j] = yr[64 * j]; }
        float mean = wave_sum(s) * (1.f / DM); float s2 = 0.f;
#pragma unroll
        for (int j = 0; j < 4; ++j) { v[j] = v[j] - mean; s2 += (v[j].x * v[j].x + v[j].y * v[j].y) + (v[j].z * v[j].z + v[j].w * v[j].w); }
        float rstd = rsqrtf(wave_sum(s2) * (1.f / DM) + LN_EPS);
        s = 0.f;
#pragma unroll
        for (int j = 0; j < 4; ++j) {
            v[j] = v[j] * rstd * gc[j] + bec[j]; *((v2u*)(x1 + (size_t)row * DM) + lane + 64 * j) = (v2u){pk2(v[j].x, v[j].y), pk2(v[j].z, v[j].w)}; s += (v[j].x + v[j].y) + (v[j].z + v[j].w); }
        mean = wave_sum(s) * (1.f / DM); s2 = 0.f;
#pragma unroll
        for (int j = 0; j < 4; ++j) { v[j] = v[j] - mean; s2 += (v[j].x * v[j].x + v[j].y * v[j].y) + (v[j].z * v[j].z + v[j].w * v[j].w); }
        rstd = rsqrtf(wave_sum(s2) * (1.f / DM) + LN_EPS);
        float amax = 0.f;
#pragma unroll
        for (int j = 0; j < 4; ++j) {
            const f32x4 o = v[j] * rstd * scc[j] + shc[j]; v[j] = o;
            amax = fmaxf(amax, fmaxf(fmaxf(fabsf(o.x), fabsf(o.y)), fmaxf(fabsf(o.z), fabsf(o.w))));
            *((v2u*)(h2b + (size_t)row * DM) + lane + 64 * j) = (v2u){pk2(o.x, o.y), pk2(o.z, o.w)};
        }
        amax = wave_max(amax); const float hinv = amax > 0.f ? 119.0f / amax : 0.f;
        unsigned* q4 = (unsigned*)(p.ws + WS_H2Q + (size_t)row * DM + ((lane & 1) ? 512 : 0)) + (lane >> 1);
#pragma unroll
        for (int j = 0; j < 4; ++j) { unsigned q = 0u;
            q = __builtin_amdgcn_cvt_pk_u8_f32(v[j].x * hinv + 128.0f, 0, q); q = __builtin_amdgcn_cvt_pk_u8_f32(v[j].y * hinv + 128.0f, 1, q);
            q = __builtin_amdgcn_cvt_pk_u8_f32(v[j].z * hinv + 128.0f, 2, q); q = __builtin_amdgcn_cvt_pk_u8_f32(v[j].w * hinv + 128.0f, 3, q);
            q ^= 0x80808080u;
            const unsigned L = q & 0x0f0f0f0fu, H = (((q >> 4) & 0x0f0f0f0fu) + ((q >> 3) & 0x01010101u)) & 0x0f0f0f0fu;
            const unsigned send = (lane & 1) ? L : H;
            const unsigned recv = (unsigned)__builtin_amdgcn_update_dpp(0, (int)send, 0xB1, 0xf, 0xf, true);
            q4[32 * j] = (lane & 1) ? (recv | (H << 4)) : (L | (recv << 4)); }
        if (lane == 0) ((float*)(p.ws + WS_HS))[row] = amax * (1.0f / 119.0f);
    }
}
__device__ __forceinline__ float readlane_f(float v, int l) { return __builtin_bit_cast(float, __builtin_amdgcn_readlane(__builtin_bit_cast(int, v), l)); }
__device__ __forceinline__ float ub0(unsigned u) { return (float)(u & 255u); }
__device__ __forceinline__ float ub1(unsigned u) { return (float)((u >> 8) & 255u); }
__device__ __forceinline__ float ub2(unsigned u) { return (float)((u >> 16) & 255u); }
__device__ __forceinline__ float ub3(unsigned u) { return (float)(u >> 24); }
__device__ __forceinline__ void ust_issue(v4u (&ub)[8], const v4u& idq, const unsigned char* TUb, unsigned c16) {
#pragma unroll
    for (int e = 0; e < 8; ++e) { const unsigned w = idq[e >> 1]; const unsigned id = (e & 1) ? (w >> 16) : (w & 0xffffu); ub[e] = *(const v4u*)(TUb + ((id << 7) + c16)); }
}
__device__ __forceinline__ int ust_dot(const v4u (&ub)[8], const v4u& h0, const v4u& h1, int lane) {
    int a[8];
#pragma unroll
    for (int e = 0; e < 8; ++e) { int vl = 0, vh = 0;
#pragma unroll
        for (int j = 0; j < 4; ++j) { vl = __builtin_amdgcn_sdot8((int)ub[e][j], (int)h0[j], vl, false); vh = __builtin_amdgcn_sdot8((int)ub[e][j], (int)h1[j], vh, false); }
        a[e] = vl + 16 * vh; }
    int a4[4];
#pragma unroll
    for (int k = 0; k < 4; ++k) { const bool up = (lane & 4) != 0; const int keep = up ? a[k + 4] : a[k], send = up ? a[k] : a[k + 4]; a4[k] = keep + __builtin_amdgcn_update_dpp(0, send, 0x141, 0xf, 0xf, true); }
    int a2[2];
#pragma unroll
    for (int k = 0; k < 2; ++k) { const bool up = (lane & 2) != 0; const int keep = up ? a4[k + 2] : a4[k], send = up ? a4[k] : a4[k + 2]; a2[k] = keep + __builtin_amdgcn_update_dpp(0, send, 0x4E, 0xf, 0xf, true); }
    const bool up = (lane & 1) != 0; const int keep = up ? a2[1] : a2[0], send = up ? a2[0] : a2[1];
    return keep + __builtin_amdgcn_update_dpp(0, send, 0xB1, 0xf, 0xf, true);
}
__device__ __forceinline__ void ph_udotact(const Params& p, LAS unsigned char* lds, int bid, int nblk) {
    const float* GS = (const float*)(p.ws + WS_GATES); const float* HS = (const float*)(p.ws + WS_HS); const float* SU = (const float*)(p.ws + WS_SU);
    unsigned char* WQ = p.ws + WS_WQ; float* WSC = (float*)(p.ws + WS_WSC);
    const int lane = opaque_tid() & 63, wave = wave_id(), c = lane & 7, tau = lane >> 3;
    const unsigned c16 = 16u * c; const unsigned mrow = tau * 256;
    LAS unsigned char* idb = lds + wave * 3104;
    const int ngrp = (NT / 8) / 8, gstride = (nblk >> 3) * NWAVES;
    const bool hand1 = (bid >> 3) * NWAVES + wave + gstride >= ngrp;
    for (int g = (bid >> 3) * NWAVES + wave; g < ngrp; g += gstride) {
        const int t0 = (bid & 7) * (NT / 8) + 8 * g, t = t0 + tau;
        { const unsigned char* ip = p.ws + WS_IDS + (size_t)t0 * 256 + 32 * lane; const v4u n0 = *(const v4u*)ip, n1 = *(const v4u*)(ip + 16);
          *(LAS v4u*)(idb + 32 * lane) = n0; *(LAS v4u*)(idb + 32 * lane + 16) = n1; }
        const unsigned char* hp = p.ws + WS_H2Q + (size_t)t * DM + 16 * c;
        int acc[16];
#pragma unroll
        for (int k = 0; k < 16; ++k) acc[k] = 0;
        v4u uA[8], uB[8], qa, qb, h0, h1, hn0, hn1;
        h0 = *(const v4u*)hp; h1 = *(const v4u*)(hp + 512);
        qa = *(LAS v4u*)(idb + mrow); qb = *(LAS v4u*)(idb + mrow + 16);
        __builtin_amdgcn_sched_barrier(0);
        ust_issue(uA, qa, p.ws + WS_TU8, c16);
        for (int s = 0; s < 4; ++s) {
            const unsigned char* TUs = p.ws + WS_TU8 + (size_t)s * (2 * MiB); const unsigned char* TUn = p.ws + WS_TU8 + (size_t)((s + 1) & 3) * (2 * MiB);
            { const unsigned char* hq = hp + 128 * ((s + 1) & 3); hn0 = *(const v4u*)hq; hn1 = *(const v4u*)(hq + 512); }
#pragma unroll
            for (int k = 0; k < 16; k += 2) {
                __builtin_amdgcn_sched_barrier(0);
                ust_issue(uB, qb, TUs, c16);
                __builtin_amdgcn_sched_barrier(0);
                acc[k] += ust_dot(uA, h0, h1, lane);
                qa = *(LAS v4u*)(idb + mrow + 16 * ((k + 2) & 15));
                __builtin_amdgcn_sched_barrier(0);
                ust_issue(uA, qa, k + 2 < 16 ? TUs : TUn, c16);
                __builtin_amdgcn_sched_barrier(0);
                acc[k + 1] += ust_dot(uB, h0, h1, lane);
                qb = *(LAS v4u*)(idb + mrow + 16 * ((k + 3) & 15));
            }
            h0 = hn0; h1 = hn1;
        }
        const float hs = HS[t];
        float w[16]; float wm = 0.f;
#pragma unroll
        for (int k = 0; k < 16; k += 2) { const unsigned id0 = *(LAS unsigned short*)(idb + mrow + 16 * k + 2 * c), id1 = *(LAS unsigned short*)(idb + mrow + 16 * (k + 1) + 2 * c);
            const pg8::f32x2 d = {(float)acc[k] * (SU[id0] * hs), (float)acc[k + 1] * (SU[id1] * hs)};
            const pg8::f32x2 ge = pg8::gelu_pk(d);
            w[k] = GS[(size_t)t * 128 + 8 * k + c] * ge.x; w[k + 1] = GS[(size_t)t * 128 + 8 * (k + 1) + c] * ge.y; wm = fmaxf(wm, fmaxf(fabsf(w[k]), fabsf(w[k + 1]))); }
        wm = fmaxf(wm, __builtin_bit_cast(float, __builtin_amdgcn_update_dpp(0, __builtin_bit_cast(int, wm), 0xB1, 0xf, 0xf, true)));
        wm = fmaxf(wm, __builtin_bit_cast(float, __builtin_amdgcn_update_dpp(0, __builtin_bit_cast(int, wm), 0x4E, 0xf, 0xf, true)));
        wm = fmaxf(wm, __builtin_bit_cast(float, __builtin_amdgcn_update_dpp(0, __builtin_bit_cast(int, wm), 0x141, 0xf, 0xf, true)));
        const float winv = wm > 0.f ? 127.0f / wm : 0.f;
#pragma unroll
        for (int k = 0; k < 16; ++k) { const unsigned b2 = __builtin_amdgcn_cvt_pk_u8_f32(w[k] * winv + 128.0f, 0, 0u) ^ 0x80u; WQ[(size_t)t * 128 + 8 * k + c] = (unsigned char)(b2 & 255u);
            *(LAS unsigned char*)(idb + 2048 + tau * 128 + 8 * k + c) = (unsigned char)(b2 & 255u); }
        if (c == 0) { WSC[t] = wm * (1.0f / 127.0f); *(LAS float*)(idb + 3072 + 4 * tau) = wm * (1.0f / 127.0f); }
        if (!hand1) asm volatile("s_waitcnt vmcnt(0)" ::: "memory");
    }
    __syncthreads();
}
__device__ __forceinline__ void vst_issue(v4u (&vb)[8], const v4u& idq, const unsigned char* TVs, unsigned c16) {
#pragma unroll
    for (int e = 0; e < 8; ++e) { const unsigned w = idq[e >> 1]; const unsigned id = (e & 1) ? (w >> 16) : (w & 0xffffu); vb[e] = *(const v4u*)(TVs + ((id << 7) + c16)); }
}
__device__ __forceinline__ void vst_compute(int (&y1)[16], int (&y2)[16], const v4u (&vb)[8], const v2u& wq) {
#pragma unroll
    for (int qd = 0; qd < 2; ++qd)
#pragma unroll
        for (int cm = 0; cm < 4; ++cm) {
            const unsigned A = vb[4 * qd][cm], B = vb[4 * qd + 1][cm], C = vb[4 * qd + 2][cm], D = vb[4 * qd + 3][cm];
            const unsigned ab01 = __builtin_amdgcn_perm(B, A, 0x05010400u), ab23 = __builtin_amdgcn_perm(B, A, 0x07030602u);
            const unsigned cd01 = __builtin_amdgcn_perm(D, C, 0x05010400u), cd23 = __builtin_amdgcn_perm(D, C, 0x07030602u);
            const unsigned t0 = __builtin_amdgcn_perm(cd01, ab01, 0x05040100u), t1 = __builtin_amdgcn_perm(cd01, ab01, 0x07060302u);
            const unsigned t2 = __builtin_amdgcn_perm(cd23, ab23, 0x05040100u), t3 = __builtin_amdgcn_perm(cd23, ab23, 0x07060302u);
            y1[4 * cm + 0] = __builtin_amdgcn_sdot4((int)t0, (int)wq[qd], y1[4 * cm + 0], false); y1[4 * cm + 1] = __builtin_amdgcn_sdot4((int)t1, (int)wq[qd], y1[4 * cm + 1], false);
            y1[4 * cm + 2] = __builtin_amdgcn_sdot4((int)t2, (int)wq[qd], y1[4 * cm + 2], false); y1[4 * cm + 3] = __builtin_amdgcn_sdot4((int)t3, (int)wq[qd], y1[4 * cm + 3], false);
            y2[4 * cm + 0] = __builtin_amdgcn_sdot4((int)(t0 & 0x0f0f0f0fu), (int)wq[qd], y2[4 * cm + 0], false); y2[4 * cm + 1] = __builtin_amdgcn_sdot4((int)(t1 & 0x0f0f0f0fu), (int)wq[qd], y2[4 * cm + 1], false);
            y2[4 * cm + 2] = __builtin_amdgcn_sdot4((int)(t2 & 0x0f0f0f0fu), (int)wq[qd], y2[4 * cm + 2], false); y2[4 * cm + 3] = __builtin_amdgcn_sdot4((int)(t3 & 0x0f0f0f0fu), (int)wq[qd], y2[4 * cm + 3], false);
        }
}
__device__ __forceinline__ void ph_vaccfinal(const Params& p, LAS unsigned char* lds, int bid, int nblk) {
    bf16* Y = (bf16*)(p.ws + WS_Y); const float* WSC = (const float*)(p.ws + WS_WSC); const bf16* x1 = (const bf16*)(p.ws + WS_X1); const float* mod = (const float*)(p.ws + WS_MOD);
    const int lane = opaque_tid() & 63, wave = wave_id(), c = lane & 7, tau = lane >> 3;
    const unsigned c16 = 16u * c;
    LAS unsigned char* idb = lds + wave * 3104;
    const unsigned mrow = tau * 256, wrow = 2048 + tau * 128;
    const int ngrp = (NT / 8) / 8, gstride = (nblk >> 3) * NWAVES;
    const bool hand = (bid >> 3) * NWAVES + wave + gstride >= ngrp;
    for (int g = (bid >> 3) * NWAVES + wave; g < ngrp; g += gstride) {
        const int t0 = (bid & 7) * (NT / 8) + 8 * g, t = t0 + tau;
        if (!hand) { const unsigned char* ip = p.ws + WS_IDS + (size_t)t0 * 256 + 32 * lane; const v4u n0 = *(const v4u*)ip, n1 = *(const v4u*)(ip + 16), n2 = *(const v4u*)(p.ws + WS_WQ + (size_t)t0 * 128 + 16 * lane);
          *(LAS v4u*)(idb + 32 * lane) = n0; *(LAS v4u*)(idb + 32 * lane + 16) = n1; *(LAS v4u*)(idb + 2048 + 16 * lane) = n2; }
        const float scn = hand ? *(LAS float*)(idb + 3072 + 4 * tau) : WSC[t];
#define VST_META(step, q, w) do { q = *(LAS v4u*)(idb + mrow + 16 * ((step) & 15)); w = *(LAS v2u*)(idb + wrow + 8 * ((step) & 15)); } while (0)
        int y1[16], y2[16], sw = 0;
#pragma unroll
        for (int k = 0; k < 16; ++k) { y1[k] = 0; y2[k] = 0; }
        v4u vA[8], vB[8];
        v4u qa, qb; v2u wqa, wqb;
        const unsigned char* TV = p.ws + WS_TV8;
        VST_META(0, qa, wqa);
        vst_issue(vA, qa, TV, c16);
        VST_META(1, qb, wqb);
        for (int st = 0; st < 64; st += 2) {
            const v2u wa = wqa; VST_META(st + 2, qa, wqa);
            asm volatile("" ::: "memory");
            vst_issue(vB, qb, TV + (size_t)((st + 1) >> 4) * (2 * MiB), c16);
            vst_compute(y1, y2, vA, wa);
            const v2u wb = wqb; VST_META(st + 3, qb, wqb);
            asm volatile("" ::: "memory");
            vst_issue(vA, qa, TV + (size_t)(((st + 2) >> 4) & 3) * (2 * MiB), c16);
            vst_compute(y1, y2, vB, wb);
            sw = __builtin_amdgcn_sdot4((int)wa.x, 0x01010101, sw, false); sw = __builtin_amdgcn_sdot4((int)wa.y, 0x01010101, sw, false);
            sw = __builtin_amdgcn_sdot4((int)wb.x, 0x01010101, sw, false); sw = __builtin_amdgcn_sdot4((int)wb.y, 0x01010101, sw, false);
            if (((st + 1) & 15) == 15) {
                const int s = st >> 4;
                { const float sc = scn; const int off = 8 * sw;
                    v4u o[4];
#pragma unroll
                    for (int k = 0; k < 8; ++k) {
                        o[k >> 2][k & 3] = pk2((float)(y2[2 * k] - off) * sc, (float)(y2[2 * k + 1] - off) * sc);
                        o[2 + (k >> 2)][k & 3] = pk2((float)((y1[2 * k] - y2[2 * k]) >> 4) * sc, (float)((y1[2 * k + 1] - y2[2 * k + 1]) >> 4) * sc); }
                    v4u* dst = (v4u*)(Y + (size_t)t * DM + 256 * s + 32 * c); dst[0] = o[0]; dst[1] = o[1]; dst[2] = o[2]; dst[3] = o[3]; }
#pragma unroll
                for (int k = 0; k < 16; ++k) { y1[k] = 0; y2[k] = 0; }
                sw = 0;
            }
        }
#undef VST_META
        {
            const int b = t0 / SEQ;
            f32x4 gc[4], bec[4], g2c[4]; v2u nxx[4], nxy[4];
            v2u xx[8][4];
#pragma unroll
            for (int j = 0; j < 4; ++j) { gc[j] = *((const f32x4*)p.g2 + lane + 64 * j); bec[j] = *((const f32x4*)p.be2 + lane + 64 * j); g2c[j] = *((const f32x4*)(mod + b * 6144 + 5120) + lane + 64 * j); }
#pragma unroll
            for (int i = 0; i < 8; ++i)
#pragma unroll
                for (int j = 0; j < 4; ++j) xx[i][j] = *((const v2u*)(x1 + (size_t)(t0 + i) * DM) + lane + 64 * j);
            asm volatile("s_waitcnt vmcnt(0)" ::: "memory");
#pragma unroll
            for (int j = 0; j < 4; ++j) { g2c[j] = g2c[j] + 1.0f; nxy[j] = *((const v2u*)(Y + (size_t)t0 * DM) + lane + 64 * j); }
#pragma unroll
            for (int i = 0; i < 8; ++i) {
                const int row = t0 + i;
                f32x4 v[4]; float s = 0.f;
#pragma unroll
                for (int j = 0; j < 4; ++j) { const v2u xw = xx[i][j], yw = nxy[j];
                    const f32x4 xv = {bflo(xw.x), bfhi(xw.x), bflo(xw.y), bfhi(xw.y)}, yv = {bflo(yw.x), bfhi(yw.x), bflo(yw.y), bfhi(yw.y)};
                    v[j] = xv * ALPHA + g2c[j] * yv; s += (v[j].x + v[j].y) + (v[j].z + v[j].w); }
                if (i + 1 < 8) {
#pragma unroll
                    for (int j = 0; j < 4; ++j) nxy[j] = *((const v2u*)(Y + (size_t)(row + 1) * DM) + lane + 64 * j); }
                const float mean = wave_sum(s) * (1.f / DM); float s2 = 0.f;
#pragma unroll
                for (int j = 0; j < 4; ++j) { v[j] = v[j] - mean; s2 += (v[j].x * v[j].x + v[j].y * v[j].y) + (v[j].z * v[j].z + v[j].w * v[j].w); }
                const float rstd = rsqrtf(wave_sum(s2) * (1.f / DM) + LN_EPS);
#pragma unroll
                for (int j = 0; j < 4; ++j) *((f32x4*)(p.out + (size_t)row * DM) + lane + 64 * j) = v[j] * rstd * gc[j] + bec[j];
            }
        }
    }
}
__device__ __forceinline__ void ph_final(const Params& p, int bid, int nblk) {
    const bf16* x1 = (const bf16*)(p.ws + WS_X1); const bf16* Y = (const bf16*)(p.ws + WS_Y); const float* mod = (const float*)(p.ws + WS_MOD);
    const int lane = opaque_tid() & 63, wave = wave_id();
    const int stride = nblk * NWAVES; int t = bid * NWAVES + wave; int bcur = -1;
    f32x4 gc[4], bec[4], g2c[4]; v2u nxx[4], nxy[4];
#pragma unroll
    for (int j = 0; j < 4; ++j) { gc[j] = *((const f32x4*)p.g2 + lane + 64 * j); bec[j] = *((const f32x4*)p.be2 + lane + 64 * j); }
    if (t < NT) {
#pragma unroll
        for (int j = 0; j < 4; ++j) { nxx[j] = *((const v2u*)(x1 + (size_t)t * DM) + lane + 64 * j); nxy[j] = *((const v2u*)(Y + (size_t)t * DM) + lane + 64 * j); } }
    for (; t < NT; t += stride) {
        const int b = t / SEQ;
        if (b != bcur) { bcur = b;
#pragma unroll
            for (int j = 0; j < 4; ++j) g2c[j] = *((const f32x4*)(mod + b * 6144 + 5120) + lane + 64 * j) + 1.0f; }
        f32x4 v[4]; float s = 0.f;
#pragma unroll
        for (int j = 0; j < 4; ++j) { const v2u xw = nxx[j], yw = nxy[j];
            const f32x4 xv = {bflo(xw.x), bfhi(xw.x), bflo(xw.y), bfhi(xw.y)}, yv = {bflo(yw.x), bfhi(yw.x), bflo(yw.y), bfhi(yw.y)};
            v[j] = xv * ALPHA + g2c[j] * yv; s += (v[j].x + v[j].y) + (v[j].z + v[j].w); }
        if (t + stride < NT) {
#pragma unroll
            for (int j = 0; j < 4; ++j) { nxx[j] = *((const v2u*)(x1 + (size_t)(t + stride) * DM) + lane + 64 * j); nxy[j] = *((const v2u*)(Y + (size_t)(t + stride) * DM) + lane + 64 * j); } }
        const float mean = wave_sum(s) * (1.f / DM); float s2 = 0.f;
#pragma unroll
        for (int j = 0; j < 4; ++j) { v[j] = v[j] - mean; s2 += (v[j].x * v[j].x + v[j].y * v[j].y) + (v[j].z * v[j].z + v[j].w * v[j].w); }
        const float rstd = rsqrtf(wave_sum(s2) * (1.f / DM) + LN_EPS);
#pragma unroll
        for (int j = 0; j < 4; ++j) *((f32x4*)(p.out + (size_t)t * DM) + lane + 64 * j) = v[j] * rstd * gc[j] + bec[j];
    }
}

#ifndef PROBE_ID
#define PROBE_ID 0
#endif
#define RUN2(id, ...) do { __VA_ARGS__; if (PROBE_ID == (id)) { xcd_barrier(bar); __VA_ARGS__; } } while (0)
#ifndef TPROBE
#define TPROBE -1
#endif
#define TMARK(k) do { if (TPROBE == (k)) tp0 = wall_clock64(); if (TPROBE >= 0 && TPROBE + 1 == (k) && bid == 0) { const unsigned long long tn = wall_clock64(), te = tn + 4ull * (tn - tp0); while (wall_clock64() < te) __builtin_amdgcn_s_sleep(4); } } while (0)
__global__ void __launch_bounds__(NTHREADS, 2) mega(Params p) {
    extern __shared__ __attribute__((aligned(16))) unsigned char lds_raw[];

    LAS unsigned char* lds = (LAS unsigned char*)lds_raw;
    const int bid = blockIdx.x, nblk = gridDim.x, tid = opaque_tid();
    for (int u = tid; u < (LDS_BYTES - LDSCTL_OFF) / 4; u += NTHREADS) ((LAS unsigned*)(lds + LDSCTL_OFF))[u] = 0u;
    __syncthreads();
    unsigned* ctl = (unsigned*)(p.ws + WS_CTL);
    XcdBarrier bar = xcd_barrier_post(ctl + CW_BAR, (volatile LAS unsigned*)(lds + MISC_OFF) + 8);
    const float* mod = (const float*)(p.ws + WS_MOD);
    unsigned long long tp0 = 0ull; TMARK(0);

    ph_mod(p, lds, bid, nblk);
    TMARK(1);
    ph_prologue(p, lds, bid, nblk);
    if (tid == 0) { unsigned* tmo = ctl + CW_BAR; XB_SPIN(xb_ld(ctl + CW_MODD) < (unsigned)(6144 / 32), tmo);
        __builtin_amdgcn_fence(__ATOMIC_ACQUIRE, "agent"); asm volatile("s_waitcnt vmcnt(0)" ::: "memory"); }
    __syncthreads();
    ph_xn(p, bid, nblk);
    xcd_barrier(bar);
    TMARK(2);
    {
        pg8::Gemm g{(const pg8::bf16_t*)(p.ws + WS_XN), (const pg8::bf16_t*)(p.ws + WS_WIN), NT, NIN, DM}; pg8::StaticOrder S; S.init(NT, NIN, nblk, bid);
        EpiIn E{(bf16*)(p.ws + WS_FZ), (bf16*)(p.ws + WS_QB), (const float*)(p.ws + WS_MISC), p.pos};
        pg8::gemm_phase<EpiIn, pg8::StaticOrder, true, true>(lds, g, S, E);
        const int nun = (NT / 256) * (NIN / 256), maxu = (nun + nblk - 1) / nblk, first = nun - (maxu - 1) * nblk;
        if (first < nblk) { if (bid >= first) ph_tables_tail(p, bid - first, nblk - first); }
        else if (TBL_TAIL > 0) ph_tables_tail(p, bid, nblk);
    }
    xcd_barrier(bar);
    TMARK(3);
    RUN2(8, ph_fft(p, lds, bid, nblk));
    RUN2(2, ph_attn_fast(p, lds, bid, nblk));
    xcd_barrier(bar);
    TMARK(4);
    const volatile LAS unsigned* stw = (volatile LAS unsigned*)(lds + MISC_OFF) + 8;
    const bool uni = __builtin_amdgcn_readfirstlane(stw[4]) != 0u && nblk == 256;
    const int vb = uni ? (int)__builtin_amdgcn_readfirstlane(stw[2] * 8u + stw[3]) : bid;
    RUN2(3, ph_merge(p, vb, nblk));
    if (uni) xcd_local_barrier(bar); else xcd_barrier(bar);
    if (tid == 0) (void)xb_add(ctl + CW_MDONE, 1u);
    TMARK(5);
    {
        pg8::Gemm g{(const pg8::bf16_t*)(p.ws + WS_XN), (const pg8::bf16_t*)(p.ws + WS_WOUT), NT, DM, DM}; pg8::StaticOrder S; S.init(NT, DM, nblk, vb);
        EpiOut E{(bf16*)(p.ws + WS_Y1), p.x, mod, p.b_out, ctl + CW_MDONE, (unsigned)nblk};
        pg8::gemm_phase<EpiOut, pg8::StaticOrder, true, true>(lds, g, S, E);
    }
    if (uni) xcd_local_barrier(bar); else xcd_barrier(bar);
    TMARK(6);
    RUN2(4, ph_ln1_fast(p, vb, nblk));
    if (uni) xcd_local_barrier(bar); else xcd_barrier(bar);
    TMARK(7);
    {
        pg8::Gemm g{(const pg8::bf16_t*)(p.ws + WS_XN), (const pg8::bf16_t*)(p.ws + WS_WPQ), NT, DM, DM}; pg8::StaticOrder S; S.init(NT, DM, nblk, vb);
        EpiPeerTopk E{(const bf16*)(p.ws + WS_SUBK), (unsigned short*)(p.ws + WS_IDS), (float*)(p.ws + WS_GATES), (const float*)(p.ws + WS_SV)};
        pg8::gemm_phase<EpiPeerTopk, pg8::StaticOrder, false, true>(lds, g, S, E);
    }
    if (uni) xcd_local_barrier(bar); else xcd_barrier(bar);
    TMARK(8);
    ph_udotact(p, lds, vb, nblk);
    TMARK(10);
    ph_vaccfinal(p, lds, vb, nblk);
    TMARK(11);
    TMARK(12);
}

extern "C" void kernel_launch(void* const* d_in, const int* in_sizes, int n_in, void* d_out, int out_size, void* d_ws, size_t ws_size, hipStream_t stream) {
    Params p{};
    p.x = (const float*)d_in[0]; p.c = (const float*)d_in[1]; p.pos = (const int*)d_in[2]; p.w_ada = (const float*)d_in[3]; p.b_ada = (const float*)d_in[4];
    p.w_in = (const float*)d_in[5]; p.b_in = (const float*)d_in[6]; p.w_four = (const float*)d_in[7]; p.w_out = (const float*)d_in[8]; p.b_out = (const float*)d_in[9];
    p.g1 = (const float*)d_in[10]; p.be1 = (const float*)d_in[11]; p.w_pq = (const float*)d_in[12]; p.subk = (const float*)d_in[13]; p.pu = (const float*)d_in[14]; p.pv = (const float*)d_in[15];
    p.g2 = (const float*)d_in[16]; p.be2 = (const float*)d_in[17]; p.out = (float*)d_out; p.ws = (unsigned char*)d_ws;
    static int grid_blocks = 0;
    if (grid_blocks == 0) {
        if (ws_size < WS_END) { fprintf(stderr, "workspace too small: %zu < %zu\n", ws_size, (size_t)WS_END); grid_blocks = -1; return; }
        int dev = 0, cus = 0, per_cu = 0;
        if (hipGetDevice(&dev) != hipSuccess || hipDeviceGetAttribute(&cus, hipDeviceAttributeMultiprocessorCount, dev) != hipSuccess) { grid_blocks = -1; return; }
        if (hipFuncSetAttribute((const void*)mega, hipFuncAttributeMaxDynamicSharedMemorySize, LDS_BYTES) != hipSuccess) { fprintf(stderr, "hipFuncSetAttribute failed\n"); grid_blocks = -1; return; }
        if (hipOccupancyMaxActiveBlocksPerMultiprocessor(&per_cu, (const void*)mega, NTHREADS, LDS_BYTES) != hipSuccess || per_cu < 1) { fprintf(stderr, "occupancy query: %d\n", per_cu); grid_blocks = -1; return; }
        if (cus < 256) { fprintf(stderr, "this kernel needs 256 CUs (one workgroup per CU, 256 workgroups); device has %d\n", cus); grid_blocks = -1; return; }
        grid_blocks = 256;
    }
    if (grid_blocks < 0) return;
    if (hipMemsetAsync((char*)d_ws + WS_CTL, 0, CTL_ZERO_BYTES, stream) != hipSuccess) { fprintf(stderr, "memset failed\n"); return; }
    void* args[] = {&p};
    hipError_t e = hipLaunchCooperativeKernel((void*)mega, dim3(grid_blocks), dim3(NTHREADS), args, LDS_BYTES, stream);
    if (e != hipSuccess) fprintf(stderr, "cooperative launch failed: %s (grid %d)\n", hipGetErrorString(e), grid_blocks);
}
```
